# Optimizing an MI355X kernel written in HIP

```python
import jax, jax.numpy as jnp
from jax import lax
import numpy as np

D_MODEL = 1024
BATCH = 16
SEQ = 2048
DEPTH = 1

N_MEM = 256
M_HEADS = 4
M_HEAD_DIM = 128
M_WIDTH = M_HEADS * M_HEAD_DIM
M_CONV = 4
M_CHUNK = 64
A_HEADS = 8
A_NOPE = 64
A_ROPE = 32
A_QK = A_NOPE + A_ROPE
A_VDIM = 64
A_WIDTH = A_HEADS * A_VDIM
A_Q_RANK = 256
A_KV_RANK = 128
ROPE_THETA = 10000.0
Q_BLOCK = 128
X_HEADS = 4
X_HEAD_DIM = D_MODEL // X_HEADS
N_EXPERTS = 32
TOP_K = 4
D_EXPERT = D_MODEL
SWIGLU_ALPHA = 1.702
SWIGLU_LIMIT = 7.0
MOE_BLOCK = 128
DN_ALPHA = (2.0 * DEPTH) ** 0.25
DN_BETA = (8.0 * DEPTH) ** -0.25
EPS = 1e-5
IN_SPLITS = (A_Q_RANK, A_KV_RANK, A_ROPE, M_WIDTH, M_WIDTH, M_WIDTH, M_HEADS, M_HEADS, D_MODEL, D_MODEL)
IN_OFFSETS = tuple(int(v) for v in np.cumsum(IN_SPLITS)[:-1])
D_IN = int(sum(IN_SPLITS))

kernel_name = 'hybrid_mlstm_mla_gated_moe_deepnorm'


def layer_norm(x, g, b):
    xf = x.astype(jnp.float32)
    mu = xf.mean(-1, keepdims=True)
    var = jnp.square(xf - mu).mean(-1, keepdims=True)
    return ((xf - mu) * lax.rsqrt(var + EPS) * g + b).astype(x.dtype)


def rms_norm(x, g):
    xf = x.astype(jnp.float32)
    return (xf * lax.rsqrt(jnp.square(xf).mean(-1, keepdims=True) + EPS) * g).astype(x.dtype)


def rope_cos_sin(positions):
    half = A_ROPE // 2
    inv_freq = ROPE_THETA ** (-jnp.arange(half, dtype=jnp.float32) / half)
    ang = positions.astype(jnp.float32)[..., None] * inv_freq
    return jnp.cos(ang), jnp.sin(ang)


def apply_rope(x, cos, sin):
    x1, x2 = jnp.split(x.astype(jnp.float32), 2, axis=-1)
    return jnp.concatenate([x1 * cos - x2 * sin, x2 * cos + x1 * sin], axis=-1).astype(x.dtype)


def mlstm_chunkwise(q, k, v, i_pre, f_pre):
    bsz, s, nh, d = q.shape
    nc = s // M_CHUNK
    f32 = jnp.float32

    def to_chunks(t):
        return t.astype(f32).reshape(bsz, nc, M_CHUNK, nh, -1).transpose(0, 3, 1, 2, 4)

    q, v = to_chunks(q), to_chunks(v)
    k = to_chunks(k) * d ** -0.5
    ig = to_chunks(i_pre[..., None])[..., 0]
    lf = jax.nn.log_sigmoid(to_chunks(f_pre[..., None])[..., 0])
    b = jnp.cumsum(lf, axis=-1)
    b_tot = b[..., -1]
    causal = jnp.tril(jnp.ones((M_CHUNK, M_CHUNK), dtype=bool))
    log_d = jnp.where(causal, b[..., :, None] - b[..., None, :] + ig[..., None, :], -jnp.inf)
    m_intra = log_d.max(-1)

    a = b_tot[..., None] - b + ig
    m_chunk = a.max(-1)
    wa = jnp.exp(a - m_chunk[..., None])
    g_c = jnp.einsum('bhcl,bhclv,bhclk->bhcvk', wa, v, k)
    n_c = jnp.einsum('bhcl,bhclk->bhck', wa, k)

    def step(carry, xs):
        c_st, n_st, m_st = carry
        bt, mc, gc, nvec = xs
        m_new = jnp.maximum(bt + m_st, mc)
        s_old = jnp.exp(bt + m_st - m_new)
        s_new = jnp.exp(mc - m_new)
        c_new = s_old[..., None, None] * c_st + s_new[..., None, None] * gc
        n_new = s_old[..., None] * n_st + s_new[..., None] * nvec
        return (c_new, n_new, m_new), (c_st, n_st, m_st)

    init = (jnp.zeros((bsz, nh, d, d), f32), jnp.zeros((bsz, nh, d), f32), jnp.zeros((bsz, nh), f32))
    xs = (jnp.moveaxis(b_tot, 2, 0), jnp.moveaxis(m_chunk, 2, 0), jnp.moveaxis(g_c, 2, 0), jnp.moveaxis(n_c, 2, 0))
    _, (c_prev, n_prev, m_prev) = lax.scan(step, init, xs)
    c_prev = jnp.moveaxis(c_prev, 0, 2)
    n_prev = jnp.moveaxis(n_prev, 0, 2)
    m_prev = jnp.moveaxis(m_prev, 0, 2)

    g_inter = b + m_prev[..., None]
    m = jnp.maximum(g_inter, m_intra)
    w_inter = jnp.exp(g_inter - m)
    scores = jnp.einsum('bhcjd,bhcsd->bhcjs', q, k) * jnp.exp(log_d - m[..., None])
    num = (w_inter[..., None] * jnp.einsum('bhcvk,bhcjk->bhcjv', c_prev, q)
           + jnp.einsum('bhcjs,bhcsv->bhcjv', scores, v))
    den = w_inter * jnp.einsum('bhck,bhcjk->bhcj', n_prev, q) + scores.sum(-1)
    h = num / jnp.maximum(jnp.abs(den), jnp.exp(-m))[..., None]
    return h.transpose(0, 2, 3, 1, 4).reshape(bsz, s, nh, d)


def mlstm_branch(xm, vm, o_pre, i_pre, f_pre, b_i, b_f, conv_w, conv_b, w_mq, w_mk, g_mhead, w_mskip):
    bsz, s, _ = xm.shape
    xpad = jnp.pad(xm, ((0, 0), (M_CONV - 1, 0), (0, 0)))
    xc = jax.nn.silu(sum(xpad[:, j:j + s] * conv_w[j] for j in range(M_CONV)) + conv_b)
    xch = xc.reshape(bsz, s, M_HEADS, M_HEAD_DIM)
    q = jnp.einsum('bshd,hde->bshe', xch, w_mq)
    k = jnp.einsum('bshd,hde->bshe', xch, w_mk)
    v = vm.reshape(bsz, s, M_HEADS, M_HEAD_DIM)
    h = mlstm_chunkwise(q, k, v, i_pre + b_i, f_pre + b_f)
    mu = h.mean(-1, keepdims=True)
    var = jnp.square(h - mu).mean(-1, keepdims=True)
    hn = (((h - mu) * lax.rsqrt(var + EPS)).reshape(bsz, s, M_WIDTH) * g_mhead).astype(xm.dtype)
    return jax.nn.sigmoid(o_pre) * (hn + w_mskip * xc)


def causal_block_attention(q, k, v, scale):
    bsz, s, nh, dq = q.shape
    nq = s // Q_BLOCK
    qb = q.reshape(bsz, nq, Q_BLOCK, nh, dq).swapaxes(0, 1)
    key_idx = jnp.arange(s)

    def one_block(args):
        qi, blk = args
        sc = jnp.einsum('bqhd,bkhd->bhqk', qi, k).astype(jnp.float32) * scale
        q_idx = blk * Q_BLOCK + jnp.arange(Q_BLOCK)
        sc = jnp.where(key_idx[None, :] <= q_idx[:, None], sc, -jnp.inf)
        p = jax.nn.softmax(sc, axis=-1).astype(v.dtype)
        return jnp.einsum('bhqk,bkhd->bqhd', p, v)

    o = lax.map(one_block, (qb, jnp.arange(nq)))
    return o.swapaxes(0, 1).reshape(bsz, s, nh * v.shape[-1])


def mla_branch(q_lat, kv_lat, k_rope, positions, g_qlat, g_kvlat, w_uq, w_ukv):
    bsz, s, _ = q_lat.shape
    q = (rms_norm(q_lat, g_qlat) @ w_uq).reshape(bsz, s, A_HEADS, A_QK)
    kv = (rms_norm(kv_lat, g_kvlat) @ w_ukv).reshape(bsz, s, A_HEADS, A_NOPE + A_VDIM)
    q_nope, q_pe = q[..., :A_NOPE], q[..., A_NOPE:]
    k_nope, v = kv[..., :A_NOPE], kv[..., A_NOPE:]
    cos, sin = rope_cos_sin(positions)
    q_pe = apply_rope(q_pe, cos[:, :, None, :], sin[:, :, None, :])
    k_pe = apply_rope(k_rope, cos, sin)
    q = jnp.concatenate([q_nope, q_pe], axis=-1)
    k = jnp.concatenate([k_nope, jnp.broadcast_to(k_pe[:, :, None, :], (bsz, s, A_HEADS, A_ROPE))], axis=-1)
    return causal_block_attention(q, k, v, A_QK ** -0.5)


def memory_cross_attention(x, mem, w_cq, w_ckv, w_co):
    bsz, s, _ = x.shape
    q = (x @ w_cq).reshape(bsz, s, X_HEADS, X_HEAD_DIM)
    kv = (mem @ w_ckv).reshape(bsz, mem.shape[1], 2, X_HEADS, X_HEAD_DIM)
    k, v = kv[:, :, 0], kv[:, :, 1]
    sc = jnp.einsum('bshd,bmhd->bhsm', q, k).astype(jnp.float32) * X_HEAD_DIM ** -0.5
    p = jax.nn.softmax(sc, axis=-1).astype(v.dtype)
    o = jnp.einsum('bhsm,bmhd->bshd', p, v).reshape(bsz, s, D_MODEL)
    return o @ w_co


def clamped_swiglu(gu):
    x_glu, x_lin = gu[..., ::2], gu[..., 1::2]
    x_glu = jnp.minimum(x_glu, SWIGLU_LIMIT)
    x_lin = jnp.clip(x_lin, -SWIGLU_LIMIT, SWIGLU_LIMIT)
    return x_glu * jax.nn.sigmoid(SWIGLU_ALPHA * x_glu) * (x_lin + 1.0)


def moe_ffn(x, w_router, b_router, w_gu, b_gu, w_dn, b_dn):
    bsz, s, d = x.shape
    t = bsz * s
    xt = x.reshape(t, d)
    logits = (xt @ w_router + b_router).astype(jnp.float32)
    top_val, top_idx = lax.top_k(logits, TOP_K)
    gate = jax.nn.softmax(top_val, axis=-1)
    n_assign = t * TOP_K
    e_flat = top_idx.reshape(-1).astype(jnp.int32)
    tok_flat = jnp.arange(n_assign, dtype=jnp.int32) // TOP_K
    w_flat = gate.reshape(-1)
    order = jnp.argsort(e_flat)
    e_sorted, tok_sorted, w_sorted = e_flat[order], tok_flat[order], w_flat[order]
    counts = jnp.zeros((N_EXPERTS,), jnp.int32).at[e_flat].add(1)
    padded = (counts + MOE_BLOCK - 1) // MOE_BLOCK * MOE_BLOCK
    starts = jnp.cumsum(counts) - counts
    pends = jnp.cumsum(padded)
    pstarts = pends - padded
    dest = pstarts[e_sorted] + (jnp.arange(n_assign, dtype=jnp.int32) - starts[e_sorted])
    n_rows = n_assign + N_EXPERTS * MOE_BLOCK
    n_blocks = n_rows // MOE_BLOCK
    buf_tok = jnp.full((n_rows,), t, jnp.int32).at[dest].set(tok_sorted)
    buf_w = jnp.zeros((n_rows,), jnp.float32).at[dest].set(w_sorted)
    blk_e = jnp.minimum(jnp.searchsorted(pends, jnp.arange(n_blocks, dtype=jnp.int32) * MOE_BLOCK, side='right'),
                        N_EXPERTS - 1)
    x_pad = jnp.concatenate([xt, jnp.zeros((1, d), xt.dtype)], axis=0)
    xb = x_pad[buf_tok].reshape(n_blocks, MOE_BLOCK, d)

    def expert_block(args):
        xi, e = args
        return clamped_swiglu(xi @ w_gu[e] + b_gu[e]) @ w_dn[e] + b_dn[e]

    yb = lax.map(expert_block, (xb, blk_e)).reshape(n_rows, d)
    y = jnp.zeros((t + 1, d), x.dtype).at[buf_tok].add(yb * buf_w[:, None].astype(yb.dtype))
    return y[:t].reshape(bsz, s, d)


def setup_inputs(seed: int = 0) -> dict:
    key = jax.random.key(seed)
    ks = iter(jax.random.split(key, 48))
    L, D = DEPTH, D_MODEL

    def nrm(shape, scale):
        return scale * jax.random.normal(next(ks), shape, jnp.float32)

    def gain(shape):
        return 1.0 + nrm(shape, 0.02)

    offsets = jax.random.randint(next(ks), (BATCH, 1), 0, 4096, dtype=jnp.int32)
    return {
        'x': nrm((BATCH, SEQ, D), 1.0),
        'mem': nrm((BATCH, N_MEM, D), 1.0),
        'positions': (offsets + jnp.arange(SEQ, dtype=jnp.int32)[None, :]).astype(jnp.int32),
        'w_in': nrm((L, D, D_IN), D ** -0.5),
        'b_igate': nrm((L, M_HEADS), 0.1),
        'b_fgate': jnp.linspace(3.0, 6.0, M_HEADS, dtype=jnp.float32)[None, :] + nrm((L, M_HEADS), 0.1),
        'conv_w': nrm((L, M_CONV, M_WIDTH), M_CONV ** -0.5),
        'conv_b': nrm((L, M_WIDTH), 0.01),
        'w_mq': nrm((L, M_HEADS, M_HEAD_DIM, M_HEAD_DIM), M_HEAD_DIM ** -0.5),
        'w_mk': nrm((L, M_HEADS, M_HEAD_DIM, M_HEAD_DIM), M_HEAD_DIM ** -0.5),
        'g_mhead': gain((L, M_WIDTH)),
        'w_mskip': gain((L, M_WIDTH)),
        'g_qlat': gain((L, A_Q_RANK)),
        'g_kvlat': gain((L, A_KV_RANK)),
        'w_uq': nrm((L, A_Q_RANK, A_HEADS * A_QK), A_Q_RANK ** -0.5),
        'w_ukv': nrm((L, A_KV_RANK, A_HEADS * (A_NOPE + A_VDIM)), A_KV_RANK ** -0.5),
        'w_br_m': nrm((L, M_WIDTH, D), M_WIDTH ** -0.5),
        'w_br_a': nrm((L, A_WIDTH, D), A_WIDTH ** -0.5),
        'w_mix_out': nrm((L, D, D), DN_BETA * D ** -0.5),
        'ln1_g': gain((L, D)),
        'ln1_b': nrm((L, D), 0.01),
        'w_cq': nrm((L, D, D), D ** -0.5),
        'w_ckv': nrm((L, D, 2 * D), D ** -0.5),
        'w_co': nrm((L, D, D), DN_BETA * D ** -0.5),
        'ln2_g': gain((L, D)),
        'ln2_b': nrm((L, D), 0.01),
        'w_router': nrm((L, D, N_EXPERTS), D ** -0.5),
        'b_router': nrm((L, N_EXPERTS), 0.01),
        'w_gu': nrm((L, N_EXPERTS, D, 2 * D_EXPERT), D ** -0.5),
        'b_gu': nrm((L, N_EXPERTS, 2 * D_EXPERT), 0.01),
        'w_dn': nrm((L, N_EXPERTS, D_EXPERT, D), DN_BETA * D_EXPERT ** -0.5),
        'b_dn': nrm((L, N_EXPERTS, D), 0.01),
        'ln3_g': gain((L, D)),
        'ln3_b': nrm((L, D), 0.01),
    }


def reference(x, mem, positions, w_in, b_igate, b_fgate, conv_w, conv_b, w_mq, w_mk, g_mhead, w_mskip,
              g_qlat, g_kvlat, w_uq, w_ukv, w_br_m, w_br_a, w_mix_out, ln1_g, ln1_b,
              w_cq, w_ckv, w_co, ln2_g, ln2_b, w_router, b_router, w_gu, b_gu, w_dn, b_dn, ln3_g, ln3_b):
    h = x
    for l in range(DEPTH):
        proj = h @ w_in[l]
        q_lat, kv_lat, k_rope, xm, vm, o_pre, i_pre, f_pre, g_m, g_a = jnp.split(proj, IN_OFFSETS, axis=-1)
        y_m = mlstm_branch(xm, vm, o_pre, i_pre, f_pre, b_igate[l], b_fgate[l], conv_w[l], conv_b[l],
                           w_mq[l], w_mk[l], g_mhead[l], w_mskip[l]) @ w_br_m[l]
        y_a = mla_branch(q_lat, kv_lat, k_rope, positions, g_qlat[l], g_kvlat[l], w_uq[l], w_ukv[l]) @ w_br_a[l]
        mix = (jax.nn.sigmoid(g_m) * y_m + jax.nn.sigmoid(g_a) * y_a) @ w_mix_out[l]
        h = layer_norm(DN_ALPHA * h + mix, ln1_g[l], ln1_b[l])
        h = layer_norm(DN_ALPHA * h + memory_cross_attention(h, mem, w_cq[l], w_ckv[l], w_co[l]), ln2_g[l], ln2_b[l])
        h = layer_norm(DN_ALPHA * h + moe_ffn(h, w_router[l], b_router[l], w_gu[l], b_gu[l], w_dn[l], b_dn[l]),
                       ln3_g[l], ln3_b[l])
    return h
```

```cpp
#include <hip/hip_runtime.h>
#include <cstdio>
#include <cstdint>
#include <cmath>

#define LAS __attribute__((address_space(3)))
#define GAS __attribute__((address_space(1)))
typedef unsigned short bf16_t;
typedef short bf16x8 __attribute__((ext_vector_type(8)));
typedef float f32x4 __attribute__((ext_vector_type(4)));
typedef float f32x2 __attribute__((ext_vector_type(2)));
typedef float f32x16 __attribute__((ext_vector_type(16)));
typedef unsigned u32x4 __attribute__((ext_vector_type(4)));
typedef unsigned u32x2 __attribute__((ext_vector_type(2)));
typedef GAS unsigned gu32;
#define RLX_AGENT __ATOMIC_RELAXED, __HIP_MEMORY_SCOPE_AGENT
#define DI __device__ __forceinline__

constexpr int D = 1024, NB = 16, SEQ = 2048, T = NB * SEQ, NMEM = 256;
constexpr int MH = 4, MHD = 128, MW = 512, MCH = 64;
constexpr int AH = 8, ANOPE = 64, AROPE = 32, AQK = 96, AVD = 64, AW = 512, AQR = 256, AKVR = 128;
constexpr int XH = 4, XHD = 256;
constexpr int NE = 32, TOPK = 4;
constexpr int DIN = 4008, NPROJ = 4096;
constexpr float DN_ALPHA = 1.189207115002721f;
constexpr float EPS = 1e-5f;
constexpr int NASSIGN = T * TOPK;
constexpr int NROWS = NASSIGN + NE * 256;
constexpr int NTILES_MAX = NROWS / 256;
constexpr int PC_QLAT = 0, PC_KVLAT = 256, PC_KROPE = 384, PC_IG = 416, PC_FG = 420, PC_XM = 512, PC_VM = 1024, PC_OP = 1536, PC_GM = 2048, PC_GA = 3072;

DI unsigned f2bf(float f) { unsigned u = __builtin_bit_cast(unsigned, f); return (u + 0x7fffu + ((u >> 16) & 1u)) >> 16; }
DI unsigned pk2(float lo, float hi) { return f2bf(lo) | (f2bf(hi) << 16); }
DI float bf2f(unsigned short b) { return __builtin_bit_cast(float, (unsigned)b << 16); }
DI float bflo(unsigned w) { return __builtin_bit_cast(float, w << 16); }
DI float bfhi(unsigned w) { return __builtin_bit_cast(float, w & 0xffff0000u); }
DI float wave_sum(float v) {
#pragma unroll
    for (int o = 1; o < 64; o <<= 1) v += __shfl_xor(v, o);
    return v;
}
DI float wave_max(float v) {
#pragma unroll
    for (int o = 1; o < 64; o <<= 1) v = fmaxf(v, __shfl_xor(v, o));
    return v;
}
DI float sigmoidf_(float x) { return 1.0f / (1.0f + __expf(-x)); }
DI int crow(int r, int hi) { return (r & 3) + 8 * (r >> 2) + 4 * hi; }
#define MFMA32(a, b, c) __builtin_amdgcn_mfma_f32_32x32x16_bf16((a), (b), (c), 0, 0, 0)

namespace pg8 {
constexpr int BM = 256, BK = 64, HALF = 128, HTB = HALF * BK * 2, STAGE_BYTES = 8 * HTB;
__host__ __device__ __forceinline__ int lds_byte(int r, int c) { const int st = (r >> 4) * 2 + (c >> 5), rr = r & 15, cc = c & 31, ob = rr * 64 + cc * 2; return st * 1024 + (ob ^ (((ob >> 9) & 1) << 5)); }
__host__ __device__ __forceinline__ void stage_rc(int b, int& R, int& C) { const int st = b / 1024, sb = b % 1024, swz = sb ^ (((sb >> 9) & 1) << 5); R = (st >> 1) * 16 + swz / 64; C = (st & 1) * 32 + (swz % 64) / 2; }
__host__ __device__ __forceinline__ int perm32(int rho) { const int n = rho >> 4, i = rho & 15; return 8 * (i >> 2) + 4 * n + (i & 3); }

struct Unit { int pm, pn, aux; const char* a; const char* b; };
struct Ctx { int wr, wc, fr, fq, wid, lane; };

DI unsigned cvt_pk_bf16(float lo, float hi) { unsigned r; asm volatile("v_cvt_pk_bf16_f32 %0, %1, %2" : "=v"(r) : "v"(lo), "v"(hi)); return r; }

typedef f32x4 Acc[2][2][4][2];

template <class Epi, class Sched>
DI void gemm_phase(LAS unsigned char* lds, const int K, const int lda, const int ldb, const Sched& S, const Epi& E) {
    int tid = threadIdx.x; asm volatile("" : "+v"(tid));
    const int wid = __builtin_amdgcn_readfirstlane(tid >> 6), lane = tid & 63, wr = wid >> 2, wc = wid & 3, fr = lane & 15, fq = lane >> 4;
    const int nt = K / BK;
    unsigned voffA[2], voffB[2];
#pragma unroll
    for (int i = 0; i < 2; ++i) { int R, C; stage_rc(tid * 16 + i * 8192, R, C); const int Rb = Epi::PERM ? ((R & ~31) + perm32(R & 31)) : R;
        voffA[i] = (unsigned)(R * lda + C) * 2u; voffB[i] = (unsigned)(Rb * ldb + C) * 2u; }
    const size_t kstep = (size_t)(BK * 2);
    const size_t hstepA = (size_t)HALF * lda * 2, hstepB = (size_t)HALF * ldb * 2;
    const unsigned ldsw = (unsigned)wid * 1024u;
    const int aoff = lds_byte(wr * 64 + fr, fq * 8), boff = lds_byte(wc * 32 + fr, fq * 8);
    const Ctx cx{wr, wc, fr, fq, wid, lane};
#define PG8_SA(b, h) (((b) * 2 + (h)) * HTB)
#define PG8_SB(b, h) ((4 + (b) * 2 + (h)) * HTB)
#define PG8_STAGE(bufoff, gbase, voff) do { _Pragma("unroll") for (int _i = 0; _i < 2; ++_i) \
        __builtin_amdgcn_global_load_lds((const unsigned*)((const char*)(gbase) + (voff)[_i]), (LAS unsigned*)(lds + (bufoff) + ldsw + _i * 8192), 16, 0, 0); } while (0)
#define PG8_LDA(dst, b, h) do { _Pragma("unroll") for (int m = 0; m < 4; ++m) _Pragma("unroll") for (int k = 0; k < 2; ++k) dst[m][k] = *(const LAS bf16x8*)(lds + PG8_SA(b, h) + aoff + m * 2048 + k * 1024); } while (0)
#define PG8_LDB(dst, b, h) do { _Pragma("unroll") for (int n = 0; n < 2; ++n) _Pragma("unroll") for (int k = 0; k < 2; ++k) dst[n][k] = *(const LAS bf16x8*)(lds + PG8_SB(b, h) + boff + n * 2048 + k * 1024); } while (0)
#define PG8_MMA(ai, bj, At, Bt) do { __builtin_amdgcn_s_setprio(1); _Pragma("unroll") for (int m = 0; m < 4; ++m) _Pragma("unroll") for (int n = 0; n < 2; ++n) _Pragma("unroll") for (int k = 0; k < 2; ++k) \
        acc[ai][bj][m][n] = __builtin_amdgcn_mfma_f32_16x16x32_bf16(Bt[n][k], At[m][k], acc[ai][bj][m][n], 0, 0, 0); __builtin_amdgcn_s_setprio(0); } while (0)
#define PG8_WAIT_V(n) asm volatile("s_waitcnt vmcnt(" #n ")" ::: "memory")
#define PG8_WAIT_L(n) asm volatile("s_waitcnt lgkmcnt(" #n ")" ::: "memory")
#define PG8_BAR __builtin_amdgcn_s_barrier()
#define PG8_SCHED __builtin_amdgcn_sched_barrier(0)
    Unit cur, nxt; int ui = 0;
    if (!S.next(0, cur)) return;
    Acc acc;
#pragma unroll
    for (int a = 0; a < 2; ++a)
#pragma unroll
        for (int b = 0; b < 2; ++b)
#pragma unroll
            for (int m = 0; m < 4; ++m)
#pragma unroll
                for (int n = 0; n < 2; ++n) acc[a][b][m][n] = (f32x4){0.f, 0.f, 0.f, 0.f};
    bf16x8 At[4][2], B0[2][2], B1[2][2];
    const char* cA = cur.a; const char* cB = cur.b;
    PG8_STAGE(PG8_SB(0, 0), cB, voffB); PG8_STAGE(PG8_SB(0, 1), cB + hstepB, voffB); PG8_STAGE(PG8_SA(0, 0), cA, voffA); PG8_STAGE(PG8_SA(0, 1), cA + hstepA, voffA);
    if (wr == 1) PG8_BAR;
    PG8_WAIT_V(2); PG8_BAR;
    PG8_STAGE(PG8_SB(1, 0), cB + kstep, voffB); PG8_STAGE(PG8_SA(1, 0), cA + kstep, voffA); PG8_STAGE(PG8_SB(1, 1), cB + hstepB + kstep, voffB);
    PG8_WAIT_V(6); PG8_BAR;
    for (;;) {
        const bool has_next = S.next(ui + 1, nxt);
        const char* nA = has_next ? nxt.a : cA; const char* nB = has_next ? nxt.b : cB;
#pragma unroll 1
        for (int t = 0; t < nt; t += 2) {
            const bool last = (t == nt - 2);
            const char* a1 = cA + (size_t)(t + 1) * kstep;
            const char* a2 = last ? nA : cA + (size_t)(t + 2) * kstep; const char* b2 = last ? nB : cB + (size_t)(t + 2) * kstep;
            const char* a3 = a2 + kstep; const char* b3 = b2 + kstep;
            PG8_LDB(B0, 0, 0); PG8_LDB(B1, 0, 1); PG8_SCHED; PG8_LDA(At, 0, 0); PG8_STAGE(PG8_SA(1, 1), a1 + hstepA, voffA);
            PG8_WAIT_V(8); PG8_WAIT_L(0); PG8_BAR; PG8_MMA(0, 0, At, B0); PG8_MMA(0, 1, At, B1); PG8_BAR; PG8_SCHED;
            PG8_LDA(At, 0, 1); PG8_STAGE(PG8_SB(0, 0), b2, voffB); PG8_STAGE(PG8_SB(0, 1), b2 + hstepB, voffB); PG8_STAGE(PG8_SA(0, 0), a2, voffA);
            PG8_WAIT_V(8); PG8_WAIT_L(0); PG8_BAR; PG8_MMA(1, 0, At, B0); PG8_MMA(1, 1, At, B1); PG8_BAR; PG8_SCHED;
            PG8_LDB(B0, 1, 0); PG8_LDB(B1, 1, 1); PG8_SCHED; PG8_LDA(At, 1, 0); PG8_STAGE(PG8_SA(0, 1), a2 + hstepA, voffA);
            PG8_WAIT_V(8); PG8_WAIT_L(0); PG8_BAR; PG8_MMA(0, 0, At, B0); PG8_MMA(0, 1, At, B1); PG8_BAR; PG8_SCHED;
            PG8_LDA(At, 1, 1); PG8_STAGE(PG8_SB(1, 0), b3, voffB); PG8_STAGE(PG8_SB(1, 1), b3 + hstepB, voffB); PG8_STAGE(PG8_SA(1, 0), a3, voffA);
            PG8_WAIT_V(8); PG8_WAIT_L(0); PG8_BAR; PG8_MMA(1, 0, At, B0); PG8_MMA(1, 1, At, B1); PG8_BAR; PG8_SCHED;
        }
        if (wr == 0) PG8_BAR;
        E(acc, cur, cx);
        if (!has_next) break;
#pragma unroll
        for (int a = 0; a < 2; ++a)
#pragma unroll
            for (int b = 0; b < 2; ++b)
#pragma unroll
                for (int m = 0; m < 4; ++m)
#pragma unroll
                    for (int n = 0; n < 2; ++n) acc[a][b][m][n] = (f32x4){0.f, 0.f, 0.f, 0.f};
        cur = nxt; cA = nA; cB = nB; ++ui;
        if (wr == 1) PG8_BAR;
    }
    PG8_WAIT_V(0);
    PG8_BAR;
#undef PG8_SA
#undef PG8_SB
#undef PG8_STAGE
#undef PG8_LDA
#undef PG8_LDB
#undef PG8_MMA
#undef PG8_WAIT_V
#undef PG8_WAIT_L
#undef PG8_BAR
#undef PG8_SCHED
}
}
namespace pg8 {
constexpr int NXCD = 8, WGM = 8;
struct DenseOrder {
    const char* A; const char* B; int nM, nN, nwg, G, c; size_t strideA, strideB;
    DI void init(const void* A_, const void* B_, int M, int N, int lda, int ldb, int G_, int c_) { A = (const char*)A_; B = (const char*)B_; nM = M / BM; nN = N / BM; nwg = nM * nN; G = G_; c = c_;
        strideA = (size_t)BM * lda * 2; strideB = (size_t)BM * ldb * 2; }
    DI bool next(int i, Unit& u) const {
        const long L = (long)i * G + c; if (L >= nwg) return false;
        int wgid = (int)L; { const int q = nwg / NXCD, r = nwg % NXCD, xcd = wgid % NXCD, off = wgid / NXCD; wgid = (xcd < r ? xcd * (q + 1) : r * (q + 1) + (xcd - r) * q) + off; }
        const int nig = WGM * nN, gid = wgid / nig, fm = gid * WGM, gsz = (nM - fm) < WGM ? (nM - fm) : WGM;
        u.pm = fm + ((wgid % nig) % gsz); u.pn = (wgid % nig) / gsz; u.aux = 0;
        u.a = A + (size_t)u.pm * strideA; u.b = B + (size_t)u.pn * strideB; return true;
    }
};
struct CrossSOrder {
    const char* Q; const char* Kc; int G, v;
    DI bool next(int i, Unit& u) const {
        const int L = i * G + v; if (L >= (T / 256) * XH) return false;
        u.pm = L >> 2; u.pn = L & 3; u.aux = 0;
        u.a = Q + ((size_t)u.pm * 256 * D + u.pn * 256) * 2; u.b = Kc + ((size_t)(u.pm >> 3) * 256 * D + u.pn * 256) * 2; return true;
    }
};
struct CrossOOrder {
    const char* P; const char* Vt; int G, v;
    DI bool next(int i, Unit& u) const {
        const int L = i * G + v; if (L >= (T / 256) * XH) return false;
        u.pm = L >> 2; u.pn = L & 3; u.aux = 0;
        u.a = P + ((size_t)u.pm * 256 * D + u.pn * 256) * 2; u.b = Vt + ((size_t)u.pn * 256 * (NB * NMEM) + (size_t)(u.pm >> 3) * 256) * 2; return true;
    }
};
struct MoeOrder {
    const char* A; const char* W; const LAS int* tstart; int npn, G, v; size_t strideA, strideW;
    DI bool next(int i, Unit& u) const {
        const int L = i * G + v; const int total = tstart[NE] * npn; if (L >= total) return false;
        const int tile = L / npn; u.pm = tile; u.pn = L - tile * npn;
        int e = 0;
#pragma unroll 1
        for (int j = 1; j < NE; ++j) e += (tstart[j] <= tile) ? 1 : 0;
        u.aux = e;
        u.a = A + (size_t)tile * strideA; u.b = W + (size_t)e * strideW + (size_t)u.pn * 256 * 1024 * 2; return true;
    }
};

struct EpiBf16 {
    static constexpr bool PERM = true;
    bf16_t* O; int ldc; int sc_from; float scale;
    DI void operator()(const Acc& acc, const Unit& u, const Ctx& c) const {
        int row0 = u.pm * BM + c.wr * 64 + c.fr, col0 = u.pn * BM + c.wc * 32 + 8 * c.fq; asm volatile("" : "+v"(row0), "+v"(col0));
        const float sc = (u.pn >= sc_from) ? scale : 1.0f;
#pragma unroll
        for (int ai = 0; ai < 2; ++ai)
#pragma unroll
            for (int m = 0; m < 4; ++m) { bf16_t* rowp = O + (size_t)(row0 + ai * HALF + m * 16) * ldc + col0;
#pragma unroll
                for (int bj = 0; bj < 2; ++bj) { const f32x4 v0 = acc[ai][bj][m][0] * sc, v1 = acc[ai][bj][m][1] * sc;
                    u32x4 w; w.x = cvt_pk_bf16(v0[0], v0[1]); w.y = cvt_pk_bf16(v0[2], v0[3]); w.z = cvt_pk_bf16(v1[0], v1[1]); w.w = cvt_pk_bf16(v1[2], v1[3]);
                    *(u32x4*)(rowp + bj * HALF) = w; } }
    }
};
struct EpiProj {
    static constexpr bool PERM = true;
    bf16_t* O; float* gates;
    DI void operator()(const Acc& acc, const Unit& u, const Ctx& c) const {
        int row0 = u.pm * BM + c.wr * 64 + c.fr, col0 = u.pn * BM + c.wc * 32 + 8 * c.fq; asm volatile("" : "+v"(row0), "+v"(col0));
#pragma unroll
        for (int ai = 0; ai < 2; ++ai)
#pragma unroll
            for (int m = 0; m < 4; ++m) { const int row = row0 + ai * HALF + m * 16; bf16_t* rowp = O + (size_t)row * NPROJ + col0;
#pragma unroll
                for (int bj = 0; bj < 2; ++bj) { const f32x4 v0 = acc[ai][bj][m][0], v1 = acc[ai][bj][m][1];
                    u32x4 w; w.x = cvt_pk_bf16(v0[0], v0[1]); w.y = cvt_pk_bf16(v0[2], v0[3]); w.z = cvt_pk_bf16(v1[0], v1[1]); w.w = cvt_pk_bf16(v1[2], v1[3]);
                    *(u32x4*)(rowp + bj * HALF) = w; }
                if (u.pn == 1 && c.wc == 1 && c.fq == 0) { *(f32x4*)(gates + (size_t)row * 8) = acc[ai][1][m][0]; *(f32x4*)(gates + (size_t)row * 8 + 4) = acc[ai][1][m][1]; } }
    }
};
struct EpiQmla {
    static constexpr bool PERM = true;
    bf16_t* O; const float* cs;
    float scale;
    DI void operator()(const Acc& acc, const Unit& u, const Ctx& c) const {
        int row0 = u.pm * BM + c.wr * 64 + c.fr, col0 = u.pn * BM + c.wc * 32 + 8 * c.fq; asm volatile("" : "+v"(row0), "+v"(col0));
#pragma unroll
        for (int ai = 0; ai < 2; ++ai)
#pragma unroll
            for (int m = 0; m < 4; ++m) { const int row = row0 + ai * HALF + m * 16; bf16_t* rowp = O + (size_t)row * (AH * AQK) + col0;
#pragma unroll
                for (int bj = 0; bj < 2; ++bj) { f32x4 v0 = acc[ai][bj][m][0] * scale, v1 = acc[ai][bj][m][1] * scale;
                    const int cc = (col0 + bj * HALF) % AQK;
                    if (cc >= ANOPE) { const int p0 = (cc - ANOPE) >> 1;
                        const f32x4 t0 = *(const f32x4*)(cs + (size_t)row * 32 + p0 * 2), t1 = *(const f32x4*)(cs + (size_t)row * 32 + p0 * 2 + 4);
                        f32x4 r0, r1;
                        r0[0] = v0[0] * t0[0] - v0[1] * t0[1]; r0[1] = v0[1] * t0[0] + v0[0] * t0[1];
                        r0[2] = v0[2] * t0[2] - v0[3] * t0[3]; r0[3] = v0[3] * t0[2] + v0[2] * t0[3];
                        r1[0] = v1[0] * t1[0] - v1[1] * t1[1]; r1[1] = v1[1] * t1[0] + v1[0] * t1[1];
                        r1[2] = v1[2] * t1[2] - v1[3] * t1[3]; r1[3] = v1[3] * t1[2] + v1[2] * t1[3];
                        v0 = r0; v1 = r1; }
                    u32x4 w; w.x = cvt_pk_bf16(v0[0], v0[1]); w.y = cvt_pk_bf16(v0[2], v0[3]); w.z = cvt_pk_bf16(v1[0], v1[1]); w.w = cvt_pk_bf16(v1[2], v1[3]);
                    *(u32x4*)(rowp + bj * HALF) = w; } }
    }
};
template <bool ADD> struct EpiGate {
    static constexpr bool PERM = true;
    bf16_t* O; const bf16_t* proj; int gcol;
    DI void operator()(const Acc& acc, const Unit& u, const Ctx& c) const {
        int row0 = u.pm * BM + c.wr * 64 + c.fr, col0 = u.pn * BM + c.wc * 32 + 8 * c.fq; asm volatile("" : "+v"(row0), "+v"(col0));
#pragma unroll
        for (int ai = 0; ai < 2; ++ai)
#pragma unroll
            for (int m = 0; m < 4; ++m) { const int row = row0 + ai * HALF + m * 16; bf16_t* rowp = O + (size_t)row * D + col0; const bf16_t* gp = proj + (size_t)row * NPROJ + gcol + col0;
#pragma unroll
                for (int bj = 0; bj < 2; ++bj) { const f32x4 v0 = acc[ai][bj][m][0], v1 = acc[ai][bj][m][1];
                    const u32x4 g = *(const u32x4*)(gp + bj * HALF);
                    float o[8];
                    o[0] = sigmoidf_(bflo(g.x)) * v0[0]; o[1] = sigmoidf_(bfhi(g.x)) * v0[1]; o[2] = sigmoidf_(bflo(g.y)) * v0[2]; o[3] = sigmoidf_(bfhi(g.y)) * v0[3];
                    o[4] = sigmoidf_(bflo(g.z)) * v1[0]; o[5] = sigmoidf_(bfhi(g.z)) * v1[1]; o[6] = sigmoidf_(bflo(g.w)) * v1[2]; o[7] = sigmoidf_(bfhi(g.w)) * v1[3];
                    if (ADD) { const u32x4 p = *(const u32x4*)(rowp + bj * HALF);
                        o[0] += bflo(p.x); o[1] += bfhi(p.x); o[2] += bflo(p.y); o[3] += bfhi(p.y); o[4] += bflo(p.z); o[5] += bfhi(p.z); o[6] += bflo(p.w); o[7] += bfhi(p.w); }
                    u32x4 w; w.x = cvt_pk_bf16(o[0], o[1]); w.y = cvt_pk_bf16(o[2], o[3]); w.z = cvt_pk_bf16(o[4], o[5]); w.w = cvt_pk_bf16(o[6], o[7]);
                    *(u32x4*)(rowp + bj * HALF) = w; } }
    }
};
struct EpiF32 {
    static constexpr bool PERM = false;
    float* C; int ldc; int ncols_valid;
    DI void operator()(const Acc& acc, const Unit& u, const Ctx& c) const {
        int row0 = u.pm * BM + c.wr * 64 + c.fr, col0 = u.pn * BM + c.wc * 32 + 4 * c.fq; asm volatile("" : "+v"(row0), "+v"(col0));
#pragma unroll
        for (int ai = 0; ai < 2; ++ai)
#pragma unroll
            for (int m = 0; m < 4; ++m) { float* rowp = C + (size_t)(row0 + ai * HALF + m * 16) * ldc + col0;
#pragma unroll
                for (int bj = 0; bj < 2; ++bj)
#pragma unroll
                    for (int n = 0; n < 2; ++n) if (col0 + bj * HALF + n * 16 < ncols_valid) *(f32x4*)(rowp + bj * HALF + n * 16) = acc[ai][bj][m][n]; }
    }
};
struct EpiSoftmax {
    static constexpr bool PERM = true;
    bf16_t* O; LAS float* red;
    DI void operator()(Acc& acc, const Unit& u, const Ctx& c) const {
        int row0 = u.pm * BM + c.wr * 64 + c.fr, col0 = u.pn * BM + c.wc * 32 + 8 * c.fq; asm volatile("" : "+v"(row0), "+v"(col0));
        int rbase = (c.wr * 64 + c.fr) * 4; asm volatile("" : "+v"(rbase));
        LAS float* r1 = red + rbase; LAS float* r2 = red + 1024 + rbase;
#pragma unroll
        for (int ai = 0; ai < 2; ++ai)
#pragma unroll
            for (int m = 0; m < 4; ++m) { float v = -INFINITY;
#pragma unroll
                for (int bj = 0; bj < 2; ++bj)
#pragma unroll
                    for (int n = 0; n < 2; ++n) { const f32x4 x = acc[ai][bj][m][n]; v = fmaxf(v, fmaxf(fmaxf(x[0], x[1]), fmaxf(x[2], x[3]))); }
                v = fmaxf(v, __shfl_xor(v, 16)); v = fmaxf(v, __shfl_xor(v, 32));
                if (c.fq == 0) r1[(ai * HALF + m * 16) * 4 + c.wc] = v;
                __builtin_amdgcn_sched_barrier(0); }
        asm volatile("s_waitcnt lgkmcnt(0)" ::: "memory"); __builtin_amdgcn_s_barrier(); asm volatile("" ::: "memory");
#pragma unroll
        for (int ai = 0; ai < 2; ++ai)
#pragma unroll
            for (int m = 0; m < 4; ++m) { const f32x4 q = *(const LAS f32x4*)(r1 + (ai * HALF + m * 16) * 4);
                const float mm = fmaxf(fmaxf(q[0], q[1]), fmaxf(q[2], q[3])); float s = 0.f;
#pragma unroll
                for (int bj = 0; bj < 2; ++bj)
#pragma unroll
                    for (int n = 0; n < 2; ++n) { f32x4 x = acc[ai][bj][m][n];
                        x[0] = __builtin_amdgcn_exp2f(x[0] - mm); x[1] = __builtin_amdgcn_exp2f(x[1] - mm); x[2] = __builtin_amdgcn_exp2f(x[2] - mm); x[3] = __builtin_amdgcn_exp2f(x[3] - mm);
                        acc[ai][bj][m][n] = x; s += (x[0] + x[1]) + (x[2] + x[3]); }
                s += __shfl_xor(s, 16); s += __shfl_xor(s, 32);
                if (c.fq == 0) r2[(ai * HALF + m * 16) * 4 + c.wc] = s;
                __builtin_amdgcn_sched_barrier(0); }
        asm volatile("s_waitcnt lgkmcnt(0)" ::: "memory"); __builtin_amdgcn_s_barrier(); asm volatile("" ::: "memory");
#pragma unroll
        for (int ai = 0; ai < 2; ++ai)
#pragma unroll
            for (int m = 0; m < 4; ++m) { const f32x4 q = *(const LAS f32x4*)(r2 + (ai * HALF + m * 16) * 4);
                const float inv = 1.0f / ((q[0] + q[1]) + (q[2] + q[3]));
                bf16_t* rowp = O + (size_t)(row0 + ai * HALF + m * 16) * D + col0;
#pragma unroll
                for (int bj = 0; bj < 2; ++bj) { const f32x4 v0 = acc[ai][bj][m][0] * inv, v1 = acc[ai][bj][m][1] * inv;
                    u32x4 w; w.x = cvt_pk_bf16(v0[0], v0[1]); w.y = cvt_pk_bf16(v0[2], v0[3]); w.z = cvt_pk_bf16(v1[0], v1[1]); w.w = cvt_pk_bf16(v1[2], v1[3]);
                    *(u32x4*)(rowp + bj * HALF) = w; }
                __builtin_amdgcn_sched_barrier(0); }
    }
};
struct EpiSwiglu {
    static constexpr bool PERM = true;
    bf16_t* O; const float* bias;
    DI void operator()(const Acc& acc, const Unit& u, const Ctx& c) const {
        int row0 = u.pm * BM + c.wr * 64 + c.fr, col0 = u.pn * BM + c.wc * 32 + 8 * c.fq; asm volatile("" : "+v"(row0), "+v"(col0));
        f32x4 bv[2][2];
#pragma unroll
        for (int bj = 0; bj < 2; ++bj)
#pragma unroll
            for (int n = 0; n < 2; ++n) bv[bj][n] = *(const f32x4*)(bias + (size_t)u.aux * 2048 + col0 + bj * HALF + 4 * n);
#pragma unroll
        for (int ai = 0; ai < 2; ++ai)
#pragma unroll
            for (int m = 0; m < 4; ++m) { bf16_t* rowp = O + (size_t)(row0 + ai * HALF + m * 16) * 1024 + (col0 >> 1);
#pragma unroll
                for (int bj = 0; bj < 2; ++bj) { const f32x4 v0 = acc[ai][bj][m][0] + bv[bj][0], v1 = acc[ai][bj][m][1] + bv[bj][1];
                    float o[4];
#define SWG(g, l) ({ const float g_ = fminf((g), 7.0f), l_ = fminf(fmaxf((l), -7.0f), 7.0f); g_ * sigmoidf_(1.702f * g_) * (l_ + 1.0f); })
                    o[0] = SWG(v0[0], v0[1]); o[1] = SWG(v0[2], v0[3]); o[2] = SWG(v1[0], v1[1]); o[3] = SWG(v1[2], v1[3]);
#undef SWG
                    u32x2 w; w.x = cvt_pk_bf16(o[0], o[1]); w.y = cvt_pk_bf16(o[2], o[3]);
                    *(u32x2*)(rowp + bj * (HALF / 2)) = w; } }
    }
};
struct EpiDown {
    static constexpr bool PERM = true;
    bf16_t* O; const float* bias; const float* rowgate;
    DI void operator()(const Acc& acc, const Unit& u, const Ctx& c) const {
        int row0 = u.pm * BM + c.wr * 64 + c.fr, col0 = u.pn * BM + c.wc * 32 + 8 * c.fq; asm volatile("" : "+v"(row0), "+v"(col0));
        f32x4 bv[2][2];
#pragma unroll
        for (int bj = 0; bj < 2; ++bj)
#pragma unroll
            for (int n = 0; n < 2; ++n) bv[bj][n] = *(const f32x4*)(bias + (size_t)u.aux * 1024 + col0 + bj * HALF + 4 * n);
#pragma unroll
        for (int ai = 0; ai < 2; ++ai)
#pragma unroll
            for (int m = 0; m < 4; ++m) { const int row = row0 + ai * HALF + m * 16; const float gt = rowgate[row]; bf16_t* rowp = O + (size_t)row * 1024 + col0;
#pragma unroll
                for (int bj = 0; bj < 2; ++bj) { const f32x4 v0 = (acc[ai][bj][m][0] + bv[bj][0]) * gt, v1 = (acc[ai][bj][m][1] + bv[bj][1]) * gt;
                    u32x4 w; w.x = cvt_pk_bf16(v0[0], v0[1]); w.y = cvt_pk_bf16(v0[2], v0[3]); w.z = cvt_pk_bf16(v1[0], v1[1]); w.w = cvt_pk_bf16(v1[2], v1[3]);
                    *(u32x4*)(rowp + bj * HALF) = w; } }
    }
};
}
constexpr size_t MiB = 1u << 20;
constexpr size_t WS_CTL = 0, CTL_ZERO_BYTES = 1 * MiB;
constexpr size_t WS_W_IN = 2 * MiB, WS_W_UQ = 10 * MiB, WS_W_UK = WS_W_UQ + 512 * 1024, WS_W_UV = WS_W_UK + 256 * 1024, WS_W_MQK = 11 * MiB, WS_W_BRM = 12 * MiB, WS_W_BRA = 13 * MiB,
                 WS_W_MIX = 14 * MiB, WS_W_CQ = 16 * MiB, WS_W_CK = 18 * MiB, WS_W_CV = 20 * MiB, WS_W_CO = 22 * MiB, WS_W_R = 24 * MiB, WS_W_GU = 26 * MiB, WS_W_DN = 154 * MiB;
constexpr size_t WS_GATES = 218 * MiB, WS_CS = 219 * MiB, WS_KPE = 223 * MiB, WS_MEMB = 225 * MiB, WS_KC = 233 * MiB, WS_VCT = 241 * MiB, WS_LOGITS = 249 * MiB,
                 WS_ASSIGN = 253 * MiB, WS_GATEW = WS_ASSIGN + 512 * 1024, WS_TOKPOS = 254 * MiB, WS_ROWGATE = WS_TOKPOS + 512 * 1024;
constexpr size_t WS_XB = 256 * MiB, WS_PROJ = 320 * MiB, WS_QN = 576 * MiB, WS_KVN = 592 * MiB, WS_XC = 608 * MiB, WS_QMLA = 640 * MiB, WS_KN = 688 * MiB, WS_VT = 720 * MiB,
                 WS_QKM = 752 * MiB, WS_KTM = 816 * MiB, WS_AO = 848 * MiB, WS_HRAW = 880 * MiB, WS_HM = 944 * MiB;
constexpr size_t WS_GATED = 256 * MiB, WS_MIXO = 576 * MiB, WS_H1B = 704 * MiB, WS_QC = 768 * MiB, WS_PC = 832 * MiB, WS_OC = 896 * MiB, WS_COO = 320 * MiB, WS_H2B = 256 * MiB;
constexpr size_t WS_XG = 320 * MiB, WS_ACT = 592 * MiB, WS_YB = 320 * MiB, WS_END = 976 * MiB;
static_assert((size_t)NROWS * 1024 * 2 <= 272 * MiB, "routed buffers");
static_assert(WS_ROWGATE + (size_t)NROWS * 4 <= 256 * MiB, "small buffers");
constexpr int CW_TMO = 0, CW_CNT = 64  , CW_BAR = 4096;

constexpr int RING_OFF = 0, RING_BYTES = 131072;
constexpr int RED_OFF = RING_BYTES;
constexpr int TST_OFF = RED_OFF + 8192;
constexpr int HIST_OFF = TST_OFF + 256, HBASE_OFF = HIST_OFF + 128;
constexpr int MISC_OFF = HBASE_OFF + 128;
constexpr int LDSCTL_OFF = TST_OFF;
constexpr int LDS_BYTES = 147456;
static_assert(MISC_OFF + 128 <= LDS_BYTES, "LDS map");
constexpr int NWAVES = 8;

#define LDS_WAIT() asm volatile("s_waitcnt lgkmcnt(0)" ::: "memory")
#define VM_WAIT() asm volatile("s_waitcnt vmcnt(0)" ::: "memory")

#define XB_TMO      128
#define XB_XCNT(j)  (256  + 64 * (j))
#define XB_XSUB(j)  (1280 + 64 * (j))
#define XB_XGEN(j)  (2304 + 64 * (j))
#define XB_TOP      3328
#define XB_TOPGEN   3392
#define XCD_BAR_WORDS 3456
#define XB_SPIN_CAP (1u << 18)
__device__ __forceinline__ unsigned xb_ld(unsigned* p)              { return __hip_atomic_load(p, __ATOMIC_RELAXED, __HIP_MEMORY_SCOPE_AGENT); }
__device__ __forceinline__ unsigned xb_add(unsigned* p, unsigned v) { return __hip_atomic_fetch_add(p, v, __ATOMIC_RELAXED, __HIP_MEMORY_SCOPE_AGENT); }
__device__ __forceinline__ unsigned xb_xcc_id() { return (unsigned)__builtin_amdgcn_s_getreg((3 << 11) | 20) & 0xFu; }
#define XB_SPIN(cond, bar) do { unsigned _sp = 0; while (cond) { __builtin_amdgcn_s_sleep(1); \
    if ((++_sp & 255u) == 0u) { if (xb_ld(&(bar)[XB_TMO])) break; if (_sp > XB_SPIN_CAP) { atomicAdd(&(bar)[XB_TMO], 1u); break; } } } } while (0)
struct XcdBarrier { unsigned* bar; unsigned x; volatile LAS unsigned* st; };
__device__ __forceinline__ XcdBarrier xcd_barrier_post(unsigned* bar, volatile LAS unsigned* st) {
    XcdBarrier b; b.bar = bar; b.x = xb_xcc_id(); b.st = st;
    if (threadIdx.x == 0) (void)xb_add(&bar[XB_XCNT(b.x)], 1u);
    return b;
}
__device__ __forceinline__ void xcd_barrier_complete(unsigned* bar, unsigned x, unsigned& nloc, unsigned& nx) {
    const unsigned G = gridDim.x * gridDim.y * gridDim.z;
    unsigned sum, cnt, mine, sp = 0u;
    for (;;) {
        sum = 0u; cnt = 0u; mine = 0u;
#pragma unroll
        for (unsigned j = 0; j < 16; ++j) { const unsigned c = xb_ld(&bar[XB_XCNT(j)]); sum += c; cnt += (c > 0u) ? 1u : 0u; mine = (j == x) ? c : mine; }
        if (sum == G) break;
        __builtin_amdgcn_s_sleep(1);
        if ((++sp & 255u) == 0u) { if (xb_ld(&bar[XB_TMO])) break; if (sp > XB_SPIN_CAP) { atomicAdd(&bar[XB_TMO], 1u); break; } }
    }
    nloc = mine > 0u ? mine : 1u; nx = cnt > 0u ? cnt : 1u;
}
__device__ __forceinline__ void xcd_barrier(const XcdBarrier& b) {
    asm volatile("s_waitcnt vmcnt(0)" ::: "memory");
    __syncthreads();
    if (threadIdx.x == 0) {
        unsigned* bar = b.bar;
        __builtin_amdgcn_s_waitcnt(0);
        unsigned nloc = b.st[0], nx = b.st[1];
        if (nloc == 0u) { xcd_barrier_complete(bar, b.x, nloc, nx); b.st[0] = nloc; b.st[1] = nx; }
        const unsigned old = xb_add(&bar[XB_XSUB(b.x)], 1u);
        const unsigned gen = old / nloc;
        if (old + 1u == (gen + 1u) * nloc) {
            __builtin_amdgcn_fence(__ATOMIC_RELEASE, "agent");
            asm volatile("s_waitcnt vmcnt(0)" ::: "memory");
            const unsigned og = xb_add(&bar[XB_TOP], 1u);
            const unsigned tg = og / nx;
            if (og + 1u == (tg + 1u) * nx) xb_add(&bar[XB_TOPGEN], 1u);
            else XB_SPIN(xb_ld(&bar[XB_TOPGEN]) == tg, bar);
            __builtin_amdgcn_fence(__ATOMIC_ACQUIRE, "agent");
            xb_add(&bar[XB_XGEN(b.x)], 1u);
            asm volatile("s_waitcnt vmcnt(0)" ::: "memory");
        } else {
            XB_SPIN(xb_ld(&bar[XB_XGEN(b.x)]) == gen, bar);
            __builtin_amdgcn_fence(__ATOMIC_ACQUIRE, "agent");
            asm volatile("s_waitcnt vmcnt(0)" ::: "memory");
        }
    }
    __syncthreads();
}

struct Args { const void* in[34]; float* out; unsigned char* ws; int ph_lo, ph_hi; };

DI void tr_item(const float* W, int ldw, int kvalid, bf16_t* WT, int ldk, int n0, int k0, int sc, LAS float* scr, int lane) {
#pragma unroll 8
    for (int i = 0; i < 32; ++i) { const int kk = 2 * i + (lane >> 5); const int k = k0 + kk;
        float v = 0.f; if (sc >= 0 && k < kvalid) v = W[(size_t)k * ldw + sc];
        scr[kk * 33 + (lane & 31)] = v; }
    LDS_WAIT(); asm volatile("" ::: "memory");
    const int c = lane & 7;
#pragma unroll
    for (int j = 0; j < 4; ++j) { const int n = (lane >> 3) + 8 * j; const LAS float* s = scr + (8 * c) * 33 + n;
        u32x4 o; o.x = pk2(s[0 * 33], s[1 * 33]); o.y = pk2(s[2 * 33], s[3 * 33]); o.z = pk2(s[4 * 33], s[5 * 33]); o.w = pk2(s[6 * 33], s[7 * 33]);
        *(GAS u32x4*)(WT + (size_t)(n0 + n) * ldk + k0 + 8 * c) = o; }
    LDS_WAIT(); asm volatile("" ::: "memory");
}
DI int win_src(int n) {
    if (n < 384) return n;
    if (n < 416) { const int i = (n - 384) >> 1; return 384 + i + 16 * ((n - 384) & 1); }
    if (n < 424) return 1952 + (n - 416);
    if (n < 512) return -1;
    if (n < 2048) return 416 + (n - 512);
    return 1960 + (n - 2048);
}
DI void p0_prologue(const Args& args, LAS unsigned char* lds, int vcu, int G) {
    int tid_ = threadIdx.x; asm volatile("" : "+v"(tid_)); const int lane = tid_ & 63; const int wave = __builtin_amdgcn_readfirstlane(tid_ >> 6);
    LAS float* scr = (LAS float*)(lds + RING_OFF + wave * 16384);
    const int gw = vcu * NWAVES + wave, NGW = G * NWAVES;
    unsigned char* ws = args.ws;
    const int j = lane & 31;
    constexpr int I_IN = 16 * 128, I_UQ = 4 * 24, I_UK = 4 * 16, I_UV = 4 * 16, I_MQK = 8 * 32, I_BRM = 8 * 32, I_BRA = 8 * 32, I_SQ = 16 * 32, I_R = 16 * 8,
                  I_GU = NE * 16 * 64, I_DN = NE * 16 * 32;
    constexpr int NITEMS = I_IN + I_UQ + I_UK + I_UV + I_MQK + I_BRM + I_BRA + 5 * I_SQ + I_R + I_GU + I_DN;
    for (int it = gw; it < NITEMS; it += NGW) {
        int r = it;
        if (r < I_GU) { const int e = r / (16 * 64), q = r % (16 * 64), kb = q / 64, nb = q % 64;
            tr_item((const float*)args.in[28] + (size_t)e * 1024 * 2048, 2048, 1024, (bf16_t*)(ws + WS_W_GU) + (size_t)e * 2048 * 1024, 1024, nb * 32, kb * 64, nb * 32 + j, scr, lane); continue; } r -= I_GU;
        if (r < I_DN) { const int e = r / (16 * 32), q = r % (16 * 32), kb = q / 32, nb = q % 32;
            tr_item((const float*)args.in[30] + (size_t)e * 1024 * 1024, 1024, 1024, (bf16_t*)(ws + WS_W_DN) + (size_t)e * 1024 * 1024, 1024, nb * 32, kb * 64, nb * 32 + j, scr, lane); continue; } r -= I_DN;
        if (r < I_IN) { const int kb = r / 128, nb = r % 128;
            tr_item((const float*)args.in[3], DIN, 1024, (bf16_t*)(ws + WS_W_IN), 1024, nb * 32, kb * 64, win_src(nb * 32 + j), scr, lane); continue; } r -= I_IN;
        if (r < I_UQ) { const int kb = r / 24, nb = r % 24; const int n = nb * 32 + j, hh = n / AQK, cc = n % AQK;
            const int sc = (cc < ANOPE) ? n : hh * AQK + ANOPE + ((cc - ANOPE) >> 1) + 16 * ((cc - ANOPE) & 1);
            tr_item((const float*)args.in[14], AH * AQK, 256, (bf16_t*)(ws + WS_W_UQ), 256, nb * 32, kb * 64, sc, scr, lane); continue; } r -= I_UQ;
        if (r < I_UK) { const int kb = r / 16, nb = r % 16; const int n = nb * 32 + j;
            tr_item((const float*)args.in[15], 1024, 128, (bf16_t*)(ws + WS_W_UK), 256, nb * 32, kb * 64, (n >> 6) * 128 + (n & 63), scr, lane); continue; } r -= I_UK;
        if (r < I_UV) { const int kb = r / 16, nb = r % 16; const int n = nb * 32 + j;
            tr_item((const float*)args.in[15], 1024, 128, (bf16_t*)(ws + WS_W_UV), 256, nb * 32, kb * 64, (n >> 6) * 128 + 64 + (n & 63), scr, lane); continue; } r -= I_UV;
        if (r < I_MQK) { const int kb = r / 32, nb = r % 32; const int n = nb * 32 + j, part = n >> 9, hh = (n >> 7) & 3, e = n & 127;
            const float* src = (const float*)args.in[part ? 9 : 8];
            tr_item(src, 128, 512, (bf16_t*)(ws + WS_W_MQK), 512, nb * 32, kb * 64, ((kb >> 1) == hh) ? e : -1, scr, lane); continue; } r -= I_MQK;
        if (r < I_BRM) { const int kb = r / 32, nb = r % 32;
            tr_item((const float*)args.in[16], 1024, 512, (bf16_t*)(ws + WS_W_BRM), 512, nb * 32, kb * 64, nb * 32 + j, scr, lane); continue; } r -= I_BRM;
        if (r < I_BRA) { const int kb = r / 32, nb = r % 32;
            tr_item((const float*)args.in[17], 1024, 512, (bf16_t*)(ws + WS_W_BRA), 512, nb * 32, kb * 64, nb * 32 + j, scr, lane); continue; } r -= I_BRA;
        if (r < 5 * I_SQ) { const int w = r / I_SQ, q = r % I_SQ, kb = q / 32, nb = q % 32;
            const float* src; int ldw, coff; bf16_t* dst;
            if (w == 0) { src = (const float*)args.in[18]; ldw = 1024; coff = 0; dst = (bf16_t*)(ws + WS_W_MIX); }
            else if (w == 1) { src = (const float*)args.in[21]; ldw = 1024; coff = 0; dst = (bf16_t*)(ws + WS_W_CQ); }
            else if (w == 2) { src = (const float*)args.in[22]; ldw = 2048; coff = 0; dst = (bf16_t*)(ws + WS_W_CK); }
            else if (w == 3) { src = (const float*)args.in[22]; ldw = 2048; coff = 1024; dst = (bf16_t*)(ws + WS_W_CV); }
            else { src = (const float*)args.in[23]; ldw = 1024; coff = 0; dst = (bf16_t*)(ws + WS_W_CO); }
            tr_item(src, ldw, 1024, dst, 1024, nb * 32, kb * 64, coff + nb * 32 + j, scr, lane); continue; } r -= 5 * I_SQ;
        { const int kb = r / 8, nb = r % 8; const int n = nb * 32 + j;
            tr_item((const float*)args.in[26], NE, 1024, (bf16_t*)(ws + WS_W_R), 1024, nb * 32, kb * 64, (n < NE) ? n : -1, scr, lane); }
    }
    const size_t gt = (size_t)gw * 64 + lane, NT_ = (size_t)NGW * 64;
    { const float* x = (const float*)args.in[0]; bf16_t* xb = (bf16_t*)(ws + WS_XB);
      for (size_t i = gt; i < (size_t)T * D / 8; i += NT_) { const f32x4 a = *(const f32x4*)(x + i * 8), b = *(const f32x4*)(x + i * 8 + 4);
          u32x4 o; o.x = pk2(a[0], a[1]); o.y = pk2(a[2], a[3]); o.z = pk2(b[0], b[1]); o.w = pk2(b[2], b[3]); *(u32x4*)(xb + i * 8) = o; } }
    { const float* x = (const float*)args.in[1]; bf16_t* xb = (bf16_t*)(ws + WS_MEMB);
      for (size_t i = gt; i < (size_t)NB * NMEM * D / 8; i += NT_) { const f32x4 a = *(const f32x4*)(x + i * 8), b = *(const f32x4*)(x + i * 8 + 4);
          u32x4 o; o.x = pk2(a[0], a[1]); o.y = pk2(a[2], a[3]); o.z = pk2(b[0], b[1]); o.w = pk2(b[2], b[3]); *(u32x4*)(xb + i * 8) = o; } }
}

DI void p2_tokens(const Args& args, int vcu, int G) {
    int tid_ = threadIdx.x; asm volatile("" : "+v"(tid_)); const int lane = tid_ & 63; const int wave = __builtin_amdgcn_readfirstlane(tid_ >> 6);
    unsigned char* ws = args.ws;
    const bf16_t* proj = (const bf16_t*)(ws + WS_PROJ);
    bf16_t* qn = (bf16_t*)(ws + WS_QN); bf16_t* kvn = (bf16_t*)(ws + WS_KVN); bf16_t* kpe = (bf16_t*)(ws + WS_KPE); bf16_t* xc = (bf16_t*)(ws + WS_XC); float* cs = (float*)(ws + WS_CS);
    const int* positions = (const int*)args.in[2];
    const float* conv_w = (const float*)args.in[6]; const float* conv_b = (const float*)args.in[7];
    const float* g_qlat = (const float*)args.in[12]; const float* g_kvlat = (const float*)args.in[13];
    const int gw = vcu * NWAVES + wave, NGW = G * NWAVES;
    float cw[4][8], cb[8];
#pragma unroll
    for (int jj = 0; jj < 4; ++jj)
#pragma unroll
        for (int c = 0; c < 8; ++c) cw[jj][c] = conv_w[jj * MW + 8 * lane + c];
#pragma unroll
    for (int c = 0; c < 8; ++c) cb[c] = conv_b[8 * lane + c];
    const f32x4 gq = *(const f32x4*)(g_qlat + 4 * lane);
    const f32x2 gk = *(const f32x2*)(g_kvlat + 2 * lane);
    const float inv_freq = exp2f(-(float)(lane & 15) * (13.287712379549449f / 16.0f));
    for (int t = gw; t < T; t += NGW) {
        const bf16_t* pr = proj + (size_t)t * NPROJ;
        { const u32x2 w = *(const u32x2*)(pr + PC_QLAT + 4 * lane); const float a0 = bflo(w.x), a1 = bfhi(w.x), a2 = bflo(w.y), a3 = bfhi(w.y);
          const float ss = wave_sum(a0 * a0 + a1 * a1 + a2 * a2 + a3 * a3); const float r = 1.0f / sqrtf(ss * (1.0f / AQR) + EPS);
          u32x2 o; o.x = pk2(a0 * r * gq[0], a1 * r * gq[1]); o.y = pk2(a2 * r * gq[2], a3 * r * gq[3]); *(u32x2*)(qn + (size_t)t * 256 + 4 * lane) = o; }
        { const unsigned w = *(const unsigned*)(pr + PC_KVLAT + 2 * lane); const float a0 = bflo(w), a1 = bfhi(w);
          const float ss = wave_sum(a0 * a0 + a1 * a1); const float r = 1.0f / sqrtf(ss * (1.0f / AKVR) + EPS);
          *(unsigned*)(kvn + (size_t)t * 256 + 2 * lane) = pk2(a0 * r * gk[0], a1 * r * gk[1]); *(unsigned*)(kvn + (size_t)t * 256 + 128 + 2 * lane) = 0u; }
        if (lane < 16) { const unsigned w = *(const unsigned*)(pr + PC_KROPE + 2 * lane); const float x1 = bflo(w), x2 = bfhi(w);
          const float ang = (float)positions[t] * inv_freq;
          const double rev = (double)ang * 0.15915494309189535; const float fr = (float)(rev - __builtin_rint(rev));
          const float cc = __builtin_amdgcn_cosf(fr), sn = __builtin_amdgcn_sinf(fr);
          *(unsigned*)(kpe + (size_t)t * 32 + 2 * lane) = pk2(x1 * cc - x2 * sn, x2 * cc + x1 * sn);
          *(f32x2*)(cs + (size_t)t * 32 + 2 * lane) = (f32x2){cc, sn}; }
        { const int s = t & (SEQ - 1); float a[8];
#pragma unroll
          for (int c = 0; c < 8; ++c) a[c] = cb[c];
#pragma unroll
          for (int jj = 0; jj < 4; ++jj) { const int back = 3 - jj; if (s - back >= 0) { const u32x4 w = *(const u32x4*)(pr - (size_t)back * NPROJ + PC_XM + 8 * lane);
              a[0] += cw[jj][0] * bflo(w.x); a[1] += cw[jj][1] * bfhi(w.x); a[2] += cw[jj][2] * bflo(w.y); a[3] += cw[jj][3] * bfhi(w.y);
              a[4] += cw[jj][4] * bflo(w.z); a[5] += cw[jj][5] * bfhi(w.z); a[6] += cw[jj][6] * bflo(w.w); a[7] += cw[jj][7] * bfhi(w.w); } }
#pragma unroll
          for (int c = 0; c < 8; ++c) a[c] = a[c] * sigmoidf_(a[c]);
          u32x4 o; o.x = pk2(a[0], a[1]); o.y = pk2(a[2], a[3]); o.z = pk2(a[4], a[5]); o.w = pk2(a[6], a[7]); *(u32x4*)(xc + (size_t)t * MW + 8 * lane) = o; }
    }
}

DI void p6_mpost(const Args& args, int vcu, int G) {
    int tid_ = threadIdx.x; asm volatile("" : "+v"(tid_)); const int lane = tid_ & 63; const int wave = __builtin_amdgcn_readfirstlane(tid_ >> 6);
    unsigned char* ws = args.ws;
    const float* hraw = (const float*)(ws + WS_HRAW); const bf16_t* xc = (const bf16_t*)(ws + WS_XC); const bf16_t* proj = (const bf16_t*)(ws + WS_PROJ); bf16_t* hm = (bf16_t*)(ws + WS_HM);
    const float* g_mhead = (const float*)args.in[10]; const float* w_mskip = (const float*)args.in[11];
    const int gw = vcu * NWAVES + wave, NGW = G * NWAVES;
    float gm[8], wsk[8];
#pragma unroll
    for (int c = 0; c < 8; ++c) { gm[c] = g_mhead[8 * lane + c]; wsk[c] = w_mskip[8 * lane + c]; }
    for (int t = gw; t < T; t += NGW) {
        const f32x4 h0 = *(const f32x4*)(hraw + (size_t)t * MW + 8 * lane), h1 = *(const f32x4*)(hraw + (size_t)t * MW + 8 * lane + 4);
        float h[8] = {h0[0], h0[1], h0[2], h0[3], h1[0], h1[1], h1[2], h1[3]};
        float s = 0.f;
#pragma unroll
        for (int c = 0; c < 8; ++c) s += h[c];
        s += __shfl_xor(s, 1); s += __shfl_xor(s, 2); s += __shfl_xor(s, 4); s += __shfl_xor(s, 8);
        const float mu = s * (1.0f / MHD); float q = 0.f;
#pragma unroll
        for (int c = 0; c < 8; ++c) { h[c] -= mu; q += h[c] * h[c]; }
        q += __shfl_xor(q, 1); q += __shfl_xor(q, 2); q += __shfl_xor(q, 4); q += __shfl_xor(q, 8);
        const float rstd = 1.0f / sqrtf(q * (1.0f / MHD) + EPS);
        const u32x4 xw = *(const u32x4*)(xc + (size_t)t * MW + 8 * lane); const u32x4 ow = *(const u32x4*)(proj + (size_t)t * NPROJ + PC_OP + 8 * lane);
        const float xv[8] = {bflo(xw.x), bfhi(xw.x), bflo(xw.y), bfhi(xw.y), bflo(xw.z), bfhi(xw.z), bflo(xw.w), bfhi(xw.w)};
        const float ov[8] = {bflo(ow.x), bfhi(ow.x), bflo(ow.y), bfhi(ow.y), bflo(ow.z), bfhi(ow.z), bflo(ow.w), bfhi(ow.w)};
        float o[8];
#pragma unroll
        for (int c = 0; c < 8; ++c) o[c] = sigmoidf_(ov[c]) * (h[c] * rstd * gm[c] + wsk[c] * xv[c]);
        u32x4 w; w.x = pk2(o[0], o[1]); w.y = pk2(o[2], o[3]); w.z = pk2(o[4], o[5]); w.w = pk2(o[6], o[7]); *(u32x4*)(hm + (size_t)t * MW + 8 * lane) = w;
    }
}

DI void ln_pass(const float* res, const float* add, const float* g, const float* b, float* out, bf16_t* outb, int vcu, int G) {
    int tid_ = threadIdx.x; asm volatile("" : "+v"(tid_)); const int lane = tid_ & 63; const int wave = __builtin_amdgcn_readfirstlane(tid_ >> 6);
    const int gw = vcu * NWAVES + wave, NGW = G * NWAVES;
    for (int t = gw; t < T; t += NGW) {
        f32x4 v[4]; float s = 0.f;
#pragma unroll
        for (int j = 0; j < 4; ++j) { const f32x4 r = *(const f32x4*)(res + (size_t)t * D + 4 * lane + 256 * j), a = *(const f32x4*)(add + (size_t)t * D + 4 * lane + 256 * j);
            v[j] = r * DN_ALPHA + a; s += (v[j][0] + v[j][1]) + (v[j][2] + v[j][3]); }
        const float mean = wave_sum(s) * (1.0f / D); float q = 0.f;
#pragma unroll
        for (int j = 0; j < 4; ++j) { v[j] = v[j] - mean; q += (v[j][0] * v[j][0] + v[j][1] * v[j][1]) + (v[j][2] * v[j][2] + v[j][3] * v[j][3]); }
        const float rstd = 1.0f / sqrtf(wave_sum(q) * (1.0f / D) + EPS);
#pragma unroll
        for (int j = 0; j < 4; ++j) { const f32x4 gg = *(const f32x4*)(g + 4 * lane + 256 * j), bb = *(const f32x4*)(b + 4 * lane + 256 * j);
            const f32x4 y = v[j] * rstd * gg + bb;
            *(f32x4*)(out + (size_t)t * D + 4 * lane + 256 * j) = y;
            if (outb) { u32x2 w; w.x = pk2(y[0], y[1]); w.y = pk2(y[2], y[3]); *(u32x2*)(outb + (size_t)t * D + 4 * lane + 256 * j) = w; } }
    }
}

DI void p16_topk(const Args& args, LAS unsigned char* lds, int vcu, int G) {
    unsigned char* ws = args.ws;
    const float* logits = (const float*)(ws + WS_LOGITS); const float* b_router = (const float*)args.in[27];
    int* assign = (int*)(ws + WS_ASSIGN); float* gatew = (float*)(ws + WS_GATEW);
    unsigned* gcnt = (unsigned*)(ws + WS_CTL) + CW_CNT;
    LAS unsigned* hist = (LAS unsigned*)(lds + HIST_OFF); LAS unsigned* hbase = (LAS unsigned*)(lds + HBASE_OFF);
    int tid = threadIdx.x; asm volatile("" : "+v"(tid));
    for (int blk = vcu; blk < T / 512; blk += G) {
        const int t = blk * 512 + tid;
        float v[NE];
#pragma unroll
        for (int j = 0; j < NE / 4; ++j) { const f32x4 a = *(const f32x4*)(logits + (size_t)t * NE + 4 * j), bb = *(const f32x4*)(b_router + 4 * j);
            v[4 * j] = a[0] + bb[0]; v[4 * j + 1] = a[1] + bb[1]; v[4 * j + 2] = a[2] + bb[2]; v[4 * j + 3] = a[3] + bb[3]; }
        int idx[TOPK]; float val[TOPK];
#pragma unroll
        for (int k = 0; k < TOPK; ++k) { float best = -INFINITY; int bi = 0;
#pragma unroll
            for (int e = 0; e < NE; ++e) { bool taken = false;
#pragma unroll
                for (int kk = 0; kk < k; ++kk) taken = taken || (idx[kk] == e);
                if (!taken && v[e] > best) { best = v[e]; bi = e; } }
            idx[k] = bi; val[k] = best; }
        float ex[TOPK], sum = 0.f;
#pragma unroll
        for (int k = 0; k < TOPK; ++k) { ex[k] = __expf(val[k] - val[0]); sum += ex[k]; }
        const float inv = 1.0f / sum;
        if (tid < NE) hist[tid] = 0u;
        __syncthreads();
        unsigned lr[TOPK];
#pragma unroll
        for (int k = 0; k < TOPK; ++k) lr[k] = __hip_atomic_fetch_add(hist + idx[k], 1u, __ATOMIC_RELAXED, __HIP_MEMORY_SCOPE_WORKGROUP);
        __syncthreads();
        if (tid < NE) hbase[tid] = __hip_atomic_fetch_add(gcnt + tid, hist[tid], RLX_AGENT);
        __syncthreads();
#pragma unroll
        for (int k = 0; k < TOPK; ++k) { assign[(size_t)t * TOPK + k] = (idx[k] << 20) | (int)(hbase[idx[k]] + lr[k]); gatew[(size_t)t * TOPK + k] = ex[k] * inv; }
        __syncthreads();
    }
}
DI void build_tstart(const Args& args, LAS unsigned char* lds) {
    const unsigned* gcnt = (const unsigned*)(args.ws + WS_CTL) + CW_CNT; LAS int* tst = (LAS int*)(lds + TST_OFF);
    if (threadIdx.x == 0) { int acc = 0;
        for (int e = 0; e < NE; ++e) { tst[e] = acc; const unsigned c = __hip_atomic_load(gcnt + e, RLX_AGENT); acc += (int)((c + 255u) >> 8); }
        tst[NE] = acc; }
    __syncthreads();
}
DI void p17_gather(const Args& args, LAS unsigned char* lds, int vcu, int G) {
    int tid_ = threadIdx.x; asm volatile("" : "+v"(tid_)); const int lane = tid_ & 63; const int wave = __builtin_amdgcn_readfirstlane(tid_ >> 6);
    unsigned char* ws = args.ws;
    build_tstart(args, lds);
    const LAS int* tst = (const LAS int*)(lds + TST_OFF);
    const unsigned* gcnt = (const unsigned*)(ws + WS_CTL) + CW_CNT;
    const int* assign = (const int*)(ws + WS_ASSIGN); const float* gatew = (const float*)(ws + WS_GATEW);
    int* tokpos = (int*)(ws + WS_TOKPOS); float* rowgate = (float*)(ws + WS_ROWGATE);
    const bf16_t* h2b = (const bf16_t*)(ws + WS_H2B); bf16_t* xg = (bf16_t*)(ws + WS_XG);
    const int gw = vcu * NWAVES + wave, NGW = G * NWAVES;
    for (int t = gw; t < T; t += NGW) {
        const u32x4 a = *(const u32x4*)(h2b + (size_t)t * D + 8 * lane), b = *(const u32x4*)(h2b + (size_t)t * D + 512 + 8 * lane);
#pragma unroll
        for (int k = 0; k < TOPK; ++k) { const int as = assign[(size_t)t * TOPK + k]; const int e = as >> 20, rank = as & 0xfffff; const int pos = tst[e] * 256 + rank;
            *(u32x4*)(xg + (size_t)pos * D + 8 * lane) = a; *(u32x4*)(xg + (size_t)pos * D + 512 + 8 * lane) = b;
            if (lane == 0) { tokpos[(size_t)t * TOPK + k] = pos; rowgate[pos] = gatew[(size_t)t * TOPK + k]; } }
    }
    for (int idx = gw; idx < NE * 256; idx += NGW) { const int e = idx >> 8, r = idx & 255; const int row = tst[e] * 256 + (int)__hip_atomic_load(gcnt + e, RLX_AGENT) + r;
        if (row < tst[e + 1] * 256) { const u32x4 z = {0u, 0u, 0u, 0u}; *(u32x4*)(xg + (size_t)row * D + 8 * lane) = z; *(u32x4*)(xg + (size_t)row * D + 512 + 8 * lane) = z; if (lane == 0) rowgate[row] = 0.f; } }
}
DI void p20_final(const Args& args, int vcu, int G) {
    int tid_ = threadIdx.x; asm volatile("" : "+v"(tid_)); const int lane = tid_ & 63; const int wave = __builtin_amdgcn_readfirstlane(tid_ >> 6);
    unsigned char* ws = args.ws;
    const int* tokpos = (const int*)(ws + WS_TOKPOS); const bf16_t* yb = (const bf16_t*)(ws + WS_YB);
    const float* g = (const float*)args.in[32]; const float* b = (const float*)args.in[33]; float* out = args.out;
    const int gw = vcu * NWAVES + wave, NGW = G * NWAVES;
    for (int t = gw; t < T; t += NGW) {
        int pos[TOPK];
#pragma unroll
        for (int k = 0; k < TOPK; ++k) pos[k] = tokpos[(size_t)t * TOPK + k];
        f32x4 v[4]; float s = 0.f;
#pragma unroll
        for (int j = 0; j < 4; ++j) { const f32x4 r = *(const f32x4*)(out + (size_t)t * D + 4 * lane + 256 * j); f32x4 a = {0.f, 0.f, 0.f, 0.f};
#pragma unroll
            for (int k = 0; k < TOPK; ++k) { const u32x2 w = *(const u32x2*)(yb + (size_t)pos[k] * D + 4 * lane + 256 * j); a[0] += bflo(w.x); a[1] += bfhi(w.x); a[2] += bflo(w.y); a[3] += bfhi(w.y); }
            v[j] = r * DN_ALPHA + a; s += (v[j][0] + v[j][1]) + (v[j][2] + v[j][3]); }
        const float mean = wave_sum(s) * (1.0f / D); float q = 0.f;
#pragma unroll
        for (int j = 0; j < 4; ++j) { v[j] = v[j] - mean; q += (v[j][0] * v[j][0] + v[j][1] * v[j][1]) + (v[j][2] * v[j][2] + v[j][3] * v[j][3]); }
        const float rstd = 1.0f / sqrtf(wave_sum(q) * (1.0f / D) + EPS);
#pragma unroll
        for (int j = 0; j < 4; ++j) { const f32x4 gg = *(const f32x4*)(g + 4 * lane + 256 * j), bb = *(const f32x4*)(b + 4 * lane + 256 * j);
            *(f32x4*)(out + (size_t)t * D + 4 * lane + 256 * j) = v[j] * rstd * gg + bb; }
    }
}
constexpr int AT_KROW = 208, AT_VROW = 136;
constexpr int AT_KBUF = 64 * AT_KROW, AT_VBUF = 64 * AT_VROW, AT_VOFF = 2 * AT_KBUF;
DI void mla_unit(int b, int h, int qb, const bf16_t* Q, const bf16_t* Kn, const bf16_t* Kpe, const bf16_t* Vt, bf16_t* O, LAS unsigned char* lds) {
    int tid = threadIdx.x; asm volatile("" : "+v"(tid)); const int lane = tid & 63, r32 = lane & 31, hi = lane >> 5; const int wid = __builtin_amdgcn_readfirstlane(tid >> 6);
    const int q0 = qb * 256 + wid * 32;
    const int qi = q0 + r32;
    const size_t tokb = (size_t)b * SEQ;
    bf16x8 qf[6];
    { const bf16_t* qp = Q + (tokb + qi) * (AH * AQK) + h * AQK + 8 * hi;
#pragma unroll
      for (int s = 0; s < 6; ++s) qf[s] = *(const bf16x8*)(qp + 16 * s); }
    const int kkey = tid >> 3, kch = tid & 7, pkey = (tid & 255) >> 2, pch = tid & 3, vd = tid >> 3, vch = tid & 7;
    const bf16_t* ksrc = Kn + (tokb + kkey) * 512 + h * 64 + kch * 8;
    const bf16_t* psrc = Kpe + (tokb + pkey) * 32 + pch * 8;
    const bf16_t* vsrc = Vt + (size_t)(h * 64 + vd) * T + tokb + vch * 8;
    const int kdst = kkey * AT_KROW + kch * 16, pdst = pkey * AT_KROW + 128 + pch * 16, vdst = AT_VOFF + vd * AT_VROW + vch * 16;
    const int nkt = 4 * (qb + 1);
    u32x4 rk, rp, rv;
    rk = *(const u32x4*)ksrc; rv = *(const u32x4*)vsrc; rp = (u32x4){0u, 0u, 0u, 0u}; if (tid < 256) rp = *(const u32x4*)psrc;
    *(LAS u32x4*)(lds + kdst) = rk; if (tid < 256) *(LAS u32x4*)(lds + pdst) = rp;
    *(LAS u32x2*)(lds + vdst) = (u32x2){rv.x, rv.y}; *(LAS u32x2*)(lds + vdst + 8) = (u32x2){rv.z, rv.w};
    __syncthreads();
    float m_run = -INFINITY, l_run = 0.f;
    f32x16 o0, o1;
#pragma unroll
    for (int r = 0; r < 16; ++r) { o0[r] = 0.f; o1[r] = 0.f; }
    for (int kt = 0; kt < nkt; ++kt) {
        const int buf = kt & 1;
        if (kt + 1 < nkt) { rk = *(const u32x4*)(ksrc + (size_t)(kt + 1) * 64 * 512); rv = *(const u32x4*)(vsrc + (kt + 1) * 64); if (tid < 256) rp = *(const u32x4*)(psrc + (size_t)(kt + 1) * 64 * 32); }
        const int key0 = kt * 64;
        if (key0 <= q0 + 31) {
            const LAS unsigned char* kb = lds + buf * AT_KBUF + r32 * AT_KROW + hi * 16;
            f32x16 p0, p1;
#pragma unroll
            for (int r = 0; r < 16; ++r) { p0[r] = 0.f; p1[r] = 0.f; }
#pragma unroll
            for (int s = 0; s < 6; ++s) { const bf16x8 a0 = *(const LAS bf16x8*)(kb + s * 32), a1 = *(const LAS bf16x8*)(kb + 32 * AT_KROW + s * 32);
                p0 = MFMA32(a0, qf[s], p0); p1 = MFMA32(a1, qf[s], p1); }
            if (key0 + 63 > q0) {
#pragma unroll
                for (int r = 0; r < 16; ++r) { const int key = key0 + crow(r, hi); if (key > qi) p0[r] = -INFINITY; if (key + 32 > qi) p1[r] = -INFINITY; }
            }
            float mx = fmaxf(p0[0], p1[0]);
#pragma unroll
            for (int r = 1; r < 16; ++r) mx = fmaxf(mx, fmaxf(p0[r], p1[r]));
            mx = fmaxf(mx, __shfl_xor(mx, 32));
            const float m_new = fmaxf(m_run, mx);
            const float alpha = __builtin_amdgcn_exp2f(m_run - m_new);
            m_run = m_new;
            float ls = 0.f;
#pragma unroll
            for (int r = 0; r < 16; ++r) { p0[r] = __builtin_amdgcn_exp2f(p0[r] - m_new); p1[r] = __builtin_amdgcn_exp2f(p1[r] - m_new); ls += p0[r] + p1[r]; }
            l_run = l_run * alpha + ls;
#pragma unroll
            for (int r = 0; r < 16; ++r) { o0[r] *= alpha; o1[r] *= alpha; }
            bf16x8 pb[4];
#pragma unroll
            for (int s = 0; s < 4; ++s) { u32x4 w;
                if (s < 2) { w.x = pk2(p0[8 * s], p0[8 * s + 1]); w.y = pk2(p0[8 * s + 2], p0[8 * s + 3]); w.z = pk2(p0[8 * s + 4], p0[8 * s + 5]); w.w = pk2(p0[8 * s + 6], p0[8 * s + 7]); }
                else { const int s2 = s - 2; w.x = pk2(p1[8 * s2], p1[8 * s2 + 1]); w.y = pk2(p1[8 * s2 + 2], p1[8 * s2 + 3]); w.z = pk2(p1[8 * s2 + 4], p1[8 * s2 + 5]); w.w = pk2(p1[8 * s2 + 6], p1[8 * s2 + 7]); }
                pb[s] = __builtin_bit_cast(bf16x8, w); }
            const LAS unsigned char* vb = lds + AT_VOFF + buf * AT_VBUF + r32 * AT_VROW + hi * 8;
#pragma unroll
            for (int s = 0; s < 4; ++s) {
                const u32x2 a0l = *(const LAS u32x2*)(vb + s * 32), a0h = *(const LAS u32x2*)(vb + s * 32 + 16);
                const u32x2 a1l = *(const LAS u32x2*)(vb + 32 * AT_VROW + s * 32), a1h = *(const LAS u32x2*)(vb + 32 * AT_VROW + s * 32 + 16);
                const bf16x8 a0 = __builtin_bit_cast(bf16x8, (u32x4){a0l.x, a0l.y, a0h.x, a0h.y}), a1 = __builtin_bit_cast(bf16x8, (u32x4){a1l.x, a1l.y, a1h.x, a1h.y});
                o0 = MFMA32(a0, pb[s], o0); o1 = MFMA32(a1, pb[s], o1); }
        }
        if (kt + 1 < nkt) { const int nb = (kt + 1) & 1;
            *(LAS u32x4*)(lds + nb * AT_KBUF + kdst) = rk; if (tid < 256) *(LAS u32x4*)(lds + nb * AT_KBUF + pdst) = rp;
            *(LAS u32x2*)(lds + nb * AT_VBUF + vdst) = (u32x2){rv.x, rv.y}; *(LAS u32x2*)(lds + nb * AT_VBUF + vdst + 8) = (u32x2){rv.z, rv.w}; }
        __syncthreads();
    }
    const float lt = l_run + __shfl_xor(l_run, 32); const float inv = 1.0f / lt;
    bf16_t* op = O + (tokb + qi) * AW + h * AVD + 4 * hi;
#pragma unroll
    for (int g = 0; g < 4; ++g) { u32x2 w0, w1;
        w0.x = pk2(o0[4 * g] * inv, o0[4 * g + 1] * inv); w0.y = pk2(o0[4 * g + 2] * inv, o0[4 * g + 3] * inv);
        w1.x = pk2(o1[4 * g] * inv, o1[4 * g + 1] * inv); w1.y = pk2(o1[4 * g + 2] * inv, o1[4 * g + 3] * inv);
        *(u32x2*)(op + 8 * g) = w0; *(u32x2*)(op + 32 + 8 * g) = w1; }
}
DI void p4_attention(const Args& args, LAS unsigned char* lds, int vcu, int G) {
    unsigned char* ws = args.ws;
    const bf16_t* Q = (const bf16_t*)(ws + WS_QMLA); const bf16_t* Kn = (const bf16_t*)(ws + WS_KN); const bf16_t* Kpe = (const bf16_t*)(ws + WS_KPE); const bf16_t* Vt = (const bf16_t*)(ws + WS_VT);
    bf16_t* O = (bf16_t*)(ws + WS_AO);
    for (int p = vcu; p < NB * AH * 4; p += G) { const int bh = p >> 2, j = p & 3; const int b = bh / AH, h = bh % AH;
        mla_unit(b, h, 7 - j, Q, Kn, Kpe, Vt, O, lds);
        mla_unit(b, h, j, Q, Kn, Kpe, Vt, O, lds); }
}

constexpr int ML_QROW = 272, ML_TROW = 144;
constexpr int ML_QS = 0, ML_KS = ML_QS + 64 * ML_QROW, ML_KTS = ML_KS + 64 * ML_QROW, ML_VTS = ML_KTS + 128 * ML_TROW, ML_CS = ML_VTS + 32 * ML_TROW, ML_SS = ML_CS + 32 * ML_QROW,
              ML_VEC = ML_SS + 64 * ML_TROW;
static_assert(ML_VEC + (7 * 64 + 128 + 4) * 4 <= RING_BYTES, "mLSTM LDS");
DI void mlstm_unit(int b, int h, int vs, const Args& args, LAS unsigned char* lds) {
    unsigned char* ws = args.ws;
    const bf16_t* qkm = (const bf16_t*)(ws + WS_QKM); const bf16_t* ktm = (const bf16_t*)(ws + WS_KTM); const bf16_t* proj = (const bf16_t*)(ws + WS_PROJ);
    const float* gates = (const float*)(ws + WS_GATES); float* hraw = (float*)(ws + WS_HRAW);
    const float b_i = ((const float*)args.in[4])[h], b_f = ((const float*)args.in[5])[h];
    int tid = threadIdx.x; asm volatile("" : "+v"(tid)); const int lane = tid & 63, r32 = lane & 31, hi = lane >> 5; const int wid = __builtin_amdgcn_readfirstlane(tid >> 6);
    LAS float* ROWT = (LAS float*)(lds + ML_VEC); LAS float* COLT = ROWT + 64; LAS float* WINT = ROWT + 128; LAS float* ENEG = ROWT + 192; LAS float* WAS = ROWT + 256;
    LAS float* NQ = ROWT + 320; LAS float* DINV = ROWT + 384; LAS float* NVEC = ROWT + 448; LAS float* SCAL = ROWT + 576;
    const size_t tokb = (size_t)b * SEQ;
    for (int i = tid; i < 32 * ML_QROW / 4; i += 512) ((LAS unsigned*)(lds + ML_CS))[i] = 0u;
    if (tid < 128) NVEC[tid] = 0.f;
    f32x16 cacc;
#pragma unroll
    for (int r = 0; r < 16; ++r) cacc[r] = 0.f;
    float m_st = 0.f;
    u32x4 sq[2], sk[2], skt[2], sv; float gi = 0.f, gf = 0.f;
    sv = (u32x4){0u, 0u, 0u, 0u};
#define ML_LOAD(c) do { const size_t tok0 = tokb + (size_t)(c) * MCH; \
        _Pragma("unroll") for (int i = 0; i < 2; ++i) { const int idx = tid + 512 * i; \
            sq[i] = *(const u32x4*)(qkm + (tok0 + (idx >> 4)) * 1024 + h * MHD + (idx & 15) * 8); \
            sk[i] = *(const u32x4*)(qkm + (tok0 + (idx >> 4)) * 1024 + 512 + h * MHD + (idx & 15) * 8); \
            skt[i] = *(const u32x4*)(ktm + (size_t)(h * MHD + (idx >> 3)) * T + tok0 + (idx & 7) * 8); } \
        if (tid < 256) sv = *(const u32x4*)(proj + (tok0 + (tid >> 2)) * NPROJ + PC_VM + h * MHD + vs * 32 + (tid & 3) * 8); \
        if (wid == 0) { gi = gates[(tok0 + lane) * 8 + h]; gf = gates[(tok0 + lane) * 8 + 4 + h]; } } while (0)
    ML_LOAD(0);
    for (int c = 0; c < SEQ / MCH; ++c) {
        const size_t tok0 = tokb + (size_t)c * MCH;
#pragma unroll
        for (int i = 0; i < 2; ++i) { const int idx = tid + 512 * i;
            *(LAS u32x4*)(lds + ML_QS + (idx >> 4) * ML_QROW + (idx & 15) * 16) = sq[i];
            *(LAS u32x4*)(lds + ML_KS + (idx >> 4) * ML_QROW + (idx & 15) * 16) = sk[i];
            *(LAS u32x4*)(lds + ML_KTS + (idx >> 3) * ML_TROW + (idx & 7) * 16) = skt[i]; }
        if (tid < 256) { const int l = tid >> 2, v0 = (tid & 3) * 8; LAS bf16_t* vt = (LAS bf16_t*)(lds + ML_VTS);
            vt[(v0 + 0) * (ML_TROW / 2) + l] = (bf16_t)(sv.x & 0xffff); vt[(v0 + 1) * (ML_TROW / 2) + l] = (bf16_t)(sv.x >> 16);
            vt[(v0 + 2) * (ML_TROW / 2) + l] = (bf16_t)(sv.y & 0xffff); vt[(v0 + 3) * (ML_TROW / 2) + l] = (bf16_t)(sv.y >> 16);
            vt[(v0 + 4) * (ML_TROW / 2) + l] = (bf16_t)(sv.z & 0xffff); vt[(v0 + 5) * (ML_TROW / 2) + l] = (bf16_t)(sv.z >> 16);
            vt[(v0 + 6) * (ML_TROW / 2) + l] = (bf16_t)(sv.w & 0xffff); vt[(v0 + 7) * (ML_TROW / 2) + l] = (bf16_t)(sv.w >> 16); }
        if (wid == 0) {
            const float xf = gf + b_f;
            const float lf = (xf >= 0.f) ? -log1pf(__expf(-xf)) : xf - log1pf(__expf(xf));
            float bb = lf;
#pragma unroll
            for (int o = 1; o < 64; o <<= 1) { const float tv = __shfl_up(bb, o); if (lane >= o) bb += tv; }
            const float btot = __shfl(bb, 63);
            const float ig = gi + b_i;
            const float a = btot - bb + ig;
            const float mchunk = wave_max(a);
            const float wa = __expf(a - mchunk);
            const float u = ig - bb;
            float pm = u;
#pragma unroll
            for (int o = 1; o < 64; o <<= 1) { const float tv = __shfl_up(pm, o); if (lane >= o) pm = fmaxf(pm, tv); }
            const float mintra = bb + pm;
            const float ginter = bb + m_st;
            const float m = fmaxf(ginter, mintra);
            const float mnew = fmaxf(btot + m_st, mchunk);
            const float sold = __expf(btot + m_st - mnew), snew = __expf(mchunk - mnew);
            ROWT[lane] = bb - m; COLT[lane] = u; WINT[lane] = __expf(ginter - m); ENEG[lane] = __expf(-m); WAS[lane] = snew * wa;
            if (lane == 0) SCAL[0] = sold;
            m_st = mnew;
        }
        __syncthreads();
        if (c + 1 < SEQ / MCH) ML_LOAD(c + 1);
        f32x16 iacc;
#pragma unroll
        for (int r = 0; r < 16; ++r) iacc[r] = 0.f;
        if (wid < 4) {
            const int jb = wid >> 1, sb = wid & 1;
            LAS bf16_t* ss = (LAS bf16_t*)(lds + ML_SS);
            if (sb <= jb) {
                f32x16 s;
#pragma unroll
                for (int r = 0; r < 16; ++r) s[r] = 0.f;
                const LAS unsigned char* qa = lds + ML_QS + (32 * jb + r32) * ML_QROW + hi * 16; const LAS unsigned char* kb = lds + ML_KS + (32 * sb + r32) * ML_QROW + hi * 16;
#pragma unroll
                for (int kk = 0; kk < 8; ++kk) s = MFMA32(*(const LAS bf16x8*)(qa + kk * 32), *(const LAS bf16x8*)(kb + kk * 32), s);
                const int sidx = 32 * sb + r32; const float ct = COLT[sidx];
#pragma unroll
                for (int r = 0; r < 16; ++r) { const int j = 32 * jb + crow(r, hi);
                    const float val = (sidx <= j) ? s[r] * __expf(ROWT[j] + ct) : 0.f;
                    ss[j * (ML_TROW / 2) + sidx] = (bf16_t)f2bf(val); }
            } else {
#pragma unroll
                for (int r = 0; r < 16; ++r) ss[(32 * jb + crow(r, hi)) * (ML_TROW / 2) + 32 * sb + r32] = (bf16_t)0;
            }
        } else if (wid < 6) {
            const int jb = wid - 4;
            const LAS unsigned char* qa = lds + ML_QS + (32 * jb + r32) * ML_QROW + hi * 16; const LAS unsigned char* cb = lds + ML_CS + r32 * ML_QROW + hi * 16;
#pragma unroll
            for (int kk = 0; kk < 8; ++kk) iacc = MFMA32(*(const LAS bf16x8*)(qa + kk * 32), *(const LAS bf16x8*)(cb + kk * 32), iacc);
        } else {
            const int j = 32 * (wid - 6) + (lane >> 1), half = lane & 1;
            const LAS unsigned char* qa = lds + ML_QS + j * ML_QROW + half * 128; float acc = 0.f;
#pragma unroll
            for (int i = 0; i < 8; ++i) { const u32x4 w = *(const LAS u32x4*)(qa + i * 16); const f32x4 n0 = *(const LAS f32x4*)(NVEC + half * 64 + i * 8), n1 = *(const LAS f32x4*)(NVEC + half * 64 + i * 8 + 4);
                acc += bflo(w.x) * n0[0] + bfhi(w.x) * n0[1] + bflo(w.y) * n0[2] + bfhi(w.y) * n0[3] + bflo(w.z) * n1[0] + bfhi(w.z) * n1[1] + bflo(w.w) * n1[2] + bfhi(w.w) * n1[3]; }
            acc += __shfl_xor(acc, 1);
            if (half == 0) NQ[j] = acc;
        }
        __syncthreads();
        if (wid < 4) {
            const float sold = SCAL[0];
#pragma unroll
            for (int r = 0; r < 16; ++r) cacc[r] *= sold;
            const LAS unsigned char* va = lds + ML_VTS + r32 * ML_TROW + hi * 16; const LAS unsigned char* kb = lds + ML_KTS + (32 * wid + r32) * ML_TROW + hi * 16;
#pragma unroll
            for (int kk = 0; kk < 4; ++kk) { const u32x4 w = *(const LAS u32x4*)(va + kk * 32);
                const f32x4 w0 = *(const LAS f32x4*)(WAS + 16 * kk + 8 * hi), w1 = *(const LAS f32x4*)(WAS + 16 * kk + 8 * hi + 4);
                u32x4 sa; sa.x = pk2(bflo(w.x) * w0[0], bfhi(w.x) * w0[1]); sa.y = pk2(bflo(w.y) * w0[2], bfhi(w.y) * w0[3]); sa.z = pk2(bflo(w.z) * w1[0], bfhi(w.z) * w1[1]); sa.w = pk2(bflo(w.w) * w1[2], bfhi(w.w) * w1[3]);
                cacc = MFMA32(__builtin_bit_cast(bf16x8, sa), *(const LAS bf16x8*)(kb + kk * 32), cacc); }
            LAS bf16_t* cs = (LAS bf16_t*)(lds + ML_CS);
#pragma unroll
            for (int r = 0; r < 16; ++r) cs[crow(r, hi) * (ML_QROW / 2) + 32 * wid + r32] = (bf16_t)f2bf(cacc[r]);
        } else if (wid < 6) {
            const int jb = wid - 4;
#pragma unroll
            for (int r = 0; r < 16; ++r) iacc[r] *= WINT[32 * jb + crow(r, hi)];
            const LAS unsigned char* sa = lds + ML_SS + (32 * jb + r32) * ML_TROW + hi * 16; const LAS unsigned char* vb = lds + ML_VTS + r32 * ML_TROW + hi * 16;
#pragma unroll
            for (int kk = 0; kk < 4; ++kk) iacc = MFMA32(*(const LAS bf16x8*)(sa + kk * 32), *(const LAS bf16x8*)(vb + kk * 32), iacc);
        } else {
            const int tl = (wid - 6) * 64 + lane;
            { const int j = tl >> 1, half = tl & 1; const LAS unsigned char* sp = lds + ML_SS + j * ML_TROW + half * 64; float rs = 0.f;
#pragma unroll
              for (int i = 0; i < 4; ++i) { const u32x4 w = *(const LAS u32x4*)(sp + i * 16); rs += (bflo(w.x) + bfhi(w.x)) + (bflo(w.y) + bfhi(w.y)) + (bflo(w.z) + bfhi(w.z)) + (bflo(w.w) + bfhi(w.w)); }
              rs += __shfl_xor(rs, 1);
              if (half == 0) { const float den = WINT[j] * NQ[j] + rs; DINV[j] = 1.0f / fmaxf(fabsf(den), ENEG[j]); } }
            { const int k = tl; const LAS unsigned char* kp = lds + ML_KTS + k * ML_TROW; float acc = SCAL[0] * NVEC[k];
#pragma unroll
              for (int i = 0; i < 8; ++i) { const u32x4 w = *(const LAS u32x4*)(kp + i * 16); const f32x4 w0 = *(const LAS f32x4*)(WAS + i * 8), w1 = *(const LAS f32x4*)(WAS + i * 8 + 4);
                  acc += bflo(w.x) * w0[0] + bfhi(w.x) * w0[1] + bflo(w.y) * w0[2] + bfhi(w.y) * w0[3] + bflo(w.z) * w1[0] + bfhi(w.z) * w1[1] + bflo(w.w) * w1[2] + bfhi(w.w) * w1[3]; }
              NVEC[k] = acc; }
        }
        __syncthreads();
        if (wid == 4 || wid == 5) {
            const int jb = wid - 4; float* hp = hraw + (tok0 + 32 * jb) * MW + h * MHD + vs * 32 + r32;
#pragma unroll
            for (int r = 0; r < 16; ++r) { const int j = crow(r, hi); hp[(size_t)j * MW] = iacc[r] * DINV[32 * jb + j]; }
        }
    }
#undef ML_LOAD
    __syncthreads();
}
DI void p5_mlstm(const Args& args, LAS unsigned char* lds, int vcu, int G) {
    for (int u = vcu; u < NB * MH * 4; u += G) { const int vs = u & 3, bh = u >> 2; mlstm_unit(bh / MH, bh % MH, vs, args, lds); }
}
#ifndef MK_ONE_LAUNCH
#define MK_ONE_LAUNCH 0
#endif
#ifndef P3SEL
#define P3SEL 31
#endif
constexpr int NPH = 20;
__global__ void __launch_bounds__(NWAVES * 64, 2) fwd_kernel(Args args) {
    extern __shared__ __attribute__((aligned(16))) unsigned char lds_raw[];
    LAS unsigned char* lds = (LAS unsigned char*)lds_raw;
    const int tid = threadIdx.x;
    const int G = gridDim.x; const int bx = blockIdx.x; const int vcu = (G % 8 == 0) ? (bx % 8) * (G / 8) + bx / 8 : bx;
    unsigned char* ws = args.ws;
    for (int u = tid; u < (LDS_BYTES - LDSCTL_OFF) / 4; u += NWAVES * 64) ((LAS unsigned*)(lds + LDSCTL_OFF))[u] = 0u;
    __syncthreads();
    volatile LAS unsigned* MISC = (volatile LAS unsigned*)(lds + MISC_OFF);
    XcdBarrier bar; bar.bar = (unsigned*)(ws + WS_CTL) + CW_BAR; bar.x = 0; bar.st = nullptr;
    const int lo = args.ph_lo, hi = args.ph_hi;
    if (hi - lo > 1) bar = xcd_barrier_post((unsigned*)(ws + WS_CTL) + CW_BAR, MISC + 8);
#ifndef PHASE_MASK
#define PHASE_MASK 0xFFFFFu
#endif
#define IN(k) (((PHASE_MASK >> (k)) & 1u) && lo <= (k) && (k) < hi)
#define SEAM(k) do { if (IN(k) && IN((k) + 1)) xcd_barrier(bar); } while (0)
    using namespace pg8;
    LAS unsigned char* ring = lds + RING_OFF;
    const bf16_t* cws = (const bf16_t*)ws;
#define WSB(off) ((bf16_t*)(ws + (off)))
#define WSF(off) ((float*)(ws + (off)))

    if (IN(0)) { p0_prologue(args, lds, vcu, G); }
    SEAM(0);
    if (IN(1)) {
        { DenseOrder S; S.init(WSB(WS_XB), WSB(WS_W_IN), T, NPROJ, D, D, G, bx); EpiProj E{WSB(WS_PROJ), WSF(WS_GATES)}; gemm_phase(ring, D, D, D, S, E); }
        { DenseOrder S; S.init(WSB(WS_MEMB), WSB(WS_W_CK), NB * NMEM, D, D, D, G, bx); EpiBf16 E{WSB(WS_KC), D, 1 << 30, 1.f}; gemm_phase(ring, D, D, D, S, E); }
        { DenseOrder S; S.init(WSB(WS_W_CV), WSB(WS_MEMB), D, NB * NMEM, D, D, G, bx); EpiBf16 E{WSB(WS_VCT), NB * NMEM, 1 << 30, 1.f}; gemm_phase(ring, D, D, D, S, E); }
    }
    SEAM(1);
    if (IN(2)) { p2_tokens(args, vcu, G); }
    SEAM(2);
    if (IN(3)) {
        if (P3SEL & 1) { DenseOrder S; S.init(WSB(WS_QN), WSB(WS_W_UQ), T, AH * AQK, 256, 256, G, bx); EpiQmla E{WSB(WS_QMLA), WSF(WS_CS), 0.10206207261596575f * 1.4426950408889634f}; gemm_phase(ring, 256, 256, 256, S, E); }
        if (P3SEL & 2) { DenseOrder S; S.init(WSB(WS_KVN), WSB(WS_W_UK), T, 512, 256, 256, G, bx); EpiBf16 E{WSB(WS_KN), 512, 1 << 30, 1.f}; gemm_phase(ring, 256, 256, 256, S, E); }
        if (P3SEL & 4) { DenseOrder S; S.init(WSB(WS_W_UV), WSB(WS_KVN), 512, T, 256, 256, G, bx); EpiBf16 E{WSB(WS_VT), T, 1 << 30, 1.f}; gemm_phase(ring, 256, 256, 256, S, E); }
        if (P3SEL & 8) { DenseOrder S; S.init(WSB(WS_XC), WSB(WS_W_MQK), T, 1024, 512, 512, G, bx); EpiBf16 E{WSB(WS_QKM), 1024, 2, 0.08838834764831845f}; gemm_phase(ring, 512, 512, 512, S, E); }
        if (P3SEL & 16) { DenseOrder S; S.init(WSB(WS_W_MQK) + 512 * 512, WSB(WS_XC), 512, T, 512, 512, G, bx); EpiBf16 E{WSB(WS_KTM), T, 0, 0.08838834764831845f}; gemm_phase(ring, 512, 512, 512, S, E); }
    }
    SEAM(3);
    if (IN(4)) { p5_mlstm(args, lds, vcu, G); p4_attention(args, lds, vcu, G); }
    SEAM(4);
    if (IN(5)) { p6_mpost(args, vcu, G); }
    SEAM(5);
    if (IN(6)) {
        { DenseOrder S; S.init(WSB(WS_HM), WSB(WS_W_BRM), T, D, 512, 512, G, bx); EpiGate<false> E{WSB(WS_GATED), WSB(WS_PROJ), PC_GM}; gemm_phase(ring, 512, 512, 512, S, E); }
        { DenseOrder S; S.init(WSB(WS_AO), WSB(WS_W_BRA), T, D, 512, 512, G, bx); EpiGate<true> E{WSB(WS_GATED), WSB(WS_PROJ), PC_GA}; gemm_phase(ring, 512, 512, 512, S, E); }
    }
    SEAM(6);
    if (IN(7)) { DenseOrder S; S.init(WSB(WS_GATED), WSB(WS_W_MIX), T, D, D, D, G, bx); EpiF32 E{WSF(WS_MIXO), D, 1 << 30}; gemm_phase(ring, D, D, D, S, E); }
    SEAM(7);
    if (IN(8)) { ln_pass((const float*)args.in[0], WSF(WS_MIXO), (const float*)args.in[19], (const float*)args.in[20], args.out, WSB(WS_H1B), vcu, G); }
    SEAM(8);
    if (IN(9)) { DenseOrder S; S.init(WSB(WS_H1B), WSB(WS_W_CQ), T, D, D, D, G, bx); EpiBf16 E{WSB(WS_QC), D, 0, 0.0625f * 1.4426950408889634f}; gemm_phase(ring, D, D, D, S, E); }
    SEAM(9);
    if (IN(10)) { CrossSOrder S{(const char*)(ws + WS_QC), (const char*)(ws + WS_KC), G, vcu}; EpiSoftmax E{WSB(WS_PC), (LAS float*)(lds + RED_OFF)}; gemm_phase(ring, 256, D, D, S, E); }
    SEAM(10);
    if (IN(11)) { CrossOOrder S{(const char*)(ws + WS_PC), (const char*)(ws + WS_VCT), G, vcu}; EpiBf16 E{WSB(WS_OC), D, 1 << 30, 1.f}; gemm_phase(ring, 256, D, NB * NMEM, S, E); }
    SEAM(11);
    if (IN(12)) { DenseOrder S; S.init(WSB(WS_OC), WSB(WS_W_CO), T, D, D, D, G, bx); EpiF32 E{WSF(WS_COO), D, 1 << 30}; gemm_phase(ring, D, D, D, S, E); }
    SEAM(12);
    if (IN(13)) { ln_pass(args.out, WSF(WS_COO), (const float*)args.in[24], (const float*)args.in[25], args.out, WSB(WS_H2B), vcu, G); }
    SEAM(13);
    if (IN(14)) { DenseOrder S; S.init(WSB(WS_H2B), WSB(WS_W_R), T, 256, D, D, G, bx); EpiF32 E{WSF(WS_LOGITS), NE, NE}; gemm_phase(ring, D, D, D, S, E); }
    SEAM(14);
    if (IN(15)) { p16_topk(args, lds, vcu, G); }
    SEAM(15);
    if (IN(16)) { p17_gather(args, lds, vcu, G); }
    SEAM(16);
    if (IN(17)) { build_tstart(args, lds);
        MoeOrder S{(const char*)(ws + WS_XG), (const char*)(ws + WS_W_GU), (const LAS int*)(lds + TST_OFF), 8, G, vcu, (size_t)256 * D * 2, (size_t)2048 * 1024 * 2};
        EpiSwiglu E{WSB(WS_ACT), (const float*)args.in[29]}; gemm_phase(ring, D, D, D, S, E); }
    SEAM(17);
    if (IN(18)) { build_tstart(args, lds);
        MoeOrder S{(const char*)(ws + WS_ACT), (const char*)(ws + WS_W_DN), (const LAS int*)(lds + TST_OFF), 4, G, vcu, (size_t)256 * D * 2, (size_t)1024 * 1024 * 2};
        EpiDown E{WSB(WS_YB), (const float*)args.in[31], WSF(WS_ROWGATE)}; gemm_phase(ring, D, D, D, S, E); }
    SEAM(18);
    if (IN(19)) { p20_final(args, vcu, G); }
    (void)cws;
#undef IN
#undef SEAM
}

extern "C" void kernel_launch(void* const* d_in, const int* in_sizes, int n_in, void* d_out, int out_size, void* d_ws, size_t ws_size, hipStream_t stream) {
    static int grid = 0;
    if (grid == 0) {
        if (n_in != 34 || in_sizes[0] != T * D || out_size != T * D || ws_size < WS_END) { fprintf(stderr, "kernel_launch: unexpected shapes / workspace (n_in %d, ws %zu)\n", n_in, ws_size); grid = -1; return; }
        int dev = 0, cus = 0, per_cu = 0;
        if (hipGetDevice(&dev) != hipSuccess || hipDeviceGetAttribute(&cus, hipDeviceAttributeMultiprocessorCount, dev) != hipSuccess) { grid = -1; return; }
        if (hipFuncSetAttribute((const void*)fwd_kernel, hipFuncAttributeMaxDynamicSharedMemorySize, LDS_BYTES) != hipSuccess) { fprintf(stderr, "kernel_launch: hipFuncSetAttribute failed\n"); grid = -1; return; }
        if (hipOccupancyMaxActiveBlocksPerMultiprocessor(&per_cu, (const void*)fwd_kernel, NWAVES * 64, LDS_BYTES) != hipSuccess || per_cu < 1) fprintf(stderr, "kernel_launch: occupancy query says %d\n", per_cu);
        (void)hipGetLastError();
        grid = cus;
    }
    if (grid < 0) return;
    if (hipMemsetAsync((char*)d_ws + WS_CTL, 0, CTL_ZERO_BYTES, stream) != hipSuccess) return;
    Args a{};
    for (int i = 0; i < 34; ++i) a.in[i] = d_in[i];
    a.out = (float*)d_out; a.ws = (unsigned char*)d_ws;
#if MK_ONE_LAUNCH
    a.ph_lo = 0; a.ph_hi = NPH;
    hipLaunchKernelGGL(fwd_kernel, dim3(grid), dim3(NWAVES * 64), LDS_BYTES, stream, a);
#else
    for (int p = 0; p < NPH; ++p) { a.ph_lo = p; a.ph_hi = p + 1; hipLaunchKernelGGL(fwd_kernel, dim3(grid), dim3(NWAVES * 64), LDS_BYTES, stream, a); }
#endif
}
```

```cpp
#include <hip/hip_runtime.h>
#include <cstdio>
#include <cstdint>
#include <cmath>

#define LAS __attribute__((address_space(3)))
#define GAS __attribute__((address_space(1)))
typedef unsigned short bf16_t;
typedef short bf16x8 __attribute__((ext_vector_type(8)));
typedef float f32x4 __attribute__((ext_vector_type(4)));
typedef float f32x2 __attribute__((ext_vector_type(2)));
typedef float f32x16 __attribute__((ext_vector_type(16)));
typedef unsigned u32x4 __attribute__((ext_vector_type(4)));
typedef unsigned u32x2 __attribute__((ext_vector_type(2)));
typedef GAS unsigned gu32;
#define RLX_AGENT __ATOMIC_RELAXED, __HIP_MEMORY_SCOPE_AGENT
#define DI __device__ __forceinline__

constexpr int D = 1024, NB = 16, SEQ = 2048, T = NB * SEQ, NMEM = 256;
constexpr int MH = 4, MHD = 128, MW = 512, MCH = 64;
constexpr int AH = 8, ANOPE = 64, AROPE = 32, AQK = 96, AVD = 64, AW = 512, AQR = 256, AKVR = 128;
constexpr int XH = 4, XHD = 256;
constexpr int NE = 32, TOPK = 4;
constexpr int DIN = 4008, NPROJ = 4096;
constexpr float DN_ALPHA = 1.189207115002721f;
constexpr float EPS = 1e-5f;
constexpr int NASSIGN = T * TOPK;
constexpr int NROWS = NASSIGN + NE * 256;
constexpr int NTILES_MAX = NROWS / 256;
constexpr int PC_QLAT = 0, PC_KVLAT = 256, PC_KROPE = 384, PC_IG = 416, PC_FG = 420, PC_XM = 512, PC_VM = 1024, PC_OP = 1536, PC_GM = 2048, PC_GA = 3072;

DI unsigned f2bf(float f) { unsigned u = __builtin_bit_cast(unsigned, f); return (u + 0x7fffu + ((u >> 16) & 1u)) >> 16; }
DI unsigned pk2(float lo, float hi) { return f2bf(lo) | (f2bf(hi) << 16); }
DI float bf2f(unsigned short b) { return __builtin_bit_cast(float, (unsigned)b << 16); }
DI float bflo(unsigned w) { return __builtin_bit_cast(float, w << 16); }
DI float bfhi(unsigned w) { return __builtin_bit_cast(float, w & 0xffff0000u); }
DI float wave_sum(float v) {
#pragma unroll
    for (int o = 1; o < 64; o <<= 1) v += __shfl_xor(v, o);
    return v;
}
DI float wave_max(float v) {
#pragma unroll
    for (int o = 1; o < 64; o <<= 1) v = fmaxf(v, __shfl_xor(v, o));
    return v;
}
DI float sigmoidf_(float x) { return 1.0f / (1.0f + __expf(-x)); }
DI int crow(int r, int hi) { return (r & 3) + 8 * (r >> 2) + 4 * hi; }
#define MFMA32(a, b, c) __builtin_amdgcn_mfma_f32_32x32x16_bf16((a), (b), (c), 0, 0, 0)

namespace pg8 {
constexpr int BM = 256, BK = 64, HALF = 128, HTB = HALF * BK * 2, STAGE_BYTES = 8 * HTB;
__host__ __device__ __forceinline__ int lds_byte(int r, int c) { const int st = (r >> 4) * 2 + (c >> 5), rr = r & 15, cc = c & 31, ob = rr * 64 + cc * 2; return st * 1024 + (ob ^ (((ob >> 9) & 1) << 5)); }
__host__ __device__ __forceinline__ void stage_rc(int b, int& R, int& C) { const int st = b / 1024, sb = b % 1024, swz = sb ^ (((sb >> 9) & 1) << 5); R = (st >> 1) * 16 + swz / 64; C = (st & 1) * 32 + (swz % 64) / 2; }
__host__ __device__ __forceinline__ int perm32(int rho) { const int n = rho >> 4, i = rho & 15; return 8 * (i >> 2) + 4 * n + (i & 3); }

struct Unit { int pm, pn, aux; const char* a; const char* b; };
struct Ctx { int wr, wc, fr, fq, wid, lane; };

DI unsigned cvt_pk_bf16(float lo, float hi) { unsigned r; asm volatile("v_cvt_pk_bf16_f32 %0, %1, %2" : "=v"(r) : "v"(lo), "v"(hi)); return r; }

typedef f32x4 Acc[2][2][4][2];

template <class Epi, class Sched>
DI void gemm_phase(LAS unsigned char* lds, const int K, const int lda, const int ldb, const Sched& S, const Epi& E) {
    int tid = threadIdx.x; asm volatile("" : "+v"(tid));
    const int wid = __builtin_amdgcn_readfirstlane(tid >> 6), lane = tid & 63, wr = wid >> 2, wc = wid & 3, fr = lane & 15, fq = lane >> 4;
    const int nt = K / BK;
    unsigned voffA[2], voffB[2];
#pragma unroll
    for (int i = 0; i < 2; ++i) { int R, C; stage_rc(tid * 16 + i * 8192, R, C); const int Rb = Epi::PERM ? ((R & ~31) + perm32(R & 31)) : R;
        voffA[i] = (unsigned)(R * lda + C) * 2u; voffB[i] = (unsigned)(Rb * ldb + C) * 2u; }
    const size_t kstep = (size_t)(BK * 2);
    const size_t hstepA = (size_t)HALF * lda * 2, hstepB = (size_t)HALF * ldb * 2;
    const unsigned ldsw = (unsigned)wid * 1024u;
    const int aoff = lds_byte(wr * 64 + fr, fq * 8), boff = lds_byte(wc * 32 + fr, fq * 8);
    const Ctx cx{wr, wc, fr, fq, wid, lane};
#define PG8_SA(b, h) (((b) * 2 + (h)) * HTB)
#define PG8_SB(b, h) ((4 + (b) * 2 + (h)) * HTB)
#define PG8_STAGE(bufoff, gbase, voff) do { _Pragma("unroll") for (int _i = 0; _i < 2; ++_i) \
        __builtin_amdgcn_global_load_lds((const unsigned*)((const char*)(gbase) + (voff)[_i]), (LAS unsigned*)(lds + (bufoff) + ldsw + _i * 8192), 16, 0, 0); } while (0)
#define PG8_LDA(dst, b, h) do { _Pragma("unroll") for (int m = 0; m < 4; ++m) _Pragma("unroll") for (int k = 0; k < 2; ++k) dst[m][k] = *(const LAS bf16x8*)(lds + PG8_SA(b, h) + aoff + m * 2048 + k * 1024); } while (0)
#define PG8_LDB(dst, b, h) do { _Pragma("unroll") for (int n = 0; n < 2; ++n) _Pragma("unroll") for (int k = 0; k < 2; ++k) dst[n][k] = *(const LAS bf16x8*)(lds + PG8_SB(b, h) + boff + n * 2048 + k * 1024); } while (0)
#define PG8_MMA(ai, bj, At, Bt) do { __builtin_amdgcn_s_setprio(1); _Pragma("unroll") for (int m = 0; m < 4; ++m) _Pragma("unroll") for (int n = 0; n < 2; ++n) _Pragma("unroll") for (int k = 0; k < 2; ++k) \
        acc[ai][bj][m][n] = __builtin_amdgcn_mfma_f32_16x16x32_bf16(Bt[n][k], At[m][k], acc[ai][bj][m][n], 0, 0, 0); __builtin_amdgcn_s_setprio(0); } while (0)
#define PG8_WAIT_V(n) asm volatile("s_waitcnt vmcnt(" #n ")" ::: "memory")
#define PG8_WAIT_L(n) asm volatile("s_waitcnt lgkmcnt(" #n ")" ::: "memory")
#define PG8_BAR __builtin_amdgcn_s_barrier()
#define PG8_SCHED __builtin_amdgcn_sched_barrier(0)
    Unit cur, nxt; int ui = 0;
    if (!S.next(0, cur)) return;
    Acc acc;
#pragma unroll
    for (int a = 0; a < 2; ++a)
#pragma unroll
        for (int b = 0; b < 2; ++b)
#pragma unroll
            for (int m = 0; m < 4; ++m)
#pragma unroll
                for (int n = 0; n < 2; ++n) acc[a][b][m][n] = (f32x4){0.f, 0.f, 0.f, 0.f};
    bf16x8 At[4][2], B0[2][2], B1[2][2];
    const char* cA = cur.a; const char* cB = cur.b;
    PG8_STAGE(PG8_SB(0, 0), cB, voffB); PG8_STAGE(PG8_SB(0, 1), cB + hstepB, voffB); PG8_STAGE(PG8_SA(0, 0), cA, voffA); PG8_STAGE(PG8_SA(0, 1), cA + hstepA, voffA);
    if (wr == 1) PG8_BAR;
    PG8_WAIT_V(2); PG8_BAR;
    PG8_STAGE(PG8_SB(1, 0), cB + kstep, voffB); PG8_STAGE(PG8_SA(1, 0), cA + kstep, voffA); PG8_STAGE(PG8_SB(1, 1), cB + hstepB + kstep, voffB);
    PG8_WAIT_V(6); PG8_BAR;
    for (;;) {
        const bool has_next = S.next(ui + 1, nxt);
        const char* nA = has_next ? nxt.a : cA; const char* nB = has_next ? nxt.b : cB;
#pragma unroll 1
        for (int t = 0; t < nt; t += 2) {
            const bool last = (t == nt - 2);
            const char* a1 = cA + (size_t)(t + 1) * kstep;
            const char* a2 = last ? nA : cA + (size_t)(t + 2) * kstep; const char* b2 = last ? nB : cB + (size_t)(t + 2) * kstep;
            const char* a3 = a2 + kstep; const char* b3 = b2 + kstep;
            PG8_LDB(B0, 0, 0); PG8_LDB(B1, 0, 1); PG8_SCHED; PG8_LDA(At, 0, 0); PG8_STAGE(PG8_SA(1, 1), a1 + hstepA, voffA);
            PG8_WAIT_V(8); PG8_WAIT_L(0); PG8_BAR; PG8_MMA(0, 0, At, B0); PG8_MMA(0, 1, At, B1); PG8_BAR; PG8_SCHED;
            PG8_LDA(At, 0, 1); PG8_STAGE(PG8_SB(0, 0), b2, voffB); PG8_STAGE(PG8_SB(0, 1), b2 + hstepB, voffB); PG8_STAGE(PG8_SA(0, 0), a2, voffA);
            PG8_WAIT_V(8); PG8_WAIT_L(0); PG8_BAR; PG8_MMA(1, 0, At, B0); PG8_MMA(1, 1, At, B1); PG8_BAR; PG8_SCHED;
            PG8_LDB(B0, 1, 0); PG8_LDB(B1, 1, 1); PG8_SCHED; PG8_LDA(At, 1, 0); PG8_STAGE(PG8_SA(0, 1), a2 + hstepA, voffA);
            PG8_WAIT_V(8); PG8_WAIT_L(0); PG8_BAR; PG8_MMA(0, 0, At, B0); PG8_MMA(0, 1, At, B1); PG8_BAR; PG8_SCHED;
            PG8_LDA(At, 1, 1); PG8_STAGE(PG8_SB(1, 0), b3, voffB); PG8_STAGE(PG8_SB(1, 1), b3 + hstepB, voffB); PG8_STAGE(PG8_SA(1, 0), a3, voffA);
            PG8_WAIT_V(8); PG8_WAIT_L(0); PG8_BAR; PG8_MMA(1, 0, At, B0); PG8_MMA(1, 1, At, B1); PG8_BAR; PG8_SCHED;
        }
        if (wr == 0) PG8_BAR;
        E(acc, cur, cx);
        if (!has_next) break;
#pragma unroll
        for (int a = 0; a < 2; ++a)
#pragma unroll
            for (int b = 0; b < 2; ++b)
#pragma unroll
                for (int m = 0; m < 4; ++m)
#pragma unroll
                    for (int n = 0; n < 2; ++n) acc[a][b][m][n] = (f32x4){0.f, 0.f, 0.f, 0.f};
        cur = nxt; cA = nA; cB = nB; ++ui;
        if (wr == 1) PG8_BAR;
    }
    PG8_WAIT_V(0);
    PG8_BAR;
#undef PG8_SA
#undef PG8_SB
#undef PG8_STAGE
#undef PG8_LDA
#undef PG8_LDB
#undef PG8_MMA
#undef PG8_WAIT_V
#undef PG8_WAIT_L
#undef PG8_BAR
#undef PG8_SCHED
}
}
namespace pg8 {
constexpr int NXCD = 8, WGM = 8;
struct DenseOrder {
    const char* A; const char* B; int nM, nN, nwg, G, c; size_t strideA, strideB;
    DI void init(const void* A_, const void* B_, int M, int N, int lda, int ldb, int G_, int c_) { A = (const char*)A_; B = (const char*)B_; nM = M / BM; nN = N / BM; nwg = nM * nN; G = G_; c = c_;
        strideA = (size_t)BM * lda * 2; strideB = (size_t)BM * ldb * 2; }
    DI bool next(int i, Unit& u) const {
        const long L = (long)i * G + c; if (L >= nwg) return false;
        int wgid = (int)L; { const int q = nwg / NXCD, r = nwg % NXCD, xcd = wgid % NXCD, off = wgid / NXCD; wgid = (xcd < r ? xcd * (q + 1) : r * (q + 1) + (xcd - r) * q) + off; }
        const int nig = WGM * nN, gid = wgid / nig, fm = gid * WGM, gsz = (nM - fm) < WGM ? (nM - fm) : WGM;
        u.pm = fm + ((wgid % nig) % gsz); u.pn = (wgid % nig) / gsz; u.aux = 0;
        u.a = A + (size_t)u.pm * strideA; u.b = B + (size_t)u.pn * strideB; return true;
    }
};
struct CrossSOrder {
    const char* Q; const char* Kc; int G, v;
    DI bool next(int i, Unit& u) const {
        const int L = i * G + v; if (L >= (T / 256) * XH) return false;
        u.pm = L >> 2; u.pn = L & 3; u.aux = 0;
        u.a = Q + ((size_t)u.pm * 256 * D + u.pn * 256) * 2; u.b = Kc + ((size_t)(u.pm >> 3) * 256 * D + u.pn * 256) * 2; return true;
    }
};
struct CrossOOrder {
    const char* P; const char* Vt; int G, v;
    DI bool next(int i, Unit& u) const {
        const int L = i * G + v; if (L >= (T / 256) * XH) return false;
        u.pm = L >> 2; u.pn = L & 3; u.aux = 0;
        u.a = P + ((size_t)u.pm * 256 * D + u.pn * 256) * 2; u.b = Vt + ((size_t)u.pn * 256 * (NB * NMEM) + (size_t)(u.pm >> 3) * 256) * 2; return true;
    }
};
struct MoeOrder {
    const char* A; const char* W; const LAS int* tstart; int npn, G, v; size_t strideA, strideW;
    DI bool next(int i, Unit& u) const {
        const int L = i * G + v; const int total = tstart[NE] * npn; if (L >= total) return false;
        const int tile = L / npn; u.pm = tile; u.pn = L - tile * npn;
        int e = 0;
#pragma unroll 1
        for (int j = 1; j < NE; ++j) e += (tstart[j] <= tile) ? 1 : 0;
        u.aux = e;
        u.a = A + (size_t)tile * strideA; u.b = W + (size_t)e * strideW + (size_t)u.pn * 256 * 1024 * 2; return true;
    }
};

struct EpiBf16 {
    static constexpr bool PERM = true;
    bf16_t* O; int ldc; int sc_from; float scale;
    DI void operator()(const Acc& acc, const Unit& u, const Ctx& c) const {
        int row0 = u.pm * BM + c.wr * 64 + c.fr, col0 = u.pn * BM + c.wc * 32 + 8 * c.fq; asm volatile("" : "+v"(row0), "+v"(col0));
        const float sc = (u.pn >= sc_from) ? scale : 1.0f;
#pragma unroll
        for (int ai = 0; ai < 2; ++ai)
#pragma unroll
            for (int m = 0; m < 4; ++m) { bf16_t* rowp = O + (size_t)(row0 + ai * HALF + m * 16) * ldc + col0;
#pragma unroll
                for (int bj = 0; bj < 2; ++bj) { const f32x4 v0 = acc[ai][bj][m][0] * sc, v1 = acc[ai][bj][m][1] * sc;
                    u32x4 w; w.x = cvt_pk_bf16(v0[0], v0[1]); w.y = cvt_pk_bf16(v0[2], v0[3]); w.z = cvt_pk_bf16(v1[0], v1[1]); w.w = cvt_pk_bf16(v1[2], v1[3]);
                    *(u32x4*)(rowp + bj * HALF) = w; } }
    }
};
struct EpiProj {
    static constexpr bool PERM = true;
    bf16_t* O; float* gates;
    DI void operator()(const Acc& acc, const Unit& u, const Ctx& c) const {
        int row0 = u.pm * BM + c.wr * 64 + c.fr, col0 = u.pn * BM + c.wc * 32 + 8 * c.fq; asm volatile("" : "+v"(row0), "+v"(col0));
#pragma unroll
        for (int ai = 0; ai < 2; ++ai)
#pragma unroll
            for (int m = 0; m < 4; ++m) { const int row = row0 + ai * HALF + m * 16; bf16_t* rowp = O + (size_t)row * NPROJ + col0;
#pragma unroll
                for (int bj = 0; bj < 2; ++bj) { const f32x4 v0 = acc[ai][bj][m][0], v1 = acc[ai][bj][m][1];
                    u32x4 w; w.x = cvt_pk_bf16(v0[0], v0[1]); w.y = cvt_pk_bf16(v0[2], v0[3]); w.z = cvt_pk_bf16(v1[0], v1[1]); w.w = cvt_pk_bf16(v1[2], v1[3]);
                    *(u32x4*)(rowp + bj * HALF) = w; }
                if (u.pn == 1 && c.wc == 1 && c.fq == 0) { *(f32x4*)(gates + (size_t)row * 8) = acc[ai][1][m][0]; *(f32x4*)(gates + (size_t)row * 8 + 4) = acc[ai][1][m][1]; } }
    }
};
struct EpiQmla {
    static constexpr bool PERM = true;
    bf16_t* O; const float* cs;
    float scale;
    DI void operator()(const Acc& acc, const Unit& u, const Ctx& c) const {
        int row0 = u.pm * BM + c.wr * 64 + c.fr, col0 = u.pn * BM + c.wc * 32 + 8 * c.fq; asm volatile("" : "+v"(row0), "+v"(col0));
#pragma unroll
        for (int ai = 0; ai < 2; ++ai)
#pragma unroll
            for (int m = 0; m < 4; ++m) { const int row = row0 + ai * HALF + m * 16; bf16_t* rowp = O + (size_t)row * (AH * AQK) + col0;
#pragma unroll
                for (int bj = 0; bj < 2; ++bj) { f32x4 v0 = acc[ai][bj][m][0] * scale, v1 = acc[ai][bj][m][1] * scale;
                    const int cc = (col0 + bj * HALF) % AQK;
                    if (cc >= ANOPE) { const int p0 = (cc - ANOPE) >> 1;
                        const f32x4 t0 = *(const f32x4*)(cs + (size_t)row * 32 + p0 * 2), t1 = *(const f32x4*)(cs + (size_t)row * 32 + p0 * 2 + 4);
                        f32x4 r0, r1;
                        r0[0] = v0[0] * t0[0] - v0[1] * t0[1]; r0[1] = v0[1] * t0[0] + v0[0] * t0[1];
                        r0[2] = v0[2] * t0[2] - v0[3] * t0[3]; r0[3] = v0[3] * t0[2] + v0[2] * t0[3];
                        r1[0] = v1[0] * t1[0] - v1[1] * t1[1]; r1[1] = v1[1] * t1[0] + v1[0] * t1[1];
                        r1[2] = v1[2] * t1[2] - v1[3] * t1[3]; r1[3] = v1[3] * t1[2] + v1[2] * t1[3];
                        v0 = r0; v1 = r1; }
                    u32x4 w; w.x = cvt_pk_bf16(v0[0], v0[1]); w.y = cvt_pk_bf16(v0[2], v0[3]); w.z = cvt_pk_bf16(v1[0], v1[1]); w.w = cvt_pk_bf16(v1[2], v1[3]);
                    *(u32x4*)(rowp + bj * HALF) = w; } }
    }
};
template <bool ADD> struct EpiGate {
    static constexpr bool PERM = true;
    bf16_t* O; const bf16_t* proj; int gcol;
    DI void operator()(const Acc& acc, const Unit& u, const Ctx& c) const {
        int row0 = u.pm * BM + c.wr * 64 + c.fr, col0 = u.pn * BM + c.wc * 32 + 8 * c.fq; asm volatile("" : "+v"(row0), "+v"(col0));
#pragma unroll
        for (int ai = 0; ai < 2; ++ai)
#pragma unroll
            for (int m = 0; m < 4; ++m) { const int row = row0 + ai * HALF + m * 16; bf16_t* rowp = O + (size_t)row * D + col0; const bf16_t* gp = proj + (size_t)row * NPROJ + gcol + col0;
#pragma unroll
                for (int bj = 0; bj < 2; ++bj) { const f32x4 v0 = acc[ai][bj][m][0], v1 = acc[ai][bj][m][1];
                    const u32x4 g = *(const u32x4*)(gp + bj * HALF);
                    float o[8];
                    o[0] = sigmoidf_(bflo(g.x)) * v0[0]; o[1] = sigmoidf_(bfhi(g.x)) * v0[1]; o[2] = sigmoidf_(bflo(g.y)) * v0[2]; o[3] = sigmoidf_(bfhi(g.y)) * v0[3];
                    o[4] = sigmoidf_(bflo(g.z)) * v1[0]; o[5] = sigmoidf_(bfhi(g.z)) * v1[1]; o[6] = sigmoidf_(bflo(g.w)) * v1[2]; o[7] = sigmoidf_(bfhi(g.w)) * v1[3];
                    if (ADD) { const u32x4 p = *(const u32x4*)(rowp + bj * HALF);
                        o[0] += bflo(p.x); o[1] += bfhi(p.x); o[2] += bflo(p.y); o[3] += bfhi(p.y); o[4] += bflo(p.z); o[5] += bfhi(p.z); o[6] += bflo(p.w); o[7] += bfhi(p.w); }
                    u32x4 w; w.x = cvt_pk_bf16(o[0], o[1]); w.y = cvt_pk_bf16(o[2], o[3]); w.z = cvt_pk_bf16(o[4], o[5]); w.w = cvt_pk_bf16(o[6], o[7]);
                    *(u32x4*)(rowp + bj * HALF) = w; } }
    }
};
struct EpiF32 {
    static constexpr bool PERM = false;
    float* C; int ldc; int ncols_valid;
    DI void operator()(const Acc& acc, const Unit& u, const Ctx& c) const {
        int row0 = u.pm * BM + c.wr * 64 + c.fr, col0 = u.pn * BM + c.wc * 32 + 4 * c.fq; asm volatile("" : "+v"(row0), "+v"(col0));
#pragma unroll
        for (int ai = 0; ai < 2; ++ai)
#pragma unroll
            for (int m = 0; m < 4; ++m) { float* rowp = C + (size_t)(row0 + ai * HALF + m * 16) * ldc + col0;
#pragma unroll
                for (int bj = 0; bj < 2; ++bj)
#pragma unroll
                    for (int n = 0; n < 2; ++n) if (col0 + bj * HALF + n * 16 < ncols_valid) *(f32x4*)(rowp + bj * HALF + n * 16) = acc[ai][bj][m][n]; }
    }
};
struct EpiSoftmax {
    static constexpr bool PERM = true;
    bf16_t* O; LAS float* red;
    DI void operator()(Acc& acc, const Unit& u, const Ctx& c) const {
        int row0 = u.pm * BM + c.wr * 64 + c.fr, col0 = u.pn * BM + c.wc * 32 + 8 * c.fq; asm volatile("" : "+v"(row0), "+v"(col0));
        int rbase = (c.wr * 64 + c.fr) * 4; asm volatile("" : "+v"(rbase));
        LAS float* r1 = red + rbase; LAS float* r2 = red + 1024 + rbase;
#pragma unroll
        for (int ai = 0; ai < 2; ++ai)
#pragma unroll
            for (int m = 0; m < 4; ++m) { float v = -INFINITY;
#pragma unroll
                for (int bj = 0; bj < 2; ++bj)
#pragma unroll
                    for (int n = 0; n < 2; ++n) { const f32x4 x = acc[ai][bj][m][n]; v = fmaxf(v, fmaxf(fmaxf(x[0], x[1]), fmaxf(x[2], x[3]))); }
                v = fmaxf(v, __shfl_xor(v, 16)); v = fmaxf(v, __shfl_xor(v, 32));
                if (c.fq == 0) r1[(ai * HALF + m * 16) * 4 + c.wc] = v;
                __builtin_amdgcn_sched_barrier(0); }
        asm volatile("s_waitcnt lgkmcnt(0)" ::: "memory"); __builtin_amdgcn_s_barrier(); asm volatile("" ::: "memory");
#pragma unroll
        for (int ai = 0; ai < 2; ++ai)
#pragma unroll
            for (int m = 0; m < 4; ++m) { const f32x4 q = *(const LAS f32x4*)(r1 + (ai * HALF + m * 16) * 4);
                const float mm = fmaxf(fmaxf(q[0], q[1]), fmaxf(q[2], q[3])); float s = 0.f;
#pragma unroll
                for (int bj = 0; bj < 2; ++bj)
#pragma unroll
                    for (int n = 0; n < 2; ++n) { f32x4 x = acc[ai][bj][m][n];
                        x[0] = __builtin_amdgcn_exp2f(x[0] - mm); x[1] = __builtin_amdgcn_exp2f(x[1] - mm); x[2] = __builtin_amdgcn_exp2f(x[2] - mm); x[3] = __builtin_amdgcn_exp2f(x[3] - mm);
                        acc[ai][bj][m][n] = x; s += (x[0] + x[1]) + (x[2] + x[3]); }
                s += __shfl_xor(s, 16); s += __shfl_xor(s, 32);
                if (c.fq == 0) r2[(ai * HALF + m * 16) * 4 + c.wc] = s;
                __builtin_amdgcn_sched_barrier(0); }
        asm volatile("s_waitcnt lgkmcnt(0)" ::: "memory"); __builtin_amdgcn_s_barrier(); asm volatile("" ::: "memory");
#pragma unroll
        for (int ai = 0; ai < 2; ++ai)
#pragma unroll
            for (int m = 0; m < 4; ++m) { const f32x4 q = *(const LAS f32x4*)(r2 + (ai * HALF + m * 16) * 4);
                const float inv = 1.0f / ((q[0] + q[1]) + (q[2] + q[3]));
                bf16_t* rowp = O + (size_t)(row0 + ai * HALF + m * 16) * D + col0;
#pragma unroll
                for (int bj = 0; bj < 2; ++bj) { const f32x4 v0 = acc[ai][bj][m][0] * inv, v1 = acc[ai][bj][m][1] * inv;
                    u32x4 w; w.x = cvt_pk_bf16(v0[0], v0[1]); w.y = cvt_pk_bf16(v0[2], v0[3]); w.z = cvt_pk_bf16(v1[0], v1[1]); w.w = cvt_pk_bf16(v1[2], v1[3]);
                    *(u32x4*)(rowp + bj * HALF) = w; }
                __builtin_amdgcn_sched_barrier(0); }
    }
};
struct EpiSwiglu {
    static constexpr bool PERM = true;
    bf16_t* O; const float* bias;
    DI void operator()(const Acc& acc, const Unit& u, const Ctx& c) const {
        int row0 = u.pm * BM + c.wr * 64 + c.fr, col0 = u.pn * BM + c.wc * 32 + 8 * c.fq; asm volatile("" : "+v"(row0), "+v"(col0));
        f32x4 bv[2][2];
#pragma unroll
        for (int bj = 0; bj < 2; ++bj)
#pragma unroll
            for (int n = 0; n < 2; ++n) bv[bj][n] = *(const f32x4*)(bias + (size_t)u.aux * 2048 + col0 + bj * HALF + 4 * n);
#pragma unroll
        for (int ai = 0; ai < 2; ++ai)
#pragma unroll
            for (int m = 0; m < 4; ++m) { bf16_t* rowp = O + (size_t)(row0 + ai * HALF + m * 16) * 1024 + (col0 >> 1);
#pragma unroll
                for (int bj = 0; bj < 2; ++bj) { const f32x4 v0 = acc[ai][bj][m][0] + bv[bj][0], v1 = acc[ai][bj][m][1] + bv[bj][1];
                    float o[4];
#define SWG(g, l) ({ const float g_ = fminf((g), 7.0f), l_ = fminf(fmaxf((l), -7.0f), 7.0f); g_ * sigmoidf_(1.702f * g_) * (l_ + 1.0f); })
                    o[0] = SWG(v0[0], v0[1]); o[1] = SWG(v0[2], v0[3]); o[2] = SWG(v1[0], v1[1]); o[3] = SWG(v1[2], v1[3]);
#undef SWG
                    u32x2 w; w.x = cvt_pk_bf16(o[0], o[1]); w.y = cvt_pk_bf16(o[2], o[3]);
                    *(u32x2*)(rowp + bj * (HALF / 2)) = w; } }
    }
};
struct EpiDown {
    static constexpr bool PERM = true;
    bf16_t* O; const float* bias; const float* rowgate;
    DI void operator()(const Acc& acc, const Unit& u, const Ctx& c) const {
        int row0 = u.pm * BM + c.wr * 64 + c.fr, col0 = u.pn * BM + c.wc * 32 + 8 * c.fq; asm volatile("" : "+v"(row0), "+v"(col0));
        f32x4 bv[2][2];
#pragma unroll
        for (int bj = 0; bj < 2; ++bj)
#pragma unroll
            for (int n = 0; n < 2; ++n) bv[bj][n] = *(const f32x4*)(bias + (size_t)u.aux * 1024 + col0 + bj * HALF + 4 * n);
#pragma unroll
        for (int ai = 0; ai < 2; ++ai)
#pragma unroll
            for (int m = 0; m < 4; ++m) { const int row = row0 + ai * HALF + m * 16; const float gt = rowgate[row]; bf16_t* rowp = O + (size_t)row * 1024 + col0;
#pragma unroll
                for (int bj = 0; bj < 2; ++bj) { const f32x4 v0 = (acc[ai][bj][m][0] + bv[bj][0]) * gt, v1 = (acc[ai][bj][m][1] + bv[bj][1]) * gt;
                    u32x4 w; w.x = cvt_pk_bf16(v0[0], v0[1]); w.y = cvt_pk_bf16(v0[2], v0[3]); w.z = cvt_pk_bf16(v1[0], v1[1]); w.w = cvt_pk_bf16(v1[2], v1[3]);
                    *(u32x4*)(rowp + bj * HALF) = w; } }
    }
};
}
constexpr size_t MiB = 1u << 20;
constexpr size_t WS_CTL = 0, CTL_ZERO_BYTES = 1 * MiB;
constexpr size_t WS_W_IN = 2 * MiB, WS_W_UQ = 10 * MiB, WS_W_UK = WS_W_UQ + 512 * 1024, WS_W_UV = WS_W_UK + 256 * 1024, WS_W_MQK = 11 * MiB, WS_W_BRM = 12 * MiB, WS_W_BRA = 13 * MiB,
                 WS_W_MIX = 14 * MiB, WS_W_CQ = 16 * MiB, WS_W_CK = 18 * MiB, WS_W_CV = 20 * MiB, WS_W_CO = 22 * MiB, WS_W_R = 24 * MiB, WS_W_GU = 26 * MiB, WS_W_DN = 154 * MiB;
constexpr size_t WS_GATES = 218 * MiB, WS_CS = 219 * MiB, WS_KPE = 223 * MiB, WS_MEMB = 225 * MiB, WS_KC = 233 * MiB, WS_VCT = 241 * MiB, WS_LOGITS = 249 * MiB,
                 WS_ASSIGN = 253 * MiB, WS_GATEW = WS_ASSIGN + 512 * 1024, WS_TOKPOS = 254 * MiB, WS_ROWGATE = WS_TOKPOS + 512 * 1024;
constexpr size_t WS_XB = 256 * MiB, WS_PROJ = 320 * MiB, WS_QN = 576 * MiB, WS_KVN = 592 * MiB, WS_XC = 608 * MiB, WS_QMLA = 640 * MiB, WS_KN = 688 * MiB, WS_VT = 720 * MiB,
                 WS_QKM = 752 * MiB, WS_KTM = 816 * MiB, WS_AO = 848 * MiB, WS_HRAW = 880 * MiB, WS_HM = 944 * MiB;
constexpr size_t WS_GATED = 256 * MiB, WS_MIXO = 576 * MiB, WS_H1B = 704 * MiB, WS_QC = 768 * MiB, WS_PC = 832 * MiB, WS_OC = 896 * MiB, WS_COO = 320 * MiB, WS_H2B = 256 * MiB;
constexpr size_t WS_XG = 320 * MiB, WS_ACT = 592 * MiB, WS_YB = 320 * MiB, WS_END = 976 * MiB;
static_assert((size_t)NROWS * 1024 * 2 <= 272 * MiB, "routed buffers");
static_assert(WS_ROWGATE + (size_t)NROWS * 4 <= 256 * MiB, "small buffers");
constexpr int CW_TMO = 0, CW_CNT = 64  , CW_BAR = 4096;

constexpr int RING_OFF = 0, RING_BYTES = 131072;
constexpr int RED_OFF = RING_BYTES;
constexpr int TST_OFF = RED_OFF + 8192;
constexpr int HIST_OFF = TST_OFF + 256, HBASE_OFF = HIST_OFF + 128;
constexpr int MISC_OFF = HBASE_OFF + 128;
constexpr int LDSCTL_OFF = TST_OFF;
constexpr int LDS_BYTES = 147456;
static_assert(MISC_OFF + 128 <= LDS_BYTES, "LDS map");
constexpr int NWAVES = 8;

#define LDS_WAIT() asm volatile("s_waitcnt lgkmcnt(0)" ::: "memory")
#define VM_WAIT() asm volatile("s_waitcnt vmcnt(0)" ::: "memory")

#define XB_TMO      128
#define XB_XCNT(j)  (256  + 64 * (j))
#define XB_XSUB(j)  (1280 + 64 * (j))
#define XB_XGEN(j)  (2304 + 64 * (j))
#define XB_TOP      3328
#define XB_TOPGEN   3392
#define XCD_BAR_WORDS 3456
#define XB_SPIN_CAP (1u << 18)
__device__ __forceinline__ unsigned xb_ld(unsigned* p)              { return __hip_atomic_load(p, __ATOMIC_RELAXED, __HIP_MEMORY_SCOPE_AGENT); }
__device__ __forceinline__ unsigned xb_add(unsigned* p, unsigned v) { return __hip_atomic_fetch_add(p, v, __ATOMIC_RELAXED, __HIP_MEMORY_SCOPE_AGENT); }
__device__ __forceinline__ unsigned xb_xcc_id() { return (unsigned)__builtin_amdgcn_s_getreg((3 << 11) | 20) & 0xFu; }
#define XB_SPIN(cond, bar) do { unsigned _sp = 0; while (cond) { __builtin_amdgcn_s_sleep(1); \
    if ((++_sp & 255u) == 0u) { if (xb_ld(&(bar)[XB_TMO])) break; if (_sp > XB_SPIN_CAP) { atomicAdd(&(bar)[XB_TMO], 1u); break; } } } } while (0)
struct XcdBarrier { unsigned* bar; unsigned x; volatile LAS unsigned* st; };
__device__ __forceinline__ XcdBarrier xcd_barrier_post(unsigned* bar, volatile LAS unsigned* st) {
    XcdBarrier b; b.bar = bar; b.x = xb_xcc_id(); b.st = st;
    if (threadIdx.x == 0) (void)xb_add(&bar[XB_XCNT(b.x)], 1u);
    return b;
}
__device__ __forceinline__ void xcd_barrier_complete(unsigned* bar, unsigned x, unsigned& nloc, unsigned& nx) {
    const unsigned G = gridDim.x * gridDim.y * gridDim.z;
    unsigned sum, cnt, mine, sp = 0u;
    for (;;) {
        sum = 0u; cnt = 0u; mine = 0u;
#pragma unroll
        for (unsigned j = 0; j < 16; ++j) { const unsigned c = xb_ld(&bar[XB_XCNT(j)]); sum += c; cnt += (c > 0u) ? 1u : 0u; mine = (j == x) ? c : mine; }
        if (sum == G) break;
        __builtin_amdgcn_s_sleep(1);
        if ((++sp & 255u) == 0u) { if (xb_ld(&bar[XB_TMO])) break; if (sp > XB_SPIN_CAP) { atomicAdd(&bar[XB_TMO], 1u); break; } }
    }
    nloc = mine > 0u ? mine : 1u; nx = cnt > 0u ? cnt : 1u;
}
__device__ __forceinline__ void xcd_barrier(const XcdBarrier& b) {
    asm volatile("s_waitcnt vmcnt(0)" ::: "memory");
    __syncthreads();
    if (threadIdx.x == 0) {
        unsigned* bar = b.bar;
        __builtin_amdgcn_s_waitcnt(0);
        unsigned nloc = b.st[0], nx = b.st[1];
        if (nloc == 0u) { xcd_barrier_complete(bar, b.x, nloc, nx); b.st[0] = nloc; b.st[1] = nx; }
        const unsigned old = xb_add(&bar[XB_XSUB(b.x)], 1u);
        const unsigned gen = old / nloc;
        if (old + 1u == (gen + 1u) * nloc) {
            __builtin_amdgcn_fence(__ATOMIC_RELEASE, "agent");
            asm volatile("s_waitcnt vmcnt(0)" ::: "memory");
            const unsigned og = xb_add(&bar[XB_TOP], 1u);
            const unsigned tg = og / nx;
            if (og + 1u == (tg + 1u) * nx) xb_add(&bar[XB_TOPGEN], 1u);
            else XB_SPIN(xb_ld(&bar[XB_TOPGEN]) == tg, bar);
            __builtin_amdgcn_fence(__ATOMIC_ACQUIRE, "agent");
            xb_add(&bar[XB_XGEN(b.x)], 1u);
            asm volatile("s_waitcnt vmcnt(0)" ::: "memory");
        } else {
            XB_SPIN(xb_ld(&bar[XB_XGEN(b.x)]) == gen, bar);
            __builtin_amdgcn_fence(__ATOMIC_ACQUIRE, "agent");
            asm volatile("s_waitcnt vmcnt(0)" ::: "memory");
        }
    }
    __syncthreads();
}

struct Args { const void* in[34]; float* out; unsigned char* ws; int ph_lo, ph_hi; };

DI void tr_item(const float* W, int ldw, int kvalid, bf16_t* WT, int ldk, int n0, int k0, int sc, LAS float* scr, int lane) {
#pragma unroll 8
    for (int i = 0; i < 32; ++i) { const int kk = 2 * i + (lane >> 5); const int k = k0 + kk;
        float v = 0.f; if (sc >= 0 && k < kvalid) v = W[(size_t)k * ldw + sc];
        scr[kk * 33 + (lane & 31)] = v; }
    LDS_WAIT(); asm volatile("" ::: "memory");
    const int c = lane & 7;
#pragma unroll
    for (int j = 0; j < 4; ++j) { const int n = (lane >> 3) + 8 * j; const LAS float* s = scr + (8 * c) * 33 + n;
        u32x4 o; o.x = pk2(s[0 * 33], s[1 * 33]); o.y = pk2(s[2 * 33], s[3 * 33]); o.z = pk2(s[4 * 33], s[5 * 33]); o.w = pk2(s[6 * 33], s[7 * 33]);
        *(GAS u32x4*)(WT + (size_t)(n0 + n) * ldk + k0 + 8 * c) = o; }
    LDS_WAIT(); asm volatile("" ::: "memory");
}
DI int win_src(int n) {
    if (n < 384) return n;
    if (n < 416) { const int i = (n - 384) >> 1; return 384 + i + 16 * ((n - 384) & 1); }
    if (n < 424) return 1952 + (n - 416);
    if (n < 512) return -1;
    if (n < 2048) return 416 + (n - 512);
    return 1960 + (n - 2048);
}
DI void p0_prologue(const Args& args, LAS unsigned char* lds, int vcu, int G) {
    int tid_ = threadIdx.x; asm volatile("" : "+v"(tid_)); const int lane = tid_ & 63; const int wave = __builtin_amdgcn_readfirstlane(tid_ >> 6);
    LAS float* scr = (LAS float*)(lds + RING_OFF + wave * 16384);
    const int gw = vcu * NWAVES + wave, NGW = G * NWAVES;
    unsigned char* ws = args.ws;
    const int j = lane & 31;
    constexpr int I_IN = 16 * 128, I_UQ = 4 * 24, I_UK = 4 * 16, I_UV = 4 * 16, I_MQK = 8 * 32, I_BRM = 8 * 32, I_BRA = 8 * 32, I_SQ = 16 * 32, I_R = 16 * 8,
                  I_GU = NE * 16 * 64, I_DN = NE * 16 * 32;
    constexpr int NITEMS = I_IN + I_UQ + I_UK + I_UV + I_MQK + I_BRM + I_BRA + 5 * I_SQ + I_R + I_GU + I_DN;
    for (int it = gw; it < NITEMS; it += NGW) {
        int r = it;
        if (r < I_GU) { const int e = r / (16 * 64), q = r % (16 * 64), kb = q / 64, nb = q % 64;
            tr_item((const float*)args.in[28] + (size_t)e * 1024 * 2048, 2048, 1024, (bf16_t*)(ws + WS_W_GU) + (size_t)e * 2048 * 1024, 1024, nb * 32, kb * 64, nb * 32 + j, scr, lane); continue; } r -= I_GU;
        if (r < I_DN) { const int e = r / (16 * 32), q = r % (16 * 32), kb = q / 32, nb = q % 32;
            tr_item((const float*)args.in[30] + (size_t)e * 1024 * 1024, 1024, 1024, (bf16_t*)(ws + WS_W_DN) + (size_t)e * 1024 * 1024, 1024, nb * 32, kb * 64, nb * 32 + j, scr, lane); continue; } r -= I_DN;
        if (r < I_IN) { const int kb = r / 128, nb = r % 128;
            tr_item((const float*)args.in[3], DIN, 1024, (bf16_t*)(ws + WS_W_IN), 1024, nb * 32, kb * 64, win_src(nb * 32 + j), scr, lane); continue; } r -= I_IN;
        if (r < I_UQ) { const int kb = r / 24, nb = r % 24; const int n = nb * 32 + j, hh = n / AQK, cc = n % AQK;
            const int sc = (cc < ANOPE) ? n : hh * AQK + ANOPE + ((cc - ANOPE) >> 1) + 16 * ((cc - ANOPE) & 1);
            tr_item((const float*)args.in[14], AH * AQK, 256, (bf16_t*)(ws + WS_W_UQ), 256, nb * 32, kb * 64, sc, scr, lane); continue; } r -= I_UQ;
        if (r < I_UK) { const int kb = r / 16, nb = r % 16; const int n = nb * 32 + j;
            tr_item((const float*)args.in[15], 1024, 128, (bf16_t*)(ws + WS_W_UK), 256, nb * 32, kb * 64, (n >> 6) * 128 + (n & 63), scr, lane); continue; } r -= I_UK;
        if (r < I_UV) { const int kb = r / 16, nb = r % 16; const int n = nb * 32 + j;
            tr_item((const float*)args.in[15], 1024, 128, (bf16_t*)(ws + WS_W_UV), 256, nb * 32, kb * 64, (n >> 6) * 128 + 64 + (n & 63), scr, lane); continue; } r -= I_UV;
        if (r < I_MQK) { const int kb = r / 32, nb = r % 32; const int n = nb * 32 + j, part = n >> 9, hh = (n >> 7) & 3, e = n & 127;
            const float* src = (const float*)args.in[part ? 9 : 8];
            tr_item(src, 128, 512, (bf16_t*)(ws + WS_W_MQK), 512, nb * 32, kb * 64, ((kb >> 1) == hh) ? e : -1, scr, lane); continue; } r -= I_MQK;
        if (r < I_BRM) { const int kb = r / 32, nb = r % 32;
            tr_item((const float*)args.in[16], 1024, 512, (bf16_t*)(ws + WS_W_BRM), 512, nb * 32, kb * 64, nb * 32 + j, scr, lane); continue; } r -= I_BRM;
        if (r < I_BRA) { const int kb = r / 32, nb = r % 32;
            tr_item((const float*)args.in[17], 1024, 512, (bf16_t*)(ws + WS_W_BRA), 512, nb * 32, kb * 64, nb * 32 + j, scr, lane); continue; } r -= I_BRA;
        if (r < 5 * I_SQ) { const int w = r / I_SQ, q = r % I_SQ, kb = q / 32, nb = q % 32;
            const float* src; int ldw, coff; bf16_t* dst;
            if (w == 0) { src = (const float*)args.in[18]; ldw = 1024; coff = 0; dst = (bf16_t*)(ws + WS_W_MIX); }
            else if (w == 1) { src = (const float*)args.in[21]; ldw = 1024; coff = 0; dst = (bf16_t*)(ws + WS_W_CQ); }
            else if (w == 2) { src = (const float*)args.in[22]; ldw = 2048; coff = 0; dst = (bf16_t*)(ws + WS_W_CK); }
            else if (w == 3) { src = (const float*)args.in[22]; ldw = 2048; coff = 1024; dst = (bf16_t*)(ws + WS_W_CV); }
            else { src = (const float*)args.in[23]; ldw = 1024; coff = 0; dst = (bf16_t*)(ws + WS_W_CO); }
            tr_item(src, ldw, 1024, dst, 1024, nb * 32, kb * 64, coff + nb * 32 + j, scr, lane); continue; } r -= 5 * I_SQ;
        { const int kb = r / 8, nb = r % 8; const int n = nb * 32 + j;
            tr_item((const float*)args.in[26], NE, 1024, (bf16_t*)(ws + WS_W_R), 1024, nb * 32, kb * 64, (n < NE) ? n : -1, scr, lane); }
    }
    const size_t gt = (size_t)gw * 64 + lane, NT_ = (size_t)NGW * 64;
    { const float* x = (const float*)args.in[0]; bf16_t* xb = (bf16_t*)(ws + WS_XB);
      for (size_t i = gt; i < (size_t)T * D / 8; i += NT_) { const f32x4 a = *(const f32x4*)(x + i * 8), b = *(const f32x4*)(x + i * 8 + 4);
          u32x4 o; o.x = pk2(a[0], a[1]); o.y = pk2(a[2], a[3]); o.z = pk2(b[0], b[1]); o.w = pk2(b[2], b[3]); *(u32x4*)(xb + i * 8) = o; } }
    { const float* x = (const float*)args.in[1]; bf16_t* xb = (bf16_t*)(ws + WS_MEMB);
      for (size_t i = gt; i < (size_t)NB * NMEM * D / 8; i += NT_) { const f32x4 a = *(const f32x4*)(x + i * 8), b = *(const f32x4*)(x + i * 8 + 4);
          u32x4 o; o.x = pk2(a[0], a[1]); o.y = pk2(a[2], a[3]); o.z = pk2(b[0], b[1]); o.w = pk2(b[2], b[3]); *(u32x4*)(xb + i * 8) = o; } }
}

DI void p2_tokens(const Args& args, int vcu, int G) {
    int tid_ = threadIdx.x; asm volatile("" : "+v"(tid_)); const int lane = tid_ & 63; const int wave = __builtin_amdgcn_readfirstlane(tid_ >> 6);
    unsigned char* ws = args.ws;
    const bf16_t* proj = (const bf16_t*)(ws + WS_PROJ);
    bf16_t* qn = (bf16_t*)(ws + WS_QN); bf16_t* kvn = (bf16_t*)(ws + WS_KVN); bf16_t* kpe = (bf16_t*)(ws + WS_KPE); bf16_t* xc = (bf16_t*)(ws + WS_XC); float* cs = (float*)(ws + WS_CS);
    const int* positions = (const int*)args.in[2];
    const float* conv_w = (const float*)args.in[6]; const float* conv_b = (const float*)args.in[7];
    const float* g_qlat = (const float*)args.in[12]; const float* g_kvlat = (const float*)args.in[13];
    const int gw = vcu * NWAVES + wave, NGW = G * NWAVES;
    float cw[4][8], cb[8];
#pragma unroll
    for (int jj = 0; jj < 4; ++jj)
#pragma unroll
        for (int c = 0; c < 8; ++c) cw[jj][c] = conv_w[jj * MW + 8 * lane + c];
#pragma unroll
    for (int c = 0; c < 8; ++c) cb[c] = conv_b[8 * lane + c];
    const f32x4 gq = *(const f32x4*)(g_qlat + 4 * lane);
    const f32x2 gk = *(const f32x2*)(g_kvlat + 2 * lane);
    const float inv_freq = exp2f(-(float)(lane & 15) * (13.287712379549449f / 16.0f));
    for (int t = gw; t < T; t += NGW) {
        const bf16_t* pr = proj + (size_t)t * NPROJ;
        { const u32x2 w = *(const u32x2*)(pr + PC_QLAT + 4 * lane); const float a0 = bflo(w.x), a1 = bfhi(w.x), a2 = bflo(w.y), a3 = bfhi(w.y);
          const float ss = wave_sum(a0 * a0 + a1 * a1 + a2 * a2 + a3 * a3); const float r = 1.0f / sqrtf(ss * (1.0f / AQR) + EPS);
          u32x2 o; o.x = pk2(a0 * r * gq[0], a1 * r * gq[1]); o.y = pk2(a2 * r * gq[2], a3 * r * gq[3]); *(u32x2*)(qn + (size_t)t * 256 + 4 * lane) = o; }
        { const unsigned w = *(const unsigned*)(pr + PC_KVLAT + 2 * lane); const float a0 = bflo(w), a1 = bfhi(w);
          const float ss = wave_sum(a0 * a0 + a1 * a1); const float r = 1.0f / sqrtf(ss * (1.0f / AKVR) + EPS);
          *(unsigned*)(kvn + (size_t)t * 256 + 2 * lane) = pk2(a0 * r * gk[0], a1 * r * gk[1]); *(unsigned*)(kvn + (size_t)t * 256 + 128 + 2 * lane) = 0u; }
        if (lane < 16) { const unsigned w = *(const unsigned*)(pr + PC_KROPE + 2 * lane); const float x1 = bflo(w), x2 = bfhi(w);
          const float ang = (float)positions[t] * inv_freq;
          const double rev = (double)ang * 0.15915494309189535; const float fr = (float)(rev - __builtin_rint(rev));
          const float cc = __builtin_amdgcn_cosf(fr), sn = __builtin_amdgcn_sinf(fr);
          *(unsigned*)(kpe + (size_t)t * 32 + 2 * lane) = pk2(x1 * cc - x2 * sn, x2 * cc + x1 * sn);
          *(f32x2*)(cs + (size_t)t * 32 + 2 * lane) = (f32x2){cc, sn}; }
        { const int s = t & (SEQ - 1); float a[8];
#pragma unroll
          for (int c = 0; c < 8; ++c) a[c] = cb[c];
#pragma unroll
          for (int jj = 0; jj < 4; ++jj) { const int back = 3 - jj; if (s - back >= 0) { const u32x4 w = *(const u32x4*)(pr - (size_t)back * NPROJ + PC_XM + 8 * lane);
              a[0] += cw[jj][0] * bflo(w.x); a[1] += cw[jj][1] * bfhi(w.x); a[2] += cw[jj][2] * bflo(w.y); a[3] += cw[jj][3] * bfhi(w.y);
              a[4] += cw[jj][4] * bflo(w.z); a[5] += cw[jj][5] * bfhi(w.z); a[6] += cw[jj][6] * bflo(w.w); a[7] += cw[jj][7] * bfhi(w.w); } }
#pragma unroll
          for (int c = 0; c < 8; ++c) a[c] = a[c] * sigmoidf_(a[c]);
          u32x4 o; o.x = pk2(a[0], a[1]); o.y = pk2(a[2], a[3]); o.z = pk2(a[4], a[5]); o.w = pk2(a[6], a[7]); *(u32x4*)(xc + (size_t)t * MW + 8 * lane) = o; }
    }
}

DI void p6_mpost(const Args& args, int vcu, int G) {
    int tid_ = threadIdx.x; asm volatile("" : "+v"(tid_)); const int lane = tid_ & 63; const int wave = __builtin_amdgcn_readfirstlane(tid_ >> 6);
    unsigned char* ws = args.ws;
    const float* hraw = (const float*)(ws + WS_HRAW); const bf16_t* xc = (const bf16_t*)(ws + WS_XC); const bf16_t* proj = (const bf16_t*)(ws + WS_PROJ); bf16_t* hm = (bf16_t*)(ws + WS_HM);
    const float* g_mhead = (const float*)args.in[10]; const float* w_mskip = (const float*)args.in[11];
    const int gw = vcu * NWAVES + wave, NGW = G * NWAVES;
    float gm[8], wsk[8];
#pragma unroll
    for (int c = 0; c < 8; ++c) { gm[c] = g_mhead[8 * lane + c]; wsk[c] = w_mskip[8 * lane + c]; }
    for (int t = gw; t < T; t += NGW) {
        const f32x4 h0 = *(const f32x4*)(hraw + (size_t)t * MW + 8 * lane), h1 = *(const f32x4*)(hraw + (size_t)t * MW + 8 * lane + 4);
        float h[8] = {h0[0], h0[1], h0[2], h0[3], h1[0], h1[1], h1[2], h1[3]};
        float s = 0.f;
#pragma unroll
        for (int c = 0; c < 8; ++c) s += h[c];
        s += __shfl_xor(s, 1); s += __shfl_xor(s, 2); s += __shfl_xor(s, 4); s += __shfl_xor(s, 8);
        const float mu = s * (1.0f / MHD); float q = 0.f;
#pragma unroll
        for (int c = 0; c < 8; ++c) { h[c] -= mu; q += h[c] * h[c]; }
        q += __shfl_xor(q, 1); q += __shfl_xor(q, 2); q += __shfl_xor(q, 4); q += __shfl_xor(q, 8);
        const float rstd = 1.0f / sqrtf(q * (1.0f / MHD) + EPS);
        const u32x4 xw = *(const u32x4*)(xc + (size_t)t * MW + 8 * lane); const u32x4 ow = *(const u32x4*)(proj + (size_t)t * NPROJ + PC_OP + 8 * lane);
        const float xv[8] = {bflo(xw.x), bfhi(xw.x), bflo(xw.y), bfhi(xw.y), bflo(xw.z), bfhi(xw.z), bflo(xw.w), bfhi(xw.w)};
        const float ov[8] = {bflo(ow.x), bfhi(ow.x), bflo(ow.y), bfhi(ow.y), bflo(ow.z), bfhi(ow.z), bflo(ow.w), bfhi(ow.w)};
        float o[8];
#pragma unroll
        for (int c = 0; c < 8; ++c) o[c] = sigmoidf_(ov[c]) * (h[c] * rstd * gm[c] + wsk[c] * xv[c]);
        u32x4 w; w.x = pk2(o[0], o[1]); w.y = pk2(o[2], o[3]); w.z = pk2(o[4], o[5]); w.w = pk2(o[6], o[7]); *(u32x4*)(hm + (size_t)t * MW + 8 * lane) = w;
    }
}

DI void ln_pass(const float* res, const float* add, const float* g, const float* b, float* out, bf16_t* outb, int vcu, int G) {
    int tid_ = threadIdx.x; asm volatile("" : "+v"(tid_)); const int lane = tid_ & 63; const int wave = __builtin_amdgcn_readfirstlane(tid_ >> 6);
    const int gw = vcu * NWAVES + wave, NGW = G * NWAVES;
    for (int t = gw; t < T; t += NGW) {
        f32x4 v[4]; float s = 0.f;
#pragma unroll
        for (int j = 0; j < 4; ++j) { const f32x4 r = *(const f32x4*)(res + (size_t)t * D + 4 * lane + 256 * j), a = *(const f32x4*)(add + (size_t)t * D + 4 * lane + 256 * j);
            v[j] = r * DN_ALPHA + a; s += (v[j][0] + v[j][1]) + (v[j][2] + v[j][3]); }
        const float mean = wave_sum(s) * (1.0f / D); float q = 0.f;
#pragma unroll
        for (int j = 0; j < 4; ++j) { v[j] = v[j] - mean; q += (v[j][0] * v[j][0] + v[j][1] * v[j][1]) + (v[j][2] * v[j][2] + v[j][3] * v[j][3]); }
        const float rstd = 1.0f / sqrtf(wave_sum(q) * (1.0f / D) + EPS);
#pragma unroll
        for (int j = 0; j < 4; ++j) { const f32x4 gg = *(const f32x4*)(g + 4 * lane + 256 * j), bb = *(const f32x4*)(b + 4 * lane + 256 * j);
            const f32x4 y = v[j] * rstd * gg + bb;
            *(f32x4*)(out + (size_t)t * D + 4 * lane + 256 * j) = y;
            if (outb) { u32x2 w; w.x = pk2(y[0], y[1]); w.y = pk2(y[2], y[3]); *(u32x2*)(outb + (size_t)t * D + 4 * lane + 256 * j) = w; } }
    }
}

DI void p16_topk(const Args& args, LAS unsigned char* lds, int vcu, int G) {
    unsigned char* ws = args.ws;
    const float* logits = (const float*)(ws + WS_LOGITS); const float* b_router = (const float*)args.in[27];
    int* assign = (int*)(ws + WS_ASSIGN); float* gatew = (float*)(ws + WS_GATEW);
    unsigned* gcnt = (unsigned*)(ws + WS_CTL) + CW_CNT;
    LAS unsigned* hist = (LAS unsigned*)(lds + HIST_OFF); LAS unsigned* hbase = (LAS unsigned*)(lds + HBASE_OFF);
    int tid = threadIdx.x; asm volatile("" : "+v"(tid));
    for (int blk = vcu; blk < T / 512; blk += G) {
        const int t = blk * 512 + tid;
        float v[NE];
#pragma unroll
        for (int j = 0; j < NE / 4; ++j) { const f32x4 a = *(const f32x4*)(logits + (size_t)t * NE + 4 * j), bb = *(const f32x4*)(b_router + 4 * j);
            v[4 * j] = a[0] + bb[0]; v[4 * j + 1] = a[1] + bb[1]; v[4 * j + 2] = a[2] + bb[2]; v[4 * j + 3] = a[3] + bb[3]; }
        int idx[TOPK]; float val[TOPK];
#pragma unroll
        for (int k = 0; k < TOPK; ++k) { float best = -INFINITY; int bi = 0;
#pragma unroll
            for (int e = 0; e < NE; ++e) { bool taken = false;
#pragma unroll
                for (int kk = 0; kk < k; ++kk) taken = taken || (idx[kk] == e);
                if (!taken && v[e] > best) { best = v[e]; bi = e; } }
            idx[k] = bi; val[k] = best; }
        float ex[TOPK], sum = 0.f;
#pragma unroll
        for (int k = 0; k < TOPK; ++k) { ex[k] = __expf(val[k] - val[0]); sum += ex[k]; }
        const float inv = 1.0f / sum;
        if (tid < NE) hist[tid] = 0u;
        __syncthreads();
        unsigned lr[TOPK];
#pragma unroll
        for (int k = 0; k < TOPK; ++k) lr[k] = __hip_atomic_fetch_add(hist + idx[k], 1u, __ATOMIC_RELAXED, __HIP_MEMORY_SCOPE_WORKGROUP);
        __syncthreads();
        if (tid < NE) hbase[tid] = __hip_atomic_fetch_add(gcnt + tid, hist[tid], RLX_AGENT);
        __syncthreads();
#pragma unroll
        for (int k = 0; k < TOPK; ++k) { assign[(size_t)t * TOPK + k] = (idx[k] << 20) | (int)(hbase[idx[k]] + lr[k]); gatew[(size_t)t * TOPK + k] = ex[k] * inv; }
        __syncthreads();
    }
}
DI void build_tstart(const Args& args, LAS unsigned char* lds) {
    const unsigned* gcnt = (const unsigned*)(args.ws + WS_CTL) + CW_CNT; LAS int* tst = (LAS int*)(lds + TST_OFF);
    if (threadIdx.x == 0) { int acc = 0;
        for (int e = 0; e < NE; ++e) { tst[e] = acc; const unsigned c = __hip_atomic_load(gcnt + e, RLX_AGENT); acc += (int)((c + 255u) >> 8); }
        tst[NE] = acc; }
    __syncthreads();
}
DI void p17_gather(const Args& args, LAS unsigned char* lds, int vcu, int G) {
    int tid_ = threadIdx.x; asm volatile("" : "+v"(tid_)); const int lane = tid_ & 63; const int wave = __builtin_amdgcn_readfirstlane(tid_ >> 6);
    unsigned char* ws = args.ws;
    build_tstart(args, lds);
    const LAS int* tst = (const LAS int*)(lds + TST_OFF);
    const unsigned* gcnt = (const unsigned*)(ws + WS_CTL) + CW_CNT;
    const int* assign = (const int*)(ws + WS_ASSIGN); const float* gatew = (const float*)(ws + WS_GATEW);
    int* tokpos = (int*)(ws + WS_TOKPOS); float* rowgate = (float*)(ws + WS_ROWGATE);
    const bf16_t* h2b = (const bf16_t*)(ws + WS_H2B); bf16_t* xg = (bf16_t*)(ws + WS_XG);
    const int gw = vcu * NWAVES + wave, NGW = G * NWAVES;
    for (int t = gw; t < T; t += NGW) {
        const u32x4 a = *(const u32x4*)(h2b + (size_t)t * D + 8 * lane), b = *(const u32x4*)(h2b + (size_t)t * D + 512 + 8 * lane);
#pragma unroll
        for (int k = 0; k < TOPK; ++k) { const int as = assign[(size_t)t * TOPK + k]; const int e = as >> 20, rank = as & 0xfffff; const int pos = tst[e] * 256 + rank;
            *(u32x4*)(xg + (size_t)pos * D + 8 * lane) = a; *(u32x4*)(xg + (size_t)pos * D + 512 + 8 * lane) = b;
            if (lane == 0) { tokpos[(size_t)t * TOPK + k] = pos; rowgate[pos] = gatew[(size_t)t * TOPK + k]; } }
    }
    for (int idx = gw; idx < NE * 256; idx += NGW) { const int e = idx >> 8, r = idx & 255; const int row = tst[e] * 256 + (int)__hip_atomic_load(gcnt + e, RLX_AGENT) + r;
        if (row < tst[e + 1] * 256) { const u32x4 z = {0u, 0u, 0u, 0u}; *(u32x4*)(xg + (size_t)row * D + 8 * lane) = z; *(u32x4*)(xg + (size_t)row * D + 512 + 8 * lane) = z; if (lane == 0) rowgate[row] = 0.f; } }
}
DI void p20_final(const Args& args, int vcu, int G) {
    int tid_ = threadIdx.x; asm volatile("" : "+v"(tid_)); const int lane = tid_ & 63; const int wave = __builtin_amdgcn_readfirstlane(tid_ >> 6);
    unsigned char* ws = args.ws;
    const int* tokpos = (const int*)(ws + WS_TOKPOS); const bf16_t* yb = (const bf16_t*)(ws + WS_YB);
    const float* g = (const float*)args.in[32]; const float* b = (const float*)args.in[33]; float* out = args.out;
    const int gw = vcu * NWAVES + wave, NGW = G * NWAVES;
    for (int t = gw; t < T; t += NGW) {
        int pos[TOPK];
#pragma unroll
        for (int k = 0; k < TOPK; ++k) pos[k] = tokpos[(size_t)t * TOPK + k];
        f32x4 v[4]; float s = 0.f;
#pragma unroll
        for (int j = 0; j < 4; ++j) { const f32x4 r = *(const f32x4*)(out + (size_t)t * D + 4 * lane + 256 * j); f32x4 a = {0.f, 0.f, 0.f, 0.f};
#pragma unroll
            for (int k = 0; k < TOPK; ++k) { const u32x2 w = *(const u32x2*)(yb + (size_t)pos[k] * D + 4 * lane + 256 * j); a[0] += bflo(w.x); a[1] += bfhi(w.x); a[2] += bflo(w.y); a[3] += bfhi(w.y); }
            v[j] = r * DN_ALPHA + a; s += (v[j][0] + v[j][1]) + (v[j][2] + v[j][3]); }
        const float mean = wave_sum(s) * (1.0f / D); float q = 0.f;
#pragma unroll
        for (int j = 0; j < 4; ++j) { v[j] = v[j] - mean; q += (v[j][0] * v[j][0] + v[j][1] * v[j][1]) + (v[j][2] * v[j][2] + v[j][3] * v[j][3]); }
        const float rstd = 1.0f / sqrtf(wave_sum(q) * (1.0f / D) + EPS);
#pragma unroll
        for (int j = 0; j < 4; ++j) { const f32x4 gg = *(const f32x4*)(g + 4 * lane + 256 * j), bb = *(const f32x4*)(b + 4 * lane + 256 * j);
            *(f32x4*)(out + (size_t)t * D + 4 * lane + 256 * j) = v[j] * rstd * gg + bb; }
    }
}
constexpr int AT_KROW = 208, AT_VROW = 136;
constexpr int AT_KBUF = 64 * AT_KROW, AT_VBUF = 64 * AT_VROW, AT_VOFF = 2 * AT_KBUF;
DI void mla_unit(int b, int h, int qb, const bf16_t* Q, const bf16_t* Kn, const bf16_t* Kpe, const bf16_t* Vt, bf16_t* O, LAS unsigned char* lds) {
    int tid = threadIdx.x; asm volatile("" : "+v"(tid)); const int lane = tid & 63, r32 = lane & 31, hi = lane >> 5; const int wid = __builtin_amdgcn_readfirstlane(tid >> 6);
    const int q0 = qb * 256 + wid * 32;
    const int qi = q0 + r32;
    const size_t tokb = (size_t)b * SEQ;
    bf16x8 qf[6];
    { const bf16_t* qp = Q + (tokb + qi) * (AH * AQK) + h * AQK + 8 * hi;
#pragma unroll
      for (int s = 0; s < 6; ++s) qf[s] = *(const bf16x8*)(qp + 16 * s); }
    const int kkey = tid >> 3, kch = tid & 7, pkey = (tid & 255) >> 2, pch = tid & 3, vd = tid >> 3, vch = tid & 7;
    const bf16_t* ksrc = Kn + (tokb + kkey) * 512 + h * 64 + kch * 8;
    const bf16_t* psrc = Kpe + (tokb + pkey) * 32 + pch * 8;
    const bf16_t* vsrc = Vt + (size_t)(h * 64 + vd) * T + tokb + vch * 8;
    const int kdst = kkey * AT_KROW + kch * 16, pdst = pkey * AT_KROW + 128 + pch * 16, vdst = AT_VOFF + vd * AT_VROW + vch * 16;
    const int nkt = 4 * (qb + 1);
    u32x4 rk, rp, rv;
    rk = *(const u32x4*)ksrc; rv = *(const u32x4*)vsrc; rp = (u32x4){0u, 0u, 0u, 0u}; if (tid < 256) rp = *(const u32x4*)psrc;
    *(LAS u32x4*)(lds + kdst) = rk; if (tid < 256) *(LAS u32x4*)(lds + pdst) = rp;
    *(LAS u32x2*)(lds + vdst) = (u32x2){rv.x, rv.y}; *(LAS u32x2*)(lds + vdst + 8) = (u32x2){rv.z, rv.w};
    __syncthreads();
    float m_run = -INFINITY, l_run = 0.f;
    f32x16 o0, o1;
#pragma unroll
    for (int r = 0; r < 16; ++r) { o0[r] = 0.f; o1[r] = 0.f; }
    for (int kt = 0; kt < nkt; ++kt) {
        const int buf = kt & 1;
        if (kt + 1 < nkt) { rk = *(const u32x4*)(ksrc + (size_t)(kt + 1) * 64 * 512); rv = *(const u32x4*)(vsrc + (kt + 1) * 64); if (tid < 256) rp = *(const u32x4*)(psrc + (size_t)(kt + 1) * 64 * 32); }
        const int key0 = kt * 64;
        if (key0 <= q0 + 31) {
            const LAS unsigned char* kb = lds + buf * AT_KBUF + r32 * AT_KROW + hi * 16;
            f32x16 p0, p1;
#pragma unroll
            for (int r = 0; r < 16; ++r) { p0[r] = 0.f; p1[r] = 0.f; }
#pragma unroll
            for (int s = 0; s < 6; ++s) { const bf16x8 a0 = *(const LAS bf16x8*)(kb + s * 32), a1 = *(const LAS bf16x8*)(kb + 32 * AT_KROW + s * 32);
                p0 = MFMA32(a0, qf[s], p0); p1 = MFMA32(a1, qf[s], p1); }
            if (key0 + 63 > q0) {
#pragma unroll
                for (int r = 0; r < 16; ++r) { const int key = key0 + crow(r, hi); if (key > qi) p0[r] = -INFINITY; if (key + 32 > qi) p1[r] = -INFINITY; }
            }
            float mx = fmaxf(p0[0], p1[0]);
#pragma unroll
            for (int r = 1; r < 16; ++r) mx = fmaxf(mx, fmaxf(p0[r], p1[r]));
            mx = fmaxf(mx, __shfl_xor(mx, 32));
            const float m_new = fmaxf(m_run, mx);
            const float alpha = __builtin_amdgcn_exp2f(m_run - m_new);
            m_run = m_new;
            float ls = 0.f;
#pragma unroll
            for (int r = 0; r < 16; ++r) { p0[r] = __builtin_amdgcn_exp2f(p0[r] - m_new); p1[r] = __builtin_amdgcn_exp2f(p1[r] - m_new); ls += p0[r] + p1[r]; }
            l_run = l_run * alpha + ls;
#pragma unroll
            for (int r = 0; r < 16; ++r) { o0[r] *= alpha; o1[r] *= alpha; }
            bf16x8 pb[4];
#pragma unroll
            for (int s = 0; s < 4; ++s) { u32x4 w;
                if (s < 2) { w.x = pk2(p0[8 * s], p0[8 * s + 1]); w.y = pk2(p0[8 * s + 2], p0[8 * s + 3]); w.z = pk2(p0[8 * s + 4], p0[8 * s + 5]); w.w = pk2(p0[8 * s + 6], p0[8 * s + 7]); }
                else { const int s2 = s - 2; w.x = pk2(p1[8 * s2], p1[8 * s2 + 1]); w.y = pk2(p1[8 * s2 + 2], p1[8 * s2 + 3]); w.z = pk2(p1[8 * s2 + 4], p1[8 * s2 + 5]); w.w = pk2(p1[8 * s2 + 6], p1[8 * s2 + 7]); }
                pb[s] = __builtin_bit_cast(bf16x8, w); }
            const LAS unsigned char* vb = lds + AT_VOFF + buf * AT_VBUF + r32 * AT_VROW + hi * 8;
#pragma unroll
            for (int s = 0; s < 4; ++s) {
                const u32x2 a0l = *(const LAS u32x2*)(vb + s * 32), a0h = *(const LAS u32x2*)(vb + s * 32 + 16);
                const u32x2 a1l = *(const LAS u32x2*)(vb + 32 * AT_VROW + s * 32), a1h = *(const LAS u32x2*)(vb + 32 * AT_VROW + s * 32 + 16);
                const bf16x8 a0 = __builtin_bit_cast(bf16x8, (u32x4){a0l.x, a0l.y, a0h.x, a0h.y}), a1 = __builtin_bit_cast(bf16x8, (u32x4){a1l.x, a1l.y, a1h.x, a1h.y});
                o0 = MFMA32(a0, pb[s], o0); o1 = MFMA32(a1, pb[s], o1); }
        }
        if (kt + 1 < nkt) { const int nb = (kt + 1) & 1;
            *(LAS u32x4*)(lds + nb * AT_KBUF + kdst) = rk; if (tid < 256) *(LAS u32x4*)(lds + nb * AT_KBUF + pdst) = rp;
            *(LAS u32x2*)(lds + nb * AT_VBUF + vdst) = (u32x2){rv.x, rv.y}; *(LAS u32x2*)(lds + nb * AT_VBUF + vdst + 8) = (u32x2){rv.z, rv.w}; }
        __syncthreads();
    }
    const float lt = l_run + __shfl_xor(l_run, 32); const float inv = 1.0f / lt;
    bf16_t* op = O + (tokb + qi) * AW + h * AVD + 4 * hi;
#pragma unroll
    for (int g = 0; g < 4; ++g) { u32x2 w0, w1;
        w0.x = pk2(o0[4 * g] * inv, o0[4 * g + 1] * inv); w0.y = pk2(o0[4 * g + 2] * inv, o0[4 * g + 3] * inv);
        w1.x = pk2(o1[4 * g] * inv, o1[4 * g + 1] * inv); w1.y = pk2(o1[4 * g + 2] * inv, o1[4 * g + 3] * inv);
        *(u32x2*)(op + 8 * g) = w0; *(u32x2*)(op + 32 + 8 * g) = w1; }
}
DI void p4_attention(const Args& args, LAS unsigned char* lds, int vcu, int G) {
    unsigned char* ws = args.ws;
    const bf16_t* Q = (const bf16_t*)(ws + WS_QMLA); const bf16_t* Kn = (const bf16_t*)(ws + WS_KN); const bf16_t* Kpe = (const bf16_t*)(ws + WS_KPE); const bf16_t* Vt = (const bf16_t*)(ws + WS_VT);
    bf16_t* O = (bf16_t*)(ws + WS_AO);
    for (int p = vcu; p < NB * AH * 4; p += G) { const int bh = p >> 2, j = p & 3; const int b = bh / AH, h = bh % AH;
        mla_unit(b, h, 7 - j, Q, Kn, Kpe, Vt, O, lds);
        mla_unit(b, h, j, Q, Kn, Kpe, Vt, O, lds); }
}

constexpr int ML_QROW = 272, ML_TROW = 144;
constexpr int ML_QS = 0, ML_KS = ML_QS + 64 * ML_QROW, ML_KTS = ML_KS + 64 * ML_QROW, ML_VTS = ML_KTS + 128 * ML_TROW, ML_CS = ML_VTS + 32 * ML_TROW, ML_SS = ML_CS + 32 * ML_QROW,
              ML_VEC = ML_SS + 64 * ML_TROW;
static_assert(ML_VEC + (7 * 64 + 128 + 4) * 4 <= RING_BYTES, "mLSTM LDS");
DI void mlstm_unit(int b, int h, int vs, const Args& args, LAS unsigned char* lds) {
    unsigned char* ws = args.ws;
    const bf16_t* qkm = (const bf16_t*)(ws + WS_QKM); const bf16_t* ktm = (const bf16_t*)(ws + WS_KTM); const bf16_t* proj = (const bf16_t*)(ws + WS_PROJ);
    const float* gates = (const float*)(ws + WS_GATES); float* hraw = (float*)(ws + WS_HRAW);
    const float b_i = ((const float*)args.in[4])[h], b_f = ((const float*)args.in[5])[h];
    int tid = threadIdx.x; asm volatile("" : "+v"(tid)); const int lane = tid & 63, r32 = lane & 31, hi = lane >> 5; const int wid = __builtin_amdgcn_readfirstlane(tid >> 6);
    LAS float* ROWT = (LAS float*)(lds + ML_VEC); LAS float* COLT = ROWT + 64; LAS float* WINT = ROWT + 128; LAS float* ENEG = ROWT + 192; LAS float* WAS = ROWT + 256;
    LAS float* NQ = ROWT + 320; LAS float* DINV = ROWT + 384; LAS float* NVEC = ROWT + 448; LAS float* SCAL = ROWT + 576;
    const size_t tokb = (size_t)b * SEQ;
    for (int i = tid; i < 32 * ML_QROW / 4; i += 512) ((LAS unsigned*)(lds + ML_CS))[i] = 0u;
    if (tid < 128) NVEC[tid] = 0.f;
    f32x16 cacc;
#pragma unroll
    for (int r = 0; r < 16; ++r) cacc[r] = 0.f;
    float m_st = 0.f;
    u32x4 sq[2], sk[2], skt[2], sv; float gi = 0.f, gf = 0.f;
    sv = (u32x4){0u, 0u, 0u, 0u};
#define ML_LOAD(c) do { const size_t tok0 = tokb + (size_t)(c) * MCH; \
        _Pragma("unroll") for (int i = 0; i < 2; ++i) { const int idx = tid + 512 * i; \
            sq[i] = *(const u32x4*)(qkm + (tok0 + (idx >> 4)) * 1024 + h * MHD + (idx & 15) * 8); \
            sk[i] = *(const u32x4*)(qkm + (tok0 + (idx >> 4)) * 1024 + 512 + h * MHD + (idx & 15) * 8); \
            skt[i] = *(const u32x4*)(ktm + (size_t)(h * MHD + (idx >> 3)) * T + tok0 + (idx & 7) * 8); } \
        if (tid < 256) sv = *(const u32x4*)(proj + (tok0 + (tid >> 2)) * NPROJ + PC_VM + h * MHD + vs * 32 + (tid & 3) * 8); \
        if (wid == 0) { gi = gates[(tok0 + lane) * 8 + h]; gf = gates[(tok0 + lane) * 8 + 4 + h]; } } while (0)
    ML_LOAD(0);
    for (int c = 0; c < SEQ / MCH; ++c) {
        const size_t tok0 = tokb + (size_t)c * MCH;
#pragma unroll
        for (int i = 0; i < 2; ++i) { const int idx = tid + 512 * i;
            *(LAS u32x4*)(lds + ML_QS + (idx >> 4) * ML_QROW + (idx & 15) * 16) = sq[i];
            *(LAS u32x4*)(lds + ML_KS + (idx >> 4) * ML_QROW + (idx & 15) * 16) = sk[i];
            *(LAS u32x4*)(lds + ML_KTS + (idx >> 3) * ML_TROW + (idx & 7) * 16) = skt[i]; }
        if (tid < 256) { const int l = tid >> 2, v0 = (tid & 3) * 8; LAS bf16_t* vt = (LAS bf16_t*)(lds + ML_VTS);
            vt[(v0 + 0) * (ML_TROW / 2) + l] = (bf16_t)(sv.x & 0xffff); vt[(v0 + 1) * (ML_TROW / 2) + l] = (bf16_t)(sv.x >> 16);
            vt[(v0 + 2) * (ML_TROW / 2) + l] = (bf16_t)(sv.y & 0xffff); vt[(v0 + 3) * (ML_TROW / 2) + l] = (bf16_t)(sv.y >> 16);
            vt[(v0 + 4) * (ML_TROW / 2) + l] = (bf16_t)(sv.z & 0xffff); vt[(v0 + 5) * (ML_TROW / 2) + l] = (bf16_t)(sv.z >> 16);
            vt[(v0 + 6) * (ML_TROW / 2) + l] = (bf16_t)(sv.w & 0xffff); vt[(v0 + 7) * (ML_TROW / 2) + l] = (bf16_t)(sv.w >> 16); }
        if (wid == 0) {
            const float xf = gf + b_f;
            const float lf = (xf >= 0.f) ? -log1pf(__expf(-xf)) : xf - log1pf(__expf(xf));
            float bb = lf;
#pragma unroll
            for (int o = 1; o < 64; o <<= 1) { const float tv = __shfl_up(bb, o); if (lane >= o) bb += tv; }
            const float btot = __shfl(bb, 63);
            const float ig = gi + b_i;
            const float a = btot - bb + ig;
            const float mchunk = wave_max(a);
            const float wa = __expf(a - mchunk);
            const float u = ig - bb;
            float pm = u;
#pragma unroll
            for (int o = 1; o < 64; o <<= 1) { const float tv = __shfl_up(pm, o); if (lane >= o) pm = fmaxf(pm, tv); }
            const float mintra = bb + pm;
            const float ginter = bb + m_st;
            const float m = fmaxf(ginter, mintra);
            const float mnew = fmaxf(btot + m_st, mchunk);
            const float sold = __expf(btot + m_st - mnew), snew = __expf(mchunk - mnew);
            ROWT[lane] = bb - m; COLT[lane] = u; WINT[lane] = __expf(ginter - m); ENEG[lane] = __expf(-m); WAS[lane] = snew * wa;
            if (lane == 0) SCAL[0] = sold;
            m_st = mnew;
        }
        __syncthreads();
        if (c + 1 < SEQ / MCH) ML_LOAD(c + 1);
        f32x16 iacc;
#pragma unroll
        for (int r = 0; r < 16; ++r) iacc[r] = 0.f;
        if (wid < 4) {
            const int jb = wid >> 1, sb = wid & 1;
            LAS bf16_t* ss = (LAS bf16_t*)(lds + ML_SS);
            if (sb <= jb) {
                f32x16 s;
#pragma unroll
                for (int r = 0; r < 16; ++r) s[r] = 0.f;
                const LAS unsigned char* qa = lds + ML_QS + (32 * jb + r32) * ML_QROW + hi * 16; const LAS unsigned char* kb = lds + ML_KS + (32 * sb + r32) * ML_QROW + hi * 16;
#pragma unroll
                for (int kk = 0; kk < 8; ++kk) s = MFMA32(*(const LAS bf16x8*)(qa + kk * 32), *(const LAS bf16x8*)(kb + kk * 32), s);
                const int sidx = 32 * sb + r32; const float ct = COLT[sidx];
#pragma unroll
                for (int r = 0; r < 16; ++r) { const int j = 32 * jb + crow(r, hi);
                    const float val = (sidx <= j) ? s[r] * __expf(ROWT[j] + ct) : 0.f;
                    ss[j * (ML_TROW / 2) + sidx] = (bf16_t)f2bf(val); }
            } else {
#pragma unroll
                for (int r = 0; r < 16; ++r) ss[(32 * jb + crow(r, hi)) * (ML_TROW / 2) + 32 * sb + r32] = (bf16_t)0;
            }
        } else if (wid < 6) {
            const int jb = wid - 4;
            const LAS unsigned char* qa = lds + ML_QS + (32 * jb + r32) * ML_QROW + hi * 16; const LAS unsigned char* cb = lds + ML_CS + r32 * ML_QROW + hi * 16;
#pragma unroll
            for (int kk = 0; kk < 8; ++kk) iacc = MFMA32(*(const LAS bf16x8*)(qa + kk * 32), *(const LAS bf16x8*)(cb + kk * 32), iacc);
        } else {
            const int j = 32 * (wid - 6) + (lane >> 1), half = lane & 1;
            const LAS unsigned char* qa = lds + ML_QS + j * ML_QROW + half * 128; float acc = 0.f;
#pragma unroll
            for (int i = 0; i < 8; ++i) { const u32x4 w = *(const LAS u32x4*)(qa + i * 16); const f32x4 n0 = *(const LAS f32x4*)(NVEC + half * 64 + i * 8), n1 = *(const LAS f32x4*)(NVEC + half * 64 + i * 8 + 4);
                acc += bflo(w.x) * n0[0] + bfhi(w.x) * n0[1] + bflo(w.y) * n0[2] + bfhi(w.y) * n0[3] + bflo(w.z) * n1[0] + bfhi(w.z) * n1[1] + bflo(w.w) * n1[2] + bfhi(w.w) * n1[3]; }
            acc += __shfl_xor(acc, 1);
            if (half == 0) NQ[j] = acc;
        }
        __syncthreads();
        if (wid < 4) {
            const float sold = SCAL[0];
#pragma unroll
            for (int r = 0; r < 16; ++r) cacc[r] *= sold;
            const LAS unsigned char* va = lds + ML_VTS + r32 * ML_TROW + hi * 16; const LAS unsigned char* kb = lds + ML_KTS + (32 * wid + r32) * ML_TROW + hi * 16;
#pragma unroll
            for (int kk = 0; kk < 4; ++kk) { const u32x4 w = *(const LAS u32x4*)(va + kk * 32);
                const f32x4 w0 = *(const LAS f32x4*)(WAS + 16 * kk + 8 * hi), w1 = *(const LAS f32x4*)(WAS + 16 * kk + 8 * hi + 4);
                u32x4 sa; sa.x = pk2(bflo(w.x) * w0[0], bfhi(w.x) * w0[1]); sa.y = pk2(bflo(w.y) * w0[2], bfhi(w.y) * w0[3]); sa.z = pk2(bflo(w.z) * w1[0], bfhi(w.z) * w1[1]); sa.w = pk2(bflo(w.w) * w1[2], bfhi(w.w) * w1[3]);
                cacc = MFMA32(__builtin_bit_cast(bf16x8, sa), *(const LAS bf16x8*)(kb + kk * 32), cacc); }
            LAS bf16_t* cs = (LAS bf16_t*)(lds + ML_CS);
#pragma unroll
            for (int r = 0; r < 16; ++r) cs[crow(r, hi) * (ML_QROW / 2) + 32 * wid + r32] = (bf16_t)f2bf(cacc[r]);
        } else if (wid < 6) {
            const int jb = wid - 4;
#pragma unroll
            for (int r = 0; r < 16; ++r) iacc[r] *= WINT[32 * jb + crow(r, hi)];
            const LAS unsigned char* sa = lds + ML_SS + (32 * jb + r32) * ML_TROW + hi * 16; const LAS unsigned char* vb = lds + ML_VTS + r32 * ML_TROW + hi * 16;
#pragma unroll
            for (int kk = 0; kk < 4; ++kk) iacc = MFMA32(*(const LAS bf16x8*)(sa + kk * 32), *(const LAS bf16x8*)(vb + kk * 32), iacc);
        } else {
            const int tl = (wid - 6) * 64 + lane;
            { const int j = tl >> 1, half = tl & 1; const LAS unsigned char* sp = lds + ML_SS + j * ML_TROW + half * 64; float rs = 0.f;
#pragma unroll
              for (int i = 0; i < 4; ++i) { const u32x4 w = *(const LAS u32x4*)(sp + i * 16); rs += (bflo(w.x) + bfhi(w.x)) + (bflo(w.y) + bfhi(w.y)) + (bflo(w.z) + bfhi(w.z)) + (bflo(w.w) + bfhi(w.w)); }
              rs += __shfl_xor(rs, 1);
              if (half == 0) { const float den = WINT[j] * NQ[j] + rs; DINV[j] = 1.0f / fmaxf(fabsf(den), ENEG[j]); } }
            { const int k = tl; const LAS unsigned char* kp = lds + ML_KTS + k * ML_TROW; float acc = SCAL[0] * NVEC[k];
#pragma unroll
              for (int i = 0; i < 8; ++i) { const u32x4 w = *(const LAS u32x4*)(kp + i * 16); const f32x4 w0 = *(const LAS f32x4*)(WAS + i * 8), w1 = *(const LAS f32x4*)(WAS + i * 8 + 4);
                  acc += bflo(w.x) * w0[0] + bfhi(w.x) * w0[1] + bflo(w.y) * w0[2] + bfhi(w.y) * w0[3] + bflo(w.z) * w1[0] + bfhi(w.z) * w1[1] + bflo(w.w) * w1[2] + bfhi(w.w) * w1[3]; }
              NVEC[k] = acc; }
        }
        __syncthreads();
        if (wid == 4 || wid == 5) {
            const int jb = wid - 4; float* hp = hraw + (tok0 + 32 * jb) * MW + h * MHD + vs * 32 + r32;
#pragma unroll
            for (int r = 0; r < 16; ++r) { const int j = crow(r, hi); hp[(size_t)j * MW] = iacc[r] * DINV[32 * jb + j]; }
        }
    }
#undef ML_LOAD
    __syncthreads();
}
DI void p5_mlstm(const Args& args, LAS unsigned char* lds, int vcu, int G) {
    for (int u = vcu; u < NB * MH * 4; u += G) { const int vs = u & 3, bh = u >> 2; mlstm_unit(bh / MH, bh % MH, vs, args, lds); }
}
#ifndef MK_ONE_LAUNCH
#define MK_ONE_LAUNCH 1
#endif
#ifndef P3SEL
#define P3SEL 31
#endif
constexpr int NPH = 20;
__global__ void __launch_bounds__(NWAVES * 64, 2) fwd_kernel(Args args) {
    extern __shared__ __attribute__((aligned(16))) unsigned char lds_raw[];
    LAS unsigned char* lds = (LAS unsigned char*)lds_raw;
    const int tid = threadIdx.x;
    const int G = gridDim.x; const int bx = blockIdx.x; const int vcu = (G % 8 == 0) ? (bx % 8) * (G / 8) + bx / 8 : bx;
    unsigned char* ws = args.ws;
    for (int u = tid; u < (LDS_BYTES - LDSCTL_OFF) / 4; u += NWAVES * 64) ((LAS unsigned*)(lds + LDSCTL_OFF))[u] = 0u;
    __syncthreads();
    volatile LAS unsigned* MISC = (volatile LAS unsigned*)(lds + MISC_OFF);
    XcdBarrier bar; bar.bar = (unsigned*)(ws + WS_CTL) + CW_BAR; bar.x = 0; bar.st = nullptr;
    const int lo = args.ph_lo, hi = args.ph_hi;
    if (hi - lo > 1) bar = xcd_barrier_post((unsigned*)(ws + WS_CTL) + CW_BAR, MISC + 8);
#ifndef PHASE_MASK
#define PHASE_MASK 0xFFFFFu
#endif
#define IN(k) (((PHASE_MASK >> (k)) & 1u) && lo <= (k) && (k) < hi)
#define SEAM(k) do { if (IN(k) && IN((k) + 1)) xcd_barrier(bar); } while (0)
    using namespace pg8;
    LAS unsigned char* ring = lds + RING_OFF;
    const bf16_t* cws = (const bf16_t*)ws;
#define WSB(off) ((bf16_t*)(ws + (off)))
#define WSF(off) ((float*)(ws + (off)))

    if (IN(0)) { p0_prologue(args, lds, vcu, G); }
    SEAM(0);
    if (IN(1)) {
        { DenseOrder S; S.init(WSB(WS_XB), WSB(WS_W_IN), T, NPROJ, D, D, G, bx); EpiProj E{WSB(WS_PROJ), WSF(WS_GATES)}; gemm_phase(ring, D, D, D, S, E); }
        { DenseOrder S; S.init(WSB(WS_MEMB), WSB(WS_W_CK), NB * NMEM, D, D, D, G, bx); EpiBf16 E{WSB(WS_KC), D, 1 << 30, 1.f}; gemm_phase(ring, D, D, D, S, E); }
        { DenseOrder S; S.init(WSB(WS_W_CV), WSB(WS_MEMB), D, NB * NMEM, D, D, G, bx); EpiBf16 E{WSB(WS_VCT), NB * NMEM, 1 << 30, 1.f}; gemm_phase(ring, D, D, D, S, E); }
    }
    SEAM(1);
    if (IN(2)) { p2_tokens(args, vcu, G); }
    SEAM(2);
    if (IN(3)) {
        if (P3SEL & 1) { DenseOrder S; S.init(WSB(WS_QN), WSB(WS_W_UQ), T, AH * AQK, 256, 256, G, bx); EpiQmla E{WSB(WS_QMLA), WSF(WS_CS), 0.10206207261596575f * 1.4426950408889634f}; gemm_phase(ring, 256, 256, 256, S, E); }
        if (P3SEL & 2) { DenseOrder S; S.init(WSB(WS_KVN), WSB(WS_W_UK), T, 512, 256, 256, G, bx); EpiBf16 E{WSB(WS_KN), 512, 1 << 30, 1.f}; gemm_phase(ring, 256, 256, 256, S, E); }
        if (P3SEL & 4) { DenseOrder S; S.init(WSB(WS_W_UV), WSB(WS_KVN), 512, T, 256, 256, G, bx); EpiBf16 E{WSB(WS_VT), T, 1 << 30, 1.f}; gemm_phase(ring, 256, 256, 256, S, E); }
        if (P3SEL & 8) { DenseOrder S; S.init(WSB(WS_XC), WSB(WS_W_MQK), T, 1024, 512, 512, G, bx); EpiBf16 E{WSB(WS_QKM), 1024, 2, 0.08838834764831845f}; gemm_phase(ring, 512, 512, 512, S, E); }
        if (P3SEL & 16) { DenseOrder S; S.init(WSB(WS_W_MQK) + 512 * 512, WSB(WS_XC), 512, T, 512, 512, G, bx); EpiBf16 E{WSB(WS_KTM), T, 0, 0.08838834764831845f}; gemm_phase(ring, 512, 512, 512, S, E); }
    }
    SEAM(3);
    if (IN(4)) { p5_mlstm(args, lds, vcu, G); p4_attention(args, lds, vcu, G); }
    SEAM(4);
    if (IN(5)) { p6_mpost(args, vcu, G); }
    SEAM(5);
    if (IN(6)) {
        { DenseOrder S; S.init(WSB(WS_HM), WSB(WS_W_BRM), T, D, 512, 512, G, bx); EpiGate<false> E{WSB(WS_GATED), WSB(WS_PROJ), PC_GM}; gemm_phase(ring, 512, 512, 512, S, E); }
        { DenseOrder S; S.init(WSB(WS_AO), WSB(WS_W_BRA), T, D, 512, 512, G, bx); EpiGate<true> E{WSB(WS_GATED), WSB(WS_PROJ), PC_GA}; gemm_phase(ring, 512, 512, 512, S, E); }
    }
    SEAM(6);
    if (IN(7)) { DenseOrder S; S.init(WSB(WS_GATED), WSB(WS_W_MIX), T, D, D, D, G, bx); EpiF32 E{WSF(WS_MIXO), D, 1 << 30}; gemm_phase(ring, D, D, D, S, E); }
    SEAM(7);
    if (IN(8)) { ln_pass((const float*)args.in[0], WSF(WS_MIXO), (const float*)args.in[19], (const float*)args.in[20], args.out, WSB(WS_H1B), vcu, G); }
    SEAM(8);
    if (IN(9)) { DenseOrder S; S.init(WSB(WS_H1B), WSB(WS_W_CQ), T, D, D, D, G, bx); EpiBf16 E{WSB(WS_QC), D, 0, 0.0625f * 1.4426950408889634f}; gemm_phase(ring, D, D, D, S, E); }
    SEAM(9);
    if (IN(10)) { CrossSOrder S{(const char*)(ws + WS_QC), (const char*)(ws + WS_KC), G, vcu}; EpiSoftmax E{WSB(WS_PC), (LAS float*)(lds + RED_OFF)}; gemm_phase(ring, 256, D, D, S, E); }
    SEAM(10);
    if (IN(11)) { CrossOOrder S{(const char*)(ws + WS_PC), (const char*)(ws + WS_VCT), G, vcu}; EpiBf16 E{WSB(WS_OC), D, 1 << 30, 1.f}; gemm_phase(ring, 256, D, NB * NMEM, S, E); }
    SEAM(11);
    if (IN(12)) { DenseOrder S; S.init(WSB(WS_OC), WSB(WS_W_CO), T, D, D, D, G, bx); EpiF32 E{WSF(WS_COO), D, 1 << 30}; gemm_phase(ring, D, D, D, S, E); }
    SEAM(12);
    if (IN(13)) { ln_pass(args.out, WSF(WS_COO), (const float*)args.in[24], (const float*)args.in[25], args.out, WSB(WS_H2B), vcu, G); }
    SEAM(13);
    if (IN(14)) { DenseOrder S; S.init(WSB(WS_H2B), WSB(WS_W_R), T, 256, D, D, G, bx); EpiF32 E{WSF(WS_LOGITS), NE, NE}; gemm_phase(ring, D, D, D, S, E); }
    SEAM(14);
    if (IN(15)) { p16_topk(args, lds, vcu, G); }
    SEAM(15);
    if (IN(16)) { p17_gather(args, lds, vcu, G); }
    SEAM(16);
    if (IN(17)) { build_tstart(args, lds);
        MoeOrder S{(const char*)(ws + WS_XG), (const char*)(ws + WS_W_GU), (const LAS int*)(lds + TST_OFF), 8, G, vcu, (size_t)256 * D * 2, (size_t)2048 * 1024 * 2};
        EpiSwiglu E{WSB(WS_ACT), (const float*)args.in[29]}; gemm_phase(ring, D, D, D, S, E); }
    SEAM(17);
    if (IN(18)) { build_tstart(args, lds);
        MoeOrder S{(const char*)(ws + WS_ACT), (const char*)(ws + WS_W_DN), (const LAS int*)(lds + TST_OFF), 4, G, vcu, (size_t)256 * D * 2, (size_t)1024 * 1024 * 2};
        EpiDown E{WSB(WS_YB), (const float*)args.in[31], WSF(WS_ROWGATE)}; gemm_phase(ring, D, D, D, S, E); }
    SEAM(18);
    if (IN(19)) { p20_final(args, vcu, G); }
    (void)cws;
#undef IN
#undef SEAM
}

extern "C" void kernel_launch(void* const* d_in, const int* in_sizes, int n_in, void* d_out, int out_size, void* d_ws, size_t ws_size, hipStream_t stream) {
    static int grid = 0;
    if (grid == 0) {
        if (n_in != 34 || in_sizes[0] != T * D || out_size != T * D || ws_size < WS_END) { fprintf(stderr, "kernel_launch: unexpected shapes / workspace (n_in %d, ws %zu)\n", n_in, ws_size); grid = -1; return; }
        int dev = 0, cus = 0, per_cu = 0;
        if (hipGetDevice(&dev) != hipSuccess || hipDeviceGetAttribute(&cus, hipDeviceAttributeMultiprocessorCount, dev) != hipSuccess) { grid = -1; return; }
        if (hipFuncSetAttribute((const void*)fwd_kernel, hipFuncAttributeMaxDynamicSharedMemorySize, LDS_BYTES) != hipSuccess) { fprintf(stderr, "kernel_launch: hipFuncSetAttribute failed\n"); grid = -1; return; }
        if (hipOccupancyMaxActiveBlocksPerMultiprocessor(&per_cu, (const void*)fwd_kernel, NWAVES * 64, LDS_BYTES) != hipSuccess || per_cu < 1) fprintf(stderr, "kernel_launch: occupancy query says %d\n", per_cu);
        (void)hipGetLastError();
        grid = cus;
    }
    if (grid < 0) return;
    if (hipMemsetAsync((char*)d_ws + WS_CTL, 0, CTL_ZERO_BYTES, stream) != hipSuccess) return;
    Args a{};
    for (int i = 0; i < 34; ++i) a.in[i] = d_in[i];
    a.out = (float*)d_out; a.ws = (unsigned char*)d_ws;
#if MK_ONE_LAUNCH
    a.ph_lo = 0; a.ph_hi = NPH;
    hipLaunchKernelGGL(fwd_kernel, dim3(grid), dim3(NWAVES * 64), LDS_BYTES, stream, a);
#else
    for (int p = 0; p < NPH; ++p) { a.ph_lo = p; a.ph_hi = p + 1; hipLaunchKernelGGL(fwd_kernel, dim3(grid), dim3(NWAVES * 64), LDS_BYTES, stream, a); }
#endif
}
```

```cpp
#include <hip/hip_runtime.h>
#include <cstdio>
#include <cstdint>
#include <cmath>

#define LAS __attribute__((address_space(3)))
#define GAS __attribute__((address_space(1)))
typedef unsigned short bf16_t;
typedef short bf16x8 __attribute__((ext_vector_type(8)));
typedef float f32x4 __attribute__((ext_vector_type(4)));
typedef float f32x2 __attribute__((ext_vector_type(2)));
typedef float f32x16 __attribute__((ext_vector_type(16)));
typedef unsigned u32x4 __attribute__((ext_vector_type(4)));
typedef unsigned u32x2 __attribute__((ext_vector_type(2)));
typedef GAS unsigned gu32;
#define RLX_AGENT __ATOMIC_RELAXED, __HIP_MEMORY_SCOPE_AGENT
#define DI __device__ __forceinline__

constexpr int D = 1024, NB = 16, SEQ = 2048, T = NB * SEQ, NMEM = 256;
constexpr int MH = 4, MHD = 128, MW = 512, MCH = 64;
constexpr int AH = 8, ANOPE = 64, AROPE = 32, AQK = 96, AVD = 64, AW = 512, AQR = 256, AKVR = 128;
constexpr int XH = 4, XHD = 256;
constexpr int NE = 32, TOPK = 4;
constexpr int DIN = 4008, NPROJ = 4096;
constexpr float DN_ALPHA = 1.189207115002721f;
constexpr float EPS = 1e-5f;
constexpr int NASSIGN = T * TOPK;
constexpr int NROWS = NASSIGN + NE * 256;
constexpr int NTILES_MAX = NROWS / 256;
constexpr int PC_QLAT = 0, PC_KVLAT = 256, PC_KROPE = 384, PC_IG = 416, PC_FG = 420, PC_XM = 512, PC_VM = 1024, PC_OP = 1536, PC_GM = 2048, PC_GA = 3072;

DI unsigned f2bf(float f) { unsigned u = __builtin_bit_cast(unsigned, f); return (u + 0x7fffu + ((u >> 16) & 1u)) >> 16; }
DI unsigned pk2(float lo, float hi) { return f2bf(lo) | (f2bf(hi) << 16); }
DI float bf2f(unsigned short b) { return __builtin_bit_cast(float, (unsigned)b << 16); }
DI float bflo(unsigned w) { return __builtin_bit_cast(float, w << 16); }
DI float bfhi(unsigned w) { return __builtin_bit_cast(float, w & 0xffff0000u); }
DI float wave_sum(float v) {
#pragma unroll
    for (int o = 1; o < 64; o <<= 1) v += __shfl_xor(v, o);
    return v;
}
DI float wave_max(float v) {
#pragma unroll
    for (int o = 1; o < 64; o <<= 1) v = fmaxf(v, __shfl_xor(v, o));
    return v;
}
DI float sigmoidf_(float x) { return 1.0f / (1.0f + __expf(-x)); }
DI int crow(int r, int hi) { return (r & 3) + 8 * (r >> 2) + 4 * hi; }
#define MFMA32(a, b, c) __builtin_amdgcn_mfma_f32_32x32x16_bf16((a), (b), (c), 0, 0, 0)

namespace pg8 {
constexpr int BM = 256, BK = 64, HALF = 128, HTB = HALF * BK * 2, STAGE_BYTES = 8 * HTB;
__host__ __device__ __forceinline__ int lds_byte(int r, int c) { const int st = (r >> 4) * 2 + (c >> 5), rr = r & 15, cc = c & 31, ob = rr * 64 + cc * 2; return st * 1024 + (ob ^ (((ob >> 9) & 1) << 5)); }
__host__ __device__ __forceinline__ void stage_rc(int b, int& R, int& C) { const int st = b / 1024, sb = b % 1024, swz = sb ^ (((sb >> 9) & 1) << 5); R = (st >> 1) * 16 + swz / 64; C = (st & 1) * 32 + (swz % 64) / 2; }
__host__ __device__ __forceinline__ int perm32(int rho) { const int n = rho >> 4, i = rho & 15; return 8 * (i >> 2) + 4 * n + (i & 3); }

struct Unit { int pm, pn, aux; const char* a; const char* b; };
struct Ctx { int wr, wc, fr, fq, wid, lane; };

DI unsigned cvt_pk_bf16(float lo, float hi) { unsigned r; asm volatile("v_cvt_pk_bf16_f32 %0, %1, %2" : "=v"(r) : "v"(lo), "v"(hi)); return r; }

typedef f32x4 Acc[2][2][4][2];

template <class Epi, class Sched>
DI void gemm_phase(LAS unsigned char* lds, const int K, const int lda, const int ldb, const Sched& S, const Epi& E) {
    int tid = threadIdx.x; asm volatile("" : "+v"(tid));
    const int wid = __builtin_amdgcn_readfirstlane(tid >> 6), lane = tid & 63, wr = wid >> 2, wc = wid & 3, fr = lane & 15, fq = lane >> 4;
    const int nt = K / BK;
    unsigned voffA[2], voffB[2];
#pragma unroll
    for (int i = 0; i < 2; ++i) { int R, C; stage_rc(tid * 16 + i * 8192, R, C); const int Rb = Epi::PERM ? ((R & ~31) + perm32(R & 31)) : R;
        voffA[i] = (unsigned)(R * lda + C) * 2u; voffB[i] = (unsigned)(Rb * ldb + C) * 2u; }
    const size_t kstep = (size_t)(BK * 2);
    const size_t hstepA = (size_t)HALF * lda * 2, hstepB = (size_t)HALF * ldb * 2;
    const unsigned ldsw = (unsigned)wid * 1024u;
    const int aoff = lds_byte(wr * 64 + fr, fq * 8), boff = lds_byte(wc * 32 + fr, fq * 8);
    const Ctx cx{wr, wc, fr, fq, wid, lane};
#define PG8_SA(b, h) (((b) * 2 + (h)) * HTB)
#define PG8_SB(b, h) ((4 + (b) * 2 + (h)) * HTB)
#define PG8_STAGE(bufoff, gbase, voff) do { _Pragma("unroll") for (int _i = 0; _i < 2; ++_i) \
        __builtin_amdgcn_global_load_lds((const unsigned*)((const char*)(gbase) + (voff)[_i]), (LAS unsigned*)(lds + (bufoff) + ldsw + _i * 8192), 16, 0, 0); } while (0)
#define PG8_LDA(dst, b, h) do { _Pragma("unroll") for (int m = 0; m < 4; ++m) _Pragma("unroll") for (int k = 0; k < 2; ++k) dst[m][k] = *(const LAS bf16x8*)(lds + PG8_SA(b, h) + aoff + m * 2048 + k * 1024); } while (0)
#define PG8_LDB(dst, b, h) do { _Pragma("unroll") for (int n = 0; n < 2; ++n) _Pragma("unroll") for (int k = 0; k < 2; ++k) dst[n][k] = *(const LAS bf16x8*)(lds + PG8_SB(b, h) + boff + n * 2048 + k * 1024); } while (0)
#define PG8_MMA(ai, bj, At, Bt) do { __builtin_amdgcn_s_setprio(1); _Pragma("unroll") for (int m = 0; m < 4; ++m) _Pragma("unroll") for (int n = 0; n < 2; ++n) _Pragma("unroll") for (int k = 0; k < 2; ++k) \
        acc[ai][bj][m][n] = __builtin_amdgcn_mfma_f32_16x16x32_bf16(Bt[n][k], At[m][k], acc[ai][bj][m][n], 0, 0, 0); __builtin_amdgcn_s_setprio(0); } while (0)
#define PG8_WAIT_V(n) asm volatile("s_waitcnt vmcnt(" #n ")" ::: "memory")
#define PG8_WAIT_L(n) asm volatile("s_waitcnt lgkmcnt(" #n ")" ::: "memory")
#define PG8_BAR __builtin_amdgcn_s_barrier()
#define PG8_SCHED __builtin_amdgcn_sched_barrier(0)
    Unit cur, nxt; int ui = 0;
    if (!S.next(0, cur)) return;
    Acc acc;
#pragma unroll
    for (int a = 0; a < 2; ++a)
#pragma unroll
        for (int b = 0; b < 2; ++b)
#pragma unroll
            for (int m = 0; m < 4; ++m)
#pragma unroll
                for (int n = 0; n < 2; ++n) acc[a][b][m][n] = (f32x4){0.f, 0.f, 0.f, 0.f};
    bf16x8 At[4][2], B0[2][2], B1[2][2];
    const char* cA = cur.a; const char* cB = cur.b;
    PG8_STAGE(PG8_SB(0, 0), cB, voffB); PG8_STAGE(PG8_SB(0, 1), cB + hstepB, voffB); PG8_STAGE(PG8_SA(0, 0), cA, voffA); PG8_STAGE(PG8_SA(0, 1), cA + hstepA, voffA);
    if (wr == 1) PG8_BAR;
    PG8_WAIT_V(2); PG8_BAR;
    PG8_STAGE(PG8_SB(1, 0), cB + kstep, voffB); PG8_STAGE(PG8_SA(1, 0), cA + kstep, voffA); PG8_STAGE(PG8_SB(1, 1), cB + hstepB + kstep, voffB);
    PG8_WAIT_V(6); PG8_BAR;
    for (;;) {
        const bool has_next = S.next(ui + 1, nxt);
        const char* nA = has_next ? nxt.a : cA; const char* nB = has_next ? nxt.b : cB;
#pragma unroll 1
        for (int t = 0; t < nt; t += 2) {
            const bool last = (t == nt - 2);
            const char* a1 = cA + (size_t)(t + 1) * kstep;
            const char* a2 = last ? nA : cA + (size_t)(t + 2) * kstep; const char* b2 = last ? nB : cB + (size_t)(t + 2) * kstep;
            const char* a3 = a2 + kstep; const char* b3 = b2 + kstep;
            PG8_LDB(B0, 0, 0); PG8_LDB(B1, 0, 1); PG8_SCHED; PG8_LDA(At, 0, 0); PG8_STAGE(PG8_SA(1, 1), a1 + hstepA, voffA);
            PG8_WAIT_V(8); PG8_WAIT_L(0); PG8_BAR; PG8_MMA(0, 0, At, B0); PG8_MMA(0, 1, At, B1); PG8_BAR; PG8_SCHED;
            PG8_LDA(At, 0, 1); PG8_STAGE(PG8_SB(0, 0), b2, voffB); PG8_STAGE(PG8_SB(0, 1), b2 + hstepB, voffB); PG8_STAGE(PG8_SA(0, 0), a2, voffA);
            PG8_WAIT_V(8); PG8_WAIT_L(0); PG8_BAR; PG8_MMA(1, 0, At, B0); PG8_MMA(1, 1, At, B1); PG8_BAR; PG8_SCHED;
            PG8_LDB(B0, 1, 0); PG8_LDB(B1, 1, 1); PG8_SCHED; PG8_LDA(At, 1, 0); PG8_STAGE(PG8_SA(0, 1), a2 + hstepA, voffA);
            PG8_WAIT_V(8); PG8_WAIT_L(0); PG8_BAR; PG8_MMA(0, 0, At, B0); PG8_MMA(0, 1, At, B1); PG8_BAR; PG8_SCHED;
            PG8_LDA(At, 1, 1); PG8_STAGE(PG8_SB(1, 0), b3, voffB); PG8_STAGE(PG8_SB(1, 1), b3 + hstepB, voffB); PG8_STAGE(PG8_SA(1, 0), a3, voffA);
            PG8_WAIT_V(8); PG8_WAIT_L(0); PG8_BAR; PG8_MMA(1, 0, At, B0); PG8_MMA(1, 1, At, B1); PG8_BAR; PG8_SCHED;
        }
        if (wr == 0) PG8_BAR;
        E(acc, cur, cx);
        if (!has_next) break;
#pragma unroll
        for (int a = 0; a < 2; ++a)
#pragma unroll
            for (int b = 0; b < 2; ++b)
#pragma unroll
                for (int m = 0; m < 4; ++m)
#pragma unroll
                    for (int n = 0; n < 2; ++n) acc[a][b][m][n] = (f32x4){0.f, 0.f, 0.f, 0.f};
        cur = nxt; cA = nA; cB = nB; ++ui;
        if (wr == 1) PG8_BAR;
    }
    PG8_WAIT_V(0);
    PG8_BAR;
#undef PG8_SA
#undef PG8_SB
#undef PG8_STAGE
#undef PG8_LDA
#undef PG8_LDB
#undef PG8_MMA
#undef PG8_WAIT_V
#undef PG8_WAIT_L
#undef PG8_BAR
#undef PG8_SCHED
}
}
namespace pg8 {
constexpr int NXCD = 8, WGM = 8;
struct DenseOrder {
    const char* A; const char* B; int nM, nN, nwg, G, c; size_t strideA, strideB;
    DI void init(const void* A_, const void* B_, int M, int N, int lda, int ldb, int G_, int c_) { A = (const char*)A_; B = (const char*)B_; nM = M / BM; nN = N / BM; nwg = nM * nN; G = G_; c = c_;
        strideA = (size_t)BM * lda * 2; strideB = (size_t)BM * ldb * 2; }
    DI bool next(int i, Unit& u) const {
        const long L = (long)i * G + c; if (L >= nwg) return false;
        int wgid = (int)L; { const int q = nwg / NXCD, r = nwg % NXCD, xcd = wgid % NXCD, off = wgid / NXCD; wgid = (xcd < r ? xcd * (q + 1) : r * (q + 1) + (xcd - r) * q) + off; }
        const int nig = WGM * nN, gid = wgid / nig, fm = gid * WGM, gsz = (nM - fm) < WGM ? (nM - fm) : WGM;
        u.pm = fm + ((wgid % nig) % gsz); u.pn = (wgid % nig) / gsz; u.aux = 0;
        u.a = A + (size_t)u.pm * strideA; u.b = B + (size_t)u.pn * strideB; return true;
    }
};
struct CrossSOrder {
    const char* Q; const char* Kc; int G, v;
    DI bool next(int i, Unit& u) const {
        const int L = i * G + v; if (L >= (T / 256) * XH) return false;
        u.pm = L >> 2; u.pn = L & 3; u.aux = 0;
        u.a = Q + ((size_t)u.pm * 256 * D + u.pn * 256) * 2; u.b = Kc + ((size_t)(u.pm >> 3) * 256 * D + u.pn * 256) * 2; return true;
    }
};
struct CrossOOrder {
    const char* P; const char* Vt; int G, v;
    DI bool next(int i, Unit& u) const {
        const int L = i * G + v; if (L >= (T / 256) * XH) return false;
        u.pm = L >> 2; u.pn = L & 3; u.aux = 0;
        u.a = P + ((size_t)u.pm * 256 * D + u.pn * 256) * 2; u.b = Vt + ((size_t)u.pn * 256 * (NB * NMEM) + (size_t)(u.pm >> 3) * 256) * 2; return true;
    }
};
struct MoeOrder {
    const char* A; const char* W; const LAS int* tstart; int npn, G, v; size_t strideA, strideW;
    DI bool next(int i, Unit& u) const {
        const int L = i * G + v; const int total = tstart[NE] * npn; if (L >= total) return false;
        const int tile = L / npn; u.pm = tile; u.pn = L - tile * npn;
        int e = 0;
#pragma unroll 1
        for (int j = 1; j < NE; ++j) e += (tstart[j] <= tile) ? 1 : 0;
        u.aux = e;
        u.a = A + (size_t)tile * strideA; u.b = W + (size_t)e * strideW + (size_t)u.pn * 256 * 1024 * 2; return true;
    }
};

struct EpiBf16 {
    static constexpr bool PERM = true;
    bf16_t* O; int ldc; int sc_from; float scale;
    DI void operator()(const Acc& acc, const Unit& u, const Ctx& c) const {
        int row0 = u.pm * BM + c.wr * 64 + c.fr, col0 = u.pn * BM + c.wc * 32 + 8 * c.fq; asm volatile("" : "+v"(row0), "+v"(col0));
        const float sc = (u.pn >= sc_from) ? scale : 1.0f;
#pragma unroll
        for (int ai = 0; ai < 2; ++ai)
#pragma unroll
            for (int m = 0; m < 4; ++m) { bf16_t* rowp = O + (size_t)(row0 + ai * HALF + m * 16) * ldc + col0;
#pragma unroll
                for (int bj = 0; bj < 2; ++bj) { const f32x4 v0 = acc[ai][bj][m][0] * sc, v1 = acc[ai][bj][m][1] * sc;
                    u32x4 w; w.x = cvt_pk_bf16(v0[0], v0[1]); w.y = cvt_pk_bf16(v0[2], v0[3]); w.z = cvt_pk_bf16(v1[0], v1[1]); w.w = cvt_pk_bf16(v1[2], v1[3]);
                    *(u32x4*)(rowp + bj * HALF) = w; } }
    }
};
struct EpiProj {
    static constexpr bool PERM = true;
    bf16_t* O; float* gates;
    DI void operator()(const Acc& acc, const Unit& u, const Ctx& c) const {
        int row0 = u.pm * BM + c.wr * 64 + c.fr, col0 = u.pn * BM + c.wc * 32 + 8 * c.fq; asm volatile("" : "+v"(row0), "+v"(col0));
#pragma unroll
        for (int ai = 0; ai < 2; ++ai)
#pragma unroll
            for (int m = 0; m < 4; ++m) { const int row = row0 + ai * HALF + m * 16; bf16_t* rowp = O + (size_t)row * NPROJ + col0;
#pragma unroll
                for (int bj = 0; bj < 2; ++bj) { const f32x4 v0 = acc[ai][bj][m][0], v1 = acc[ai][bj][m][1];
                    u32x4 w; w.x = cvt_pk_bf16(v0[0], v0[1]); w.y = cvt_pk_bf16(v0[2], v0[3]); w.z = cvt_pk_bf16(v1[0], v1[1]); w.w = cvt_pk_bf16(v1[2], v1[3]);
                    *(u32x4*)(rowp + bj * HALF) = w; }
                if (u.pn == 1 && c.wc == 1 && c.fq == 0) { *(f32x4*)(gates + (size_t)row * 8) = acc[ai][1][m][0]; *(f32x4*)(gates + (size_t)row * 8 + 4) = acc[ai][1][m][1]; } }
    }
};
struct EpiQmla {
    static constexpr bool PERM = true;
    bf16_t* O; const float* cs;
    float scale;
    DI void operator()(const Acc& acc, const Unit& u, const Ctx& c) const {
        int row0 = u.pm * BM + c.wr * 64 + c.fr, col0 = u.pn * BM + c.wc * 32 + 8 * c.fq; asm volatile("" : "+v"(row0), "+v"(col0));
#pragma unroll
        for (int ai = 0; ai < 2; ++ai)
#pragma unroll
            for (int m = 0; m < 4; ++m) { const int row = row0 + ai * HALF + m * 16; bf16_t* rowp = O + (size_t)row * (AH * AQK) + col0;
#pragma unroll
                for (int bj = 0; bj < 2; ++bj) { f32x4 v0 = acc[ai][bj][m][0] * scale, v1 = acc[ai][bj][m][1] * scale;
                    const int cc = (col0 + bj * HALF) % AQK;
                    if (cc >= ANOPE) { const int p0 = (cc - ANOPE) >> 1;
                        const f32x4 t0 = *(const f32x4*)(cs + (size_t)row * 32 + p0 * 2), t1 = *(const f32x4*)(cs + (size_t)row * 32 + p0 * 2 + 4);
                        f32x4 r0, r1;
                        r0[0] = v0[0] * t0[0] - v0[1] * t0[1]; r0[1] = v0[1] * t0[0] + v0[0] * t0[1];
                        r0[2] = v0[2] * t0[2] - v0[3] * t0[3]; r0[3] = v0[3] * t0[2] + v0[2] * t0[3];
                        r1[0] = v1[0] * t1[0] - v1[1] * t1[1]; r1[1] = v1[1] * t1[0] + v1[0] * t1[1];
                        r1[2] = v1[2] * t1[2] - v1[3] * t1[3]; r1[3] = v1[3] * t1[2] + v1[2] * t1[3];
                        v0 = r0; v1 = r1; }
                    u32x4 w; w.x = cvt_pk_bf16(v0[0], v0[1]); w.y = cvt_pk_bf16(v0[2], v0[3]); w.z = cvt_pk_bf16(v1[0], v1[1]); w.w = cvt_pk_bf16(v1[2], v1[3]);
                    *(u32x4*)(rowp + bj * HALF) = w; } }
    }
};
template <bool ADD> struct EpiGate {
    static constexpr bool PERM = true;
    bf16_t* O; const bf16_t* proj; int gcol;
    DI void operator()(const Acc& acc, const Unit& u, const Ctx& c) const {
        int row0 = u.pm * BM + c.wr * 64 + c.fr, col0 = u.pn * BM + c.wc * 32 + 8 * c.fq; asm volatile("" : "+v"(row0), "+v"(col0));
#pragma unroll
        for (int ai = 0; ai < 2; ++ai)
#pragma unroll
            for (int m = 0; m < 4; ++m) { const int row = row0 + ai * HALF + m * 16; bf16_t* rowp = O + (size_t)row * D + col0; const bf16_t* gp = proj + (size_t)row * NPROJ + gcol + col0;
#pragma unroll
                for (int bj = 0; bj < 2; ++bj) { const f32x4 v0 = acc[ai][bj][m][0], v1 = acc[ai][bj][m][1];
                    const u32x4 g = *(const u32x4*)(gp + bj * HALF);
                    float o[8];
                    o[0] = sigmoidf_(bflo(g.x)) * v0[0]; o[1] = sigmoidf_(bfhi(g.x)) * v0[1]; o[2] = sigmoidf_(bflo(g.y)) * v0[2]; o[3] = sigmoidf_(bfhi(g.y)) * v0[3];
                    o[4] = sigmoidf_(bflo(g.z)) * v1[0]; o[5] = sigmoidf_(bfhi(g.z)) * v1[1]; o[6] = sigmoidf_(bflo(g.w)) * v1[2]; o[7] = sigmoidf_(bfhi(g.w)) * v1[3];
                    if (ADD) { const u32x4 p = *(const u32x4*)(rowp + bj * HALF);
                        o[0] += bflo(p.x); o[1] += bfhi(p.x); o[2] += bflo(p.y); o[3] += bfhi(p.y); o[4] += bflo(p.z); o[5] += bfhi(p.z); o[6] += bflo(p.w); o[7] += bfhi(p.w); }
                    u32x4 w; w.x = cvt_pk_bf16(o[0], o[1]); w.y = cvt_pk_bf16(o[2], o[3]); w.z = cvt_pk_bf16(o[4], o[5]); w.w = cvt_pk_bf16(o[6], o[7]);
                    *(u32x4*)(rowp + bj * HALF) = w; } }
    }
};
struct EpiF32 {
    static constexpr bool PERM = false;
    float* C; int ldc; int ncols_valid;
    DI void operator()(const Acc& acc, const Unit& u, const Ctx& c) const {
        int row0 = u.pm * BM + c.wr * 64 + c.fr, col0 = u.pn * BM + c.wc * 32 + 4 * c.fq; asm volatile("" : "+v"(row0), "+v"(col0));
#pragma unroll
        for (int ai = 0; ai < 2; ++ai)
#pragma unroll
            for (int m = 0; m < 4; ++m) { float* rowp = C + (size_t)(row0 + ai * HALF + m * 16) * ldc + col0;
#pragma unroll
                for (int bj = 0; bj < 2; ++bj)
#pragma unroll
                    for (int n = 0; n < 2; ++n) if (col0 + bj * HALF + n * 16 < ncols_valid) *(f32x4*)(rowp + bj * HALF + n * 16) = acc[ai][bj][m][n]; }
    }
};
struct EpiSoftmax {
    static constexpr bool PERM = true;
    bf16_t* O; LAS float* red;
    DI void operator()(Acc& acc, const Unit& u, const Ctx& c) const {
        int row0 = u.pm * BM + c.wr * 64 + c.fr, col0 = u.pn * BM + c.wc * 32 + 8 * c.fq; asm volatile("" : "+v"(row0), "+v"(col0));
        int rbase = (c.wr * 64 + c.fr) * 4; asm volatile("" : "+v"(rbase));
        LAS float* r1 = red + rbase; LAS float* r2 = red + 1024 + rbase;
#pragma unroll
        for (int ai = 0; ai < 2; ++ai)
#pragma unroll
            for (int m = 0; m < 4; ++m) { float v = -INFINITY;
#pragma unroll
                for (int bj = 0; bj < 2; ++bj)
#pragma unroll
                    for (int n = 0; n < 2; ++n) { const f32x4 x = acc[ai][bj][m][n]; v = fmaxf(v, fmaxf(fmaxf(x[0], x[1]), fmaxf(x[2], x[3]))); }
                v = fmaxf(v, __shfl_xor(v, 16)); v = fmaxf(v, __shfl_xor(v, 32));
                if (c.fq == 0) r1[(ai * HALF + m * 16) * 4 + c.wc] = v;
                __builtin_amdgcn_sched_barrier(0); }
        asm volatile("s_waitcnt lgkmcnt(0)" ::: "memory"); __builtin_amdgcn_s_barrier(); asm volatile("" ::: "memory");
#pragma unroll
        for (int ai = 0; ai < 2; ++ai)
#pragma unroll
            for (int m = 0; m < 4; ++m) { const f32x4 q = *(const LAS f32x4*)(r1 + (ai * HALF + m * 16) * 4);
                const float mm = fmaxf(fmaxf(q[0], q[1]), fmaxf(q[2], q[3])); float s = 0.f;
#pragma unroll
                for (int bj = 0; bj < 2; ++bj)
#pragma unroll
                    for (int n = 0; n < 2; ++n) { f32x4 x = acc[ai][bj][m][n];
                        x[0] = __builtin_amdgcn_exp2f(x[0] - mm); x[1] = __builtin_amdgcn_exp2f(x[1] - mm); x[2] = __builtin_amdgcn_exp2f(x[2] - mm); x[3] = __builtin_amdgcn_exp2f(x[3] - mm);
                        acc[ai][bj][m][n] = x; s += (x[0] + x[1]) + (x[2] + x[3]); }
                s += __shfl_xor(s, 16); s += __shfl_xor(s, 32);
                if (c.fq == 0) r2[(ai * HALF + m * 16) * 4 + c.wc] = s;
                __builtin_amdgcn_sched_barrier(0); }
        asm volatile("s_waitcnt lgkmcnt(0)" ::: "memory"); __builtin_amdgcn_s_barrier(); asm volatile("" ::: "memory");
#pragma unroll
        for (int ai = 0; ai < 2; ++ai)
#pragma unroll
            for (int m = 0; m < 4; ++m) { const f32x4 q = *(const LAS f32x4*)(r2 + (ai * HALF + m * 16) * 4);
                const float inv = 1.0f / ((q[0] + q[1]) + (q[2] + q[3]));
                bf16_t* rowp = O + (size_t)(row0 + ai * HALF + m * 16) * D + col0;
#pragma unroll
                for (int bj = 0; bj < 2; ++bj) { const f32x4 v0 = acc[ai][bj][m][0] * inv, v1 = acc[ai][bj][m][1] * inv;
                    u32x4 w; w.x = cvt_pk_bf16(v0[0], v0[1]); w.y = cvt_pk_bf16(v0[2], v0[3]); w.z = cvt_pk_bf16(v1[0], v1[1]); w.w = cvt_pk_bf16(v1[2], v1[3]);
                    *(u32x4*)(rowp + bj * HALF) = w; }
                __builtin_amdgcn_sched_barrier(0); }
    }
};
struct EpiSwiglu {
    static constexpr bool PERM = true;
    bf16_t* O; const float* bias;
    DI void operator()(const Acc& acc, const Unit& u, const Ctx& c) const {
        int row0 = u.pm * BM + c.wr * 64 + c.fr, col0 = u.pn * BM + c.wc * 32 + 8 * c.fq; asm volatile("" : "+v"(row0), "+v"(col0));
        f32x4 bv[2][2];
#pragma unroll
        for (int bj = 0; bj < 2; ++bj)
#pragma unroll
            for (int n = 0; n < 2; ++n) bv[bj][n] = *(const f32x4*)(bias + (size_t)u.aux * 2048 + col0 + bj * HALF + 4 * n);
#pragma unroll
        for (int ai = 0; ai < 2; ++ai)
#pragma unroll
            for (int m = 0; m < 4; ++m) { bf16_t* rowp = O + (size_t)(row0 + ai * HALF + m * 16) * 1024 + (col0 >> 1);
#pragma unroll
                for (int bj = 0; bj < 2; ++bj) { const f32x4 v0 = acc[ai][bj][m][0] + bv[bj][0], v1 = acc[ai][bj][m][1] + bv[bj][1];
                    float o[4];
#define SWG(g, l) ({ const float g_ = fminf((g), 7.0f), l_ = fminf(fmaxf((l), -7.0f), 7.0f); g_ * sigmoidf_(1.702f * g_) * (l_ + 1.0f); })
                    o[0] = SWG(v0[0], v0[1]); o[1] = SWG(v0[2], v0[3]); o[2] = SWG(v1[0], v1[1]); o[3] = SWG(v1[2], v1[3]);
#undef SWG
                    u32x2 w; w.x = cvt_pk_bf16(o[0], o[1]); w.y = cvt_pk_bf16(o[2], o[3]);
                    *(u32x2*)(rowp + bj * (HALF / 2)) = w; } }
    }
};
struct EpiDown {
    static constexpr bool PERM = true;
    bf16_t* O; const float* bias; const float* rowgate;
    DI void operator()(const Acc& acc, const Unit& u, const Ctx& c) const {
        int row0 = u.pm * BM + c.wr * 64 + c.fr, col0 = u.pn * BM + c.wc * 32 + 8 * c.fq; asm volatile("" : "+v"(row0), "+v"(col0));
        f32x4 bv[2][2];
#pragma unroll
        for (int bj = 0; bj < 2; ++bj)
#pragma unroll
            for (int n = 0; n < 2; ++n) bv[bj][n] = *(const f32x4*)(bias + (size_t)u.aux * 1024 + col0 + bj * HALF + 4 * n);
#pragma unroll
        for (int ai = 0; ai < 2; ++ai)
#pragma unroll
            for (int m = 0; m < 4; ++m) { const int row = row0 + ai * HALF + m * 16; const float gt = rowgate[row]; bf16_t* rowp = O + (size_t)row * 1024 + col0;
#pragma unroll
                for (int bj = 0; bj < 2; ++bj) { const f32x4 v0 = (acc[ai][bj][m][0] + bv[bj][0]) * gt, v1 = (acc[ai][bj][m][1] + bv[bj][1]) * gt;
                    u32x4 w; w.x = cvt_pk_bf16(v0[0], v0[1]); w.y = cvt_pk_bf16(v0[2], v0[3]); w.z = cvt_pk_bf16(v1[0], v1[1]); w.w = cvt_pk_bf16(v1[2], v1[3]);
                    *(u32x4*)(rowp + bj * HALF) = w; } }
    }
};
}
constexpr size_t MiB = 1u << 20;
constexpr size_t WS_CTL = 0, CTL_ZERO_BYTES = 1 * MiB;
constexpr size_t WS_W_IN = 2 * MiB, WS_W_UQ = 10 * MiB, WS_W_UK = WS_W_UQ + 512 * 1024, WS_W_UV = WS_W_UK + 256 * 1024, WS_W_MQK = 11 * MiB, WS_W_BRM = 12 * MiB, WS_W_BRA = 13 * MiB,
                 WS_W_MIX = 14 * MiB, WS_W_CQ = 16 * MiB, WS_W_CK = 18 * MiB, WS_W_CV = 20 * MiB, WS_W_CO = 22 * MiB, WS_W_R = 24 * MiB, WS_W_GU = 26 * MiB, WS_W_DN = 154 * MiB;
constexpr size_t WS_GATES = 218 * MiB, WS_CS = 219 * MiB, WS_KPE = 223 * MiB, WS_MEMB = 225 * MiB, WS_KC = 233 * MiB, WS_VCT = 241 * MiB, WS_LOGITS = 249 * MiB,
                 WS_ASSIGN = 253 * MiB, WS_GATEW = WS_ASSIGN + 512 * 1024, WS_TOKPOS = 254 * MiB, WS_ROWGATE = WS_TOKPOS + 512 * 1024;
constexpr size_t WS_XB = 256 * MiB, WS_PROJ = 320 * MiB, WS_QN = 576 * MiB, WS_KVN = 592 * MiB, WS_XC = 608 * MiB, WS_QMLA = 640 * MiB, WS_KN = 688 * MiB, WS_VT = 720 * MiB,
                 WS_QKM = 752 * MiB, WS_KTM = 816 * MiB, WS_AO = 848 * MiB, WS_HRAW = 880 * MiB, WS_HM = 944 * MiB;
constexpr size_t WS_GATED = 256 * MiB, WS_MIXO = 576 * MiB, WS_H1B = 704 * MiB, WS_QC = 768 * MiB, WS_PC = 832 * MiB, WS_OC = 896 * MiB, WS_COO = 320 * MiB, WS_H2B = 256 * MiB;
constexpr size_t WS_XG = 320 * MiB, WS_ACT = 592 * MiB, WS_YB = 320 * MiB, WS_END = 976 * MiB;
static_assert((size_t)NROWS * 1024 * 2 <= 272 * MiB, "routed buffers");
static_assert(WS_ROWGATE + (size_t)NROWS * 4 <= 256 * MiB, "small buffers");
constexpr int CW_TMO = 0, CW_CNT = 64  , CW_BAR = 4096;

constexpr int RING_OFF = 0, RING_BYTES = 131072;
constexpr int RED_OFF = RING_BYTES;
constexpr int TST_OFF = RED_OFF + 8192;
constexpr int HIST_OFF = TST_OFF + 256, HBASE_OFF = HIST_OFF + 128;
constexpr int MISC_OFF = HBASE_OFF + 128;
constexpr int LDSCTL_OFF = TST_OFF;
constexpr int LDS_BYTES = 147456;
static_assert(MISC_OFF + 128 <= LDS_BYTES, "LDS map");
constexpr int NWAVES = 8;

#define LDS_WAIT() asm volatile("s_waitcnt lgkmcnt(0)" ::: "memory")
#define VM_WAIT() asm volatile("s_waitcnt vmcnt(0)" ::: "memory")

#define XB_TMO      128
#define XB_XCNT(j)  (256  + 64 * (j))
#define XB_XSUB(j)  (1280 + 64 * (j))
#define XB_XGEN(j)  (2304 + 64 * (j))
#define XB_TOP      3328
#define XB_TOPGEN   3392
#define XCD_BAR_WORDS 3456
#define XB_SPIN_CAP (1u << 18)
__device__ __forceinline__ unsigned xb_ld(unsigned* p)              { return __hip_atomic_load(p, __ATOMIC_RELAXED, __HIP_MEMORY_SCOPE_AGENT); }
__device__ __forceinline__ unsigned xb_add(unsigned* p, unsigned v) { return __hip_atomic_fetch_add(p, v, __ATOMIC_RELAXED, __HIP_MEMORY_SCOPE_AGENT); }
__device__ __forceinline__ unsigned xb_xcc_id() { return (unsigned)__builtin_amdgcn_s_getreg((3 << 11) | 20) & 0xFu; }
#define XB_SPIN(cond, bar) do { unsigned _sp = 0; while (cond) { __builtin_amdgcn_s_sleep(1); \
    if ((++_sp & 255u) == 0u) { if (xb_ld(&(bar)[XB_TMO])) break; if (_sp > XB_SPIN_CAP) { atomicAdd(&(bar)[XB_TMO], 1u); break; } } } } while (0)
struct XcdBarrier { unsigned* bar; unsigned x; volatile LAS unsigned* st; };
__device__ __forceinline__ XcdBarrier xcd_barrier_post(unsigned* bar, volatile LAS unsigned* st) {
    XcdBarrier b; b.bar = bar; b.x = xb_xcc_id(); b.st = st;
    if (threadIdx.x == 0) (void)xb_add(&bar[XB_XCNT(b.x)], 1u);
    return b;
}
__device__ __forceinline__ void xcd_barrier_complete(unsigned* bar, unsigned x, unsigned& nloc, unsigned& nx) {
    const unsigned G = gridDim.x * gridDim.y * gridDim.z;
    unsigned sum, cnt, mine, sp = 0u;
    for (;;) {
        sum = 0u; cnt = 0u; mine = 0u;
#pragma unroll
        for (unsigned j = 0; j < 16; ++j) { const unsigned c = xb_ld(&bar[XB_XCNT(j)]); sum += c; cnt += (c > 0u) ? 1u : 0u; mine = (j == x) ? c : mine; }
        if (sum == G) break;
        __builtin_amdgcn_s_sleep(1);
        if ((++sp & 255u) == 0u) { if (xb_ld(&bar[XB_TMO])) break; if (sp > XB_SPIN_CAP) { atomicAdd(&bar[XB_TMO], 1u); break; } }
    }
    nloc = mine > 0u ? mine : 1u; nx = cnt > 0u ? cnt : 1u;
}
__device__ __forceinline__ void xcd_barrier(const XcdBarrier& b) {
    asm volatile("s_waitcnt vmcnt(0)" ::: "memory");
    __syncthreads();
    if (threadIdx.x == 0) {
        unsigned* bar = b.bar;
        __builtin_amdgcn_s_waitcnt(0);
        unsigned nloc = b.st[0], nx = b.st[1];
        if (nloc == 0u) { xcd_barrier_complete(bar, b.x, nloc, nx); b.st[0] = nloc; b.st[1] = nx; }
        const unsigned old = xb_add(&bar[XB_XSUB(b.x)], 1u);
        const unsigned gen = old / nloc;
        if (old + 1u == (gen + 1u) * nloc) {
            __builtin_amdgcn_fence(__ATOMIC_RELEASE, "agent");
            asm volatile("s_waitcnt vmcnt(0)" ::: "memory");
            const unsigned og = xb_add(&bar[XB_TOP], 1u);
            const unsigned tg = og / nx;
            if (og + 1u == (tg + 1u) * nx) xb_add(&bar[XB_TOPGEN], 1u);
            else XB_SPIN(xb_ld(&bar[XB_TOPGEN]) == tg, bar);
            __builtin_amdgcn_fence(__ATOMIC_ACQUIRE, "agent");
            xb_add(&bar[XB_XGEN(b.x)], 1u);
            asm volatile("s_waitcnt vmcnt(0)" ::: "memory");
        } else {
            XB_SPIN(xb_ld(&bar[XB_XGEN(b.x)]) == gen, bar);
            __builtin_amdgcn_fence(__ATOMIC_ACQUIRE, "agent");
            asm volatile("s_waitcnt vmcnt(0)" ::: "memory");
        }
    }
    __syncthreads();
}

struct Args { const void* in[34]; float* out; unsigned char* ws; int ph_lo, ph_hi; };

DI void tr_item(const float* W, int ldw, int kvalid, bf16_t* WT, int ldk, int n0, int k0, int sc, LAS float* scr, int lane) {
#pragma unroll 8
    for (int i = 0; i < 32; ++i) { const int kk = 2 * i + (lane >> 5); const int k = k0 + kk;
        float v = 0.f; if (sc >= 0 && k < kvalid) v = W[(size_t)k * ldw + sc];
        scr[kk * 33 + (lane & 31)] = v; }
    LDS_WAIT(); asm volatile("" ::: "memory");
    const int c = lane & 7;
#pragma unroll
    for (int j = 0; j < 4; ++j) { const int n = (lane >> 3) + 8 * j; const LAS float* s = scr + (8 * c) * 33 + n;
        u32x4 o; o.x = pk2(s[0 * 33], s[1 * 33]); o.y = pk2(s[2 * 33], s[3 * 33]); o.z = pk2(s[4 * 33], s[5 * 33]); o.w = pk2(s[6 * 33], s[7 * 33]);
        *(GAS u32x4*)(WT + (size_t)(n0 + n) * ldk + k0 + 8 * c) = o; }
    LDS_WAIT(); asm volatile("" ::: "memory");
}

DI void tr_item_v4(const float* W, int ldw, bf16_t* WT, int ldk, int n0, int k0, int c0, LAS float* scr, int lane) {
    const int kr = lane >> 3, n4 = lane & 7;
    f32x4 v[8];
#pragma unroll
    for (int i = 0; i < 8; ++i) v[i] = *(const f32x4*)(W + (size_t)(k0 + i * 8 + kr) * ldw + c0 + 4 * n4);
#pragma unroll
    for (int i = 0; i < 8; ++i) { LAS float* p = scr + (i * 8 + kr) * 33 + 4 * n4; p[0] = v[i][0]; p[1] = v[i][1]; p[2] = v[i][2]; p[3] = v[i][3]; }
    LDS_WAIT(); asm volatile("" ::: "memory");
    const int c = lane & 7;
#pragma unroll
    for (int j = 0; j < 4; ++j) { const int n = (lane >> 3) + 8 * j; const LAS float* s = scr + (8 * c) * 33 + n;
        u32x4 o; o.x = pk2(s[0 * 33], s[1 * 33]); o.y = pk2(s[2 * 33], s[3 * 33]); o.z = pk2(s[4 * 33], s[5 * 33]); o.w = pk2(s[6 * 33], s[7 * 33]);
        *(GAS u32x4*)(WT + (size_t)(n0 + n) * ldk + k0 + 8 * c) = o; }
    LDS_WAIT(); asm volatile("" ::: "memory");
}
DI int win_src(int n) {
    if (n < 384) return n;
    if (n < 416) { const int i = (n - 384) >> 1; return 384 + i + 16 * ((n - 384) & 1); }
    if (n < 424) return 1952 + (n - 416);
    if (n < 512) return -1;
    if (n < 2048) return 416 + (n - 512);
    return 1960 + (n - 2048);
}
DI void p0_prologue(const Args& args, LAS unsigned char* lds, int vcu, int G) {
    int tid_ = threadIdx.x; asm volatile("" : "+v"(tid_)); const int lane = tid_ & 63; const int wave = __builtin_amdgcn_readfirstlane(tid_ >> 6);
    LAS float* scr = (LAS float*)(lds + RING_OFF + wave * 16384);
    const int gw = vcu * NWAVES + wave, NGW = G * NWAVES;
    unsigned char* ws = args.ws;
    const int j = lane & 31;
    constexpr int I_IN = 16 * 128, I_UQ = 4 * 24, I_UK = 4 * 16, I_UV = 4 * 16, I_MQK = 8 * 32, I_BRM = 8 * 32, I_BRA = 8 * 32, I_SQ = 16 * 32, I_R = 16 * 8,
                  I_GU = NE * 16 * 64, I_DN = NE * 16 * 32;
    constexpr int NITEMS = I_IN + I_UQ + I_UK + I_UV + I_MQK + I_BRM + I_BRA + 5 * I_SQ + I_R + I_GU + I_DN;
    for (int it = gw; it < NITEMS; it += NGW) {
        int r = it;
        if (r < I_GU) { const int e = r / (16 * 64), q = r % (16 * 64), kb = q / 64, nb = q % 64;
            tr_item_v4((const float*)args.in[28] + (size_t)e * 1024 * 2048, 2048, (bf16_t*)(ws + WS_W_GU) + (size_t)e * 2048 * 1024, 1024, nb * 32, kb * 64, nb * 32, scr, lane); continue; } r -= I_GU;
        if (r < I_DN) { const int e = r / (16 * 32), q = r % (16 * 32), kb = q / 32, nb = q % 32;
            tr_item_v4((const float*)args.in[30] + (size_t)e * 1024 * 1024, 1024, (bf16_t*)(ws + WS_W_DN) + (size_t)e * 1024 * 1024, 1024, nb * 32, kb * 64, nb * 32, scr, lane); continue; } r -= I_DN;
        if (r < I_IN) { const int kb = r / 128, nb = r % 128;
            tr_item((const float*)args.in[3], DIN, 1024, (bf16_t*)(ws + WS_W_IN), 1024, nb * 32, kb * 64, win_src(nb * 32 + j), scr, lane); continue; } r -= I_IN;
        if (r < I_UQ) { const int kb = r / 24, nb = r % 24; const int n = nb * 32 + j, hh = n / AQK, cc = n % AQK;
            const int sc = (cc < ANOPE) ? n : hh * AQK + ANOPE + ((cc - ANOPE) >> 1) + 16 * ((cc - ANOPE) & 1);
            tr_item((const float*)args.in[14], AH * AQK, 256, (bf16_t*)(ws + WS_W_UQ), 256, nb * 32, kb * 64, sc, scr, lane); continue; } r -= I_UQ;
        if (r < I_UK) { const int kb = r / 16, nb = r % 16; const int n = nb * 32 + j;
            tr_item((const float*)args.in[15], 1024, 128, (bf16_t*)(ws + WS_W_UK), 256, nb * 32, kb * 64, (n >> 6) * 128 + (n & 63), scr, lane); continue; } r -= I_UK;
        if (r < I_UV) { const int kb = r / 16, nb = r % 16; const int n = nb * 32 + j;
            tr_item((const float*)args.in[15], 1024, 128, (bf16_t*)(ws + WS_W_UV), 256, nb * 32, kb * 64, (n >> 6) * 128 + 64 + (n & 63), scr, lane); continue; } r -= I_UV;
        if (r < I_MQK) { const int kb = r / 32, nb = r % 32; const int n = nb * 32 + j, part = n >> 9, hh = (n >> 7) & 3, e = n & 127;
            const float* src = (const float*)args.in[part ? 9 : 8];
            tr_item(src, 128, 512, (bf16_t*)(ws + WS_W_MQK), 512, nb * 32, kb * 64, ((kb >> 1) == hh) ? e : -1, scr, lane); continue; } r -= I_MQK;
        if (r < I_BRM) { const int kb = r / 32, nb = r % 32;
            tr_item_v4((const float*)args.in[16], 1024, (bf16_t*)(ws + WS_W_BRM), 512, nb * 32, kb * 64, nb * 32, scr, lane); continue; } r -= I_BRM;
        if (r < I_BRA) { const int kb = r / 32, nb = r % 32;
            tr_item_v4((const float*)args.in[17], 1024, (bf16_t*)(ws + WS_W_BRA), 512, nb * 32, kb * 64, nb * 32, scr, lane); continue; } r -= I_BRA;
        if (r < 5 * I_SQ) { const int w = r / I_SQ, q = r % I_SQ, kb = q / 32, nb = q % 32;
            const float* src; int ldw, coff; bf16_t* dst;
            if (w == 0) { src = (const float*)args.in[18]; ldw = 1024; coff = 0; dst = (bf16_t*)(ws + WS_W_MIX); }
            else if (w == 1) { src = (const float*)args.in[21]; ldw = 1024; coff = 0; dst = (bf16_t*)(ws + WS_W_CQ); }
            else if (w == 2) { src = (const float*)args.in[22]; ldw = 2048; coff = 0; dst = (bf16_t*)(ws + WS_W_CK); }
            else if (w == 3) { src = (const float*)args.in[22]; ldw = 2048; coff = 1024; dst = (bf16_t*)(ws + WS_W_CV); }
            else { src = (const float*)args.in[23]; ldw = 1024; coff = 0; dst = (bf16_t*)(ws + WS_W_CO); }
            tr_item_v4(src, ldw, dst, 1024, nb * 32, kb * 64, coff + nb * 32, scr, lane); continue; } r -= 5 * I_SQ;
        { const int kb = r / 8, nb = r % 8; const int n = nb * 32 + j;
            tr_item((const float*)args.in[26], NE, 1024, (bf16_t*)(ws + WS_W_R), 1024, nb * 32, kb * 64, (n < NE) ? n : -1, scr, lane); }
    }
    const size_t gt = (size_t)gw * 64 + lane, NT_ = (size_t)NGW * 64;
    { const float* x = (const float*)args.in[0]; bf16_t* xb = (bf16_t*)(ws + WS_XB);
      for (size_t i = gt; i < (size_t)T * D / 8; i += NT_) { const f32x4 a = *(const f32x4*)(x + i * 8), b = *(const f32x4*)(x + i * 8 + 4);
          u32x4 o; o.x = pk2(a[0], a[1]); o.y = pk2(a[2], a[3]); o.z = pk2(b[0], b[1]); o.w = pk2(b[2], b[3]); *(u32x4*)(xb + i * 8) = o; } }
    { const float* x = (const float*)args.in[1]; bf16_t* xb = (bf16_t*)(ws + WS_MEMB);
      for (size_t i = gt; i < (size_t)NB * NMEM * D / 8; i += NT_) { const f32x4 a = *(const f32x4*)(x + i * 8), b = *(const f32x4*)(x + i * 8 + 4);
          u32x4 o; o.x = pk2(a[0], a[1]); o.y = pk2(a[2], a[3]); o.z = pk2(b[0], b[1]); o.w = pk2(b[2], b[3]); *(u32x4*)(xb + i * 8) = o; } }
}

DI void p2_tokens(const Args& args, int vcu, int G) {
    int tid_ = threadIdx.x; asm volatile("" : "+v"(tid_)); const int lane = tid_ & 63; const int wave = __builtin_amdgcn_readfirstlane(tid_ >> 6);
    unsigned char* ws = args.ws;
    const bf16_t* proj = (const bf16_t*)(ws + WS_PROJ);
    bf16_t* qn = (bf16_t*)(ws + WS_QN); bf16_t* kvn = (bf16_t*)(ws + WS_KVN); bf16_t* kpe = (bf16_t*)(ws + WS_KPE); bf16_t* xc = (bf16_t*)(ws + WS_XC); float* cs = (float*)(ws + WS_CS);
    const int* positions = (const int*)args.in[2];
    const float* conv_w = (const float*)args.in[6]; const float* conv_b = (const float*)args.in[7];
    const float* g_qlat = (const float*)args.in[12]; const float* g_kvlat = (const float*)args.in[13];
    const int gw = vcu * NWAVES + wave, NGW = G * NWAVES;
    float cw[4][8], cb[8];
#pragma unroll
    for (int jj = 0; jj < 4; ++jj)
#pragma unroll
        for (int c = 0; c < 8; ++c) cw[jj][c] = conv_w[jj * MW + 8 * lane + c];
#pragma unroll
    for (int c = 0; c < 8; ++c) cb[c] = conv_b[8 * lane + c];
    const f32x4 gq = *(const f32x4*)(g_qlat + 4 * lane);
    const f32x2 gk = *(const f32x2*)(g_kvlat + 2 * lane);
    const float inv_freq = exp2f(-(float)(lane & 15) * (13.287712379549449f / 16.0f));
    for (int t = gw; t < T; t += NGW) {
        const bf16_t* pr = proj + (size_t)t * NPROJ;
        { const u32x2 w = *(const u32x2*)(pr + PC_QLAT + 4 * lane); const float a0 = bflo(w.x), a1 = bfhi(w.x), a2 = bflo(w.y), a3 = bfhi(w.y);
          const float ss = wave_sum(a0 * a0 + a1 * a1 + a2 * a2 + a3 * a3); const float r = 1.0f / sqrtf(ss * (1.0f / AQR) + EPS);
          u32x2 o; o.x = pk2(a0 * r * gq[0], a1 * r * gq[1]); o.y = pk2(a2 * r * gq[2], a3 * r * gq[3]); *(u32x2*)(qn + (size_t)t * 256 + 4 * lane) = o; }
        { const unsigned w = *(const unsigned*)(pr + PC_KVLAT + 2 * lane); const float a0 = bflo(w), a1 = bfhi(w);
          const float ss = wave_sum(a0 * a0 + a1 * a1); const float r = 1.0f / sqrtf(ss * (1.0f / AKVR) + EPS);
          *(unsigned*)(kvn + (size_t)t * 256 + 2 * lane) = pk2(a0 * r * gk[0], a1 * r * gk[1]); *(unsigned*)(kvn + (size_t)t * 256 + 128 + 2 * lane) = 0u; }
        if (lane < 16) { const unsigned w = *(const unsigned*)(pr + PC_KROPE + 2 * lane); const float x1 = bflo(w), x2 = bfhi(w);
          const float ang = (float)positions[t] * inv_freq;
          const double rev = (double)ang * 0.15915494309189535; const float fr = (float)(rev - __builtin_rint(rev));
          const float cc = __builtin_amdgcn_cosf(fr), sn = __builtin_amdgcn_sinf(fr);
          *(unsigned*)(kpe + (size_t)t * 32 + 2 * lane) = pk2(x1 * cc - x2 * sn, x2 * cc + x1 * sn);
          *(f32x2*)(cs + (size_t)t * 32 + 2 * lane) = (f32x2){cc, sn}; }
        { const int s = t & (SEQ - 1); float a[8];
#pragma unroll
          for (int c = 0; c < 8; ++c) a[c] = cb[c];
#pragma unroll
          for (int jj = 0; jj < 4; ++jj) { const int back = 3 - jj; if (s - back >= 0) { const u32x4 w = *(const u32x4*)(pr - (size_t)back * NPROJ + PC_XM + 8 * lane);
              a[0] += cw[jj][0] * bflo(w.x); a[1] += cw[jj][1] * bfhi(w.x); a[2] += cw[jj][2] * bflo(w.y); a[3] += cw[jj][3] * bfhi(w.y);
              a[4] += cw[jj][4] * bflo(w.z); a[5] += cw[jj][5] * bfhi(w.z); a[6] += cw[jj][6] * bflo(w.w); a[7] += cw[jj][7] * bfhi(w.w); } }
#pragma unroll
          for (int c = 0; c < 8; ++c) a[c] = a[c] * sigmoidf_(a[c]);
          u32x4 o; o.x = pk2(a[0], a[1]); o.y = pk2(a[2], a[3]); o.z = pk2(a[4], a[5]); o.w = pk2(a[6], a[7]); *(u32x4*)(xc + (size_t)t * MW + 8 * lane) = o; }
    }
}

DI void p6_mpost(const Args& args, int vcu, int G) {
    int tid_ = threadIdx.x; asm volatile("" : "+v"(tid_)); const int lane = tid_ & 63; const int wave = __builtin_amdgcn_readfirstlane(tid_ >> 6);
    unsigned char* ws = args.ws;
    const float* hraw = (const float*)(ws + WS_HRAW); const bf16_t* xc = (const bf16_t*)(ws + WS_XC); const bf16_t* proj = (const bf16_t*)(ws + WS_PROJ); bf16_t* hm = (bf16_t*)(ws + WS_HM);
    const float* g_mhead = (const float*)args.in[10]; const float* w_mskip = (const float*)args.in[11];
    const int gw = vcu * NWAVES + wave, NGW = G * NWAVES;
    float gm[8], wsk[8];
#pragma unroll
    for (int c = 0; c < 8; ++c) { gm[c] = g_mhead[8 * lane + c]; wsk[c] = w_mskip[8 * lane + c]; }
    for (int t = gw; t < T; t += NGW) {
        const f32x4 h0 = *(const f32x4*)(hraw + (size_t)t * MW + 8 * lane), h1 = *(const f32x4*)(hraw + (size_t)t * MW + 8 * lane + 4);
        float h[8] = {h0[0], h0[1], h0[2], h0[3], h1[0], h1[1], h1[2], h1[3]};
        float s = 0.f;
#pragma unroll
        for (int c = 0; c < 8; ++c) s += h[c];
        s += __shfl_xor(s, 1); s += __shfl_xor(s, 2); s += __shfl_xor(s, 4); s += __shfl_xor(s, 8);
        const float mu = s * (1.0f / MHD); float q = 0.f;
#pragma unroll
        for (int c = 0; c < 8; ++c) { h[c] -= mu; q += h[c] * h[c]; }
        q += __shfl_xor(q, 1); q += __shfl_xor(q, 2); q += __shfl_xor(q, 4); q += __shfl_xor(q, 8);
        const float rstd = 1.0f / sqrtf(q * (1.0f / MHD) + EPS);
        const u32x4 xw = *(const u32x4*)(xc + (size_t)t * MW + 8 * lane); const u32x4 ow = *(const u32x4*)(proj + (size_t)t * NPROJ + PC_OP + 8 * lane);
        const float xv[8] = {bflo(xw.x), bfhi(xw.x), bflo(xw.y), bfhi(xw.y), bflo(xw.z), bfhi(xw.z), bflo(xw.w), bfhi(xw.w)};
        const float ov[8] = {bflo(ow.x), bfhi(ow.x), bflo(ow.y), bfhi(ow.y), bflo(ow.z), bfhi(ow.z), bflo(ow.w), bfhi(ow.w)};
        float o[8];
#pragma unroll
        for (int c = 0; c < 8; ++c) o[c] = sigmoidf_(ov[c]) * (h[c] * rstd * gm[c] + wsk[c] * xv[c]);
        u32x4 w; w.x = pk2(o[0], o[1]); w.y = pk2(o[2], o[3]); w.z = pk2(o[4], o[5]); w.w = pk2(o[6], o[7]); *(u32x4*)(hm + (size_t)t * MW + 8 * lane) = w;
    }
}

DI void ln_pass(const float* res, const float* add, const float* g, const float* b, float* out, bf16_t* outb, int vcu, int G) {
    int tid_ = threadIdx.x; asm volatile("" : "+v"(tid_)); const int lane = tid_ & 63; const int wave = __builtin_amdgcn_readfirstlane(tid_ >> 6);
    const int gw = vcu * NWAVES + wave, NGW = G * NWAVES;
    for (int t = gw; t < T; t += NGW) {
        f32x4 v[4]; float s = 0.f;
#pragma unroll
        for (int j = 0; j < 4; ++j) { const f32x4 r = *(const f32x4*)(res + (size_t)t * D + 4 * lane + 256 * j), a = *(const f32x4*)(add + (size_t)t * D + 4 * lane + 256 * j);
            v[j] = r * DN_ALPHA + a; s += (v[j][0] + v[j][1]) + (v[j][2] + v[j][3]); }
        const float mean = wave_sum(s) * (1.0f / D); float q = 0.f;
#pragma unroll
        for (int j = 0; j < 4; ++j) { v[j] = v[j] - mean; q += (v[j][0] * v[j][0] + v[j][1] * v[j][1]) + (v[j][2] * v[j][2] + v[j][3] * v[j][3]); }
        const float rstd = 1.0f / sqrtf(wave_sum(q) * (1.0f / D) + EPS);
#pragma unroll
        for (int j = 0; j < 4; ++j) { const f32x4 gg = *(const f32x4*)(g + 4 * lane + 256 * j), bb = *(const f32x4*)(b + 4 * lane + 256 * j);
            const f32x4 y = v[j] * rstd * gg + bb;
            *(f32x4*)(out + (size_t)t * D + 4 * lane + 256 * j) = y;
            if (outb) { u32x2 w; w.x = pk2(y[0], y[1]); w.y = pk2(y[2], y[3]); *(u32x2*)(outb + (size_t)t * D + 4 * lane + 256 * j) = w; } }
    }
}

DI void p16_topk(const Args& args, LAS unsigned char* lds, int vcu, int G) {
    unsigned char* ws = args.ws;
    const float* logits = (const float*)(ws + WS_LOGITS); const float* b_router = (const float*)args.in[27];
    int* assign = (int*)(ws + WS_ASSIGN); float* gatew = (float*)(ws + WS_GATEW);
    unsigned* gcnt = (unsigned*)(ws + WS_CTL) + CW_CNT;
    LAS unsigned* hist = (LAS unsigned*)(lds + HIST_OFF); LAS unsigned* hbase = (LAS unsigned*)(lds + HBASE_OFF);
    int tid = threadIdx.x; asm volatile("" : "+v"(tid));
    for (int blk = vcu; blk < T / 512; blk += G) {
        const int t = blk * 512 + tid;
        float v[NE];
#pragma unroll
        for (int j = 0; j < NE / 4; ++j) { const f32x4 a = *(const f32x4*)(logits + (size_t)t * NE + 4 * j), bb = *(const f32x4*)(b_router + 4 * j);
            v[4 * j] = a[0] + bb[0]; v[4 * j + 1] = a[1] + bb[1]; v[4 * j + 2] = a[2] + bb[2]; v[4 * j + 3] = a[3] + bb[3]; }
        int idx[TOPK]; float val[TOPK];
#pragma unroll
        for (int k = 0; k < TOPK; ++k) { float best = -INFINITY; int bi = 0;
#pragma unroll
            for (int e = 0; e < NE; ++e) { bool taken = false;
#pragma unroll
                for (int kk = 0; kk < k; ++kk) taken = taken || (idx[kk] == e);
                if (!taken && v[e] > best) { best = v[e]; bi = e; } }
            idx[k] = bi; val[k] = best; }
        float ex[TOPK], sum = 0.f;
#pragma unroll
        for (int k = 0; k < TOPK; ++k) { ex[k] = __expf(val[k] - val[0]); sum += ex[k]; }
        const float inv = 1.0f / sum;
        if (tid < NE) hist[tid] = 0u;
        __syncthreads();
        unsigned lr[TOPK];
#pragma unroll
        for (int k = 0; k < TOPK; ++k) lr[k] = __hip_atomic_fetch_add(hist + idx[k], 1u, __ATOMIC_RELAXED, __HIP_MEMORY_SCOPE_WORKGROUP);
        __syncthreads();
        if (tid < NE) hbase[tid] = __hip_atomic_fetch_add(gcnt + tid, hist[tid], RLX_AGENT);
        __syncthreads();
#pragma unroll
        for (int k = 0; k < TOPK; ++k) { assign[(size_t)t * TOPK + k] = (idx[k] << 20) | (int)(hbase[idx[k]] + lr[k]); gatew[(size_t)t * TOPK + k] = ex[k] * inv; }
        __syncthreads();
    }
}
DI void build_tstart(const Args& args, LAS unsigned char* lds) {
    const unsigned* gcnt = (const unsigned*)(args.ws + WS_CTL) + CW_CNT; LAS int* tst = (LAS int*)(lds + TST_OFF);
    if (threadIdx.x == 0) { int acc = 0;
        for (int e = 0; e < NE; ++e) { tst[e] = acc; const unsigned c = __hip_atomic_load(gcnt + e, RLX_AGENT); acc += (int)((c + 255u) >> 8); }
        tst[NE] = acc; }
    __syncthreads();
}
DI void p17_gather(const Args& args, LAS unsigned char* lds, int vcu, int G) {
    int tid_ = threadIdx.x; asm volatile("" : "+v"(tid_)); const int lane = tid_ & 63; const int wave = __builtin_amdgcn_readfirstlane(tid_ >> 6);
    unsigned char* ws = args.ws;
    build_tstart(args, lds);
    const LAS int* tst = (const LAS int*)(lds + TST_OFF);
    const unsigned* gcnt = (const unsigned*)(ws + WS_CTL) + CW_CNT;
    const int* assign = (const int*)(ws + WS_ASSIGN); const float* gatew = (const float*)(ws + WS_GATEW);
    int* tokpos = (int*)(ws + WS_TOKPOS); float* rowgate = (float*)(ws + WS_ROWGATE);
    const bf16_t* h2b = (const bf16_t*)(ws + WS_H2B); bf16_t* xg = (bf16_t*)(ws + WS_XG);
    const int gw = vcu * NWAVES + wave, NGW = G * NWAVES;
    for (int t = gw; t < T; t += NGW) {
        const u32x4 a = *(const u32x4*)(h2b + (size_t)t * D + 8 * lane), b = *(const u32x4*)(h2b + (size_t)t * D + 512 + 8 * lane);
#pragma unroll
        for (int k = 0; k < TOPK; ++k) { const int as = assign[(size_t)t * TOPK + k]; const int e = as >> 20, rank = as & 0xfffff; const int pos = tst[e] * 256 + rank;
            *(u32x4*)(xg + (size_t)pos * D + 8 * lane) = a; *(u32x4*)(xg + (size_t)pos * D + 512 + 8 * lane) = b;
            if (lane == 0) { tokpos[(size_t)t * TOPK + k] = pos; rowgate[pos] = gatew[(size_t)t * TOPK + k]; } }
    }
    for (int idx = gw; idx < NE * 256; idx += NGW) { const int e = idx >> 8, r = idx & 255; const int row = tst[e] * 256 + (int)__hip_atomic_load(gcnt + e, RLX_AGENT) + r;
        if (row < tst[e + 1] * 256) { const u32x4 z = {0u, 0u, 0u, 0u}; *(u32x4*)(xg + (size_t)row * D + 8 * lane) = z; *(u32x4*)(xg + (size_t)row * D + 512 + 8 * lane) = z; if (lane == 0) rowgate[row] = 0.f; } }
}
DI void p20_final(const Args& args, int vcu, int G) {
    int tid_ = threadIdx.x; asm volatile("" : "+v"(tid_)); const int lane = tid_ & 63; const int wave = __builtin_amdgcn_readfirstlane(tid_ >> 6);
    unsigned char* ws = args.ws;
    const int* tokpos = (const int*)(ws + WS_TOKPOS); const bf16_t* yb = (const bf16_t*)(ws + WS_YB);
    const float* g = (const float*)args.in[32]; const float* b = (const float*)args.in[33]; float* out = args.out;
    const int gw = vcu * NWAVES + wave, NGW = G * NWAVES;
    for (int t = gw; t < T; t += NGW) {
        int pos[TOPK];
#pragma unroll
        for (int k = 0; k < TOPK; ++k) pos[k] = tokpos[(size_t)t * TOPK + k];
        f32x4 v[4]; float s = 0.f;
#pragma unroll
        for (int j = 0; j < 4; ++j) { const f32x4 r = *(const f32x4*)(out + (size_t)t * D + 4 * lane + 256 * j); f32x4 a = {0.f, 0.f, 0.f, 0.f};
#pragma unroll
            for (int k = 0; k < TOPK; ++k) { const u32x2 w = *(const u32x2*)(yb + (size_t)pos[k] * D + 4 * lane + 256 * j); a[0] += bflo(w.x); a[1] += bfhi(w.x); a[2] += bflo(w.y); a[3] += bfhi(w.y); }
            v[j] = r * DN_ALPHA + a; s += (v[j][0] + v[j][1]) + (v[j][2] + v[j][3]); }
        const float mean = wave_sum(s) * (1.0f / D); float q = 0.f;
#pragma unroll
        for (int j = 0; j < 4; ++j) { v[j] = v[j] - mean; q += (v[j][0] * v[j][0] + v[j][1] * v[j][1]) + (v[j][2] * v[j][2] + v[j][3] * v[j][3]); }
        const float rstd = 1.0f / sqrtf(wave_sum(q) * (1.0f / D) + EPS);
#pragma unroll
        for (int j = 0; j < 4; ++j) { const f32x4 gg = *(const f32x4*)(g + 4 * lane + 256 * j), bb = *(const f32x4*)(b + 4 * lane + 256 * j);
            *(f32x4*)(out + (size_t)t * D + 4 * lane + 256 * j) = v[j] * rstd * gg + bb; }
    }
}
constexpr int AT_KROW = 208, AT_VROW = 136;
constexpr int AT_KBUF = 64 * AT_KROW, AT_VBUF = 64 * AT_VROW, AT_VOFF = 2 * AT_KBUF;
DI void mla_unit(int b, int h, int qb, const bf16_t* Q, const bf16_t* Kn, const bf16_t* Kpe, const bf16_t* Vt, bf16_t* O, LAS unsigned char* lds) {
    int tid = threadIdx.x; asm volatile("" : "+v"(tid)); const int lane = tid & 63, r32 = lane & 31, hi = lane >> 5; const int wid = __builtin_amdgcn_readfirstlane(tid >> 6);
    const int q0 = qb * 256 + wid * 32;
    const int qi = q0 + r32;
    const size_t tokb = (size_t)b * SEQ;
    bf16x8 qf[6];
    { const bf16_t* qp = Q + (tokb + qi) * (AH * AQK) + h * AQK + 8 * hi;
#pragma unroll
      for (int s = 0; s < 6; ++s) qf[s] = *(const bf16x8*)(qp + 16 * s); }
    const int kkey = tid >> 3, kch = tid & 7, pkey = (tid & 255) >> 2, pch = tid & 3, vd = tid >> 3, vch = tid & 7;
    const bf16_t* ksrc = Kn + (tokb + kkey) * 512 + h * 64 + kch * 8;
    const bf16_t* psrc = Kpe + (tokb + pkey) * 32 + pch * 8;
    const bf16_t* vsrc = Vt + (size_t)(h * 64 + vd) * T + tokb + vch * 8;
    const int kdst = kkey * AT_KROW + kch * 16, pdst = pkey * AT_KROW + 128 + pch * 16, vdst = AT_VOFF + vd * AT_VROW + vch * 16;
    const int nkt = 4 * (qb + 1);
    u32x4 rk, rp, rv;
    rk = *(const u32x4*)ksrc; rv = *(const u32x4*)vsrc; rp = (u32x4){0u, 0u, 0u, 0u}; if (tid < 256) rp = *(const u32x4*)psrc;
    *(LAS u32x4*)(lds + kdst) = rk; if (tid < 256) *(LAS u32x4*)(lds + pdst) = rp;
    *(LAS u32x2*)(lds + vdst) = (u32x2){rv.x, rv.y}; *(LAS u32x2*)(lds + vdst + 8) = (u32x2){rv.z, rv.w};
    __syncthreads();
    float m_run = -INFINITY, l_run = 0.f;
    f32x16 o0, o1;
#pragma unroll
    for (int r = 0; r < 16; ++r) { o0[r] = 0.f; o1[r] = 0.f; }
    for (int kt = 0; kt < nkt; ++kt) {
        const int buf = kt & 1;
        if (kt + 1 < nkt) { rk = *(const u32x4*)(ksrc + (size_t)(kt + 1) * 64 * 512); rv = *(const u32x4*)(vsrc + (kt + 1) * 64); if (tid < 256) rp = *(const u32x4*)(psrc + (size_t)(kt + 1) * 64 * 32); }
        const int key0 = kt * 64;
        if (key0 <= q0 + 31) {
            const LAS unsigned char* kb = lds + buf * AT_KBUF + r32 * AT_KROW + hi * 16;
            f32x16 p0, p1;
#pragma unroll
            for (int r = 0; r < 16; ++r) { p0[r] = 0.f; p1[r] = 0.f; }
#pragma unroll
            for (int s = 0; s < 6; ++s) { const bf16x8 a0 = *(const LAS bf16x8*)(kb + s * 32), a1 = *(const LAS bf16x8*)(kb + 32 * AT_KROW + s * 32);
                p0 = MFMA32(a0, qf[s], p0); p1 = MFMA32(a1, qf[s], p1); }
            if (key0 + 63 > q0) {
#pragma unroll
                for (int r = 0; r < 16; ++r) { const int key = key0 + crow(r, hi); if (key > qi) p0[r] = -INFINITY; if (key + 32 > qi) p1[r] = -INFINITY; }
            }
            float mx = fmaxf(p0[0], p1[0]);
#pragma unroll
            for (int r = 1; r < 16; ++r) mx = fmaxf(mx, fmaxf(p0[r], p1[r]));
            mx = fmaxf(mx, __shfl_xor(mx, 32));
            const float m_new = fmaxf(m_run, mx);
            const float alpha = __builtin_amdgcn_exp2f(m_run - m_new);
            m_run = m_new;
            float ls = 0.f;
#pragma unroll
            for (int r = 0; r < 16; ++r) { p0[r] = __builtin_amdgcn_exp2f(p0[r] - m_new); p1[r] = __builtin_amdgcn_exp2f(p1[r] - m_new); ls += p0[r] + p1[r]; }
            l_run = l_run * alpha + ls;
#pragma unroll
            for (int r = 0; r < 16; ++r) { o0[r] *= alpha; o1[r] *= alpha; }
            bf16x8 pb[4];
#pragma unroll
            for (int s = 0; s < 4; ++s) { u32x4 w;
                if (s < 2) { w.x = pk2(p0[8 * s], p0[8 * s + 1]); w.y = pk2(p0[8 * s + 2], p0[8 * s + 3]); w.z = pk2(p0[8 * s + 4], p0[8 * s + 5]); w.w = pk2(p0[8 * s + 6], p0[8 * s + 7]); }
                else { const int s2 = s - 2; w.x = pk2(p1[8 * s2], p1[8 * s2 + 1]); w.y = pk2(p1[8 * s2 + 2], p1[8 * s2 + 3]); w.z = pk2(p1[8 * s2 + 4], p1[8 * s2 + 5]); w.w = pk2(p1[8 * s2 + 6], p1[8 * s2 + 7]); }
                pb[s] = __builtin_bit_cast(bf16x8, w); }
            const LAS unsigned char* vb = lds + AT_VOFF + buf * AT_VBUF + r32 * AT_VROW + hi * 8;
#pragma unroll
            for (int s = 0; s < 4; ++s) {
                const u32x2 a0l = *(const LAS u32x2*)(vb + s * 32), a0h = *(const LAS u32x2*)(vb + s * 32 + 16);
                const u32x2 a1l = *(const LAS u32x2*)(vb + 32 * AT_VROW + s * 32), a1h = *(const LAS u32x2*)(vb + 32 * AT_VROW + s * 32 + 16);
                const bf16x8 a0 = __builtin_bit_cast(bf16x8, (u32x4){a0l.x, a0l.y, a0h.x, a0h.y}), a1 = __builtin_bit_cast(bf16x8, (u32x4){a1l.x, a1l.y, a1h.x, a1h.y});
                o0 = MFMA32(a0, pb[s], o0); o1 = MFMA32(a1, pb[s], o1); }
        }
        if (kt + 1 < nkt) { const int nb = (kt + 1) & 1;
            *(LAS u32x4*)(lds + nb * AT_KBUF + kdst) = rk; if (tid < 256) *(LAS u32x4*)(lds + nb * AT_KBUF + pdst) = rp;
            *(LAS u32x2*)(lds + nb * AT_VBUF + vdst) = (u32x2){rv.x, rv.y}; *(LAS u32x2*)(lds + nb * AT_VBUF + vdst + 8) = (u32x2){rv.z, rv.w}; }
        __syncthreads();
    }
    const float lt = l_run + __shfl_xor(l_run, 32); const float inv = 1.0f / lt;
    bf16_t* op = O + (tokb + qi) * AW + h * AVD + 4 * hi;
#pragma unroll
    for (int g = 0; g < 4; ++g) { u32x2 w0, w1;
        w0.x = pk2(o0[4 * g] * inv, o0[4 * g + 1] * inv); w0.y = pk2(o0[4 * g + 2] * inv, o0[4 * g + 3] * inv);
        w1.x = pk2(o1[4 * g] * inv, o1[4 * g + 1] * inv); w1.y = pk2(o1[4 * g + 2] * inv, o1[4 * g + 3] * inv);
        *(u32x2*)(op + 8 * g) = w0; *(u32x2*)(op + 32 + 8 * g) = w1; }
}
DI void p4_attention(const Args& args, LAS unsigned char* lds, int vcu, int G) {
    unsigned char* ws = args.ws;
    const bf16_t* Q = (const bf16_t*)(ws + WS_QMLA); const bf16_t* Kn = (const bf16_t*)(ws + WS_KN); const bf16_t* Kpe = (const bf16_t*)(ws + WS_KPE); const bf16_t* Vt = (const bf16_t*)(ws + WS_VT);
    bf16_t* O = (bf16_t*)(ws + WS_AO);
    for (int p = vcu; p < NB * AH * 4; p += G) { const int bh = p >> 2, j = p & 3; const int b = bh / AH, h = bh % AH;
        mla_unit(b, h, 7 - j, Q, Kn, Kpe, Vt, O, lds);
        mla_unit(b, h, j, Q, Kn, Kpe, Vt, O, lds); }
}

constexpr int ML_QROW = 272, ML_TROW = 144;
constexpr int ML_QS = 0, ML_KS = ML_QS + 64 * ML_QROW, ML_KTS = ML_KS + 64 * ML_QROW, ML_VTS = ML_KTS + 128 * ML_TROW, ML_CS = ML_VTS + 32 * ML_TROW, ML_SS = ML_CS + 32 * ML_QROW,
              ML_VEC = ML_SS + 64 * ML_TROW;
static_assert(ML_VEC + (7 * 64 + 128 + 4) * 4 <= RING_BYTES, "mLSTM LDS");
DI void mlstm_unit(int b, int h, int vs, const Args& args, LAS unsigned char* lds) {
    unsigned char* ws = args.ws;
    const bf16_t* qkm = (const bf16_t*)(ws + WS_QKM); const bf16_t* ktm = (const bf16_t*)(ws + WS_KTM); const bf16_t* proj = (const bf16_t*)(ws + WS_PROJ);
    const float* gates = (const float*)(ws + WS_GATES); float* hraw = (float*)(ws + WS_HRAW);
    const float b_i = ((const float*)args.in[4])[h], b_f = ((const float*)args.in[5])[h];
    int tid = threadIdx.x; asm volatile("" : "+v"(tid)); const int lane = tid & 63, r32 = lane & 31, hi = lane >> 5; const int wid = __builtin_amdgcn_readfirstlane(tid >> 6);
    LAS float* ROWT = (LAS float*)(lds + ML_VEC); LAS float* COLT = ROWT + 64; LAS float* WINT = ROWT + 128; LAS float* ENEG = ROWT + 192; LAS float* WAS = ROWT + 256;
    LAS float* NQ = ROWT + 320; LAS float* DINV = ROWT + 384; LAS float* NVEC = ROWT + 448; LAS float* SCAL = ROWT + 576;
    const size_t tokb = (size_t)b * SEQ;
    for (int i = tid; i < 32 * ML_QROW / 4; i += 512) ((LAS unsigned*)(lds + ML_CS))[i] = 0u;
    if (tid < 128) NVEC[tid] = 0.f;
    f32x16 cacc;
#pragma unroll
    for (int r = 0; r < 16; ++r) cacc[r] = 0.f;
    float m_st = 0.f;
    u32x4 sq[2], sk[2], skt[2], sv; float gi = 0.f, gf = 0.f;
    sv = (u32x4){0u, 0u, 0u, 0u};
#define ML_LOAD(c) do { const size_t tok0 = tokb + (size_t)(c) * MCH; \
        _Pragma("unroll") for (int i = 0; i < 2; ++i) { const int idx = tid + 512 * i; \
            sq[i] = *(const u32x4*)(qkm + (tok0 + (idx >> 4)) * 1024 + h * MHD + (idx & 15) * 8); \
            sk[i] = *(const u32x4*)(qkm + (tok0 + (idx >> 4)) * 1024 + 512 + h * MHD + (idx & 15) * 8); \
            skt[i] = *(const u32x4*)(ktm + (size_t)(h * MHD + (idx >> 3)) * T + tok0 + (idx & 7) * 8); } \
        if (tid < 256) sv = *(const u32x4*)(proj + (tok0 + (tid >> 2)) * NPROJ + PC_VM + h * MHD + vs * 32 + (tid & 3) * 8); \
        if (wid == 0) { gi = gates[(tok0 + lane) * 8 + h]; gf = gates[(tok0 + lane) * 8 + 4 + h]; } } while (0)
    ML_LOAD(0);
    for (int c = 0; c < SEQ / MCH; ++c) {
        const size_t tok0 = tokb + (size_t)c * MCH;
#pragma unroll
        for (int i = 0; i < 2; ++i) { const int idx = tid + 512 * i;
            *(LAS u32x4*)(lds + ML_QS + (idx >> 4) * ML_QROW + (idx & 15) * 16) = sq[i];
            *(LAS u32x4*)(lds + ML_KS + (idx >> 4) * ML_QROW + (idx & 15) * 16) = sk[i];
            *(LAS u32x4*)(lds + ML_KTS + (idx >> 3) * ML_TROW + (idx & 7) * 16) = skt[i]; }
        if (tid < 256) { const int l = tid >> 2, v0 = (tid & 3) * 8; LAS bf16_t* vt = (LAS bf16_t*)(lds + ML_VTS);
            vt[(v0 + 0) * (ML_TROW / 2) + l] = (bf16_t)(sv.x & 0xffff); vt[(v0 + 1) * (ML_TROW / 2) + l] = (bf16_t)(sv.x >> 16);
            vt[(v0 + 2) * (ML_TROW / 2) + l] = (bf16_t)(sv.y & 0xffff); vt[(v0 + 3) * (ML_TROW / 2) + l] = (bf16_t)(sv.y >> 16);
            vt[(v0 + 4) * (ML_TROW / 2) + l] = (bf16_t)(sv.z & 0xffff); vt[(v0 + 5) * (ML_TROW / 2) + l] = (bf16_t)(sv.z >> 16);
            vt[(v0 + 6) * (ML_TROW / 2) + l] = (bf16_t)(sv.w & 0xffff); vt[(v0 + 7) * (ML_TROW / 2) + l] = (bf16_t)(sv.w >> 16); }
        if (wid == 0) {
            const float xf = gf + b_f;
            const float lf = (xf >= 0.f) ? -log1pf(__expf(-xf)) : xf - log1pf(__expf(xf));
            float bb = lf;
#pragma unroll
            for (int o = 1; o < 64; o <<= 1) { const float tv = __shfl_up(bb, o); if (lane >= o) bb += tv; }
            const float btot = __shfl(bb, 63);
            const float ig = gi + b_i;
            const float a = btot - bb + ig;
            const float mchunk = wave_max(a);
            const float wa = __expf(a - mchunk);
            const float u = ig - bb;
            float pm = u;
#pragma unroll
            for (int o = 1; o < 64; o <<= 1) { const float tv = __shfl_up(pm, o); if (lane >= o) pm = fmaxf(pm, tv); }
            const float mintra = bb + pm;
            const float ginter = bb + m_st;
            const float m = fmaxf(ginter, mintra);
            const float mnew = fmaxf(btot + m_st, mchunk);
            const float sold = __expf(btot + m_st - mnew), snew = __expf(mchunk - mnew);
            ROWT[lane] = bb - m; COLT[lane] = u; WINT[lane] = __expf(ginter - m); ENEG[lane] = __expf(-m); WAS[lane] = snew * wa;
            if (lane == 0) SCAL[0] = sold;
            m_st = mnew;
        }
        __syncthreads();
        if (c + 1 < SEQ / MCH) ML_LOAD(c + 1);
        f32x16 iacc;
#pragma unroll
        for (int r = 0; r < 16; ++r) iacc[r] = 0.f;
        if (wid < 4) {
            const int jb = wid >> 1, sb = wid & 1;
            LAS bf16_t* ss = (LAS bf16_t*)(lds + ML_SS);
            if (sb <= jb) {
                f32x16 s;
#pragma unroll
                for (int r = 0; r < 16; ++r) s[r] = 0.f;
                const LAS unsigned char* qa = lds + ML_QS + (32 * jb + r32) * ML_QROW + hi * 16; const LAS unsigned char* kb = lds + ML_KS + (32 * sb + r32) * ML_QROW + hi * 16;
#pragma unroll
                for (int kk = 0; kk < 8; ++kk) s = MFMA32(*(const LAS bf16x8*)(qa + kk * 32), *(const LAS bf16x8*)(kb + kk * 32), s);
                const int sidx = 32 * sb + r32; const float ct = COLT[sidx];
#pragma unroll
                for (int r = 0; r < 16; ++r) { const int j = 32 * jb + crow(r, hi);
                    const float val = (sidx <= j) ? s[r] * __expf(ROWT[j] + ct) : 0.f;
                    ss[j * (ML_TROW / 2) + sidx] = (bf16_t)f2bf(val); }
            } else {
#pragma unroll
                for (int r = 0; r < 16; ++r) ss[(32 * jb + crow(r, hi)) * (ML_TROW / 2) + 32 * sb + r32] = (bf16_t)0;
            }
        } else if (wid < 6) {
            const int jb = wid - 4;
            const LAS unsigned char* qa = lds + ML_QS + (32 * jb + r32) * ML_QROW + hi * 16; const LAS unsigned char* cb = lds + ML_CS + r32 * ML_QROW + hi * 16;
#pragma unroll
            for (int kk = 0; kk < 8; ++kk) iacc = MFMA32(*(const LAS bf16x8*)(qa + kk * 32), *(const LAS bf16x8*)(cb + kk * 32), iacc);
        } else {
            const int j = 32 * (wid - 6) + (lane >> 1), half = lane & 1;
            const LAS unsigned char* qa = lds + ML_QS + j * ML_QROW + half * 128; float acc = 0.f;
#pragma unroll
            for (int i = 0; i < 8; ++i) { const u32x4 w = *(const LAS u32x4*)(qa + i * 16); const f32x4 n0 = *(const LAS f32x4*)(NVEC + half * 64 + i * 8), n1 = *(const LAS f32x4*)(NVEC + half * 64 + i * 8 + 4);
                acc += bflo(w.x) * n0[0] + bfhi(w.x) * n0[1] + bflo(w.y) * n0[2] + bfhi(w.y) * n0[3] + bflo(w.z) * n1[0] + bfhi(w.z) * n1[1] + bflo(w.w) * n1[2] + bfhi(w.w) * n1[3]; }
            acc += __shfl_xor(acc, 1);
            if (half == 0) NQ[j] = acc;
        }
        __syncthreads();
        if (wid < 4) {
            const float sold = SCAL[0];
#pragma unroll
            for (int r = 0; r < 16; ++r) cacc[r] *= sold;
            const LAS unsigned char* va = lds + ML_VTS + r32 * ML_TROW + hi * 16; const LAS unsigned char* kb = lds + ML_KTS + (32 * wid + r32) * ML_TROW + hi * 16;
#pragma unroll
            for (int kk = 0; kk < 4; ++kk) { const u32x4 w = *(const LAS u32x4*)(va + kk * 32);
                const f32x4 w0 = *(const LAS f32x4*)(WAS + 16 * kk + 8 * hi), w1 = *(const LAS f32x4*)(WAS + 16 * kk + 8 * hi + 4);
                u32x4 sa; sa.x = pk2(bflo(w.x) * w0[0], bfhi(w.x) * w0[1]); sa.y = pk2(bflo(w.y) * w0[2], bfhi(w.y) * w0[3]); sa.z = pk2(bflo(w.z) * w1[0], bfhi(w.z) * w1[1]); sa.w = pk2(bflo(w.w) * w1[2], bfhi(w.w) * w1[3]);
                cacc = MFMA32(__builtin_bit_cast(bf16x8, sa), *(const LAS bf16x8*)(kb + kk * 32), cacc); }
            LAS bf16_t* cs = (LAS bf16_t*)(lds + ML_CS);
#pragma unroll
            for (int r = 0; r < 16; ++r) cs[crow(r, hi) * (ML_QROW / 2) + 32 * wid + r32] = (bf16_t)f2bf(cacc[r]);
        } else if (wid < 6) {
            const int jb = wid - 4;
#pragma unroll
            for (int r = 0; r < 16; ++r) iacc[r] *= WINT[32 * jb + crow(r, hi)];
            const LAS unsigned char* sa = lds + ML_SS + (32 * jb + r32) * ML_TROW + hi * 16; const LAS unsigned char* vb = lds + ML_VTS + r32 * ML_TROW + hi * 16;
#pragma unroll
            for (int kk = 0; kk < 4; ++kk) iacc = MFMA32(*(const LAS bf16x8*)(sa + kk * 32), *(const LAS bf16x8*)(vb + kk * 32), iacc);
        } else {
            const int tl = (wid - 6) * 64 + lane;
            { const int j = tl >> 1, half = tl & 1; const LAS unsigned char* sp = lds + ML_SS + j * ML_TROW + half * 64; float rs = 0.f;
#pragma unroll
              for (int i = 0; i < 4; ++i) { const u32x4 w = *(const LAS u32x4*)(sp + i * 16); rs += (bflo(w.x) + bfhi(w.x)) + (bflo(w.y) + bfhi(w.y)) + (bflo(w.z) + bfhi(w.z)) + (bflo(w.w) + bfhi(w.w)); }
              rs += __shfl_xor(rs, 1);
              if (half == 0) { const float den = WINT[j] * NQ[j] + rs; DINV[j] = 1.0f / fmaxf(fabsf(den), ENEG[j]); } }
            { const int k = tl; const LAS unsigned char* kp = lds + ML_KTS + k * ML_TROW; float acc = SCAL[0] * NVEC[k];
#pragma unroll
              for (int i = 0; i < 8; ++i) { const u32x4 w = *(const LAS u32x4*)(kp + i * 16); const f32x4 w0 = *(const LAS f32x4*)(WAS + i * 8), w1 = *(const LAS f32x4*)(WAS + i * 8 + 4);
                  acc += bflo(w.x) * w0[0] + bfhi(w.x) * w0[1] + bflo(w.y) * w0[2] + bfhi(w.y) * w0[3] + bflo(w.z) * w1[0] + bfhi(w.z) * w1[1] + bflo(w.w) * w1[2] + bfhi(w.w) * w1[3]; }
              NVEC[k] = acc; }
        }
        __syncthreads();
        if (wid == 4 || wid == 5) {
            const int jb = wid - 4; float* hp = hraw + (tok0 + 32 * jb) * MW + h * MHD + vs * 32 + r32;
#pragma unroll
            for (int r = 0; r < 16; ++r) { const int j = crow(r, hi); hp[(size_t)j * MW] = iacc[r] * DINV[32 * jb + j]; }
        }
    }
#undef ML_LOAD
    __syncthreads();
}
DI void p5_mlstm(const Args& args, LAS unsigned char* lds, int vcu, int G) {
    for (int u = vcu; u < NB * MH * 4; u += G) { const int vs = u & 3, bh = u >> 2; mlstm_unit(bh / MH, bh % MH, vs, args, lds); }
}
#ifndef MK_ONE_LAUNCH
#define MK_ONE_LAUNCH 1
#endif
#ifndef P3SEL
#define P3SEL 31
#endif
constexpr int NPH = 20;
__global__ void __launch_bounds__(NWAVES * 64, 2) fwd_kernel(Args args) {
    extern __shared__ __attribute__((aligned(16))) unsigned char lds_raw[];
    LAS unsigned char* lds = (LAS unsigned char*)lds_raw;
    const int tid = threadIdx.x;
    const int G = gridDim.x; const int bx = blockIdx.x; const int vcu = (G % 8 == 0) ? (bx % 8) * (G / 8) + bx / 8 : bx;
    unsigned char* ws = args.ws;
    for (int u = tid; u < (LDS_BYTES - LDSCTL_OFF) / 4; u += NWAVES * 64) ((LAS unsigned*)(lds + LDSCTL_OFF))[u] = 0u;
    __syncthreads();
    volatile LAS unsigned* MISC = (volatile LAS unsigned*)(lds + MISC_OFF);
    XcdBarrier bar; bar.bar = (unsigned*)(ws + WS_CTL) + CW_BAR; bar.x = 0; bar.st = nullptr;
    const int lo = args.ph_lo, hi = args.ph_hi;
    if (hi - lo > 1) bar = xcd_barrier_post((unsigned*)(ws + WS_CTL) + CW_BAR, MISC + 8);
#ifndef PHASE_MASK
#define PHASE_MASK 0xFFFFFu
#endif
#define IN(k) (((PHASE_MASK >> (k)) & 1u) && lo <= (k) && (k) < hi)
#ifndef DUP_PHASE
#define DUP_PHASE -1
#endif
#define REP(k) _Pragma("unroll 1") for (int rep_ = 0; rep_ < ((DUP_PHASE == (k)) ? 2 : 1); ++rep_)
#define SEAM(k) do { if (IN(k) && IN((k) + 1)) xcd_barrier(bar); } while (0)
    using namespace pg8;
    LAS unsigned char* ring = lds + RING_OFF;
    const bf16_t* cws = (const bf16_t*)ws;
#define WSB(off) ((bf16_t*)(ws + (off)))
#define WSF(off) ((float*)(ws + (off)))

    if (IN(0)) REP(0) { p0_prologue(args, lds, vcu, G); }
    SEAM(0);
    if (IN(1)) REP(1) {
        { DenseOrder S; S.init(WSB(WS_XB), WSB(WS_W_IN), T, NPROJ, D, D, G, bx); EpiProj E{WSB(WS_PROJ), WSF(WS_GATES)}; gemm_phase(ring, D, D, D, S, E); }
        { DenseOrder S; S.init(WSB(WS_MEMB), WSB(WS_W_CK), NB * NMEM, D, D, D, G, bx); EpiBf16 E{WSB(WS_KC), D, 1 << 30, 1.f}; gemm_phase(ring, D, D, D, S, E); }
        { DenseOrder S; S.init(WSB(WS_W_CV), WSB(WS_MEMB), D, NB * NMEM, D, D, G, bx); EpiBf16 E{WSB(WS_VCT), NB * NMEM, 1 << 30, 1.f}; gemm_phase(ring, D, D, D, S, E); }
    }
    SEAM(1);
    if (IN(2)) REP(2) { p2_tokens(args, vcu, G); }
    SEAM(2);
    if (IN(3)) REP(3) {
        if (P3SEL & 1) { DenseOrder S; S.init(WSB(WS_QN), WSB(WS_W_UQ), T, AH * AQK, 256, 256, G, bx); EpiQmla E{WSB(WS_QMLA), WSF(WS_CS), 0.10206207261596575f * 1.4426950408889634f}; gemm_phase(ring, 256, 256, 256, S, E); }
        if (P3SEL & 2) { DenseOrder S; S.init(WSB(WS_KVN), WSB(WS_W_UK), T, 512, 256, 256, G, bx); EpiBf16 E{WSB(WS_KN), 512, 1 << 30, 1.f}; gemm_phase(ring, 256, 256, 256, S, E); }
        if (P3SEL & 4) { DenseOrder S; S.init(WSB(WS_W_UV), WSB(WS_KVN), 512, T, 256, 256, G, bx); EpiBf16 E{WSB(WS_VT), T, 1 << 30, 1.f}; gemm_phase(ring, 256, 256, 256, S, E); }
        if (P3SEL & 8) { DenseOrder S; S.init(WSB(WS_XC), WSB(WS_W_MQK), T, 1024, 512, 512, G, bx); EpiBf16 E{WSB(WS_QKM), 1024, 2, 0.08838834764831845f}; gemm_phase(ring, 512, 512, 512, S, E); }
        if (P3SEL & 16) { DenseOrder S; S.init(WSB(WS_W_MQK) + 512 * 512, WSB(WS_XC), 512, T, 512, 512, G, bx); EpiBf16 E{WSB(WS_KTM), T, 0, 0.08838834764831845f}; gemm_phase(ring, 512, 512, 512, S, E); }
    }
    SEAM(3);
    if (IN(4)) { REP(40) { p5_mlstm(args, lds, vcu, G); } REP(41) { p4_attention(args, lds, vcu, G); } }
    SEAM(4);
    if (IN(5)) REP(5) { p6_mpost(args, vcu, G); }
    SEAM(5);
    if (IN(6)) REP(6) {
        { DenseOrder S; S.init(WSB(WS_HM), WSB(WS_W_BRM), T, D, 512, 512, G, bx); EpiGate<false> E{WSB(WS_GATED), WSB(WS_PROJ), PC_GM}; gemm_phase(ring, 512, 512, 512, S, E); }
        { DenseOrder S; S.init(WSB(WS_AO), WSB(WS_W_BRA), T, D, 512, 512, G, bx); EpiGate<true> E{WSB(WS_GATED), WSB(WS_PROJ), PC_GA}; gemm_phase(ring, 512, 512, 512, S, E); }
    }
    SEAM(6);
    if (IN(7)) REP(7) { DenseOrder S; S.init(WSB(WS_GATED), WSB(WS_W_MIX), T, D, D, D, G, bx); EpiF32 E{WSF(WS_MIXO), D, 1 << 30}; gemm_phase(ring, D, D, D, S, E); }
    SEAM(7);
    if (IN(8)) REP(8) { ln_pass((const float*)args.in[0], WSF(WS_MIXO), (const float*)args.in[19], (const float*)args.in[20], args.out, WSB(WS_H1B), vcu, G); }
    SEAM(8);
    if (IN(9)) REP(9) { DenseOrder S; S.init(WSB(WS_H1B), WSB(WS_W_CQ), T, D, D, D, G, bx); EpiBf16 E{WSB(WS_QC), D, 0, 0.0625f * 1.4426950408889634f}; gemm_phase(ring, D, D, D, S, E); }
    SEAM(9);
    if (IN(10)) REP(10) { CrossSOrder S{(const char*)(ws + WS_QC), (const char*)(ws + WS_KC), G, vcu}; EpiSoftmax E{WSB(WS_PC), (LAS float*)(lds + RED_OFF)}; gemm_phase(ring, 256, D, D, S, E); }
    SEAM(10);
    if (IN(11)) REP(11) { CrossOOrder S{(const char*)(ws + WS_PC), (const char*)(ws + WS_VCT), G, vcu}; EpiBf16 E{WSB(WS_OC), D, 1 << 30, 1.f}; gemm_phase(ring, 256, D, NB * NMEM, S, E); }
    SEAM(11);
    if (IN(12)) REP(12) { DenseOrder S; S.init(WSB(WS_OC), WSB(WS_W_CO), T, D, D, D, G, bx); EpiF32 E{WSF(WS_COO), D, 1 << 30}; gemm_phase(ring, D, D, D, S, E); }
    SEAM(12);
    if (IN(13)) REP(13) { ln_pass(args.out, WSF(WS_COO), (const float*)args.in[24], (const float*)args.in[25], args.out, WSB(WS_H2B), vcu, G); }
    SEAM(13);
    if (IN(14)) REP(14) { DenseOrder S; S.init(WSB(WS_H2B), WSB(WS_W_R), T, 256, D, D, G, bx); EpiF32 E{WSF(WS_LOGITS), NE, NE}; gemm_phase(ring, D, D, D, S, E); }
    SEAM(14);
    if (IN(15)) REP(15) { p16_topk(args, lds, vcu, G); }
    SEAM(15);
    if (IN(16)) REP(16) { p17_gather(args, lds, vcu, G); }
    SEAM(16);
    if (IN(17)) REP(17) { build_tstart(args, lds);
        MoeOrder S{(const char*)(ws + WS_XG), (const char*)(ws + WS_W_GU), (const LAS int*)(lds + TST_OFF), 8, G, vcu, (size_t)256 * D * 2, (size_t)2048 * 1024 * 2};
        EpiSwiglu E{WSB(WS_ACT), (const float*)args.in[29]}; gemm_phase(ring, D, D, D, S, E); }
    SEAM(17);
    if (IN(18)) REP(18) { build_tstart(args, lds);
        MoeOrder S{(const char*)(ws + WS_ACT), (const char*)(ws + WS_W_DN), (const LAS int*)(lds + TST_OFF), 4, G, vcu, (size_t)256 * D * 2, (size_t)1024 * 1024 * 2};
        EpiDown E{WSB(WS_YB), (const float*)args.in[31], WSF(WS_ROWGATE)}; gemm_phase(ring, D, D, D, S, E); }
    SEAM(18);
    if (IN(19)) REP(19) { p20_final(args, vcu, G); }
    (void)cws;
#undef IN
#undef SEAM
}

extern "C" void kernel_launch(void* const* d_in, const int* in_sizes, int n_in, void* d_out, int out_size, void* d_ws, size_t ws_size, hipStream_t stream) {
    static int grid = 0;
    if (grid == 0) {
        if (n_in != 34 || in_sizes[0] != T * D || out_size != T * D || ws_size < WS_END) { fprintf(stderr, "kernel_launch: unexpected shapes / workspace (n_in %d, ws %zu)\n", n_in, ws_size); grid = -1; return; }
        int dev = 0, cus = 0, per_cu = 0;
        if (hipGetDevice(&dev) != hipSuccess || hipDeviceGetAttribute(&cus, hipDeviceAttributeMultiprocessorCount, dev) != hipSuccess) { grid = -1; return; }
        if (hipFuncSetAttribute((const void*)fwd_kernel, hipFuncAttributeMaxDynamicSharedMemorySize, LDS_BYTES) != hipSuccess) { fprintf(stderr, "kernel_launch: hipFuncSetAttribute failed\n"); grid = -1; return; }
        if (hipOccupancyMaxActiveBlocksPerMultiprocessor(&per_cu, (const void*)fwd_kernel, NWAVES * 64, LDS_BYTES) != hipSuccess || per_cu < 1) fprintf(stderr, "kernel_launch: occupancy query says %d\n", per_cu);
        (void)hipGetLastError();
        grid = cus;
    }
    if (grid < 0) return;
    if (hipMemsetAsync((char*)d_ws + WS_CTL, 0, CTL_ZERO_BYTES, stream) != hipSuccess) return;
    Args a{};
    for (int i = 0; i < 34; ++i) a.in[i] = d_in[i];
    a.out = (float*)d_out; a.ws = (unsigned char*)d_ws;
#if MK_ONE_LAUNCH
    a.ph_lo = 0; a.ph_hi = NPH;
    hipLaunchKernelGGL(fwd_kernel, dim3(grid), dim3(NWAVES * 64), LDS_BYTES, stream, a);
#else
    for (int p = 0; p < NPH; ++p) { a.ph_lo = p; a.ph_hi = p + 1; hipLaunchKernelGGL(fwd_kernel, dim3(grid), dim3(NWAVES * 64), LDS_BYTES, stream, a); }
#endif
}
```

```cpp
#include <hip/hip_runtime.h>
#include <cstdio>
#include <cstdint>
#include <cmath>

#define LAS __attribute__((address_space(3)))
#define GAS __attribute__((address_space(1)))
typedef unsigned short bf16_t;
typedef short bf16x8 __attribute__((ext_vector_type(8)));
typedef float f32x4 __attribute__((ext_vector_type(4)));
typedef float f32x2 __attribute__((ext_vector_type(2)));
typedef float f32x16 __attribute__((ext_vector_type(16)));
typedef unsigned u32x4 __attribute__((ext_vector_type(4)));
typedef unsigned u32x2 __attribute__((ext_vector_type(2)));
typedef GAS unsigned gu32;
#define RLX_AGENT __ATOMIC_RELAXED, __HIP_MEMORY_SCOPE_AGENT
#define DI __device__ __forceinline__

constexpr int D = 1024, NB = 16, SEQ = 2048, T = NB * SEQ, NMEM = 256;
constexpr int MH = 4, MHD = 128, MW = 512, MCH = 64;
constexpr int AH = 8, ANOPE = 64, AROPE = 32, AQK = 96, AVD = 64, AW = 512, AQR = 256, AKVR = 128;
constexpr int XH = 4, XHD = 256;
constexpr int NE = 32, TOPK = 4;
constexpr int DIN = 4008, NPROJ = 4096;
constexpr float DN_ALPHA = 1.189207115002721f;
constexpr float EPS = 1e-5f;
constexpr int NASSIGN = T * TOPK;
constexpr int NROWS = NASSIGN + NE * 256;
constexpr int NTILES_MAX = NROWS / 256;
constexpr int PC_QLAT = 0, PC_KVLAT = 256, PC_KROPE = 384, PC_IG = 416, PC_FG = 420, PC_XM = 512, PC_VM = 1024, PC_OP = 1536, PC_GM = 2048, PC_GA = 3072;

DI unsigned f2bf(float f) { unsigned u = __builtin_bit_cast(unsigned, f); return (u + 0x7fffu + ((u >> 16) & 1u)) >> 16; }
DI unsigned pk2(float lo, float hi) { return f2bf(lo) | (f2bf(hi) << 16); }
DI float bf2f(unsigned short b) { return __builtin_bit_cast(float, (unsigned)b << 16); }
DI float bflo(unsigned w) { return __builtin_bit_cast(float, w << 16); }
DI float bfhi(unsigned w) { return __builtin_bit_cast(float, w & 0xffff0000u); }
DI float wave_sum(float v) {
#pragma unroll
    for (int o = 1; o < 64; o <<= 1) v += __shfl_xor(v, o);
    return v;
}
DI float wave_max(float v) {
#pragma unroll
    for (int o = 1; o < 64; o <<= 1) v = fmaxf(v, __shfl_xor(v, o));
    return v;
}
DI float sigmoidf_(float x) { return 1.0f / (1.0f + __expf(-x)); }
DI int crow(int r, int hi) { return (r & 3) + 8 * (r >> 2) + 4 * hi; }
#define MFMA32(a, b, c) __builtin_amdgcn_mfma_f32_32x32x16_bf16((a), (b), (c), 0, 0, 0)

namespace pg8 {
constexpr int BM = 256, BK = 64, HALF = 128, HTB = HALF * BK * 2, STAGE_BYTES = 8 * HTB;
__host__ __device__ __forceinline__ int lds_byte(int r, int c) { const int st = (r >> 4) * 2 + (c >> 5), rr = r & 15, cc = c & 31, ob = rr * 64 + cc * 2; return st * 1024 + (ob ^ (((ob >> 9) & 1) << 5)); }
__host__ __device__ __forceinline__ void stage_rc(int b, int& R, int& C) { const int st = b / 1024, sb = b % 1024, swz = sb ^ (((sb >> 9) & 1) << 5); R = (st >> 1) * 16 + swz / 64; C = (st & 1) * 32 + (swz % 64) / 2; }
__host__ __device__ __forceinline__ int perm32(int rho) { const int n = rho >> 4, i = rho & 15; return 8 * (i >> 2) + 4 * n + (i & 3); }

struct Unit { int pm, pn, aux; const char* a; const char* b; };
struct Ctx { int wr, wc, fr, fq, wid, lane; };

DI unsigned cvt_pk_bf16(float lo, float hi) { unsigned r; asm volatile("v_cvt_pk_bf16_f32 %0, %1, %2" : "=v"(r) : "v"(lo), "v"(hi)); return r; }

typedef f32x4 Acc[2][2][4][2];

DI void glds16_s(const char* gbase, unsigned voff, unsigned lds_dst) { unsigned keep;
    asm volatile("s_mov_b32 %0, m0\n\ts_mov_b32 m0, %1\n\ts_nop 0\n\tglobal_load_lds_dwordx4 %2, %3\n\ts_mov_b32 m0, %0" : "=&s"(keep) : "s"(lds_dst), "v"(voff), "s"(gbase) : "memory"); }
typedef int v8i_t __attribute__((ext_vector_type(8)));
typedef int i32x4_t __attribute__((ext_vector_type(4)));
template <class Epi, class Sched, bool FP8 = false>
DI void gemm_phase(LAS unsigned char* lds, const int K, const int lda, const int ldb, const Sched& S, const Epi& E) {
    int tid = threadIdx.x; asm volatile("" : "+v"(tid));
    const int wid = __builtin_amdgcn_readfirstlane(tid >> 6), lane = tid & 63, wr = wid >> 2, wc = wid & 3, fr = lane & 15, fq = lane >> 4;
    constexpr int ESZ = FP8 ? 1 : 2;
    const int nt = K * ESZ / (BK * 2);
    unsigned voffA[2], voffB[2];
#pragma unroll
    for (int i = 0; i < 2; ++i) { int R, C; stage_rc(tid * 16 + i * 8192, R, C); const int Rb = Epi::PERM ? ((R & ~31) + perm32(R & 31)) : R;
        voffA[i] = (unsigned)(R * lda * ESZ + C * 2); voffB[i] = (unsigned)(Rb * ldb * ESZ + C * 2); }
    const size_t kstep = (size_t)(BK * 2);
    const size_t hstepA = (size_t)HALF * lda * ESZ, hstepB = (size_t)HALF * ldb * ESZ;
    const unsigned ldsw = (unsigned)wid * 1024u;
    const int aoff = lds_byte(wr * 64 + fr, fq * 8), boff = lds_byte(wc * 32 + fr, fq * 8);
    const Ctx cx{wr, wc, fr, fq, wid, lane};
    const unsigned lds_u = (unsigned)__builtin_amdgcn_readfirstlane((int)((unsigned)(size_t)lds + ldsw));
    LAS unsigned char* ldsB = lds + 4 * HTB + boff;
#define PG8_SA(b, h) (((b) * 2 + (h)) * HTB)
#define PG8_SB(b, h) ((4 + (b) * 2 + (h)) * HTB)
#define PG8_SBL(b, h) (((b) * 2 + (h)) * HTB)
#define PG8_STAGE(bufoff, gbase, voff) do { _Pragma("unroll") for (int _i = 0; _i < 2; ++_i) \
        glds16_s((const char*)(gbase), (voff)[_i], lds_u + (unsigned)((bufoff) + _i * 8192)); } while (0)
#define PG8_RD(off) (*(const LAS i32x4_t*)(lds + (off)))
#define PG8_CAT2(x, y) __builtin_shufflevector((x), (y), 0, 1, 2, 3, 4, 5, 6, 7)
#define PG8_LDA(dst, b, h) do { if constexpr (FP8) { _Pragma("unroll") for (int m = 0; m < 4; ++m) dst##8[m] = PG8_CAT2(PG8_RD(PG8_SA(b, h) + aoff + m * 2048), PG8_RD(PG8_SA(b, h) + aoff + m * 2048 + 1024)); } \
        else { _Pragma("unroll") for (int m = 0; m < 4; ++m) _Pragma("unroll") for (int k = 0; k < 2; ++k) dst[m][k] = *(const LAS bf16x8*)(lds + PG8_SA(b, h) + aoff + m * 2048 + k * 1024); } } while (0)
#define PG8_LDB(dst, b, h) do { if constexpr (FP8) { _Pragma("unroll") for (int n = 0; n < 2; ++n) dst##8[n] = PG8_CAT2(*(const LAS i32x4_t*)(ldsB + PG8_SBL(b, h) + n * 2048), *(const LAS i32x4_t*)(ldsB + PG8_SBL(b, h) + n * 2048 + 1024)); } \
        else { _Pragma("unroll") for (int n = 0; n < 2; ++n) _Pragma("unroll") for (int k = 0; k < 2; ++k) dst[n][k] = *(const LAS bf16x8*)(ldsB + PG8_SBL(b, h) + n * 2048 + k * 1024); } } while (0)
#define PG8_MMA(ai, bj, At, Bt) do { __builtin_amdgcn_s_setprio(1); \
        if constexpr (FP8) { _Pragma("unroll") for (int m = 0; m < 4; ++m) _Pragma("unroll") for (int n = 0; n < 2; ++n) \
            acc[ai][bj][m][n] = __builtin_amdgcn_mfma_scale_f32_16x16x128_f8f6f4(Bt##8[n], At##8[m], acc[ai][bj][m][n], 0, 0, 0, 0x7f7f7f7f, 0, 0x7f7f7f7f); } \
        else { _Pragma("unroll") for (int m = 0; m < 4; ++m) _Pragma("unroll") for (int n = 0; n < 2; ++n) _Pragma("unroll") for (int k = 0; k < 2; ++k) \
            acc[ai][bj][m][n] = __builtin_amdgcn_mfma_f32_16x16x32_bf16(Bt[n][k], At[m][k], acc[ai][bj][m][n], 0, 0, 0); } \
        __builtin_amdgcn_s_setprio(0); } while (0)
#define PG8_WAIT_V(n) asm volatile("s_waitcnt vmcnt(" #n ")" ::: "memory")
#define PG8_WAIT_L(n) asm volatile("s_waitcnt lgkmcnt(" #n ")" ::: "memory")
#define PG8_BAR __builtin_amdgcn_s_barrier()
#define PG8_SCHED __builtin_amdgcn_sched_barrier(0)
    Unit cur, nxt; int ui = 0;
    if (!S.next(0, cur)) return;
    Acc acc;
#pragma unroll
    for (int a = 0; a < 2; ++a)
#pragma unroll
        for (int b = 0; b < 2; ++b)
#pragma unroll
            for (int m = 0; m < 4; ++m)
#pragma unroll
                for (int n = 0; n < 2; ++n) acc[a][b][m][n] = (f32x4){0.f, 0.f, 0.f, 0.f};
    bf16x8 At[4][2], B0[2][2], B1[2][2]; v8i_t At8[4], B08[2], B18[2];
    const char* cA = cur.a; const char* cB = cur.b;
    PG8_STAGE(PG8_SB(0, 0), cB, voffB); PG8_STAGE(PG8_SB(0, 1), cB + hstepB, voffB); PG8_STAGE(PG8_SA(0, 0), cA, voffA); PG8_STAGE(PG8_SA(0, 1), cA + hstepA, voffA);
    if (wr == 1) PG8_BAR;
    PG8_WAIT_V(2); PG8_BAR;
    PG8_STAGE(PG8_SB(1, 0), cB + kstep, voffB); PG8_STAGE(PG8_SA(1, 0), cA + kstep, voffA); PG8_STAGE(PG8_SB(1, 1), cB + hstepB + kstep, voffB);
    PG8_WAIT_V(6); PG8_BAR;
    for (;;) {
        const bool has_next = S.next(ui + 1, nxt);
        const char* nA = has_next ? nxt.a : cA; const char* nB = has_next ? nxt.b : cB;
#pragma unroll 1
        for (int t = 0; t < nt; t += 2) {
            const bool last = (t == nt - 2);
            const char* a1 = cA + (size_t)(t + 1) * kstep;
            const char* a2 = last ? nA : cA + (size_t)(t + 2) * kstep; const char* b2 = last ? nB : cB + (size_t)(t + 2) * kstep;
            const char* a3 = a2 + kstep; const char* b3 = b2 + kstep;
            PG8_LDB(B0, 0, 0); PG8_LDB(B1, 0, 1); PG8_SCHED; PG8_LDA(At, 0, 0); PG8_STAGE(PG8_SA(1, 1), a1 + hstepA, voffA);
            PG8_WAIT_V(8); PG8_WAIT_L(0); PG8_BAR; PG8_MMA(0, 0, At, B0); PG8_MMA(0, 1, At, B1); PG8_BAR; PG8_SCHED;
            PG8_LDA(At, 0, 1); PG8_STAGE(PG8_SB(0, 0), b2, voffB); PG8_STAGE(PG8_SB(0, 1), b2 + hstepB, voffB); PG8_STAGE(PG8_SA(0, 0), a2, voffA);
            PG8_WAIT_V(8); PG8_WAIT_L(0); PG8_BAR; PG8_MMA(1, 0, At, B0); PG8_MMA(1, 1, At, B1); PG8_BAR; PG8_SCHED;
            PG8_LDB(B0, 1, 0); PG8_LDB(B1, 1, 1); PG8_SCHED; PG8_LDA(At, 1, 0); PG8_STAGE(PG8_SA(0, 1), a2 + hstepA, voffA);
            PG8_WAIT_V(8); PG8_WAIT_L(0); PG8_BAR; PG8_MMA(0, 0, At, B0); PG8_MMA(0, 1, At, B1); PG8_BAR; PG8_SCHED;
            PG8_LDA(At, 1, 1); PG8_STAGE(PG8_SB(1, 0), b3, voffB); PG8_STAGE(PG8_SB(1, 1), b3 + hstepB, voffB); PG8_STAGE(PG8_SA(1, 0), a3, voffA);
            PG8_WAIT_V(8); PG8_WAIT_L(0); PG8_BAR; PG8_MMA(1, 0, At, B0); PG8_MMA(1, 1, At, B1); PG8_BAR; PG8_SCHED;
        }
        if (wr == 0) PG8_BAR;
        E(acc, cur, cx);
        if (!has_next) break;
#pragma unroll
        for (int a = 0; a < 2; ++a)
#pragma unroll
            for (int b = 0; b < 2; ++b)
#pragma unroll
                for (int m = 0; m < 4; ++m)
#pragma unroll
                    for (int n = 0; n < 2; ++n) acc[a][b][m][n] = (f32x4){0.f, 0.f, 0.f, 0.f};
        cur = nxt; cA = nA; cB = nB; ++ui;
        if (wr == 1) PG8_BAR;
    }
    PG8_WAIT_V(0);
    PG8_BAR;
#undef PG8_SA
#undef PG8_SB
#undef PG8_SBL
#undef PG8_STAGE
#undef PG8_LDA
#undef PG8_LDB
#undef PG8_MMA
#undef PG8_CAT2
#undef PG8_RD
#undef PG8_WAIT_V
#undef PG8_WAIT_L
#undef PG8_BAR
#undef PG8_SCHED
}
}
namespace pg8 {
constexpr int NXCD = 8, WGM = 8;
struct DenseOrder {
    const char* A; const char* B; int nM, nN, nwg, G, c; size_t strideA, strideB;
    DI void init(const void* A_, const void* B_, int M, int N, int lda, int ldb, int G_, int c_) { A = (const char*)A_; B = (const char*)B_; nM = M / BM; nN = N / BM; nwg = nM * nN; G = G_; c = c_;
        strideA = (size_t)BM * lda * 2; strideB = (size_t)BM * ldb * 2; }
    DI bool next(int i, Unit& u) const {
        const long L = (long)i * G + c; if (L >= nwg) return false;
        int wgid = (int)L; { const int q = nwg / NXCD, r = nwg % NXCD, xcd = wgid % NXCD, off = wgid / NXCD; wgid = (xcd < r ? xcd * (q + 1) : r * (q + 1) + (xcd - r) * q) + off; }
        const int nig = WGM * nN, gid = wgid / nig, fm = gid * WGM, gsz = (nM - fm) < WGM ? (nM - fm) : WGM;
        u.pm = fm + ((wgid % nig) % gsz); u.pn = (wgid % nig) / gsz; u.aux = 0;
        u.a = A + (size_t)u.pm * strideA; u.b = B + (size_t)u.pn * strideB; return true;
    }
};
struct CrossSOrder {
    const char* Q; const char* Kc; int G, v;
    DI bool next(int i, Unit& u) const {
        const int L = i * G + v; if (L >= (T / 256) * XH) return false;
        u.pm = L >> 2; u.pn = L & 3; u.aux = 0;
        u.a = Q + ((size_t)u.pm * 256 * D + u.pn * 256) * 2; u.b = Kc + ((size_t)(u.pm >> 3) * 256 * D + u.pn * 256) * 2; return true;
    }
};
struct CrossOOrder {
    const char* P; const char* Vt; int G, v;
    DI bool next(int i, Unit& u) const {
        const int L = i * G + v; if (L >= (T / 256) * XH) return false;
        u.pm = L >> 2; u.pn = L & 3; u.aux = 0;
        u.a = P + ((size_t)u.pm * 256 * D + u.pn * 256) * 2; u.b = Vt + ((size_t)u.pn * 256 * (NB * NMEM) + (size_t)(u.pm >> 3) * 256) * 2; return true;
    }
};
struct MoeOrder {
    const char* A; const char* W; const LAS int* tstart; int npn, G, v; size_t strideA, strideW, strideN;
    DI bool next(int i, Unit& u) const {
        const int L = i * G + v; const int total = __builtin_amdgcn_readfirstlane(tstart[NE]) * npn; if (L >= total) return false;
        const int tile = L / npn; u.pm = tile; u.pn = L - tile * npn;
        int e = 0;
#pragma unroll 1
        for (int j = 1; j < NE; ++j) e += (__builtin_amdgcn_readfirstlane(tstart[j]) <= tile) ? 1 : 0;
        u.aux = e;
        u.a = A + (size_t)tile * strideA; u.b = W + (size_t)e * strideW + (size_t)u.pn * strideN; return true;
    }
};

DI unsigned pk4_fp8(float a, float b, float c, float d) { int w = 0; w = __builtin_amdgcn_cvt_pk_fp8_f32(a, b, w, false); w = __builtin_amdgcn_cvt_pk_fp8_f32(c, d, w, true); return (unsigned)w; }
constexpr float F8_XS = 16.0f, F8_WS = 64.0f, F8_AS = 8.0f;
struct EpiBf16 {
    static constexpr bool PERM = true;
    bf16_t* O; int ldc; int sc_from; float scale;
    DI void operator()(const Acc& acc, const Unit& u, const Ctx& c) const {
        int row0 = u.pm * BM + c.wr * 64 + c.fr, col0 = u.pn * BM + c.wc * 32 + 8 * c.fq; asm volatile("" : "+v"(row0), "+v"(col0));
        const float sc = (u.pn >= sc_from) ? scale : 1.0f;
#pragma unroll
        for (int ai = 0; ai < 2; ++ai)
#pragma unroll
            for (int m = 0; m < 4; ++m) { bf16_t* rowp = O + (size_t)(row0 + ai * HALF + m * 16) * ldc + col0;
#pragma unroll
                for (int bj = 0; bj < 2; ++bj) { const f32x4 v0 = acc[ai][bj][m][0] * sc, v1 = acc[ai][bj][m][1] * sc;
                    u32x4 w; w.x = cvt_pk_bf16(v0[0], v0[1]); w.y = cvt_pk_bf16(v0[2], v0[3]); w.z = cvt_pk_bf16(v1[0], v1[1]); w.w = cvt_pk_bf16(v1[2], v1[3]);
                    *(u32x4*)(rowp + bj * HALF) = w; } }
    }
};
struct EpiProj {
    static constexpr bool PERM = true;
    bf16_t* O; float* gates;
    DI void operator()(const Acc& acc, const Unit& u, const Ctx& c) const {
        int row0 = u.pm * BM + c.wr * 64 + c.fr, col0 = u.pn * BM + c.wc * 32 + 8 * c.fq; asm volatile("" : "+v"(row0), "+v"(col0));
#pragma unroll
        for (int ai = 0; ai < 2; ++ai)
#pragma unroll
            for (int m = 0; m < 4; ++m) { const int row = row0 + ai * HALF + m * 16; bf16_t* rowp = O + (size_t)row * NPROJ + col0;
#pragma unroll
                for (int bj = 0; bj < 2; ++bj) { const f32x4 v0 = acc[ai][bj][m][0], v1 = acc[ai][bj][m][1];
                    u32x4 w; w.x = cvt_pk_bf16(v0[0], v0[1]); w.y = cvt_pk_bf16(v0[2], v0[3]); w.z = cvt_pk_bf16(v1[0], v1[1]); w.w = cvt_pk_bf16(v1[2], v1[3]);
                    *(u32x4*)(rowp + bj * HALF) = w; }
                if (u.pn == 1 && c.wc == 1 && c.fq == 0) { *(f32x4*)(gates + (size_t)row * 8) = acc[ai][1][m][0]; *(f32x4*)(gates + (size_t)row * 8 + 4) = acc[ai][1][m][1]; } }
    }
};
struct EpiQmla {
    static constexpr bool PERM = true;
    bf16_t* O; const float* cs;
    float scale;
    DI void operator()(const Acc& acc, const Unit& u, const Ctx& c) const {
        int row0 = u.pm * BM + c.wr * 64 + c.fr, col0 = u.pn * BM + c.wc * 32 + 8 * c.fq; asm volatile("" : "+v"(row0), "+v"(col0));
#pragma unroll
        for (int ai = 0; ai < 2; ++ai)
#pragma unroll
            for (int m = 0; m < 4; ++m) { const int row = row0 + ai * HALF + m * 16; bf16_t* rowp = O + (size_t)row * (AH * AQK) + col0;
#pragma unroll
                for (int bj = 0; bj < 2; ++bj) { f32x4 v0 = acc[ai][bj][m][0] * scale, v1 = acc[ai][bj][m][1] * scale;
                    const int cc = (col0 + bj * HALF) % AQK;
                    if (cc >= ANOPE) { const int p0 = (cc - ANOPE) >> 1;
                        const f32x4 t0 = *(const f32x4*)(cs + (size_t)row * 32 + p0 * 2), t1 = *(const f32x4*)(cs + (size_t)row * 32 + p0 * 2 + 4);
                        f32x4 r0, r1;
                        r0[0] = v0[0] * t0[0] - v0[1] * t0[1]; r0[1] = v0[1] * t0[0] + v0[0] * t0[1];
                        r0[2] = v0[2] * t0[2] - v0[3] * t0[3]; r0[3] = v0[3] * t0[2] + v0[2] * t0[3];
                        r1[0] = v1[0] * t1[0] - v1[1] * t1[1]; r1[1] = v1[1] * t1[0] + v1[0] * t1[1];
                        r1[2] = v1[2] * t1[2] - v1[3] * t1[3]; r1[3] = v1[3] * t1[2] + v1[2] * t1[3];
                        v0 = r0; v1 = r1; }
                    u32x4 w; w.x = cvt_pk_bf16(v0[0], v0[1]); w.y = cvt_pk_bf16(v0[2], v0[3]); w.z = cvt_pk_bf16(v1[0], v1[1]); w.w = cvt_pk_bf16(v1[2], v1[3]);
                    *(u32x4*)(rowp + bj * HALF) = w; } }
    }
};
template <bool ADD> struct EpiGate {
    static constexpr bool PERM = true;
    bf16_t* O; const bf16_t* proj; int gcol;
    DI void operator()(const Acc& acc, const Unit& u, const Ctx& c) const {
        int row0 = u.pm * BM + c.wr * 64 + c.fr, col0 = u.pn * BM + c.wc * 32 + 8 * c.fq; asm volatile("" : "+v"(row0), "+v"(col0));
#pragma unroll
        for (int ai = 0; ai < 2; ++ai)
#pragma unroll
            for (int m = 0; m < 4; ++m) { const int row = row0 + ai * HALF + m * 16; bf16_t* rowp = O + (size_t)row * D + col0; const bf16_t* gp = proj + (size_t)row * NPROJ + gcol + col0;
#pragma unroll
                for (int bj = 0; bj < 2; ++bj) { const f32x4 v0 = acc[ai][bj][m][0], v1 = acc[ai][bj][m][1];
                    const u32x4 g = *(const u32x4*)(gp + bj * HALF);
                    float o[8];
                    o[0] = sigmoidf_(bflo(g.x)) * v0[0]; o[1] = sigmoidf_(bfhi(g.x)) * v0[1]; o[2] = sigmoidf_(bflo(g.y)) * v0[2]; o[3] = sigmoidf_(bfhi(g.y)) * v0[3];
                    o[4] = sigmoidf_(bflo(g.z)) * v1[0]; o[5] = sigmoidf_(bfhi(g.z)) * v1[1]; o[6] = sigmoidf_(bflo(g.w)) * v1[2]; o[7] = sigmoidf_(bfhi(g.w)) * v1[3];
                    if (ADD) { const u32x4 p = *(const u32x4*)(rowp + bj * HALF);
                        o[0] += bflo(p.x); o[1] += bfhi(p.x); o[2] += bflo(p.y); o[3] += bfhi(p.y); o[4] += bflo(p.z); o[5] += bfhi(p.z); o[6] += bflo(p.w); o[7] += bfhi(p.w); }
                    u32x4 w; w.x = cvt_pk_bf16(o[0], o[1]); w.y = cvt_pk_bf16(o[2], o[3]); w.z = cvt_pk_bf16(o[4], o[5]); w.w = cvt_pk_bf16(o[6], o[7]);
                    *(u32x4*)(rowp + bj * HALF) = w; } }
    }
};
struct EpiF32 {
    static constexpr bool PERM = false;
    float* C; int ldc; int ncols_valid;
    DI void operator()(const Acc& acc, const Unit& u, const Ctx& c) const {
        int row0 = u.pm * BM + c.wr * 64 + c.fr, col0 = u.pn * BM + c.wc * 32 + 4 * c.fq; asm volatile("" : "+v"(row0), "+v"(col0));
#pragma unroll
        for (int ai = 0; ai < 2; ++ai)
#pragma unroll
            for (int m = 0; m < 4; ++m) { float* rowp = C + (size_t)(row0 + ai * HALF + m * 16) * ldc + col0;
#pragma unroll
                for (int bj = 0; bj < 2; ++bj)
#pragma unroll
                    for (int n = 0; n < 2; ++n) if (col0 + bj * HALF + n * 16 < ncols_valid) *(f32x4*)(rowp + bj * HALF + n * 16) = acc[ai][bj][m][n]; }
    }
};
struct EpiSoftmax {
    static constexpr bool PERM = true;
    bf16_t* O; LAS float* red;
    DI void operator()(Acc& acc, const Unit& u, const Ctx& c) const {
        int row0 = u.pm * BM + c.wr * 64 + c.fr, col0 = u.pn * BM + c.wc * 32 + 8 * c.fq; asm volatile("" : "+v"(row0), "+v"(col0));
        int rbase = (c.wr * 64 + c.fr) * 4; asm volatile("" : "+v"(rbase));
        LAS float* r1 = red + rbase; LAS float* r2 = red + 1024 + rbase;
#pragma unroll
        for (int ai = 0; ai < 2; ++ai)
#pragma unroll
            for (int m = 0; m < 4; ++m) { float v = -INFINITY;
#pragma unroll
                for (int bj = 0; bj < 2; ++bj)
#pragma unroll
                    for (int n = 0; n < 2; ++n) { const f32x4 x = acc[ai][bj][m][n]; v = fmaxf(v, fmaxf(fmaxf(x[0], x[1]), fmaxf(x[2], x[3]))); }
                v = fmaxf(v, __shfl_xor(v, 16)); v = fmaxf(v, __shfl_xor(v, 32));
                if (c.fq == 0) r1[(ai * HALF + m * 16) * 4 + c.wc] = v;
                __builtin_amdgcn_sched_barrier(0); }
        asm volatile("s_waitcnt lgkmcnt(0)" ::: "memory"); __builtin_amdgcn_s_barrier(); asm volatile("" ::: "memory");
#pragma unroll
        for (int ai = 0; ai < 2; ++ai)
#pragma unroll
            for (int m = 0; m < 4; ++m) { const f32x4 q = *(const LAS f32x4*)(r1 + (ai * HALF + m * 16) * 4);
                const float mm = fmaxf(fmaxf(q[0], q[1]), fmaxf(q[2], q[3])); float s = 0.f;
#pragma unroll
                for (int bj = 0; bj < 2; ++bj)
#pragma unroll
                    for (int n = 0; n < 2; ++n) { f32x4 x = acc[ai][bj][m][n];
                        x[0] = __builtin_amdgcn_exp2f(x[0] - mm); x[1] = __builtin_amdgcn_exp2f(x[1] - mm); x[2] = __builtin_amdgcn_exp2f(x[2] - mm); x[3] = __builtin_amdgcn_exp2f(x[3] - mm);
                        acc[ai][bj][m][n] = x; s += (x[0] + x[1]) + (x[2] + x[3]); }
                s += __shfl_xor(s, 16); s += __shfl_xor(s, 32);
                if (c.fq == 0) r2[(ai * HALF + m * 16) * 4 + c.wc] = s;
                __builtin_amdgcn_sched_barrier(0); }
        asm volatile("s_waitcnt lgkmcnt(0)" ::: "memory"); __builtin_amdgcn_s_barrier(); asm volatile("" ::: "memory");
#pragma unroll
        for (int ai = 0; ai < 2; ++ai)
#pragma unroll
            for (int m = 0; m < 4; ++m) { const f32x4 q = *(const LAS f32x4*)(r2 + (ai * HALF + m * 16) * 4);
                const float inv = 1.0f / ((q[0] + q[1]) + (q[2] + q[3]));
                bf16_t* rowp = O + (size_t)(row0 + ai * HALF + m * 16) * D + col0;
#pragma unroll
                for (int bj = 0; bj < 2; ++bj) { const f32x4 v0 = acc[ai][bj][m][0] * inv, v1 = acc[ai][bj][m][1] * inv;
                    u32x4 w; w.x = cvt_pk_bf16(v0[0], v0[1]); w.y = cvt_pk_bf16(v0[2], v0[3]); w.z = cvt_pk_bf16(v1[0], v1[1]); w.w = cvt_pk_bf16(v1[2], v1[3]);
                    *(u32x4*)(rowp + bj * HALF) = w; }
                __builtin_amdgcn_sched_barrier(0); }
    }
};
struct EpiSwiglu {
    static constexpr bool PERM = true;
    unsigned char* O; const float* bias;
    DI void operator()(const Acc& acc, const Unit& u, const Ctx& c) const {
        int row0 = u.pm * BM + c.wr * 64 + c.fr, col0 = u.pn * BM + c.wc * 32 + 8 * c.fq; asm volatile("" : "+v"(row0), "+v"(col0));
        constexpr float us = 1.0f / (F8_XS * F8_WS);
        f32x4 bv[2][2];
#pragma unroll
        for (int bj = 0; bj < 2; ++bj)
#pragma unroll
            for (int n = 0; n < 2; ++n) bv[bj][n] = *(const f32x4*)(bias + (size_t)u.aux * 2048 + col0 + bj * HALF + 4 * n);
#pragma unroll
        for (int ai = 0; ai < 2; ++ai)
#pragma unroll
            for (int m = 0; m < 4; ++m) { unsigned char* rowp = O + (size_t)(row0 + ai * HALF + m * 16) * 1024 + (col0 >> 1);
#pragma unroll
                for (int bj = 0; bj < 2; ++bj) { const f32x4 v0 = acc[ai][bj][m][0] * us + bv[bj][0], v1 = acc[ai][bj][m][1] * us + bv[bj][1];
                    float o[4];
#define SWG(g, l) ({ const float g_ = fminf((g), 7.0f), l_ = fminf(fmaxf((l), -7.0f), 7.0f); fminf(fmaxf(g_ * sigmoidf_(1.702f * g_) * (l_ + 1.0f) * F8_AS, -448.0f), 448.0f); })
                    o[0] = SWG(v0[0], v0[1]); o[1] = SWG(v0[2], v0[3]); o[2] = SWG(v1[0], v1[1]); o[3] = SWG(v1[2], v1[3]);
#undef SWG
                    *(unsigned*)(rowp + bj * (HALF / 2)) = pk4_fp8(o[0], o[1], o[2], o[3]); } }
    }
};
struct EpiDown {
    static constexpr bool PERM = true;
    bf16_t* O; const float* bias; const float* rowgate;
    DI void operator()(const Acc& acc, const Unit& u, const Ctx& c) const {
        int row0 = u.pm * BM + c.wr * 64 + c.fr, col0 = u.pn * BM + c.wc * 32 + 8 * c.fq; asm volatile("" : "+v"(row0), "+v"(col0));
        f32x4 bv[2][2];
#pragma unroll
        for (int bj = 0; bj < 2; ++bj)
#pragma unroll
            for (int n = 0; n < 2; ++n) bv[bj][n] = *(const f32x4*)(bias + (size_t)u.aux * 1024 + col0 + bj * HALF + 4 * n);
#pragma unroll
        for (int ai = 0; ai < 2; ++ai)
#pragma unroll
            for (int m = 0; m < 4; ++m) { const int row = row0 + ai * HALF + m * 16; const float gt = rowgate[row]; bf16_t* rowp = O + (size_t)row * 1024 + col0;
#pragma unroll
                for (int bj = 0; bj < 2; ++bj) { const f32x4 v0 = (acc[ai][bj][m][0] * (1.0f / (F8_AS * F8_WS)) + bv[bj][0]) * gt, v1 = (acc[ai][bj][m][1] * (1.0f / (F8_AS * F8_WS)) + bv[bj][1]) * gt;
                    u32x4 w; w.x = cvt_pk_bf16(v0[0], v0[1]); w.y = cvt_pk_bf16(v0[2], v0[3]); w.z = cvt_pk_bf16(v1[0], v1[1]); w.w = cvt_pk_bf16(v1[2], v1[3]);
                    *(u32x4*)(rowp + bj * HALF) = w; } }
    }
};
}
constexpr size_t MiB = 1u << 20;
constexpr size_t WS_CTL = 0, CTL_ZERO_BYTES = 1 * MiB;
constexpr size_t WS_W_IN = 2 * MiB, WS_W_UQ = 10 * MiB, WS_W_UK = WS_W_UQ + 512 * 1024, WS_W_UV = WS_W_UK + 256 * 1024, WS_W_MQK = 11 * MiB, WS_W_BRM = 12 * MiB, WS_W_BRA = 13 * MiB,
                 WS_W_MIX = 14 * MiB, WS_W_CQ = 16 * MiB, WS_W_CK = 18 * MiB, WS_W_CV = 20 * MiB, WS_W_CO = 22 * MiB, WS_W_R = 24 * MiB, WS_W_GU = 26 * MiB, WS_W_DN = 90 * MiB;
constexpr size_t WS_GATES = 218 * MiB, WS_CS = 219 * MiB, WS_KPE = 223 * MiB, WS_MEMB = 225 * MiB, WS_KC = 233 * MiB, WS_VCT = 241 * MiB, WS_LOGITS = 249 * MiB,
                 WS_ASSIGN = 253 * MiB, WS_GATEW = WS_ASSIGN + 512 * 1024, WS_TOKPOS = 254 * MiB, WS_ROWGATE = WS_TOKPOS + 512 * 1024;
constexpr size_t WS_XB = 256 * MiB, WS_PROJ = 320 * MiB, WS_QN = 576 * MiB, WS_KVN = 592 * MiB, WS_XC = 608 * MiB, WS_QMLA = 640 * MiB, WS_KN = 688 * MiB, WS_VT = 720 * MiB,
                 WS_QKM = 752 * MiB, WS_KTM = 816 * MiB, WS_AO = 848 * MiB, WS_HRAW = 880 * MiB, WS_HM = 944 * MiB;
constexpr size_t WS_GATED = 256 * MiB, WS_MIXO = 576 * MiB, WS_H1B = 704 * MiB, WS_QC = 768 * MiB, WS_PC = 832 * MiB, WS_OC = 896 * MiB, WS_COO = 320 * MiB, WS_H2B = 256 * MiB;
constexpr size_t WS_XG = 320 * MiB, WS_ACT = 456 * MiB, WS_YB = 592 * MiB, WS_END = 976 * MiB;
static_assert((size_t)NROWS * 1024 * 2 <= 272 * MiB, "routed buffers");
static_assert(WS_ROWGATE + (size_t)NROWS * 4 <= 256 * MiB, "small buffers");
constexpr int CW_TMO = 0, CW_CNT = 64  , CW_BAR = 4096;

constexpr int RING_OFF = 0, RING_BYTES = 131072;
constexpr int RED_OFF = RING_BYTES;
constexpr int TST_OFF = RED_OFF + 8192;
constexpr int HIST_OFF = TST_OFF + 256, HBASE_OFF = HIST_OFF + 128;
constexpr int MISC_OFF = HBASE_OFF + 128;
constexpr int LDSCTL_OFF = TST_OFF;
constexpr int LDS_BYTES = 147456;
static_assert(MISC_OFF + 128 <= LDS_BYTES, "LDS map");
constexpr int NWAVES = 8;

#define LDS_WAIT() asm volatile("s_waitcnt lgkmcnt(0)" ::: "memory")
#define VM_WAIT() asm volatile("s_waitcnt vmcnt(0)" ::: "memory")

#define XB_TMO      128
#define XB_XCNT(j)  (256  + 64 * (j))
#define XB_XSUB(j)  (1280 + 64 * (j))
#define XB_XGEN(j)  (2304 + 64 * (j))
#define XB_TOP      3328
#define XB_TOPGEN   3392
#define XCD_BAR_WORDS 3456
#define XB_SPIN_CAP (1u << 18)
__device__ __forceinline__ unsigned xb_ld(unsigned* p)              { return __hip_atomic_load(p, __ATOMIC_RELAXED, __HIP_MEMORY_SCOPE_AGENT); }
__device__ __forceinline__ unsigned xb_add(unsigned* p, unsigned v) { return __hip_atomic_fetch_add(p, v, __ATOMIC_RELAXED, __HIP_MEMORY_SCOPE_AGENT); }
__device__ __forceinline__ unsigned xb_xcc_id() { return (unsigned)__builtin_amdgcn_s_getreg((3 << 11) | 20) & 0xFu; }
#define XB_SPIN(cond, bar) do { unsigned _sp = 0; while (cond) { __builtin_amdgcn_s_sleep(1); \
    if ((++_sp & 255u) == 0u) { if (xb_ld(&(bar)[XB_TMO])) break; if (_sp > XB_SPIN_CAP) { atomicAdd(&(bar)[XB_TMO], 1u); break; } } } } while (0)
struct XcdBarrier { unsigned* bar; unsigned x; volatile LAS unsigned* st; };
__device__ __forceinline__ XcdBarrier xcd_barrier_post(unsigned* bar, volatile LAS unsigned* st) {
    XcdBarrier b; b.bar = bar; b.x = xb_xcc_id(); b.st = st;
    if (threadIdx.x == 0) (void)xb_add(&bar[XB_XCNT(b.x)], 1u);
    return b;
}
__device__ __forceinline__ void xcd_barrier_complete(unsigned* bar, unsigned x, unsigned& nloc, unsigned& nx) {
    const unsigned G = gridDim.x * gridDim.y * gridDim.z;
    unsigned sum, cnt, mine, sp = 0u;
    for (;;) {
        sum = 0u; cnt = 0u; mine = 0u;
#pragma unroll
        for (unsigned j = 0; j < 16; ++j) { const unsigned c = xb_ld(&bar[XB_XCNT(j)]); sum += c; cnt += (c > 0u) ? 1u : 0u; mine = (j == x) ? c : mine; }
        if (sum == G) break;
        __builtin_amdgcn_s_sleep(1);
        if ((++sp & 255u) == 0u) { if (xb_ld(&bar[XB_TMO])) break; if (sp > XB_SPIN_CAP) { atomicAdd(&bar[XB_TMO], 1u); break; } }
    }
    nloc = mine > 0u ? mine : 1u; nx = cnt > 0u ? cnt : 1u;
}
__device__ __forceinline__ void xcd_barrier(const XcdBarrier& b) {
    asm volatile("s_waitcnt vmcnt(0)" ::: "memory");
    __syncthreads();
    if (threadIdx.x == 0) {
        unsigned* bar = b.bar;
        __builtin_amdgcn_s_waitcnt(0);
        unsigned nloc = b.st[0], nx = b.st[1];
        if (nloc == 0u) { xcd_barrier_complete(bar, b.x, nloc, nx); b.st[0] = nloc; b.st[1] = nx; }
        const unsigned old = xb_add(&bar[XB_XSUB(b.x)], 1u);
        const unsigned gen = old / nloc;
        if (old + 1u == (gen + 1u) * nloc) {
            __builtin_amdgcn_fence(__ATOMIC_RELEASE, "agent");
            asm volatile("s_waitcnt vmcnt(0)" ::: "memory");
            const unsigned og = xb_add(&bar[XB_TOP], 1u);
            const unsigned tg = og / nx;
            if (og + 1u == (tg + 1u) * nx) xb_add(&bar[XB_TOPGEN], 1u);
            else XB_SPIN(xb_ld(&bar[XB_TOPGEN]) == tg, bar);
            __builtin_amdgcn_fence(__ATOMIC_ACQUIRE, "agent");
            xb_add(&bar[XB_XGEN(b.x)], 1u);
            asm volatile("s_waitcnt vmcnt(0)" ::: "memory");
        } else {
            XB_SPIN(xb_ld(&bar[XB_XGEN(b.x)]) == gen, bar);
            __builtin_amdgcn_fence(__ATOMIC_ACQUIRE, "agent");
            asm volatile("s_waitcnt vmcnt(0)" ::: "memory");
        }
    }
    __syncthreads();
}

struct Args { const void* in[34]; float* out; unsigned char* ws; int ph_lo, ph_hi; };

DI void tr_item(const float* W, int ldw, int kvalid, bf16_t* WT, int ldk, int n0, int k0, int sc, LAS float* scr, int lane) {
#pragma unroll 8
    for (int i = 0; i < 32; ++i) { const int kk = 2 * i + (lane >> 5); const int k = k0 + kk;
        float v = 0.f; if (sc >= 0 && k < kvalid) v = W[(size_t)k * ldw + sc];
        scr[kk * 33 + (lane & 31)] = v; }
    LDS_WAIT(); asm volatile("" ::: "memory");
    const int c = lane & 7;
#pragma unroll
    for (int j = 0; j < 4; ++j) { const int n = (lane >> 3) + 8 * j; const LAS float* s = scr + (8 * c) * 33 + n;
        u32x4 o; o.x = pk2(s[0 * 33], s[1 * 33]); o.y = pk2(s[2 * 33], s[3 * 33]); o.z = pk2(s[4 * 33], s[5 * 33]); o.w = pk2(s[6 * 33], s[7 * 33]);
        *(GAS u32x4*)(WT + (size_t)(n0 + n) * ldk + k0 + 8 * c) = o; }
    LDS_WAIT(); asm volatile("" ::: "memory");
}

DI void tr_item_v4(const float* W, int ldw, bf16_t* WT, int ldk, int n0, int k0, int c0, LAS float* scr, int lane) {
    const int kr = lane >> 3, n4 = lane & 7;
    f32x4 v[8];
#pragma unroll
    for (int i = 0; i < 8; ++i) v[i] = *(const f32x4*)(W + (size_t)(k0 + i * 8 + kr) * ldw + c0 + 4 * n4);
#pragma unroll
    for (int i = 0; i < 8; ++i) { LAS float* p = scr + (i * 8 + kr) * 33 + 4 * n4; p[0] = v[i][0]; p[1] = v[i][1]; p[2] = v[i][2]; p[3] = v[i][3]; }
    LDS_WAIT(); asm volatile("" ::: "memory");
    const int c = lane & 7;
#pragma unroll
    for (int j = 0; j < 4; ++j) { const int n = (lane >> 3) + 8 * j; const LAS float* s = scr + (8 * c) * 33 + n;
        u32x4 o; o.x = pk2(s[0 * 33], s[1 * 33]); o.y = pk2(s[2 * 33], s[3 * 33]); o.z = pk2(s[4 * 33], s[5 * 33]); o.w = pk2(s[6 * 33], s[7 * 33]);
        *(GAS u32x4*)(WT + (size_t)(n0 + n) * ldk + k0 + 8 * c) = o; }
    LDS_WAIT(); asm volatile("" ::: "memory");
}

DI void tr_item_v4_fp8(const float* W, int ldw, unsigned char* WT, int ldk, int n0, int k0, int c0, float sc, LAS float* scr, int lane) {
    const int kr = lane >> 3, n4 = lane & 7;
    f32x4 v[8];
#pragma unroll
    for (int i = 0; i < 8; ++i) v[i] = *(const f32x4*)(W + (size_t)(k0 + i * 8 + kr) * ldw + c0 + 4 * n4);
#pragma unroll
    for (int i = 0; i < 8; ++i) { LAS float* p = scr + (i * 8 + kr) * 33 + 4 * n4; p[0] = v[i][0] * sc; p[1] = v[i][1] * sc; p[2] = v[i][2] * sc; p[3] = v[i][3] * sc; }
    LDS_WAIT(); asm volatile("" ::: "memory");
    const int c = lane & 7;
#pragma unroll
    for (int j = 0; j < 4; ++j) { const int n = (lane >> 3) + 8 * j; const LAS float* s = scr + (8 * c) * 33 + n;
        u32x2 o; o.x = pg8::pk4_fp8(s[0 * 33], s[1 * 33], s[2 * 33], s[3 * 33]); o.y = pg8::pk4_fp8(s[4 * 33], s[5 * 33], s[6 * 33], s[7 * 33]);
        *(GAS u32x2*)(WT + (size_t)(n0 + n) * ldk + k0 + 8 * c) = o; }
    LDS_WAIT(); asm volatile("" ::: "memory");
}
DI int win_src(int n) {
    if (n < 384) return n;
    if (n < 416) { const int i = (n - 384) >> 1; return 384 + i + 16 * ((n - 384) & 1); }
    if (n < 424) return 1952 + (n - 416);
    if (n < 512) return -1;
    if (n < 2048) return 416 + (n - 512);
    return 1960 + (n - 2048);
}
DI void p0_prologue(const Args& args, LAS unsigned char* lds, int vcu, int G) {
    int tid_ = threadIdx.x; asm volatile("" : "+v"(tid_)); const int lane = tid_ & 63; const int wave = __builtin_amdgcn_readfirstlane(tid_ >> 6);
    LAS float* scr = (LAS float*)(lds + RING_OFF + wave * 16384);
    const int gw = vcu * NWAVES + wave, NGW = G * NWAVES;
    unsigned char* ws = args.ws;
    const int j = lane & 31;
    constexpr int I_IN = 16 * 128, I_UQ = 4 * 24, I_UK = 4 * 16, I_UV = 4 * 16, I_MQK = 8 * 32, I_BRM = 8 * 32, I_BRA = 8 * 32, I_SQ = 16 * 32, I_R = 16 * 8,
                  I_GU = NE * 16 * 64, I_DN = NE * 16 * 32;
    constexpr int NITEMS = I_IN + I_UQ + I_UK + I_UV + I_MQK + I_BRM + I_BRA + 5 * I_SQ + I_R + I_GU + I_DN;
    for (int it = gw; it < NITEMS; it += NGW) {
        int r = it;
        if (r < I_GU) { const int e = r / (16 * 64), q = r % (16 * 64), kb = q / 64, nb = q % 64;
            tr_item_v4_fp8((const float*)args.in[28] + (size_t)e * 1024 * 2048, 2048, ws + WS_W_GU + (size_t)e * 2048 * 1024, 1024, nb * 32, kb * 64, nb * 32, pg8::F8_WS, scr, lane); continue; } r -= I_GU;
        if (r < I_DN) { const int e = r / (16 * 32), q = r % (16 * 32), kb = q / 32, nb = q % 32;
            tr_item_v4_fp8((const float*)args.in[30] + (size_t)e * 1024 * 1024, 1024, ws + WS_W_DN + (size_t)e * 1024 * 1024, 1024, nb * 32, kb * 64, nb * 32, pg8::F8_WS, scr, lane); continue; } r -= I_DN;
        if (r < I_IN) { const int kb = r / 128, nb = r % 128;
            tr_item((const float*)args.in[3], DIN, 1024, (bf16_t*)(ws + WS_W_IN), 1024, nb * 32, kb * 64, win_src(nb * 32 + j), scr, lane); continue; } r -= I_IN;
        if (r < I_UQ) { const int kb = r / 24, nb = r % 24; const int n = nb * 32 + j, hh = n / AQK, cc = n % AQK;
            const int sc = (cc < ANOPE) ? n : hh * AQK + ANOPE + ((cc - ANOPE) >> 1) + 16 * ((cc - ANOPE) & 1);
            tr_item((const float*)args.in[14], AH * AQK, 256, (bf16_t*)(ws + WS_W_UQ), 256, nb * 32, kb * 64, sc, scr, lane); continue; } r -= I_UQ;
        if (r < I_UK) { const int kb = r / 16, nb = r % 16; const int n = nb * 32 + j;
            tr_item((const float*)args.in[15], 1024, 128, (bf16_t*)(ws + WS_W_UK), 256, nb * 32, kb * 64, (n >> 6) * 128 + (n & 63), scr, lane); continue; } r -= I_UK;
        if (r < I_UV) { const int kb = r / 16, nb = r % 16; const int n = nb * 32 + j;
            tr_item((const float*)args.in[15], 1024, 128, (bf16_t*)(ws + WS_W_UV), 256, nb * 32, kb * 64, (n >> 6) * 128 + 64 + (n & 63), scr, lane); continue; } r -= I_UV;
        if (r < I_MQK) { const int kb = r / 32, nb = r % 32; const int n = nb * 32 + j, part = n >> 9, hh = (n >> 7) & 3, e = n & 127;
            const float* src = (const float*)args.in[part ? 9 : 8];
            tr_item(src, 128, 512, (bf16_t*)(ws + WS_W_MQK), 512, nb * 32, kb * 64, ((kb >> 1) == hh) ? e : -1, scr, lane); continue; } r -= I_MQK;
        if (r < I_BRM) { const int kb = r / 32, nb = r % 32;
            tr_item_v4((const float*)args.in[16], 1024, (bf16_t*)(ws + WS_W_BRM), 512, nb * 32, kb * 64, nb * 32, scr, lane); continue; } r -= I_BRM;
        if (r < I_BRA) { const int kb = r / 32, nb = r % 32;
            tr_item_v4((const float*)args.in[17], 1024, (bf16_t*)(ws + WS_W_BRA), 512, nb * 32, kb * 64, nb * 32, scr, lane); continue; } r -= I_BRA;
        if (r < 5 * I_SQ) { const int w = r / I_SQ, q = r % I_SQ, kb = q / 32, nb = q % 32;
            const float* src; int ldw, coff; bf16_t* dst;
            if (w == 0) { src = (const float*)args.in[18]; ldw = 1024; coff = 0; dst = (bf16_t*)(ws + WS_W_MIX); }
            else if (w == 1) { src = (const float*)args.in[21]; ldw = 1024; coff = 0; dst = (bf16_t*)(ws + WS_W_CQ); }
            else if (w == 2) { src = (const float*)args.in[22]; ldw = 2048; coff = 0; dst = (bf16_t*)(ws + WS_W_CK); }
            else if (w == 3) { src = (const float*)args.in[22]; ldw = 2048; coff = 1024; dst = (bf16_t*)(ws + WS_W_CV); }
            else { src = (const float*)args.in[23]; ldw = 1024; coff = 0; dst = (bf16_t*)(ws + WS_W_CO); }
            tr_item_v4(src, ldw, dst, 1024, nb * 32, kb * 64, coff + nb * 32, scr, lane); continue; } r -= 5 * I_SQ;
        { const int kb = r / 8, nb = r % 8; const int n = nb * 32 + j;
            tr_item((const float*)args.in[26], NE, 1024, (bf16_t*)(ws + WS_W_R), 1024, nb * 32, kb * 64, (n < NE) ? n : -1, scr, lane); }
    }
    const size_t gt = (size_t)gw * 64 + lane, NT_ = (size_t)NGW * 64;
    { const float* x = (const float*)args.in[0]; bf16_t* xb = (bf16_t*)(ws + WS_XB);
      for (size_t i = gt; i < (size_t)T * D / 8; i += NT_) { const f32x4 a = *(const f32x4*)(x + i * 8), b = *(const f32x4*)(x + i * 8 + 4);
          u32x4 o; o.x = pk2(a[0], a[1]); o.y = pk2(a[2], a[3]); o.z = pk2(b[0], b[1]); o.w = pk2(b[2], b[3]); *(u32x4*)(xb + i * 8) = o; } }
    { const float* x = (const float*)args.in[1]; bf16_t* xb = (bf16_t*)(ws + WS_MEMB);
      for (size_t i = gt; i < (size_t)NB * NMEM * D / 8; i += NT_) { const f32x4 a = *(const f32x4*)(x + i * 8), b = *(const f32x4*)(x + i * 8 + 4);
          u32x4 o; o.x = pk2(a[0], a[1]); o.y = pk2(a[2], a[3]); o.z = pk2(b[0], b[1]); o.w = pk2(b[2], b[3]); *(u32x4*)(xb + i * 8) = o; } }
}

DI void p2_tokens(const Args& args, int vcu, int G) {
    int tid_ = threadIdx.x; asm volatile("" : "+v"(tid_)); const int lane = tid_ & 63; const int wave = __builtin_amdgcn_readfirstlane(tid_ >> 6);
    unsigned char* ws = args.ws;
    const bf16_t* proj = (const bf16_t*)(ws + WS_PROJ);
    bf16_t* qn = (bf16_t*)(ws + WS_QN); bf16_t* kvn = (bf16_t*)(ws + WS_KVN); bf16_t* kpe = (bf16_t*)(ws + WS_KPE); bf16_t* xc = (bf16_t*)(ws + WS_XC); float* cs = (float*)(ws + WS_CS);
    const int* positions = (const int*)args.in[2];
    const float* conv_w = (const float*)args.in[6]; const float* conv_b = (const float*)args.in[7];
    const float* g_qlat = (const float*)args.in[12]; const float* g_kvlat = (const float*)args.in[13];
    const int gw = vcu * NWAVES + wave, NGW = G * NWAVES;
    float cw[4][8], cb[8];
#pragma unroll
    for (int jj = 0; jj < 4; ++jj)
#pragma unroll
        for (int c = 0; c < 8; ++c) cw[jj][c] = conv_w[jj * MW + 8 * lane + c];
#pragma unroll
    for (int c = 0; c < 8; ++c) cb[c] = conv_b[8 * lane + c];
    const f32x4 gq = *(const f32x4*)(g_qlat + 4 * lane);
    const f32x2 gk = *(const f32x2*)(g_kvlat + 2 * lane);
    const float inv_freq = exp2f(-(float)(lane & 15) * (13.287712379549449f / 16.0f));
    for (int t = gw; t < T; t += NGW) {
        const bf16_t* pr = proj + (size_t)t * NPROJ;
        { const u32x2 w = *(const u32x2*)(pr + PC_QLAT + 4 * lane); const float a0 = bflo(w.x), a1 = bfhi(w.x), a2 = bflo(w.y), a3 = bfhi(w.y);
          const float ss = wave_sum(a0 * a0 + a1 * a1 + a2 * a2 + a3 * a3); const float r = 1.0f / sqrtf(ss * (1.0f / AQR) + EPS);
          u32x2 o; o.x = pk2(a0 * r * gq[0], a1 * r * gq[1]); o.y = pk2(a2 * r * gq[2], a3 * r * gq[3]); *(u32x2*)(qn + (size_t)t * 256 + 4 * lane) = o; }
        { const unsigned w = *(const unsigned*)(pr + PC_KVLAT + 2 * lane); const float a0 = bflo(w), a1 = bfhi(w);
          const float ss = wave_sum(a0 * a0 + a1 * a1); const float r = 1.0f / sqrtf(ss * (1.0f / AKVR) + EPS);
          *(unsigned*)(kvn + (size_t)t * 256 + 2 * lane) = pk2(a0 * r * gk[0], a1 * r * gk[1]); *(unsigned*)(kvn + (size_t)t * 256 + 128 + 2 * lane) = 0u; }
        if (lane < 16) { const unsigned w = *(const unsigned*)(pr + PC_KROPE + 2 * lane); const float x1 = bflo(w), x2 = bfhi(w);
          const float ang = (float)positions[t] * inv_freq;
          const double rev = (double)ang * 0.15915494309189535; const float fr = (float)(rev - __builtin_rint(rev));
          const float cc = __builtin_amdgcn_cosf(fr), sn = __builtin_amdgcn_sinf(fr);
          *(unsigned*)(kpe + (size_t)t * 32 + 2 * lane) = pk2(x1 * cc - x2 * sn, x2 * cc + x1 * sn);
          *(f32x2*)(cs + (size_t)t * 32 + 2 * lane) = (f32x2){cc, sn}; }
        { const int s = t & (SEQ - 1); float a[8];
#pragma unroll
          for (int c = 0; c < 8; ++c) a[c] = cb[c];
#pragma unroll
          for (int jj = 0; jj < 4; ++jj) { const int back = 3 - jj; if (s - back >= 0) { const u32x4 w = *(const u32x4*)(pr - (size_t)back * NPROJ + PC_XM + 8 * lane);
              a[0] += cw[jj][0] * bflo(w.x); a[1] += cw[jj][1] * bfhi(w.x); a[2] += cw[jj][2] * bflo(w.y); a[3] += cw[jj][3] * bfhi(w.y);
              a[4] += cw[jj][4] * bflo(w.z); a[5] += cw[jj][5] * bfhi(w.z); a[6] += cw[jj][6] * bflo(w.w); a[7] += cw[jj][7] * bfhi(w.w); } }
#pragma unroll
          for (int c = 0; c < 8; ++c) a[c] = a[c] * sigmoidf_(a[c]);
          u32x4 o; o.x = pk2(a[0], a[1]); o.y = pk2(a[2], a[3]); o.z = pk2(a[4], a[5]); o.w = pk2(a[6], a[7]); *(u32x4*)(xc + (size_t)t * MW + 8 * lane) = o; }
    }
}

DI void p6_mpost(const Args& args, int vcu, int G) {
    int tid_ = threadIdx.x; asm volatile("" : "+v"(tid_)); const int lane = tid_ & 63; const int wave = __builtin_amdgcn_readfirstlane(tid_ >> 6);
    unsigned char* ws = args.ws;
    const float* hraw = (const float*)(ws + WS_HRAW); const bf16_t* xc = (const bf16_t*)(ws + WS_XC); const bf16_t* proj = (const bf16_t*)(ws + WS_PROJ); bf16_t* hm = (bf16_t*)(ws + WS_HM);
    const float* g_mhead = (const float*)args.in[10]; const float* w_mskip = (const float*)args.in[11];
    const int gw = vcu * NWAVES + wave, NGW = G * NWAVES;
    float gm[8], wsk[8];
#pragma unroll
    for (int c = 0; c < 8; ++c) { gm[c] = g_mhead[8 * lane + c]; wsk[c] = w_mskip[8 * lane + c]; }
    for (int t = gw; t < T; t += NGW) {
        const f32x4 h0 = *(const f32x4*)(hraw + (size_t)t * MW + 8 * lane), h1 = *(const f32x4*)(hraw + (size_t)t * MW + 8 * lane + 4);
        float h[8] = {h0[0], h0[1], h0[2], h0[3], h1[0], h1[1], h1[2], h1[3]};
        float s = 0.f;
#pragma unroll
        for (int c = 0; c < 8; ++c) s += h[c];
        s += __shfl_xor(s, 1); s += __shfl_xor(s, 2); s += __shfl_xor(s, 4); s += __shfl_xor(s, 8);
        const float mu = s * (1.0f / MHD); float q = 0.f;
#pragma unroll
        for (int c = 0; c < 8; ++c) { h[c] -= mu; q += h[c] * h[c]; }
        q += __shfl_xor(q, 1); q += __shfl_xor(q, 2); q += __shfl_xor(q, 4); q += __shfl_xor(q, 8);
        const float rstd = 1.0f / sqrtf(q * (1.0f / MHD) + EPS);
        const u32x4 xw = *(const u32x4*)(xc + (size_t)t * MW + 8 * lane); const u32x4 ow = *(const u32x4*)(proj + (size_t)t * NPROJ + PC_OP + 8 * lane);
        const float xv[8] = {bflo(xw.x), bfhi(xw.x), bflo(xw.y), bfhi(xw.y), bflo(xw.z), bfhi(xw.z), bflo(xw.w), bfhi(xw.w)};
        const float ov[8] = {bflo(ow.x), bfhi(ow.x), bflo(ow.y), bfhi(ow.y), bflo(ow.z), bfhi(ow.z), bflo(ow.w), bfhi(ow.w)};
        float o[8];
#pragma unroll
        for (int c = 0; c < 8; ++c) o[c] = sigmoidf_(ov[c]) * (h[c] * rstd * gm[c] + wsk[c] * xv[c]);
        u32x4 w; w.x = pk2(o[0], o[1]); w.y = pk2(o[2], o[3]); w.z = pk2(o[4], o[5]); w.w = pk2(o[6], o[7]); *(u32x4*)(hm + (size_t)t * MW + 8 * lane) = w;
    }
}

DI void ln_pass(const float* res, const float* add, const float* g, const float* b, float* out, bf16_t* outb, int vcu, int G) {
    int tid_ = threadIdx.x; asm volatile("" : "+v"(tid_)); const int lane = tid_ & 63; const int wave = __builtin_amdgcn_readfirstlane(tid_ >> 6);
    const int gw = vcu * NWAVES + wave, NGW = G * NWAVES;
    for (int t = gw; t < T; t += NGW) {
        f32x4 v[4]; float s = 0.f;
#pragma unroll
        for (int j = 0; j < 4; ++j) { const f32x4 r = *(const f32x4*)(res + (size_t)t * D + 4 * lane + 256 * j), a = *(const f32x4*)(add + (size_t)t * D + 4 * lane + 256 * j);
            v[j] = r * DN_ALPHA + a; s += (v[j][0] + v[j][1]) + (v[j][2] + v[j][3]); }
        const float mean = wave_sum(s) * (1.0f / D); float q = 0.f;
#pragma unroll
        for (int j = 0; j < 4; ++j) { v[j] = v[j] - mean; q += (v[j][0] * v[j][0] + v[j][1] * v[j][1]) + (v[j][2] * v[j][2] + v[j][3] * v[j][3]); }
        const float rstd = 1.0f / sqrtf(wave_sum(q) * (1.0f / D) + EPS);
#pragma unroll
        for (int j = 0; j < 4; ++j) { const f32x4 gg = *(const f32x4*)(g + 4 * lane + 256 * j), bb = *(const f32x4*)(b + 4 * lane + 256 * j);
            const f32x4 y = v[j] * rstd * gg + bb;
            *(f32x4*)(out + (size_t)t * D + 4 * lane + 256 * j) = y;
            if (outb) { u32x2 w; w.x = pk2(y[0], y[1]); w.y = pk2(y[2], y[3]); *(u32x2*)(outb + (size_t)t * D + 4 * lane + 256 * j) = w; } }
    }
}

DI void p16_topk(const Args& args, LAS unsigned char* lds, int vcu, int G) {
    unsigned char* ws = args.ws;
    const float* logits = (const float*)(ws + WS_LOGITS); const float* b_router = (const float*)args.in[27];
    int* assign = (int*)(ws + WS_ASSIGN); float* gatew = (float*)(ws + WS_GATEW);
    unsigned* gcnt = (unsigned*)(ws + WS_CTL) + CW_CNT;
    LAS unsigned* hist = (LAS unsigned*)(lds + HIST_OFF); LAS unsigned* hbase = (LAS unsigned*)(lds + HBASE_OFF);
    int tid = threadIdx.x; asm volatile("" : "+v"(tid));
    for (int blk = vcu; blk < T / 512; blk += G) {
        const int t = blk * 512 + tid;
        float v[NE];
#pragma unroll
        for (int j = 0; j < NE / 4; ++j) { const f32x4 a = *(const f32x4*)(logits + (size_t)t * NE + 4 * j), bb = *(const f32x4*)(b_router + 4 * j);
            v[4 * j] = a[0] + bb[0]; v[4 * j + 1] = a[1] + bb[1]; v[4 * j + 2] = a[2] + bb[2]; v[4 * j + 3] = a[3] + bb[3]; }
        int idx[TOPK]; float val[TOPK];
#pragma unroll
        for (int k = 0; k < TOPK; ++k) { float best = -INFINITY; int bi = 0;
#pragma unroll
            for (int e = 0; e < NE; ++e) { bool taken = false;
#pragma unroll
                for (int kk = 0; kk < k; ++kk) taken = taken || (idx[kk] == e);
                if (!taken && v[e] > best) { best = v[e]; bi = e; } }
            idx[k] = bi; val[k] = best; }
        float ex[TOPK], sum = 0.f;
#pragma unroll
        for (int k = 0; k < TOPK; ++k) { ex[k] = __expf(val[k] - val[0]); sum += ex[k]; }
        const float inv = 1.0f / sum;
        if (tid < NE) hist[tid] = 0u;
        __syncthreads();
        unsigned lr[TOPK];
#pragma unroll
        for (int k = 0; k < TOPK; ++k) lr[k] = __hip_atomic_fetch_add(hist + idx[k], 1u, __ATOMIC_RELAXED, __HIP_MEMORY_SCOPE_WORKGROUP);
        __syncthreads();
        if (tid < NE) hbase[tid] = __hip_atomic_fetch_add(gcnt + tid, hist[tid], RLX_AGENT);
        __syncthreads();
#pragma unroll
        for (int k = 0; k < TOPK; ++k) { assign[(size_t)t * TOPK + k] = (idx[k] << 20) | (int)(hbase[idx[k]] + lr[k]); gatew[(size_t)t * TOPK + k] = ex[k] * inv; }
        __syncthreads();
    }
}
DI void build_tstart(const Args& args, LAS unsigned char* lds) {
    const unsigned* gcnt = (const unsigned*)(args.ws + WS_CTL) + CW_CNT; LAS int* tst = (LAS int*)(lds + TST_OFF);
    if (threadIdx.x == 0) { int acc = 0;
        for (int e = 0; e < NE; ++e) { tst[e] = acc; const unsigned c = __hip_atomic_load(gcnt + e, RLX_AGENT); acc += (int)((c + 255u) >> 8); }
        tst[NE] = acc; }
    __syncthreads();
}
DI void p17_gather(const Args& args, LAS unsigned char* lds, int vcu, int G) {
    int tid_ = threadIdx.x; asm volatile("" : "+v"(tid_)); const int lane = tid_ & 63; const int wave = __builtin_amdgcn_readfirstlane(tid_ >> 6);
    unsigned char* ws = args.ws;
    build_tstart(args, lds);
    const LAS int* tst = (const LAS int*)(lds + TST_OFF);
    const unsigned* gcnt = (const unsigned*)(ws + WS_CTL) + CW_CNT;
    const int* assign = (const int*)(ws + WS_ASSIGN); const float* gatew = (const float*)(ws + WS_GATEW);
    int* tokpos = (int*)(ws + WS_TOKPOS); float* rowgate = (float*)(ws + WS_ROWGATE);
    const bf16_t* h2b = (const bf16_t*)(ws + WS_H2B); unsigned char* xg = ws + WS_XG;
    const int gw = vcu * NWAVES + wave, NGW = G * NWAVES;
    for (int t = gw; t < T; t += NGW) {
        const u32x4 a = *(const u32x4*)(h2b + (size_t)t * D + 16 * lane), b = *(const u32x4*)(h2b + (size_t)t * D + 16 * lane + 8);
        u32x4 o;
        o.x = pg8::pk4_fp8(bflo(a.x) * pg8::F8_XS, bfhi(a.x) * pg8::F8_XS, bflo(a.y) * pg8::F8_XS, bfhi(a.y) * pg8::F8_XS); o.y = pg8::pk4_fp8(bflo(a.z) * pg8::F8_XS, bfhi(a.z) * pg8::F8_XS, bflo(a.w) * pg8::F8_XS, bfhi(a.w) * pg8::F8_XS);
        o.z = pg8::pk4_fp8(bflo(b.x) * pg8::F8_XS, bfhi(b.x) * pg8::F8_XS, bflo(b.y) * pg8::F8_XS, bfhi(b.y) * pg8::F8_XS); o.w = pg8::pk4_fp8(bflo(b.z) * pg8::F8_XS, bfhi(b.z) * pg8::F8_XS, bflo(b.w) * pg8::F8_XS, bfhi(b.w) * pg8::F8_XS);
#pragma unroll
        for (int k = 0; k < TOPK; ++k) { const int as = assign[(size_t)t * TOPK + k]; const int e = as >> 20, rank = as & 0xfffff; const int pos = tst[e] * 256 + rank;
            *(u32x4*)(xg + (size_t)pos * D + 16 * lane) = o;
            if (lane == 0) { tokpos[(size_t)t * TOPK + k] = pos; rowgate[pos] = gatew[(size_t)t * TOPK + k]; } }
    }
    for (int idx = gw; idx < NE * 256; idx += NGW) { const int e = idx >> 8, r = idx & 255; const int row = tst[e] * 256 + (int)__hip_atomic_load(gcnt + e, RLX_AGENT) + r;
        if (row < tst[e + 1] * 256) { const u32x4 z = {0u, 0u, 0u, 0u}; *(u32x4*)(xg + (size_t)row * D + 16 * lane) = z; if (lane == 0) rowgate[row] = 0.f; } }
}
DI void p20_final(const Args& args, int vcu, int G) {
    int tid_ = threadIdx.x; asm volatile("" : "+v"(tid_)); const int lane = tid_ & 63; const int wave = __builtin_amdgcn_readfirstlane(tid_ >> 6);
    unsigned char* ws = args.ws;
    const int* tokpos = (const int*)(ws + WS_TOKPOS); const bf16_t* yb = (const bf16_t*)(ws + WS_YB);
    const float* g = (const float*)args.in[32]; const float* b = (const float*)args.in[33]; float* out = args.out;
    const int gw = vcu * NWAVES + wave, NGW = G * NWAVES;
    for (int t = gw; t < T; t += NGW) {
        int pos[TOPK];
#pragma unroll
        for (int k = 0; k < TOPK; ++k) pos[k] = tokpos[(size_t)t * TOPK + k];
        f32x4 v[4]; float s = 0.f;
#pragma unroll
        for (int j = 0; j < 4; ++j) { const f32x4 r = *(const f32x4*)(out + (size_t)t * D + 4 * lane + 256 * j); f32x4 a = {0.f, 0.f, 0.f, 0.f};
#pragma unroll
            for (int k = 0; k < TOPK; ++k) { const u32x2 w = *(const u32x2*)(yb + (size_t)pos[k] * D + 4 * lane + 256 * j); a[0] += bflo(w.x); a[1] += bfhi(w.x); a[2] += bflo(w.y); a[3] += bfhi(w.y); }
            v[j] = r * DN_ALPHA + a; s += (v[j][0] + v[j][1]) + (v[j][2] + v[j][3]); }
        const float mean = wave_sum(s) * (1.0f / D); float q = 0.f;
#pragma unroll
        for (int j = 0; j < 4; ++j) { v[j] = v[j] - mean; q += (v[j][0] * v[j][0] + v[j][1] * v[j][1]) + (v[j][2] * v[j][2] + v[j][3] * v[j][3]); }
        const float rstd = 1.0f / sqrtf(wave_sum(q) * (1.0f / D) + EPS);
#pragma unroll
        for (int j = 0; j < 4; ++j) { const f32x4 gg = *(const f32x4*)(g + 4 * lane + 256 * j), bb = *(const f32x4*)(b + 4 * lane + 256 * j);
            *(f32x4*)(out + (size_t)t * D + 4 * lane + 256 * j) = v[j] * rstd * gg + bb; }
    }
}
constexpr int AT_KROW = 208, AT_VROW = 136;
constexpr int AT_KBUF = 64 * AT_KROW, AT_VBUF = 64 * AT_VROW, AT_VOFF = 2 * AT_KBUF;
DI void mla_unit(int b, int h, int qb, const bf16_t* Q, const bf16_t* Kn, const bf16_t* Kpe, const bf16_t* Vt, bf16_t* O, LAS unsigned char* lds) {
    int tid = threadIdx.x; asm volatile("" : "+v"(tid)); const int lane = tid & 63, r32 = lane & 31, hi = lane >> 5; const int wid = __builtin_amdgcn_readfirstlane(tid >> 6);
    const int q0 = qb * 256 + wid * 32;
    const int qi = q0 + r32;
    const size_t tokb = (size_t)b * SEQ;
    bf16x8 qf[6];
    { const bf16_t* qp = Q + (tokb + qi) * (AH * AQK) + h * AQK + 8 * hi;
#pragma unroll
      for (int s = 0; s < 6; ++s) qf[s] = *(const bf16x8*)(qp + 16 * s); }
    const int kkey = tid >> 3, kch = tid & 7, pkey = (tid & 255) >> 2, pch = tid & 3, vd = tid >> 3, vch = tid & 7;
    const bf16_t* ksrc = Kn + (tokb + kkey) * 512 + h * 64 + kch * 8;
    const bf16_t* psrc = Kpe + (tokb + pkey) * 32 + pch * 8;
    const bf16_t* vsrc = Vt + (size_t)(h * 64 + vd) * T + tokb + vch * 8;
    const int kdst = kkey * AT_KROW + kch * 16, pdst = pkey * AT_KROW + 128 + pch * 16, vdst = AT_VOFF + vd * AT_VROW + vch * 16;
    const int nkt = 4 * (qb + 1);
    u32x4 rk, rp, rv;
    rk = *(const u32x4*)ksrc; rv = *(const u32x4*)vsrc; rp = (u32x4){0u, 0u, 0u, 0u}; if (tid < 256) rp = *(const u32x4*)psrc;
    *(LAS u32x4*)(lds + kdst) = rk; if (tid < 256) *(LAS u32x4*)(lds + pdst) = rp;
    *(LAS u32x2*)(lds + vdst) = (u32x2){rv.x, rv.y}; *(LAS u32x2*)(lds + vdst + 8) = (u32x2){rv.z, rv.w};
    __syncthreads();
    float m_run = -INFINITY, l_run = 0.f;
    f32x16 o0, o1;
#pragma unroll
    for (int r = 0; r < 16; ++r) { o0[r] = 0.f; o1[r] = 0.f; }
    for (int kt = 0; kt < nkt; ++kt) {
        const int buf = kt & 1;
        if (kt + 1 < nkt) { rk = *(const u32x4*)(ksrc + (size_t)(kt + 1) * 64 * 512); rv = *(const u32x4*)(vsrc + (kt + 1) * 64); if (tid < 256) rp = *(const u32x4*)(psrc + (size_t)(kt + 1) * 64 * 32); }
        const int key0 = kt * 64;
        if (key0 <= q0 + 31) {
            const LAS unsigned char* kb = lds + buf * AT_KBUF + r32 * AT_KROW + hi * 16;
            f32x16 p0, p1;
#pragma unroll
            for (int r = 0; r < 16; ++r) { p0[r] = 0.f; p1[r] = 0.f; }
#pragma unroll
            for (int s = 0; s < 6; ++s) { const bf16x8 a0 = *(const LAS bf16x8*)(kb + s * 32), a1 = *(const LAS bf16x8*)(kb + 32 * AT_KROW + s * 32);
                p0 = MFMA32(a0, qf[s], p0); p1 = MFMA32(a1, qf[s], p1); }
            if (key0 + 63 > q0) {
#pragma unroll
                for (int r = 0; r < 16; ++r) { const int key = key0 + crow(r, hi); if (key > qi) p0[r] = -INFINITY; if (key + 32 > qi) p1[r] = -INFINITY; }
            }
            float mx = fmaxf(p0[0], p1[0]);
#pragma unroll
            for (int r = 1; r < 16; ++r) mx = fmaxf(mx, fmaxf(p0[r], p1[r]));
            mx = fmaxf(mx, __shfl_xor(mx, 32));
            const float m_new = fmaxf(m_run, mx);
            const float alpha = __builtin_amdgcn_exp2f(m_run - m_new);
            m_run = m_new;
            float ls = 0.f;
#pragma unroll
            for (int r = 0; r < 16; ++r) { p0[r] = __builtin_amdgcn_exp2f(p0[r] - m_new); p1[r] = __builtin_amdgcn_exp2f(p1[r] - m_new); ls += p0[r] + p1[r]; }
            l_run = l_run * alpha + ls;
#pragma unroll
            for (int r = 0; r < 16; ++r) { o0[r] *= alpha; o1[r] *= alpha; }
            bf16x8 pb[4];
#pragma unroll
            for (int s = 0; s < 4; ++s) { u32x4 w;
                if (s < 2) { w.x = pk2(p0[8 * s], p0[8 * s + 1]); w.y = pk2(p0[8 * s + 2], p0[8 * s + 3]); w.z = pk2(p0[8 * s + 4], p0[8 * s + 5]); w.w = pk2(p0[8 * s + 6], p0[8 * s + 7]); }
                else { const int s2 = s - 2; w.x = pk2(p1[8 * s2], p1[8 * s2 + 1]); w.y = pk2(p1[8 * s2 + 2], p1[8 * s2 + 3]); w.z = pk2(p1[8 * s2 + 4], p1[8 * s2 + 5]); w.w = pk2(p1[8 * s2 + 6], p1[8 * s2 + 7]); }
                pb[s] = __builtin_bit_cast(bf16x8, w); }
            const LAS unsigned char* vb = lds + AT_VOFF + buf * AT_VBUF + r32 * AT_VROW + hi * 8;
#pragma unroll
            for (int s = 0; s < 4; ++s) {
                const u32x2 a0l = *(const LAS u32x2*)(vb + s * 32), a0h = *(const LAS u32x2*)(vb + s * 32 + 16);
                const u32x2 a1l = *(const LAS u32x2*)(vb + 32 * AT_VROW + s * 32), a1h = *(const LAS u32x2*)(vb + 32 * AT_VROW + s * 32 + 16);
                const bf16x8 a0 = __builtin_bit_cast(bf16x8, (u32x4){a0l.x, a0l.y, a0h.x, a0h.y}), a1 = __builtin_bit_cast(bf16x8, (u32x4){a1l.x, a1l.y, a1h.x, a1h.y});
                o0 = MFMA32(a0, pb[s], o0); o1 = MFMA32(a1, pb[s], o1); }
        }
        if (kt + 1 < nkt) { const int nb = (kt + 1) & 1;
            *(LAS u32x4*)(lds + nb * AT_KBUF + kdst) = rk; if (tid < 256) *(LAS u32x4*)(lds + nb * AT_KBUF + pdst) = rp;
            *(LAS u32x2*)(lds + nb * AT_VBUF + vdst) = (u32x2){rv.x, rv.y}; *(LAS u32x2*)(lds + nb * AT_VBUF + vdst + 8) = (u32x2){rv.z, rv.w}; }
        __syncthreads();
    }
    const float lt = l_run + __shfl_xor(l_run, 32); const float inv = 1.0f / lt;
    bf16_t* op = O + (tokb + qi) * AW + h * AVD + 4 * hi;
#pragma unroll
    for (int g = 0; g < 4; ++g) { u32x2 w0, w1;
        w0.x = pk2(o0[4 * g] * inv, o0[4 * g + 1] * inv); w0.y = pk2(o0[4 * g + 2] * inv, o0[4 * g + 3] * inv);
        w1.x = pk2(o1[4 * g] * inv, o1[4 * g + 1] * inv); w1.y = pk2(o1[4 * g + 2] * inv, o1[4 * g + 3] * inv);
        *(u32x2*)(op + 8 * g) = w0; *(u32x2*)(op + 32 + 8 * g) = w1; }
}
DI void p4_attention(const Args& args, LAS unsigned char* lds, int vcu, int G) {
    unsigned char* ws = args.ws;
    const bf16_t* Q = (const bf16_t*)(ws + WS_QMLA); const bf16_t* Kn = (const bf16_t*)(ws + WS_KN); const bf16_t* Kpe = (const bf16_t*)(ws + WS_KPE); const bf16_t* Vt = (const bf16_t*)(ws + WS_VT);
    bf16_t* O = (bf16_t*)(ws + WS_AO);
    for (int p = vcu; p < NB * AH * 4; p += G) { const int bh = p >> 2, j = p & 3; const int b = bh / AH, h = bh % AH;
        mla_unit(b, h, 7 - j, Q, Kn, Kpe, Vt, O, lds);
        mla_unit(b, h, j, Q, Kn, Kpe, Vt, O, lds); }
}

constexpr int ML_QROW = 272, ML_TROW = 144;
constexpr int ML_QS = 0, ML_KS = ML_QS + 64 * ML_QROW, ML_KTS = ML_KS + 64 * ML_QROW, ML_VTS = ML_KTS + 128 * ML_TROW, ML_CS = ML_VTS + 32 * ML_TROW, ML_SS = ML_CS + 32 * ML_QROW,
              ML_VEC = ML_SS + 64 * ML_TROW;
static_assert(ML_VEC + (7 * 64 + 128 + 4) * 4 <= RING_BYTES, "mLSTM LDS");
DI void mlstm_unit(int b, int h, int vs, const Args& args, LAS unsigned char* lds) {
    unsigned char* ws = args.ws;
    const bf16_t* qkm = (const bf16_t*)(ws + WS_QKM); const bf16_t* ktm = (const bf16_t*)(ws + WS_KTM); const bf16_t* proj = (const bf16_t*)(ws + WS_PROJ);
    const float* gates = (const float*)(ws + WS_GATES); float* hraw = (float*)(ws + WS_HRAW);
    const float b_i = ((const float*)args.in[4])[h], b_f = ((const float*)args.in[5])[h];
    int tid = threadIdx.x; asm volatile("" : "+v"(tid)); const int lane = tid & 63, r32 = lane & 31, hi = lane >> 5; const int wid = __builtin_amdgcn_readfirstlane(tid >> 6);
    LAS float* ROWT = (LAS float*)(lds + ML_VEC); LAS float* COLT = ROWT + 64; LAS float* WINT = ROWT + 128; LAS float* ENEG = ROWT + 192; LAS float* WAS = ROWT + 256;
    LAS float* NQ = ROWT + 320; LAS float* DINV = ROWT + 384; LAS float* NVEC = ROWT + 448; LAS float* SCAL = ROWT + 576;
    const size_t tokb = (size_t)b * SEQ;
    for (int i = tid; i < 32 * ML_QROW / 4; i += 512) ((LAS unsigned*)(lds + ML_CS))[i] = 0u;
    if (tid < 128) NVEC[tid] = 0.f;
    f32x16 cacc;
#pragma unroll
    for (int r = 0; r < 16; ++r) cacc[r] = 0.f;
    float m_st = 0.f;
    u32x4 sq[2], sk[2], skt[2], sv; float gi = 0.f, gf = 0.f;
    sv = (u32x4){0u, 0u, 0u, 0u};
#define ML_LOAD(c) do { const size_t tok0 = tokb + (size_t)(c) * MCH; \
        _Pragma("unroll") for (int i = 0; i < 2; ++i) { const int idx = tid + 512 * i; \
            sq[i] = *(const u32x4*)(qkm + (tok0 + (idx >> 4)) * 1024 + h * MHD + (idx & 15) * 8); \
            sk[i] = *(const u32x4*)(qkm + (tok0 + (idx >> 4)) * 1024 + 512 + h * MHD + (idx & 15) * 8); \
            skt[i] = *(const u32x4*)(ktm + (size_t)(h * MHD + (idx >> 3)) * T + tok0 + (idx & 7) * 8); } \
        if (tid < 256) sv = *(const u32x4*)(proj + (tok0 + (tid >> 2)) * NPROJ + PC_VM + h * MHD + vs * 32 + (tid & 3) * 8); \
        if (wid == 0) { gi = gates[(tok0 + lane) * 8 + h]; gf = gates[(tok0 + lane) * 8 + 4 + h]; } } while (0)
    ML_LOAD(0);
    for (int c = 0; c < SEQ / MCH; ++c) {
        const size_t tok0 = tokb + (size_t)c * MCH;
#pragma unroll
        for (int i = 0; i < 2; ++i) { const int idx = tid + 512 * i;
            *(LAS u32x4*)(lds + ML_QS + (idx >> 4) * ML_QROW + (idx & 15) * 16) = sq[i];
            *(LAS u32x4*)(lds + ML_KS + (idx >> 4) * ML_QROW + (idx & 15) * 16) = sk[i];
            *(LAS u32x4*)(lds + ML_KTS + (idx >> 3) * ML_TROW + (idx & 7) * 16) = skt[i]; }
        if (tid < 256) { const int l = tid >> 2, v0 = (tid & 3) * 8; LAS bf16_t* vt = (LAS bf16_t*)(lds + ML_VTS);
            vt[(v0 + 0) * (ML_TROW / 2) + l] = (bf16_t)(sv.x & 0xffff); vt[(v0 + 1) * (ML_TROW / 2) + l] = (bf16_t)(sv.x >> 16);
            vt[(v0 + 2) * (ML_TROW / 2) + l] = (bf16_t)(sv.y & 0xffff); vt[(v0 + 3) * (ML_TROW / 2) + l] = (bf16_t)(sv.y >> 16);
            vt[(v0 + 4) * (ML_TROW / 2) + l] = (bf16_t)(sv.z & 0xffff); vt[(v0 + 5) * (ML_TROW / 2) + l] = (bf16_t)(sv.z >> 16);
            vt[(v0 + 6) * (ML_TROW / 2) + l] = (bf16_t)(sv.w & 0xffff); vt[(v0 + 7) * (ML_TROW / 2) + l] = (bf16_t)(sv.w >> 16); }
        if (wid == 0) {
            const float xf = gf + b_f;
            const float lf = (xf >= 0.f) ? -log1pf(__expf(-xf)) : xf - log1pf(__expf(xf));
            float bb = lf;
#pragma unroll
            for (int o = 1; o < 64; o <<= 1) { const float tv = __shfl_up(bb, o); if (lane >= o) bb += tv; }
            const float btot = __shfl(bb, 63);
            const float ig = gi + b_i;
            const float a = btot - bb + ig;
            const float mchunk = wave_max(a);
            const float wa = __expf(a - mchunk);
            const float u = ig - bb;
            float pm = u;
#pragma unroll
            for (int o = 1; o < 64; o <<= 1) { const float tv = __shfl_up(pm, o); if (lane >= o) pm = fmaxf(pm, tv); }
            const float mintra = bb + pm;
            const float ginter = bb + m_st;
            const float m = fmaxf(ginter, mintra);
            const float mnew = fmaxf(btot + m_st, mchunk);
            const float sold = __expf(btot + m_st - mnew), snew = __expf(mchunk - mnew);
            ROWT[lane] = bb - m; COLT[lane] = u; WINT[lane] = __expf(ginter - m); ENEG[lane] = __expf(-m); WAS[lane] = snew * wa;
            if (lane == 0) SCAL[0] = sold;
            m_st = mnew;
        }
        __syncthreads();
        if (c + 1 < SEQ / MCH) ML_LOAD(c + 1);
        f32x16 iacc;
#pragma unroll
        for (int r = 0; r < 16; ++r) iacc[r] = 0.f;
        if (wid < 4) {
            const int jb = wid >> 1, sb = wid & 1;
            LAS bf16_t* ss = (LAS bf16_t*)(lds + ML_SS);
            if (sb <= jb) {
                f32x16 s;
#pragma unroll
                for (int r = 0; r < 16; ++r) s[r] = 0.f;
                const LAS unsigned char* qa = lds + ML_QS + (32 * jb + r32) * ML_QROW + hi * 16; const LAS unsigned char* kb = lds + ML_KS + (32 * sb + r32) * ML_QROW + hi * 16;
#pragma unroll
                for (int kk = 0; kk < 8; ++kk) s = MFMA32(*(const LAS bf16x8*)(qa + kk * 32), *(const LAS bf16x8*)(kb + kk * 32), s);
                const int sidx = 32 * sb + r32; const float ct = COLT[sidx];
#pragma unroll
                for (int r = 0; r < 16; ++r) { const int j = 32 * jb + crow(r, hi);
                    const float val = (sidx <= j) ? s[r] * __expf(ROWT[j] + ct) : 0.f;
                    ss[j * (ML_TROW / 2) + sidx] = (bf16_t)f2bf(val); }
            } else {
#pragma unroll
                for (int r = 0; r < 16; ++r) ss[(32 * jb + crow(r, hi)) * (ML_TROW / 2) + 32 * sb + r32] = (bf16_t)0;
            }
        } else if (wid < 6) {
            const int jb = wid - 4;
            const LAS unsigned char* qa = lds + ML_QS + (32 * jb + r32) * ML_QROW + hi * 16; const LAS unsigned char* cb = lds + ML_CS + r32 * ML_QROW + hi * 16;
#pragma unroll
            for (int kk = 0; kk < 8; ++kk) iacc = MFMA32(*(const LAS bf16x8*)(qa + kk * 32), *(const LAS bf16x8*)(cb + kk * 32), iacc);
        } else {
            const int j = 32 * (wid - 6) + (lane >> 1), half = lane & 1;
            const LAS unsigned char* qa = lds + ML_QS + j * ML_QROW + half * 128; float acc = 0.f;
#pragma unroll
            for (int i = 0; i < 8; ++i) { const u32x4 w = *(const LAS u32x4*)(qa + i * 16); const f32x4 n0 = *(const LAS f32x4*)(NVEC + half * 64 + i * 8), n1 = *(const LAS f32x4*)(NVEC + half * 64 + i * 8 + 4);
                acc += bflo(w.x) * n0[0] + bfhi(w.x) * n0[1] + bflo(w.y) * n0[2] + bfhi(w.y) * n0[3] + bflo(w.z) * n1[0] + bfhi(w.z) * n1[1] + bflo(w.w) * n1[2] + bfhi(w.w) * n1[3]; }
            acc += __shfl_xor(acc, 1);
            if (half == 0) NQ[j] = acc;
        }
        __syncthreads();
        if (wid < 4) {
            const float sold = SCAL[0];
#pragma unroll
            for (int r = 0; r < 16; ++r) cacc[r] *= sold;
            const LAS unsigned char* va = lds + ML_VTS + r32 * ML_TROW + hi * 16; const LAS unsigned char* kb = lds + ML_KTS + (32 * wid + r32) * ML_TROW + hi * 16;
#pragma unroll
            for (int kk = 0; kk < 4; ++kk) { const u32x4 w = *(const LAS u32x4*)(va + kk * 32);
                const f32x4 w0 = *(const LAS f32x4*)(WAS + 16 * kk + 8 * hi), w1 = *(const LAS f32x4*)(WAS + 16 * kk + 8 * hi + 4);
                u32x4 sa; sa.x = pk2(bflo(w.x) * w0[0], bfhi(w.x) * w0[1]); sa.y = pk2(bflo(w.y) * w0[2], bfhi(w.y) * w0[3]); sa.z = pk2(bflo(w.z) * w1[0], bfhi(w.z) * w1[1]); sa.w = pk2(bflo(w.w) * w1[2], bfhi(w.w) * w1[3]);
                cacc = MFMA32(__builtin_bit_cast(bf16x8, sa), *(const LAS bf16x8*)(kb + kk * 32), cacc); }
            LAS bf16_t* cs = (LAS bf16_t*)(lds + ML_CS);
#pragma unroll
            for (int r = 0; r < 16; ++r) cs[crow(r, hi) * (ML_QROW / 2) + 32 * wid + r32] = (bf16_t)f2bf(cacc[r]);
        } else if (wid < 6) {
            const int jb = wid - 4;
#pragma unroll
            for (int r = 0; r < 16; ++r) iacc[r] *= WINT[32 * jb + crow(r, hi)];
            const LAS unsigned char* sa = lds + ML_SS + (32 * jb + r32) * ML_TROW + hi * 16; const LAS unsigned char* vb = lds + ML_VTS + r32 * ML_TROW + hi * 16;
#pragma unroll
            for (int kk = 0; kk < 4; ++kk) iacc = MFMA32(*(const LAS bf16x8*)(sa + kk * 32), *(const LAS bf16x8*)(vb + kk * 32), iacc);
        } else {
            const int tl = (wid - 6) * 64 + lane;
            { const int j = tl >> 1, half = tl & 1; const LAS unsigned char* sp = lds + ML_SS + j * ML_TROW + half * 64; float rs = 0.f;
#pragma unroll
              for (int i = 0; i < 4; ++i) { const u32x4 w = *(const LAS u32x4*)(sp + i * 16); rs += (bflo(w.x) + bfhi(w.x)) + (bflo(w.y) + bfhi(w.y)) + (bflo(w.z) + bfhi(w.z)) + (bflo(w.w) + bfhi(w.w)); }
              rs += __shfl_xor(rs, 1);
              if (half == 0) { const float den = WINT[j] * NQ[j] + rs; DINV[j] = 1.0f / fmaxf(fabsf(den), ENEG[j]); } }
            { const int k = tl; const LAS unsigned char* kp = lds + ML_KTS + k * ML_TROW; float acc = SCAL[0] * NVEC[k];
#pragma unroll
              for (int i = 0; i < 8; ++i) { const u32x4 w = *(const LAS u32x4*)(kp + i * 16); const f32x4 w0 = *(const LAS f32x4*)(WAS + i * 8), w1 = *(const LAS f32x4*)(WAS + i * 8 + 4);
                  acc += bflo(w.x) * w0[0] + bfhi(w.x) * w0[1] + bflo(w.y) * w0[2] + bfhi(w.y) * w0[3] + bflo(w.z) * w1[0] + bfhi(w.z) * w1[1] + bflo(w.w) * w1[2] + bfhi(w.w) * w1[3]; }
              NVEC[k] = acc; }
        }
        __syncthreads();
        if (wid == 4 || wid == 5) {
            const int jb = wid - 4; float* hp = hraw + (tok0 + 32 * jb) * MW + h * MHD + vs * 32 + r32;
#pragma unroll
            for (int r = 0; r < 16; ++r) { const int j = crow(r, hi); hp[(size_t)j * MW] = iacc[r] * DINV[32 * jb + j]; }
        }
    }
#undef ML_LOAD
    __syncthreads();
}
DI void p5_mlstm(const Args& args, LAS unsigned char* lds, int vcu, int G) {
    for (int u = vcu; u < NB * MH * 4; u += G) { const int vs = u & 3, bh = u >> 2; mlstm_unit(bh / MH, bh % MH, vs, args, lds); }
}
#ifndef MK_ONE_LAUNCH
#define MK_ONE_LAUNCH 1
#endif
#ifndef P3SEL
#define P3SEL 31
#endif
constexpr int NPH = 20;
__global__ void __launch_bounds__(NWAVES * 64, 2) fwd_kernel(Args args) {
    extern __shared__ __attribute__((aligned(16))) unsigned char lds_raw[];
    LAS unsigned char* lds = (LAS unsigned char*)lds_raw;
    const int tid = threadIdx.x;
    const int G = gridDim.x; const int bx = blockIdx.x; const int vcu = (G % 8 == 0) ? (bx % 8) * (G / 8) + bx / 8 : bx;
    unsigned char* ws = args.ws;
    for (int u = tid; u < (LDS_BYTES - LDSCTL_OFF) / 4; u += NWAVES * 64) ((LAS unsigned*)(lds + LDSCTL_OFF))[u] = 0u;
    __syncthreads();
    volatile LAS unsigned* MISC = (volatile LAS unsigned*)(lds + MISC_OFF);
    XcdBarrier bar; bar.bar = (unsigned*)(ws + WS_CTL) + CW_BAR; bar.x = 0; bar.st = nullptr;
    const int lo = args.ph_lo, hi = args.ph_hi;
    if (hi - lo > 1) bar = xcd_barrier_post((unsigned*)(ws + WS_CTL) + CW_BAR, MISC + 8);
#ifndef PHASE_MASK
#define PHASE_MASK 0xFFFFFu
#endif
#define IN(k) (((PHASE_MASK >> (k)) & 1u) && lo <= (k) && (k) < hi)
#ifndef DUP_PHASE
#define DUP_PHASE -1
#endif
#define REP(k) _Pragma("unroll 1") for (int rep_ = 0; rep_ < ((DUP_PHASE == (k)) ? 2 : 1); ++rep_)
#define SEAM(k) do { if (IN(k) && IN((k) + 1)) xcd_barrier(bar); } while (0)
    using namespace pg8;
    LAS unsigned char* ring = lds + RING_OFF;
    const bf16_t* cws = (const bf16_t*)ws;
#define WSB(off) ((bf16_t*)(ws + (off)))
#define WSF(off) ((float*)(ws + (off)))

    if (IN(0)) REP(0) { p0_prologue(args, lds, vcu, G); }
    SEAM(0);
    if (IN(1)) REP(1) {
        { DenseOrder S; S.init(WSB(WS_XB), WSB(WS_W_IN), T, NPROJ, D, D, G, bx); EpiProj E{WSB(WS_PROJ), WSF(WS_GATES)}; gemm_phase(ring, D, D, D, S, E); }
        { DenseOrder S; S.init(WSB(WS_MEMB), WSB(WS_W_CK), NB * NMEM, D, D, D, G, bx); EpiBf16 E{WSB(WS_KC), D, 1 << 30, 1.f}; gemm_phase(ring, D, D, D, S, E); }
        { DenseOrder S; S.init(WSB(WS_W_CV), WSB(WS_MEMB), D, NB * NMEM, D, D, G, bx); EpiBf16 E{WSB(WS_VCT), NB * NMEM, 1 << 30, 1.f}; gemm_phase(ring, D, D, D, S, E); }
    }
    SEAM(1);
    if (IN(2)) REP(2) { p2_tokens(args, vcu, G); }
    SEAM(2);
    if (IN(3)) REP(3) {
        if (P3SEL & 1) { DenseOrder S; S.init(WSB(WS_QN), WSB(WS_W_UQ), T, AH * AQK, 256, 256, G, bx); EpiQmla E{WSB(WS_QMLA), WSF(WS_CS), 0.10206207261596575f * 1.4426950408889634f}; gemm_phase(ring, 256, 256, 256, S, E); }
        if (P3SEL & 2) { DenseOrder S; S.init(WSB(WS_KVN), WSB(WS_W_UK), T, 512, 256, 256, G, bx); EpiBf16 E{WSB(WS_KN), 512, 1 << 30, 1.f}; gemm_phase(ring, 256, 256, 256, S, E); }
        if (P3SEL & 4) { DenseOrder S; S.init(WSB(WS_W_UV), WSB(WS_KVN), 512, T, 256, 256, G, bx); EpiBf16 E{WSB(WS_VT), T, 1 << 30, 1.f}; gemm_phase(ring, 256, 256, 256, S, E); }
        if (P3SEL & 8) { DenseOrder S; S.init(WSB(WS_XC), WSB(WS_W_MQK), T, 1024, 512, 512, G, bx); EpiBf16 E{WSB(WS_QKM), 1024, 2, 0.08838834764831845f}; gemm_phase(ring, 512, 512, 512, S, E); }
        if (P3SEL & 16) { DenseOrder S; S.init(WSB(WS_W_MQK) + 512 * 512, WSB(WS_XC), 512, T, 512, 512, G, bx); EpiBf16 E{WSB(WS_KTM), T, 0, 0.08838834764831845f}; gemm_phase(ring, 512, 512, 512, S, E); }
    }
    SEAM(3);
    if (IN(4)) { REP(40) { p5_mlstm(args, lds, vcu, G); } REP(41) { p4_attention(args, lds, vcu, G); } }
    SEAM(4);
    if (IN(5)) REP(5) { p6_mpost(args, vcu, G); }
    SEAM(5);
    if (IN(6)) REP(6) {
        { DenseOrder S; S.init(WSB(WS_HM), WSB(WS_W_BRM), T, D, 512, 512, G, bx); EpiGate<false> E{WSB(WS_GATED), WSB(WS_PROJ), PC_GM}; gemm_phase(ring, 512, 512, 512, S, E); }
        { DenseOrder S; S.init(WSB(WS_AO), WSB(WS_W_BRA), T, D, 512, 512, G, bx); EpiGate<true> E{WSB(WS_GATED), WSB(WS_PROJ), PC_GA}; gemm_phase(ring, 512, 512, 512, S, E); }
    }
    SEAM(6);
    if (IN(7)) REP(7) { DenseOrder S; S.init(WSB(WS_GATED), WSB(WS_W_MIX), T, D, D, D, G, bx); EpiF32 E{WSF(WS_MIXO), D, 1 << 30}; gemm_phase(ring, D, D, D, S, E); }
    SEAM(7);
    if (IN(8)) REP(8) { ln_pass((const float*)args.in[0], WSF(WS_MIXO), (const float*)args.in[19], (const float*)args.in[20], args.out, WSB(WS_H1B), vcu, G); }
    SEAM(8);
    if (IN(9)) REP(9) { DenseOrder S; S.init(WSB(WS_H1B), WSB(WS_W_CQ), T, D, D, D, G, bx); EpiBf16 E{WSB(WS_QC), D, 0, 0.0625f * 1.4426950408889634f}; gemm_phase(ring, D, D, D, S, E); }
    SEAM(9);
    if (IN(10)) REP(10) { CrossSOrder S{(const char*)(ws + WS_QC), (const char*)(ws + WS_KC), G, vcu}; EpiSoftmax E{WSB(WS_PC), (LAS float*)(lds + RED_OFF)}; gemm_phase(ring, 256, D, D, S, E); }
    SEAM(10);
    if (IN(11)) REP(11) { CrossOOrder S{(const char*)(ws + WS_PC), (const char*)(ws + WS_VCT), G, vcu}; EpiBf16 E{WSB(WS_OC), D, 1 << 30, 1.f}; gemm_phase(ring, 256, D, NB * NMEM, S, E); }
    SEAM(11);
    if (IN(12)) REP(12) { DenseOrder S; S.init(WSB(WS_OC), WSB(WS_W_CO), T, D, D, D, G, bx); EpiF32 E{WSF(WS_COO), D, 1 << 30}; gemm_phase(ring, D, D, D, S, E); }
    SEAM(12);
    if (IN(13)) REP(13) { ln_pass(args.out, WSF(WS_COO), (const float*)args.in[24], (const float*)args.in[25], args.out, WSB(WS_H2B), vcu, G); }
    SEAM(13);
    if (IN(14)) REP(14) { DenseOrder S; S.init(WSB(WS_H2B), WSB(WS_W_R), T, 256, D, D, G, bx); EpiF32 E{WSF(WS_LOGITS), NE, NE}; gemm_phase(ring, D, D, D, S, E); }
    SEAM(14);
    if (IN(15)) REP(15) { p16_topk(args, lds, vcu, G); }
    SEAM(15);
    if (IN(16)) REP(16) { p17_gather(args, lds, vcu, G); }
    SEAM(16);
    if (IN(17)) REP(17) { build_tstart(args, lds);
        MoeOrder S{(const char*)(ws + WS_XG), (const char*)(ws + WS_W_GU), (const LAS int*)(lds + TST_OFF), 8, G, vcu, (size_t)256 * D, (size_t)2048 * 1024, (size_t)256 * 1024};
        EpiSwiglu E{ws + WS_ACT, (const float*)args.in[29]}; gemm_phase<EpiSwiglu, MoeOrder, true>(ring, D, D, D, S, E); }
    SEAM(17);
    if (IN(18)) REP(18) { build_tstart(args, lds);
        MoeOrder S{(const char*)(ws + WS_ACT), (const char*)(ws + WS_W_DN), (const LAS int*)(lds + TST_OFF), 4, G, vcu, (size_t)256 * D, (size_t)1024 * 1024, (size_t)256 * 1024};
        EpiDown E{WSB(WS_YB), (const float*)args.in[31], WSF(WS_ROWGATE)}; gemm_phase<EpiDown, MoeOrder, true>(ring, D, D, D, S, E); }
    SEAM(18);
    if (IN(19)) REP(19) { p20_final(args, vcu, G); }
    (void)cws;
#undef IN
#undef SEAM
}

extern "C" void kernel_launch(void* const* d_in, const int* in_sizes, int n_in, void* d_out, int out_size, void* d_ws, size_t ws_size, hipStream_t stream) {
    static int grid = 0;
    if (grid == 0) {
        if (n_in != 34 || in_sizes[0] != T * D || out_size != T * D || ws_size < WS_END) { fprintf(stderr, "kernel_launch: unexpected shapes / workspace (n_in %d, ws %zu)\n", n_in, ws_size); grid = -1; return; }
        int dev = 0, cus = 0, per_cu = 0;
        if (hipGetDevice(&dev) != hipSuccess || hipDeviceGetAttribute(&cus, hipDeviceAttributeMultiprocessorCount, dev) != hipSuccess) { grid = -1; return; }
        if (hipFuncSetAttribute((const void*)fwd_kernel, hipFuncAttributeMaxDynamicSharedMemorySize, LDS_BYTES) != hipSuccess) { fprintf(stderr, "kernel_launch: hipFuncSetAttribute failed\n"); grid = -1; return; }
        if (hipOccupancyMaxActiveBlocksPerMultiprocessor(&per_cu, (const void*)fwd_kernel, NWAVES * 64, LDS_BYTES) != hipSuccess || per_cu < 1) fprintf(stderr, "kernel_launch: occupancy query says %d\n", per_cu);
        (void)hipGetLastError();
        grid = cus;
    }
    if (grid < 0) return;
    if (hipMemsetAsync((char*)d_ws + WS_CTL, 0, CTL_ZERO_BYTES, stream) != hipSuccess) return;
    Args a{};
    for (int i = 0; i < 34; ++i) a.in[i] = d_in[i];
    a.out = (float*)d_out; a.ws = (unsigned char*)d_ws;
#if MK_ONE_LAUNCH
    a.ph_lo = 0; a.ph_hi = NPH;
    hipLaunchKernelGGL(fwd_kernel, dim3(grid), dim3(NWAVES * 64), LDS_BYTES, stream, a);
#else
    for (int p = 0; p < NPH; ++p) { a.ph_lo = p; a.ph_hi = p + 1; hipLaunchKernelGGL(fwd_kernel, dim3(grid), dim3(NWAVES * 64), LDS_BYTES, stream, a); }
#endif
}
```

```cpp
#include <hip/hip_runtime.h>
#include <cstdio>
#include <cstdint>
#include <cmath>

#define LAS __attribute__((address_space(3)))
#define GAS __attribute__((address_space(1)))
typedef unsigned short bf16_t;
typedef short bf16x8 __attribute__((ext_vector_type(8)));
typedef float f32x4 __attribute__((ext_vector_type(4)));
typedef float f32x2 __attribute__((ext_vector_type(2)));
typedef float f32x16 __attribute__((ext_vector_type(16)));
typedef unsigned u32x4 __attribute__((ext_vector_type(4)));
typedef unsigned u32x2 __attribute__((ext_vector_type(2)));
typedef GAS unsigned gu32;
#define RLX_AGENT __ATOMIC_RELAXED, __HIP_MEMORY_SCOPE_AGENT
#define DI __device__ __forceinline__

constexpr int D = 1024, NB = 16, SEQ = 2048, T = NB * SEQ, NMEM = 256;
constexpr int MH = 4, MHD = 128, MW = 512, MCH = 64;
constexpr int AH = 8, ANOPE = 64, AROPE = 32, AQK = 96, AVD = 64, AW = 512, AQR = 256, AKVR = 128;
constexpr int XH = 4, XHD = 256;
constexpr int NE = 32, TOPK = 4;
constexpr int DIN = 4008, NPROJ = 4096;
constexpr float DN_ALPHA = 1.189207115002721f;
constexpr float EPS = 1e-5f;
constexpr int NASSIGN = T * TOPK;
constexpr int NROWS = NASSIGN + NE * 256;
constexpr int NTILES_MAX = NROWS / 256;
constexpr int PC_QLAT = 0, PC_KVLAT = 256, PC_KROPE = 384, PC_IG = 416, PC_FG = 420, PC_XM = 512, PC_VM = 1024, PC_OP = 1536, PC_GM = 2048, PC_GA = 3072;

DI unsigned f2bf(float f) { unsigned u = __builtin_bit_cast(unsigned, f); return (u + 0x7fffu + ((u >> 16) & 1u)) >> 16; }
DI unsigned pk2(float lo, float hi) { return f2bf(lo) | (f2bf(hi) << 16); }
DI float bf2f(unsigned short b) { return __builtin_bit_cast(float, (unsigned)b << 16); }
DI float bflo(unsigned w) { return __builtin_bit_cast(float, w << 16); }
DI float bfhi(unsigned w) { return __builtin_bit_cast(float, w & 0xffff0000u); }
DI float wave_sum(float v) {
#pragma unroll
    for (int o = 1; o < 64; o <<= 1) v += __shfl_xor(v, o);
    return v;
}
DI float wave_max(float v) {
#pragma unroll
    for (int o = 1; o < 64; o <<= 1) v = fmaxf(v, __shfl_xor(v, o));
    return v;
}
DI float rcpf_(float x) { return __builtin_amdgcn_rcpf(x); }
DI float sigmoidf_(float x) { return __builtin_amdgcn_rcpf(1.0f + __builtin_amdgcn_exp2f(-1.4426950408889634f * x)); }
DI int crow(int r, int hi) { return (r & 3) + 8 * (r >> 2) + 4 * hi; }
#define MFMA32(a, b, c) __builtin_amdgcn_mfma_f32_32x32x16_bf16((a), (b), (c), 0, 0, 0)

namespace pg8 {
constexpr int BM = 256, BK = 64, HALF = 128, HTB = HALF * BK * 2, STAGE_BYTES = 8 * HTB;
__host__ __device__ __forceinline__ int lds_byte(int r, int c) { const int st = (r >> 4) * 2 + (c >> 5), rr = r & 15, cc = c & 31, ob = rr * 64 + cc * 2; return st * 1024 + (ob ^ (((ob >> 9) & 1) << 5)); }
__host__ __device__ __forceinline__ void stage_rc(int b, int& R, int& C) { const int st = b / 1024, sb = b % 1024, swz = sb ^ (((sb >> 9) & 1) << 5); R = (st >> 1) * 16 + swz / 64; C = (st & 1) * 32 + (swz % 64) / 2; }
__host__ __device__ __forceinline__ int perm32(int rho) { const int n = rho >> 4, i = rho & 15; return 8 * (i >> 2) + 4 * n + (i & 3); }

struct Unit { int pm, pn, aux; const char* a; const char* b; };
struct Ctx { int wr, wc, fr, fq, wid, lane; };

DI unsigned cvt_pk_bf16(float lo, float hi) { unsigned r; asm volatile("v_cvt_pk_bf16_f32 %0, %1, %2" : "=v"(r) : "v"(lo), "v"(hi)); return r; }

typedef f32x4 Acc[2][2][4][2];

DI void glds16_s(const char* gbase, unsigned voff, unsigned lds_dst) { unsigned keep;
    asm volatile("s_mov_b32 %0, m0\n\ts_mov_b32 m0, %1\n\ts_nop 0\n\tglobal_load_lds_dwordx4 %2, %3\n\ts_mov_b32 m0, %0" : "=&s"(keep) : "s"(lds_dst), "v"(voff), "s"(gbase) : "memory"); }
typedef int v8i_t __attribute__((ext_vector_type(8)));
typedef int i32x4_t __attribute__((ext_vector_type(4)));
template <class Epi, class Sched, bool FP8 = false>
DI void gemm_phase(LAS unsigned char* lds, const int K, const int lda, const int ldb, const Sched& S, const Epi& E) {
    int tid = threadIdx.x; asm volatile("" : "+v"(tid));
    const int wid = __builtin_amdgcn_readfirstlane(tid >> 6), lane = tid & 63, wr = wid >> 2, wc = wid & 3, fr = lane & 15, fq = lane >> 4;
    constexpr int ESZ = FP8 ? 1 : 2;
    const int nt = K * ESZ / (BK * 2);
    unsigned voffA[2], voffB[2];
#pragma unroll
    for (int i = 0; i < 2; ++i) { int R, C; stage_rc(tid * 16 + i * 8192, R, C); const int Rb = Epi::PERM ? ((R & ~31) + perm32(R & 31)) : R;
        voffA[i] = (unsigned)(R * lda * ESZ + C * 2); voffB[i] = (unsigned)(Rb * ldb * ESZ + C * 2); }
    const size_t kstep = (size_t)(BK * 2);
    const size_t hstepA = (size_t)HALF * lda * ESZ, hstepB = (size_t)HALF * ldb * ESZ;
    const unsigned ldsw = (unsigned)wid * 1024u;
    const int aoff = lds_byte(wr * 64 + fr, fq * 8), boff = lds_byte(wc * 32 + fr, fq * 8);
    const Ctx cx{wr, wc, fr, fq, wid, lane};
    const unsigned lds_u = (unsigned)__builtin_amdgcn_readfirstlane((int)((unsigned)(size_t)lds + ldsw));
    LAS unsigned char* ldsB = lds + 4 * HTB + boff;
#define PG8_SA(b, h) (((b) * 2 + (h)) * HTB)
#define PG8_SB(b, h) ((4 + (b) * 2 + (h)) * HTB)
#define PG8_SBL(b, h) (((b) * 2 + (h)) * HTB)
#define PG8_STAGE(bufoff, gbase, voff) do { _Pragma("unroll") for (int _i = 0; _i < 2; ++_i) \
        glds16_s((const char*)(gbase), (voff)[_i], lds_u + (unsigned)((bufoff) + _i * 8192)); } while (0)
#define PG8_RD(off) (*(const LAS i32x4_t*)(lds + (off)))
#define PG8_CAT2(x, y) __builtin_shufflevector((x), (y), 0, 1, 2, 3, 4, 5, 6, 7)
#define PG8_LDA(dst, b, h) do { if constexpr (FP8) { _Pragma("unroll") for (int m = 0; m < 4; ++m) dst##8[m] = PG8_CAT2(PG8_RD(PG8_SA(b, h) + aoff + m * 2048), PG8_RD(PG8_SA(b, h) + aoff + m * 2048 + 1024)); } \
        else { _Pragma("unroll") for (int m = 0; m < 4; ++m) _Pragma("unroll") for (int k = 0; k < 2; ++k) dst[m][k] = *(const LAS bf16x8*)(lds + PG8_SA(b, h) + aoff + m * 2048 + k * 1024); } } while (0)
#define PG8_LDB(dst, b, h) do { if constexpr (FP8) { _Pragma("unroll") for (int n = 0; n < 2; ++n) dst##8[n] = PG8_CAT2(*(const LAS i32x4_t*)(ldsB + PG8_SBL(b, h) + n * 2048), *(const LAS i32x4_t*)(ldsB + PG8_SBL(b, h) + n * 2048 + 1024)); } \
        else { _Pragma("unroll") for (int n = 0; n < 2; ++n) _Pragma("unroll") for (int k = 0; k < 2; ++k) dst[n][k] = *(const LAS bf16x8*)(ldsB + PG8_SBL(b, h) + n * 2048 + k * 1024); } } while (0)
#define PG8_MMA(ai, bj, At, Bt) do { __builtin_amdgcn_s_setprio(1); \
        if constexpr (FP8) { _Pragma("unroll") for (int m = 0; m < 4; ++m) _Pragma("unroll") for (int n = 0; n < 2; ++n) \
            acc[ai][bj][m][n] = __builtin_amdgcn_mfma_scale_f32_16x16x128_f8f6f4(Bt##8[n], At##8[m], acc[ai][bj][m][n], 0, 0, 0, 0x7f7f7f7f, 0, 0x7f7f7f7f); } \
        else { _Pragma("unroll") for (int m = 0; m < 4; ++m) _Pragma("unroll") for (int n = 0; n < 2; ++n) _Pragma("unroll") for (int k = 0; k < 2; ++k) \
            acc[ai][bj][m][n] = __builtin_amdgcn_mfma_f32_16x16x32_bf16(Bt[n][k], At[m][k], acc[ai][bj][m][n], 0, 0, 0); } \
        __builtin_amdgcn_s_setprio(0); } while (0)
#define PG8_WAIT_V(n) asm volatile("s_waitcnt vmcnt(" #n ")" ::: "memory")
#define PG8_WAIT_L(n) asm volatile("s_waitcnt lgkmcnt(" #n ")" ::: "memory")
#define PG8_BAR __builtin_amdgcn_s_barrier()
#define PG8_SCHED __builtin_amdgcn_sched_barrier(0)
    Unit cur, nxt; int ui = 0;
    if (!S.next(0, cur)) return;
    Acc acc;
#pragma unroll
    for (int a = 0; a < 2; ++a)
#pragma unroll
        for (int b = 0; b < 2; ++b)
#pragma unroll
            for (int m = 0; m < 4; ++m)
#pragma unroll
                for (int n = 0; n < 2; ++n) acc[a][b][m][n] = (f32x4){0.f, 0.f, 0.f, 0.f};
    bf16x8 At[4][2], B0[2][2], B1[2][2]; v8i_t At8[4], B08[2], B18[2];
    const char* cA = cur.a; const char* cB = cur.b;
    PG8_STAGE(PG8_SB(0, 0), cB, voffB); PG8_STAGE(PG8_SB(0, 1), cB + hstepB, voffB); PG8_STAGE(PG8_SA(0, 0), cA, voffA); PG8_STAGE(PG8_SA(0, 1), cA + hstepA, voffA);
    if (wr == 1) PG8_BAR;
    PG8_WAIT_V(2); PG8_BAR;
    PG8_STAGE(PG8_SB(1, 0), cB + kstep, voffB); PG8_STAGE(PG8_SA(1, 0), cA + kstep, voffA); PG8_STAGE(PG8_SB(1, 1), cB + hstepB + kstep, voffB);
    PG8_WAIT_V(6); PG8_BAR;
    for (;;) {
        const bool has_next = S.next(ui + 1, nxt);
        const char* nA = has_next ? nxt.a : cA; const char* nB = has_next ? nxt.b : cB;
#pragma unroll 1
        for (int t = 0; t < nt; t += 2) {
            const bool last = (t == nt - 2);
            const char* a1 = cA + (size_t)(t + 1) * kstep;
            const char* a2 = last ? nA : cA + (size_t)(t + 2) * kstep; const char* b2 = last ? nB : cB + (size_t)(t + 2) * kstep;
            const char* a3 = a2 + kstep; const char* b3 = b2 + kstep;
            PG8_LDB(B0, 0, 0); PG8_LDB(B1, 0, 1); PG8_SCHED; PG8_LDA(At, 0, 0); PG8_STAGE(PG8_SA(1, 1), a1 + hstepA, voffA);
            PG8_WAIT_V(8); PG8_WAIT_L(0); PG8_BAR; PG8_MMA(0, 0, At, B0); PG8_MMA(0, 1, At, B1); PG8_BAR; PG8_SCHED;
            PG8_LDA(At, 0, 1); PG8_STAGE(PG8_SB(0, 0), b2, voffB); PG8_STAGE(PG8_SB(0, 1), b2 + hstepB, voffB); PG8_STAGE(PG8_SA(0, 0), a2, voffA);
            PG8_WAIT_V(8); PG8_WAIT_L(0); PG8_BAR; PG8_MMA(1, 0, At, B0); PG8_MMA(1, 1, At, B1); PG8_BAR; PG8_SCHED;
            PG8_LDB(B0, 1, 0); PG8_LDB(B1, 1, 1); PG8_SCHED; PG8_LDA(At, 1, 0); PG8_STAGE(PG8_SA(0, 1), a2 + hstepA, voffA);
            PG8_WAIT_V(8); PG8_WAIT_L(0); PG8_BAR; PG8_MMA(0, 0, At, B0); PG8_MMA(0, 1, At, B1); PG8_BAR; PG8_SCHED;
            PG8_LDA(At, 1, 1); PG8_STAGE(PG8_SB(1, 0), b3, voffB); PG8_STAGE(PG8_SB(1, 1), b3 + hstepB, voffB); PG8_STAGE(PG8_SA(1, 0), a3, voffA);
            PG8_WAIT_V(8); PG8_WAIT_L(0); PG8_BAR; PG8_MMA(1, 0, At, B0); PG8_MMA(1, 1, At, B1); PG8_BAR; PG8_SCHED;
        }
        if (wr == 0) PG8_BAR;
        E(acc, cur, cx);
        if (!has_next) break;
#pragma unroll
        for (int a = 0; a < 2; ++a)
#pragma unroll
            for (int b = 0; b < 2; ++b)
#pragma unroll
                for (int m = 0; m < 4; ++m)
#pragma unroll
                    for (int n = 0; n < 2; ++n) acc[a][b][m][n] = (f32x4){0.f, 0.f, 0.f, 0.f};
        cur = nxt; cA = nA; cB = nB; ++ui;
        if (wr == 1) PG8_BAR;
    }
    PG8_WAIT_V(0);
    PG8_BAR;
#undef PG8_SA
#undef PG8_SB
#undef PG8_SBL
#undef PG8_STAGE
#undef PG8_LDA
#undef PG8_LDB
#undef PG8_MMA
#undef PG8_CAT2
#undef PG8_RD
#undef PG8_WAIT_V
#undef PG8_WAIT_L
#undef PG8_BAR
#undef PG8_SCHED
}
}
namespace pg8 {
constexpr int NXCD = 8, WGM = 8;
struct DenseOrder {
    const char* A; const char* B; int nM, nN, nwg, G, c; size_t strideA, strideB;
    DI void init(const void* A_, const void* B_, int M, int N, int lda, int ldb, int G_, int c_) { A = (const char*)A_; B = (const char*)B_; nM = M / BM; nN = N / BM; nwg = nM * nN; G = G_; c = c_;
        strideA = (size_t)BM * lda * 2; strideB = (size_t)BM * ldb * 2; }
    DI bool next(int i, Unit& u) const {
        const long L = (long)i * G + c; if (L >= nwg) return false;
        int wgid = (int)L; { const int q = nwg / NXCD, r = nwg % NXCD, xcd = wgid % NXCD, off = wgid / NXCD; wgid = (xcd < r ? xcd * (q + 1) : r * (q + 1) + (xcd - r) * q) + off; }
        const int nig = WGM * nN, gid = wgid / nig, fm = gid * WGM, gsz = (nM - fm) < WGM ? (nM - fm) : WGM;
        u.pm = fm + ((wgid % nig) % gsz); u.pn = (wgid % nig) / gsz; u.aux = 0;
        u.a = A + (size_t)u.pm * strideA; u.b = B + (size_t)u.pn * strideB; return true;
    }
};
struct CrossSOrder {
    const char* Q; const char* Kc; int G, v;
    DI bool next(int i, Unit& u) const {
        const int L = i * G + v; if (L >= (T / 256) * XH) return false;
        u.pm = L >> 2; u.pn = L & 3; u.aux = 0;
        u.a = Q + ((size_t)u.pm * 256 * D + u.pn * 256) * 2; u.b = Kc + ((size_t)(u.pm >> 3) * 256 * D + u.pn * 256) * 2; return true;
    }
};
struct CrossOOrder {
    const char* P; const char* Vt; int G, v;
    DI bool next(int i, Unit& u) const {
        const int L = i * G + v; if (L >= (T / 256) * XH) return false;
        u.pm = L >> 2; u.pn = L & 3; u.aux = 0;
        u.a = P + ((size_t)u.pm * 256 * D + u.pn * 256) * 2; u.b = Vt + ((size_t)u.pn * 256 * (NB * NMEM) + (size_t)(u.pm >> 3) * 256) * 2; return true;
    }
};
struct MoeOrder {
    const char* A; const char* W; const LAS int* tstart; const LAS int* tile_e; int npn, G, v; size_t strideA, strideW, strideN;
    DI bool next(int i, Unit& u) const {
        const int L = i * G + v; const int total = __builtin_amdgcn_readfirstlane(tstart[NE]) * npn; if (L >= total) return false;
        const int tile = L / npn; u.pm = tile; u.pn = L - tile * npn;
        const int e = __builtin_amdgcn_readfirstlane(tile_e[tile]);
        u.aux = e;
        u.a = A + (size_t)tile * strideA; u.b = W + (size_t)e * strideW + (size_t)u.pn * strideN; return true;
    }
};

DI unsigned pk4_fp8(float a, float b, float c, float d) { int w = 0; w = __builtin_amdgcn_cvt_pk_fp8_f32(a, b, w, false); w = __builtin_amdgcn_cvt_pk_fp8_f32(c, d, w, true); return (unsigned)w; }
constexpr float F8_XS = 16.0f, F8_WS = 64.0f, F8_AS = 8.0f;
struct EpiBf16 {
    static constexpr bool PERM = true;
    bf16_t* O; int ldc; int sc_from; float scale;
    DI void operator()(const Acc& acc, const Unit& u, const Ctx& c) const {
        int row0 = u.pm * BM + c.wr * 64 + c.fr, col0 = u.pn * BM + c.wc * 32 + 8 * c.fq; asm volatile("" : "+v"(row0), "+v"(col0));
        const float sc = (u.pn >= sc_from) ? scale : 1.0f;
#pragma unroll
        for (int ai = 0; ai < 2; ++ai)
#pragma unroll
            for (int m = 0; m < 4; ++m) { bf16_t* rowp = O + (size_t)(row0 + ai * HALF + m * 16) * ldc + col0;
#pragma unroll
                for (int bj = 0; bj < 2; ++bj) { const f32x4 v0 = acc[ai][bj][m][0] * sc, v1 = acc[ai][bj][m][1] * sc;
                    u32x4 w; w.x = cvt_pk_bf16(v0[0], v0[1]); w.y = cvt_pk_bf16(v0[2], v0[3]); w.z = cvt_pk_bf16(v1[0], v1[1]); w.w = cvt_pk_bf16(v1[2], v1[3]);
                    *(u32x4*)(rowp + bj * HALF) = w; } }
    }
};
struct EpiProj {
    static constexpr bool PERM = true;
    bf16_t* O; float* gates;
    DI void operator()(const Acc& acc, const Unit& u, const Ctx& c) const {
        int row0 = u.pm * BM + c.wr * 64 + c.fr, col0 = u.pn * BM + c.wc * 32 + 8 * c.fq; asm volatile("" : "+v"(row0), "+v"(col0));
#pragma unroll
        for (int ai = 0; ai < 2; ++ai)
#pragma unroll
            for (int m = 0; m < 4; ++m) { const int row = row0 + ai * HALF + m * 16; bf16_t* rowp = O + (size_t)row * NPROJ + col0;
#pragma unroll
                for (int bj = 0; bj < 2; ++bj) { const f32x4 v0 = acc[ai][bj][m][0], v1 = acc[ai][bj][m][1];
                    u32x4 w; w.x = cvt_pk_bf16(v0[0], v0[1]); w.y = cvt_pk_bf16(v0[2], v0[3]); w.z = cvt_pk_bf16(v1[0], v1[1]); w.w = cvt_pk_bf16(v1[2], v1[3]);
                    *(u32x4*)(rowp + bj * HALF) = w; }
                if (u.pn == 1 && c.wc == 1 && c.fq == 0) { *(f32x4*)(gates + (size_t)row * 8) = acc[ai][1][m][0]; *(f32x4*)(gates + (size_t)row * 8 + 4) = acc[ai][1][m][1]; } }
    }
};
struct EpiQmla {
    static constexpr bool PERM = true;
    bf16_t* O; const float* cs;
    float scale;
    DI void operator()(const Acc& acc, const Unit& u, const Ctx& c) const {
        int row0 = u.pm * BM + c.wr * 64 + c.fr, col0 = u.pn * BM + c.wc * 32 + 8 * c.fq; asm volatile("" : "+v"(row0), "+v"(col0));
#pragma unroll
        for (int ai = 0; ai < 2; ++ai)
#pragma unroll
            for (int m = 0; m < 4; ++m) { const int row = row0 + ai * HALF + m * 16; bf16_t* rowp = O + (size_t)row * (AH * AQK) + col0;
#pragma unroll
                for (int bj = 0; bj < 2; ++bj) { f32x4 v0 = acc[ai][bj][m][0] * scale, v1 = acc[ai][bj][m][1] * scale;
                    const int cc = (col0 + bj * HALF) % AQK;
                    if (cc >= ANOPE) { const int p0 = (cc - ANOPE) >> 1;
                        const f32x4 t0 = *(const f32x4*)(cs + (size_t)row * 32 + p0 * 2), t1 = *(const f32x4*)(cs + (size_t)row * 32 + p0 * 2 + 4);
                        f32x4 r0, r1;
                        r0[0] = v0[0] * t0[0] - v0[1] * t0[1]; r0[1] = v0[1] * t0[0] + v0[0] * t0[1];
                        r0[2] = v0[2] * t0[2] - v0[3] * t0[3]; r0[3] = v0[3] * t0[2] + v0[2] * t0[3];
                        r1[0] = v1[0] * t1[0] - v1[1] * t1[1]; r1[1] = v1[1] * t1[0] + v1[0] * t1[1];
                        r1[2] = v1[2] * t1[2] - v1[3] * t1[3]; r1[3] = v1[3] * t1[2] + v1[2] * t1[3];
                        v0 = r0; v1 = r1; }
                    u32x4 w; w.x = cvt_pk_bf16(v0[0], v0[1]); w.y = cvt_pk_bf16(v0[2], v0[3]); w.z = cvt_pk_bf16(v1[0], v1[1]); w.w = cvt_pk_bf16(v1[2], v1[3]);
                    *(u32x4*)(rowp + bj * HALF) = w; } }
    }
};
template <bool ADD> struct EpiGate {
    static constexpr bool PERM = true;
    bf16_t* O; const bf16_t* proj; int gcol;
    DI void operator()(const Acc& acc, const Unit& u, const Ctx& c) const {
        int row0 = u.pm * BM + c.wr * 64 + c.fr, col0 = u.pn * BM + c.wc * 32 + 8 * c.fq; asm volatile("" : "+v"(row0), "+v"(col0));
#pragma unroll
        for (int ai = 0; ai < 2; ++ai)
#pragma unroll
            for (int m = 0; m < 4; ++m) { const int row = row0 + ai * HALF + m * 16; bf16_t* rowp = O + (size_t)row * D + col0; const bf16_t* gp = proj + (size_t)row * NPROJ + gcol + col0;
#pragma unroll
                for (int bj = 0; bj < 2; ++bj) { const f32x4 v0 = acc[ai][bj][m][0], v1 = acc[ai][bj][m][1];
                    const u32x4 g = *(const u32x4*)(gp + bj * HALF);
                    float o[8];
                    o[0] = sigmoidf_(bflo(g.x)) * v0[0]; o[1] = sigmoidf_(bfhi(g.x)) * v0[1]; o[2] = sigmoidf_(bflo(g.y)) * v0[2]; o[3] = sigmoidf_(bfhi(g.y)) * v0[3];
                    o[4] = sigmoidf_(bflo(g.z)) * v1[0]; o[5] = sigmoidf_(bfhi(g.z)) * v1[1]; o[6] = sigmoidf_(bflo(g.w)) * v1[2]; o[7] = sigmoidf_(bfhi(g.w)) * v1[3];
                    if (ADD) { const u32x4 p = *(const u32x4*)(rowp + bj * HALF);
                        o[0] += bflo(p.x); o[1] += bfhi(p.x); o[2] += bflo(p.y); o[3] += bfhi(p.y); o[4] += bflo(p.z); o[5] += bfhi(p.z); o[6] += bflo(p.w); o[7] += bfhi(p.w); }
                    u32x4 w; w.x = cvt_pk_bf16(o[0], o[1]); w.y = cvt_pk_bf16(o[2], o[3]); w.z = cvt_pk_bf16(o[4], o[5]); w.w = cvt_pk_bf16(o[6], o[7]);
                    *(u32x4*)(rowp + bj * HALF) = w; } }
    }
};
struct EpiF32 {
    static constexpr bool PERM = false;
    float* C; int ldc; int ncols_valid;
    DI void operator()(const Acc& acc, const Unit& u, const Ctx& c) const {
        int row0 = u.pm * BM + c.wr * 64 + c.fr, col0 = u.pn * BM + c.wc * 32 + 4 * c.fq; asm volatile("" : "+v"(row0), "+v"(col0));
#pragma unroll
        for (int ai = 0; ai < 2; ++ai)
#pragma unroll
            for (int m = 0; m < 4; ++m) { float* rowp = C + (size_t)(row0 + ai * HALF + m * 16) * ldc + col0;
#pragma unroll
                for (int bj = 0; bj < 2; ++bj)
#pragma unroll
                    for (int n = 0; n < 2; ++n) if (col0 + bj * HALF + n * 16 < ncols_valid) *(f32x4*)(rowp + bj * HALF + n * 16) = acc[ai][bj][m][n]; }
    }
};
struct EpiSoftmax {
    static constexpr bool PERM = true;
    bf16_t* O; LAS float* red;
    DI void operator()(Acc& acc, const Unit& u, const Ctx& c) const {
        int row0 = u.pm * BM + c.wr * 64 + c.fr, col0 = u.pn * BM + c.wc * 32 + 8 * c.fq; asm volatile("" : "+v"(row0), "+v"(col0));
        int rbase = (c.wr * 64 + c.fr) * 4; asm volatile("" : "+v"(rbase));
        LAS float* r1 = red + rbase; LAS float* r2 = red + 1024 + rbase;
#pragma unroll
        for (int ai = 0; ai < 2; ++ai)
#pragma unroll
            for (int m = 0; m < 4; ++m) { float v = -INFINITY;
#pragma unroll
                for (int bj = 0; bj < 2; ++bj)
#pragma unroll
                    for (int n = 0; n < 2; ++n) { const f32x4 x = acc[ai][bj][m][n]; v = fmaxf(v, fmaxf(fmaxf(x[0], x[1]), fmaxf(x[2], x[3]))); }
                v = fmaxf(v, __shfl_xor(v, 16)); v = fmaxf(v, __shfl_xor(v, 32));
                if (c.fq == 0) r1[(ai * HALF + m * 16) * 4 + c.wc] = v;
                __builtin_amdgcn_sched_barrier(0); }
        asm volatile("s_waitcnt lgkmcnt(0)" ::: "memory"); __builtin_amdgcn_s_barrier(); asm volatile("" ::: "memory");
#pragma unroll
        for (int ai = 0; ai < 2; ++ai)
#pragma unroll
            for (int m = 0; m < 4; ++m) { const f32x4 q = *(const LAS f32x4*)(r1 + (ai * HALF + m * 16) * 4);
                const float mm = fmaxf(fmaxf(q[0], q[1]), fmaxf(q[2], q[3])); float s = 0.f;
#pragma unroll
                for (int bj = 0; bj < 2; ++bj)
#pragma unroll
                    for (int n = 0; n < 2; ++n) { f32x4 x = acc[ai][bj][m][n];
                        x[0] = __builtin_amdgcn_exp2f(x[0] - mm); x[1] = __builtin_amdgcn_exp2f(x[1] - mm); x[2] = __builtin_amdgcn_exp2f(x[2] - mm); x[3] = __builtin_amdgcn_exp2f(x[3] - mm);
                        acc[ai][bj][m][n] = x; s += (x[0] + x[1]) + (x[2] + x[3]); }
                s += __shfl_xor(s, 16); s += __shfl_xor(s, 32);
                if (c.fq == 0) r2[(ai * HALF + m * 16) * 4 + c.wc] = s;
                __builtin_amdgcn_sched_barrier(0); }
        asm volatile("s_waitcnt lgkmcnt(0)" ::: "memory"); __builtin_amdgcn_s_barrier(); asm volatile("" ::: "memory");
#pragma unroll
        for (int ai = 0; ai < 2; ++ai)
#pragma unroll
            for (int m = 0; m < 4; ++m) { const f32x4 q = *(const LAS f32x4*)(r2 + (ai * HALF + m * 16) * 4);
                const float inv = rcpf_((q[0] + q[1]) + (q[2] + q[3]));
                bf16_t* rowp = O + (size_t)(row0 + ai * HALF + m * 16) * D + col0;
#pragma unroll
                for (int bj = 0; bj < 2; ++bj) { const f32x4 v0 = acc[ai][bj][m][0] * inv, v1 = acc[ai][bj][m][1] * inv;
                    u32x4 w; w.x = cvt_pk_bf16(v0[0], v0[1]); w.y = cvt_pk_bf16(v0[2], v0[3]); w.z = cvt_pk_bf16(v1[0], v1[1]); w.w = cvt_pk_bf16(v1[2], v1[3]);
                    *(u32x4*)(rowp + bj * HALF) = w; }
                __builtin_amdgcn_sched_barrier(0); }
    }
};
struct EpiSwiglu {
    static constexpr bool PERM = true;
    unsigned char* O; const float* bias;
    DI void operator()(const Acc& acc, const Unit& u, const Ctx& c) const {
        int row0 = u.pm * BM + c.wr * 64 + c.fr, col0 = u.pn * BM + c.wc * 32 + 8 * c.fq; asm volatile("" : "+v"(row0), "+v"(col0));
        constexpr float us = 1.0f / (F8_XS * F8_WS);
        f32x4 bv[2][2];
#pragma unroll
        for (int bj = 0; bj < 2; ++bj)
#pragma unroll
            for (int n = 0; n < 2; ++n) bv[bj][n] = *(const f32x4*)(bias + (size_t)u.aux * 2048 + col0 + bj * HALF + 4 * n);
#pragma unroll
        for (int ai = 0; ai < 2; ++ai)
#pragma unroll
            for (int m = 0; m < 4; ++m) { unsigned char* rowp = O + (size_t)(row0 + ai * HALF + m * 16) * 1024 + (col0 >> 1);
#pragma unroll
                for (int bj = 0; bj < 2; ++bj) { const f32x4 v0 = acc[ai][bj][m][0] * us + bv[bj][0], v1 = acc[ai][bj][m][1] * us + bv[bj][1];
                    float o[4];
#define SWG(g, l) ({ const float g_ = fminf((g), 7.0f), l_ = fminf(fmaxf((l), -7.0f), 7.0f); fminf(fmaxf(g_ * sigmoidf_(1.702f * g_) * (l_ + 1.0f) * F8_AS, -448.0f), 448.0f); })
                    o[0] = SWG(v0[0], v0[1]); o[1] = SWG(v0[2], v0[3]); o[2] = SWG(v1[0], v1[1]); o[3] = SWG(v1[2], v1[3]);
#undef SWG
                    *(unsigned*)(rowp + bj * (HALF / 2)) = pk4_fp8(o[0], o[1], o[2], o[3]); } }
    }
};
struct EpiDown {
    static constexpr bool PERM = true;
    bf16_t* O; const float* bias; const float* rowgate;
    DI void operator()(const Acc& acc, const Unit& u, const Ctx& c) const {
        int row0 = u.pm * BM + c.wr * 64 + c.fr, col0 = u.pn * BM + c.wc * 32 + 8 * c.fq; asm volatile("" : "+v"(row0), "+v"(col0));
        f32x4 bv[2][2];
#pragma unroll
        for (int bj = 0; bj < 2; ++bj)
#pragma unroll
            for (int n = 0; n < 2; ++n) bv[bj][n] = *(const f32x4*)(bias + (size_t)u.aux * 1024 + col0 + bj * HALF + 4 * n);
#pragma unroll
        for (int ai = 0; ai < 2; ++ai)
#pragma unroll
            for (int m = 0; m < 4; ++m) { const int row = row0 + ai * HALF + m * 16; const float gt = rowgate[row]; bf16_t* rowp = O + (size_t)row * 1024 + col0;
#pragma unroll
                for (int bj = 0; bj < 2; ++bj) { const f32x4 v0 = (acc[ai][bj][m][0] * (1.0f / (F8_AS * F8_WS)) + bv[bj][0]) * gt, v1 = (acc[ai][bj][m][1] * (1.0f / (F8_AS * F8_WS)) + bv[bj][1]) * gt;
                    u32x4 w; w.x = cvt_pk_bf16(v0[0], v0[1]); w.y = cvt_pk_bf16(v0[2], v0[3]); w.z = cvt_pk_bf16(v1[0], v1[1]); w.w = cvt_pk_bf16(v1[2], v1[3]);
                    *(u32x4*)(rowp + bj * HALF) = w; } }
    }
};
}
constexpr size_t MiB = 1u << 20;
constexpr size_t WS_CTL = 0, CTL_ZERO_BYTES = 1 * MiB;
constexpr size_t WS_W_IN = 2 * MiB, WS_W_UQ = 10 * MiB, WS_W_UK = WS_W_UQ + 512 * 1024, WS_W_UV = WS_W_UK + 256 * 1024, WS_W_MQK = 11 * MiB, WS_W_BRM = 12 * MiB, WS_W_BRA = 13 * MiB,
                 WS_W_MIX = 14 * MiB, WS_W_CQ = 16 * MiB, WS_W_CK = 18 * MiB, WS_W_CV = 20 * MiB, WS_W_CO = 22 * MiB, WS_W_R = 24 * MiB, WS_W_GU = 26 * MiB, WS_W_DN = 90 * MiB;
constexpr size_t WS_GATES = 218 * MiB, WS_CS = 219 * MiB, WS_KPE = 223 * MiB, WS_MEMB = 225 * MiB, WS_KC = 233 * MiB, WS_VCT = 241 * MiB, WS_LOGITS = 249 * MiB,
                 WS_ASSIGN = 253 * MiB, WS_GATEW = WS_ASSIGN + 512 * 1024, WS_TOKPOS = 254 * MiB, WS_ROWGATE = WS_TOKPOS + 512 * 1024;
constexpr size_t WS_XB = 256 * MiB, WS_PROJ = 320 * MiB, WS_QN = 576 * MiB, WS_KVN = 592 * MiB, WS_XC = 608 * MiB, WS_QMLA = 640 * MiB, WS_KN = 688 * MiB, WS_VT = 720 * MiB,
                 WS_QKM = 752 * MiB, WS_KTM = 816 * MiB, WS_AO = 848 * MiB, WS_HRAW = 880 * MiB, WS_HM = 944 * MiB;
constexpr size_t WS_GATED = 256 * MiB, WS_MIXO = 576 * MiB, WS_H1B = 704 * MiB, WS_QC = 768 * MiB, WS_PC = 832 * MiB, WS_OC = 896 * MiB, WS_COO = 320 * MiB, WS_H2B = 256 * MiB;
constexpr size_t WS_XG = 320 * MiB, WS_ACT = 456 * MiB, WS_YB = 592 * MiB, WS_END = 976 * MiB;
static_assert((size_t)NROWS * 1024 * 2 <= 272 * MiB, "routed buffers");
static_assert(WS_ROWGATE + (size_t)NROWS * 4 <= 256 * MiB, "small buffers");
constexpr int CW_TMO = 0, CW_CNT = 64  , CW_BAR = 4096;

constexpr int RING_OFF = 0, RING_BYTES = 131072;
constexpr int RED_OFF = RING_BYTES;
constexpr int TST_OFF = RED_OFF + 8192;
constexpr int HIST_OFF = TST_OFF + 256, HBASE_OFF = HIST_OFF + 128;
constexpr int MISC_OFF = HBASE_OFF + 128;
constexpr int TILE_E_OFF = MISC_OFF + 128;
constexpr int LDSCTL_OFF = TST_OFF;
constexpr int LDS_BYTES = 147456;
static_assert(TILE_E_OFF + NTILES_MAX * 4 <= LDS_BYTES, "LDS map");
constexpr int NWAVES = 8;

#define LDS_WAIT() asm volatile("s_waitcnt lgkmcnt(0)" ::: "memory")
#define VM_WAIT() asm volatile("s_waitcnt vmcnt(0)" ::: "memory")

#define XB_TMO      128
#define XB_XCNT(j)  (256  + 64 * (j))
#define XB_XSUB(j)  (1280 + 64 * (j))
#define XB_XGEN(j)  (2304 + 64 * (j))
#define XB_TOP      3328
#define XB_TOPGEN   3392
#define XCD_BAR_WORDS 3456
#define XB_SPIN_CAP (1u << 18)
__device__ __forceinline__ unsigned xb_ld(unsigned* p)              { return __hip_atomic_load(p, __ATOMIC_RELAXED, __HIP_MEMORY_SCOPE_AGENT); }
__device__ __forceinline__ unsigned xb_add(unsigned* p, unsigned v) { return __hip_atomic_fetch_add(p, v, __ATOMIC_RELAXED, __HIP_MEMORY_SCOPE_AGENT); }
__device__ __forceinline__ unsigned xb_xcc_id() { return (unsigned)__builtin_amdgcn_s_getreg((3 << 11) | 20) & 0xFu; }
#define XB_SPIN(cond, bar) do { unsigned _sp = 0; while (cond) { __builtin_amdgcn_s_sleep(1); \
    if ((++_sp & 255u) == 0u) { if (xb_ld(&(bar)[XB_TMO])) break; if (_sp > XB_SPIN_CAP) { atomicAdd(&(bar)[XB_TMO], 1u); break; } } } } while (0)
struct XcdBarrier { unsigned* bar; unsigned x; volatile LAS unsigned* st; };
__device__ __forceinline__ XcdBarrier xcd_barrier_post(unsigned* bar, volatile LAS unsigned* st) {
    XcdBarrier b; b.bar = bar; b.x = xb_xcc_id(); b.st = st;
    if (threadIdx.x == 0) (void)xb_add(&bar[XB_XCNT(b.x)], 1u);
    return b;
}
__device__ __forceinline__ void xcd_barrier_complete(unsigned* bar, unsigned x, unsigned& nloc, unsigned& nx) {
    const unsigned G = gridDim.x * gridDim.y * gridDim.z;
    unsigned sum, cnt, mine, sp = 0u;
    for (;;) {
        sum = 0u; cnt = 0u; mine = 0u;
#pragma unroll
        for (unsigned j = 0; j < 16; ++j) { const unsigned c = xb_ld(&bar[XB_XCNT(j)]); sum += c; cnt += (c > 0u) ? 1u : 0u; mine = (j == x) ? c : mine; }
        if (sum == G) break;
        __builtin_amdgcn_s_sleep(1);
        if ((++sp & 255u) == 0u) { if (xb_ld(&bar[XB_TMO])) break; if (sp > XB_SPIN_CAP) { atomicAdd(&bar[XB_TMO], 1u); break; } }
    }
    nloc = mine > 0u ? mine : 1u; nx = cnt > 0u ? cnt : 1u;
}
__device__ __forceinline__ void xcd_barrier(const XcdBarrier& b) {
    asm volatile("s_waitcnt vmcnt(0)" ::: "memory");
    __syncthreads();
    if (threadIdx.x == 0) {
        unsigned* bar = b.bar;
        __builtin_amdgcn_s_waitcnt(0);
        unsigned nloc = b.st[0], nx = b.st[1];
        if (nloc == 0u) { xcd_barrier_complete(bar, b.x, nloc, nx); b.st[0] = nloc; b.st[1] = nx; }
        const unsigned old = xb_add(&bar[XB_XSUB(b.x)], 1u);
        const unsigned gen = old / nloc;
        if (old + 1u == (gen + 1u) * nloc) {
            __builtin_amdgcn_fence(__ATOMIC_RELEASE, "agent");
            asm volatile("s_waitcnt vmcnt(0)" ::: "memory");
            const unsigned og = xb_add(&bar[XB_TOP], 1u);
            const unsigned tg = og / nx;
            if (og + 1u == (tg + 1u) * nx) xb_add(&bar[XB_TOPGEN], 1u);
            else XB_SPIN(xb_ld(&bar[XB_TOPGEN]) == tg, bar);
            __builtin_amdgcn_fence(__ATOMIC_ACQUIRE, "agent");
            xb_add(&bar[XB_XGEN(b.x)], 1u);
            asm volatile("s_waitcnt vmcnt(0)" ::: "memory");
        } else {
            XB_SPIN(xb_ld(&bar[XB_XGEN(b.x)]) == gen, bar);
            __builtin_amdgcn_fence(__ATOMIC_ACQUIRE, "agent");
            asm volatile("s_waitcnt vmcnt(0)" ::: "memory");
        }
    }
    __syncthreads();
}

struct Args { const void* in[34]; float* out; unsigned char* ws; int ph_lo, ph_hi; };

DI void tr_item(const float* W, int ldw, int kvalid, bf16_t* WT, int ldk, int n0, int k0, int sc, LAS float* scr, int lane) {
#pragma unroll 8
    for (int i = 0; i < 32; ++i) { const int kk = 2 * i + (lane >> 5); const int k = k0 + kk;
        float v = 0.f; if (sc >= 0 && k < kvalid) v = W[(size_t)k * ldw + sc];
        scr[kk * 33 + (lane & 31)] = v; }
    LDS_WAIT(); asm volatile("" ::: "memory");
    const int c = lane & 7;
#pragma unroll
    for (int j = 0; j < 4; ++j) { const int n = (lane >> 3) + 8 * j; const LAS float* s = scr + (8 * c) * 33 + n;
        u32x4 o; o.x = pk2(s[0 * 33], s[1 * 33]); o.y = pk2(s[2 * 33], s[3 * 33]); o.z = pk2(s[4 * 33], s[5 * 33]); o.w = pk2(s[6 * 33], s[7 * 33]);
        *(GAS u32x4*)(WT + (size_t)(n0 + n) * ldk + k0 + 8 * c) = o; }
    LDS_WAIT(); asm volatile("" ::: "memory");
}

DI void tr_item_v4(const float* W, int ldw, bf16_t* WT, int ldk, int n0, int k0, int c0, LAS float* scr, int lane) {
    const int kr = lane >> 3, n4 = lane & 7;
    f32x4 v[8];
#pragma unroll
    for (int i = 0; i < 8; ++i) v[i] = *(const f32x4*)(W + (size_t)(k0 + i * 8 + kr) * ldw + c0 + 4 * n4);
#pragma unroll
    for (int i = 0; i < 8; ++i) { LAS float* p = scr + (i * 8 + kr) * 33 + 4 * n4; p[0] = v[i][0]; p[1] = v[i][1]; p[2] = v[i][2]; p[3] = v[i][3]; }
    LDS_WAIT(); asm volatile("" ::: "memory");
    const int c = lane & 7;
#pragma unroll
    for (int j = 0; j < 4; ++j) { const int n = (lane >> 3) + 8 * j; const LAS float* s = scr + (8 * c) * 33 + n;
        u32x4 o; o.x = pk2(s[0 * 33], s[1 * 33]); o.y = pk2(s[2 * 33], s[3 * 33]); o.z = pk2(s[4 * 33], s[5 * 33]); o.w = pk2(s[6 * 33], s[7 * 33]);
        *(GAS u32x4*)(WT + (size_t)(n0 + n) * ldk + k0 + 8 * c) = o; }
    LDS_WAIT(); asm volatile("" ::: "memory");
}

DI void tr_item_v4_fp8(const float* W, int ldw, unsigned char* WT, int ldk, int n0, int k0, int c0, float sc, LAS float* scr, int lane) {
    const int kr = lane >> 3, n4 = lane & 7;
    f32x4 v[8];
#pragma unroll
    for (int i = 0; i < 8; ++i) v[i] = *(const f32x4*)(W + (size_t)(k0 + i * 8 + kr) * ldw + c0 + 4 * n4);
#pragma unroll
    for (int i = 0; i < 8; ++i) { LAS float* p = scr + (i * 8 + kr) * 33 + 4 * n4; p[0] = v[i][0] * sc; p[1] = v[i][1] * sc; p[2] = v[i][2] * sc; p[3] = v[i][3] * sc; }
    LDS_WAIT(); asm volatile("" ::: "memory");
    const int c = lane & 7;
#pragma unroll
    for (int j = 0; j < 4; ++j) { const int n = (lane >> 3) + 8 * j; const LAS float* s = scr + (8 * c) * 33 + n;
        u32x2 o; o.x = pg8::pk4_fp8(s[0 * 33], s[1 * 33], s[2 * 33], s[3 * 33]); o.y = pg8::pk4_fp8(s[4 * 33], s[5 * 33], s[6 * 33], s[7 * 33]);
        *(GAS u32x2*)(WT + (size_t)(n0 + n) * ldk + k0 + 8 * c) = o; }
    LDS_WAIT(); asm volatile("" ::: "memory");
}
DI int win_src(int n) {
    if (n < 384) return n;
    if (n < 416) { const int i = (n - 384) >> 1; return 384 + i + 16 * ((n - 384) & 1); }
    if (n < 424) return 1952 + (n - 416);
    if (n < 512) return -1;
    if (n < 2048) return 416 + (n - 512);
    return 1960 + (n - 2048);
}
DI void p0_prologue(const Args& args, LAS unsigned char* lds, int vcu, int G) {
    int tid_ = threadIdx.x; asm volatile("" : "+v"(tid_)); const int lane = tid_ & 63; const int wave = __builtin_amdgcn_readfirstlane(tid_ >> 6);
    LAS float* scr = (LAS float*)(lds + RING_OFF + wave * 16384);
    const int gw = vcu * NWAVES + wave, NGW = G * NWAVES;
    unsigned char* ws = args.ws;
    const int j = lane & 31;
    constexpr int I_IN = 16 * 128, I_UQ = 4 * 24, I_UK = 4 * 16, I_UV = 4 * 16, I_MQK = 8 * 32, I_BRM = 8 * 32, I_BRA = 8 * 32, I_SQ = 16 * 32, I_R = 16 * 8,
                  I_GU = NE * 16 * 64, I_DN = NE * 16 * 32;
    constexpr int NITEMS = I_IN + I_UQ + I_UK + I_UV + I_MQK + I_BRM + I_BRA + 5 * I_SQ + I_R + I_GU + I_DN;
    for (int it = gw; it < NITEMS; it += NGW) {
        int r = it;
        if (r < I_GU) { const int e = r / (16 * 64), q = r % (16 * 64), kb = q / 64, nb = q % 64;
            tr_item_v4_fp8((const float*)args.in[28] + (size_t)e * 1024 * 2048, 2048, ws + WS_W_GU + (size_t)e * 2048 * 1024, 1024, nb * 32, kb * 64, nb * 32, pg8::F8_WS, scr, lane); continue; } r -= I_GU;
        if (r < I_DN) { const int e = r / (16 * 32), q = r % (16 * 32), kb = q / 32, nb = q % 32;
            tr_item_v4_fp8((const float*)args.in[30] + (size_t)e * 1024 * 1024, 1024, ws + WS_W_DN + (size_t)e * 1024 * 1024, 1024, nb * 32, kb * 64, nb * 32, pg8::F8_WS, scr, lane); continue; } r -= I_DN;
        if (r < I_IN) { const int kb = r / 128, nb = r % 128;
            tr_item((const float*)args.in[3], DIN, 1024, (bf16_t*)(ws + WS_W_IN), 1024, nb * 32, kb * 64, win_src(nb * 32 + j), scr, lane); continue; } r -= I_IN;
        if (r < I_UQ) { const int kb = r / 24, nb = r % 24; const int n = nb * 32 + j, hh = n / AQK, cc = n % AQK;
            const int sc = (cc < ANOPE) ? n : hh * AQK + ANOPE + ((cc - ANOPE) >> 1) + 16 * ((cc - ANOPE) & 1);
            tr_item((const float*)args.in[14], AH * AQK, 256, (bf16_t*)(ws + WS_W_UQ), 256, nb * 32, kb * 64, sc, scr, lane); continue; } r -= I_UQ;
        if (r < I_UK) { const int kb = r / 16, nb = r % 16; const int n = nb * 32 + j;
            tr_item((const float*)args.in[15], 1024, 128, (bf16_t*)(ws + WS_W_UK), 256, nb * 32, kb * 64, (n >> 6) * 128 + (n & 63), scr, lane); continue; } r -= I_UK;
        if (r < I_UV) { const int kb = r / 16, nb = r % 16; const int n = nb * 32 + j;
            tr_item((const float*)args.in[15], 1024, 128, (bf16_t*)(ws + WS_W_UV), 256, nb * 32, kb * 64, (n >> 6) * 128 + 64 + (n & 63), scr, lane); continue; } r -= I_UV;
        if (r < I_MQK) { const int kb = r / 32, nb = r % 32; const int n = nb * 32 + j, part = n >> 9, hh = (n >> 7) & 3, e = n & 127;
            const float* src = (const float*)args.in[part ? 9 : 8];
            tr_item(src, 128, 512, (bf16_t*)(ws + WS_W_MQK), 512, nb * 32, kb * 64, ((kb >> 1) == hh) ? e : -1, scr, lane); continue; } r -= I_MQK;
        if (r < I_BRM) { const int kb = r / 32, nb = r % 32;
            tr_item_v4((const float*)args.in[16], 1024, (bf16_t*)(ws + WS_W_BRM), 512, nb * 32, kb * 64, nb * 32, scr, lane); continue; } r -= I_BRM;
        if (r < I_BRA) { const int kb = r / 32, nb = r % 32;
            tr_item_v4((const float*)args.in[17], 1024, (bf16_t*)(ws + WS_W_BRA), 512, nb * 32, kb * 64, nb * 32, scr, lane); continue; } r -= I_BRA;
        if (r < 5 * I_SQ) { const int w = r / I_SQ, q = r % I_SQ, kb = q / 32, nb = q % 32;
            const float* src; int ldw, coff; bf16_t* dst;
            if (w == 0) { src = (const float*)args.in[18]; ldw = 1024; coff = 0; dst = (bf16_t*)(ws + WS_W_MIX); }
            else if (w == 1) { src = (const float*)args.in[21]; ldw = 1024; coff = 0; dst = (bf16_t*)(ws + WS_W_CQ); }
            else if (w == 2) { src = (const float*)args.in[22]; ldw = 2048; coff = 0; dst = (bf16_t*)(ws + WS_W_CK); }
            else if (w == 3) { src = (const float*)args.in[22]; ldw = 2048; coff = 1024; dst = (bf16_t*)(ws + WS_W_CV); }
            else { src = (const float*)args.in[23]; ldw = 1024; coff = 0; dst = (bf16_t*)(ws + WS_W_CO); }
            tr_item_v4(src, ldw, dst, 1024, nb * 32, kb * 64, coff + nb * 32, scr, lane); continue; } r -= 5 * I_SQ;
        { const int kb = r / 8, nb = r % 8; const int n = nb * 32 + j;
            tr_item((const float*)args.in[26], NE, 1024, (bf16_t*)(ws + WS_W_R), 1024, nb * 32, kb * 64, (n < NE) ? n : -1, scr, lane); }
    }
    const size_t gt = (size_t)gw * 64 + lane, NT_ = (size_t)NGW * 64;
    { const float* x = (const float*)args.in[0]; bf16_t* xb = (bf16_t*)(ws + WS_XB);
      for (size_t i = gt; i < (size_t)T * D / 8; i += NT_) { const f32x4 a = *(const f32x4*)(x + i * 8), b = *(const f32x4*)(x + i * 8 + 4);
          u32x4 o; o.x = pk2(a[0], a[1]); o.y = pk2(a[2], a[3]); o.z = pk2(b[0], b[1]); o.w = pk2(b[2], b[3]); *(u32x4*)(xb + i * 8) = o; } }
    { const float* x = (const float*)args.in[1]; bf16_t* xb = (bf16_t*)(ws + WS_MEMB);
      for (size_t i = gt; i < (size_t)NB * NMEM * D / 8; i += NT_) { const f32x4 a = *(const f32x4*)(x + i * 8), b = *(const f32x4*)(x + i * 8 + 4);
          u32x4 o; o.x = pk2(a[0], a[1]); o.y = pk2(a[2], a[3]); o.z = pk2(b[0], b[1]); o.w = pk2(b[2], b[3]); *(u32x4*)(xb + i * 8) = o; } }
}

DI void p2_tokens(const Args& args, int vcu, int G) {
    int tid_ = threadIdx.x; asm volatile("" : "+v"(tid_)); const int lane = tid_ & 63; const int wave = __builtin_amdgcn_readfirstlane(tid_ >> 6);
    unsigned char* ws = args.ws;
    const bf16_t* proj = (const bf16_t*)(ws + WS_PROJ);
    bf16_t* qn = (bf16_t*)(ws + WS_QN); bf16_t* kvn = (bf16_t*)(ws + WS_KVN); bf16_t* kpe = (bf16_t*)(ws + WS_KPE); bf16_t* xc = (bf16_t*)(ws + WS_XC); float* cs = (float*)(ws + WS_CS);
    const int* positions = (const int*)args.in[2];
    const float* conv_w = (const float*)args.in[6]; const float* conv_b = (const float*)args.in[7];
    const float* g_qlat = (const float*)args.in[12]; const float* g_kvlat = (const float*)args.in[13];
    const int gw = vcu * NWAVES + wave, NGW = G * NWAVES;
    float cw[4][8], cb[8];
#pragma unroll
    for (int jj = 0; jj < 4; ++jj)
#pragma unroll
        for (int c = 0; c < 8; ++c) cw[jj][c] = conv_w[jj * MW + 8 * lane + c];
#pragma unroll
    for (int c = 0; c < 8; ++c) cb[c] = conv_b[8 * lane + c];
    const f32x4 gq = *(const f32x4*)(g_qlat + 4 * lane);
    const f32x2 gk = *(const f32x2*)(g_kvlat + 2 * lane);
    const float inv_freq = exp2f(-(float)(lane & 15) * (13.287712379549449f / 16.0f));
    for (int t = gw; t < T; t += NGW) {
        const bf16_t* pr = proj + (size_t)t * NPROJ;
        { const u32x2 w = *(const u32x2*)(pr + PC_QLAT + 4 * lane); const float a0 = bflo(w.x), a1 = bfhi(w.x), a2 = bflo(w.y), a3 = bfhi(w.y);
          const float ss = wave_sum(a0 * a0 + a1 * a1 + a2 * a2 + a3 * a3); const float r = 1.0f / sqrtf(ss * (1.0f / AQR) + EPS);
          u32x2 o; o.x = pk2(a0 * r * gq[0], a1 * r * gq[1]); o.y = pk2(a2 * r * gq[2], a3 * r * gq[3]); *(u32x2*)(qn + (size_t)t * 256 + 4 * lane) = o; }
        { const unsigned w = *(const unsigned*)(pr + PC_KVLAT + 2 * lane); const float a0 = bflo(w), a1 = bfhi(w);
          const float ss = wave_sum(a0 * a0 + a1 * a1); const float r = 1.0f / sqrtf(ss * (1.0f / AKVR) + EPS);
          *(unsigned*)(kvn + (size_t)t * 256 + 2 * lane) = pk2(a0 * r * gk[0], a1 * r * gk[1]); *(unsigned*)(kvn + (size_t)t * 256 + 128 + 2 * lane) = 0u; }
        if (lane < 16) { const unsigned w = *(const unsigned*)(pr + PC_KROPE + 2 * lane); const float x1 = bflo(w), x2 = bfhi(w);
          const float ang = (float)positions[t] * inv_freq;
          const double rev = (double)ang * 0.15915494309189535; const float fr = (float)(rev - __builtin_rint(rev));
          const float cc = __builtin_amdgcn_cosf(fr), sn = __builtin_amdgcn_sinf(fr);
          *(unsigned*)(kpe + (size_t)t * 32 + 2 * lane) = pk2(x1 * cc - x2 * sn, x2 * cc + x1 * sn);
          *(f32x2*)(cs + (size_t)t * 32 + 2 * lane) = (f32x2){cc, sn}; }
        { const int s = t & (SEQ - 1); float a[8];
#pragma unroll
          for (int c = 0; c < 8; ++c) a[c] = cb[c];
#pragma unroll
          for (int jj = 0; jj < 4; ++jj) { const int back = 3 - jj; if (s - back >= 0) { const u32x4 w = *(const u32x4*)(pr - (size_t)back * NPROJ + PC_XM + 8 * lane);
              a[0] += cw[jj][0] * bflo(w.x); a[1] += cw[jj][1] * bfhi(w.x); a[2] += cw[jj][2] * bflo(w.y); a[3] += cw[jj][3] * bfhi(w.y);
              a[4] += cw[jj][4] * bflo(w.z); a[5] += cw[jj][5] * bfhi(w.z); a[6] += cw[jj][6] * bflo(w.w); a[7] += cw[jj][7] * bfhi(w.w); } }
#pragma unroll
          for (int c = 0; c < 8; ++c) a[c] = a[c] * sigmoidf_(a[c]);
          u32x4 o; o.x = pk2(a[0], a[1]); o.y = pk2(a[2], a[3]); o.z = pk2(a[4], a[5]); o.w = pk2(a[6], a[7]); *(u32x4*)(xc + (size_t)t * MW + 8 * lane) = o; }
    }
}

DI void p6_mpost(const Args& args, int vcu, int G) {
    int tid_ = threadIdx.x; asm volatile("" : "+v"(tid_)); const int lane = tid_ & 63; const int wave = __builtin_amdgcn_readfirstlane(tid_ >> 6);
    unsigned char* ws = args.ws;
    const float* hraw = (const float*)(ws + WS_HRAW); const bf16_t* xc = (const bf16_t*)(ws + WS_XC); const bf16_t* proj = (const bf16_t*)(ws + WS_PROJ); bf16_t* hm = (bf16_t*)(ws + WS_HM);
    const float* g_mhead = (const float*)args.in[10]; const float* w_mskip = (const float*)args.in[11];
    const int gw = vcu * NWAVES + wave, NGW = G * NWAVES;
    float gm[8], wsk[8];
#pragma unroll
    for (int c = 0; c < 8; ++c) { gm[c] = g_mhead[8 * lane + c]; wsk[c] = w_mskip[8 * lane + c]; }
    for (int t = gw; t < T; t += NGW) {
        const f32x4 h0 = *(const f32x4*)(hraw + (size_t)t * MW + 8 * lane), h1 = *(const f32x4*)(hraw + (size_t)t * MW + 8 * lane + 4);
        float h[8] = {h0[0], h0[1], h0[2], h0[3], h1[0], h1[1], h1[2], h1[3]};
        float s = 0.f;
#pragma unroll
        for (int c = 0; c < 8; ++c) s += h[c];
        s += __shfl_xor(s, 1); s += __shfl_xor(s, 2); s += __shfl_xor(s, 4); s += __shfl_xor(s, 8);
        const float mu = s * (1.0f / MHD); float q = 0.f;
#pragma unroll
        for (int c = 0; c < 8; ++c) { h[c] -= mu; q += h[c] * h[c]; }
        q += __shfl_xor(q, 1); q += __shfl_xor(q, 2); q += __shfl_xor(q, 4); q += __shfl_xor(q, 8);
        const float rstd = 1.0f / sqrtf(q * (1.0f / MHD) + EPS);
        const u32x4 xw = *(const u32x4*)(xc + (size_t)t * MW + 8 * lane); const u32x4 ow = *(const u32x4*)(proj + (size_t)t * NPROJ + PC_OP + 8 * lane);
        const float xv[8] = {bflo(xw.x), bfhi(xw.x), bflo(xw.y), bfhi(xw.y), bflo(xw.z), bfhi(xw.z), bflo(xw.w), bfhi(xw.w)};
        const float ov[8] = {bflo(ow.x), bfhi(ow.x), bflo(ow.y), bfhi(ow.y), bflo(ow.z), bfhi(ow.z), bflo(ow.w), bfhi(ow.w)};
        float o[8];
#pragma unroll
        for (int c = 0; c < 8; ++c) o[c] = sigmoidf_(ov[c]) * (h[c] * rstd * gm[c] + wsk[c] * xv[c]);
        u32x4 w; w.x = pk2(o[0], o[1]); w.y = pk2(o[2], o[3]); w.z = pk2(o[4], o[5]); w.w = pk2(o[6], o[7]); *(u32x4*)(hm + (size_t)t * MW + 8 * lane) = w;
    }
}

DI void ln_pass(const float* res, const float* add, const float* g, const float* b, float* out, bf16_t* outb, int vcu, int G) {
    int tid_ = threadIdx.x; asm volatile("" : "+v"(tid_)); const int lane = tid_ & 63; const int wave = __builtin_amdgcn_readfirstlane(tid_ >> 6);
    const int gw = vcu * NWAVES + wave, NGW = G * NWAVES;
    for (int t = gw; t < T; t += NGW) {
        f32x4 v[4]; float s = 0.f;
#pragma unroll
        for (int j = 0; j < 4; ++j) { const f32x4 r = *(const f32x4*)(res + (size_t)t * D + 4 * lane + 256 * j), a = *(const f32x4*)(add + (size_t)t * D + 4 * lane + 256 * j);
            v[j] = r * DN_ALPHA + a; s += (v[j][0] + v[j][1]) + (v[j][2] + v[j][3]); }
        const float mean = wave_sum(s) * (1.0f / D); float q = 0.f;
#pragma unroll
        for (int j = 0; j < 4; ++j) { v[j] = v[j] - mean; q += (v[j][0] * v[j][0] + v[j][1] * v[j][1]) + (v[j][2] * v[j][2] + v[j][3] * v[j][3]); }
        const float rstd = 1.0f / sqrtf(wave_sum(q) * (1.0f / D) + EPS);
#pragma unroll
        for (int j = 0; j < 4; ++j) { const f32x4 gg = *(const f32x4*)(g + 4 * lane + 256 * j), bb = *(const f32x4*)(b + 4 * lane + 256 * j);
            const f32x4 y = v[j] * rstd * gg + bb;
            *(f32x4*)(out + (size_t)t * D + 4 * lane + 256 * j) = y;
            if (outb) { u32x2 w; w.x = pk2(y[0], y[1]); w.y = pk2(y[2], y[3]); *(u32x2*)(outb + (size_t)t * D + 4 * lane + 256 * j) = w; } }
    }
}

DI void p16_topk(const Args& args, LAS unsigned char* lds, int vcu, int G) {
    unsigned char* ws = args.ws;
    const float* logits = (const float*)(ws + WS_LOGITS); const float* b_router = (const float*)args.in[27];
    int* assign = (int*)(ws + WS_ASSIGN); float* gatew = (float*)(ws + WS_GATEW);
    unsigned* gcnt = (unsigned*)(ws + WS_CTL) + CW_CNT;
    LAS unsigned* hist = (LAS unsigned*)(lds + HIST_OFF); LAS unsigned* hbase = (LAS unsigned*)(lds + HBASE_OFF);
    int tid = threadIdx.x; asm volatile("" : "+v"(tid));
    for (int blk = vcu; blk < T / 512; blk += G) {
        const int t = blk * 512 + tid;
        float v[NE];
#pragma unroll
        for (int j = 0; j < NE / 4; ++j) { const f32x4 a = *(const f32x4*)(logits + (size_t)t * NE + 4 * j), bb = *(const f32x4*)(b_router + 4 * j);
            v[4 * j] = a[0] + bb[0]; v[4 * j + 1] = a[1] + bb[1]; v[4 * j + 2] = a[2] + bb[2]; v[4 * j + 3] = a[3] + bb[3]; }
        int idx[TOPK]; float val[TOPK];
#pragma unroll
        for (int k = 0; k < TOPK; ++k) { float best = -INFINITY; int bi = 0;
#pragma unroll
            for (int e = 0; e < NE; ++e) { bool taken = false;
#pragma unroll
                for (int kk = 0; kk < k; ++kk) taken = taken || (idx[kk] == e);
                if (!taken && v[e] > best) { best = v[e]; bi = e; } }
            idx[k] = bi; val[k] = best; }
        float ex[TOPK], sum = 0.f;
#pragma unroll
        for (int k = 0; k < TOPK; ++k) { ex[k] = __expf(val[k] - val[0]); sum += ex[k]; }
        const float inv = 1.0f / sum;
        if (tid < NE) hist[tid] = 0u;
        __syncthreads();
        unsigned lr[TOPK];
#pragma unroll
        for (int k = 0; k < TOPK; ++k) lr[k] = __hip_atomic_fetch_add(hist + idx[k], 1u, __ATOMIC_RELAXED, __HIP_MEMORY_SCOPE_WORKGROUP);
        __syncthreads();
        if (tid < NE) hbase[tid] = __hip_atomic_fetch_add(gcnt + tid, hist[tid], RLX_AGENT);
        __syncthreads();
#pragma unroll
        for (int k = 0; k < TOPK; ++k) { assign[(size_t)t * TOPK + k] = (idx[k] << 20) | (int)(hbase[idx[k]] + lr[k]); gatew[(size_t)t * TOPK + k] = ex[k] * inv; }
        __syncthreads();
    }
}
DI void build_tstart(const Args& args, LAS unsigned char* lds) {
    const unsigned* gcnt = (const unsigned*)(args.ws + WS_CTL) + CW_CNT; LAS int* tst = (LAS int*)(lds + TST_OFF); LAS int* tile_e = (LAS int*)(lds + TILE_E_OFF);
    if (threadIdx.x == 0) { int acc = 0;
        for (int e = 0; e < NE; ++e) { tst[e] = acc; const unsigned c = __hip_atomic_load(gcnt + e, RLX_AGENT); acc += (int)((c + 255u) >> 8); }
        tst[NE] = acc; }
    __syncthreads();
    for (int t = threadIdx.x; t < tst[NE]; t += NWAVES * 64) { int e = 0;
        for (int j = 1; j < NE; ++j) e += (tst[j] <= t) ? 1 : 0;
        tile_e[t] = e; }
    __syncthreads();
}
DI void p17_gather(const Args& args, LAS unsigned char* lds, int vcu, int G) {
    int tid_ = threadIdx.x; asm volatile("" : "+v"(tid_)); const int lane = tid_ & 63; const int wave = __builtin_amdgcn_readfirstlane(tid_ >> 6);
    unsigned char* ws = args.ws;
    build_tstart(args, lds);
    const LAS int* tst = (const LAS int*)(lds + TST_OFF);
    const unsigned* gcnt = (const unsigned*)(ws + WS_CTL) + CW_CNT;
    const int* assign = (const int*)(ws + WS_ASSIGN); const float* gatew = (const float*)(ws + WS_GATEW);
    int* tokpos = (int*)(ws + WS_TOKPOS); float* rowgate = (float*)(ws + WS_ROWGATE);
    const bf16_t* h2b = (const bf16_t*)(ws + WS_H2B); unsigned char* xg = ws + WS_XG;
    const int gw = vcu * NWAVES + wave, NGW = G * NWAVES;
    for (int t = gw; t < T; t += NGW) {
        const u32x4 a = *(const u32x4*)(h2b + (size_t)t * D + 16 * lane), b = *(const u32x4*)(h2b + (size_t)t * D + 16 * lane + 8);
        u32x4 o;
        o.x = pg8::pk4_fp8(bflo(a.x) * pg8::F8_XS, bfhi(a.x) * pg8::F8_XS, bflo(a.y) * pg8::F8_XS, bfhi(a.y) * pg8::F8_XS); o.y = pg8::pk4_fp8(bflo(a.z) * pg8::F8_XS, bfhi(a.z) * pg8::F8_XS, bflo(a.w) * pg8::F8_XS, bfhi(a.w) * pg8::F8_XS);
        o.z = pg8::pk4_fp8(bflo(b.x) * pg8::F8_XS, bfhi(b.x) * pg8::F8_XS, bflo(b.y) * pg8::F8_XS, bfhi(b.y) * pg8::F8_XS); o.w = pg8::pk4_fp8(bflo(b.z) * pg8::F8_XS, bfhi(b.z) * pg8::F8_XS, bflo(b.w) * pg8::F8_XS, bfhi(b.w) * pg8::F8_XS);
#pragma unroll
        for (int k = 0; k < TOPK; ++k) { const int as = assign[(size_t)t * TOPK + k]; const int e = as >> 20, rank = as & 0xfffff; const int pos = tst[e] * 256 + rank;
            *(u32x4*)(xg + (size_t)pos * D + 16 * lane) = o;
            if (lane == 0) { tokpos[(size_t)t * TOPK + k] = pos; rowgate[pos] = gatew[(size_t)t * TOPK + k]; } }
    }
    for (int idx = gw; idx < NE * 256; idx += NGW) { const int e = idx >> 8, r = idx & 255; const int row = tst[e] * 256 + (int)__hip_atomic_load(gcnt + e, RLX_AGENT) + r;
        if (row < tst[e + 1] * 256) { const u32x4 z = {0u, 0u, 0u, 0u}; *(u32x4*)(xg + (size_t)row * D + 16 * lane) = z; if (lane == 0) rowgate[row] = 0.f; } }
}
DI void p20_final(const Args& args, int vcu, int G) {
    int tid_ = threadIdx.x; asm volatile("" : "+v"(tid_)); const int lane = tid_ & 63; const int wave = __builtin_amdgcn_readfirstlane(tid_ >> 6);
    unsigned char* ws = args.ws;
    const int* tokpos = (const int*)(ws + WS_TOKPOS); const bf16_t* yb = (const bf16_t*)(ws + WS_YB);
    const float* g = (const float*)args.in[32]; const float* b = (const float*)args.in[33]; float* out = args.out;
    const int gw = vcu * NWAVES + wave, NGW = G * NWAVES;
    for (int t = gw; t < T; t += NGW) {
        int pos[TOPK];
#pragma unroll
        for (int k = 0; k < TOPK; ++k) pos[k] = tokpos[(size_t)t * TOPK + k];
        f32x4 v[4]; float s = 0.f;
#pragma unroll
        for (int j = 0; j < 4; ++j) { const f32x4 r = *(const f32x4*)(out + (size_t)t * D + 4 * lane + 256 * j); f32x4 a = {0.f, 0.f, 0.f, 0.f};
#pragma unroll
            for (int k = 0; k < TOPK; ++k) { const u32x2 w = *(const u32x2*)(yb + (size_t)pos[k] * D + 4 * lane + 256 * j); a[0] += bflo(w.x); a[1] += bfhi(w.x); a[2] += bflo(w.y); a[3] += bfhi(w.y); }
            v[j] = r * DN_ALPHA + a; s += (v[j][0] + v[j][1]) + (v[j][2] + v[j][3]); }
        const float mean = wave_sum(s) * (1.0f / D); float q = 0.f;
#pragma unroll
        for (int j = 0; j < 4; ++j) { v[j] = v[j] - mean; q += (v[j][0] * v[j][0] + v[j][1] * v[j][1]) + (v[j][2] * v[j][2] + v[j][3] * v[j][3]); }
        const float rstd = 1.0f / sqrtf(wave_sum(q) * (1.0f / D) + EPS);
#pragma unroll
        for (int j = 0; j < 4; ++j) { const f32x4 gg = *(const f32x4*)(g + 4 * lane + 256 * j), bb = *(const f32x4*)(b + 4 * lane + 256 * j);
            *(f32x4*)(out + (size_t)t * D + 4 * lane + 256 * j) = v[j] * rstd * gg + bb; }
    }
}
constexpr int AT_KROW = 208, AT_VROW = 136;
constexpr int AT_KBUF = 64 * AT_KROW, AT_VBUF = 64 * AT_VROW, AT_VOFF = 2 * AT_KBUF;
DI void mla_unit(int b, int h, int qb, const bf16_t* Q, const bf16_t* Kn, const bf16_t* Kpe, const bf16_t* Vt, bf16_t* O, LAS unsigned char* lds) {
    int tid = threadIdx.x; asm volatile("" : "+v"(tid)); const int lane = tid & 63, r32 = lane & 31, hi = lane >> 5; const int wid = __builtin_amdgcn_readfirstlane(tid >> 6);
    const int q0 = qb * 256 + wid * 32;
    const int qi = q0 + r32;
    const size_t tokb = (size_t)b * SEQ;
    bf16x8 qf[6];
    { const bf16_t* qp = Q + (tokb + qi) * (AH * AQK) + h * AQK + 8 * hi;
#pragma unroll
      for (int s = 0; s < 6; ++s) qf[s] = *(const bf16x8*)(qp + 16 * s); }
    const int kkey = tid >> 3, kch = tid & 7, pkey = (tid & 255) >> 2, pch = tid & 3, vd = tid >> 3, vch = tid & 7;
    const bf16_t* ksrc = Kn + (tokb + kkey) * 512 + h * 64 + kch * 8;
    const bf16_t* psrc = Kpe + (tokb + pkey) * 32 + pch * 8;
    const bf16_t* vsrc = Vt + (size_t)(h * 64 + vd) * T + tokb + vch * 8;
    const int kdst = kkey * AT_KROW + kch * 16, pdst = pkey * AT_KROW + 128 + pch * 16, vdst = AT_VOFF + vd * AT_VROW + vch * 16;
    const int nkt = 4 * (qb + 1);
    u32x4 rk, rp, rv;
    rk = *(const u32x4*)ksrc; rv = *(const u32x4*)vsrc; rp = (u32x4){0u, 0u, 0u, 0u}; if (tid < 256) rp = *(const u32x4*)psrc;
    *(LAS u32x4*)(lds + kdst) = rk; if (tid < 256) *(LAS u32x4*)(lds + pdst) = rp;
    *(LAS u32x2*)(lds + vdst) = (u32x2){rv.x, rv.y}; *(LAS u32x2*)(lds + vdst + 8) = (u32x2){rv.z, rv.w};
    __syncthreads();
    float m_run = -INFINITY, l_run = 0.f;
    f32x16 o0, o1;
#pragma unroll
    for (int r = 0; r < 16; ++r) { o0[r] = 0.f; o1[r] = 0.f; }
    for (int kt = 0; kt < nkt; ++kt) {
        const int buf = kt & 1;
        if (kt + 1 < nkt) { rk = *(const u32x4*)(ksrc + (size_t)(kt + 1) * 64 * 512); rv = *(const u32x4*)(vsrc + (kt + 1) * 64); if (tid < 256) rp = *(const u32x4*)(psrc + (size_t)(kt + 1) * 64 * 32); }
        const int key0 = kt * 64;
        if (key0 <= q0 + 31) {
            const LAS unsigned char* kb = lds + buf * AT_KBUF + r32 * AT_KROW + hi * 16;
            f32x16 p0, p1;
#pragma unroll
            for (int r = 0; r < 16; ++r) { p0[r] = 0.f; p1[r] = 0.f; }
#pragma unroll
            for (int s = 0; s < 6; ++s) { const bf16x8 a0 = *(const LAS bf16x8*)(kb + s * 32), a1 = *(const LAS bf16x8*)(kb + 32 * AT_KROW + s * 32);
                p0 = MFMA32(a0, qf[s], p0); p1 = MFMA32(a1, qf[s], p1); }
            if (key0 + 63 > q0) {
#pragma unroll
                for (int r = 0; r < 16; ++r) { const int key = key0 + crow(r, hi); if (key > qi) p0[r] = -INFINITY; if (key + 32 > qi) p1[r] = -INFINITY; }
            }
            float mx = fmaxf(p0[0], p1[0]);
#pragma unroll
            for (int r = 1; r < 16; ++r) mx = fmaxf(mx, fmaxf(p0[r], p1[r]));
            mx = fmaxf(mx, __shfl_xor(mx, 32));
            const float m_new = fmaxf(m_run, mx);
            const float alpha = __builtin_amdgcn_exp2f(m_run - m_new);
            m_run = m_new;
            float ls = 0.f;
#pragma unroll
            for (int r = 0; r < 16; ++r) { p0[r] = __builtin_amdgcn_exp2f(p0[r] - m_new); p1[r] = __builtin_amdgcn_exp2f(p1[r] - m_new); ls += p0[r] + p1[r]; }
            l_run = l_run * alpha + ls;
#pragma unroll
            for (int r = 0; r < 16; ++r) { o0[r] *= alpha; o1[r] *= alpha; }
            bf16x8 pb[4];
#pragma unroll
            for (int s = 0; s < 4; ++s) { u32x4 w;
                if (s < 2) { w.x = pk2(p0[8 * s], p0[8 * s + 1]); w.y = pk2(p0[8 * s + 2], p0[8 * s + 3]); w.z = pk2(p0[8 * s + 4], p0[8 * s + 5]); w.w = pk2(p0[8 * s + 6], p0[8 * s + 7]); }
                else { const int s2 = s - 2; w.x = pk2(p1[8 * s2], p1[8 * s2 + 1]); w.y = pk2(p1[8 * s2 + 2], p1[8 * s2 + 3]); w.z = pk2(p1[8 * s2 + 4], p1[8 * s2 + 5]); w.w = pk2(p1[8 * s2 + 6], p1[8 * s2 + 7]); }
                pb[s] = __builtin_bit_cast(bf16x8, w); }
            const LAS unsigned char* vb = lds + AT_VOFF + buf * AT_VBUF + r32 * AT_VROW + hi * 8;
#pragma unroll
            for (int s = 0; s < 4; ++s) {
                const u32x2 a0l = *(const LAS u32x2*)(vb + s * 32), a0h = *(const LAS u32x2*)(vb + s * 32 + 16);
                const u32x2 a1l = *(const LAS u32x2*)(vb + 32 * AT_VROW + s * 32), a1h = *(const LAS u32x2*)(vb + 32 * AT_VROW + s * 32 + 16);
                const bf16x8 a0 = __builtin_bit_cast(bf16x8, (u32x4){a0l.x, a0l.y, a0h.x, a0h.y}), a1 = __builtin_bit_cast(bf16x8, (u32x4){a1l.x, a1l.y, a1h.x, a1h.y});
                o0 = MFMA32(a0, pb[s], o0); o1 = MFMA32(a1, pb[s], o1); }
        }
        if (kt + 1 < nkt) { const int nb = (kt + 1) & 1;
            *(LAS u32x4*)(lds + nb * AT_KBUF + kdst) = rk; if (tid < 256) *(LAS u32x4*)(lds + nb * AT_KBUF + pdst) = rp;
            *(LAS u32x2*)(lds + nb * AT_VBUF + vdst) = (u32x2){rv.x, rv.y}; *(LAS u32x2*)(lds + nb * AT_VBUF + vdst + 8) = (u32x2){rv.z, rv.w}; }
        __syncthreads();
    }
    const float lt = l_run + __shfl_xor(l_run, 32); const float inv = 1.0f / lt;
    bf16_t* op = O + (tokb + qi) * AW + h * AVD + 4 * hi;
#pragma unroll
    for (int g = 0; g < 4; ++g) { u32x2 w0, w1;
        w0.x = pk2(o0[4 * g] * inv, o0[4 * g + 1] * inv); w0.y = pk2(o0[4 * g + 2] * inv, o0[4 * g + 3] * inv);
        w1.x = pk2(o1[4 * g] * inv, o1[4 * g + 1] * inv); w1.y = pk2(o1[4 * g + 2] * inv, o1[4 * g + 3] * inv);
        *(u32x2*)(op + 8 * g) = w0; *(u32x2*)(op + 32 + 8 * g) = w1; }
}
DI void p4_attention(const Args& args, LAS unsigned char* lds, int vcu, int G) {
    unsigned char* ws = args.ws;
    const bf16_t* Q = (const bf16_t*)(ws + WS_QMLA); const bf16_t* Kn = (const bf16_t*)(ws + WS_KN); const bf16_t* Kpe = (const bf16_t*)(ws + WS_KPE); const bf16_t* Vt = (const bf16_t*)(ws + WS_VT);
    bf16_t* O = (bf16_t*)(ws + WS_AO);
    for (int p = vcu; p < NB * AH * 4; p += G) { const int bh = p >> 2, j = p & 3; const int b = bh / AH, h = bh % AH;
        mla_unit(b, h, 7 - j, Q, Kn, Kpe, Vt, O, lds);
        mla_unit(b, h, j, Q, Kn, Kpe, Vt, O, lds); }
}

constexpr int ML_QROW = 272, ML_TROW = 144;
constexpr int ML_QS = 0, ML_KS = ML_QS + 64 * ML_QROW, ML_KTS = ML_KS + 64 * ML_QROW, ML_VTS = ML_KTS + 128 * ML_TROW, ML_CS = ML_VTS + 32 * ML_TROW, ML_SS = ML_CS + 32 * ML_QROW,
              ML_VEC = ML_SS + 64 * ML_TROW;
static_assert(ML_VEC + (7 * 64 + 128 + 4) * 4 <= RING_BYTES, "mLSTM LDS");
DI void mlstm_unit(int b, int h, int vs, const Args& args, LAS unsigned char* lds) {
    unsigned char* ws = args.ws;
    const bf16_t* qkm = (const bf16_t*)(ws + WS_QKM); const bf16_t* ktm = (const bf16_t*)(ws + WS_KTM); const bf16_t* proj = (const bf16_t*)(ws + WS_PROJ);
    const float* gates = (const float*)(ws + WS_GATES); float* hraw = (float*)(ws + WS_HRAW);
    const float b_i = ((const float*)args.in[4])[h], b_f = ((const float*)args.in[5])[h];
    int tid = threadIdx.x; asm volatile("" : "+v"(tid)); const int lane = tid & 63, r32 = lane & 31, hi = lane >> 5; const int wid = __builtin_amdgcn_readfirstlane(tid >> 6);
    LAS float* ROWT = (LAS float*)(lds + ML_VEC); LAS float* COLT = ROWT + 64; LAS float* WINT = ROWT + 128; LAS float* ENEG = ROWT + 192; LAS float* WAS = ROWT + 256;
    LAS float* NQ = ROWT + 320; LAS float* DINV = ROWT + 384; LAS float* NVEC = ROWT + 448; LAS float* SCAL = ROWT + 576;
    const size_t tokb = (size_t)b * SEQ;
    for (int i = tid; i < 32 * ML_QROW / 4; i += 512) ((LAS unsigned*)(lds + ML_CS))[i] = 0u;
    if (tid < 128) NVEC[tid] = 0.f;
    f32x16 cacc;
#pragma unroll
    for (int r = 0; r < 16; ++r) cacc[r] = 0.f;
    float m_st = 0.f;
    u32x4 sq[2], sk[2], skt[2], sv; float gi = 0.f, gf = 0.f;
    sv = (u32x4){0u, 0u, 0u, 0u};
#define ML_LOAD(c) do { const size_t tok0 = tokb + (size_t)(c) * MCH; \
        _Pragma("unroll") for (int i = 0; i < 2; ++i) { const int idx = tid + 512 * i; \
            sq[i] = *(const u32x4*)(qkm + (tok0 + (idx >> 4)) * 1024 + h * MHD + (idx & 15) * 8); \
            sk[i] = *(const u32x4*)(qkm + (tok0 + (idx >> 4)) * 1024 + 512 + h * MHD + (idx & 15) * 8); \
            skt[i] = *(const u32x4*)(ktm + (size_t)(h * MHD + (idx >> 3)) * T + tok0 + (idx & 7) * 8); } \
        if (tid < 256) sv = *(const u32x4*)(proj + (tok0 + (tid >> 2)) * NPROJ + PC_VM + h * MHD + vs * 32 + (tid & 3) * 8); \
        if (wid == 0) { gi = gates[(tok0 + lane) * 8 + h]; gf = gates[(tok0 + lane) * 8 + 4 + h]; } } while (0)
    ML_LOAD(0);
    for (int c = 0; c < SEQ / MCH; ++c) {
        const size_t tok0 = tokb + (size_t)c * MCH;
#pragma unroll
        for (int i = 0; i < 2; ++i) { const int idx = tid + 512 * i;
            *(LAS u32x4*)(lds + ML_QS + (idx >> 4) * ML_QROW + (idx & 15) * 16) = sq[i];
            *(LAS u32x4*)(lds + ML_KS + (idx >> 4) * ML_QROW + (idx & 15) * 16) = sk[i];
            *(LAS u32x4*)(lds + ML_KTS + (idx >> 3) * ML_TROW + (idx & 7) * 16) = skt[i]; }
        if (tid < 256) { const int l = tid >> 2, v0 = (tid & 3) * 8; LAS bf16_t* vt = (LAS bf16_t*)(lds + ML_VTS);
            vt[(v0 + 0) * (ML_TROW / 2) + l] = (bf16_t)(sv.x & 0xffff); vt[(v0 + 1) * (ML_TROW / 2) + l] = (bf16_t)(sv.x >> 16);
            vt[(v0 + 2) * (ML_TROW / 2) + l] = (bf16_t)(sv.y & 0xffff); vt[(v0 + 3) * (ML_TROW / 2) + l] = (bf16_t)(sv.y >> 16);
            vt[(v0 + 4) * (ML_TROW / 2) + l] = (bf16_t)(sv.z & 0xffff); vt[(v0 + 5) * (ML_TROW / 2) + l] = (bf16_t)(sv.z >> 16);
            vt[(v0 + 6) * (ML_TROW / 2) + l] = (bf16_t)(sv.w & 0xffff); vt[(v0 + 7) * (ML_TROW / 2) + l] = (bf16_t)(sv.w >> 16); }
        if (wid == 0) {
            const float xf = gf + b_f;
            const float lf = (xf >= 0.f) ? -log1pf(__expf(-xf)) : xf - log1pf(__expf(xf));
            float bb = lf;
#pragma unroll
            for (int o = 1; o < 64; o <<= 1) { const float tv = __shfl_up(bb, o); if (lane >= o) bb += tv; }
            const float btot = __shfl(bb, 63);
            const float ig = gi + b_i;
            const float a = btot - bb + ig;
            const float mchunk = wave_max(a);
            const float wa = __expf(a - mchunk);
            const float u = ig - bb;
            float pm = u;
#pragma unroll
            for (int o = 1; o < 64; o <<= 1) { const float tv = __shfl_up(pm, o); if (lane >= o) pm = fmaxf(pm, tv); }
            const float mintra = bb + pm;
            const float ginter = bb + m_st;
            const float m = fmaxf(ginter, mintra);
            const float mnew = fmaxf(btot + m_st, mchunk);
            const float sold = __expf(btot + m_st - mnew), snew = __expf(mchunk - mnew);
            ROWT[lane] = bb - m; COLT[lane] = u; WINT[lane] = __expf(ginter - m); ENEG[lane] = __expf(-m); WAS[lane] = snew * wa;
            if (lane == 0) SCAL[0] = sold;
            m_st = mnew;
        }
        __syncthreads();
        if (c + 1 < SEQ / MCH) ML_LOAD(c + 1);
        f32x16 iacc;
#pragma unroll
        for (int r = 0; r < 16; ++r) iacc[r] = 0.f;
        if (wid < 4) {
            const int jb = wid >> 1, sb = wid & 1;
            LAS bf16_t* ss = (LAS bf16_t*)(lds + ML_SS);
            if (sb <= jb) {
                f32x16 s;
#pragma unroll
                for (int r = 0; r < 16; ++r) s[r] = 0.f;
                const LAS unsigned char* qa = lds + ML_QS + (32 * jb + r32) * ML_QROW + hi * 16; const LAS unsigned char* kb = lds + ML_KS + (32 * sb + r32) * ML_QROW + hi * 16;
#pragma unroll
                for (int kk = 0; kk < 8; ++kk) s = MFMA32(*(const LAS bf16x8*)(qa + kk * 32), *(const LAS bf16x8*)(kb + kk * 32), s);
                const int sidx = 32 * sb + r32; const float ct = COLT[sidx];
#pragma unroll
                for (int r = 0; r < 16; ++r) { const int j = 32 * jb + crow(r, hi);
                    const float val = (sidx <= j) ? s[r] * __expf(ROWT[j] + ct) : 0.f;
                    ss[j * (ML_TROW / 2) + sidx] = (bf16_t)f2bf(val); }
            } else {
#pragma unroll
                for (int r = 0; r < 16; ++r) ss[(32 * jb + crow(r, hi)) * (ML_TROW / 2) + 32 * sb + r32] = (bf16_t)0;
            }
        } else if (wid < 6) {
            const int jb = wid - 4;
            const LAS unsigned char* qa = lds + ML_QS + (32 * jb + r32) * ML_QROW + hi * 16; const LAS unsigned char* cb = lds + ML_CS + r32 * ML_QROW + hi * 16;
#pragma unroll
            for (int kk = 0; kk < 8; ++kk) iacc = MFMA32(*(const LAS bf16x8*)(qa + kk * 32), *(const LAS bf16x8*)(cb + kk * 32), iacc);
        } else {
            const int j = 32 * (wid - 6) + (lane >> 1), half = lane & 1;
            const LAS unsigned char* qa = lds + ML_QS + j * ML_QROW + half * 128; float acc = 0.f;
#pragma unroll
            for (int i = 0; i < 8; ++i) { const u32x4 w = *(const LAS u32x4*)(qa + i * 16); const f32x4 n0 = *(const LAS f32x4*)(NVEC + half * 64 + i * 8), n1 = *(const LAS f32x4*)(NVEC + half * 64 + i * 8 + 4);
                acc += bflo(w.x) * n0[0] + bfhi(w.x) * n0[1] + bflo(w.y) * n0[2] + bfhi(w.y) * n0[3] + bflo(w.z) * n1[0] + bfhi(w.z) * n1[1] + bflo(w.w) * n1[2] + bfhi(w.w) * n1[3]; }
            acc += __shfl_xor(acc, 1);
            if (half == 0) NQ[j] = acc;
        }
        __syncthreads();
        if (wid < 4) {
            const float sold = SCAL[0];
#pragma unroll
            for (int r = 0; r < 16; ++r) cacc[r] *= sold;
            const LAS unsigned char* va = lds + ML_VTS + r32 * ML_TROW + hi * 16; const LAS unsigned char* kb = lds + ML_KTS + (32 * wid + r32) * ML_TROW + hi * 16;
#pragma unroll
            for (int kk = 0; kk < 4; ++kk) { const u32x4 w = *(const LAS u32x4*)(va + kk * 32);
                const f32x4 w0 = *(const LAS f32x4*)(WAS + 16 * kk + 8 * hi), w1 = *(const LAS f32x4*)(WAS + 16 * kk + 8 * hi + 4);
                u32x4 sa; sa.x = pk2(bflo(w.x) * w0[0], bfhi(w.x) * w0[1]); sa.y = pk2(bflo(w.y) * w0[2], bfhi(w.y) * w0[3]); sa.z = pk2(bflo(w.z) * w1[0], bfhi(w.z) * w1[1]); sa.w = pk2(bflo(w.w) * w1[2], bfhi(w.w) * w1[3]);
                cacc = MFMA32(__builtin_bit_cast(bf16x8, sa), *(const LAS bf16x8*)(kb + kk * 32), cacc); }
            LAS bf16_t* cs = (LAS bf16_t*)(lds + ML_CS);
#pragma unroll
            for (int r = 0; r < 16; ++r) cs[crow(r, hi) * (ML_QROW / 2) + 32 * wid + r32] = (bf16_t)f2bf(cacc[r]);
        } else if (wid < 6) {
            const int jb = wid - 4;
#pragma unroll
            for (int r = 0; r < 16; ++r) iacc[r] *= WINT[32 * jb + crow(r, hi)];
            const LAS unsigned char* sa = lds + ML_SS + (32 * jb + r32) * ML_TROW + hi * 16; const LAS unsigned char* vb = lds + ML_VTS + r32 * ML_TROW + hi * 16;
#pragma unroll
            for (int kk = 0; kk < 4; ++kk) iacc = MFMA32(*(const LAS bf16x8*)(sa + kk * 32), *(const LAS bf16x8*)(vb + kk * 32), iacc);
        } else {
            const int tl = (wid - 6) * 64 + lane;
            { const int j = tl >> 1, half = tl & 1; const LAS unsigned char* sp = lds + ML_SS + j * ML_TROW + half * 64; float rs = 0.f;
#pragma unroll
              for (int i = 0; i < 4; ++i) { const u32x4 w = *(const LAS u32x4*)(sp + i * 16); rs += (bflo(w.x) + bfhi(w.x)) + (bflo(w.y) + bfhi(w.y)) + (bflo(w.z) + bfhi(w.z)) + (bflo(w.w) + bfhi(w.w)); }
              rs += __shfl_xor(rs, 1);
              if (half == 0) { const float den = WINT[j] * NQ[j] + rs; DINV[j] = 1.0f / fmaxf(fabsf(den), ENEG[j]); } }
            { const int k = tl; const LAS unsigned char* kp = lds + ML_KTS + k * ML_TROW; float acc = SCAL[0] * NVEC[k];
#pragma unroll
              for (int i = 0; i < 8; ++i) { const u32x4 w = *(const LAS u32x4*)(kp + i * 16); const f32x4 w0 = *(const LAS f32x4*)(WAS + i * 8), w1 = *(const LAS f32x4*)(WAS + i * 8 + 4);
                  acc += bflo(w.x) * w0[0] + bfhi(w.x) * w0[1] + bflo(w.y) * w0[2] + bfhi(w.y) * w0[3] + bflo(w.z) * w1[0] + bfhi(w.z) * w1[1] + bflo(w.w) * w1[2] + bfhi(w.w) * w1[3]; }
              NVEC[k] = acc; }
        }
        __syncthreads();
        if (wid == 4 || wid == 5) {
            const int jb = wid - 4; float* hp = hraw + (tok0 + 32 * jb) * MW + h * MHD + vs * 32 + r32;
#pragma unroll
            for (int r = 0; r < 16; ++r) { const int j = crow(r, hi); hp[(size_t)j * MW] = iacc[r] * DINV[32 * jb + j]; }
        }
    }
#undef ML_LOAD
    __syncthreads();
}
DI void p5_mlstm(const Args& args, LAS unsigned char* lds, int vcu, int G) {
    for (int u = vcu; u < NB * MH * 4; u += G) { const int vs = u & 3, bh = u >> 2; mlstm_unit(bh / MH, bh % MH, vs, args, lds); }
}
#ifndef MK_ONE_LAUNCH
#define MK_ONE_LAUNCH 1
#endif
#ifndef P3SEL
#define P3SEL 31
#endif
constexpr int NPH = 20;
__global__ void __launch_bounds__(NWAVES * 64, 2) fwd_kernel(Args args) {
    extern __shared__ __attribute__((aligned(16))) unsigned char lds_raw[];
    LAS unsigned char* lds = (LAS unsigned char*)lds_raw;
    const int tid = threadIdx.x;
    const int G = gridDim.x; const int bx = blockIdx.x; const int vcu = (G % 8 == 0) ? (bx % 8) * (G / 8) + bx / 8 : bx;
    unsigned char* ws = args.ws;
    for (int u = tid; u < (LDS_BYTES - LDSCTL_OFF) / 4; u += NWAVES * 64) ((LAS unsigned*)(lds + LDSCTL_OFF))[u] = 0u;
    __syncthreads();
    volatile LAS unsigned* MISC = (volatile LAS unsigned*)(lds + MISC_OFF);
    XcdBarrier bar; bar.bar = (unsigned*)(ws + WS_CTL) + CW_BAR; bar.x = 0; bar.st = nullptr;
    const int lo = args.ph_lo, hi = args.ph_hi;
    if (hi - lo > 1) bar = xcd_barrier_post((unsigned*)(ws + WS_CTL) + CW_BAR, MISC + 8);
#ifndef PHASE_MASK
#define PHASE_MASK 0xFFFFFu
#endif
#define IN(k) (((PHASE_MASK >> (k)) & 1u) && lo <= (k) && (k) < hi)
#ifndef DUP_PHASE
#define DUP_PHASE -1
#endif
#define REP(k) _Pragma("unroll 1") for (int rep_ = 0; rep_ < ((DUP_PHASE == (k)) ? 2 : 1); ++rep_)
#define SEAM(k) do { if (IN(k) && IN((k) + 1)) xcd_barrier(bar); } while (0)
    using namespace pg8;
    LAS unsigned char* ring = lds + RING_OFF;
    const bf16_t* cws = (const bf16_t*)ws;
#define WSB(off) ((bf16_t*)(ws + (off)))
#define WSF(off) ((float*)(ws + (off)))

    if (IN(0)) REP(0) { p0_prologue(args, lds, vcu, G); }
    SEAM(0);
    if (IN(1)) REP(1) {
        { DenseOrder S; S.init(WSB(WS_XB), WSB(WS_W_IN), T, NPROJ, D, D, G, bx); EpiProj E{WSB(WS_PROJ), WSF(WS_GATES)}; gemm_phase(ring, D, D, D, S, E); }
        { DenseOrder S; S.init(WSB(WS_MEMB), WSB(WS_W_CK), NB * NMEM, D, D, D, G, bx); EpiBf16 E{WSB(WS_KC), D, 1 << 30, 1.f}; gemm_phase(ring, D, D, D, S, E); }
        { DenseOrder S; S.init(WSB(WS_W_CV), WSB(WS_MEMB), D, NB * NMEM, D, D, G, bx); EpiBf16 E{WSB(WS_VCT), NB * NMEM, 1 << 30, 1.f}; gemm_phase(ring, D, D, D, S, E); }
    }
    SEAM(1);
    if (IN(2)) REP(2) { p2_tokens(args, vcu, G); }
    SEAM(2);
    if (IN(3)) REP(3) {
        if (P3SEL & 1) { DenseOrder S; S.init(WSB(WS_QN), WSB(WS_W_UQ), T, AH * AQK, 256, 256, G, bx); EpiQmla E{WSB(WS_QMLA), WSF(WS_CS), 0.10206207261596575f * 1.4426950408889634f}; gemm_phase(ring, 256, 256, 256, S, E); }
        if (P3SEL & 2) { DenseOrder S; S.init(WSB(WS_KVN), WSB(WS_W_UK), T, 512, 256, 256, G, bx); EpiBf16 E{WSB(WS_KN), 512, 1 << 30, 1.f}; gemm_phase(ring, 256, 256, 256, S, E); }
        if (P3SEL & 4) { DenseOrder S; S.init(WSB(WS_W_UV), WSB(WS_KVN), 512, T, 256, 256, G, bx); EpiBf16 E{WSB(WS_VT), T, 1 << 30, 1.f}; gemm_phase(ring, 256, 256, 256, S, E); }
        if (P3SEL & 8) { DenseOrder S; S.init(WSB(WS_XC), WSB(WS_W_MQK), T, 1024, 512, 512, G, bx); EpiBf16 E{WSB(WS_QKM), 1024, 2, 0.08838834764831845f}; gemm_phase(ring, 512, 512, 512, S, E); }
        if (P3SEL & 16) { DenseOrder S; S.init(WSB(WS_W_MQK) + 512 * 512, WSB(WS_XC), 512, T, 512, 512, G, bx); EpiBf16 E{WSB(WS_KTM), T, 0, 0.08838834764831845f}; gemm_phase(ring, 512, 512, 512, S, E); }
    }
    SEAM(3);
    if (IN(4)) { REP(40) { p5_mlstm(args, lds, vcu, G); } REP(41) { p4_attention(args, lds, vcu, G); } }
    SEAM(4);
    if (IN(5)) REP(5) { p6_mpost(args, vcu, G); }
    SEAM(5);
    if (IN(6)) REP(6) {
        { DenseOrder S; S.init(WSB(WS_HM), WSB(WS_W_BRM), T, D, 512, 512, G, bx); EpiGate<false> E{WSB(WS_GATED), WSB(WS_PROJ), PC_GM}; gemm_phase(ring, 512, 512, 512, S, E); }
        { DenseOrder S; S.init(WSB(WS_AO), WSB(WS_W_BRA), T, D, 512, 512, G, bx); EpiGate<true> E{WSB(WS_GATED), WSB(WS_PROJ), PC_GA}; gemm_phase(ring, 512, 512, 512, S, E); }
    }
    SEAM(6);
    if (IN(7)) REP(7) { DenseOrder S; S.init(WSB(WS_GATED), WSB(WS_W_MIX), T, D, D, D, G, bx); EpiF32 E{WSF(WS_MIXO), D, 1 << 30}; gemm_phase(ring, D, D, D, S, E); }
    SEAM(7);
    if (IN(8)) REP(8) { ln_pass((const float*)args.in[0], WSF(WS_MIXO), (const float*)args.in[19], (const float*)args.in[20], args.out, WSB(WS_H1B), vcu, G); }
    SEAM(8);
    if (IN(9)) REP(9) { DenseOrder S; S.init(WSB(WS_H1B), WSB(WS_W_CQ), T, D, D, D, G, bx); EpiBf16 E{WSB(WS_QC), D, 0, 0.0625f * 1.4426950408889634f}; gemm_phase(ring, D, D, D, S, E); }
    SEAM(9);
    if (IN(10)) REP(10) { CrossSOrder S{(const char*)(ws + WS_QC), (const char*)(ws + WS_KC), G, vcu}; EpiSoftmax E{WSB(WS_PC), (LAS float*)(lds + RED_OFF)}; gemm_phase(ring, 256, D, D, S, E); }
    SEAM(10);
    if (IN(11)) REP(11) { CrossOOrder S{(const char*)(ws + WS_PC), (const char*)(ws + WS_VCT), G, vcu}; EpiBf16 E{WSB(WS_OC), D, 1 << 30, 1.f}; gemm_phase(ring, 256, D, NB * NMEM, S, E); }
    SEAM(11);
    if (IN(12)) REP(12) { DenseOrder S; S.init(WSB(WS_OC), WSB(WS_W_CO), T, D, D, D, G, bx); EpiF32 E{WSF(WS_COO), D, 1 << 30}; gemm_phase(ring, D, D, D, S, E); }
    SEAM(12);
    if (IN(13)) REP(13) { ln_pass(args.out, WSF(WS_COO), (const float*)args.in[24], (const float*)args.in[25], args.out, WSB(WS_H2B), vcu, G); }
    SEAM(13);
    if (IN(14)) REP(14) { DenseOrder S; S.init(WSB(WS_H2B), WSB(WS_W_R), T, 256, D, D, G, bx); EpiF32 E{WSF(WS_LOGITS), NE, NE}; gemm_phase(ring, D, D, D, S, E); }
    SEAM(14);
    if (IN(15)) REP(15) { p16_topk(args, lds, vcu, G); }
    SEAM(15);
    if (IN(16)) REP(16) { p17_gather(args, lds, vcu, G); }
    SEAM(16);
    if (IN(17)) REP(17) { build_tstart(args, lds);
        MoeOrder S{(const char*)(ws + WS_XG), (const char*)(ws + WS_W_GU), (const LAS int*)(lds + TST_OFF), (const LAS int*)(lds + TILE_E_OFF), 8, G, vcu, (size_t)256 * D, (size_t)2048 * 1024, (size_t)256 * 1024};
        EpiSwiglu E{ws + WS_ACT, (const float*)args.in[29]}; gemm_phase<EpiSwiglu, MoeOrder, true>(ring, D, D, D, S, E); }
    SEAM(17);
    if (IN(18)) REP(18) { build_tstart(args, lds);
        MoeOrder S{(const char*)(ws + WS_ACT), (const char*)(ws + WS_W_DN), (const LAS int*)(lds + TST_OFF), (const LAS int*)(lds + TILE_E_OFF), 4, G, vcu, (size_t)256 * D, (size_t)1024 * 1024, (size_t)256 * 1024};
        EpiDown E{WSB(WS_YB), (const float*)args.in[31], WSF(WS_ROWGATE)}; gemm_phase<EpiDown, MoeOrder, true>(ring, D, D, D, S, E); }
    SEAM(18);
    if (IN(19)) REP(19) { p20_final(args, vcu, G); }
    (void)cws;
#undef IN
#undef SEAM
}

extern "C" void kernel_launch(void* const* d_in, const int* in_sizes, int n_in, void* d_out, int out_size, void* d_ws, size_t ws_size, hipStream_t stream) {
    static int grid = 0;
    if (grid == 0) {
        if (n_in != 34 || in_sizes[0] != T * D || out_size != T * D || ws_size < WS_END) { fprintf(stderr, "kernel_launch: unexpected shapes / workspace (n_in %d, ws %zu)\n", n_in, ws_size); grid = -1; return; }
        int dev = 0, cus = 0, per_cu = 0;
        if (hipGetDevice(&dev) != hipSuccess || hipDeviceGetAttribute(&cus, hipDeviceAttributeMultiprocessorCount, dev) != hipSuccess) { grid = -1; return; }
        if (hipFuncSetAttribute((const void*)fwd_kernel, hipFuncAttributeMaxDynamicSharedMemorySize, LDS_BYTES) != hipSuccess) { fprintf(stderr, "kernel_launch: hipFuncSetAttribute failed\n"); grid = -1; return; }
        if (hipOccupancyMaxActiveBlocksPerMultiprocessor(&per_cu, (const void*)fwd_kernel, NWAVES * 64, LDS_BYTES) != hipSuccess || per_cu < 1) fprintf(stderr, "kernel_launch: occupancy query says %d\n", per_cu);
        (void)hipGetLastError();
        grid = cus;
    }
    if (grid < 0) return;
    if (hipMemsetAsync((char*)d_ws + WS_CTL, 0, CTL_ZERO_BYTES, stream) != hipSuccess) return;
    Args a{};
    for (int i = 0; i < 34; ++i) a.in[i] = d_in[i];
    a.out = (float*)d_out; a.ws = (unsigned char*)d_ws;
#if MK_ONE_LAUNCH
    a.ph_lo = 0; a.ph_hi = NPH;
    hipLaunchKernelGGL(fwd_kernel, dim3(grid), dim3(NWAVES * 64), LDS_BYTES, stream, a);
#else
    for (int p = 0; p < NPH; ++p) { a.ph_lo = p; a.ph_hi = p + 1; hipLaunchKernelGGL(fwd_kernel, dim3(grid), dim3(NWAVES * 64), LDS_BYTES, stream, a); }
#endif
}
```

```cpp
#include <hip/hip_runtime.h>
#include <cstdio>
#include <cstdint>
#include <cmath>

#define LAS __attribute__((address_space(3)))
#define GAS __attribute__((address_space(1)))
typedef unsigned short bf16_t;
typedef short bf16x8 __attribute__((ext_vector_type(8)));
typedef float f32x4 __attribute__((ext_vector_type(4)));
typedef float f32x2 __attribute__((ext_vector_type(2)));
typedef float f32x16 __attribute__((ext_vector_type(16)));
typedef unsigned u32x4 __attribute__((ext_vector_type(4)));
typedef unsigned u32x2 __attribute__((ext_vector_type(2)));
typedef GAS unsigned gu32;
#define RLX_AGENT __ATOMIC_RELAXED, __HIP_MEMORY_SCOPE_AGENT
#define DI __device__ __forceinline__

constexpr int D = 1024, NB = 16, SEQ = 2048, T = NB * SEQ, NMEM = 256;
constexpr int MH = 4, MHD = 128, MW = 512, MCH = 64;
constexpr int AH = 8, ANOPE = 64, AROPE = 32, AQK = 96, AVD = 64, AW = 512, AQR = 256, AKVR = 128;
constexpr int XH = 4, XHD = 256;
constexpr int NE = 32, TOPK = 4;
constexpr int DIN = 4008, NPROJ = 4096;
constexpr float DN_ALPHA = 1.189207115002721f;
constexpr float EPS = 1e-5f;
constexpr int NASSIGN = T * TOPK;
constexpr int NROWS = NASSIGN + NE * 256;
constexpr int NTILES_MAX = NROWS / 256;
constexpr int PC_QLAT = 0, PC_KVLAT = 256, PC_KROPE = 384, PC_IG = 416, PC_FG = 420, PC_XM = 512, PC_VM = 1024, PC_OP = 1536, PC_GM = 2048, PC_GA = 3072;

DI unsigned f2bf(float f) { unsigned u = __builtin_bit_cast(unsigned, f); return (u + 0x7fffu + ((u >> 16) & 1u)) >> 16; }
DI unsigned pk2(float lo, float hi) { return f2bf(lo) | (f2bf(hi) << 16); }
DI float bf2f(unsigned short b) { return __builtin_bit_cast(float, (unsigned)b << 16); }
DI float bflo(unsigned w) { return __builtin_bit_cast(float, w << 16); }
DI float bfhi(unsigned w) { return __builtin_bit_cast(float, w & 0xffff0000u); }
DI float wave_sum(float v) {
#pragma unroll
    for (int o = 1; o < 64; o <<= 1) v += __shfl_xor(v, o);
    return v;
}
DI float wave_max(float v) {
#pragma unroll
    for (int o = 1; o < 64; o <<= 1) v = fmaxf(v, __shfl_xor(v, o));
    return v;
}
DI float rcpf_(float x) { return __builtin_amdgcn_rcpf(x); }
DI float sigmoidf_(float x) { return __builtin_amdgcn_rcpf(1.0f + __builtin_amdgcn_exp2f(-1.4426950408889634f * x)); }
DI int crow(int r, int hi) { return (r & 3) + 8 * (r >> 2) + 4 * hi; }
#define MFMA32(a, b, c) __builtin_amdgcn_mfma_f32_32x32x16_bf16((a), (b), (c), 0, 0, 0)

namespace pg8 {
constexpr int BM = 256, BK = 64, HALF = 128, HTB = HALF * BK * 2, STAGE_BYTES = 8 * HTB;
__host__ __device__ __forceinline__ int lds_byte(int r, int c) { const int st = (r >> 4) * 2 + (c >> 5), rr = r & 15, cc = c & 31, ob = rr * 64 + cc * 2; return st * 1024 + (ob ^ (((ob >> 9) & 1) << 5)); }
__host__ __device__ __forceinline__ void stage_rc(int b, int& R, int& C) { const int st = b / 1024, sb = b % 1024, swz = sb ^ (((sb >> 9) & 1) << 5); R = (st >> 1) * 16 + swz / 64; C = (st & 1) * 32 + (swz % 64) / 2; }
__host__ __device__ __forceinline__ int perm32(int rho) { const int n = rho >> 4, i = rho & 15; return 8 * (i >> 2) + 4 * n + (i & 3); }

struct Unit { int pm, pn, aux; const char* a; const char* b; };
struct Ctx { int wr, wc, fr, fq, wid, lane; };

DI unsigned cvt_pk_bf16(float lo, float hi) { unsigned r; asm volatile("v_cvt_pk_bf16_f32 %0, %1, %2" : "=v"(r) : "v"(lo), "v"(hi)); return r; }

typedef f32x4 Acc[2][2][4][2];

DI void glds16_s(const char* gbase, unsigned voff, unsigned lds_dst) { unsigned keep;
    asm volatile("s_mov_b32 %0, m0\n\ts_mov_b32 m0, %1\n\ts_nop 0\n\tglobal_load_lds_dwordx4 %2, %3\n\ts_mov_b32 m0, %0" : "=&s"(keep) : "s"(lds_dst), "v"(voff), "s"(gbase) : "memory"); }
typedef int v8i_t __attribute__((ext_vector_type(8)));
typedef int i32x4_t __attribute__((ext_vector_type(4)));
template <class Epi, class Sched, bool FP8 = false>
DI void gemm_phase(LAS unsigned char* lds, const int K, const int lda, const int ldb, const Sched& S, const Epi& E) {
    int tid = threadIdx.x; asm volatile("" : "+v"(tid));
    const int wid = __builtin_amdgcn_readfirstlane(tid >> 6), lane = tid & 63, wr = wid >> 2, wc = wid & 3, fr = lane & 15, fq = lane >> 4;
    constexpr int ESZ = FP8 ? 1 : 2;
    const int nt = K * ESZ / (BK * 2);
    unsigned voffA[2], voffB[2];
#pragma unroll
    for (int i = 0; i < 2; ++i) { int R, C; stage_rc(tid * 16 + i * 8192, R, C); const int Rb = Epi::PERM ? ((R & ~31) + perm32(R & 31)) : R;
        voffA[i] = (unsigned)(R * lda * ESZ + C * 2); voffB[i] = (unsigned)(Rb * ldb * ESZ + C * 2); }
    const size_t kstep = (size_t)(BK * 2);
    const size_t hstepA = (size_t)HALF * lda * ESZ, hstepB = (size_t)HALF * ldb * ESZ;
    const unsigned ldsw = (unsigned)wid * 1024u;
    const int aoff = lds_byte(wr * 64 + fr, fq * 8), boff = lds_byte(wc * 32 + fr, fq * 8);
    const Ctx cx{wr, wc, fr, fq, wid, lane};
    const unsigned lds_u = (unsigned)__builtin_amdgcn_readfirstlane((int)((unsigned)(size_t)lds + ldsw));
    LAS unsigned char* ldsB = lds + 4 * HTB + boff;
#define PG8_SA(b, h) (((b) * 2 + (h)) * HTB)
#define PG8_SB(b, h) ((4 + (b) * 2 + (h)) * HTB)
#define PG8_SBL(b, h) (((b) * 2 + (h)) * HTB)
#define PG8_STAGE(bufoff, gbase, voff) do { _Pragma("unroll") for (int _i = 0; _i < 2; ++_i) \
        glds16_s((const char*)(gbase), (voff)[_i], lds_u + (unsigned)((bufoff) + _i * 8192)); } while (0)
#define PG8_RD(off) (*(const LAS i32x4_t*)(lds + (off)))
#define PG8_CAT2(x, y) __builtin_shufflevector((x), (y), 0, 1, 2, 3, 4, 5, 6, 7)
#define PG8_LDA(dst, b, h) do { if constexpr (FP8) { _Pragma("unroll") for (int m = 0; m < 4; ++m) dst##8[m] = PG8_CAT2(PG8_RD(PG8_SA(b, h) + aoff + m * 2048), PG8_RD(PG8_SA(b, h) + aoff + m * 2048 + 1024)); } \
        else { _Pragma("unroll") for (int m = 0; m < 4; ++m) _Pragma("unroll") for (int k = 0; k < 2; ++k) dst[m][k] = *(const LAS bf16x8*)(lds + PG8_SA(b, h) + aoff + m * 2048 + k * 1024); } } while (0)
#define PG8_LDB(dst, b, h) do { if constexpr (FP8) { _Pragma("unroll") for (int n = 0; n < 2; ++n) dst##8[n] = PG8_CAT2(*(const LAS i32x4_t*)(ldsB + PG8_SBL(b, h) + n * 2048), *(const LAS i32x4_t*)(ldsB + PG8_SBL(b, h) + n * 2048 + 1024)); } \
        else { _Pragma("unroll") for (int n = 0; n < 2; ++n) _Pragma("unroll") for (int k = 0; k < 2; ++k) dst[n][k] = *(const LAS bf16x8*)(ldsB + PG8_SBL(b, h) + n * 2048 + k * 1024); } } while (0)
#define PG8_MMA(ai, bj, At, Bt) do { __builtin_amdgcn_s_setprio(1); \
        if constexpr (FP8) { _Pragma("unroll") for (int m = 0; m < 4; ++m) _Pragma("unroll") for (int n = 0; n < 2; ++n) \
            acc[ai][bj][m][n] = __builtin_amdgcn_mfma_scale_f32_16x16x128_f8f6f4(Bt##8[n], At##8[m], acc[ai][bj][m][n], 0, 0, 0, 0x7f7f7f7f, 0, 0x7f7f7f7f); } \
        else { _Pragma("unroll") for (int m = 0; m < 4; ++m) _Pragma("unroll") for (int n = 0; n < 2; ++n) _Pragma("unroll") for (int k = 0; k < 2; ++k) \
            acc[ai][bj][m][n] = __builtin_amdgcn_mfma_f32_16x16x32_bf16(Bt[n][k], At[m][k], acc[ai][bj][m][n], 0, 0, 0); } \
        __builtin_amdgcn_s_setprio(0); } while (0)
#define PG8_WAIT_V(n) asm volatile("s_waitcnt vmcnt(" #n ")" ::: "memory")
#define PG8_WAIT_L(n) asm volatile("s_waitcnt lgkmcnt(" #n ")" ::: "memory")
#define PG8_BAR __builtin_amdgcn_s_barrier()
#define PG8_SCHED __builtin_amdgcn_sched_barrier(0)
    Unit cur, nxt; int ui = 0;
    if (!S.next(0, cur)) return;
    Acc acc;
#pragma unroll
    for (int a = 0; a < 2; ++a)
#pragma unroll
        for (int b = 0; b < 2; ++b)
#pragma unroll
            for (int m = 0; m < 4; ++m)
#pragma unroll
                for (int n = 0; n < 2; ++n) acc[a][b][m][n] = (f32x4){0.f, 0.f, 0.f, 0.f};
    bf16x8 At[4][2], B0[2][2], B1[2][2]; v8i_t At8[4], B08[2], B18[2];
    const char* cA = cur.a; const char* cB = cur.b;
    PG8_STAGE(PG8_SB(0, 0), cB, voffB); PG8_STAGE(PG8_SB(0, 1), cB + hstepB, voffB); PG8_STAGE(PG8_SA(0, 0), cA, voffA); PG8_STAGE(PG8_SA(0, 1), cA + hstepA, voffA);
    if (wr == 1) PG8_BAR;
    PG8_WAIT_V(2); PG8_BAR;
    PG8_STAGE(PG8_SB(1, 0), cB + kstep, voffB); PG8_STAGE(PG8_SA(1, 0), cA + kstep, voffA); PG8_STAGE(PG8_SB(1, 1), cB + hstepB + kstep, voffB);
    PG8_WAIT_V(6); PG8_BAR;
    for (;;) {
        const bool has_next = S.next(ui + 1, nxt);
        const char* nA = has_next ? nxt.a : cA; const char* nB = has_next ? nxt.b : cB;
#pragma unroll 1
        for (int t = 0; t < nt; t += 2) {
            const bool last = (t == nt - 2);
            const char* a1 = cA + (size_t)(t + 1) * kstep;
            const char* a2 = last ? nA : cA + (size_t)(t + 2) * kstep; const char* b2 = last ? nB : cB + (size_t)(t + 2) * kstep;
            const char* a3 = a2 + kstep; const char* b3 = b2 + kstep;
            PG8_LDB(B0, 0, 0); PG8_LDB(B1, 0, 1); PG8_SCHED; PG8_LDA(At, 0, 0); PG8_STAGE(PG8_SA(1, 1), a1 + hstepA, voffA);
            PG8_WAIT_V(8); PG8_WAIT_L(0); PG8_BAR; PG8_MMA(0, 0, At, B0); PG8_MMA(0, 1, At, B1); PG8_BAR; PG8_SCHED;
            PG8_LDA(At, 0, 1); PG8_STAGE(PG8_SB(0, 0), b2, voffB); PG8_STAGE(PG8_SB(0, 1), b2 + hstepB, voffB); PG8_STAGE(PG8_SA(0, 0), a2, voffA);
            PG8_WAIT_V(8); PG8_WAIT_L(0); PG8_BAR; PG8_MMA(1, 0, At, B0); PG8_MMA(1, 1, At, B1); PG8_BAR; PG8_SCHED;
            PG8_LDB(B0, 1, 0); PG8_LDB(B1, 1, 1); PG8_SCHED; PG8_LDA(At, 1, 0); PG8_STAGE(PG8_SA(0, 1), a2 + hstepA, voffA);
            PG8_WAIT_V(8); PG8_WAIT_L(0); PG8_BAR; PG8_MMA(0, 0, At, B0); PG8_MMA(0, 1, At, B1); PG8_BAR; PG8_SCHED;
            PG8_LDA(At, 1, 1); PG8_STAGE(PG8_SB(1, 0), b3, voffB); PG8_STAGE(PG8_SB(1, 1), b3 + hstepB, voffB); PG8_STAGE(PG8_SA(1, 0), a3, voffA);
            PG8_WAIT_V(8); PG8_WAIT_L(0); PG8_BAR; PG8_MMA(1, 0, At, B0); PG8_MMA(1, 1, At, B1); PG8_BAR; PG8_SCHED;
        }
        if (wr == 0) PG8_BAR;
        E(acc, cur, cx);
        if (!has_next) break;
#pragma unroll
        for (int a = 0; a < 2; ++a)
#pragma unroll
            for (int b = 0; b < 2; ++b)
#pragma unroll
                for (int m = 0; m < 4; ++m)
#pragma unroll
                    for (int n = 0; n < 2; ++n) acc[a][b][m][n] = (f32x4){0.f, 0.f, 0.f, 0.f};
        cur = nxt; cA = nA; cB = nB; ++ui;
        if (wr == 1) PG8_BAR;
    }
    PG8_WAIT_V(0);
    PG8_BAR;
#undef PG8_SA
#undef PG8_SB
#undef PG8_SBL
#undef PG8_STAGE
#undef PG8_LDA
#undef PG8_LDB
#undef PG8_MMA
#undef PG8_CAT2
#undef PG8_RD
#undef PG8_WAIT_V
#undef PG8_WAIT_L
#undef PG8_BAR
#undef PG8_SCHED
}
}
namespace pg8 {
constexpr int NXCD = 8, WGM = 8;
struct DenseOrder {
    const char* A; const char* B; int nM, nN, nwg, G, c; size_t strideA, strideB;
    DI void init(const void* A_, const void* B_, int M, int N, int lda, int ldb, int G_, int c_) { A = (const char*)A_; B = (const char*)B_; nM = M / BM; nN = N / BM; nwg = nM * nN; G = G_; c = c_;
        strideA = (size_t)BM * lda * 2; strideB = (size_t)BM * ldb * 2; }
    DI bool next(int i, Unit& u) const {
        const long L = (long)i * G + c; if (L >= nwg) return false;
        int wgid = (int)L; { const int q = nwg / NXCD, r = nwg % NXCD, xcd = wgid % NXCD, off = wgid / NXCD; wgid = (xcd < r ? xcd * (q + 1) : r * (q + 1) + (xcd - r) * q) + off; }
        const int nig = WGM * nN, gid = wgid / nig, fm = gid * WGM, gsz = (nM - fm) < WGM ? (nM - fm) : WGM;
        u.pm = fm + ((wgid % nig) % gsz); u.pn = (wgid % nig) / gsz; u.aux = 0;
        u.a = A + (size_t)u.pm * strideA; u.b = B + (size_t)u.pn * strideB; return true;
    }
};
struct CrossSOrder {
    const char* Q; const char* Kc; int G, v;
    DI bool next(int i, Unit& u) const {
        const int L = i * G + v; if (L >= (T / 256) * XH) return false;
        u.pm = L >> 2; u.pn = L & 3; u.aux = 0;
        u.a = Q + ((size_t)u.pm * 256 * D + u.pn * 256) * 2; u.b = Kc + ((size_t)(u.pm >> 3) * 256 * D + u.pn * 256) * 2; return true;
    }
};
struct CrossOOrder {
    const char* P; const char* Vt; int G, v;
    DI bool next(int i, Unit& u) const {
        const int L = i * G + v; if (L >= (T / 256) * XH) return false;
        u.pm = L >> 2; u.pn = L & 3; u.aux = 0;
        u.a = P + ((size_t)u.pm * 256 * D + u.pn * 256) * 2; u.b = Vt + ((size_t)u.pn * 256 * (NB * NMEM) + (size_t)(u.pm >> 3) * 256) * 2; return true;
    }
};
struct MoeOrder {
    const char* A; const char* W; const LAS int* tstart; const LAS int* tile_e; int npn, G, v; size_t strideA, strideW, strideN;
    DI bool next(int i, Unit& u) const {
        const int L = i * G + v; const int total = __builtin_amdgcn_readfirstlane(tstart[NE]) * npn; if (L >= total) return false;
        const int tile = L / npn; u.pm = tile; u.pn = L - tile * npn;
        const int e = __builtin_amdgcn_readfirstlane(tile_e[tile]);
        u.aux = e;
        u.a = A + (size_t)tile * strideA; u.b = W + (size_t)e * strideW + (size_t)u.pn * strideN; return true;
    }
};

DI unsigned pk4_fp8(float a, float b, float c, float d) { int w = 0; w = __builtin_amdgcn_cvt_pk_fp8_f32(a, b, w, false); w = __builtin_amdgcn_cvt_pk_fp8_f32(c, d, w, true); return (unsigned)w; }
constexpr float F8_XS = 16.0f, F8_WS = 64.0f, F8_AS = 8.0f;
struct EpiBf16 {
    static constexpr bool PERM = true;
    bf16_t* O; int ldc; int sc_from; float scale;
    DI void operator()(const Acc& acc, const Unit& u, const Ctx& c) const {
        int row0 = u.pm * BM + c.wr * 64 + c.fr, col0 = u.pn * BM + c.wc * 32 + 8 * c.fq; asm volatile("" : "+v"(row0), "+v"(col0));
        const float sc = (u.pn >= sc_from) ? scale : 1.0f;
#pragma unroll
        for (int ai = 0; ai < 2; ++ai)
#pragma unroll
            for (int m = 0; m < 4; ++m) { bf16_t* rowp = O + (size_t)(row0 + ai * HALF + m * 16) * ldc + col0;
#pragma unroll
                for (int bj = 0; bj < 2; ++bj) { const f32x4 v0 = acc[ai][bj][m][0] * sc, v1 = acc[ai][bj][m][1] * sc;
                    u32x4 w; w.x = cvt_pk_bf16(v0[0], v0[1]); w.y = cvt_pk_bf16(v0[2], v0[3]); w.z = cvt_pk_bf16(v1[0], v1[1]); w.w = cvt_pk_bf16(v1[2], v1[3]);
                    *(u32x4*)(rowp + bj * HALF) = w; } }
    }
};
struct EpiProj {
    static constexpr bool PERM = true;
    bf16_t* O; float* gates;
    DI void operator()(const Acc& acc, const Unit& u, const Ctx& c) const {
        int row0 = u.pm * BM + c.wr * 64 + c.fr, col0 = u.pn * BM + c.wc * 32 + 8 * c.fq; asm volatile("" : "+v"(row0), "+v"(col0));
#pragma unroll
        for (int ai = 0; ai < 2; ++ai)
#pragma unroll
            for (int m = 0; m < 4; ++m) { const int row = row0 + ai * HALF + m * 16; bf16_t* rowp = O + (size_t)row * NPROJ + col0;
#pragma unroll
                for (int bj = 0; bj < 2; ++bj) { const f32x4 v0 = acc[ai][bj][m][0], v1 = acc[ai][bj][m][1];
                    u32x4 w; w.x = cvt_pk_bf16(v0[0], v0[1]); w.y = cvt_pk_bf16(v0[2], v0[3]); w.z = cvt_pk_bf16(v1[0], v1[1]); w.w = cvt_pk_bf16(v1[2], v1[3]);
                    *(u32x4*)(rowp + bj * HALF) = w; }
                if (u.pn == 1 && c.wc == 1 && c.fq == 0) { *(f32x4*)(gates + (size_t)row * 8) = acc[ai][1][m][0]; *(f32x4*)(gates + (size_t)row * 8 + 4) = acc[ai][1][m][1]; } }
    }
};
struct EpiQmla {
    static constexpr bool PERM = true;
    bf16_t* O; const float* cs;
    float scale;
    DI void operator()(const Acc& acc, const Unit& u, const Ctx& c) const {
        int row0 = u.pm * BM + c.wr * 64 + c.fr, col0 = u.pn * BM + c.wc * 32 + 8 * c.fq; asm volatile("" : "+v"(row0), "+v"(col0));
#pragma unroll
        for (int ai = 0; ai < 2; ++ai)
#pragma unroll
            for (int m = 0; m < 4; ++m) { const int row = row0 + ai * HALF + m * 16; bf16_t* rowp = O + (size_t)row * (AH * AQK) + col0;
#pragma unroll
                for (int bj = 0; bj < 2; ++bj) { f32x4 v0 = acc[ai][bj][m][0] * scale, v1 = acc[ai][bj][m][1] * scale;
                    const int cc = (col0 + bj * HALF) % AQK;
                    if (cc >= ANOPE) { const int p0 = (cc - ANOPE) >> 1;
                        const f32x4 t0 = *(const f32x4*)(cs + (size_t)row * 32 + p0 * 2), t1 = *(const f32x4*)(cs + (size_t)row * 32 + p0 * 2 + 4);
                        f32x4 r0, r1;
                        r0[0] = v0[0] * t0[0] - v0[1] * t0[1]; r0[1] = v0[1] * t0[0] + v0[0] * t0[1];
                        r0[2] = v0[2] * t0[2] - v0[3] * t0[3]; r0[3] = v0[3] * t0[2] + v0[2] * t0[3];
                        r1[0] = v1[0] * t1[0] - v1[1] * t1[1]; r1[1] = v1[1] * t1[0] + v1[0] * t1[1];
                        r1[2] = v1[2] * t1[2] - v1[3] * t1[3]; r1[3] = v1[3] * t1[2] + v1[2] * t1[3];
                        v0 = r0; v1 = r1; }
                    u32x4 w; w.x = cvt_pk_bf16(v0[0], v0[1]); w.y = cvt_pk_bf16(v0[2], v0[3]); w.z = cvt_pk_bf16(v1[0], v1[1]); w.w = cvt_pk_bf16(v1[2], v1[3]);
                    *(u32x4*)(rowp + bj * HALF) = w; } }
    }
};
template <bool ADD> struct EpiGate {
    static constexpr bool PERM = true;
    bf16_t* O; const bf16_t* proj; int gcol;
    DI void operator()(const Acc& acc, const Unit& u, const Ctx& c) const {
        int row0 = u.pm * BM + c.wr * 64 + c.fr, col0 = u.pn * BM + c.wc * 32 + 8 * c.fq; asm volatile("" : "+v"(row0), "+v"(col0));
#pragma unroll
        for (int ai = 0; ai < 2; ++ai)
#pragma unroll
            for (int m = 0; m < 4; ++m) { const int row = row0 + ai * HALF + m * 16; bf16_t* rowp = O + (size_t)row * D + col0; const bf16_t* gp = proj + (size_t)row * NPROJ + gcol + col0;
#pragma unroll
                for (int bj = 0; bj < 2; ++bj) { const f32x4 v0 = acc[ai][bj][m][0], v1 = acc[ai][bj][m][1];
                    const u32x4 g = *(const u32x4*)(gp + bj * HALF);
                    float o[8];
                    o[0] = sigmoidf_(bflo(g.x)) * v0[0]; o[1] = sigmoidf_(bfhi(g.x)) * v0[1]; o[2] = sigmoidf_(bflo(g.y)) * v0[2]; o[3] = sigmoidf_(bfhi(g.y)) * v0[3];
                    o[4] = sigmoidf_(bflo(g.z)) * v1[0]; o[5] = sigmoidf_(bfhi(g.z)) * v1[1]; o[6] = sigmoidf_(bflo(g.w)) * v1[2]; o[7] = sigmoidf_(bfhi(g.w)) * v1[3];
                    if (ADD) { const u32x4 p = *(const u32x4*)(rowp + bj * HALF);
                        o[0] += bflo(p.x); o[1] += bfhi(p.x); o[2] += bflo(p.y); o[3] += bfhi(p.y); o[4] += bflo(p.z); o[5] += bfhi(p.z); o[6] += bflo(p.w); o[7] += bfhi(p.w); }
                    u32x4 w; w.x = cvt_pk_bf16(o[0], o[1]); w.y = cvt_pk_bf16(o[2], o[3]); w.z = cvt_pk_bf16(o[4], o[5]); w.w = cvt_pk_bf16(o[6], o[7]);
                    *(u32x4*)(rowp + bj * HALF) = w; } }
    }
};
struct EpiF32 {
    static constexpr bool PERM = false;
    float* C; int ldc; int ncols_valid;
    DI void operator()(const Acc& acc, const Unit& u, const Ctx& c) const {
        int row0 = u.pm * BM + c.wr * 64 + c.fr, col0 = u.pn * BM + c.wc * 32 + 4 * c.fq; asm volatile("" : "+v"(row0), "+v"(col0));
#pragma unroll
        for (int ai = 0; ai < 2; ++ai)
#pragma unroll
            for (int m = 0; m < 4; ++m) { float* rowp = C + (size_t)(row0 + ai * HALF + m * 16) * ldc + col0;
#pragma unroll
                for (int bj = 0; bj < 2; ++bj)
#pragma unroll
                    for (int n = 0; n < 2; ++n) if (col0 + bj * HALF + n * 16 < ncols_valid) *(f32x4*)(rowp + bj * HALF + n * 16) = acc[ai][bj][m][n]; }
    }
};

DI void row_stats(const float* stats, int row, float& mean, float& rstd) { const f32x2 st = *(const f32x2*)(stats + (size_t)row * 2);
    mean = st[0] * (1.0f / D); const float var = fmaxf(st[1] * (1.0f / D) - mean * mean, 0.f); rstd = __builtin_amdgcn_rsqf(var + EPS); }
template <bool NORM> struct EpiResStats {
    static constexpr bool PERM = true;
    const float* res; const float* pstats; const float* pg; const float* pb; float* V; bf16_t* VB; float* stats;
    DI void operator()(const Acc& acc, const Unit& u, const Ctx& c) const {
        int row0 = u.pm * BM + c.wr * 64 + c.fr, col0 = u.pn * BM + c.wc * 32 + 8 * c.fq; asm volatile("" : "+v"(row0), "+v"(col0));
#pragma unroll
        for (int ai = 0; ai < 2; ++ai)
#pragma unroll
            for (int m = 0; m < 4; ++m) { const int row = row0 + ai * HALF + m * 16; const size_t ro = (size_t)row * D + col0;
                float mean = 0.f, rstd = 1.f; if (NORM) row_stats(pstats, row, mean, rstd);
                float s1 = 0.f, s2 = 0.f;
#pragma unroll
                for (int bj = 0; bj < 2; ++bj) { f32x4 r0 = *(const f32x4*)(res + ro + bj * HALF), r1 = *(const f32x4*)(res + ro + bj * HALF + 4);
                    if (NORM) { const f32x4 g0 = *(const f32x4*)(pg + col0 + bj * HALF), g1 = *(const f32x4*)(pg + col0 + bj * HALF + 4), b0 = *(const f32x4*)(pb + col0 + bj * HALF), b1 = *(const f32x4*)(pb + col0 + bj * HALF + 4);
                        r0 = (r0 - mean) * rstd * g0 + b0; r1 = (r1 - mean) * rstd * g1 + b1; }
                    const f32x4 v0 = r0 * DN_ALPHA + acc[ai][bj][m][0], v1 = r1 * DN_ALPHA + acc[ai][bj][m][1];
                    *(f32x4*)(V + ro + bj * HALF) = v0; *(f32x4*)(V + ro + bj * HALF + 4) = v1;
                    u32x4 w; w.x = cvt_pk_bf16(v0[0], v0[1]); w.y = cvt_pk_bf16(v0[2], v0[3]); w.z = cvt_pk_bf16(v1[0], v1[1]); w.w = cvt_pk_bf16(v1[2], v1[3]);
                    *(u32x4*)(VB + ro + bj * HALF) = w;
                    s1 += (v0[0] + v0[1]) + (v0[2] + v0[3]) + (v1[0] + v1[1]) + (v1[2] + v1[3]);
                    s2 += (v0[0] * v0[0] + v0[1] * v0[1]) + (v0[2] * v0[2] + v0[3] * v0[3]) + (v1[0] * v1[0] + v1[1] * v1[1]) + (v1[2] * v1[2] + v1[3] * v1[3]); }
                s1 += __shfl_xor(s1, 16); s1 += __shfl_xor(s1, 32); s2 += __shfl_xor(s2, 16); s2 += __shfl_xor(s2, 32);
                if (c.fq == 0) { __hip_atomic_fetch_add(stats + (size_t)row * 2, s1, RLX_AGENT); __hip_atomic_fetch_add(stats + (size_t)row * 2 + 1, s2, RLX_AGENT); }
                __builtin_amdgcn_sched_barrier(0); }
    }
};
struct EpiLNApplyBf16 {
    static constexpr bool PERM = true;
    bf16_t* O; int ldc; const float* stats; const float* cs; const float* cb; float scale;
    DI void operator()(const Acc& acc, const Unit& u, const Ctx& c) const {
        int row0 = u.pm * BM + c.wr * 64 + c.fr, col0 = u.pn * BM + c.wc * 32 + 8 * c.fq; asm volatile("" : "+v"(row0), "+v"(col0));
        f32x4 csv[2][2], cbv[2][2];
#pragma unroll
        for (int bj = 0; bj < 2; ++bj)
#pragma unroll
            for (int n = 0; n < 2; ++n) { csv[bj][n] = *(const f32x4*)(cs + col0 + bj * HALF + 4 * n); cbv[bj][n] = *(const f32x4*)(cb + col0 + bj * HALF + 4 * n); }
#pragma unroll
        for (int ai = 0; ai < 2; ++ai)
#pragma unroll
            for (int m = 0; m < 4; ++m) { const int row = row0 + ai * HALF + m * 16; float mean, rstd; row_stats(stats, row, mean, rstd);
                bf16_t* rowp = O + (size_t)row * ldc + col0;
#pragma unroll
                for (int bj = 0; bj < 2; ++bj) { const f32x4 v0 = ((acc[ai][bj][m][0] - csv[bj][0] * mean) * rstd + cbv[bj][0]) * scale, v1 = ((acc[ai][bj][m][1] - csv[bj][1] * mean) * rstd + cbv[bj][1]) * scale;
                    u32x4 w; w.x = cvt_pk_bf16(v0[0], v0[1]); w.y = cvt_pk_bf16(v0[2], v0[3]); w.z = cvt_pk_bf16(v1[0], v1[1]); w.w = cvt_pk_bf16(v1[2], v1[3]);
                    *(u32x4*)(rowp + bj * HALF) = w; } }
    }
};
struct EpiLNApplyF32 {
    static constexpr bool PERM = false;
    float* C; int ldc; int ncols_valid; const float* stats; const float* cs; const float* cb;
    DI void operator()(const Acc& acc, const Unit& u, const Ctx& c) const {
        int row0 = u.pm * BM + c.wr * 64 + c.fr, col0 = u.pn * BM + c.wc * 32 + 4 * c.fq; asm volatile("" : "+v"(row0), "+v"(col0));
#pragma unroll
        for (int ai = 0; ai < 2; ++ai)
#pragma unroll
            for (int m = 0; m < 4; ++m) { const int row = row0 + ai * HALF + m * 16; float mean, rstd; row_stats(stats, row, mean, rstd);
                float* rowp = C + (size_t)row * ldc + col0;
#pragma unroll
                for (int bj = 0; bj < 2; ++bj)
#pragma unroll
                    for (int n = 0; n < 2; ++n) if (col0 + bj * HALF + n * 16 < ncols_valid) { const f32x4 csv = *(const f32x4*)(cs + col0 + bj * HALF + n * 16), cbv = *(const f32x4*)(cb + col0 + bj * HALF + n * 16);
                        *(f32x4*)(rowp + bj * HALF + n * 16) = (acc[ai][bj][m][n] - csv * mean) * rstd + cbv; } }
    }
};
struct EpiSoftmax {
    static constexpr bool PERM = true;
    bf16_t* O; LAS float* red;
    DI void operator()(Acc& acc, const Unit& u, const Ctx& c) const {
        int row0 = u.pm * BM + c.wr * 64 + c.fr, col0 = u.pn * BM + c.wc * 32 + 8 * c.fq; asm volatile("" : "+v"(row0), "+v"(col0));
        int rbase = (c.wr * 64 + c.fr) * 4; asm volatile("" : "+v"(rbase));
        LAS float* r1 = red + rbase; LAS float* r2 = red + 1024 + rbase;
#pragma unroll
        for (int ai = 0; ai < 2; ++ai)
#pragma unroll
            for (int m = 0; m < 4; ++m) { float v = -INFINITY;
#pragma unroll
                for (int bj = 0; bj < 2; ++bj)
#pragma unroll
                    for (int n = 0; n < 2; ++n) { const f32x4 x = acc[ai][bj][m][n]; v = fmaxf(v, fmaxf(fmaxf(x[0], x[1]), fmaxf(x[2], x[3]))); }
                v = fmaxf(v, __shfl_xor(v, 16)); v = fmaxf(v, __shfl_xor(v, 32));
                if (c.fq == 0) r1[(ai * HALF + m * 16) * 4 + c.wc] = v;
                __builtin_amdgcn_sched_barrier(0); }
        asm volatile("s_waitcnt lgkmcnt(0)" ::: "memory"); __builtin_amdgcn_s_barrier(); asm volatile("" ::: "memory");
#pragma unroll
        for (int ai = 0; ai < 2; ++ai)
#pragma unroll
            for (int m = 0; m < 4; ++m) { const f32x4 q = *(const LAS f32x4*)(r1 + (ai * HALF + m * 16) * 4);
                const float mm = fmaxf(fmaxf(q[0], q[1]), fmaxf(q[2], q[3])); float s = 0.f;
#pragma unroll
                for (int bj = 0; bj < 2; ++bj)
#pragma unroll
                    for (int n = 0; n < 2; ++n) { f32x4 x = acc[ai][bj][m][n];
                        x[0] = __builtin_amdgcn_exp2f(x[0] - mm); x[1] = __builtin_amdgcn_exp2f(x[1] - mm); x[2] = __builtin_amdgcn_exp2f(x[2] - mm); x[3] = __builtin_amdgcn_exp2f(x[3] - mm);
                        acc[ai][bj][m][n] = x; s += (x[0] + x[1]) + (x[2] + x[3]); }
                s += __shfl_xor(s, 16); s += __shfl_xor(s, 32);
                if (c.fq == 0) r2[(ai * HALF + m * 16) * 4 + c.wc] = s;
                __builtin_amdgcn_sched_barrier(0); }
        asm volatile("s_waitcnt lgkmcnt(0)" ::: "memory"); __builtin_amdgcn_s_barrier(); asm volatile("" ::: "memory");
#pragma unroll
        for (int ai = 0; ai < 2; ++ai)
#pragma unroll
            for (int m = 0; m < 4; ++m) { const f32x4 q = *(const LAS f32x4*)(r2 + (ai * HALF + m * 16) * 4);
                const float inv = rcpf_((q[0] + q[1]) + (q[2] + q[3]));
                bf16_t* rowp = O + (size_t)(row0 + ai * HALF + m * 16) * D + col0;
#pragma unroll
                for (int bj = 0; bj < 2; ++bj) { const f32x4 v0 = acc[ai][bj][m][0] * inv, v1 = acc[ai][bj][m][1] * inv;
                    u32x4 w; w.x = cvt_pk_bf16(v0[0], v0[1]); w.y = cvt_pk_bf16(v0[2], v0[3]); w.z = cvt_pk_bf16(v1[0], v1[1]); w.w = cvt_pk_bf16(v1[2], v1[3]);
                    *(u32x4*)(rowp + bj * HALF) = w; }
                __builtin_amdgcn_sched_barrier(0); }
    }
};
struct EpiSwiglu {
    static constexpr bool PERM = true;
    unsigned char* O; const float* bias;
    DI void operator()(const Acc& acc, const Unit& u, const Ctx& c) const {
        int row0 = u.pm * BM + c.wr * 64 + c.fr, col0 = u.pn * BM + c.wc * 32 + 8 * c.fq; asm volatile("" : "+v"(row0), "+v"(col0));
        constexpr float us = 1.0f / (F8_XS * F8_WS);
        f32x4 bv[2][2];
#pragma unroll
        for (int bj = 0; bj < 2; ++bj)
#pragma unroll
            for (int n = 0; n < 2; ++n) bv[bj][n] = *(const f32x4*)(bias + (size_t)u.aux * 2048 + col0 + bj * HALF + 4 * n);
#pragma unroll
        for (int ai = 0; ai < 2; ++ai)
#pragma unroll
            for (int m = 0; m < 4; ++m) { unsigned char* rowp = O + (size_t)(row0 + ai * HALF + m * 16) * 1024 + (col0 >> 1);
#pragma unroll
                for (int bj = 0; bj < 2; ++bj) { const f32x4 v0 = acc[ai][bj][m][0] * us + bv[bj][0], v1 = acc[ai][bj][m][1] * us + bv[bj][1];
                    float o[4];
#define SWG(g, l) ({ const float g_ = fminf((g), 7.0f), l_ = fminf(fmaxf((l), -7.0f), 7.0f); fminf(fmaxf(g_ * sigmoidf_(1.702f * g_) * (l_ + 1.0f) * F8_AS, -448.0f), 448.0f); })
                    o[0] = SWG(v0[0], v0[1]); o[1] = SWG(v0[2], v0[3]); o[2] = SWG(v1[0], v1[1]); o[3] = SWG(v1[2], v1[3]);
#undef SWG
                    *(unsigned*)(rowp + bj * (HALF / 2)) = pk4_fp8(o[0], o[1], o[2], o[3]); } }
    }
};
struct EpiDown {
    static constexpr bool PERM = true;
    bf16_t* O; const float* bias; const float* rowgate;
    DI void operator()(const Acc& acc, const Unit& u, const Ctx& c) const {
        int row0 = u.pm * BM + c.wr * 64 + c.fr, col0 = u.pn * BM + c.wc * 32 + 8 * c.fq; asm volatile("" : "+v"(row0), "+v"(col0));
        f32x4 bv[2][2];
#pragma unroll
        for (int bj = 0; bj < 2; ++bj)
#pragma unroll
            for (int n = 0; n < 2; ++n) bv[bj][n] = *(const f32x4*)(bias + (size_t)u.aux * 1024 + col0 + bj * HALF + 4 * n);
#pragma unroll
        for (int ai = 0; ai < 2; ++ai)
#pragma unroll
            for (int m = 0; m < 4; ++m) { const int row = row0 + ai * HALF + m * 16; const float gt = rowgate[row]; bf16_t* rowp = O + (size_t)row * 1024 + col0;
#pragma unroll
                for (int bj = 0; bj < 2; ++bj) { const f32x4 v0 = (acc[ai][bj][m][0] * (1.0f / (F8_AS * F8_WS)) + bv[bj][0]) * gt, v1 = (acc[ai][bj][m][1] * (1.0f / (F8_AS * F8_WS)) + bv[bj][1]) * gt;
                    u32x4 w; w.x = cvt_pk_bf16(v0[0], v0[1]); w.y = cvt_pk_bf16(v0[2], v0[3]); w.z = cvt_pk_bf16(v1[0], v1[1]); w.w = cvt_pk_bf16(v1[2], v1[3]);
                    *(u32x4*)(rowp + bj * HALF) = w; } }
    }
};
}
constexpr size_t MiB = 1u << 20;
constexpr size_t WS_CTL = 0, CTL_ZERO_BYTES = 1 * MiB;
constexpr size_t WS_W_IN = 2 * MiB, WS_W_UQ = 10 * MiB, WS_W_UK = WS_W_UQ + 512 * 1024, WS_W_UV = WS_W_UK + 256 * 1024, WS_W_MQK = 11 * MiB, WS_W_BRM = 12 * MiB, WS_W_BRA = 13 * MiB,
                 WS_W_MIX = 14 * MiB, WS_W_CQ = 16 * MiB, WS_W_CK = 18 * MiB, WS_W_CV = 20 * MiB, WS_W_CO = 22 * MiB, WS_W_R = 24 * MiB, WS_W_GU = 26 * MiB, WS_W_DN = 90 * MiB;
constexpr size_t WS_GATES = 218 * MiB, WS_CS = 219 * MiB, WS_KPE = 223 * MiB, WS_MEMB = 225 * MiB, WS_KC = 233 * MiB, WS_VCT = 241 * MiB, WS_LOGITS = 249 * MiB,
                 WS_ASSIGN = 253 * MiB, WS_GATEW = WS_ASSIGN + 512 * 1024, WS_TOKPOS = 254 * MiB, WS_ROWGATE = WS_TOKPOS + 512 * 1024;
constexpr size_t WS_XB = 256 * MiB, WS_PROJ = 320 * MiB, WS_QN = 576 * MiB, WS_KVN = 592 * MiB, WS_XC = 608 * MiB, WS_QMLA = 640 * MiB, WS_KN = 688 * MiB, WS_VT = 720 * MiB,
                 WS_QKM = 752 * MiB, WS_KTM = 816 * MiB, WS_AO = 848 * MiB, WS_HRAW = 880 * MiB, WS_HM = 944 * MiB;
constexpr size_t WS_GATED = 256 * MiB, WS_V1 = 576 * MiB, WS_V1B = 704 * MiB, WS_QC = 384 * MiB, WS_PC = 448 * MiB, WS_OC = 320 * MiB, WS_V2 = 864 * MiB, WS_V2B = 256 * MiB;
constexpr size_t WS_XG = 320 * MiB, WS_ACT = 456 * MiB, WS_YB = 592 * MiB, WS_END = 992 * MiB;
static_assert((size_t)NROWS * 1024 * 2 <= 272 * MiB, "routed buffers");
static_assert(WS_ROWGATE + (size_t)NROWS * 4 <= 256 * MiB, "small buffers");
constexpr int CW_TMO = 0, CW_CNT = 64  , CW_BAR = 4096;
constexpr size_t CTL_CS1 = 64 * 1024, CTL_CB1 = 68 * 1024, CTL_CSR = 72 * 1024, CTL_CBR = 73 * 1024;
constexpr size_t CTL_STATS1 = 256 * 1024, CTL_STATS2 = 512 * 1024;

constexpr int RING_OFF = 0, RING_BYTES = 131072;
constexpr int RED_OFF = RING_BYTES;
constexpr int TST_OFF = RED_OFF + 8192;
constexpr int HIST_OFF = TST_OFF + 256, HBASE_OFF = HIST_OFF + 128;
constexpr int MISC_OFF = HBASE_OFF + 128;
constexpr int TILE_E_OFF = MISC_OFF + 128;
constexpr int LDSCTL_OFF = TST_OFF;
constexpr int LDS_BYTES = 147456;
static_assert(TILE_E_OFF + NTILES_MAX * 4 <= LDS_BYTES, "LDS map");
constexpr int NWAVES = 8;

#define LDS_WAIT() asm volatile("s_waitcnt lgkmcnt(0)" ::: "memory")
#define VM_WAIT() asm volatile("s_waitcnt vmcnt(0)" ::: "memory")

#define XB_TMO      128
#define XB_XCNT(j)  (256  + 64 * (j))
#define XB_XSUB(j)  (1280 + 64 * (j))
#define XB_XGEN(j)  (2304 + 64 * (j))
#define XB_TOP      3328
#define XB_TOPGEN   3392
#define XCD_BAR_WORDS 3456
#define XB_SPIN_CAP (1u << 18)
__device__ __forceinline__ unsigned xb_ld(unsigned* p)              { return __hip_atomic_load(p, __ATOMIC_RELAXED, __HIP_MEMORY_SCOPE_AGENT); }
__device__ __forceinline__ unsigned xb_add(unsigned* p, unsigned v) { return __hip_atomic_fetch_add(p, v, __ATOMIC_RELAXED, __HIP_MEMORY_SCOPE_AGENT); }
__device__ __forceinline__ unsigned xb_xcc_id() { return (unsigned)__builtin_amdgcn_s_getreg((3 << 11) | 20) & 0xFu; }
#define XB_SPIN(cond, bar) do { unsigned _sp = 0; while (cond) { __builtin_amdgcn_s_sleep(1); \
    if ((++_sp & 255u) == 0u) { if (xb_ld(&(bar)[XB_TMO])) break; if (_sp > XB_SPIN_CAP) { atomicAdd(&(bar)[XB_TMO], 1u); break; } } } } while (0)
struct XcdBarrier { unsigned* bar; unsigned x; volatile LAS unsigned* st; };
__device__ __forceinline__ XcdBarrier xcd_barrier_post(unsigned* bar, volatile LAS unsigned* st) {
    XcdBarrier b; b.bar = bar; b.x = xb_xcc_id(); b.st = st;
    if (threadIdx.x == 0) (void)xb_add(&bar[XB_XCNT(b.x)], 1u);
    return b;
}
__device__ __forceinline__ void xcd_barrier_complete(unsigned* bar, unsigned x, unsigned& nloc, unsigned& nx) {
    const unsigned G = gridDim.x * gridDim.y * gridDim.z;
    unsigned sum, cnt, mine, sp = 0u;
    for (;;) {
        sum = 0u; cnt = 0u; mine = 0u;
#pragma unroll
        for (unsigned j = 0; j < 16; ++j) { const unsigned c = xb_ld(&bar[XB_XCNT(j)]); sum += c; cnt += (c > 0u) ? 1u : 0u; mine = (j == x) ? c : mine; }
        if (sum == G) break;
        __builtin_amdgcn_s_sleep(1);
        if ((++sp & 255u) == 0u) { if (xb_ld(&bar[XB_TMO])) break; if (sp > XB_SPIN_CAP) { atomicAdd(&bar[XB_TMO], 1u); break; } }
    }
    nloc = mine > 0u ? mine : 1u; nx = cnt > 0u ? cnt : 1u;
}
__device__ __forceinline__ void xcd_barrier(const XcdBarrier& b) {
    asm volatile("s_waitcnt vmcnt(0)" ::: "memory");
    __syncthreads();
    if (threadIdx.x == 0) {
        unsigned* bar = b.bar;
        __builtin_amdgcn_s_waitcnt(0);
        unsigned nloc = b.st[0], nx = b.st[1];
        if (nloc == 0u) { xcd_barrier_complete(bar, b.x, nloc, nx); b.st[0] = nloc; b.st[1] = nx; }
        const unsigned old = xb_add(&bar[XB_XSUB(b.x)], 1u);
        const unsigned gen = old / nloc;
        if (old + 1u == (gen + 1u) * nloc) {
            __builtin_amdgcn_fence(__ATOMIC_RELEASE, "agent");
            asm volatile("s_waitcnt vmcnt(0)" ::: "memory");
            const unsigned og = xb_add(&bar[XB_TOP], 1u);
            const unsigned tg = og / nx;
            if (og + 1u == (tg + 1u) * nx) xb_add(&bar[XB_TOPGEN], 1u);
            else XB_SPIN(xb_ld(&bar[XB_TOPGEN]) == tg, bar);
            __builtin_amdgcn_fence(__ATOMIC_ACQUIRE, "agent");
            xb_add(&bar[XB_XGEN(b.x)], 1u);
            asm volatile("s_waitcnt vmcnt(0)" ::: "memory");
        } else {
            XB_SPIN(xb_ld(&bar[XB_XGEN(b.x)]) == gen, bar);
            __builtin_amdgcn_fence(__ATOMIC_ACQUIRE, "agent");
            asm volatile("s_waitcnt vmcnt(0)" ::: "memory");
        }
    }
    __syncthreads();
}

struct Args { const void* in[34]; float* out; unsigned char* ws; int ph_lo, ph_hi; };

DI void tr_item(const float* W, int ldw, int kvalid, bf16_t* WT, int ldk, int n0, int k0, int sc, LAS float* scr, int lane, const float* rs = nullptr) {
#pragma unroll 8
    for (int i = 0; i < 32; ++i) { const int kk = 2 * i + (lane >> 5); const int k = k0 + kk;
        float v = 0.f; if (sc >= 0 && k < kvalid) { v = W[(size_t)k * ldw + sc]; if (rs) v *= rs[k]; }
        scr[kk * 33 + (lane & 31)] = v; }
    LDS_WAIT(); asm volatile("" ::: "memory");
    const int c = lane & 7;
#pragma unroll
    for (int j = 0; j < 4; ++j) { const int n = (lane >> 3) + 8 * j; const LAS float* s = scr + (8 * c) * 33 + n;
        u32x4 o; o.x = pk2(s[0 * 33], s[1 * 33]); o.y = pk2(s[2 * 33], s[3 * 33]); o.z = pk2(s[4 * 33], s[5 * 33]); o.w = pk2(s[6 * 33], s[7 * 33]);
        *(GAS u32x4*)(WT + (size_t)(n0 + n) * ldk + k0 + 8 * c) = o; }
    LDS_WAIT(); asm volatile("" ::: "memory");
}

DI void tr_item_v4(const float* W, int ldw, bf16_t* WT, int ldk, int n0, int k0, int c0, LAS float* scr, int lane, const float* rs = nullptr) {
    const int kr = lane >> 3, n4 = lane & 7;
    f32x4 v[8];
#pragma unroll
    for (int i = 0; i < 8; ++i) v[i] = *(const f32x4*)(W + (size_t)(k0 + i * 8 + kr) * ldw + c0 + 4 * n4);
    if (rs) {
#pragma unroll
        for (int i = 0; i < 8; ++i) v[i] = v[i] * rs[k0 + i * 8 + kr]; }
#pragma unroll
    for (int i = 0; i < 8; ++i) { LAS float* p = scr + (i * 8 + kr) * 33 + 4 * n4; p[0] = v[i][0]; p[1] = v[i][1]; p[2] = v[i][2]; p[3] = v[i][3]; }
    LDS_WAIT(); asm volatile("" ::: "memory");
    const int c = lane & 7;
#pragma unroll
    for (int j = 0; j < 4; ++j) { const int n = (lane >> 3) + 8 * j; const LAS float* s = scr + (8 * c) * 33 + n;
        u32x4 o; o.x = pk2(s[0 * 33], s[1 * 33]); o.y = pk2(s[2 * 33], s[3 * 33]); o.z = pk2(s[4 * 33], s[5 * 33]); o.w = pk2(s[6 * 33], s[7 * 33]);
        *(GAS u32x4*)(WT + (size_t)(n0 + n) * ldk + k0 + 8 * c) = o; }
    LDS_WAIT(); asm volatile("" ::: "memory");
}

DI void tr_item_v4_fp8(const float* W, int ldw, unsigned char* WT, int ldk, int n0, int k0, int c0, float sc, LAS float* scr, int lane) {
    const int kr = lane >> 3, n4 = lane & 7;
    f32x4 v[8];
#pragma unroll
    for (int i = 0; i < 8; ++i) v[i] = *(const f32x4*)(W + (size_t)(k0 + i * 8 + kr) * ldw + c0 + 4 * n4);
#pragma unroll
    for (int i = 0; i < 8; ++i) { LAS float* p = scr + (i * 8 + kr) * 33 + 4 * n4; p[0] = v[i][0] * sc; p[1] = v[i][1] * sc; p[2] = v[i][2] * sc; p[3] = v[i][3] * sc; }
    LDS_WAIT(); asm volatile("" ::: "memory");
    const int c = lane & 7;
#pragma unroll
    for (int j = 0; j < 4; ++j) { const int n = (lane >> 3) + 8 * j; const LAS float* s = scr + (8 * c) * 33 + n;
        u32x2 o; o.x = pg8::pk4_fp8(s[0 * 33], s[1 * 33], s[2 * 33], s[3 * 33]); o.y = pg8::pk4_fp8(s[4 * 33], s[5 * 33], s[6 * 33], s[7 * 33]);
        *(GAS u32x2*)(WT + (size_t)(n0 + n) * ldk + k0 + 8 * c) = o; }
    LDS_WAIT(); asm volatile("" ::: "memory");
}
DI int win_src(int n) {
    if (n < 384) return n;
    if (n < 416) { const int i = (n - 384) >> 1; return 384 + i + 16 * ((n - 384) & 1); }
    if (n < 424) return 1952 + (n - 416);
    if (n < 512) return -1;
    if (n < 2048) return 416 + (n - 512);
    return 1960 + (n - 2048);
}
DI void p0_prologue(const Args& args, LAS unsigned char* lds, int vcu, int G) {
    int tid_ = threadIdx.x; asm volatile("" : "+v"(tid_)); const int lane = tid_ & 63; const int wave = __builtin_amdgcn_readfirstlane(tid_ >> 6);
    LAS float* scr = (LAS float*)(lds + RING_OFF + wave * 16384);
    const int gw = vcu * NWAVES + wave, NGW = G * NWAVES;
    unsigned char* ws = args.ws;
    const int j = lane & 31;
    constexpr int I_IN = 16 * 128, I_UQ = 4 * 24, I_UK = 4 * 16, I_UV = 4 * 16, I_MQK = 8 * 32, I_BRM = 8 * 32, I_BRA = 8 * 32, I_SQ = 16 * 32, I_R = 16 * 8,
                  I_GU = NE * 16 * 64, I_DN = NE * 16 * 32;
    constexpr int NITEMS = I_IN + I_UQ + I_UK + I_UV + I_MQK + I_BRM + I_BRA + 5 * I_SQ + I_R + I_GU + I_DN;
    for (int it = gw; it < 33 * 8; it += NGW) { const int grp = it >> 3, kc = it & 7; const bool rt = (grp == 32);
        const float* W = (const float*)args.in[rt ? 26 : 21]; const int ldw = rt ? NE : 1024; const int col = (rt ? 0 : grp * 32) + (lane & 31);
        const float* gv = (const float*)args.in[rt ? 24 : 19]; const float* bv = (const float*)args.in[rt ? 25 : 20];
        float as = 0.f, ab = 0.f;
#pragma unroll 8
        for (int i = 0; i < 64; ++i) { const int k = kc * 128 + 2 * i + (lane >> 5); const float w = W[(size_t)k * ldw + col]; as += bf2f((unsigned short)f2bf(gv[k] * w)); ab += bv[k] * w; }
        as += __shfl_xor(as, 32); ab += __shfl_xor(ab, 32);
        if (lane < 32) { float* csd = (float*)(ws + (rt ? CTL_CSR : CTL_CS1)) + col; float* cbd = (float*)(ws + (rt ? CTL_CBR : CTL_CB1)) + col;
            __hip_atomic_fetch_add(csd, as, RLX_AGENT); __hip_atomic_fetch_add(cbd, ab, RLX_AGENT); } }
    for (int it = gw; it < NITEMS; it += NGW) {
        int r = it;
        if (r < I_GU) { const int e = r / (16 * 64), q = r % (16 * 64), kb = q / 64, nb = q % 64;
            tr_item_v4_fp8((const float*)args.in[28] + (size_t)e * 1024 * 2048, 2048, ws + WS_W_GU + (size_t)e * 2048 * 1024, 1024, nb * 32, kb * 64, nb * 32, pg8::F8_WS, scr, lane); continue; } r -= I_GU;
        if (r < I_DN) { const int e = r / (16 * 32), q = r % (16 * 32), kb = q / 32, nb = q % 32;
            tr_item_v4_fp8((const float*)args.in[30] + (size_t)e * 1024 * 1024, 1024, ws + WS_W_DN + (size_t)e * 1024 * 1024, 1024, nb * 32, kb * 64, nb * 32, pg8::F8_WS, scr, lane); continue; } r -= I_DN;
        if (r < I_IN) { const int kb = r / 128, nb = r % 128;
            tr_item((const float*)args.in[3], DIN, 1024, (bf16_t*)(ws + WS_W_IN), 1024, nb * 32, kb * 64, win_src(nb * 32 + j), scr, lane); continue; } r -= I_IN;
        if (r < I_UQ) { const int kb = r / 24, nb = r % 24; const int n = nb * 32 + j, hh = n / AQK, cc = n % AQK;
            const int sc = (cc < ANOPE) ? n : hh * AQK + ANOPE + ((cc - ANOPE) >> 1) + 16 * ((cc - ANOPE) & 1);
            tr_item((const float*)args.in[14], AH * AQK, 256, (bf16_t*)(ws + WS_W_UQ), 256, nb * 32, kb * 64, sc, scr, lane); continue; } r -= I_UQ;
        if (r < I_UK) { const int kb = r / 16, nb = r % 16; const int n = nb * 32 + j;
            tr_item((const float*)args.in[15], 1024, 128, (bf16_t*)(ws + WS_W_UK), 256, nb * 32, kb * 64, (n >> 6) * 128 + (n & 63), scr, lane); continue; } r -= I_UK;
        if (r < I_UV) { const int kb = r / 16, nb = r % 16; const int n = nb * 32 + j;
            tr_item((const float*)args.in[15], 1024, 128, (bf16_t*)(ws + WS_W_UV), 256, nb * 32, kb * 64, (n >> 6) * 128 + 64 + (n & 63), scr, lane); continue; } r -= I_UV;
        if (r < I_MQK) { const int kb = r / 32, nb = r % 32; const int n = nb * 32 + j, part = n >> 9, hh = (n >> 7) & 3, e = n & 127;
            const float* src = (const float*)args.in[part ? 9 : 8];
            tr_item(src, 128, 512, (bf16_t*)(ws + WS_W_MQK), 512, nb * 32, kb * 64, ((kb >> 1) == hh) ? e : -1, scr, lane); continue; } r -= I_MQK;
        if (r < I_BRM) { const int kb = r / 32, nb = r % 32;
            tr_item_v4((const float*)args.in[16], 1024, (bf16_t*)(ws + WS_W_BRM), 512, nb * 32, kb * 64, nb * 32, scr, lane); continue; } r -= I_BRM;
        if (r < I_BRA) { const int kb = r / 32, nb = r % 32;
            tr_item_v4((const float*)args.in[17], 1024, (bf16_t*)(ws + WS_W_BRA), 512, nb * 32, kb * 64, nb * 32, scr, lane); continue; } r -= I_BRA;
        if (r < 5 * I_SQ) { const int w = r / I_SQ, q = r % I_SQ, kb = q / 32, nb = q % 32;
            const float* src; int ldw, coff; bf16_t* dst; const float* rs = nullptr;
            if (w == 0) { src = (const float*)args.in[18]; ldw = 1024; coff = 0; dst = (bf16_t*)(ws + WS_W_MIX); }
            else if (w == 1) { src = (const float*)args.in[21]; ldw = 1024; coff = 0; dst = (bf16_t*)(ws + WS_W_CQ); rs = (const float*)args.in[19]; }
            else if (w == 2) { src = (const float*)args.in[22]; ldw = 2048; coff = 0; dst = (bf16_t*)(ws + WS_W_CK); }
            else if (w == 3) { src = (const float*)args.in[22]; ldw = 2048; coff = 1024; dst = (bf16_t*)(ws + WS_W_CV); }
            else { src = (const float*)args.in[23]; ldw = 1024; coff = 0; dst = (bf16_t*)(ws + WS_W_CO); }
            tr_item_v4(src, ldw, dst, 1024, nb * 32, kb * 64, coff + nb * 32, scr, lane, rs); continue; } r -= 5 * I_SQ;
        { const int kb = r / 8, nb = r % 8; const int n = nb * 32 + j;
            tr_item((const float*)args.in[26], NE, 1024, (bf16_t*)(ws + WS_W_R), 1024, nb * 32, kb * 64, (n < NE) ? n : -1, scr, lane, (const float*)args.in[24]); }
    }
    const size_t gt = (size_t)gw * 64 + lane, NT_ = (size_t)NGW * 64;
    { const float* x = (const float*)args.in[0]; bf16_t* xb = (bf16_t*)(ws + WS_XB);
      for (size_t i = gt; i < (size_t)T * D / 8; i += NT_) { const f32x4 a = *(const f32x4*)(x + i * 8), b = *(const f32x4*)(x + i * 8 + 4);
          u32x4 o; o.x = pk2(a[0], a[1]); o.y = pk2(a[2], a[3]); o.z = pk2(b[0], b[1]); o.w = pk2(b[2], b[3]); *(u32x4*)(xb + i * 8) = o; } }
    { const float* x = (const float*)args.in[1]; bf16_t* xb = (bf16_t*)(ws + WS_MEMB);
      for (size_t i = gt; i < (size_t)NB * NMEM * D / 8; i += NT_) { const f32x4 a = *(const f32x4*)(x + i * 8), b = *(const f32x4*)(x + i * 8 + 4);
          u32x4 o; o.x = pk2(a[0], a[1]); o.y = pk2(a[2], a[3]); o.z = pk2(b[0], b[1]); o.w = pk2(b[2], b[3]); *(u32x4*)(xb + i * 8) = o; } }
}

DI void p2_tokens(const Args& args, int vcu, int G) {
    int tid_ = threadIdx.x; asm volatile("" : "+v"(tid_)); const int lane = tid_ & 63; const int wave = __builtin_amdgcn_readfirstlane(tid_ >> 6);
    unsigned char* ws = args.ws;
    const bf16_t* proj = (const bf16_t*)(ws + WS_PROJ);
    bf16_t* qn = (bf16_t*)(ws + WS_QN); bf16_t* kvn = (bf16_t*)(ws + WS_KVN); bf16_t* kpe = (bf16_t*)(ws + WS_KPE); bf16_t* xc = (bf16_t*)(ws + WS_XC); float* cs = (float*)(ws + WS_CS);
    const int* positions = (const int*)args.in[2];
    const float* conv_w = (const float*)args.in[6]; const float* conv_b = (const float*)args.in[7];
    const float* g_qlat = (const float*)args.in[12]; const float* g_kvlat = (const float*)args.in[13];
    const int gw = vcu * NWAVES + wave, NGW = G * NWAVES;
    float cw[4][8], cb[8];
#pragma unroll
    for (int jj = 0; jj < 4; ++jj)
#pragma unroll
        for (int c = 0; c < 8; ++c) cw[jj][c] = conv_w[jj * MW + 8 * lane + c];
#pragma unroll
    for (int c = 0; c < 8; ++c) cb[c] = conv_b[8 * lane + c];
    const f32x4 gq = *(const f32x4*)(g_qlat + 4 * lane);
    const f32x2 gk = *(const f32x2*)(g_kvlat + 2 * lane);
    const float inv_freq = exp2f(-(float)(lane & 15) * (13.287712379549449f / 16.0f));
    for (int t = gw; t < T; t += NGW) {
        const bf16_t* pr = proj + (size_t)t * NPROJ;
        { const u32x2 w = *(const u32x2*)(pr + PC_QLAT + 4 * lane); const float a0 = bflo(w.x), a1 = bfhi(w.x), a2 = bflo(w.y), a3 = bfhi(w.y);
          const float ss = wave_sum(a0 * a0 + a1 * a1 + a2 * a2 + a3 * a3); const float r = 1.0f / sqrtf(ss * (1.0f / AQR) + EPS);
          u32x2 o; o.x = pk2(a0 * r * gq[0], a1 * r * gq[1]); o.y = pk2(a2 * r * gq[2], a3 * r * gq[3]); *(u32x2*)(qn + (size_t)t * 256 + 4 * lane) = o; }
        { const unsigned w = *(const unsigned*)(pr + PC_KVLAT + 2 * lane); const float a0 = bflo(w), a1 = bfhi(w);
          const float ss = wave_sum(a0 * a0 + a1 * a1); const float r = 1.0f / sqrtf(ss * (1.0f / AKVR) + EPS);
          *(unsigned*)(kvn + (size_t)t * 256 + 2 * lane) = pk2(a0 * r * gk[0], a1 * r * gk[1]); *(unsigned*)(kvn + (size_t)t * 256 + 128 + 2 * lane) = 0u; }
        if (lane < 16) { const unsigned w = *(const unsigned*)(pr + PC_KROPE + 2 * lane); const float x1 = bflo(w), x2 = bfhi(w);
          const float ang = (float)positions[t] * inv_freq;
          const double rev = (double)ang * 0.15915494309189535; const float fr = (float)(rev - __builtin_rint(rev));
          const float cc = __builtin_amdgcn_cosf(fr), sn = __builtin_amdgcn_sinf(fr);
          *(unsigned*)(kpe + (size_t)t * 32 + 2 * lane) = pk2(x1 * cc - x2 * sn, x2 * cc + x1 * sn);
          *(f32x2*)(cs + (size_t)t * 32 + 2 * lane) = (f32x2){cc, sn}; }
        { const int s = t & (SEQ - 1); float a[8];
#pragma unroll
          for (int c = 0; c < 8; ++c) a[c] = cb[c];
#pragma unroll
          for (int jj = 0; jj < 4; ++jj) { const int back = 3 - jj; if (s - back >= 0) { const u32x4 w = *(const u32x4*)(pr - (size_t)back * NPROJ + PC_XM + 8 * lane);
              a[0] += cw[jj][0] * bflo(w.x); a[1] += cw[jj][1] * bfhi(w.x); a[2] += cw[jj][2] * bflo(w.y); a[3] += cw[jj][3] * bfhi(w.y);
              a[4] += cw[jj][4] * bflo(w.z); a[5] += cw[jj][5] * bfhi(w.z); a[6] += cw[jj][6] * bflo(w.w); a[7] += cw[jj][7] * bfhi(w.w); } }
#pragma unroll
          for (int c = 0; c < 8; ++c) a[c] = a[c] * sigmoidf_(a[c]);
          u32x4 o; o.x = pk2(a[0], a[1]); o.y = pk2(a[2], a[3]); o.z = pk2(a[4], a[5]); o.w = pk2(a[6], a[7]); *(u32x4*)(xc + (size_t)t * MW + 8 * lane) = o; }
    }
}

DI void p6_mpost(const Args& args, int vcu, int G) {
    int tid_ = threadIdx.x; asm volatile("" : "+v"(tid_)); const int lane = tid_ & 63; const int wave = __builtin_amdgcn_readfirstlane(tid_ >> 6);
    unsigned char* ws = args.ws;
    const float* hraw = (const float*)(ws + WS_HRAW); const bf16_t* xc = (const bf16_t*)(ws + WS_XC); const bf16_t* proj = (const bf16_t*)(ws + WS_PROJ); bf16_t* hm = (bf16_t*)(ws + WS_HM);
    const float* g_mhead = (const float*)args.in[10]; const float* w_mskip = (const float*)args.in[11];
    const int gw = vcu * NWAVES + wave, NGW = G * NWAVES;
    float gm[8], wsk[8];
#pragma unroll
    for (int c = 0; c < 8; ++c) { gm[c] = g_mhead[8 * lane + c]; wsk[c] = w_mskip[8 * lane + c]; }
    for (int t = gw; t < T; t += NGW) {
        const f32x4 h0 = *(const f32x4*)(hraw + (size_t)t * MW + 8 * lane), h1 = *(const f32x4*)(hraw + (size_t)t * MW + 8 * lane + 4);
        float h[8] = {h0[0], h0[1], h0[2], h0[3], h1[0], h1[1], h1[2], h1[3]};
        float s = 0.f;
#pragma unroll
        for (int c = 0; c < 8; ++c) s += h[c];
        s += __shfl_xor(s, 1); s += __shfl_xor(s, 2); s += __shfl_xor(s, 4); s += __shfl_xor(s, 8);
        const float mu = s * (1.0f / MHD); float q = 0.f;
#pragma unroll
        for (int c = 0; c < 8; ++c) { h[c] -= mu; q += h[c] * h[c]; }
        q += __shfl_xor(q, 1); q += __shfl_xor(q, 2); q += __shfl_xor(q, 4); q += __shfl_xor(q, 8);
        const float rstd = 1.0f / sqrtf(q * (1.0f / MHD) + EPS);
        const u32x4 xw = *(const u32x4*)(xc + (size_t)t * MW + 8 * lane); const u32x4 ow = *(const u32x4*)(proj + (size_t)t * NPROJ + PC_OP + 8 * lane);
        const float xv[8] = {bflo(xw.x), bfhi(xw.x), bflo(xw.y), bfhi(xw.y), bflo(xw.z), bfhi(xw.z), bflo(xw.w), bfhi(xw.w)};
        const float ov[8] = {bflo(ow.x), bfhi(ow.x), bflo(ow.y), bfhi(ow.y), bflo(ow.z), bfhi(ow.z), bflo(ow.w), bfhi(ow.w)};
        float o[8];
#pragma unroll
        for (int c = 0; c < 8; ++c) o[c] = sigmoidf_(ov[c]) * (h[c] * rstd * gm[c] + wsk[c] * xv[c]);
        u32x4 w; w.x = pk2(o[0], o[1]); w.y = pk2(o[2], o[3]); w.z = pk2(o[4], o[5]); w.w = pk2(o[6], o[7]); *(u32x4*)(hm + (size_t)t * MW + 8 * lane) = w;
    }
}

DI void ln_pass(const float* res, const float* add, const float* g, const float* b, float* out, bf16_t* outb, int vcu, int G) {
    int tid_ = threadIdx.x; asm volatile("" : "+v"(tid_)); const int lane = tid_ & 63; const int wave = __builtin_amdgcn_readfirstlane(tid_ >> 6);
    const int gw = vcu * NWAVES + wave, NGW = G * NWAVES;
    for (int t = gw; t < T; t += NGW) {
        f32x4 v[4]; float s = 0.f;
#pragma unroll
        for (int j = 0; j < 4; ++j) { const f32x4 r = *(const f32x4*)(res + (size_t)t * D + 4 * lane + 256 * j), a = *(const f32x4*)(add + (size_t)t * D + 4 * lane + 256 * j);
            v[j] = r * DN_ALPHA + a; s += (v[j][0] + v[j][1]) + (v[j][2] + v[j][3]); }
        const float mean = wave_sum(s) * (1.0f / D); float q = 0.f;
#pragma unroll
        for (int j = 0; j < 4; ++j) { v[j] = v[j] - mean; q += (v[j][0] * v[j][0] + v[j][1] * v[j][1]) + (v[j][2] * v[j][2] + v[j][3] * v[j][3]); }
        const float rstd = 1.0f / sqrtf(wave_sum(q) * (1.0f / D) + EPS);
#pragma unroll
        for (int j = 0; j < 4; ++j) { const f32x4 gg = *(const f32x4*)(g + 4 * lane + 256 * j), bb = *(const f32x4*)(b + 4 * lane + 256 * j);
            const f32x4 y = v[j] * rstd * gg + bb;
            *(f32x4*)(out + (size_t)t * D + 4 * lane + 256 * j) = y;
            if (outb) { u32x2 w; w.x = pk2(y[0], y[1]); w.y = pk2(y[2], y[3]); *(u32x2*)(outb + (size_t)t * D + 4 * lane + 256 * j) = w; } }
    }
}

DI void p16_topk(const Args& args, LAS unsigned char* lds, int vcu, int G) {
    unsigned char* ws = args.ws;
    const float* logits = (const float*)(ws + WS_LOGITS); const float* b_router = (const float*)args.in[27];
    int* assign = (int*)(ws + WS_ASSIGN); float* gatew = (float*)(ws + WS_GATEW);
    unsigned* gcnt = (unsigned*)(ws + WS_CTL) + CW_CNT;
    LAS unsigned* hist = (LAS unsigned*)(lds + HIST_OFF); LAS unsigned* hbase = (LAS unsigned*)(lds + HBASE_OFF);
    int tid = threadIdx.x; asm volatile("" : "+v"(tid));
    for (int blk = vcu; blk < T / 512; blk += G) {
        const int t = blk * 512 + tid;
        float v[NE];
#pragma unroll
        for (int j = 0; j < NE / 4; ++j) { const f32x4 a = *(const f32x4*)(logits + (size_t)t * NE + 4 * j), bb = *(const f32x4*)(b_router + 4 * j);
            v[4 * j] = a[0] + bb[0]; v[4 * j + 1] = a[1] + bb[1]; v[4 * j + 2] = a[2] + bb[2]; v[4 * j + 3] = a[3] + bb[3]; }
        int idx[TOPK]; float val[TOPK];
#pragma unroll
        for (int k = 0; k < TOPK; ++k) { float best = -INFINITY; int bi = 0;
#pragma unroll
            for (int e = 0; e < NE; ++e) { bool taken = false;
#pragma unroll
                for (int kk = 0; kk < k; ++kk) taken = taken || (idx[kk] == e);
                if (!taken && v[e] > best) { best = v[e]; bi = e; } }
            idx[k] = bi; val[k] = best; }
        float ex[TOPK], sum = 0.f;
#pragma unroll
        for (int k = 0; k < TOPK; ++k) { ex[k] = __expf(val[k] - val[0]); sum += ex[k]; }
        const float inv = 1.0f / sum;
        if (tid < NE) hist[tid] = 0u;
        __syncthreads();
        unsigned lr[TOPK];
#pragma unroll
        for (int k = 0; k < TOPK; ++k) lr[k] = __hip_atomic_fetch_add(hist + idx[k], 1u, __ATOMIC_RELAXED, __HIP_MEMORY_SCOPE_WORKGROUP);
        __syncthreads();
        if (tid < NE) hbase[tid] = __hip_atomic_fetch_add(gcnt + tid, hist[tid], RLX_AGENT);
        __syncthreads();
#pragma unroll
        for (int k = 0; k < TOPK; ++k) { assign[(size_t)t * TOPK + k] = (idx[k] << 20) | (int)(hbase[idx[k]] + lr[k]); gatew[(size_t)t * TOPK + k] = ex[k] * inv; }
        __syncthreads();
    }
}
DI void build_tstart(const Args& args, LAS unsigned char* lds) {
    const unsigned* gcnt = (const unsigned*)(args.ws + WS_CTL) + CW_CNT; LAS int* tst = (LAS int*)(lds + TST_OFF); LAS int* tile_e = (LAS int*)(lds + TILE_E_OFF);
    if (threadIdx.x == 0) { int acc = 0;
        for (int e = 0; e < NE; ++e) { tst[e] = acc; const unsigned c = __hip_atomic_load(gcnt + e, RLX_AGENT); acc += (int)((c + 255u) >> 8); }
        tst[NE] = acc; }
    __syncthreads();
    for (int t = threadIdx.x; t < tst[NE]; t += NWAVES * 64) { int e = 0;
        for (int j = 1; j < NE; ++j) e += (tst[j] <= t) ? 1 : 0;
        tile_e[t] = e; }
    __syncthreads();
}
DI void p17_gather(const Args& args, LAS unsigned char* lds, int vcu, int G) {
    int tid_ = threadIdx.x; asm volatile("" : "+v"(tid_)); const int lane = tid_ & 63; const int wave = __builtin_amdgcn_readfirstlane(tid_ >> 6);
    unsigned char* ws = args.ws;
    build_tstart(args, lds);
    const LAS int* tst = (const LAS int*)(lds + TST_OFF);
    const unsigned* gcnt = (const unsigned*)(ws + WS_CTL) + CW_CNT;
    const int* assign = (const int*)(ws + WS_ASSIGN); const float* gatew = (const float*)(ws + WS_GATEW);
    int* tokpos = (int*)(ws + WS_TOKPOS); float* rowgate = (float*)(ws + WS_ROWGATE);
    const float* v2 = (const float*)(ws + WS_V2); const float* stats2 = (const float*)(ws + CTL_STATS2); unsigned char* xg = ws + WS_XG;
    const int gw = vcu * NWAVES + wave, NGW = G * NWAVES;
    f32x4 g2[4], b2[4];
#pragma unroll
    for (int j = 0; j < 4; ++j) { g2[j] = *(const f32x4*)((const float*)args.in[24] + 16 * lane + 4 * j) * pg8::F8_XS; b2[j] = *(const f32x4*)((const float*)args.in[25] + 16 * lane + 4 * j) * pg8::F8_XS; }
    for (int t = gw; t < T; t += NGW) {
        float mean, rstd; pg8::row_stats(stats2, t, mean, rstd);
        u32x4 o;
#pragma unroll
        for (int j = 0; j < 4; ++j) { const f32x4 x = (*(const f32x4*)(v2 + (size_t)t * D + 16 * lane + 4 * j) - mean) * rstd * g2[j] + b2[j]; o[j] = pg8::pk4_fp8(x[0], x[1], x[2], x[3]); }
#pragma unroll
        for (int k = 0; k < TOPK; ++k) { const int as = assign[(size_t)t * TOPK + k]; const int e = as >> 20, rank = as & 0xfffff; const int pos = tst[e] * 256 + rank;
            *(u32x4*)(xg + (size_t)pos * D + 16 * lane) = o;
            if (lane == 0) { tokpos[(size_t)t * TOPK + k] = pos; rowgate[pos] = gatew[(size_t)t * TOPK + k]; } }
    }
    for (int idx = gw; idx < NE * 256; idx += NGW) { const int e = idx >> 8, r = idx & 255; const int row = tst[e] * 256 + (int)__hip_atomic_load(gcnt + e, RLX_AGENT) + r;
        if (row < tst[e + 1] * 256) { const u32x4 z = {0u, 0u, 0u, 0u}; *(u32x4*)(xg + (size_t)row * D + 16 * lane) = z; if (lane == 0) rowgate[row] = 0.f; } }
}
DI void p20_final(const Args& args, int vcu, int G) {
    int tid_ = threadIdx.x; asm volatile("" : "+v"(tid_)); const int lane = tid_ & 63; const int wave = __builtin_amdgcn_readfirstlane(tid_ >> 6);
    unsigned char* ws = args.ws;
    const int* tokpos = (const int*)(ws + WS_TOKPOS); const bf16_t* yb = (const bf16_t*)(ws + WS_YB);
    const float* v2 = (const float*)(ws + WS_V2); const float* stats2 = (const float*)(ws + CTL_STATS2);
    const float* g2 = (const float*)args.in[24]; const float* b2 = (const float*)args.in[25];
    const float* g = (const float*)args.in[32]; const float* b = (const float*)args.in[33]; float* out = args.out;
    const int gw = vcu * NWAVES + wave, NGW = G * NWAVES;
    for (int t = gw; t < T; t += NGW) {
        int pos[TOPK];
#pragma unroll
        for (int k = 0; k < TOPK; ++k) pos[k] = tokpos[(size_t)t * TOPK + k];
        float mean2, rstd2; pg8::row_stats(stats2, t, mean2, rstd2);
        f32x4 v[4]; float s = 0.f;
#pragma unroll
        for (int j = 0; j < 4; ++j) { const f32x4 r = (*(const f32x4*)(v2 + (size_t)t * D + 4 * lane + 256 * j) - mean2) * rstd2 * *(const f32x4*)(g2 + 4 * lane + 256 * j) + *(const f32x4*)(b2 + 4 * lane + 256 * j);
            f32x4 a = {0.f, 0.f, 0.f, 0.f};
#pragma unroll
            for (int k = 0; k < TOPK; ++k) { const u32x2 w = *(const u32x2*)(yb + (size_t)pos[k] * D + 4 * lane + 256 * j); a[0] += bflo(w.x); a[1] += bfhi(w.x); a[2] += bflo(w.y); a[3] += bfhi(w.y); }
            v[j] = r * DN_ALPHA + a; s += (v[j][0] + v[j][1]) + (v[j][2] + v[j][3]); }
        const float mean = wave_sum(s) * (1.0f / D); float q = 0.f;
#pragma unroll
        for (int j = 0; j < 4; ++j) { v[j] = v[j] - mean; q += (v[j][0] * v[j][0] + v[j][1] * v[j][1]) + (v[j][2] * v[j][2] + v[j][3] * v[j][3]); }
        const float rstd = 1.0f / sqrtf(wave_sum(q) * (1.0f / D) + EPS);
#pragma unroll
        for (int j = 0; j < 4; ++j) { const f32x4 gg = *(const f32x4*)(g + 4 * lane + 256 * j), bb = *(const f32x4*)(b + 4 * lane + 256 * j);
            *(f32x4*)(out + (size_t)t * D + 4 * lane + 256 * j) = v[j] * rstd * gg + bb; }
    }
}
constexpr int AT_KROW = 208, AT_VROW = 136;
constexpr int AT_KBUF = 64 * AT_KROW, AT_VBUF = 64 * AT_VROW, AT_VOFF = 2 * AT_KBUF;
DI void mla_unit(int b, int h, int qb, const bf16_t* Q, const bf16_t* Kn, const bf16_t* Kpe, const bf16_t* Vt, bf16_t* O, LAS unsigned char* lds) {
    int tid = threadIdx.x; asm volatile("" : "+v"(tid)); const int lane = tid & 63, r32 = lane & 31, hi = lane >> 5; const int wid = __builtin_amdgcn_readfirstlane(tid >> 6);
    const int q0 = qb * 256 + wid * 32;
    const int qi = q0 + r32;
    const size_t tokb = (size_t)b * SEQ;
    bf16x8 qf[6];
    { const bf16_t* qp = Q + (tokb + qi) * (AH * AQK) + h * AQK + 8 * hi;
#pragma unroll
      for (int s = 0; s < 6; ++s) qf[s] = *(const bf16x8*)(qp + 16 * s); }
    const int kkey = tid >> 3, kch = tid & 7, pkey = (tid & 255) >> 2, pch = tid & 3, vd = tid >> 3, vch = tid & 7;
    const bf16_t* ksrc = Kn + (tokb + kkey) * 512 + h * 64 + kch * 8;
    const bf16_t* psrc = Kpe + (tokb + pkey) * 32 + pch * 8;
    const bf16_t* vsrc = Vt + (size_t)(h * 64 + vd) * T + tokb + vch * 8;
    const int kdst = kkey * AT_KROW + kch * 16, pdst = pkey * AT_KROW + 128 + pch * 16, vdst = AT_VOFF + vd * AT_VROW + vch * 16;
    const int nkt = 4 * (qb + 1);
    u32x4 rk, rp, rv;
    rk = *(const u32x4*)ksrc; rv = *(const u32x4*)vsrc; rp = (u32x4){0u, 0u, 0u, 0u}; if (tid < 256) rp = *(const u32x4*)psrc;
    *(LAS u32x4*)(lds + kdst) = rk; if (tid < 256) *(LAS u32x4*)(lds + pdst) = rp;
    *(LAS u32x2*)(lds + vdst) = (u32x2){rv.x, rv.y}; *(LAS u32x2*)(lds + vdst + 8) = (u32x2){rv.z, rv.w};
    __syncthreads();
    float m_run = -INFINITY, l_run = 0.f;
    f32x16 o0, o1;
#pragma unroll
    for (int r = 0; r < 16; ++r) { o0[r] = 0.f; o1[r] = 0.f; }
    for (int kt = 0; kt < nkt; ++kt) {
        const int buf = kt & 1;
        if (kt + 1 < nkt) { rk = *(const u32x4*)(ksrc + (size_t)(kt + 1) * 64 * 512); rv = *(const u32x4*)(vsrc + (kt + 1) * 64); if (tid < 256) rp = *(const u32x4*)(psrc + (size_t)(kt + 1) * 64 * 32); }
        const int key0 = kt * 64;
        if (key0 <= q0 + 31) {
            const LAS unsigned char* kb = lds + buf * AT_KBUF + r32 * AT_KROW + hi * 16;
            f32x16 p0, p1;
#pragma unroll
            for (int r = 0; r < 16; ++r) { p0[r] = 0.f; p1[r] = 0.f; }
#pragma unroll
            for (int s = 0; s < 6; ++s) { const bf16x8 a0 = *(const LAS bf16x8*)(kb + s * 32), a1 = *(const LAS bf16x8*)(kb + 32 * AT_KROW + s * 32);
                p0 = MFMA32(a0, qf[s], p0); p1 = MFMA32(a1, qf[s], p1); }
            if (key0 + 63 > q0) {
#pragma unroll
                for (int r = 0; r < 16; ++r) { const int key = key0 + crow(r, hi); if (key > qi) p0[r] = -INFINITY; if (key + 32 > qi) p1[r] = -INFINITY; }
            }
            float mx = fmaxf(p0[0], p1[0]);
#pragma unroll
            for (int r = 1; r < 16; ++r) mx = fmaxf(mx, fmaxf(p0[r], p1[r]));
            mx = fmaxf(mx, __shfl_xor(mx, 32));
            const float m_new = fmaxf(m_run, mx);
            const float alpha = __builtin_amdgcn_exp2f(m_run - m_new);
            m_run = m_new;
            float ls = 0.f;
#pragma unroll
            for (int r = 0; r < 16; ++r) { p0[r] = __builtin_amdgcn_exp2f(p0[r] - m_new); p1[r] = __builtin_amdgcn_exp2f(p1[r] - m_new); ls += p0[r] + p1[r]; }
            l_run = l_run * alpha + ls;
#pragma unroll
            for (int r = 0; r < 16; ++r) { o0[r] *= alpha; o1[r] *= alpha; }
            bf16x8 pb[4];
#pragma unroll
            for (int s = 0; s < 4; ++s) { u32x4 w;
                if (s < 2) { w.x = pk2(p0[8 * s], p0[8 * s + 1]); w.y = pk2(p0[8 * s + 2], p0[8 * s + 3]); w.z = pk2(p0[8 * s + 4], p0[8 * s + 5]); w.w = pk2(p0[8 * s + 6], p0[8 * s + 7]); }
                else { const int s2 = s - 2; w.x = pk2(p1[8 * s2], p1[8 * s2 + 1]); w.y = pk2(p1[8 * s2 + 2], p1[8 * s2 + 3]); w.z = pk2(p1[8 * s2 + 4], p1[8 * s2 + 5]); w.w = pk2(p1[8 * s2 + 6], p1[8 * s2 + 7]); }
                pb[s] = __builtin_bit_cast(bf16x8, w); }
            const LAS unsigned char* vb = lds + AT_VOFF + buf * AT_VBUF + r32 * AT_VROW + hi * 8;
#pragma unroll
            for (int s = 0; s < 4; ++s) {
                const u32x2 a0l = *(const LAS u32x2*)(vb + s * 32), a0h = *(const LAS u32x2*)(vb + s * 32 + 16);
                const u32x2 a1l = *(const LAS u32x2*)(vb + 32 * AT_VROW + s * 32), a1h = *(const LAS u32x2*)(vb + 32 * AT_VROW + s * 32 + 16);
                const bf16x8 a0 = __builtin_bit_cast(bf16x8, (u32x4){a0l.x, a0l.y, a0h.x, a0h.y}), a1 = __builtin_bit_cast(bf16x8, (u32x4){a1l.x, a1l.y, a1h.x, a1h.y});
                o0 = MFMA32(a0, pb[s], o0); o1 = MFMA32(a1, pb[s], o1); }
        }
        if (kt + 1 < nkt) { const int nb = (kt + 1) & 1;
            *(LAS u32x4*)(lds + nb * AT_KBUF + kdst) = rk; if (tid < 256) *(LAS u32x4*)(lds + nb * AT_KBUF + pdst) = rp;
            *(LAS u32x2*)(lds + nb * AT_VBUF + vdst) = (u32x2){rv.x, rv.y}; *(LAS u32x2*)(lds + nb * AT_VBUF + vdst + 8) = (u32x2){rv.z, rv.w}; }
        __syncthreads();
    }
    const float lt = l_run + __shfl_xor(l_run, 32); const float inv = 1.0f / lt;
    bf16_t* op = O + (tokb + qi) * AW + h * AVD + 4 * hi;
#pragma unroll
    for (int g = 0; g < 4; ++g) { u32x2 w0, w1;
        w0.x = pk2(o0[4 * g] * inv, o0[4 * g + 1] * inv); w0.y = pk2(o0[4 * g + 2] * inv, o0[4 * g + 3] * inv);
        w1.x = pk2(o1[4 * g] * inv, o1[4 * g + 1] * inv); w1.y = pk2(o1[4 * g + 2] * inv, o1[4 * g + 3] * inv);
        *(u32x2*)(op + 8 * g) = w0; *(u32x2*)(op + 32 + 8 * g) = w1; }
}
DI void p4_attention(const Args& args, LAS unsigned char* lds, int vcu, int G) {
    unsigned char* ws = args.ws;
    const bf16_t* Q = (const bf16_t*)(ws + WS_QMLA); const bf16_t* Kn = (const bf16_t*)(ws + WS_KN); const bf16_t* Kpe = (const bf16_t*)(ws + WS_KPE); const bf16_t* Vt = (const bf16_t*)(ws + WS_VT);
    bf16_t* O = (bf16_t*)(ws + WS_AO);
    for (int p = vcu; p < NB * AH * 4; p += G) { const int bh = p >> 2, j = p & 3; const int b = bh / AH, h = bh % AH;
        mla_unit(b, h, 7 - j, Q, Kn, Kpe, Vt, O, lds);
        mla_unit(b, h, j, Q, Kn, Kpe, Vt, O, lds); }
}

constexpr int ML_QROW = 272, ML_TROW = 144;
constexpr int ML_QS = 0, ML_KS = ML_QS + 64 * ML_QROW, ML_KTS = ML_KS + 64 * ML_QROW, ML_VTS = ML_KTS + 128 * ML_TROW, ML_CS = ML_VTS + 32 * ML_TROW, ML_SS = ML_CS + 32 * ML_QROW,
              ML_VEC = ML_SS + 64 * ML_TROW;
static_assert(ML_VEC + (7 * 64 + 128 + 4) * 4 <= RING_BYTES, "mLSTM LDS");
DI void mlstm_unit(int b, int h, int vs, const Args& args, LAS unsigned char* lds) {
    unsigned char* ws = args.ws;
    const bf16_t* qkm = (const bf16_t*)(ws + WS_QKM); const bf16_t* ktm = (const bf16_t*)(ws + WS_KTM); const bf16_t* proj = (const bf16_t*)(ws + WS_PROJ);
    const float* gates = (const float*)(ws + WS_GATES); float* hraw = (float*)(ws + WS_HRAW);
    const float b_i = ((const float*)args.in[4])[h], b_f = ((const float*)args.in[5])[h];
    int tid = threadIdx.x; asm volatile("" : "+v"(tid)); const int lane = tid & 63, r32 = lane & 31, hi = lane >> 5; const int wid = __builtin_amdgcn_readfirstlane(tid >> 6);
    LAS float* ROWT = (LAS float*)(lds + ML_VEC); LAS float* COLT = ROWT + 64; LAS float* WINT = ROWT + 128; LAS float* ENEG = ROWT + 192; LAS float* WAS = ROWT + 256;
    LAS float* NQ = ROWT + 320; LAS float* DINV = ROWT + 384; LAS float* NVEC = ROWT + 448; LAS float* SCAL = ROWT + 576;
    const size_t tokb = (size_t)b * SEQ;
    for (int i = tid; i < 32 * ML_QROW / 4; i += 512) ((LAS unsigned*)(lds + ML_CS))[i] = 0u;
    if (tid < 128) NVEC[tid] = 0.f;
    f32x16 cacc;
#pragma unroll
    for (int r = 0; r < 16; ++r) cacc[r] = 0.f;
    float m_st = 0.f;
    u32x4 sq[2], sk[2], skt[2], sv; float gi = 0.f, gf = 0.f;
    sv = (u32x4){0u, 0u, 0u, 0u};
#define ML_LOAD(c) do { const size_t tok0 = tokb + (size_t)(c) * MCH; \
        _Pragma("unroll") for (int i = 0; i < 2; ++i) { const int idx = tid + 512 * i; \
            sq[i] = *(const u32x4*)(qkm + (tok0 + (idx >> 4)) * 1024 + h * MHD + (idx & 15) * 8); \
            sk[i] = *(const u32x4*)(qkm + (tok0 + (idx >> 4)) * 1024 + 512 + h * MHD + (idx & 15) * 8); \
            skt[i] = *(const u32x4*)(ktm + (size_t)(h * MHD + (idx >> 3)) * T + tok0 + (idx & 7) * 8); } \
        if (tid < 256) sv = *(const u32x4*)(proj + (tok0 + (tid >> 2)) * NPROJ + PC_VM + h * MHD + vs * 32 + (tid & 3) * 8); \
        if (wid == 0) { gi = gates[(tok0 + lane) * 8 + h]; gf = gates[(tok0 + lane) * 8 + 4 + h]; } } while (0)
    ML_LOAD(0);
    for (int c = 0; c < SEQ / MCH; ++c) {
        const size_t tok0 = tokb + (size_t)c * MCH;
#pragma unroll
        for (int i = 0; i < 2; ++i) { const int idx = tid + 512 * i;
            *(LAS u32x4*)(lds + ML_QS + (idx >> 4) * ML_QROW + (idx & 15) * 16) = sq[i];
            *(LAS u32x4*)(lds + ML_KS + (idx >> 4) * ML_QROW + (idx & 15) * 16) = sk[i];
            *(LAS u32x4*)(lds + ML_KTS + (idx >> 3) * ML_TROW + (idx & 7) * 16) = skt[i]; }
        if (tid < 256) { const int l = tid >> 2, v0 = (tid & 3) * 8; LAS bf16_t* vt = (LAS bf16_t*)(lds + ML_VTS);
            vt[(v0 + 0) * (ML_TROW / 2) + l] = (bf16_t)(sv.x & 0xffff); vt[(v0 + 1) * (ML_TROW / 2) + l] = (bf16_t)(sv.x >> 16);
            vt[(v0 + 2) * (ML_TROW / 2) + l] = (bf16_t)(sv.y & 0xffff); vt[(v0 + 3) * (ML_TROW / 2) + l] = (bf16_t)(sv.y >> 16);
            vt[(v0 + 4) * (ML_TROW / 2) + l] = (bf16_t)(sv.z & 0xffff); vt[(v0 + 5) * (ML_TROW / 2) + l] = (bf16_t)(sv.z >> 16);
            vt[(v0 + 6) * (ML_TROW / 2) + l] = (bf16_t)(sv.w & 0xffff); vt[(v0 + 7) * (ML_TROW / 2) + l] = (bf16_t)(sv.w >> 16); }
        if (wid == 0) {
            const float xf = gf + b_f;
            const float lf = (xf >= 0.f) ? -log1pf(__expf(-xf)) : xf - log1pf(__expf(xf));
            float bb = lf;
#pragma unroll
            for (int o = 1; o < 64; o <<= 1) { const float tv = __shfl_up(bb, o); if (lane >= o) bb += tv; }
            const float btot = __shfl(bb, 63);
            const float ig = gi + b_i;
            const float a = btot - bb + ig;
            const float mchunk = wave_max(a);
            const float wa = __expf(a - mchunk);
            const float u = ig - bb;
            float pm = u;
#pragma unroll
            for (int o = 1; o < 64; o <<= 1) { const float tv = __shfl_up(pm, o); if (lane >= o) pm = fmaxf(pm, tv); }
            const float mintra = bb + pm;
            const float ginter = bb + m_st;
            const float m = fmaxf(ginter, mintra);
            const float mnew = fmaxf(btot + m_st, mchunk);
            const float sold = __expf(btot + m_st - mnew), snew = __expf(mchunk - mnew);
            ROWT[lane] = bb - m; COLT[lane] = u; WINT[lane] = __expf(ginter - m); ENEG[lane] = __expf(-m); WAS[lane] = snew * wa;
            if (lane == 0) SCAL[0] = sold;
            m_st = mnew;
        }
        __syncthreads();
        if (c + 1 < SEQ / MCH) ML_LOAD(c + 1);
        f32x16 iacc;
#pragma unroll
        for (int r = 0; r < 16; ++r) iacc[r] = 0.f;
        if (wid < 4) {
            const int jb = wid >> 1, sb = wid & 1;
            LAS bf16_t* ss = (LAS bf16_t*)(lds + ML_SS);
            if (sb <= jb) {
                f32x16 s;
#pragma unroll
                for (int r = 0; r < 16; ++r) s[r] = 0.f;
                const LAS unsigned char* qa = lds + ML_QS + (32 * jb + r32) * ML_QROW + hi * 16; const LAS unsigned char* kb = lds + ML_KS + (32 * sb + r32) * ML_QROW + hi * 16;
#pragma unroll
                for (int kk = 0; kk < 8; ++kk) s = MFMA32(*(const LAS bf16x8*)(qa + kk * 32), *(const LAS bf16x8*)(kb + kk * 32), s);
                const int sidx = 32 * sb + r32; const float ct = COLT[sidx];
#pragma unroll
                for (int r = 0; r < 16; ++r) { const int j = 32 * jb + crow(r, hi);
                    const float val = (sidx <= j) ? s[r] * __expf(ROWT[j] + ct) : 0.f;
                    ss[j * (ML_TROW / 2) + sidx] = (bf16_t)f2bf(val); }
            } else {
#pragma unroll
                for (int r = 0; r < 16; ++r) ss[(32 * jb + crow(r, hi)) * (ML_TROW / 2) + 32 * sb + r32] = (bf16_t)0;
            }
        } else if (wid < 6) {
            const int jb = wid - 4;
            const LAS unsigned char* qa = lds + ML_QS + (32 * jb + r32) * ML_QROW + hi * 16; const LAS unsigned char* cb = lds + ML_CS + r32 * ML_QROW + hi * 16;
#pragma unroll
            for (int kk = 0; kk < 8; ++kk) iacc = MFMA32(*(const LAS bf16x8*)(qa + kk * 32), *(const LAS bf16x8*)(cb + kk * 32), iacc);
        } else {
            const int j = 32 * (wid - 6) + (lane >> 1), half = lane & 1;
            const LAS unsigned char* qa = lds + ML_QS + j * ML_QROW + half * 128; float acc = 0.f;
#pragma unroll
            for (int i = 0; i < 8; ++i) { const u32x4 w = *(const LAS u32x4*)(qa + i * 16); const f32x4 n0 = *(const LAS f32x4*)(NVEC + half * 64 + i * 8), n1 = *(const LAS f32x4*)(NVEC + half * 64 + i * 8 + 4);
                acc += bflo(w.x) * n0[0] + bfhi(w.x) * n0[1] + bflo(w.y) * n0[2] + bfhi(w.y) * n0[3] + bflo(w.z) * n1[0] + bfhi(w.z) * n1[1] + bflo(w.w) * n1[2] + bfhi(w.w) * n1[3]; }
            acc += __shfl_xor(acc, 1);
            if (half == 0) NQ[j] = acc;
        }
        __syncthreads();
        if (wid < 4) {
            const float sold = SCAL[0];
#pragma unroll
            for (int r = 0; r < 16; ++r) cacc[r] *= sold;
            const LAS unsigned char* va = lds + ML_VTS + r32 * ML_TROW + hi * 16; const LAS unsigned char* kb = lds + ML_KTS + (32 * wid + r32) * ML_TROW + hi * 16;
#pragma unroll
            for (int kk = 0; kk < 4; ++kk) { const u32x4 w = *(const LAS u32x4*)(va + kk * 32);
                const f32x4 w0 = *(const LAS f32x4*)(WAS + 16 * kk + 8 * hi), w1 = *(const LAS f32x4*)(WAS + 16 * kk + 8 * hi + 4);
                u32x4 sa; sa.x = pk2(bflo(w.x) * w0[0], bfhi(w.x) * w0[1]); sa.y = pk2(bflo(w.y) * w0[2], bfhi(w.y) * w0[3]); sa.z = pk2(bflo(w.z) * w1[0], bfhi(w.z) * w1[1]); sa.w = pk2(bflo(w.w) * w1[2], bfhi(w.w) * w1[3]);
                cacc = MFMA32(__builtin_bit_cast(bf16x8, sa), *(const LAS bf16x8*)(kb + kk * 32), cacc); }
            LAS bf16_t* cs = (LAS bf16_t*)(lds + ML_CS);
#pragma unroll
            for (int r = 0; r < 16; ++r) cs[crow(r, hi) * (ML_QROW / 2) + 32 * wid + r32] = (bf16_t)f2bf(cacc[r]);
        } else if (wid < 6) {
            const int jb = wid - 4;
#pragma unroll
            for (int r = 0; r < 16; ++r) iacc[r] *= WINT[32 * jb + crow(r, hi)];
            const LAS unsigned char* sa = lds + ML_SS + (32 * jb + r32) * ML_TROW + hi * 16; const LAS unsigned char* vb = lds + ML_VTS + r32 * ML_TROW + hi * 16;
#pragma unroll
            for (int kk = 0; kk < 4; ++kk) iacc = MFMA32(*(const LAS bf16x8*)(sa + kk * 32), *(const LAS bf16x8*)(vb + kk * 32), iacc);
        } else {
            const int tl = (wid - 6) * 64 + lane;
            { const int j = tl >> 1, half = tl & 1; const LAS unsigned char* sp = lds + ML_SS + j * ML_TROW + half * 64; float rs = 0.f;
#pragma unroll
              for (int i = 0; i < 4; ++i) { const u32x4 w = *(const LAS u32x4*)(sp + i * 16); rs += (bflo(w.x) + bfhi(w.x)) + (bflo(w.y) + bfhi(w.y)) + (bflo(w.z) + bfhi(w.z)) + (bflo(w.w) + bfhi(w.w)); }
              rs += __shfl_xor(rs, 1);
              if (half == 0) { const float den = WINT[j] * NQ[j] + rs; DINV[j] = 1.0f / fmaxf(fabsf(den), ENEG[j]); } }
            { const int k = tl; const LAS unsigned char* kp = lds + ML_KTS + k * ML_TROW; float acc = SCAL[0] * NVEC[k];
#pragma unroll
              for (int i = 0; i < 8; ++i) { const u32x4 w = *(const LAS u32x4*)(kp + i * 16); const f32x4 w0 = *(const LAS f32x4*)(WAS + i * 8), w1 = *(const LAS f32x4*)(WAS + i * 8 + 4);
                  acc += bflo(w.x) * w0[0] + bfhi(w.x) * w0[1] + bflo(w.y) * w0[2] + bfhi(w.y) * w0[3] + bflo(w.z) * w1[0] + bfhi(w.z) * w1[1] + bflo(w.w) * w1[2] + bfhi(w.w) * w1[3]; }
              NVEC[k] = acc; }
        }
        __syncthreads();
        if (wid == 4 || wid == 5) {
            const int jb = wid - 4; float* hp = hraw + (tok0 + 32 * jb) * MW + h * MHD + vs * 32 + r32;
#pragma unroll
            for (int r = 0; r < 16; ++r) { const int j = crow(r, hi); hp[(size_t)j * MW] = iacc[r] * DINV[32 * jb + j]; }
        }
    }
#undef ML_LOAD
    __syncthreads();
}
DI void p5_mlstm(const Args& args, LAS unsigned char* lds, int vcu, int G) {
    for (int u = vcu; u < NB * MH * 4; u += G) { const int vs = u & 3, bh = u >> 2; mlstm_unit(bh / MH, bh % MH, vs, args, lds); }
}
#ifndef MK_ONE_LAUNCH
#define MK_ONE_LAUNCH 1
#endif
#ifndef P3SEL
#define P3SEL 31
#endif
constexpr int NPH = 20;
__global__ void __launch_bounds__(NWAVES * 64, 2) fwd_kernel(Args args) {
    extern __shared__ __attribute__((aligned(16))) unsigned char lds_raw[];
    LAS unsigned char* lds = (LAS unsigned char*)lds_raw;
    const int tid = threadIdx.x;
    const int G = gridDim.x; const int bx = blockIdx.x; const int vcu = (G % 8 == 0) ? (bx % 8) * (G / 8) + bx / 8 : bx;
    unsigned char* ws = args.ws;
    for (int u = tid; u < (LDS_BYTES - LDSCTL_OFF) / 4; u += NWAVES * 64) ((LAS unsigned*)(lds + LDSCTL_OFF))[u] = 0u;
    __syncthreads();
    volatile LAS unsigned* MISC = (volatile LAS unsigned*)(lds + MISC_OFF);
    XcdBarrier bar; bar.bar = (unsigned*)(ws + WS_CTL) + CW_BAR; bar.x = 0; bar.st = nullptr;
    const int lo = args.ph_lo, hi = args.ph_hi;
    if (hi - lo > 1) bar = xcd_barrier_post((unsigned*)(ws + WS_CTL) + CW_BAR, MISC + 8);
#ifndef PHASE_MASK
#define PHASE_MASK 0xFFFFFu
#endif
#define IN(k) (((PHASE_MASK >> (k)) & 1u) && lo <= (k) && (k) < hi)
#ifndef DUP_PHASE
#define DUP_PHASE -1
#endif
#define REP(k) _Pragma("unroll 1") for (int rep_ = 0; rep_ < ((DUP_PHASE == (k)) ? 2 : 1); ++rep_)
#define SEAM(k) do { if (IN(k) && IN(NEXTPH(k))) xcd_barrier(bar); } while (0)
#define NEXTPH(k) (((k) == 7 || (k) == 12) ? (k) + 2 : (k) + 1)
    using namespace pg8;
    LAS unsigned char* ring = lds + RING_OFF;
    const bf16_t* cws = (const bf16_t*)ws;
#define WSB(off) ((bf16_t*)(ws + (off)))
#define WSF(off) ((float*)(ws + (off)))

    if (IN(0)) REP(0) { p0_prologue(args, lds, vcu, G); }
    SEAM(0);
    if (IN(1)) REP(1) {
        { DenseOrder S; S.init(WSB(WS_XB), WSB(WS_W_IN), T, NPROJ, D, D, G, bx); EpiProj E{WSB(WS_PROJ), WSF(WS_GATES)}; gemm_phase(ring, D, D, D, S, E); }
        { DenseOrder S; S.init(WSB(WS_MEMB), WSB(WS_W_CK), NB * NMEM, D, D, D, G, bx); EpiBf16 E{WSB(WS_KC), D, 1 << 30, 1.f}; gemm_phase(ring, D, D, D, S, E); }
        { DenseOrder S; S.init(WSB(WS_W_CV), WSB(WS_MEMB), D, NB * NMEM, D, D, G, bx); EpiBf16 E{WSB(WS_VCT), NB * NMEM, 1 << 30, 1.f}; gemm_phase(ring, D, D, D, S, E); }
    }
    SEAM(1);
    if (IN(2)) REP(2) { p2_tokens(args, vcu, G); }
    SEAM(2);
    if (IN(3)) REP(3) {
        if (P3SEL & 1) { DenseOrder S; S.init(WSB(WS_QN), WSB(WS_W_UQ), T, AH * AQK, 256, 256, G, bx); EpiQmla E{WSB(WS_QMLA), WSF(WS_CS), 0.10206207261596575f * 1.4426950408889634f}; gemm_phase(ring, 256, 256, 256, S, E); }
        if (P3SEL & 2) { DenseOrder S; S.init(WSB(WS_KVN), WSB(WS_W_UK), T, 512, 256, 256, G, bx); EpiBf16 E{WSB(WS_KN), 512, 1 << 30, 1.f}; gemm_phase(ring, 256, 256, 256, S, E); }
        if (P3SEL & 4) { DenseOrder S; S.init(WSB(WS_W_UV), WSB(WS_KVN), 512, T, 256, 256, G, bx); EpiBf16 E{WSB(WS_VT), T, 1 << 30, 1.f}; gemm_phase(ring, 256, 256, 256, S, E); }
        if (P3SEL & 8) { DenseOrder S; S.init(WSB(WS_XC), WSB(WS_W_MQK), T, 1024, 512, 512, G, bx); EpiBf16 E{WSB(WS_QKM), 1024, 2, 0.08838834764831845f}; gemm_phase(ring, 512, 512, 512, S, E); }
        if (P3SEL & 16) { DenseOrder S; S.init(WSB(WS_W_MQK) + 512 * 512, WSB(WS_XC), 512, T, 512, 512, G, bx); EpiBf16 E{WSB(WS_KTM), T, 0, 0.08838834764831845f}; gemm_phase(ring, 512, 512, 512, S, E); }
    }
    SEAM(3);
    if (IN(4)) { REP(40) { p5_mlstm(args, lds, vcu, G); } REP(41) { p4_attention(args, lds, vcu, G); } }
    SEAM(4);
    if (IN(5)) REP(5) { p6_mpost(args, vcu, G); }
    SEAM(5);
    if (IN(6)) REP(6) {
        { DenseOrder S; S.init(WSB(WS_HM), WSB(WS_W_BRM), T, D, 512, 512, G, bx); EpiGate<false> E{WSB(WS_GATED), WSB(WS_PROJ), PC_GM}; gemm_phase(ring, 512, 512, 512, S, E); }
        { DenseOrder S; S.init(WSB(WS_AO), WSB(WS_W_BRA), T, D, 512, 512, G, bx); EpiGate<true> E{WSB(WS_GATED), WSB(WS_PROJ), PC_GA}; gemm_phase(ring, 512, 512, 512, S, E); }
    }
    SEAM(6);
    if (IN(7)) REP(7) { DenseOrder S; S.init(WSB(WS_GATED), WSB(WS_W_MIX), T, D, D, D, G, bx); EpiResStats<false> E{(const float*)args.in[0], nullptr, nullptr, nullptr, WSF(WS_V1), WSB(WS_V1B), WSF(CTL_STATS1)}; gemm_phase(ring, D, D, D, S, E); }
    SEAM(7);
    if (IN(9)) REP(9) { DenseOrder S; S.init(WSB(WS_V1B), WSB(WS_W_CQ), T, D, D, D, G, bx); EpiLNApplyBf16 E{WSB(WS_QC), D, WSF(CTL_STATS1), WSF(CTL_CS1), WSF(CTL_CB1), 0.0625f * 1.4426950408889634f}; gemm_phase(ring, D, D, D, S, E); }
    SEAM(9);
    if (IN(10)) REP(10) { CrossSOrder S{(const char*)(ws + WS_QC), (const char*)(ws + WS_KC), G, vcu}; EpiSoftmax E{WSB(WS_PC), (LAS float*)(lds + RED_OFF)}; gemm_phase(ring, 256, D, D, S, E); }
    SEAM(10);
    if (IN(11)) REP(11) { CrossOOrder S{(const char*)(ws + WS_PC), (const char*)(ws + WS_VCT), G, vcu}; EpiBf16 E{WSB(WS_OC), D, 1 << 30, 1.f}; gemm_phase(ring, 256, D, NB * NMEM, S, E); }
    SEAM(11);
    if (IN(12)) REP(12) { DenseOrder S; S.init(WSB(WS_OC), WSB(WS_W_CO), T, D, D, D, G, bx); EpiResStats<true> E{WSF(WS_V1), WSF(CTL_STATS1), (const float*)args.in[19], (const float*)args.in[20], WSF(WS_V2), WSB(WS_V2B), WSF(CTL_STATS2)}; gemm_phase(ring, D, D, D, S, E); }
    SEAM(12);
    if (IN(14)) REP(14) { DenseOrder S; S.init(WSB(WS_V2B), WSB(WS_W_R), T, 256, D, D, G, bx); EpiLNApplyF32 E{WSF(WS_LOGITS), NE, NE, WSF(CTL_STATS2), WSF(CTL_CSR), WSF(CTL_CBR)}; gemm_phase(ring, D, D, D, S, E); }
    SEAM(14);
    if (IN(15)) REP(15) { p16_topk(args, lds, vcu, G); }
    SEAM(15);
    if (IN(16)) REP(16) { p17_gather(args, lds, vcu, G); }
    SEAM(16);
    if (IN(17)) REP(17) { build_tstart(args, lds);
        MoeOrder S{(const char*)(ws + WS_XG), (const char*)(ws + WS_W_GU), (const LAS int*)(lds + TST_OFF), (const LAS int*)(lds + TILE_E_OFF), 8, G, vcu, (size_t)256 * D, (size_t)2048 * 1024, (size_t)256 * 1024};
        EpiSwiglu E{ws + WS_ACT, (const float*)args.in[29]}; gemm_phase<EpiSwiglu, MoeOrder, true>(ring, D, D, D, S, E); }
    SEAM(17);
    if (IN(18)) REP(18) { build_tstart(args, lds);
        MoeOrder S{(const char*)(ws + WS_ACT), (const char*)(ws + WS_W_DN), (const LAS int*)(lds + TST_OFF), (const LAS int*)(lds + TILE_E_OFF), 4, G, vcu, (size_t)256 * D, (size_t)1024 * 1024, (size_t)256 * 1024};
        EpiDown E{WSB(WS_YB), (const float*)args.in[31], WSF(WS_ROWGATE)}; gemm_phase<EpiDown, MoeOrder, true>(ring, D, D, D, S, E); }
    SEAM(18);
    if (IN(19)) REP(19) { p20_final(args, vcu, G); }
    (void)cws;
#undef IN
#undef SEAM
}

extern "C" void kernel_launch(void* const* d_in, const int* in_sizes, int n_in, void* d_out, int out_size, void* d_ws, size_t ws_size, hipStream_t stream) {
    static int grid = 0;
    if (grid == 0) {
        if (n_in != 34 || in_sizes[0] != T * D || out_size != T * D || ws_size < WS_END) { fprintf(stderr, "kernel_launch: unexpected shapes / workspace (n_in %d, ws %zu)\n", n_in, ws_size); grid = -1; return; }
        int dev = 0, cus = 0, per_cu = 0;
        if (hipGetDevice(&dev) != hipSuccess || hipDeviceGetAttribute(&cus, hipDeviceAttributeMultiprocessorCount, dev) != hipSuccess) { grid = -1; return; }
        if (hipFuncSetAttribute((const void*)fwd_kernel, hipFuncAttributeMaxDynamicSharedMemorySize, LDS_BYTES) != hipSuccess) { fprintf(stderr, "kernel_launch: hipFuncSetAttribute failed\n"); grid = -1; return; }
        if (hipOccupancyMaxActiveBlocksPerMultiprocessor(&per_cu, (const void*)fwd_kernel, NWAVES * 64, LDS_BYTES) != hipSuccess || per_cu < 1) fprintf(stderr, "kernel_launch: occupancy query says %d\n", per_cu);
        (void)hipGetLastError();
        grid = cus;
    }
    if (grid < 0) return;
    if (hipMemsetAsync((char*)d_ws + WS_CTL, 0, CTL_ZERO_BYTES, stream) != hipSuccess) return;
    Args a{};
    for (int i = 0; i < 34; ++i) a.in[i] = d_in[i];
    a.out = (float*)d_out; a.ws = (unsigned char*)d_ws;
#if MK_ONE_LAUNCH
    a.ph_lo = 0; a.ph_hi = NPH;
    hipLaunchKernelGGL(fwd_kernel, dim3(grid), dim3(NWAVES * 64), LDS_BYTES, stream, a);
#else
    for (int p = 0; p < NPH; ++p) { a.ph_lo = p; a.ph_hi = p + 1; hipLaunchKernelGGL(fwd_kernel, dim3(grid), dim3(NWAVES * 64), LDS_BYTES, stream, a); }
#endif
}
```

```cpp
#include <hip/hip_runtime.h>
#include <cstdio>
#include <cstdint>
#include <cmath>

#define LAS __attribute__((address_space(3)))
#define GAS __attribute__((address_space(1)))
typedef unsigned short bf16_t;
typedef short bf16x8 __attribute__((ext_vector_type(8)));
typedef float f32x4 __attribute__((ext_vector_type(4)));
typedef float f32x2 __attribute__((ext_vector_type(2)));
typedef float f32x16 __attribute__((ext_vector_type(16)));
typedef unsigned u32x4 __attribute__((ext_vector_type(4)));
typedef unsigned u32x2 __attribute__((ext_vector_type(2)));
typedef GAS unsigned gu32;
#define RLX_AGENT __ATOMIC_RELAXED, __HIP_MEMORY_SCOPE_AGENT
#define DI __device__ __forceinline__

constexpr int D = 1024, NB = 16, SEQ = 2048, T = NB * SEQ, NMEM = 256;
constexpr int MH = 4, MHD = 128, MW = 512, MCH = 64;
constexpr int AH = 8, ANOPE = 64, AROPE = 32, AQK = 96, AVD = 64, AW = 512, AQR = 256, AKVR = 128;
constexpr int XH = 4, XHD = 256;
constexpr int NE = 32, TOPK = 4;
constexpr int DIN = 4008, NPROJ = 4096;
constexpr float DN_ALPHA = 1.189207115002721f;
constexpr float EPS = 1e-5f;
constexpr int NASSIGN = T * TOPK;
constexpr int NROWS = NASSIGN + NE * 256;
constexpr int NTILES_MAX = NROWS / 256;
constexpr int PC_QLAT = 0, PC_KVLAT = 256, PC_KROPE = 384, PC_IG = 416, PC_FG = 420, PC_XM = 512, PC_VM = 1024, PC_OP = 1536, PC_GM = 2048, PC_GA = 3072;

DI unsigned f2bf(float f) { unsigned u = __builtin_bit_cast(unsigned, f); return (u + 0x7fffu + ((u >> 16) & 1u)) >> 16; }
DI unsigned pk2(float lo, float hi) { return f2bf(lo) | (f2bf(hi) << 16); }
DI float bf2f(unsigned short b) { return __builtin_bit_cast(float, (unsigned)b << 16); }
DI float bflo(unsigned w) { return __builtin_bit_cast(float, w << 16); }
DI float bfhi(unsigned w) { return __builtin_bit_cast(float, w & 0xffff0000u); }
DI float wave_sum(float v) {
#pragma unroll
    for (int o = 1; o < 64; o <<= 1) v += __shfl_xor(v, o);
    return v;
}
DI float wave_max(float v) {
#pragma unroll
    for (int o = 1; o < 64; o <<= 1) v = fmaxf(v, __shfl_xor(v, o));
    return v;
}
DI float rcpf_(float x) { return __builtin_amdgcn_rcpf(x); }
DI float sigmoidf_(float x) { return __builtin_amdgcn_rcpf(1.0f + __builtin_amdgcn_exp2f(-1.4426950408889634f * x)); }
DI int crow(int r, int hi) { return (r & 3) + 8 * (r >> 2) + 4 * hi; }
#define MFMA32(a, b, c) __builtin_amdgcn_mfma_f32_32x32x16_bf16((a), (b), (c), 0, 0, 0)

namespace pg8 {
constexpr int BM = 256, BK = 64, HALF = 128, HTB = HALF * BK * 2, STAGE_BYTES = 8 * HTB;
__host__ __device__ __forceinline__ int lds_byte(int r, int c) { const int st = (r >> 4) * 2 + (c >> 5), rr = r & 15, cc = c & 31, ob = rr * 64 + cc * 2; return st * 1024 + (ob ^ (((ob >> 9) & 1) << 5)); }
__host__ __device__ __forceinline__ void stage_rc(int b, int& R, int& C) { const int st = b / 1024, sb = b % 1024, swz = sb ^ (((sb >> 9) & 1) << 5); R = (st >> 1) * 16 + swz / 64; C = (st & 1) * 32 + (swz % 64) / 2; }
__host__ __device__ __forceinline__ int perm32(int rho) { const int n = rho >> 4, i = rho & 15; return 8 * (i >> 2) + 4 * n + (i & 3); }

struct Unit { int pm, pn, aux; const char* a; const char* b; };
struct Ctx { int wr, wc, fr, fq, wid, lane; };

DI unsigned cvt_pk_bf16(float lo, float hi) { unsigned r; asm volatile("v_cvt_pk_bf16_f32 %0, %1, %2" : "=v"(r) : "v"(lo), "v"(hi)); return r; }

typedef f32x4 Acc[2][2][4][2];

DI void glds16_s(const char* gbase, unsigned voff, unsigned lds_dst) { unsigned keep;
    asm volatile("s_mov_b32 %0, m0\n\ts_mov_b32 m0, %1\n\ts_nop 0\n\tglobal_load_lds_dwordx4 %2, %3\n\ts_mov_b32 m0, %0" : "=&s"(keep) : "s"(lds_dst), "v"(voff), "s"(gbase) : "memory"); }
typedef int v8i_t __attribute__((ext_vector_type(8)));
typedef int i32x4_t __attribute__((ext_vector_type(4)));
template <class Epi, class Sched, bool FP8 = false>
DI void gemm_phase(LAS unsigned char* lds, const int K, const int lda, const int ldb, const Sched& S, const Epi& E) {
    int tid = threadIdx.x; asm volatile("" : "+v"(tid));
    const int wid = __builtin_amdgcn_readfirstlane(tid >> 6), lane = tid & 63, wr = wid >> 2, wc = wid & 3, fr = lane & 15, fq = lane >> 4;
    constexpr int ESZ = FP8 ? 1 : 2;
    const int nt = K * ESZ / (BK * 2);
    unsigned voffA[2], voffB[2];
#pragma unroll
    for (int i = 0; i < 2; ++i) { int R, C; stage_rc(tid * 16 + i * 8192, R, C); const int Rb = Epi::PERM ? ((R & ~31) + perm32(R & 31)) : R;
        voffA[i] = (unsigned)(R * lda * ESZ + C * 2); voffB[i] = (unsigned)(Rb * ldb * ESZ + C * 2); }
    const size_t kstep = (size_t)(BK * 2);
    const size_t hstepA = (size_t)HALF * lda * ESZ, hstepB = (size_t)HALF * ldb * ESZ;
    const unsigned ldsw = (unsigned)wid * 1024u;
    const int aoff = lds_byte(wr * 64 + fr, fq * 8), boff = lds_byte(wc * 32 + fr, fq * 8);
    const Ctx cx{wr, wc, fr, fq, wid, lane};
    const unsigned lds_u = (unsigned)__builtin_amdgcn_readfirstlane((int)((unsigned)(size_t)lds + ldsw));
    LAS unsigned char* ldsB = lds + 4 * HTB + boff;
#define PG8_SA(b, h) (((b) * 2 + (h)) * HTB)
#define PG8_SB(b, h) ((4 + (b) * 2 + (h)) * HTB)
#define PG8_SBL(b, h) (((b) * 2 + (h)) * HTB)
#define PG8_STAGE(bufoff, gbase, voff) do { _Pragma("unroll") for (int _i = 0; _i < 2; ++_i) \
        glds16_s((const char*)(gbase), (voff)[_i], lds_u + (unsigned)((bufoff) + _i * 8192)); } while (0)
#define PG8_RD(off) (*(const LAS i32x4_t*)(lds + (off)))
#define PG8_CAT2(x, y) __builtin_shufflevector((x), (y), 0, 1, 2, 3, 4, 5, 6, 7)
#define PG8_LDA(dst, b, h) do { if constexpr (FP8) { _Pragma("unroll") for (int m = 0; m < 4; ++m) dst##8[m] = PG8_CAT2(PG8_RD(PG8_SA(b, h) + aoff + m * 2048), PG8_RD(PG8_SA(b, h) + aoff + m * 2048 + 1024)); } \
        else { _Pragma("unroll") for (int m = 0; m < 4; ++m) _Pragma("unroll") for (int k = 0; k < 2; ++k) dst[m][k] = *(const LAS bf16x8*)(lds + PG8_SA(b, h) + aoff + m * 2048 + k * 1024); } } while (0)
#define PG8_LDB(dst, b, h) do { if constexpr (FP8) { _Pragma("unroll") for (int n = 0; n < 2; ++n) dst##8[n] = PG8_CAT2(*(const LAS i32x4_t*)(ldsB + PG8_SBL(b, h) + n * 2048), *(const LAS i32x4_t*)(ldsB + PG8_SBL(b, h) + n * 2048 + 1024)); } \
        else { _Pragma("unroll") for (int n = 0; n < 2; ++n) _Pragma("unroll") for (int k = 0; k < 2; ++k) dst[n][k] = *(const LAS bf16x8*)(ldsB + PG8_SBL(b, h) + n * 2048 + k * 1024); } } while (0)
#define PG8_MMA(ai, bj, At, Bt) do { __builtin_amdgcn_s_setprio(1); \
        if constexpr (FP8) { _Pragma("unroll") for (int m = 0; m < 4; ++m) _Pragma("unroll") for (int n = 0; n < 2; ++n) \
            acc[ai][bj][m][n] = __builtin_amdgcn_mfma_scale_f32_16x16x128_f8f6f4(Bt##8[n], At##8[m], acc[ai][bj][m][n], 0, 0, 0, 0x7f7f7f7f, 0, 0x7f7f7f7f); } \
        else { _Pragma("unroll") for (int m = 0; m < 4; ++m) _Pragma("unroll") for (int n = 0; n < 2; ++n) _Pragma("unroll") for (int k = 0; k < 2; ++k) \
            acc[ai][bj][m][n] = __builtin_amdgcn_mfma_f32_16x16x32_bf16(Bt[n][k], At[m][k], acc[ai][bj][m][n], 0, 0, 0); } \
        __builtin_amdgcn_s_setprio(0); } while (0)
#define PG8_WAIT_V(n) asm volatile("s_waitcnt vmcnt(" #n ")" ::: "memory")
#define PG8_WAIT_L(n) asm volatile("s_waitcnt lgkmcnt(" #n ")" ::: "memory")
#define PG8_BAR __builtin_amdgcn_s_barrier()
#define PG8_SCHED __builtin_amdgcn_sched_barrier(0)
    Unit cur, nxt; int ui = 0;
    if (!S.next(0, cur)) return;
    Acc acc;
#pragma unroll
    for (int a = 0; a < 2; ++a)
#pragma unroll
        for (int b = 0; b < 2; ++b)
#pragma unroll
            for (int m = 0; m < 4; ++m)
#pragma unroll
                for (int n = 0; n < 2; ++n) acc[a][b][m][n] = (f32x4){0.f, 0.f, 0.f, 0.f};
    bf16x8 At[4][2], B0[2][2], B1[2][2]; v8i_t At8[4], B08[2], B18[2];
    const char* cA = cur.a; const char* cB = cur.b;
    PG8_STAGE(PG8_SB(0, 0), cB, voffB); PG8_STAGE(PG8_SB(0, 1), cB + hstepB, voffB); PG8_STAGE(PG8_SA(0, 0), cA, voffA); PG8_STAGE(PG8_SA(0, 1), cA + hstepA, voffA);
    if (wr == 1) PG8_BAR;
    PG8_WAIT_V(2); PG8_BAR;
    PG8_STAGE(PG8_SB(1, 0), cB + kstep, voffB); PG8_STAGE(PG8_SA(1, 0), cA + kstep, voffA); PG8_STAGE(PG8_SB(1, 1), cB + hstepB + kstep, voffB);
    PG8_WAIT_V(6); PG8_BAR;
    for (;;) {
        const bool has_next = S.next(ui + 1, nxt);
        const char* nA = has_next ? nxt.a : cA; const char* nB = has_next ? nxt.b : cB;
#pragma unroll 1
        for (int t = 0; t < nt; t += 2) {
            const bool last = (t == nt - 2);
            const char* a1 = cA + (size_t)(t + 1) * kstep;
            const char* a2 = last ? nA : cA + (size_t)(t + 2) * kstep; const char* b2 = last ? nB : cB + (size_t)(t + 2) * kstep;
            const char* a3 = a2 + kstep; const char* b3 = b2 + kstep;
            PG8_LDB(B0, 0, 0); PG8_LDB(B1, 0, 1); PG8_SCHED; PG8_LDA(At, 0, 0); PG8_STAGE(PG8_SA(1, 1), a1 + hstepA, voffA);
            PG8_WAIT_V(8); PG8_WAIT_L(0); PG8_BAR; PG8_MMA(0, 0, At, B0); PG8_MMA(0, 1, At, B1); PG8_BAR; PG8_SCHED;
            PG8_LDA(At, 0, 1); PG8_STAGE(PG8_SB(0, 0), b2, voffB); PG8_STAGE(PG8_SB(0, 1), b2 + hstepB, voffB); PG8_STAGE(PG8_SA(0, 0), a2, voffA);
            PG8_WAIT_V(8); PG8_WAIT_L(0); PG8_BAR; PG8_MMA(1, 0, At, B0); PG8_MMA(1, 1, At, B1); PG8_BAR; PG8_SCHED;
            PG8_LDB(B0, 1, 0); PG8_LDB(B1, 1, 1); PG8_SCHED; PG8_LDA(At, 1, 0); PG8_STAGE(PG8_SA(0, 1), a2 + hstepA, voffA);
            PG8_WAIT_V(8); PG8_WAIT_L(0); PG8_BAR; PG8_MMA(0, 0, At, B0); PG8_MMA(0, 1, At, B1); PG8_BAR; PG8_SCHED;
            PG8_LDA(At, 1, 1); PG8_STAGE(PG8_SB(1, 0), b3, voffB); PG8_STAGE(PG8_SB(1, 1), b3 + hstepB, voffB); PG8_STAGE(PG8_SA(1, 0), a3, voffA);
            PG8_WAIT_V(8); PG8_WAIT_L(0); PG8_BAR; PG8_MMA(1, 0, At, B0); PG8_MMA(1, 1, At, B1); PG8_BAR; PG8_SCHED;
        }
        if (wr == 0) PG8_BAR;
        E(acc, cur, cx);
        if (!has_next) break;
#pragma unroll
        for (int a = 0; a < 2; ++a)
#pragma unroll
            for (int b = 0; b < 2; ++b)
#pragma unroll
                for (int m = 0; m < 4; ++m)
#pragma unroll
                    for (int n = 0; n < 2; ++n) acc[a][b][m][n] = (f32x4){0.f, 0.f, 0.f, 0.f};
        cur = nxt; cA = nA; cB = nB; ++ui;
        if (wr == 1) PG8_BAR;
    }
    PG8_WAIT_V(0);
    PG8_BAR;
#undef PG8_SA
#undef PG8_SB
#undef PG8_SBL
#undef PG8_STAGE
#undef PG8_LDA
#undef PG8_LDB
#undef PG8_MMA
#undef PG8_CAT2
#undef PG8_RD
#undef PG8_WAIT_V
#undef PG8_WAIT_L
#undef PG8_BAR
#undef PG8_SCHED
}
}
namespace pg8 {
constexpr int NXCD = 8, WGM = 8;
struct DenseOrder {
    const char* A; const char* B; int nM, nN, nwg, G, c; size_t strideA, strideB;
    DI void init(const void* A_, const void* B_, int M, int N, int lda, int ldb, int G_, int c_) { A = (const char*)A_; B = (const char*)B_; nM = M / BM; nN = N / BM; nwg = nM * nN; G = G_; c = c_;
        strideA = (size_t)BM * lda * 2; strideB = (size_t)BM * ldb * 2; }
    DI bool next(int i, Unit& u) const {
        const long L = (long)i * G + c; if (L >= nwg) return false;
        int wgid = (int)L; { const int q = nwg / NXCD, r = nwg % NXCD, xcd = wgid % NXCD, off = wgid / NXCD; wgid = (xcd < r ? xcd * (q + 1) : r * (q + 1) + (xcd - r) * q) + off; }
        const int nig = WGM * nN, gid = wgid / nig, fm = gid * WGM, gsz = (nM - fm) < WGM ? (nM - fm) : WGM;
        u.pm = fm + ((wgid % nig) % gsz); u.pn = (wgid % nig) / gsz; u.aux = 0;
        u.a = A + (size_t)u.pm * strideA; u.b = B + (size_t)u.pn * strideB; return true;
    }
};
struct CrossSOrder {
    const char* Q; const char* Kc; int G, v;
    DI bool next(int i, Unit& u) const {
        const int L = i * G + v; if (L >= (T / 256) * XH) return false;
        u.pm = L >> 2; u.pn = L & 3; u.aux = 0;
        u.a = Q + ((size_t)u.pm * 256 * D + u.pn * 256) * 2; u.b = Kc + ((size_t)(u.pm >> 3) * 256 * D + u.pn * 256) * 2; return true;
    }
};
struct CrossOOrder {
    const char* P; const char* Vt; int G, v;
    DI bool next(int i, Unit& u) const {
        const int L = i * G + v; if (L >= (T / 256) * XH) return false;
        u.pm = L >> 2; u.pn = L & 3; u.aux = 0;
        u.a = P + ((size_t)u.pm * 256 * D + u.pn * 256) * 2; u.b = Vt + ((size_t)u.pn * 256 * (NB * NMEM) + (size_t)(u.pm >> 3) * 256) * 2; return true;
    }
};
struct MoeOrder {
    const char* A; const char* W; const LAS int* tstart; const LAS int* tile_e; int npn, G, v; size_t strideA, strideW, strideN;
    DI bool next(int i, Unit& u) const {
        const int L = i * G + v; const int total = __builtin_amdgcn_readfirstlane(tstart[NE]) * npn; if (L >= total) return false;
        const int tile = L / npn; u.pm = tile; u.pn = L - tile * npn;
        const int e = __builtin_amdgcn_readfirstlane(tile_e[tile]);
        u.aux = e;
        u.a = A + (size_t)tile * strideA; u.b = W + (size_t)e * strideW + (size_t)u.pn * strideN; return true;
    }
};

DI unsigned pk4_fp8(float a, float b, float c, float d) { int w = 0; w = __builtin_amdgcn_cvt_pk_fp8_f32(a, b, w, false); w = __builtin_amdgcn_cvt_pk_fp8_f32(c, d, w, true); return (unsigned)w; }
constexpr float F8_XS = 16.0f, F8_WS = 64.0f, F8_AS = 8.0f;
struct EpiBf16 {
    static constexpr bool PERM = true;
    bf16_t* O; int ldc; int sc_from; float scale;
    DI void operator()(const Acc& acc, const Unit& u, const Ctx& c) const {
        int row0 = u.pm * BM + c.wr * 64 + c.fr, col0 = u.pn * BM + c.wc * 32 + 8 * c.fq; asm volatile("" : "+v"(row0), "+v"(col0));
        const float sc = (u.pn >= sc_from) ? scale : 1.0f;
#pragma unroll
        for (int ai = 0; ai < 2; ++ai)
#pragma unroll
            for (int m = 0; m < 4; ++m) { bf16_t* rowp = O + (size_t)(row0 + ai * HALF + m * 16) * ldc + col0;
#pragma unroll
                for (int bj = 0; bj < 2; ++bj) { const f32x4 v0 = acc[ai][bj][m][0] * sc, v1 = acc[ai][bj][m][1] * sc;
                    u32x4 w; w.x = cvt_pk_bf16(v0[0], v0[1]); w.y = cvt_pk_bf16(v0[2], v0[3]); w.z = cvt_pk_bf16(v1[0], v1[1]); w.w = cvt_pk_bf16(v1[2], v1[3]);
                    *(u32x4*)(rowp + bj * HALF) = w; } }
    }
};
struct EpiProj {
    static constexpr bool PERM = true;
    bf16_t* O; float* gates;
    DI void operator()(const Acc& acc, const Unit& u, const Ctx& c) const {
        int row0 = u.pm * BM + c.wr * 64 + c.fr, col0 = u.pn * BM + c.wc * 32 + 8 * c.fq; asm volatile("" : "+v"(row0), "+v"(col0));
#pragma unroll
        for (int ai = 0; ai < 2; ++ai)
#pragma unroll
            for (int m = 0; m < 4; ++m) { const int row = row0 + ai * HALF + m * 16; bf16_t* rowp = O + (size_t)row * NPROJ + col0;
#pragma unroll
                for (int bj = 0; bj < 2; ++bj) { const f32x4 v0 = acc[ai][bj][m][0], v1 = acc[ai][bj][m][1];
                    u32x4 w; w.x = cvt_pk_bf16(v0[0], v0[1]); w.y = cvt_pk_bf16(v0[2], v0[3]); w.z = cvt_pk_bf16(v1[0], v1[1]); w.w = cvt_pk_bf16(v1[2], v1[3]);
                    *(u32x4*)(rowp + bj * HALF) = w; }
                if (u.pn == 1 && c.wc == 1 && c.fq == 0) { *(f32x4*)(gates + (size_t)row * 8) = acc[ai][1][m][0]; *(f32x4*)(gates + (size_t)row * 8 + 4) = acc[ai][1][m][1]; } }
    }
};
struct EpiQmla {
    static constexpr bool PERM = true;
    bf16_t* O; const float* cs;
    float scale;
    DI void operator()(const Acc& acc, const Unit& u, const Ctx& c) const {
        int row0 = u.pm * BM + c.wr * 64 + c.fr, col0 = u.pn * BM + c.wc * 32 + 8 * c.fq; asm volatile("" : "+v"(row0), "+v"(col0));
#pragma unroll
        for (int ai = 0; ai < 2; ++ai)
#pragma unroll
            for (int m = 0; m < 4; ++m) { const int row = row0 + ai * HALF + m * 16; bf16_t* rowp = O + (size_t)row * (AH * AQK) + col0;
#pragma unroll
                for (int bj = 0; bj < 2; ++bj) { f32x4 v0 = acc[ai][bj][m][0] * scale, v1 = acc[ai][bj][m][1] * scale;
                    const int cc = (col0 + bj * HALF) % AQK;
                    if (cc >= ANOPE) { const int p0 = (cc - ANOPE) >> 1;
                        const f32x4 t0 = *(const f32x4*)(cs + (size_t)row * 32 + p0 * 2), t1 = *(const f32x4*)(cs + (size_t)row * 32 + p0 * 2 + 4);
                        f32x4 r0, r1;
                        r0[0] = v0[0] * t0[0] - v0[1] * t0[1]; r0[1] = v0[1] * t0[0] + v0[0] * t0[1];
                        r0[2] = v0[2] * t0[2] - v0[3] * t0[3]; r0[3] = v0[3] * t0[2] + v0[2] * t0[3];
                        r1[0] = v1[0] * t1[0] - v1[1] * t1[1]; r1[1] = v1[1] * t1[0] + v1[0] * t1[1];
                        r1[2] = v1[2] * t1[2] - v1[3] * t1[3]; r1[3] = v1[3] * t1[2] + v1[2] * t1[3];
                        v0 = r0; v1 = r1; }
                    u32x4 w; w.x = cvt_pk_bf16(v0[0], v0[1]); w.y = cvt_pk_bf16(v0[2], v0[3]); w.z = cvt_pk_bf16(v1[0], v1[1]); w.w = cvt_pk_bf16(v1[2], v1[3]);
                    *(u32x4*)(rowp + bj * HALF) = w; } }
    }
};
template <bool ADD> struct EpiGate {
    static constexpr bool PERM = true;
    bf16_t* O; const bf16_t* proj; int gcol;
    DI void operator()(const Acc& acc, const Unit& u, const Ctx& c) const {
        int row0 = u.pm * BM + c.wr * 64 + c.fr, col0 = u.pn * BM + c.wc * 32 + 8 * c.fq; asm volatile("" : "+v"(row0), "+v"(col0));
#pragma unroll
        for (int ai = 0; ai < 2; ++ai)
#pragma unroll
            for (int m = 0; m < 4; ++m) { const int row = row0 + ai * HALF + m * 16; bf16_t* rowp = O + (size_t)row * D + col0; const bf16_t* gp = proj + (size_t)row * NPROJ + gcol + col0;
#pragma unroll
                for (int bj = 0; bj < 2; ++bj) { const f32x4 v0 = acc[ai][bj][m][0], v1 = acc[ai][bj][m][1];
                    const u32x4 g = *(const u32x4*)(gp + bj * HALF);
                    float o[8];
                    o[0] = sigmoidf_(bflo(g.x)) * v0[0]; o[1] = sigmoidf_(bfhi(g.x)) * v0[1]; o[2] = sigmoidf_(bflo(g.y)) * v0[2]; o[3] = sigmoidf_(bfhi(g.y)) * v0[3];
                    o[4] = sigmoidf_(bflo(g.z)) * v1[0]; o[5] = sigmoidf_(bfhi(g.z)) * v1[1]; o[6] = sigmoidf_(bflo(g.w)) * v1[2]; o[7] = sigmoidf_(bfhi(g.w)) * v1[3];
                    if (ADD) { const u32x4 p = *(const u32x4*)(rowp + bj * HALF);
                        o[0] += bflo(p.x); o[1] += bfhi(p.x); o[2] += bflo(p.y); o[3] += bfhi(p.y); o[4] += bflo(p.z); o[5] += bfhi(p.z); o[6] += bflo(p.w); o[7] += bfhi(p.w); }
                    u32x4 w; w.x = cvt_pk_bf16(o[0], o[1]); w.y = cvt_pk_bf16(o[2], o[3]); w.z = cvt_pk_bf16(o[4], o[5]); w.w = cvt_pk_bf16(o[6], o[7]);
                    *(u32x4*)(rowp + bj * HALF) = w; } }
    }
};
struct EpiF32 {
    static constexpr bool PERM = false;
    float* C; int ldc; int ncols_valid;
    DI void operator()(const Acc& acc, const Unit& u, const Ctx& c) const {
        int row0 = u.pm * BM + c.wr * 64 + c.fr, col0 = u.pn * BM + c.wc * 32 + 4 * c.fq; asm volatile("" : "+v"(row0), "+v"(col0));
#pragma unroll
        for (int ai = 0; ai < 2; ++ai)
#pragma unroll
            for (int m = 0; m < 4; ++m) { float* rowp = C + (size_t)(row0 + ai * HALF + m * 16) * ldc + col0;
#pragma unroll
                for (int bj = 0; bj < 2; ++bj)
#pragma unroll
                    for (int n = 0; n < 2; ++n) if (col0 + bj * HALF + n * 16 < ncols_valid) *(f32x4*)(rowp + bj * HALF + n * 16) = acc[ai][bj][m][n]; }
    }
};

DI void row_stats(const float* stats, int row, float& mean, float& rstd) { const f32x2 st = *(const f32x2*)(stats + (size_t)row * 2);
    mean = st[0] * (1.0f / D); const float var = fmaxf(st[1] * (1.0f / D) - mean * mean, 0.f); rstd = __builtin_amdgcn_rsqf(var + EPS); }
template <bool NORM> struct EpiResStats {
    static constexpr bool PERM = true;
    const bf16_t* res; const float* pstats; const float* pg; const float* pb; bf16_t* VB; float* stats;
    DI void operator()(const Acc& acc, const Unit& u, const Ctx& c) const {
        int row0 = u.pm * BM + c.wr * 64 + c.fr, col0 = u.pn * BM + c.wc * 32 + 8 * c.fq; asm volatile("" : "+v"(row0), "+v"(col0));
#pragma unroll
        for (int ai = 0; ai < 2; ++ai) {
            u32x4 rr[4][2];
#pragma unroll
            for (int m = 0; m < 4; ++m)
#pragma unroll
                for (int bj = 0; bj < 2; ++bj) rr[m][bj] = *(const u32x4*)(res + (size_t)(row0 + ai * HALF + m * 16) * D + col0 + bj * HALF);
#pragma unroll
            for (int m = 0; m < 4; ++m) { const int row = row0 + ai * HALF + m * 16; const size_t ro = (size_t)row * D + col0;
                float mean = 0.f, rstd = 1.f; if (NORM) row_stats(pstats, row, mean, rstd);
                float s1 = 0.f, s2 = 0.f;
#pragma unroll
                for (int bj = 0; bj < 2; ++bj) { const u32x4 w = rr[m][bj];
                    f32x4 r0 = {bflo(w.x), bfhi(w.x), bflo(w.y), bfhi(w.y)}, r1 = {bflo(w.z), bfhi(w.z), bflo(w.w), bfhi(w.w)};
                    if (NORM) { const f32x4 g0 = *(const f32x4*)(pg + col0 + bj * HALF), g1 = *(const f32x4*)(pg + col0 + bj * HALF + 4), b0 = *(const f32x4*)(pb + col0 + bj * HALF), b1 = *(const f32x4*)(pb + col0 + bj * HALF + 4);
                        r0 = (r0 - mean) * rstd * g0 + b0; r1 = (r1 - mean) * rstd * g1 + b1; }
                    const f32x4 v0 = r0 * DN_ALPHA + acc[ai][bj][m][0], v1 = r1 * DN_ALPHA + acc[ai][bj][m][1];
                    u32x4 o; o.x = cvt_pk_bf16(v0[0], v0[1]); o.y = cvt_pk_bf16(v0[2], v0[3]); o.z = cvt_pk_bf16(v1[0], v1[1]); o.w = cvt_pk_bf16(v1[2], v1[3]);
                    *(u32x4*)(VB + ro + bj * HALF) = o;
                    s1 += (v0[0] + v0[1]) + (v0[2] + v0[3]) + (v1[0] + v1[1]) + (v1[2] + v1[3]);
                    s2 += (v0[0] * v0[0] + v0[1] * v0[1]) + (v0[2] * v0[2] + v0[3] * v0[3]) + (v1[0] * v1[0] + v1[1] * v1[1]) + (v1[2] * v1[2] + v1[3] * v1[3]); }
                s1 += __shfl_xor(s1, 16); s1 += __shfl_xor(s1, 32); s2 += __shfl_xor(s2, 16); s2 += __shfl_xor(s2, 32);
                if (c.fq == 0) { __hip_atomic_fetch_add(stats + (size_t)row * 2, s1, RLX_AGENT); __hip_atomic_fetch_add(stats + (size_t)row * 2 + 1, s2, RLX_AGENT); } }
            __builtin_amdgcn_sched_barrier(0); }
    }
};
struct EpiLNApplyBf16 {
    static constexpr bool PERM = true;
    bf16_t* O; int ldc; const float* stats; const float* cs; const float* cb; float scale;
    DI void operator()(const Acc& acc, const Unit& u, const Ctx& c) const {
        int row0 = u.pm * BM + c.wr * 64 + c.fr, col0 = u.pn * BM + c.wc * 32 + 8 * c.fq; asm volatile("" : "+v"(row0), "+v"(col0));
        f32x4 csv[2][2], cbv[2][2];
#pragma unroll
        for (int bj = 0; bj < 2; ++bj)
#pragma unroll
            for (int n = 0; n < 2; ++n) { csv[bj][n] = *(const f32x4*)(cs + col0 + bj * HALF + 4 * n); cbv[bj][n] = *(const f32x4*)(cb + col0 + bj * HALF + 4 * n); }
#pragma unroll
        for (int ai = 0; ai < 2; ++ai)
#pragma unroll
            for (int m = 0; m < 4; ++m) { const int row = row0 + ai * HALF + m * 16; float mean, rstd; row_stats(stats, row, mean, rstd);
                bf16_t* rowp = O + (size_t)row * ldc + col0;
#pragma unroll
                for (int bj = 0; bj < 2; ++bj) { const f32x4 v0 = ((acc[ai][bj][m][0] - csv[bj][0] * mean) * rstd + cbv[bj][0]) * scale, v1 = ((acc[ai][bj][m][1] - csv[bj][1] * mean) * rstd + cbv[bj][1]) * scale;
                    u32x4 w; w.x = cvt_pk_bf16(v0[0], v0[1]); w.y = cvt_pk_bf16(v0[2], v0[3]); w.z = cvt_pk_bf16(v1[0], v1[1]); w.w = cvt_pk_bf16(v1[2], v1[3]);
                    *(u32x4*)(rowp + bj * HALF) = w; } }
    }
};
struct EpiLNApplyF32 {
    static constexpr bool PERM = false;
    float* C; int ldc; int ncols_valid; const float* stats; const float* cs; const float* cb;
    DI void operator()(const Acc& acc, const Unit& u, const Ctx& c) const {
        int row0 = u.pm * BM + c.wr * 64 + c.fr, col0 = u.pn * BM + c.wc * 32 + 4 * c.fq; asm volatile("" : "+v"(row0), "+v"(col0));
#pragma unroll
        for (int ai = 0; ai < 2; ++ai)
#pragma unroll
            for (int m = 0; m < 4; ++m) { const int row = row0 + ai * HALF + m * 16; float mean, rstd; row_stats(stats, row, mean, rstd);
                float* rowp = C + (size_t)row * ldc + col0;
#pragma unroll
                for (int bj = 0; bj < 2; ++bj)
#pragma unroll
                    for (int n = 0; n < 2; ++n) if (col0 + bj * HALF + n * 16 < ncols_valid) { const f32x4 csv = *(const f32x4*)(cs + col0 + bj * HALF + n * 16), cbv = *(const f32x4*)(cb + col0 + bj * HALF + n * 16);
                        *(f32x4*)(rowp + bj * HALF + n * 16) = (acc[ai][bj][m][n] - csv * mean) * rstd + cbv; } }
    }
};
struct EpiSoftmax {
    static constexpr bool PERM = true;
    bf16_t* O; LAS float* red;
    DI void operator()(Acc& acc, const Unit& u, const Ctx& c) const {
        int row0 = u.pm * BM + c.wr * 64 + c.fr, col0 = u.pn * BM + c.wc * 32 + 8 * c.fq; asm volatile("" : "+v"(row0), "+v"(col0));
        int rbase = (c.wr * 64 + c.fr) * 4; asm volatile("" : "+v"(rbase));
        LAS float* r1 = red + rbase; LAS float* r2 = red + 1024 + rbase;
#pragma unroll
        for (int ai = 0; ai < 2; ++ai)
#pragma unroll
            for (int m = 0; m < 4; ++m) { float v = -INFINITY;
#pragma unroll
                for (int bj = 0; bj < 2; ++bj)
#pragma unroll
                    for (int n = 0; n < 2; ++n) { const f32x4 x = acc[ai][bj][m][n]; v = fmaxf(v, fmaxf(fmaxf(x[0], x[1]), fmaxf(x[2], x[3]))); }
                v = fmaxf(v, __shfl_xor(v, 16)); v = fmaxf(v, __shfl_xor(v, 32));
                if (c.fq == 0) r1[(ai * HALF + m * 16) * 4 + c.wc] = v;
                __builtin_amdgcn_sched_barrier(0); }
        asm volatile("s_waitcnt lgkmcnt(0)" ::: "memory"); __builtin_amdgcn_s_barrier(); asm volatile("" ::: "memory");
#pragma unroll
        for (int ai = 0; ai < 2; ++ai)
#pragma unroll
            for (int m = 0; m < 4; ++m) { const f32x4 q = *(const LAS f32x4*)(r1 + (ai * HALF + m * 16) * 4);
                const float mm = fmaxf(fmaxf(q[0], q[1]), fmaxf(q[2], q[3])); float s = 0.f;
#pragma unroll
                for (int bj = 0; bj < 2; ++bj)
#pragma unroll
                    for (int n = 0; n < 2; ++n) { f32x4 x = acc[ai][bj][m][n];
                        x[0] = __builtin_amdgcn_exp2f(x[0] - mm); x[1] = __builtin_amdgcn_exp2f(x[1] - mm); x[2] = __builtin_amdgcn_exp2f(x[2] - mm); x[3] = __builtin_amdgcn_exp2f(x[3] - mm);
                        acc[ai][bj][m][n] = x; s += (x[0] + x[1]) + (x[2] + x[3]); }
                s += __shfl_xor(s, 16); s += __shfl_xor(s, 32);
                if (c.fq == 0) r2[(ai * HALF + m * 16) * 4 + c.wc] = s;
                __builtin_amdgcn_sched_barrier(0); }
        asm volatile("s_waitcnt lgkmcnt(0)" ::: "memory"); __builtin_amdgcn_s_barrier(); asm volatile("" ::: "memory");
#pragma unroll
        for (int ai = 0; ai < 2; ++ai)
#pragma unroll
            for (int m = 0; m < 4; ++m) { const f32x4 q = *(const LAS f32x4*)(r2 + (ai * HALF + m * 16) * 4);
                const float inv = rcpf_((q[0] + q[1]) + (q[2] + q[3]));
                bf16_t* rowp = O + (size_t)(row0 + ai * HALF + m * 16) * D + col0;
#pragma unroll
                for (int bj = 0; bj < 2; ++bj) { const f32x4 v0 = acc[ai][bj][m][0] * inv, v1 = acc[ai][bj][m][1] * inv;
                    u32x4 w; w.x = cvt_pk_bf16(v0[0], v0[1]); w.y = cvt_pk_bf16(v0[2], v0[3]); w.z = cvt_pk_bf16(v1[0], v1[1]); w.w = cvt_pk_bf16(v1[2], v1[3]);
                    *(u32x4*)(rowp + bj * HALF) = w; }
                __builtin_amdgcn_sched_barrier(0); }
    }
};
struct EpiSwiglu {
    static constexpr bool PERM = true;
    unsigned char* O; const float* bias;
    DI void operator()(const Acc& acc, const Unit& u, const Ctx& c) const {
        int row0 = u.pm * BM + c.wr * 64 + c.fr, col0 = u.pn * BM + c.wc * 32 + 8 * c.fq; asm volatile("" : "+v"(row0), "+v"(col0));
        constexpr float us = 1.0f / (F8_XS * F8_WS);
        f32x4 bv[2][2];
#pragma unroll
        for (int bj = 0; bj < 2; ++bj)
#pragma unroll
            for (int n = 0; n < 2; ++n) bv[bj][n] = *(const f32x4*)(bias + (size_t)u.aux * 2048 + col0 + bj * HALF + 4 * n);
#pragma unroll
        for (int ai = 0; ai < 2; ++ai)
#pragma unroll
            for (int m = 0; m < 4; ++m) { unsigned char* rowp = O + (size_t)(row0 + ai * HALF + m * 16) * 1024 + (col0 >> 1);
#pragma unroll
                for (int bj = 0; bj < 2; ++bj) { const f32x4 v0 = acc[ai][bj][m][0] * us + bv[bj][0], v1 = acc[ai][bj][m][1] * us + bv[bj][1];
                    float o[4];
#define SWG(g, l) ({ const float g_ = fminf((g), 7.0f), l_ = fminf(fmaxf((l), -7.0f), 7.0f); fminf(fmaxf(g_ * sigmoidf_(1.702f * g_) * (l_ + 1.0f) * F8_AS, -448.0f), 448.0f); })
                    o[0] = SWG(v0[0], v0[1]); o[1] = SWG(v0[2], v0[3]); o[2] = SWG(v1[0], v1[1]); o[3] = SWG(v1[2], v1[3]);
#undef SWG
                    *(unsigned*)(rowp + bj * (HALF / 2)) = pk4_fp8(o[0], o[1], o[2], o[3]); } }
    }
};
struct EpiDown {
    static constexpr bool PERM = true;
    bf16_t* O; const float* bias; const float* rowgate;
    DI void operator()(const Acc& acc, const Unit& u, const Ctx& c) const {
        int row0 = u.pm * BM + c.wr * 64 + c.fr, col0 = u.pn * BM + c.wc * 32 + 8 * c.fq; asm volatile("" : "+v"(row0), "+v"(col0));
        f32x4 bv[2][2];
#pragma unroll
        for (int bj = 0; bj < 2; ++bj)
#pragma unroll
            for (int n = 0; n < 2; ++n) bv[bj][n] = *(const f32x4*)(bias + (size_t)u.aux * 1024 + col0 + bj * HALF + 4 * n);
#pragma unroll
        for (int ai = 0; ai < 2; ++ai)
#pragma unroll
            for (int m = 0; m < 4; ++m) { const int row = row0 + ai * HALF + m * 16; const float gt = rowgate[row]; bf16_t* rowp = O + (size_t)row * 1024 + col0;
#pragma unroll
                for (int bj = 0; bj < 2; ++bj) { const f32x4 v0 = (acc[ai][bj][m][0] * (1.0f / (F8_AS * F8_WS)) + bv[bj][0]) * gt, v1 = (acc[ai][bj][m][1] * (1.0f / (F8_AS * F8_WS)) + bv[bj][1]) * gt;
                    u32x4 w; w.x = cvt_pk_bf16(v0[0], v0[1]); w.y = cvt_pk_bf16(v0[2], v0[3]); w.z = cvt_pk_bf16(v1[0], v1[1]); w.w = cvt_pk_bf16(v1[2], v1[3]);
                    *(u32x4*)(rowp + bj * HALF) = w; } }
    }
};
}
constexpr size_t MiB = 1u << 20;
constexpr size_t WS_CTL = 0, CTL_ZERO_BYTES = 1 * MiB;
constexpr size_t WS_W_IN = 2 * MiB, WS_W_UQ = 10 * MiB, WS_W_UK = WS_W_UQ + 512 * 1024, WS_W_UV = WS_W_UK + 256 * 1024, WS_W_MQK = 11 * MiB, WS_W_BRM = 12 * MiB, WS_W_BRA = 13 * MiB,
                 WS_W_MIX = 14 * MiB, WS_W_CQ = 16 * MiB, WS_W_CK = 18 * MiB, WS_W_CV = 20 * MiB, WS_W_CO = 22 * MiB, WS_W_R = 24 * MiB, WS_W_GU = 26 * MiB, WS_W_DN = 90 * MiB;
constexpr size_t WS_GATES = 218 * MiB, WS_CS = 219 * MiB, WS_KPE = 223 * MiB, WS_MEMB = 225 * MiB, WS_KC = 233 * MiB, WS_VCT = 241 * MiB, WS_LOGITS = 249 * MiB,
                 WS_ASSIGN = 253 * MiB, WS_GATEW = WS_ASSIGN + 512 * 1024, WS_TOKPOS = 254 * MiB, WS_ROWGATE = WS_TOKPOS + 512 * 1024;
constexpr size_t WS_XB = 256 * MiB, WS_PROJ = 320 * MiB, WS_QN = 576 * MiB, WS_KVN = 592 * MiB, WS_XC = 608 * MiB, WS_QMLA = 640 * MiB, WS_KN = 688 * MiB, WS_VT = 720 * MiB,
                 WS_QKM = 752 * MiB, WS_KTM = 816 * MiB, WS_AO = 848 * MiB, WS_HRAW = 880 * MiB, WS_HM = 944 * MiB;
constexpr size_t WS_GATED = 576 * MiB, WS_V1B = 704 * MiB, WS_QC = 384 * MiB, WS_PC = 448 * MiB, WS_OC = 320 * MiB, WS_V2B = 864 * MiB;
constexpr size_t WS_XG = 320 * MiB, WS_ACT = 456 * MiB, WS_YB = 592 * MiB, WS_END = 976 * MiB;
static_assert((size_t)NROWS * 1024 * 2 <= 272 * MiB, "routed buffers");
static_assert(WS_ROWGATE + (size_t)NROWS * 4 <= 256 * MiB, "small buffers");
constexpr int CW_TMO = 0, CW_CNT = 64  , CW_BAR = 4096;
constexpr size_t CTL_CS1 = 64 * 1024, CTL_CB1 = 68 * 1024, CTL_CSR = 72 * 1024, CTL_CBR = 73 * 1024;
constexpr size_t CTL_STATS1 = 256 * 1024, CTL_STATS2 = 512 * 1024;

constexpr int RING_OFF = 0, RING_BYTES = 131072;
constexpr int RED_OFF = RING_BYTES;
constexpr int TST_OFF = RED_OFF + 8192;
constexpr int HIST_OFF = TST_OFF + 256, HBASE_OFF = HIST_OFF + 128;
constexpr int MISC_OFF = HBASE_OFF + 128;
constexpr int TILE_E_OFF = MISC_OFF + 128;
constexpr int LDSCTL_OFF = TST_OFF;
constexpr int LDS_BYTES = 147456;
static_assert(TILE_E_OFF + NTILES_MAX * 4 <= LDS_BYTES, "LDS map");
constexpr int NWAVES = 8;

#define LDS_WAIT() asm volatile("s_waitcnt lgkmcnt(0)" ::: "memory")
#define VM_WAIT() asm volatile("s_waitcnt vmcnt(0)" ::: "memory")

#define XB_TMO      128
#define XB_XCNT(j)  (256  + 64 * (j))
#define XB_XSUB(j)  (1280 + 64 * (j))
#define XB_XGEN(j)  (2304 + 64 * (j))
#define XB_TOP      3328
#define XB_TOPGEN   3392
#define XCD_BAR_WORDS 3456
#define XB_SPIN_CAP (1u << 18)
__device__ __forceinline__ unsigned xb_ld(unsigned* p)              { return __hip_atomic_load(p, __ATOMIC_RELAXED, __HIP_MEMORY_SCOPE_AGENT); }
__device__ __forceinline__ unsigned xb_add(unsigned* p, unsigned v) { return __hip_atomic_fetch_add(p, v, __ATOMIC_RELAXED, __HIP_MEMORY_SCOPE_AGENT); }
__device__ __forceinline__ unsigned xb_xcc_id() { return (unsigned)__builtin_amdgcn_s_getreg((3 << 11) | 20) & 0xFu; }
#define XB_SPIN(cond, bar) do { unsigned _sp = 0; while (cond) { __builtin_amdgcn_s_sleep(1); \
    if ((++_sp & 255u) == 0u) { if (xb_ld(&(bar)[XB_TMO])) break; if (_sp > XB_SPIN_CAP) { atomicAdd(&(bar)[XB_TMO], 1u); break; } } } } while (0)
struct XcdBarrier { unsigned* bar; unsigned x; volatile LAS unsigned* st; };
__device__ __forceinline__ XcdBarrier xcd_barrier_post(unsigned* bar, volatile LAS unsigned* st) {
    XcdBarrier b; b.bar = bar; b.x = xb_xcc_id(); b.st = st;
    if (threadIdx.x == 0) (void)xb_add(&bar[XB_XCNT(b.x)], 1u);
    return b;
}
__device__ __forceinline__ void xcd_barrier_complete(unsigned* bar, unsigned x, unsigned& nloc, unsigned& nx) {
    const unsigned G = gridDim.x * gridDim.y * gridDim.z;
    unsigned sum, cnt, mine, sp = 0u;
    for (;;) {
        sum = 0u; cnt = 0u; mine = 0u;
#pragma unroll
        for (unsigned j = 0; j < 16; ++j) { const unsigned c = xb_ld(&bar[XB_XCNT(j)]); sum += c; cnt += (c > 0u) ? 1u : 0u; mine = (j == x) ? c : mine; }
        if (sum == G) break;
        __builtin_amdgcn_s_sleep(1);
        if ((++sp & 255u) == 0u) { if (xb_ld(&bar[XB_TMO])) break; if (sp > XB_SPIN_CAP) { atomicAdd(&bar[XB_TMO], 1u); break; } }
    }
    nloc = mine > 0u ? mine : 1u; nx = cnt > 0u ? cnt : 1u;
}
__device__ __forceinline__ void xcd_barrier(const XcdBarrier& b) {
    asm volatile("s_waitcnt vmcnt(0)" ::: "memory");
    __syncthreads();
    if (threadIdx.x == 0) {
        unsigned* bar = b.bar;
        __builtin_amdgcn_s_waitcnt(0);
        unsigned nloc = b.st[0], nx = b.st[1];
        if (nloc == 0u) { xcd_barrier_complete(bar, b.x, nloc, nx); b.st[0] = nloc; b.st[1] = nx; }
        const unsigned old = xb_add(&bar[XB_XSUB(b.x)], 1u);
        const unsigned gen = old / nloc;
        if (old + 1u == (gen + 1u) * nloc) {
            __builtin_amdgcn_fence(__ATOMIC_RELEASE, "agent");
            asm volatile("s_waitcnt vmcnt(0)" ::: "memory");
            const unsigned og = xb_add(&bar[XB_TOP], 1u);
            const unsigned tg = og / nx;
            if (og + 1u == (tg + 1u) * nx) xb_add(&bar[XB_TOPGEN], 1u);
            else XB_SPIN(xb_ld(&bar[XB_TOPGEN]) == tg, bar);
            __builtin_amdgcn_fence(__ATOMIC_ACQUIRE, "agent");
            xb_add(&bar[XB_XGEN(b.x)], 1u);
            asm volatile("s_waitcnt vmcnt(0)" ::: "memory");
        } else {
            XB_SPIN(xb_ld(&bar[XB_XGEN(b.x)]) == gen, bar);
            __builtin_amdgcn_fence(__ATOMIC_ACQUIRE, "agent");
            asm volatile("s_waitcnt vmcnt(0)" ::: "memory");
        }
    }
    __syncthreads();
}

struct Args { const void* in[34]; float* out; unsigned char* ws; int ph_lo, ph_hi; };

DI void tr_item(const float* W, int ldw, int kvalid, bf16_t* WT, int ldk, int n0, int k0, int sc, LAS float* scr, int lane, const float* rs = nullptr) {
#pragma unroll 8
    for (int i = 0; i < 32; ++i) { const int kk = 2 * i + (lane >> 5); const int k = k0 + kk;
        float v = 0.f; if (sc >= 0 && k < kvalid) { v = W[(size_t)k * ldw + sc]; if (rs) v *= rs[k]; }
        scr[kk * 33 + (lane & 31)] = v; }
    LDS_WAIT(); asm volatile("" ::: "memory");
    const int c = lane & 7;
#pragma unroll
    for (int j = 0; j < 4; ++j) { const int n = (lane >> 3) + 8 * j; const LAS float* s = scr + (8 * c) * 33 + n;
        u32x4 o; o.x = pk2(s[0 * 33], s[1 * 33]); o.y = pk2(s[2 * 33], s[3 * 33]); o.z = pk2(s[4 * 33], s[5 * 33]); o.w = pk2(s[6 * 33], s[7 * 33]);
        *(GAS u32x4*)(WT + (size_t)(n0 + n) * ldk + k0 + 8 * c) = o; }
    LDS_WAIT(); asm volatile("" ::: "memory");
}

DI void tr_item_v4(const float* W, int ldw, bf16_t* WT, int ldk, int n0, int k0, int c0, LAS float* scr, int lane, const float* rs = nullptr) {
    const int kr = lane >> 3, n4 = lane & 7;
    f32x4 v[8];
#pragma unroll
    for (int i = 0; i < 8; ++i) v[i] = *(const f32x4*)(W + (size_t)(k0 + i * 8 + kr) * ldw + c0 + 4 * n4);
    if (rs) {
#pragma unroll
        for (int i = 0; i < 8; ++i) v[i] = v[i] * rs[k0 + i * 8 + kr]; }
#pragma unroll
    for (int i = 0; i < 8; ++i) { LAS float* p = scr + (i * 8 + kr) * 33 + 4 * n4; p[0] = v[i][0]; p[1] = v[i][1]; p[2] = v[i][2]; p[3] = v[i][3]; }
    LDS_WAIT(); asm volatile("" ::: "memory");
    const int c = lane & 7;
#pragma unroll
    for (int j = 0; j < 4; ++j) { const int n = (lane >> 3) + 8 * j; const LAS float* s = scr + (8 * c) * 33 + n;
        u32x4 o; o.x = pk2(s[0 * 33], s[1 * 33]); o.y = pk2(s[2 * 33], s[3 * 33]); o.z = pk2(s[4 * 33], s[5 * 33]); o.w = pk2(s[6 * 33], s[7 * 33]);
        *(GAS u32x4*)(WT + (size_t)(n0 + n) * ldk + k0 + 8 * c) = o; }
    LDS_WAIT(); asm volatile("" ::: "memory");
}

DI void tr_item_v4_fp8(const float* W, int ldw, unsigned char* WT, int ldk, int n0, int k0, int c0, float sc, LAS float* scr, int lane) {
    const int kr = lane >> 3, n4 = lane & 7;
    f32x4 v[8];
#pragma unroll
    for (int i = 0; i < 8; ++i) v[i] = *(const f32x4*)(W + (size_t)(k0 + i * 8 + kr) * ldw + c0 + 4 * n4);
#pragma unroll
    for (int i = 0; i < 8; ++i) { LAS float* p = scr + (i * 8 + kr) * 33 + 4 * n4; p[0] = v[i][0] * sc; p[1] = v[i][1] * sc; p[2] = v[i][2] * sc; p[3] = v[i][3] * sc; }
    LDS_WAIT(); asm volatile("" ::: "memory");
    const int c = lane & 7;
#pragma unroll
    for (int j = 0; j < 4; ++j) { const int n = (lane >> 3) + 8 * j; const LAS float* s = scr + (8 * c) * 33 + n;
        u32x2 o; o.x = pg8::pk4_fp8(s[0 * 33], s[1 * 33], s[2 * 33], s[3 * 33]); o.y = pg8::pk4_fp8(s[4 * 33], s[5 * 33], s[6 * 33], s[7 * 33]);
        *(GAS u32x2*)(WT + (size_t)(n0 + n) * ldk + k0 + 8 * c) = o; }
    LDS_WAIT(); asm volatile("" ::: "memory");
}
DI int win_src(int n) {
    if (n < 384) return n;
    if (n < 416) { const int i = (n - 384) >> 1; return 384 + i + 16 * ((n - 384) & 1); }
    if (n < 424) return 1952 + (n - 416);
    if (n < 512) return -1;
    if (n < 2048) return 416 + (n - 512);
    return 1960 + (n - 2048);
}
DI void p0_prologue(const Args& args, LAS unsigned char* lds, int vcu, int G) {
    int tid_ = threadIdx.x; asm volatile("" : "+v"(tid_)); const int lane = tid_ & 63; const int wave = __builtin_amdgcn_readfirstlane(tid_ >> 6);
    LAS float* scr = (LAS float*)(lds + RING_OFF + wave * 16384);
    const int gw = vcu * NWAVES + wave, NGW = G * NWAVES;
    unsigned char* ws = args.ws;
    const int j = lane & 31;
    constexpr int I_IN = 16 * 128, I_UQ = 4 * 24, I_UK = 4 * 16, I_UV = 4 * 16, I_MQK = 8 * 32, I_BRM = 8 * 32, I_BRA = 8 * 32, I_SQ = 16 * 32, I_R = 16 * 8,
                  I_GU = NE * 16 * 64, I_DN = NE * 16 * 32;
    constexpr int NITEMS = I_IN + I_UQ + I_UK + I_UV + I_MQK + I_BRM + I_BRA + 5 * I_SQ + I_R + I_GU + I_DN;
    for (int it = gw; it < 33 * 8; it += NGW) { const int grp = it >> 3, kc = it & 7; const bool rt = (grp == 32);
        const float* W = (const float*)args.in[rt ? 26 : 21]; const int ldw = rt ? NE : 1024; const int col = (rt ? 0 : grp * 32) + (lane & 31);
        const float* gv = (const float*)args.in[rt ? 24 : 19]; const float* bv = (const float*)args.in[rt ? 25 : 20];
        float as = 0.f, ab = 0.f;
#pragma unroll 8
        for (int i = 0; i < 64; ++i) { const int k = kc * 128 + 2 * i + (lane >> 5); const float w = W[(size_t)k * ldw + col]; as += bf2f((unsigned short)f2bf(gv[k] * w)); ab += bv[k] * w; }
        as += __shfl_xor(as, 32); ab += __shfl_xor(ab, 32);
        if (lane < 32) { float* csd = (float*)(ws + (rt ? CTL_CSR : CTL_CS1)) + col; float* cbd = (float*)(ws + (rt ? CTL_CBR : CTL_CB1)) + col;
            __hip_atomic_fetch_add(csd, as, RLX_AGENT); __hip_atomic_fetch_add(cbd, ab, RLX_AGENT); } }
    for (int it = gw; it < NITEMS; it += NGW) {
        int r = it;
        if (r < I_GU) { const int e = r / (16 * 64), q = r % (16 * 64), kb = q / 64, nb = q % 64;
            tr_item_v4_fp8((const float*)args.in[28] + (size_t)e * 1024 * 2048, 2048, ws + WS_W_GU + (size_t)e * 2048 * 1024, 1024, nb * 32, kb * 64, nb * 32, pg8::F8_WS, scr, lane); continue; } r -= I_GU;
        if (r < I_DN) { const int e = r / (16 * 32), q = r % (16 * 32), kb = q / 32, nb = q % 32;
            tr_item_v4_fp8((const float*)args.in[30] + (size_t)e * 1024 * 1024, 1024, ws + WS_W_DN + (size_t)e * 1024 * 1024, 1024, nb * 32, kb * 64, nb * 32, pg8::F8_WS, scr, lane); continue; } r -= I_DN;
        if (r < I_IN) { const int kb = r / 128, nb = r % 128;
            tr_item((const float*)args.in[3], DIN, 1024, (bf16_t*)(ws + WS_W_IN), 1024, nb * 32, kb * 64, win_src(nb * 32 + j), scr, lane); continue; } r -= I_IN;
        if (r < I_UQ) { const int kb = r / 24, nb = r % 24; const int n = nb * 32 + j, hh = n / AQK, cc = n % AQK;
            const int sc = (cc < ANOPE) ? n : hh * AQK + ANOPE + ((cc - ANOPE) >> 1) + 16 * ((cc - ANOPE) & 1);
            tr_item((const float*)args.in[14], AH * AQK, 256, (bf16_t*)(ws + WS_W_UQ), 256, nb * 32, kb * 64, sc, scr, lane); continue; } r -= I_UQ;
        if (r < I_UK) { const int kb = r / 16, nb = r % 16; const int n = nb * 32 + j;
            tr_item((const float*)args.in[15], 1024, 128, (bf16_t*)(ws + WS_W_UK), 256, nb * 32, kb * 64, (n >> 6) * 128 + (n & 63), scr, lane); continue; } r -= I_UK;
        if (r < I_UV) { const int kb = r / 16, nb = r % 16; const int n = nb * 32 + j;
            tr_item((const float*)args.in[15], 1024, 128, (bf16_t*)(ws + WS_W_UV), 256, nb * 32, kb * 64, (n >> 6) * 128 + 64 + (n & 63), scr, lane); continue; } r -= I_UV;
        if (r < I_MQK) { const int kb = r / 32, nb = r % 32; const int n = nb * 32 + j, part = n >> 9, hh = (n >> 7) & 3, e = n & 127;
            const float* src = (const float*)args.in[part ? 9 : 8];
            tr_item(src, 128, 512, (bf16_t*)(ws + WS_W_MQK), 512, nb * 32, kb * 64, ((kb >> 1) == hh) ? e : -1, scr, lane); continue; } r -= I_MQK;
        if (r < I_BRM) { const int kb = r / 32, nb = r % 32;
            tr_item_v4((const float*)args.in[16], 1024, (bf16_t*)(ws + WS_W_BRM), 512, nb * 32, kb * 64, nb * 32, scr, lane); continue; } r -= I_BRM;
        if (r < I_BRA) { const int kb = r / 32, nb = r % 32;
            tr_item_v4((const float*)args.in[17], 1024, (bf16_t*)(ws + WS_W_BRA), 512, nb * 32, kb * 64, nb * 32, scr, lane); continue; } r -= I_BRA;
        if (r < 5 * I_SQ) { const int w = r / I_SQ, q = r % I_SQ, kb = q / 32, nb = q % 32;
            const float* src; int ldw, coff; bf16_t* dst; const float* rs = nullptr;
            if (w == 0) { src = (const float*)args.in[18]; ldw = 1024; coff = 0; dst = (bf16_t*)(ws + WS_W_MIX); }
            else if (w == 1) { src = (const float*)args.in[21]; ldw = 1024; coff = 0; dst = (bf16_t*)(ws + WS_W_CQ); rs = (const float*)args.in[19]; }
            else if (w == 2) { src = (const float*)args.in[22]; ldw = 2048; coff = 0; dst = (bf16_t*)(ws + WS_W_CK); }
            else if (w == 3) { src = (const float*)args.in[22]; ldw = 2048; coff = 1024; dst = (bf16_t*)(ws + WS_W_CV); }
            else { src = (const float*)args.in[23]; ldw = 1024; coff = 0; dst = (bf16_t*)(ws + WS_W_CO); }
            tr_item_v4(src, ldw, dst, 1024, nb * 32, kb * 64, coff + nb * 32, scr, lane, rs); continue; } r -= 5 * I_SQ;
        { const int kb = r / 8, nb = r % 8; const int n = nb * 32 + j;
            tr_item((const float*)args.in[26], NE, 1024, (bf16_t*)(ws + WS_W_R), 1024, nb * 32, kb * 64, (n < NE) ? n : -1, scr, lane, (const float*)args.in[24]); }
    }
    const size_t gt = (size_t)gw * 64 + lane, NT_ = (size_t)NGW * 64;
    { const float* x = (const float*)args.in[0]; bf16_t* xb = (bf16_t*)(ws + WS_XB);
      for (size_t i = gt; i < (size_t)T * D / 8; i += NT_) { const f32x4 a = *(const f32x4*)(x + i * 8), b = *(const f32x4*)(x + i * 8 + 4);
          u32x4 o; o.x = pk2(a[0], a[1]); o.y = pk2(a[2], a[3]); o.z = pk2(b[0], b[1]); o.w = pk2(b[2], b[3]); *(u32x4*)(xb + i * 8) = o; } }
    { const float* x = (const float*)args.in[1]; bf16_t* xb = (bf16_t*)(ws + WS_MEMB);
      for (size_t i = gt; i < (size_t)NB * NMEM * D / 8; i += NT_) { const f32x4 a = *(const f32x4*)(x + i * 8), b = *(const f32x4*)(x + i * 8 + 4);
          u32x4 o; o.x = pk2(a[0], a[1]); o.y = pk2(a[2], a[3]); o.z = pk2(b[0], b[1]); o.w = pk2(b[2], b[3]); *(u32x4*)(xb + i * 8) = o; } }
}

DI void p2_tokens(const Args& args, int vcu, int G) {
    int tid_ = threadIdx.x; asm volatile("" : "+v"(tid_)); const int lane = tid_ & 63; const int wave = __builtin_amdgcn_readfirstlane(tid_ >> 6);
    unsigned char* ws = args.ws;
    const bf16_t* proj = (const bf16_t*)(ws + WS_PROJ);
    bf16_t* qn = (bf16_t*)(ws + WS_QN); bf16_t* kvn = (bf16_t*)(ws + WS_KVN); bf16_t* kpe = (bf16_t*)(ws + WS_KPE); bf16_t* xc = (bf16_t*)(ws + WS_XC); float* cs = (float*)(ws + WS_CS);
    const int* positions = (const int*)args.in[2];
    const float* conv_w = (const float*)args.in[6]; const float* conv_b = (const float*)args.in[7];
    const float* g_qlat = (const float*)args.in[12]; const float* g_kvlat = (const float*)args.in[13];
    const int gw = vcu * NWAVES + wave, NGW = G * NWAVES;
    float cw[4][8], cb[8];
#pragma unroll
    for (int jj = 0; jj < 4; ++jj)
#pragma unroll
        for (int c = 0; c < 8; ++c) cw[jj][c] = conv_w[jj * MW + 8 * lane + c];
#pragma unroll
    for (int c = 0; c < 8; ++c) cb[c] = conv_b[8 * lane + c];
    const f32x4 gq = *(const f32x4*)(g_qlat + 4 * lane);
    const f32x2 gk = *(const f32x2*)(g_kvlat + 2 * lane);
    const float inv_freq = exp2f(-(float)(lane & 15) * (13.287712379549449f / 16.0f));
    for (int t = gw; t < T; t += NGW) {
        const bf16_t* pr = proj + (size_t)t * NPROJ;
        { const u32x2 w = *(const u32x2*)(pr + PC_QLAT + 4 * lane); const float a0 = bflo(w.x), a1 = bfhi(w.x), a2 = bflo(w.y), a3 = bfhi(w.y);
          const float ss = wave_sum(a0 * a0 + a1 * a1 + a2 * a2 + a3 * a3); const float r = 1.0f / sqrtf(ss * (1.0f / AQR) + EPS);
          u32x2 o; o.x = pk2(a0 * r * gq[0], a1 * r * gq[1]); o.y = pk2(a2 * r * gq[2], a3 * r * gq[3]); *(u32x2*)(qn + (size_t)t * 256 + 4 * lane) = o; }
        { const unsigned w = *(const unsigned*)(pr + PC_KVLAT + 2 * lane); const float a0 = bflo(w), a1 = bfhi(w);
          const float ss = wave_sum(a0 * a0 + a1 * a1); const float r = 1.0f / sqrtf(ss * (1.0f / AKVR) + EPS);
          *(unsigned*)(kvn + (size_t)t * 256 + 2 * lane) = pk2(a0 * r * gk[0], a1 * r * gk[1]); *(unsigned*)(kvn + (size_t)t * 256 + 128 + 2 * lane) = 0u; }
        if (lane < 16) { const unsigned w = *(const unsigned*)(pr + PC_KROPE + 2 * lane); const float x1 = bflo(w), x2 = bfhi(w);
          const float ang = (float)positions[t] * inv_freq;
          const double rev = (double)ang * 0.15915494309189535; const float fr = (float)(rev - __builtin_rint(rev));
          const float cc = __builtin_amdgcn_cosf(fr), sn = __builtin_amdgcn_sinf(fr);
          *(unsigned*)(kpe + (size_t)t * 32 + 2 * lane) = pk2(x1 * cc - x2 * sn, x2 * cc + x1 * sn);
          *(f32x2*)(cs + (size_t)t * 32 + 2 * lane) = (f32x2){cc, sn}; }
        { const int s = t & (SEQ - 1); float a[8];
#pragma unroll
          for (int c = 0; c < 8; ++c) a[c] = cb[c];
#pragma unroll
          for (int jj = 0; jj < 4; ++jj) { const int back = 3 - jj; if (s - back >= 0) { const u32x4 w = *(const u32x4*)(pr - (size_t)back * NPROJ + PC_XM + 8 * lane);
              a[0] += cw[jj][0] * bflo(w.x); a[1] += cw[jj][1] * bfhi(w.x); a[2] += cw[jj][2] * bflo(w.y); a[3] += cw[jj][3] * bfhi(w.y);
              a[4] += cw[jj][4] * bflo(w.z); a[5] += cw[jj][5] * bfhi(w.z); a[6] += cw[jj][6] * bflo(w.w); a[7] += cw[jj][7] * bfhi(w.w); } }
#pragma unroll
          for (int c = 0; c < 8; ++c) a[c] = a[c] * sigmoidf_(a[c]);
          u32x4 o; o.x = pk2(a[0], a[1]); o.y = pk2(a[2], a[3]); o.z = pk2(a[4], a[5]); o.w = pk2(a[6], a[7]); *(u32x4*)(xc + (size_t)t * MW + 8 * lane) = o; }
    }
}

DI void p6_mpost(const Args& args, int vcu, int G) {
    int tid_ = threadIdx.x; asm volatile("" : "+v"(tid_)); const int lane = tid_ & 63; const int wave = __builtin_amdgcn_readfirstlane(tid_ >> 6);
    unsigned char* ws = args.ws;
    const float* hraw = (const float*)(ws + WS_HRAW); const bf16_t* xc = (const bf16_t*)(ws + WS_XC); const bf16_t* proj = (const bf16_t*)(ws + WS_PROJ); bf16_t* hm = (bf16_t*)(ws + WS_HM);
    const float* g_mhead = (const float*)args.in[10]; const float* w_mskip = (const float*)args.in[11];
    const int gw = vcu * NWAVES + wave, NGW = G * NWAVES;
    float gm[8], wsk[8];
#pragma unroll
    for (int c = 0; c < 8; ++c) { gm[c] = g_mhead[8 * lane + c]; wsk[c] = w_mskip[8 * lane + c]; }
    for (int t = gw; t < T; t += NGW) {
        const f32x4 h0 = *(const f32x4*)(hraw + (size_t)t * MW + 8 * lane), h1 = *(const f32x4*)(hraw + (size_t)t * MW + 8 * lane + 4);
        float h[8] = {h0[0], h0[1], h0[2], h0[3], h1[0], h1[1], h1[2], h1[3]};
        float s = 0.f;
#pragma unroll
        for (int c = 0; c < 8; ++c) s += h[c];
        s += __shfl_xor(s, 1); s += __shfl_xor(s, 2); s += __shfl_xor(s, 4); s += __shfl_xor(s, 8);
        const float mu = s * (1.0f / MHD); float q = 0.f;
#pragma unroll
        for (int c = 0; c < 8; ++c) { h[c] -= mu; q += h[c] * h[c]; }
        q += __shfl_xor(q, 1); q += __shfl_xor(q, 2); q += __shfl_xor(q, 4); q += __shfl_xor(q, 8);
        const float rstd = 1.0f / sqrtf(q * (1.0f / MHD) + EPS);
        const u32x4 xw = *(const u32x4*)(xc + (size_t)t * MW + 8 * lane); const u32x4 ow = *(const u32x4*)(proj + (size_t)t * NPROJ + PC_OP + 8 * lane);
        const float xv[8] = {bflo(xw.x), bfhi(xw.x), bflo(xw.y), bfhi(xw.y), bflo(xw.z), bfhi(xw.z), bflo(xw.w), bfhi(xw.w)};
        const float ov[8] = {bflo(ow.x), bfhi(ow.x), bflo(ow.y), bfhi(ow.y), bflo(ow.z), bfhi(ow.z), bflo(ow.w), bfhi(ow.w)};
        float o[8];
#pragma unroll
        for (int c = 0; c < 8; ++c) o[c] = sigmoidf_(ov[c]) * (h[c] * rstd * gm[c] + wsk[c] * xv[c]);
        u32x4 w; w.x = pk2(o[0], o[1]); w.y = pk2(o[2], o[3]); w.z = pk2(o[4], o[5]); w.w = pk2(o[6], o[7]); *(u32x4*)(hm + (size_t)t * MW + 8 * lane) = w;
    }
}

DI void ln_pass(const float* res, const float* add, const float* g, const float* b, float* out, bf16_t* outb, int vcu, int G) {
    int tid_ = threadIdx.x; asm volatile("" : "+v"(tid_)); const int lane = tid_ & 63; const int wave = __builtin_amdgcn_readfirstlane(tid_ >> 6);
    const int gw = vcu * NWAVES + wave, NGW = G * NWAVES;
    for (int t = gw; t < T; t += NGW) {
        f32x4 v[4]; float s = 0.f;
#pragma unroll
        for (int j = 0; j < 4; ++j) { const f32x4 r = *(const f32x4*)(res + (size_t)t * D + 4 * lane + 256 * j), a = *(const f32x4*)(add + (size_t)t * D + 4 * lane + 256 * j);
            v[j] = r * DN_ALPHA + a; s += (v[j][0] + v[j][1]) + (v[j][2] + v[j][3]); }
        const float mean = wave_sum(s) * (1.0f / D); float q = 0.f;
#pragma unroll
        for (int j = 0; j < 4; ++j) { v[j] = v[j] - mean; q += (v[j][0] * v[j][0] + v[j][1] * v[j][1]) + (v[j][2] * v[j][2] + v[j][3] * v[j][3]); }
        const float rstd = 1.0f / sqrtf(wave_sum(q) * (1.0f / D) + EPS);
#pragma unroll
        for (int j = 0; j < 4; ++j) { const f32x4 gg = *(const f32x4*)(g + 4 * lane + 256 * j), bb = *(const f32x4*)(b + 4 * lane + 256 * j);
            const f32x4 y = v[j] * rstd * gg + bb;
            *(f32x4*)(out + (size_t)t * D + 4 * lane + 256 * j) = y;
            if (outb) { u32x2 w; w.x = pk2(y[0], y[1]); w.y = pk2(y[2], y[3]); *(u32x2*)(outb + (size_t)t * D + 4 * lane + 256 * j) = w; } }
    }
}

DI void p16_topk(const Args& args, LAS unsigned char* lds, int vcu, int G) {
    unsigned char* ws = args.ws;
    const float* logits = (const float*)(ws + WS_LOGITS); const float* b_router = (const float*)args.in[27];
    int* assign = (int*)(ws + WS_ASSIGN); float* gatew = (float*)(ws + WS_GATEW);
    unsigned* gcnt = (unsigned*)(ws + WS_CTL) + CW_CNT;
    LAS unsigned* hist = (LAS unsigned*)(lds + HIST_OFF); LAS unsigned* hbase = (LAS unsigned*)(lds + HBASE_OFF);
    int tid = threadIdx.x; asm volatile("" : "+v"(tid));
    for (int blk = vcu; blk < T / 512; blk += G) {
        const int t = blk * 512 + tid;
        float v[NE];
#pragma unroll
        for (int j = 0; j < NE / 4; ++j) { const f32x4 a = *(const f32x4*)(logits + (size_t)t * NE + 4 * j), bb = *(const f32x4*)(b_router + 4 * j);
            v[4 * j] = a[0] + bb[0]; v[4 * j + 1] = a[1] + bb[1]; v[4 * j + 2] = a[2] + bb[2]; v[4 * j + 3] = a[3] + bb[3]; }
        int idx[TOPK]; float val[TOPK];
#pragma unroll
        for (int k = 0; k < TOPK; ++k) { float best = -INFINITY; int bi = 0;
#pragma unroll
            for (int e = 0; e < NE; ++e) { bool taken = false;
#pragma unroll
                for (int kk = 0; kk < k; ++kk) taken = taken || (idx[kk] == e);
                if (!taken && v[e] > best) { best = v[e]; bi = e; } }
            idx[k] = bi; val[k] = best; }
        float ex[TOPK], sum = 0.f;
#pragma unroll
        for (int k = 0; k < TOPK; ++k) { ex[k] = __expf(val[k] - val[0]); sum += ex[k]; }
        const float inv = 1.0f / sum;
        if (tid < NE) hist[tid] = 0u;
        __syncthreads();
        unsigned lr[TOPK];
#pragma unroll
        for (int k = 0; k < TOPK; ++k) lr[k] = __hip_atomic_fetch_add(hist + idx[k], 1u, __ATOMIC_RELAXED, __HIP_MEMORY_SCOPE_WORKGROUP);
        __syncthreads();
        if (tid < NE) hbase[tid] = __hip_atomic_fetch_add(gcnt + tid, hist[tid], RLX_AGENT);
        __syncthreads();
#pragma unroll
        for (int k = 0; k < TOPK; ++k) { assign[(size_t)t * TOPK + k] = (idx[k] << 20) | (int)(hbase[idx[k]] + lr[k]); gatew[(size_t)t * TOPK + k] = ex[k] * inv; }
        __syncthreads();
    }
}
DI void build_tstart(const Args& args, LAS unsigned char* lds) {
    const unsigned* gcnt = (const unsigned*)(args.ws + WS_CTL) + CW_CNT; LAS int* tst = (LAS int*)(lds + TST_OFF); LAS int* tile_e = (LAS int*)(lds + TILE_E_OFF);
    if (threadIdx.x == 0) { int acc = 0;
        for (int e = 0; e < NE; ++e) { tst[e] = acc; const unsigned c = __hip_atomic_load(gcnt + e, RLX_AGENT); acc += (int)((c + 255u) >> 8); }
        tst[NE] = acc; }
    __syncthreads();
    for (int t = threadIdx.x; t < tst[NE]; t += NWAVES * 64) { int e = 0;
        for (int j = 1; j < NE; ++j) e += (tst[j] <= t) ? 1 : 0;
        tile_e[t] = e; }
    __syncthreads();
}
DI void p17_gather(const Args& args, LAS unsigned char* lds, int vcu, int G) {
    int tid_ = threadIdx.x; asm volatile("" : "+v"(tid_)); const int lane = tid_ & 63; const int wave = __builtin_amdgcn_readfirstlane(tid_ >> 6);
    unsigned char* ws = args.ws;
    build_tstart(args, lds);
    const LAS int* tst = (const LAS int*)(lds + TST_OFF);
    const unsigned* gcnt = (const unsigned*)(ws + WS_CTL) + CW_CNT;
    const int* assign = (const int*)(ws + WS_ASSIGN); const float* gatew = (const float*)(ws + WS_GATEW);
    int* tokpos = (int*)(ws + WS_TOKPOS); float* rowgate = (float*)(ws + WS_ROWGATE);
    const bf16_t* v2 = (const bf16_t*)(ws + WS_V2B); const float* stats2 = (const float*)(ws + CTL_STATS2); unsigned char* xg = ws + WS_XG;
    const int gw = vcu * NWAVES + wave, NGW = G * NWAVES;
    f32x4 g2[4], b2[4];
#pragma unroll
    for (int j = 0; j < 4; ++j) { g2[j] = *(const f32x4*)((const float*)args.in[24] + 16 * lane + 4 * j) * pg8::F8_XS; b2[j] = *(const f32x4*)((const float*)args.in[25] + 16 * lane + 4 * j) * pg8::F8_XS; }
    for (int t = gw; t < T; t += NGW) {
        float mean, rstd; pg8::row_stats(stats2, t, mean, rstd);
        u32x4 o; const u32x4 wa = *(const u32x4*)(v2 + (size_t)t * D + 16 * lane), wb = *(const u32x4*)(v2 + (size_t)t * D + 16 * lane + 8);
        const f32x4 xin[4] = {{bflo(wa.x), bfhi(wa.x), bflo(wa.y), bfhi(wa.y)}, {bflo(wa.z), bfhi(wa.z), bflo(wa.w), bfhi(wa.w)}, {bflo(wb.x), bfhi(wb.x), bflo(wb.y), bfhi(wb.y)}, {bflo(wb.z), bfhi(wb.z), bflo(wb.w), bfhi(wb.w)}};
#pragma unroll
        for (int j = 0; j < 4; ++j) { const f32x4 x = (xin[j] - mean) * rstd * g2[j] + b2[j]; o[j] = pg8::pk4_fp8(x[0], x[1], x[2], x[3]); }
#pragma unroll
        for (int k = 0; k < TOPK; ++k) { const int as = assign[(size_t)t * TOPK + k]; const int e = as >> 20, rank = as & 0xfffff; const int pos = tst[e] * 256 + rank;
            *(u32x4*)(xg + (size_t)pos * D + 16 * lane) = o;
            if (lane == 0) { tokpos[(size_t)t * TOPK + k] = pos; rowgate[pos] = gatew[(size_t)t * TOPK + k]; } }
    }
    for (int idx = gw; idx < NE * 256; idx += NGW) { const int e = idx >> 8, r = idx & 255; const int row = tst[e] * 256 + (int)__hip_atomic_load(gcnt + e, RLX_AGENT) + r;
        if (row < tst[e + 1] * 256) { const u32x4 z = {0u, 0u, 0u, 0u}; *(u32x4*)(xg + (size_t)row * D + 16 * lane) = z; if (lane == 0) rowgate[row] = 0.f; } }
}
DI void p20_final(const Args& args, int vcu, int G) {
    int tid_ = threadIdx.x; asm volatile("" : "+v"(tid_)); const int lane = tid_ & 63; const int wave = __builtin_amdgcn_readfirstlane(tid_ >> 6);
    unsigned char* ws = args.ws;
    const int* tokpos = (const int*)(ws + WS_TOKPOS); const bf16_t* yb = (const bf16_t*)(ws + WS_YB);
    const bf16_t* v2 = (const bf16_t*)(ws + WS_V2B); const float* stats2 = (const float*)(ws + CTL_STATS2);
    const float* g2 = (const float*)args.in[24]; const float* b2 = (const float*)args.in[25];
    const float* g = (const float*)args.in[32]; const float* b = (const float*)args.in[33]; float* out = args.out;
    const int gw = vcu * NWAVES + wave, NGW = G * NWAVES;
    for (int t = gw; t < T; t += NGW) {
        int pos[TOPK];
#pragma unroll
        for (int k = 0; k < TOPK; ++k) pos[k] = tokpos[(size_t)t * TOPK + k];
        float mean2, rstd2; pg8::row_stats(stats2, t, mean2, rstd2);
        f32x4 v[4]; float s = 0.f;
#pragma unroll
        for (int j = 0; j < 4; ++j) { const u32x2 vw = *(const u32x2*)(v2 + (size_t)t * D + 4 * lane + 256 * j); const f32x4 vin = {bflo(vw.x), bfhi(vw.x), bflo(vw.y), bfhi(vw.y)};
            const f32x4 r = (vin - mean2) * rstd2 * *(const f32x4*)(g2 + 4 * lane + 256 * j) + *(const f32x4*)(b2 + 4 * lane + 256 * j);
            f32x4 a = {0.f, 0.f, 0.f, 0.f};
#pragma unroll
            for (int k = 0; k < TOPK; ++k) { const u32x2 w = *(const u32x2*)(yb + (size_t)pos[k] * D + 4 * lane + 256 * j); a[0] += bflo(w.x); a[1] += bfhi(w.x); a[2] += bflo(w.y); a[3] += bfhi(w.y); }
            v[j] = r * DN_ALPHA + a; s += (v[j][0] + v[j][1]) + (v[j][2] + v[j][3]); }
        const float mean = wave_sum(s) * (1.0f / D); float q = 0.f;
#pragma unroll
        for (int j = 0; j < 4; ++j) { v[j] = v[j] - mean; q += (v[j][0] * v[j][0] + v[j][1] * v[j][1]) + (v[j][2] * v[j][2] + v[j][3] * v[j][3]); }
        const float rstd = 1.0f / sqrtf(wave_sum(q) * (1.0f / D) + EPS);
#pragma unroll
        for (int j = 0; j < 4; ++j) { const f32x4 gg = *(const f32x4*)(g + 4 * lane + 256 * j), bb = *(const f32x4*)(b + 4 * lane + 256 * j);
            *(f32x4*)(out + (size_t)t * D + 4 * lane + 256 * j) = v[j] * rstd * gg + bb; }
    }
}
constexpr int AT_KROW = 208, AT_VROW = 136;
constexpr int AT_KBUF = 64 * AT_KROW, AT_VBUF = 64 * AT_VROW, AT_VOFF = 2 * AT_KBUF;
DI void mla_unit(int b, int h, int qb, const bf16_t* Q, const bf16_t* Kn, const bf16_t* Kpe, const bf16_t* Vt, bf16_t* O, LAS unsigned char* lds) {
    int tid = threadIdx.x; asm volatile("" : "+v"(tid)); const int lane = tid & 63, r32 = lane & 31, hi = lane >> 5; const int wid = __builtin_amdgcn_readfirstlane(tid >> 6);
    const int q0 = qb * 256 + wid * 32;
    const int qi = q0 + r32;
    const size_t tokb = (size_t)b * SEQ;
    bf16x8 qf[6];
    { const bf16_t* qp = Q + (tokb + qi) * (AH * AQK) + h * AQK + 8 * hi;
#pragma unroll
      for (int s = 0; s < 6; ++s) qf[s] = *(const bf16x8*)(qp + 16 * s); }
    const int kkey = tid >> 3, kch = tid & 7, pkey = (tid & 255) >> 2, pch = tid & 3, vd = tid >> 3, vch = tid & 7;
    const bf16_t* ksrc = Kn + (tokb + kkey) * 512 + h * 64 + kch * 8;
    const bf16_t* psrc = Kpe + (tokb + pkey) * 32 + pch * 8;
    const bf16_t* vsrc = Vt + (size_t)(h * 64 + vd) * T + tokb + vch * 8;
    const int kdst = kkey * AT_KROW + kch * 16, pdst = pkey * AT_KROW + 128 + pch * 16, vdst = AT_VOFF + vd * AT_VROW + vch * 16;
    const int nkt = 4 * (qb + 1);
    u32x4 rk, rp, rv;
    rk = *(const u32x4*)ksrc; rv = *(const u32x4*)vsrc; rp = (u32x4){0u, 0u, 0u, 0u}; if (tid < 256) rp = *(const u32x4*)psrc;
    *(LAS u32x4*)(lds + kdst) = rk; if (tid < 256) *(LAS u32x4*)(lds + pdst) = rp;
    *(LAS u32x2*)(lds + vdst) = (u32x2){rv.x, rv.y}; *(LAS u32x2*)(lds + vdst + 8) = (u32x2){rv.z, rv.w};
    __syncthreads();
    float m_run = -INFINITY, l_run = 0.f;
    f32x16 o0, o1;
#pragma unroll
    for (int r = 0; r < 16; ++r) { o0[r] = 0.f; o1[r] = 0.f; }
    for (int kt = 0; kt < nkt; ++kt) {
        const int buf = kt & 1;
        if (kt + 1 < nkt) { rk = *(const u32x4*)(ksrc + (size_t)(kt + 1) * 64 * 512); rv = *(const u32x4*)(vsrc + (kt + 1) * 64); if (tid < 256) rp = *(const u32x4*)(psrc + (size_t)(kt + 1) * 64 * 32); }
        const int key0 = kt * 64;
        if (key0 <= q0 + 31) {
            const LAS unsigned char* kb = lds + buf * AT_KBUF + r32 * AT_KROW + hi * 16;
            f32x16 p0, p1;
#pragma unroll
            for (int r = 0; r < 16; ++r) { p0[r] = 0.f; p1[r] = 0.f; }
#pragma unroll
            for (int s = 0; s < 6; ++s) { const bf16x8 a0 = *(const LAS bf16x8*)(kb + s * 32), a1 = *(const LAS bf16x8*)(kb + 32 * AT_KROW + s * 32);
                p0 = MFMA32(a0, qf[s], p0); p1 = MFMA32(a1, qf[s], p1); }
            if (key0 + 63 > q0) {
#pragma unroll
                for (int r = 0; r < 16; ++r) { const int key = key0 + crow(r, hi); if (key > qi) p0[r] = -INFINITY; if (key + 32 > qi) p1[r] = -INFINITY; }
            }
            float mx = fmaxf(p0[0], p1[0]);
#pragma unroll
            for (int r = 1; r < 16; ++r) mx = fmaxf(mx, fmaxf(p0[r], p1[r]));
            mx = fmaxf(mx, __shfl_xor(mx, 32));
            const float m_new = fmaxf(m_run, mx);
            const float alpha = __builtin_amdgcn_exp2f(m_run - m_new);
            m_run = m_new;
            float ls = 0.f;
#pragma unroll
            for (int r = 0; r < 16; ++r) { p0[r] = __builtin_amdgcn_exp2f(p0[r] - m_new); p1[r] = __builtin_amdgcn_exp2f(p1[r] - m_new); ls += p0[r] + p1[r]; }
            l_run = l_run * alpha + ls;
#pragma unroll
            for (int r = 0; r < 16; ++r) { o0[r] *= alpha; o1[r] *= alpha; }
            bf16x8 pb[4];
#pragma unroll
            for (int s = 0; s < 4; ++s) { u32x4 w;
                if (s < 2) { w.x = pk2(p0[8 * s], p0[8 * s + 1]); w.y = pk2(p0[8 * s + 2], p0[8 * s + 3]); w.z = pk2(p0[8 * s + 4], p0[8 * s + 5]); w.w = pk2(p0[8 * s + 6], p0[8 * s + 7]); }
                else { const int s2 = s - 2; w.x = pk2(p1[8 * s2], p1[8 * s2 + 1]); w.y = pk2(p1[8 * s2 + 2], p1[8 * s2 + 3]); w.z = pk2(p1[8 * s2 + 4], p1[8 * s2 + 5]); w.w = pk2(p1[8 * s2 + 6], p1[8 * s2 + 7]); }
                pb[s] = __builtin_bit_cast(bf16x8, w); }
            const LAS unsigned char* vb = lds + AT_VOFF + buf * AT_VBUF + r32 * AT_VROW + hi * 8;
#pragma unroll
            for (int s = 0; s < 4; ++s) {
                const u32x2 a0l = *(const LAS u32x2*)(vb + s * 32), a0h = *(const LAS u32x2*)(vb + s * 32 + 16);
                const u32x2 a1l = *(const LAS u32x2*)(vb + 32 * AT_VROW + s * 32), a1h = *(const LAS u32x2*)(vb + 32 * AT_VROW + s * 32 + 16);
                const bf16x8 a0 = __builtin_bit_cast(bf16x8, (u32x4){a0l.x, a0l.y, a0h.x, a0h.y}), a1 = __builtin_bit_cast(bf16x8, (u32x4){a1l.x, a1l.y, a1h.x, a1h.y});
                o0 = MFMA32(a0, pb[s], o0); o1 = MFMA32(a1, pb[s], o1); }
        }
        if (kt + 1 < nkt) { const int nb = (kt + 1) & 1;
            *(LAS u32x4*)(lds + nb * AT_KBUF + kdst) = rk; if (tid < 256) *(LAS u32x4*)(lds + nb * AT_KBUF + pdst) = rp;
            *(LAS u32x2*)(lds + nb * AT_VBUF + vdst) = (u32x2){rv.x, rv.y}; *(LAS u32x2*)(lds + nb * AT_VBUF + vdst + 8) = (u32x2){rv.z, rv.w}; }
        __syncthreads();
    }
    const float lt = l_run + __shfl_xor(l_run, 32); const float inv = 1.0f / lt;
    bf16_t* op = O + (tokb + qi) * AW + h * AVD + 4 * hi;
#pragma unroll
    for (int g = 0; g < 4; ++g) { u32x2 w0, w1;
        w0.x = pk2(o0[4 * g] * inv, o0[4 * g + 1] * inv); w0.y = pk2(o0[4 * g + 2] * inv, o0[4 * g + 3] * inv);
        w1.x = pk2(o1[4 * g] * inv, o1[4 * g + 1] * inv); w1.y = pk2(o1[4 * g + 2] * inv, o1[4 * g + 3] * inv);
        *(u32x2*)(op + 8 * g) = w0; *(u32x2*)(op + 32 + 8 * g) = w1; }
}
DI void p4_attention(const Args& args, LAS unsigned char* lds, int vcu, int G) {
    unsigned char* ws = args.ws;
    const bf16_t* Q = (const bf16_t*)(ws + WS_QMLA); const bf16_t* Kn = (const bf16_t*)(ws + WS_KN); const bf16_t* Kpe = (const bf16_t*)(ws + WS_KPE); const bf16_t* Vt = (const bf16_t*)(ws + WS_VT);
    bf16_t* O = (bf16_t*)(ws + WS_AO);
    for (int p = vcu; p < NB * AH * 4; p += G) { const int bh = p >> 2, j = p & 3; const int b = bh / AH, h = bh % AH;
        mla_unit(b, h, 7 - j, Q, Kn, Kpe, Vt, O, lds);
        mla_unit(b, h, j, Q, Kn, Kpe, Vt, O, lds); }
}

constexpr int ML_QROW = 272, ML_TROW = 144;
constexpr int ML_QS = 0, ML_KS = ML_QS + 64 * ML_QROW, ML_KTS = ML_KS + 64 * ML_QROW, ML_VTS = ML_KTS + 128 * ML_TROW, ML_CS = ML_VTS + 32 * ML_TROW, ML_SS = ML_CS + 32 * ML_QROW,
              ML_VEC = ML_SS + 64 * ML_TROW;
static_assert(ML_VEC + (7 * 64 + 128 + 4) * 4 <= RING_BYTES, "mLSTM LDS");
DI void mlstm_unit(int b, int h, int vs, const Args& args, LAS unsigned char* lds) {
    unsigned char* ws = args.ws;
    const bf16_t* qkm = (const bf16_t*)(ws + WS_QKM); const bf16_t* ktm = (const bf16_t*)(ws + WS_KTM); const bf16_t* proj = (const bf16_t*)(ws + WS_PROJ);
    const float* gates = (const float*)(ws + WS_GATES); float* hraw = (float*)(ws + WS_HRAW);
    const float b_i = ((const float*)args.in[4])[h], b_f = ((const float*)args.in[5])[h];
    int tid = threadIdx.x; asm volatile("" : "+v"(tid)); const int lane = tid & 63, r32 = lane & 31, hi = lane >> 5; const int wid = __builtin_amdgcn_readfirstlane(tid >> 6);
    LAS float* ROWT = (LAS float*)(lds + ML_VEC); LAS float* COLT = ROWT + 64; LAS float* WINT = ROWT + 128; LAS float* ENEG = ROWT + 192; LAS float* WAS = ROWT + 256;
    LAS float* NQ = ROWT + 320; LAS float* DINV = ROWT + 384; LAS float* NVEC = ROWT + 448; LAS float* SCAL = ROWT + 576;
    const size_t tokb = (size_t)b * SEQ;
    for (int i = tid; i < 32 * ML_QROW / 4; i += 512) ((LAS unsigned*)(lds + ML_CS))[i] = 0u;
    if (tid < 128) NVEC[tid] = 0.f;
    f32x16 cacc;
#pragma unroll
    for (int r = 0; r < 16; ++r) cacc[r] = 0.f;
    float m_st = 0.f;
    u32x4 sq[2], sk[2], skt[2], sv; float gi = 0.f, gf = 0.f;
    sv = (u32x4){0u, 0u, 0u, 0u};
#define ML_LOAD(c) do { const size_t tok0 = tokb + (size_t)(c) * MCH; \
        _Pragma("unroll") for (int i = 0; i < 2; ++i) { const int idx = tid + 512 * i; \
            sq[i] = *(const u32x4*)(qkm + (tok0 + (idx >> 4)) * 1024 + h * MHD + (idx & 15) * 8); \
            sk[i] = *(const u32x4*)(qkm + (tok0 + (idx >> 4)) * 1024 + 512 + h * MHD + (idx & 15) * 8); \
            skt[i] = *(const u32x4*)(ktm + (size_t)(h * MHD + (idx >> 3)) * T + tok0 + (idx & 7) * 8); } \
        if (tid < 256) sv = *(const u32x4*)(proj + (tok0 + (tid >> 2)) * NPROJ + PC_VM + h * MHD + vs * 32 + (tid & 3) * 8); \
        if (wid == 0) { gi = gates[(tok0 + lane) * 8 + h]; gf = gates[(tok0 + lane) * 8 + 4 + h]; } } while (0)
    ML_LOAD(0);
    for (int c = 0; c < SEQ / MCH; ++c) {
        const size_t tok0 = tokb + (size_t)c * MCH;
#pragma unroll
        for (int i = 0; i < 2; ++i) { const int idx = tid + 512 * i;
            *(LAS u32x4*)(lds + ML_QS + (idx >> 4) * ML_QROW + (idx & 15) * 16) = sq[i];
            *(LAS u32x4*)(lds + ML_KS + (idx >> 4) * ML_QROW + (idx & 15) * 16) = sk[i];
            *(LAS u32x4*)(lds + ML_KTS + (idx >> 3) * ML_TROW + (idx & 7) * 16) = skt[i]; }
        if (tid < 256) { const int l = tid >> 2, v0 = (tid & 3) * 8; LAS bf16_t* vt = (LAS bf16_t*)(lds + ML_VTS);
            vt[(v0 + 0) * (ML_TROW / 2) + l] = (bf16_t)(sv.x & 0xffff); vt[(v0 + 1) * (ML_TROW / 2) + l] = (bf16_t)(sv.x >> 16);
            vt[(v0 + 2) * (ML_TROW / 2) + l] = (bf16_t)(sv.y & 0xffff); vt[(v0 + 3) * (ML_TROW / 2) + l] = (bf16_t)(sv.y >> 16);
            vt[(v0 + 4) * (ML_TROW / 2) + l] = (bf16_t)(sv.z & 0xffff); vt[(v0 + 5) * (ML_TROW / 2) + l] = (bf16_t)(sv.z >> 16);
            vt[(v0 + 6) * (ML_TROW / 2) + l] = (bf16_t)(sv.w & 0xffff); vt[(v0 + 7) * (ML_TROW / 2) + l] = (bf16_t)(sv.w >> 16); }
        if (wid == 0) {
            const float xf = gf + b_f;
            const float lf = (xf >= 0.f) ? -log1pf(__expf(-xf)) : xf - log1pf(__expf(xf));
            float bb = lf;
#pragma unroll
            for (int o = 1; o < 64; o <<= 1) { const float tv = __shfl_up(bb, o); if (lane >= o) bb += tv; }
            const float btot = __shfl(bb, 63);
            const float ig = gi + b_i;
            const float a = btot - bb + ig;
            const float mchunk = wave_max(a);
            const float wa = __expf(a - mchunk);
            const float u = ig - bb;
            float pm = u;
#pragma unroll
            for (int o = 1; o < 64; o <<= 1) { const float tv = __shfl_up(pm, o); if (lane >= o) pm = fmaxf(pm, tv); }
            const float mintra = bb + pm;
            const float ginter = bb + m_st;
            const float m = fmaxf(ginter, mintra);
            const float mnew = fmaxf(btot + m_st, mchunk);
            const float sold = __expf(btot + m_st - mnew), snew = __expf(mchunk - mnew);
            ROWT[lane] = bb - m; COLT[lane] = u; WINT[lane] = __expf(ginter - m); ENEG[lane] = __expf(-m); WAS[lane] = snew * wa;
            if (lane == 0) SCAL[0] = sold;
            m_st = mnew;
        }
        __syncthreads();
        if (c + 1 < SEQ / MCH) ML_LOAD(c + 1);
        f32x16 iacc;
#pragma unroll
        for (int r = 0; r < 16; ++r) iacc[r] = 0.f;
        if (wid < 4) {
            const int jb = wid >> 1, sb = wid & 1;
            LAS bf16_t* ss = (LAS bf16_t*)(lds + ML_SS);
            if (sb <= jb) {
                f32x16 s;
#pragma unroll
                for (int r = 0; r < 16; ++r) s[r] = 0.f;
                const LAS unsigned char* qa = lds + ML_QS + (32 * jb + r32) * ML_QROW + hi * 16; const LAS unsigned char* kb = lds + ML_KS + (32 * sb + r32) * ML_QROW + hi * 16;
#pragma unroll
                for (int kk = 0; kk < 8; ++kk) s = MFMA32(*(const LAS bf16x8*)(qa + kk * 32), *(const LAS bf16x8*)(kb + kk * 32), s);
                const int sidx = 32 * sb + r32; const float ct = COLT[sidx];
#pragma unroll
                for (int r = 0; r < 16; ++r) { const int j = 32 * jb + crow(r, hi);
                    const float val = (sidx <= j) ? s[r] * __expf(ROWT[j] + ct) : 0.f;
                    ss[j * (ML_TROW / 2) + sidx] = (bf16_t)f2bf(val); }
            } else {
#pragma unroll
                for (int r = 0; r < 16; ++r) ss[(32 * jb + crow(r, hi)) * (ML_TROW / 2) + 32 * sb + r32] = (bf16_t)0;
            }
        } else if (wid < 6) {
            const int jb = wid - 4;
            const LAS unsigned char* qa = lds + ML_QS + (32 * jb + r32) * ML_QROW + hi * 16; const LAS unsigned char* cb = lds + ML_CS + r32 * ML_QROW + hi * 16;
#pragma unroll
            for (int kk = 0; kk < 8; ++kk) iacc = MFMA32(*(const LAS bf16x8*)(qa + kk * 32), *(const LAS bf16x8*)(cb + kk * 32), iacc);
        } else {
            const int j = 32 * (wid - 6) + (lane >> 1), half = lane & 1;
            const LAS unsigned char* qa = lds + ML_QS + j * ML_QROW + half * 128; float acc = 0.f;
#pragma unroll
            for (int i = 0; i < 8; ++i) { const u32x4 w = *(const LAS u32x4*)(qa + i * 16); const f32x4 n0 = *(const LAS f32x4*)(NVEC + half * 64 + i * 8), n1 = *(const LAS f32x4*)(NVEC + half * 64 + i * 8 + 4);
                acc += bflo(w.x) * n0[0] + bfhi(w.x) * n0[1] + bflo(w.y) * n0[2] + bfhi(w.y) * n0[3] + bflo(w.z) * n1[0] + bfhi(w.z) * n1[1] + bflo(w.w) * n1[2] + bfhi(w.w) * n1[3]; }
            acc += __shfl_xor(acc, 1);
            if (half == 0) NQ[j] = acc;
        }
        __syncthreads();
        if (wid < 4) {
            const float sold = SCAL[0];
#pragma unroll
            for (int r = 0; r < 16; ++r) cacc[r] *= sold;
            const LAS unsigned char* va = lds + ML_VTS + r32 * ML_TROW + hi * 16; const LAS unsigned char* kb = lds + ML_KTS + (32 * wid + r32) * ML_TROW + hi * 16;
#pragma unroll
            for (int kk = 0; kk < 4; ++kk) { const u32x4 w = *(const LAS u32x4*)(va + kk * 32);
                const f32x4 w0 = *(const LAS f32x4*)(WAS + 16 * kk + 8 * hi), w1 = *(const LAS f32x4*)(WAS + 16 * kk + 8 * hi + 4);
                u32x4 sa; sa.x = pk2(bflo(w.x) * w0[0], bfhi(w.x) * w0[1]); sa.y = pk2(bflo(w.y) * w0[2], bfhi(w.y) * w0[3]); sa.z = pk2(bflo(w.z) * w1[0], bfhi(w.z) * w1[1]); sa.w = pk2(bflo(w.w) * w1[2], bfhi(w.w) * w1[3]);
                cacc = MFMA32(__builtin_bit_cast(bf16x8, sa), *(const LAS bf16x8*)(kb + kk * 32), cacc); }
            LAS bf16_t* cs = (LAS bf16_t*)(lds + ML_CS);
#pragma unroll
            for (int r = 0; r < 16; ++r) cs[crow(r, hi) * (ML_QROW / 2) + 32 * wid + r32] = (bf16_t)f2bf(cacc[r]);
        } else if (wid < 6) {
            const int jb = wid - 4;
#pragma unroll
            for (int r = 0; r < 16; ++r) iacc[r] *= WINT[32 * jb + crow(r, hi)];
            const LAS unsigned char* sa = lds + ML_SS + (32 * jb + r32) * ML_TROW + hi * 16; const LAS unsigned char* vb = lds + ML_VTS + r32 * ML_TROW + hi * 16;
#pragma unroll
            for (int kk = 0; kk < 4; ++kk) iacc = MFMA32(*(const LAS bf16x8*)(sa + kk * 32), *(const LAS bf16x8*)(vb + kk * 32), iacc);
        } else {
            const int tl = (wid - 6) * 64 + lane;
            { const int j = tl >> 1, half = tl & 1; const LAS unsigned char* sp = lds + ML_SS + j * ML_TROW + half * 64; float rs = 0.f;
#pragma unroll
              for (int i = 0; i < 4; ++i) { const u32x4 w = *(const LAS u32x4*)(sp + i * 16); rs += (bflo(w.x) + bfhi(w.x)) + (bflo(w.y) + bfhi(w.y)) + (bflo(w.z) + bfhi(w.z)) + (bflo(w.w) + bfhi(w.w)); }
              rs += __shfl_xor(rs, 1);
              if (half == 0) { const float den = WINT[j] * NQ[j] + rs; DINV[j] = 1.0f / fmaxf(fabsf(den), ENEG[j]); } }
            { const int k = tl; const LAS unsigned char* kp = lds + ML_KTS + k * ML_TROW; float acc = SCAL[0] * NVEC[k];
#pragma unroll
              for (int i = 0; i < 8; ++i) { const u32x4 w = *(const LAS u32x4*)(kp + i * 16); const f32x4 w0 = *(const LAS f32x4*)(WAS + i * 8), w1 = *(const LAS f32x4*)(WAS + i * 8 + 4);
                  acc += bflo(w.x) * w0[0] + bfhi(w.x) * w0[1] + bflo(w.y) * w0[2] + bfhi(w.y) * w0[3] + bflo(w.z) * w1[0] + bfhi(w.z) * w1[1] + bflo(w.w) * w1[2] + bfhi(w.w) * w1[3]; }
              NVEC[k] = acc; }
        }
        __syncthreads();
        if (wid == 4 || wid == 5) {
            const int jb = wid - 4; float* hp = hraw + (tok0 + 32 * jb) * MW + h * MHD + vs * 32 + r32;
#pragma unroll
            for (int r = 0; r < 16; ++r) { const int j = crow(r, hi); hp[(size_t)j * MW] = iacc[r] * DINV[32 * jb + j]; }
        }
    }
#undef ML_LOAD
    __syncthreads();
}
DI void p5_mlstm(const Args& args, LAS unsigned char* lds, int vcu, int G) {
    for (int u = vcu; u < NB * MH * 4; u += G) { const int vs = u & 3, bh = u >> 2; mlstm_unit(bh / MH, bh % MH, vs, args, lds); }
}
#ifndef MK_ONE_LAUNCH
#define MK_ONE_LAUNCH 1
#endif
#ifndef P3SEL
#define P3SEL 31
#endif
constexpr int NPH = 20;
__global__ void __launch_bounds__(NWAVES * 64, 2) fwd_kernel(Args args) {
    extern __shared__ __attribute__((aligned(16))) unsigned char lds_raw[];
    LAS unsigned char* lds = (LAS unsigned char*)lds_raw;
    const int tid = threadIdx.x;
    const int G = gridDim.x; const int bx = blockIdx.x; const int vcu = (G % 8 == 0) ? (bx % 8) * (G / 8) + bx / 8 : bx;
    unsigned char* ws = args.ws;
    for (int u = tid; u < (LDS_BYTES - LDSCTL_OFF) / 4; u += NWAVES * 64) ((LAS unsigned*)(lds + LDSCTL_OFF))[u] = 0u;
    __syncthreads();
    volatile LAS unsigned* MISC = (volatile LAS unsigned*)(lds + MISC_OFF);
    XcdBarrier bar; bar.bar = (unsigned*)(ws + WS_CTL) + CW_BAR; bar.x = 0; bar.st = nullptr;
    const int lo = args.ph_lo, hi = args.ph_hi;
    if (hi - lo > 1) bar = xcd_barrier_post((unsigned*)(ws + WS_CTL) + CW_BAR, MISC + 8);
#ifndef PHASE_MASK
#define PHASE_MASK 0xFFFFFu
#endif
#define IN(k) (((PHASE_MASK >> (k)) & 1u) && lo <= (k) && (k) < hi)
#ifndef DUP_PHASE
#define DUP_PHASE -1
#endif
#define REP(k) _Pragma("unroll 1") for (int rep_ = 0; rep_ < ((DUP_PHASE == (k)) ? 2 : 1); ++rep_)
#define SEAM(k) do { if (IN(k) && IN(NEXTPH(k))) xcd_barrier(bar); } while (0)
#define NEXTPH(k) (((k) == 7 || (k) == 12) ? (k) + 2 : (k) + 1)
    using namespace pg8;
    LAS unsigned char* ring = lds + RING_OFF;
    const bf16_t* cws = (const bf16_t*)ws;
#define WSB(off) ((bf16_t*)(ws + (off)))
#define WSF(off) ((float*)(ws + (off)))

    if (IN(0)) REP(0) { p0_prologue(args, lds, vcu, G); }
    SEAM(0);
    if (IN(1)) REP(1) {
        { DenseOrder S; S.init(WSB(WS_XB), WSB(WS_W_IN), T, NPROJ, D, D, G, bx); EpiProj E{WSB(WS_PROJ), WSF(WS_GATES)}; gemm_phase(ring, D, D, D, S, E); }
        { DenseOrder S; S.init(WSB(WS_MEMB), WSB(WS_W_CK), NB * NMEM, D, D, D, G, bx); EpiBf16 E{WSB(WS_KC), D, 1 << 30, 1.f}; gemm_phase(ring, D, D, D, S, E); }
        { DenseOrder S; S.init(WSB(WS_W_CV), WSB(WS_MEMB), D, NB * NMEM, D, D, G, bx); EpiBf16 E{WSB(WS_VCT), NB * NMEM, 1 << 30, 1.f}; gemm_phase(ring, D, D, D, S, E); }
    }
    SEAM(1);
    if (IN(2)) REP(2) { p2_tokens(args, vcu, G); }
    SEAM(2);
    if (IN(3)) REP(3) {
        if (P3SEL & 1) { DenseOrder S; S.init(WSB(WS_QN), WSB(WS_W_UQ), T, AH * AQK, 256, 256, G, bx); EpiQmla E{WSB(WS_QMLA), WSF(WS_CS), 0.10206207261596575f * 1.4426950408889634f}; gemm_phase(ring, 256, 256, 256, S, E); }
        if (P3SEL & 2) { DenseOrder S; S.init(WSB(WS_KVN), WSB(WS_W_UK), T, 512, 256, 256, G, bx); EpiBf16 E{WSB(WS_KN), 512, 1 << 30, 1.f}; gemm_phase(ring, 256, 256, 256, S, E); }
        if (P3SEL & 4) { DenseOrder S; S.init(WSB(WS_W_UV), WSB(WS_KVN), 512, T, 256, 256, G, bx); EpiBf16 E{WSB(WS_VT), T, 1 << 30, 1.f}; gemm_phase(ring, 256, 256, 256, S, E); }
        if (P3SEL & 8) { DenseOrder S; S.init(WSB(WS_XC), WSB(WS_W_MQK), T, 1024, 512, 512, G, bx); EpiBf16 E{WSB(WS_QKM), 1024, 2, 0.08838834764831845f}; gemm_phase(ring, 512, 512, 512, S, E); }
        if (P3SEL & 16) { DenseOrder S; S.init(WSB(WS_W_MQK) + 512 * 512, WSB(WS_XC), 512, T, 512, 512, G, bx); EpiBf16 E{WSB(WS_KTM), T, 0, 0.08838834764831845f}; gemm_phase(ring, 512, 512, 512, S, E); }
    }
    SEAM(3);
    if (IN(4)) { REP(40) { p5_mlstm(args, lds, vcu, G); } REP(41) { p4_attention(args, lds, vcu, G); } }
    SEAM(4);
    if (IN(5)) REP(5) { p6_mpost(args, vcu, G); }
    SEAM(5);
    if (IN(6)) REP(6) {
        { DenseOrder S; S.init(WSB(WS_HM), WSB(WS_W_BRM), T, D, 512, 512, G, bx); EpiGate<false> E{WSB(WS_GATED), WSB(WS_PROJ), PC_GM}; gemm_phase(ring, 512, 512, 512, S, E); }
        { DenseOrder S; S.init(WSB(WS_AO), WSB(WS_W_BRA), T, D, 512, 512, G, bx); EpiGate<true> E{WSB(WS_GATED), WSB(WS_PROJ), PC_GA}; gemm_phase(ring, 512, 512, 512, S, E); }
    }
    SEAM(6);
    if (IN(7)) REP(7) { DenseOrder S; S.init(WSB(WS_GATED), WSB(WS_W_MIX), T, D, D, D, G, bx); EpiResStats<false> E{WSB(WS_XB), nullptr, nullptr, nullptr, WSB(WS_V1B), WSF(CTL_STATS1)}; gemm_phase(ring, D, D, D, S, E); }
    SEAM(7);
    if (IN(9)) REP(9) { DenseOrder S; S.init(WSB(WS_V1B), WSB(WS_W_CQ), T, D, D, D, G, bx); EpiLNApplyBf16 E{WSB(WS_QC), D, WSF(CTL_STATS1), WSF(CTL_CS1), WSF(CTL_CB1), 0.0625f * 1.4426950408889634f}; gemm_phase(ring, D, D, D, S, E); }
    SEAM(9);
    if (IN(10)) REP(10) { CrossSOrder S{(const char*)(ws + WS_QC), (const char*)(ws + WS_KC), G, vcu}; EpiSoftmax E{WSB(WS_PC), (LAS float*)(lds + RED_OFF)}; gemm_phase(ring, 256, D, D, S, E); }
    SEAM(10);
    if (IN(11)) REP(11) { CrossOOrder S{(const char*)(ws + WS_PC), (const char*)(ws + WS_VCT), G, vcu}; EpiBf16 E{WSB(WS_OC), D, 1 << 30, 1.f}; gemm_phase(ring, 256, D, NB * NMEM, S, E); }
    SEAM(11);
    if (IN(12)) REP(12) { DenseOrder S; S.init(WSB(WS_OC), WSB(WS_W_CO), T, D, D, D, G, bx); EpiResStats<true> E{WSB(WS_V1B), WSF(CTL_STATS1), (const float*)args.in[19], (const float*)args.in[20], WSB(WS_V2B), WSF(CTL_STATS2)}; gemm_phase(ring, D, D, D, S, E); }
    SEAM(12);
    if (IN(14)) REP(14) { DenseOrder S; S.init(WSB(WS_V2B), WSB(WS_W_R), T, 256, D, D, G, bx); EpiLNApplyF32 E{WSF(WS_LOGITS), NE, NE, WSF(CTL_STATS2), WSF(CTL_CSR), WSF(CTL_CBR)}; gemm_phase(ring, D, D, D, S, E); }
    SEAM(14);
    if (IN(15)) REP(15) { p16_topk(args, lds, vcu, G); }
    SEAM(15);
    if (IN(16)) REP(16) { p17_gather(args, lds, vcu, G); }
    SEAM(16);
    if (IN(17)) REP(17) { build_tstart(args, lds);
        MoeOrder S{(const char*)(ws + WS_XG), (const char*)(ws + WS_W_GU), (const LAS int*)(lds + TST_OFF), (const LAS int*)(lds + TILE_E_OFF), 8, G, vcu, (size_t)256 * D, (size_t)2048 * 1024, (size_t)256 * 1024};
        EpiSwiglu E{ws + WS_ACT, (const float*)args.in[29]}; gemm_phase<EpiSwiglu, MoeOrder, true>(ring, D, D, D, S, E); }
    SEAM(17);
    if (IN(18)) REP(18) { build_tstart(args, lds);
        MoeOrder S{(const char*)(ws + WS_ACT), (const char*)(ws + WS_W_DN), (const LAS int*)(lds + TST_OFF), (const LAS int*)(lds + TILE_E_OFF), 4, G, vcu, (size_t)256 * D, (size_t)1024 * 1024, (size_t)256 * 1024};
        EpiDown E{WSB(WS_YB), (const float*)args.in[31], WSF(WS_ROWGATE)}; gemm_phase<EpiDown, MoeOrder, true>(ring, D, D, D, S, E); }
    SEAM(18);
    if (IN(19)) REP(19) { p20_final(args, vcu, G); }
    (void)cws;
#undef IN
#undef SEAM
}

extern "C" void kernel_launch(void* const* d_in, const int* in_sizes, int n_in, void* d_out, int out_size, void* d_ws, size_t ws_size, hipStream_t stream) {
    static int grid = 0;
    if (grid == 0) {
        if (n_in != 34 || in_sizes[0] != T * D || out_size != T * D || ws_size < WS_END) { fprintf(stderr, "kernel_launch: unexpected shapes / workspace (n_in %d, ws %zu)\n", n_in, ws_size); grid = -1; return; }
        int dev = 0, cus = 0, per_cu = 0;
        if (hipGetDevice(&dev) != hipSuccess || hipDeviceGetAttribute(&cus, hipDeviceAttributeMultiprocessorCount, dev) != hipSuccess) { grid = -1; return; }
        if (hipFuncSetAttribute((const void*)fwd_kernel, hipFuncAttributeMaxDynamicSharedMemorySize, LDS_BYTES) != hipSuccess) { fprintf(stderr, "kernel_launch: hipFuncSetAttribute failed\n"); grid = -1; return; }
        if (hipOccupancyMaxActiveBlocksPerMultiprocessor(&per_cu, (const void*)fwd_kernel, NWAVES * 64, LDS_BYTES) != hipSuccess || per_cu < 1) fprintf(stderr, "kernel_launch: occupancy query says %d\n", per_cu);
        (void)hipGetLastError();
        grid = cus;
    }
    if (grid < 0) return;
    if (hipMemsetAsync((char*)d_ws + WS_CTL, 0, CTL_ZERO_BYTES, stream) != hipSuccess) return;
    Args a{};
    for (int i = 0; i < 34; ++i) a.in[i] = d_in[i];
    a.out = (float*)d_out; a.ws = (unsigned char*)d_ws;
#if MK_ONE_LAUNCH
    a.ph_lo = 0; a.ph_hi = NPH;
    hipLaunchKernelGGL(fwd_kernel, dim3(grid), dim3(NWAVES * 64), LDS_BYTES, stream, a);
#else
    for (int p = 0; p < NPH; ++p) { a.ph_lo = p; a.ph_hi = p + 1; hipLaunchKernelGGL(fwd_kernel, dim3(grid), dim3(NWAVES * 64), LDS_BYTES, stream, a); }
#endif
}
```

```cpp
#include <hip/hip_runtime.h>
#include <cstdio>
#include <cstdint>
#include <cmath>

#define LAS __attribute__((address_space(3)))
#define GAS __attribute__((address_space(1)))
typedef unsigned short bf16_t;
typedef short bf16x8 __attribute__((ext_vector_type(8)));
typedef float f32x4 __attribute__((ext_vector_type(4)));
typedef float f32x2 __attribute__((ext_vector_type(2)));
typedef float f32x16 __attribute__((ext_vector_type(16)));
typedef unsigned u32x4 __attribute__((ext_vector_type(4)));
typedef unsigned u32x2 __attribute__((ext_vector_type(2)));
typedef GAS unsigned gu32;
#define RLX_AGENT __ATOMIC_RELAXED, __HIP_MEMORY_SCOPE_AGENT
#define DI __device__ __forceinline__

constexpr int D = 1024, NB = 16, SEQ = 2048, T = NB * SEQ, NMEM = 256;
constexpr int MH = 4, MHD = 128, MW = 512, MCH = 64;
constexpr int AH = 8, ANOPE = 64, AROPE = 32, AQK = 96, AVD = 64, AW = 512, AQR = 256, AKVR = 128;
constexpr int XH = 4, XHD = 256;
constexpr int NE = 32, TOPK = 4;
constexpr int DIN = 4008, NPROJ = 4096;
constexpr float DN_ALPHA = 1.189207115002721f;
constexpr float EPS = 1e-5f;
constexpr int NASSIGN = T * TOPK;
constexpr int NROWS = NASSIGN + NE * 256;
constexpr int NTILES_MAX = NROWS / 256;
constexpr int PC_QLAT = 0, PC_KVLAT = 256, PC_KROPE = 384, PC_IG = 416, PC_FG = 420, PC_XM = 512, PC_VM = 1024, PC_OP = 1536, PC_GM = 2048, PC_GA = 3072;

DI unsigned f2bf(float f) { unsigned u = __builtin_bit_cast(unsigned, f); return (u + 0x7fffu + ((u >> 16) & 1u)) >> 16; }
DI unsigned pk2(float lo, float hi) { return f2bf(lo) | (f2bf(hi) << 16); }
DI float bf2f(unsigned short b) { return __builtin_bit_cast(float, (unsigned)b << 16); }
DI float bflo(unsigned w) { return __builtin_bit_cast(float, w << 16); }
DI float bfhi(unsigned w) { return __builtin_bit_cast(float, w & 0xffff0000u); }
DI float wave_sum(float v) {
#pragma unroll
    for (int o = 1; o < 64; o <<= 1) v += __shfl_xor(v, o);
    return v;
}
DI float wave_max(float v) {
#pragma unroll
    for (int o = 1; o < 64; o <<= 1) v = fmaxf(v, __shfl_xor(v, o));
    return v;
}
DI float rcpf_(float x) { return __builtin_amdgcn_rcpf(x); }
DI float sigmoidf_(float x) { return __builtin_amdgcn_rcpf(1.0f + __builtin_amdgcn_exp2f(-1.4426950408889634f * x)); }
DI int crow(int r, int hi) { return (r & 3) + 8 * (r >> 2) + 4 * hi; }
#define MFMA32(a, b, c) __builtin_amdgcn_mfma_f32_32x32x16_bf16((a), (b), (c), 0, 0, 0)

namespace pg8 {
constexpr int BM = 256, BK = 64, HALF = 128, HTB = HALF * BK * 2, STAGE_BYTES = 8 * HTB;
__host__ __device__ __forceinline__ int lds_byte(int r, int c) { const int st = (r >> 4) * 2 + (c >> 5), rr = r & 15, cc = c & 31, ob = rr * 64 + cc * 2; return st * 1024 + (ob ^ (((ob >> 9) & 1) << 5)); }
__host__ __device__ __forceinline__ void stage_rc(int b, int& R, int& C) { const int st = b / 1024, sb = b % 1024, swz = sb ^ (((sb >> 9) & 1) << 5); R = (st >> 1) * 16 + swz / 64; C = (st & 1) * 32 + (swz % 64) / 2; }
__host__ __device__ __forceinline__ int perm32(int rho) { const int n = rho >> 4, i = rho & 15; return 8 * (i >> 2) + 4 * n + (i & 3); }

struct Unit { int pm, pn, aux; const char* a; const char* b; };
struct Ctx { int wr, wc, fr, fq, wid, lane; };

DI unsigned cvt_pk_bf16(float lo, float hi) { unsigned r; asm volatile("v_cvt_pk_bf16_f32 %0, %1, %2" : "=v"(r) : "v"(lo), "v"(hi)); return r; }

typedef f32x4 Acc[2][2][4][2];

DI void glds16_s(const char* gbase, unsigned voff, unsigned lds_dst) { unsigned keep;
    asm volatile("s_mov_b32 %0, m0\n\ts_mov_b32 m0, %1\n\ts_nop 0\n\tglobal_load_lds_dwordx4 %2, %3\n\ts_mov_b32 m0, %0" : "=&s"(keep) : "s"(lds_dst), "v"(voff), "s"(gbase) : "memory"); }
typedef int v8i_t __attribute__((ext_vector_type(8)));
typedef int i32x4_t __attribute__((ext_vector_type(4)));
template <class Epi, class Sched, bool FP8 = false>
DI void gemm_phase(LAS unsigned char* lds, const int K, const int lda, const int ldb, const Sched& S, const Epi& E) {
    int tid = threadIdx.x; asm volatile("" : "+v"(tid));
    const int wid = __builtin_amdgcn_readfirstlane(tid >> 6), lane = tid & 63, wr = wid >> 2, wc = wid & 3, fr = lane & 15, fq = lane >> 4;
    constexpr int ESZ = FP8 ? 1 : 2;
    const int nt = K * ESZ / (BK * 2);
    unsigned voffA[2], voffB[2];
#pragma unroll
    for (int i = 0; i < 2; ++i) { int R, C; stage_rc(tid * 16 + i * 8192, R, C); const int Rb = Epi::PERM ? ((R & ~31) + perm32(R & 31)) : R;
        voffA[i] = (unsigned)(R * lda * ESZ + C * 2); voffB[i] = (unsigned)(Rb * ldb * ESZ + C * 2); }
    const size_t kstep = (size_t)(BK * 2);
    const size_t hstepA = (size_t)HALF * lda * ESZ, hstepB = (size_t)HALF * ldb * ESZ;
    const unsigned ldsw = (unsigned)wid * 1024u;
    const int aoff = lds_byte(wr * 64 + fr, fq * 8), boff = lds_byte(wc * 32 + fr, fq * 8);
    const Ctx cx{wr, wc, fr, fq, wid, lane};
    const unsigned lds_u = (unsigned)__builtin_amdgcn_readfirstlane((int)((unsigned)(size_t)lds + ldsw));
    LAS unsigned char* ldsB = lds + 4 * HTB + boff;
#define PG8_SA(b, h) (((b) * 2 + (h)) * HTB)
#define PG8_SB(b, h) ((4 + (b) * 2 + (h)) * HTB)
#define PG8_SBL(b, h) (((b) * 2 + (h)) * HTB)
#define PG8_STAGE(bufoff, gbase, voff) do { _Pragma("unroll") for (int _i = 0; _i < 2; ++_i) \
        glds16_s((const char*)(gbase), (voff)[_i], lds_u + (unsigned)((bufoff) + _i * 8192)); } while (0)
#define PG8_RD(off) (*(const LAS i32x4_t*)(lds + (off)))
#define PG8_CAT2(x, y) __builtin_shufflevector((x), (y), 0, 1, 2, 3, 4, 5, 6, 7)
#define PG8_LDA(dst, b, h) do { if constexpr (FP8) { _Pragma("unroll") for (int m = 0; m < 4; ++m) dst##8[m] = PG8_CAT2(PG8_RD(PG8_SA(b, h) + aoff + m * 2048), PG8_RD(PG8_SA(b, h) + aoff + m * 2048 + 1024)); } \
        else { _Pragma("unroll") for (int m = 0; m < 4; ++m) _Pragma("unroll") for (int k = 0; k < 2; ++k) dst[m][k] = *(const LAS bf16x8*)(lds + PG8_SA(b, h) + aoff + m * 2048 + k * 1024); } } while (0)
#define PG8_LDB(dst, b, h) do { if constexpr (FP8) { _Pragma("unroll") for (int n = 0; n < 2; ++n) dst##8[n] = PG8_CAT2(*(const LAS i32x4_t*)(ldsB + PG8_SBL(b, h) + n * 2048), *(const LAS i32x4_t*)(ldsB + PG8_SBL(b, h) + n * 2048 + 1024)); } \
        else { _Pragma("unroll") for (int n = 0; n < 2; ++n) _Pragma("unroll") for (int k = 0; k < 2; ++k) dst[n][k] = *(const LAS bf16x8*)(ldsB + PG8_SBL(b, h) + n * 2048 + k * 1024); } } while (0)
#define PG8_MMA(ai, bj, At, Bt) do { __builtin_amdgcn_s_setprio(1); \
        if constexpr (FP8) { _Pragma("unroll") for (int m = 0; m < 4; ++m) _Pragma("unroll") for (int n = 0; n < 2; ++n) \
            acc[ai][bj][m][n] = __builtin_amdgcn_mfma_scale_f32_16x16x128_f8f6f4(Bt##8[n], At##8[m], acc[ai][bj][m][n], 0, 0, 0, 0x7f7f7f7f, 0, 0x7f7f7f7f); } \
        else { _Pragma("unroll") for (int m = 0; m < 4; ++m) _Pragma("unroll") for (int n = 0; n < 2; ++n) _Pragma("unroll") for (int k = 0; k < 2; ++k) \
            acc[ai][bj][m][n] = __builtin_amdgcn_mfma_f32_16x16x32_bf16(Bt[n][k], At[m][k], acc[ai][bj][m][n], 0, 0, 0); } \
        __builtin_amdgcn_s_setprio(0); } while (0)
#define PG8_WAIT_V(n) asm volatile("s_waitcnt vmcnt(" #n ")" ::: "memory")
#define PG8_WAIT_L(n) asm volatile("s_waitcnt lgkmcnt(" #n ")" ::: "memory")
#define PG8_BAR __builtin_amdgcn_s_barrier()
#define PG8_SCHED __builtin_amdgcn_sched_barrier(0)
    Unit cur, nxt; int ui = 0;
    if (!S.next(0, cur)) return;
    Acc acc;
#pragma unroll
    for (int a = 0; a < 2; ++a)
#pragma unroll
        for (int b = 0; b < 2; ++b)
#pragma unroll
            for (int m = 0; m < 4; ++m)
#pragma unroll
                for (int n = 0; n < 2; ++n) acc[a][b][m][n] = (f32x4){0.f, 0.f, 0.f, 0.f};
    bf16x8 At[4][2], B0[2][2], B1[2][2]; v8i_t At8[4], B08[2], B18[2];
    const char* cA = cur.a; const char* cB = cur.b;
    PG8_STAGE(PG8_SB(0, 0), cB, voffB); PG8_STAGE(PG8_SB(0, 1), cB + hstepB, voffB); PG8_STAGE(PG8_SA(0, 0), cA, voffA); PG8_STAGE(PG8_SA(0, 1), cA + hstepA, voffA);
    if (wr == 1) PG8_BAR;
    PG8_WAIT_V(2); PG8_BAR;
    PG8_STAGE(PG8_SB(1, 0), cB + kstep, voffB); PG8_STAGE(PG8_SA(1, 0), cA + kstep, voffA); PG8_STAGE(PG8_SB(1, 1), cB + hstepB + kstep, voffB);
    PG8_WAIT_V(6); PG8_BAR;
    for (;;) {
        const bool has_next = S.next(ui + 1, nxt);
        const char* nA = has_next ? nxt.a : cA; const char* nB = has_next ? nxt.b : cB;
#pragma unroll 1
        for (int t = 0; t < nt; t += 2) {
            const bool last = (t == nt - 2);
            const char* a1 = cA + (size_t)(t + 1) * kstep;
            const char* a2 = last ? nA : cA + (size_t)(t + 2) * kstep; const char* b2 = last ? nB : cB + (size_t)(t + 2) * kstep;
            const char* a3 = a2 + kstep; const char* b3 = b2 + kstep;
            PG8_LDB(B0, 0, 0); PG8_LDB(B1, 0, 1); PG8_SCHED; PG8_LDA(At, 0, 0); PG8_STAGE(PG8_SA(1, 1), a1 + hstepA, voffA);
            PG8_WAIT_V(8); PG8_WAIT_L(0); PG8_BAR; PG8_MMA(0, 0, At, B0); PG8_MMA(0, 1, At, B1); PG8_BAR; PG8_SCHED;
            PG8_LDA(At, 0, 1); PG8_STAGE(PG8_SB(0, 0), b2, voffB); PG8_STAGE(PG8_SB(0, 1), b2 + hstepB, voffB); PG8_STAGE(PG8_SA(0, 0), a2, voffA);
            PG8_WAIT_V(8); PG8_WAIT_L(0); PG8_BAR; PG8_MMA(1, 0, At, B0); PG8_MMA(1, 1, At, B1); PG8_BAR; PG8_SCHED;
            PG8_LDB(B0, 1, 0); PG8_LDB(B1, 1, 1); PG8_SCHED; PG8_LDA(At, 1, 0); PG8_STAGE(PG8_SA(0, 1), a2 + hstepA, voffA);
            PG8_WAIT_V(8); PG8_WAIT_L(0); PG8_BAR; PG8_MMA(0, 0, At, B0); PG8_MMA(0, 1, At, B1); PG8_BAR; PG8_SCHED;
            PG8_LDA(At, 1, 1); PG8_STAGE(PG8_SB(1, 0), b3, voffB); PG8_STAGE(PG8_SB(1, 1), b3 + hstepB, voffB); PG8_STAGE(PG8_SA(1, 0), a3, voffA);
            PG8_WAIT_V(8); PG8_WAIT_L(0); PG8_BAR; PG8_MMA(1, 0, At, B0); PG8_MMA(1, 1, At, B1); PG8_BAR; PG8_SCHED;
        }
        if (wr == 0) PG8_BAR;
        E(acc, cur, cx);
        if (!has_next) break;
#pragma unroll
        for (int a = 0; a < 2; ++a)
#pragma unroll
            for (int b = 0; b < 2; ++b)
#pragma unroll
                for (int m = 0; m < 4; ++m)
#pragma unroll
                    for (int n = 0; n < 2; ++n) acc[a][b][m][n] = (f32x4){0.f, 0.f, 0.f, 0.f};
        cur = nxt; cA = nA; cB = nB; ++ui;
        if (wr == 1) PG8_BAR;
    }
    PG8_WAIT_V(0);
    PG8_BAR;
#undef PG8_SA
#undef PG8_SB
#undef PG8_SBL
#undef PG8_STAGE
#undef PG8_LDA
#undef PG8_LDB
#undef PG8_MMA
#undef PG8_CAT2
#undef PG8_RD
#undef PG8_WAIT_V
#undef PG8_WAIT_L
#undef PG8_BAR
#undef PG8_SCHED
}
}
namespace pg8 {
constexpr int NXCD = 8, WGM = 8;
struct DenseOrder {
    const char* A; const char* B; int nM, nN, nwg, G, c; size_t strideA, strideB;
    DI void init(const void* A_, const void* B_, int M, int N, int lda, int ldb, int G_, int c_) { A = (const char*)A_; B = (const char*)B_; nM = M / BM; nN = N / BM; nwg = nM * nN; G = G_; c = c_;
        strideA = (size_t)BM * lda * 2; strideB = (size_t)BM * ldb * 2; }
    DI bool next(int i, Unit& u) const {
        const long L = (long)i * G + c; if (L >= nwg) return false;
        int wgid = (int)L; { const int q = nwg / NXCD, r = nwg % NXCD, xcd = wgid % NXCD, off = wgid / NXCD; wgid = (xcd < r ? xcd * (q + 1) : r * (q + 1) + (xcd - r) * q) + off; }
        const int nig = WGM * nN, gid = wgid / nig, fm = gid * WGM, gsz = (nM - fm) < WGM ? (nM - fm) : WGM;
        u.pm = fm + ((wgid % nig) % gsz); u.pn = (wgid % nig) / gsz; u.aux = 0;
        u.a = A + (size_t)u.pm * strideA; u.b = B + (size_t)u.pn * strideB; return true;
    }
};
struct CrossSOrder {
    const char* Q; const char* Kc; int G, v;
    DI bool next(int i, Unit& u) const {
        const int L = i * G + v; if (L >= (T / 256) * XH) return false;
        u.pm = L >> 2; u.pn = L & 3; u.aux = 0;
        u.a = Q + ((size_t)u.pm * 256 * D + u.pn * 256) * 2; u.b = Kc + ((size_t)(u.pm >> 3) * 256 * D + u.pn * 256) * 2; return true;
    }
};
struct CrossOOrder {
    const char* P; const char* Vt; int G, v;
    DI bool next(int i, Unit& u) const {
        const int L = i * G + v; if (L >= (T / 256) * XH) return false;
        u.pm = L >> 2; u.pn = L & 3; u.aux = 0;
        u.a = P + ((size_t)u.pm * 256 * D + u.pn * 256) * 2; u.b = Vt + ((size_t)u.pn * 256 * (NB * NMEM) + (size_t)(u.pm >> 3) * 256) * 2; return true;
    }
};
struct MoeOrder {
    const char* A; const char* W; const LAS int* tstart; const LAS int* tile_e; int npn, G, v; size_t strideA, strideW, strideN;
    DI bool next(int i, Unit& u) const {
        const int L = i * G + v; const int total = __builtin_amdgcn_readfirstlane(tstart[NE]) * npn; if (L >= total) return false;
        const int tile = L / npn; u.pm = tile; u.pn = L - tile * npn;
        const int e = __builtin_amdgcn_readfirstlane(tile_e[tile]);
        u.aux = e;
        u.a = A + (size_t)tile * strideA; u.b = W + (size_t)e * strideW + (size_t)u.pn * strideN; return true;
    }
};

DI unsigned pk4_fp8(float a, float b, float c, float d) { int w = 0; w = __builtin_amdgcn_cvt_pk_fp8_f32(a, b, w, false); w = __builtin_amdgcn_cvt_pk_fp8_f32(c, d, w, true); return (unsigned)w; }
constexpr float F8_XS = 16.0f, F8_WS = 64.0f, F8_AS = 8.0f;
struct EpiBf16 {
    static constexpr bool PERM = true;
    bf16_t* O; int ldc; int sc_from; float scale;
    DI void operator()(const Acc& acc, const Unit& u, const Ctx& c) const {
        int row0 = u.pm * BM + c.wr * 64 + c.fr, col0 = u.pn * BM + c.wc * 32 + 8 * c.fq; asm volatile("" : "+v"(row0), "+v"(col0));
        const float sc = (u.pn >= sc_from) ? scale : 1.0f;
#pragma unroll
        for (int ai = 0; ai < 2; ++ai)
#pragma unroll
            for (int m = 0; m < 4; ++m) { bf16_t* rowp = O + (size_t)(row0 + ai * HALF + m * 16) * ldc + col0;
#pragma unroll
                for (int bj = 0; bj < 2; ++bj) { const f32x4 v0 = acc[ai][bj][m][0] * sc, v1 = acc[ai][bj][m][1] * sc;
                    u32x4 w; w.x = cvt_pk_bf16(v0[0], v0[1]); w.y = cvt_pk_bf16(v0[2], v0[3]); w.z = cvt_pk_bf16(v1[0], v1[1]); w.w = cvt_pk_bf16(v1[2], v1[3]);
                    *(u32x4*)(rowp + bj * HALF) = w; } }
    }
};
struct EpiProj {
    static constexpr bool PERM = true;
    bf16_t* O; float* gates;
    DI void operator()(const Acc& acc, const Unit& u, const Ctx& c) const {
        int row0 = u.pm * BM + c.wr * 64 + c.fr, col0 = u.pn * BM + c.wc * 32 + 8 * c.fq; asm volatile("" : "+v"(row0), "+v"(col0));
#pragma unroll
        for (int ai = 0; ai < 2; ++ai)
#pragma unroll
            for (int m = 0; m < 4; ++m) { const int row = row0 + ai * HALF + m * 16; bf16_t* rowp = O + (size_t)row * NPROJ + col0;
#pragma unroll
                for (int bj = 0; bj < 2; ++bj) { const f32x4 v0 = acc[ai][bj][m][0], v1 = acc[ai][bj][m][1];
                    u32x4 w; w.x = cvt_pk_bf16(v0[0], v0[1]); w.y = cvt_pk_bf16(v0[2], v0[3]); w.z = cvt_pk_bf16(v1[0], v1[1]); w.w = cvt_pk_bf16(v1[2], v1[3]);
                    *(u32x4*)(rowp + bj * HALF) = w; }
                if (u.pn == 1 && c.wc == 1 && c.fq == 0) { *(f32x4*)(gates + (size_t)row * 8) = acc[ai][1][m][0]; *(f32x4*)(gates + (size_t)row * 8 + 4) = acc[ai][1][m][1]; } }
    }
};
struct EpiQmla {
    static constexpr bool PERM = true;
    bf16_t* O; const float* cs;
    float scale;
    DI void operator()(const Acc& acc, const Unit& u, const Ctx& c) const {
        int row0 = u.pm * BM + c.wr * 64 + c.fr, col0 = u.pn * BM + c.wc * 32 + 8 * c.fq; asm volatile("" : "+v"(row0), "+v"(col0));
#pragma unroll
        for (int ai = 0; ai < 2; ++ai)
#pragma unroll
            for (int m = 0; m < 4; ++m) { const int row = row0 + ai * HALF + m * 16; bf16_t* rowp = O + (size_t)row * (AH * AQK) + col0;
#pragma unroll
                for (int bj = 0; bj < 2; ++bj) { f32x4 v0 = acc[ai][bj][m][0] * scale, v1 = acc[ai][bj][m][1] * scale;
                    const int cc = (col0 + bj * HALF) % AQK;
                    if (cc >= ANOPE) { const int p0 = (cc - ANOPE) >> 1;
                        const f32x4 t0 = *(const f32x4*)(cs + (size_t)row * 32 + p0 * 2), t1 = *(const f32x4*)(cs + (size_t)row * 32 + p0 * 2 + 4);
                        f32x4 r0, r1;
                        r0[0] = v0[0] * t0[0] - v0[1] * t0[1]; r0[1] = v0[1] * t0[0] + v0[0] * t0[1];
                        r0[2] = v0[2] * t0[2] - v0[3] * t0[3]; r0[3] = v0[3] * t0[2] + v0[2] * t0[3];
                        r1[0] = v1[0] * t1[0] - v1[1] * t1[1]; r1[1] = v1[1] * t1[0] + v1[0] * t1[1];
                        r1[2] = v1[2] * t1[2] - v1[3] * t1[3]; r1[3] = v1[3] * t1[2] + v1[2] * t1[3];
                        v0 = r0; v1 = r1; }
                    u32x4 w; w.x = cvt_pk_bf16(v0[0], v0[1]); w.y = cvt_pk_bf16(v0[2], v0[3]); w.z = cvt_pk_bf16(v1[0], v1[1]); w.w = cvt_pk_bf16(v1[2], v1[3]);
                    *(u32x4*)(rowp + bj * HALF) = w; } }
    }
};
template <bool ADD> struct EpiGate {
    static constexpr bool PERM = true;
    bf16_t* O; const bf16_t* proj; int gcol;
    DI void operator()(const Acc& acc, const Unit& u, const Ctx& c) const {
        int row0 = u.pm * BM + c.wr * 64 + c.fr, col0 = u.pn * BM + c.wc * 32 + 8 * c.fq; asm volatile("" : "+v"(row0), "+v"(col0));
#pragma unroll
        for (int ai = 0; ai < 2; ++ai) {
            u32x4 gg[4][2], pp[4][2];
#pragma unroll
            for (int m = 0; m < 4; ++m)
#pragma unroll
                for (int bj = 0; bj < 2; ++bj) { const int row = row0 + ai * HALF + m * 16; gg[m][bj] = *(const u32x4*)(proj + (size_t)row * NPROJ + gcol + col0 + bj * HALF);
                    if (ADD) pp[m][bj] = *(const u32x4*)(O + (size_t)row * D + col0 + bj * HALF); }
#pragma unroll
            for (int m = 0; m < 4; ++m) { const int row = row0 + ai * HALF + m * 16; bf16_t* rowp = O + (size_t)row * D + col0;
#pragma unroll
                for (int bj = 0; bj < 2; ++bj) { const f32x4 v0 = acc[ai][bj][m][0], v1 = acc[ai][bj][m][1];
                    const u32x4 g = gg[m][bj];
                    float o[8];
                    o[0] = sigmoidf_(bflo(g.x)) * v0[0]; o[1] = sigmoidf_(bfhi(g.x)) * v0[1]; o[2] = sigmoidf_(bflo(g.y)) * v0[2]; o[3] = sigmoidf_(bfhi(g.y)) * v0[3];
                    o[4] = sigmoidf_(bflo(g.z)) * v1[0]; o[5] = sigmoidf_(bfhi(g.z)) * v1[1]; o[6] = sigmoidf_(bflo(g.w)) * v1[2]; o[7] = sigmoidf_(bfhi(g.w)) * v1[3];
                    if (ADD) { const u32x4 p = pp[m][bj];
                        o[0] += bflo(p.x); o[1] += bfhi(p.x); o[2] += bflo(p.y); o[3] += bfhi(p.y); o[4] += bflo(p.z); o[5] += bfhi(p.z); o[6] += bflo(p.w); o[7] += bfhi(p.w); }
                    u32x4 w; w.x = cvt_pk_bf16(o[0], o[1]); w.y = cvt_pk_bf16(o[2], o[3]); w.z = cvt_pk_bf16(o[4], o[5]); w.w = cvt_pk_bf16(o[6], o[7]);
                    *(u32x4*)(rowp + bj * HALF) = w; } }
            __builtin_amdgcn_sched_barrier(0); }
    }
};
struct EpiF32 {
    static constexpr bool PERM = false;
    float* C; int ldc; int ncols_valid;
    DI void operator()(const Acc& acc, const Unit& u, const Ctx& c) const {
        int row0 = u.pm * BM + c.wr * 64 + c.fr, col0 = u.pn * BM + c.wc * 32 + 4 * c.fq; asm volatile("" : "+v"(row0), "+v"(col0));
#pragma unroll
        for (int ai = 0; ai < 2; ++ai)
#pragma unroll
            for (int m = 0; m < 4; ++m) { float* rowp = C + (size_t)(row0 + ai * HALF + m * 16) * ldc + col0;
#pragma unroll
                for (int bj = 0; bj < 2; ++bj)
#pragma unroll
                    for (int n = 0; n < 2; ++n) if (col0 + bj * HALF + n * 16 < ncols_valid) *(f32x4*)(rowp + bj * HALF + n * 16) = acc[ai][bj][m][n]; }
    }
};

DI void row_stats(const float* stats, int row, float& mean, float& rstd) { const f32x2 st = *(const f32x2*)(stats + (size_t)row * 2);
    mean = st[0] * (1.0f / D); const float var = fmaxf(st[1] * (1.0f / D) - mean * mean, 0.f); rstd = __builtin_amdgcn_rsqf(var + EPS); }
template <bool NORM> struct EpiResStats {
    static constexpr bool PERM = true;
    const bf16_t* res; const float* pstats; const float* pg; const float* pb; bf16_t* VB; float* stats;
    DI void operator()(const Acc& acc, const Unit& u, const Ctx& c) const {
        int row0 = u.pm * BM + c.wr * 64 + c.fr, col0 = u.pn * BM + c.wc * 32 + 8 * c.fq; asm volatile("" : "+v"(row0), "+v"(col0));
#pragma unroll
        for (int ai = 0; ai < 2; ++ai) {
            u32x4 rr[4][2];
#pragma unroll
            for (int m = 0; m < 4; ++m)
#pragma unroll
                for (int bj = 0; bj < 2; ++bj) rr[m][bj] = *(const u32x4*)(res + (size_t)(row0 + ai * HALF + m * 16) * D + col0 + bj * HALF);
#pragma unroll
            for (int m = 0; m < 4; ++m) { const int row = row0 + ai * HALF + m * 16; const size_t ro = (size_t)row * D + col0;
                float mean = 0.f, rstd = 1.f; if (NORM) row_stats(pstats, row, mean, rstd);
                float s1 = 0.f, s2 = 0.f;
#pragma unroll
                for (int bj = 0; bj < 2; ++bj) { const u32x4 w = rr[m][bj];
                    f32x4 r0 = {bflo(w.x), bfhi(w.x), bflo(w.y), bfhi(w.y)}, r1 = {bflo(w.z), bfhi(w.z), bflo(w.w), bfhi(w.w)};
                    if (NORM) { const f32x4 g0 = *(const f32x4*)(pg + col0 + bj * HALF), g1 = *(const f32x4*)(pg + col0 + bj * HALF + 4), b0 = *(const f32x4*)(pb + col0 + bj * HALF), b1 = *(const f32x4*)(pb + col0 + bj * HALF + 4);
                        r0 = (r0 - mean) * rstd * g0 + b0; r1 = (r1 - mean) * rstd * g1 + b1; }
                    const f32x4 v0 = r0 * DN_ALPHA + acc[ai][bj][m][0], v1 = r1 * DN_ALPHA + acc[ai][bj][m][1];
                    u32x4 o; o.x = cvt_pk_bf16(v0[0], v0[1]); o.y = cvt_pk_bf16(v0[2], v0[3]); o.z = cvt_pk_bf16(v1[0], v1[1]); o.w = cvt_pk_bf16(v1[2], v1[3]);
                    *(u32x4*)(VB + ro + bj * HALF) = o;
                    s1 += (v0[0] + v0[1]) + (v0[2] + v0[3]) + (v1[0] + v1[1]) + (v1[2] + v1[3]);
                    s2 += (v0[0] * v0[0] + v0[1] * v0[1]) + (v0[2] * v0[2] + v0[3] * v0[3]) + (v1[0] * v1[0] + v1[1] * v1[1]) + (v1[2] * v1[2] + v1[3] * v1[3]); }
                s1 += __shfl_xor(s1, 16); s1 += __shfl_xor(s1, 32); s2 += __shfl_xor(s2, 16); s2 += __shfl_xor(s2, 32);
                if (c.fq == 0) { __hip_atomic_fetch_add(stats + (size_t)row * 2, s1, RLX_AGENT); __hip_atomic_fetch_add(stats + (size_t)row * 2 + 1, s2, RLX_AGENT); } }
            __builtin_amdgcn_sched_barrier(0); }
    }
};
struct EpiLNApplyBf16 {
    static constexpr bool PERM = true;
    bf16_t* O; int ldc; const float* stats; const float* cs; const float* cb; float scale;
    DI void operator()(const Acc& acc, const Unit& u, const Ctx& c) const {
        int row0 = u.pm * BM + c.wr * 64 + c.fr, col0 = u.pn * BM + c.wc * 32 + 8 * c.fq; asm volatile("" : "+v"(row0), "+v"(col0));
        f32x4 csv[2][2], cbv[2][2];
#pragma unroll
        for (int bj = 0; bj < 2; ++bj)
#pragma unroll
            for (int n = 0; n < 2; ++n) { csv[bj][n] = *(const f32x4*)(cs + col0 + bj * HALF + 4 * n); cbv[bj][n] = *(const f32x4*)(cb + col0 + bj * HALF + 4 * n); }
        f32x2 sts[2][4];
#pragma unroll
        for (int ai = 0; ai < 2; ++ai)
#pragma unroll
            for (int m = 0; m < 4; ++m) sts[ai][m] = *(const f32x2*)(stats + (size_t)(row0 + ai * HALF + m * 16) * 2);
#pragma unroll
        for (int ai = 0; ai < 2; ++ai)
#pragma unroll
            for (int m = 0; m < 4; ++m) { const int row = row0 + ai * HALF + m * 16; const float mean = sts[ai][m][0] * (1.0f / D); const float rstd = __builtin_amdgcn_rsqf(fmaxf(sts[ai][m][1] * (1.0f / D) - mean * mean, 0.f) + EPS);
                bf16_t* rowp = O + (size_t)row * ldc + col0;
#pragma unroll
                for (int bj = 0; bj < 2; ++bj) { const f32x4 v0 = ((acc[ai][bj][m][0] - csv[bj][0] * mean) * rstd + cbv[bj][0]) * scale, v1 = ((acc[ai][bj][m][1] - csv[bj][1] * mean) * rstd + cbv[bj][1]) * scale;
                    u32x4 w; w.x = cvt_pk_bf16(v0[0], v0[1]); w.y = cvt_pk_bf16(v0[2], v0[3]); w.z = cvt_pk_bf16(v1[0], v1[1]); w.w = cvt_pk_bf16(v1[2], v1[3]);
                    *(u32x4*)(rowp + bj * HALF) = w; } }
    }
};
struct EpiLNApplyF32 {
    static constexpr bool PERM = false;
    float* C; int ldc; int ncols_valid; const float* stats; const float* cs; const float* cb;
    DI void operator()(const Acc& acc, const Unit& u, const Ctx& c) const {
        int row0 = u.pm * BM + c.wr * 64 + c.fr, col0 = u.pn * BM + c.wc * 32 + 4 * c.fq; asm volatile("" : "+v"(row0), "+v"(col0));
#pragma unroll
        for (int ai = 0; ai < 2; ++ai)
#pragma unroll
            for (int m = 0; m < 4; ++m) { const int row = row0 + ai * HALF + m * 16; float mean, rstd; row_stats(stats, row, mean, rstd);
                float* rowp = C + (size_t)row * ldc + col0;
#pragma unroll
                for (int bj = 0; bj < 2; ++bj)
#pragma unroll
                    for (int n = 0; n < 2; ++n) if (col0 + bj * HALF + n * 16 < ncols_valid) { const f32x4 csv = *(const f32x4*)(cs + col0 + bj * HALF + n * 16), cbv = *(const f32x4*)(cb + col0 + bj * HALF + n * 16);
                        *(f32x4*)(rowp + bj * HALF + n * 16) = (acc[ai][bj][m][n] - csv * mean) * rstd + cbv; } }
    }
};
struct EpiSoftmax {
    static constexpr bool PERM = true;
    bf16_t* O; LAS float* red;
    DI void operator()(Acc& acc, const Unit& u, const Ctx& c) const {
        int row0 = u.pm * BM + c.wr * 64 + c.fr, col0 = u.pn * BM + c.wc * 32 + 8 * c.fq; asm volatile("" : "+v"(row0), "+v"(col0));
        int rbase = (c.wr * 64 + c.fr) * 4; asm volatile("" : "+v"(rbase));
        LAS float* r1 = red + rbase; LAS float* r2 = red + 1024 + rbase;
#pragma unroll
        for (int ai = 0; ai < 2; ++ai)
#pragma unroll
            for (int m = 0; m < 4; ++m) { float v = -INFINITY;
#pragma unroll
                for (int bj = 0; bj < 2; ++bj)
#pragma unroll
                    for (int n = 0; n < 2; ++n) { const f32x4 x = acc[ai][bj][m][n]; v = fmaxf(v, fmaxf(fmaxf(x[0], x[1]), fmaxf(x[2], x[3]))); }
                v = fmaxf(v, __shfl_xor(v, 16)); v = fmaxf(v, __shfl_xor(v, 32));
                if (c.fq == 0) r1[(ai * HALF + m * 16) * 4 + c.wc] = v;
                __builtin_amdgcn_sched_barrier(0); }
        asm volatile("s_waitcnt lgkmcnt(0)" ::: "memory"); __builtin_amdgcn_s_barrier(); asm volatile("" ::: "memory");
#pragma unroll
        for (int ai = 0; ai < 2; ++ai)
#pragma unroll
            for (int m = 0; m < 4; ++m) { const f32x4 q = *(const LAS f32x4*)(r1 + (ai * HALF + m * 16) * 4);
                const float mm = fmaxf(fmaxf(q[0], q[1]), fmaxf(q[2], q[3])); float s = 0.f;
#pragma unroll
                for (int bj = 0; bj < 2; ++bj)
#pragma unroll
                    for (int n = 0; n < 2; ++n) { f32x4 x = acc[ai][bj][m][n];
                        x[0] = __builtin_amdgcn_exp2f(x[0] - mm); x[1] = __builtin_amdgcn_exp2f(x[1] - mm); x[2] = __builtin_amdgcn_exp2f(x[2] - mm); x[3] = __builtin_amdgcn_exp2f(x[3] - mm);
                        acc[ai][bj][m][n] = x; s += (x[0] + x[1]) + (x[2] + x[3]); }
                s += __shfl_xor(s, 16); s += __shfl_xor(s, 32);
                if (c.fq == 0) r2[(ai * HALF + m * 16) * 4 + c.wc] = s;
                __builtin_amdgcn_sched_barrier(0); }
        asm volatile("s_waitcnt lgkmcnt(0)" ::: "memory"); __builtin_amdgcn_s_barrier(); asm volatile("" ::: "memory");
#pragma unroll
        for (int ai = 0; ai < 2; ++ai)
#pragma unroll
            for (int m = 0; m < 4; ++m) { const f32x4 q = *(const LAS f32x4*)(r2 + (ai * HALF + m * 16) * 4);
                const float inv = rcpf_((q[0] + q[1]) + (q[2] + q[3]));
                bf16_t* rowp = O + (size_t)(row0 + ai * HALF + m * 16) * D + col0;
#pragma unroll
                for (int bj = 0; bj < 2; ++bj) { const f32x4 v0 = acc[ai][bj][m][0] * inv, v1 = acc[ai][bj][m][1] * inv;
                    u32x4 w; w.x = cvt_pk_bf16(v0[0], v0[1]); w.y = cvt_pk_bf16(v0[2], v0[3]); w.z = cvt_pk_bf16(v1[0], v1[1]); w.w = cvt_pk_bf16(v1[2], v1[3]);
                    *(u32x4*)(rowp + bj * HALF) = w; }
                __builtin_amdgcn_sched_barrier(0); }
    }
};
struct EpiSwiglu {
    static constexpr bool PERM = true;
    unsigned char* O; const float* bias;
    DI void operator()(const Acc& acc, const Unit& u, const Ctx& c) const {
        int row0 = u.pm * BM + c.wr * 64 + c.fr, col0 = u.pn * BM + c.wc * 32 + 8 * c.fq; asm volatile("" : "+v"(row0), "+v"(col0));
        constexpr float us = 1.0f / (F8_XS * F8_WS);
        f32x4 bv[2][2];
#pragma unroll
        for (int bj = 0; bj < 2; ++bj)
#pragma unroll
            for (int n = 0; n < 2; ++n) bv[bj][n] = *(const f32x4*)(bias + (size_t)u.aux * 2048 + col0 + bj * HALF + 4 * n);
#pragma unroll
        for (int ai = 0; ai < 2; ++ai)
#pragma unroll
            for (int m = 0; m < 4; ++m) { unsigned char* rowp = O + (size_t)(row0 + ai * HALF + m * 16) * 1024 + (col0 >> 1);
#pragma unroll
                for (int bj = 0; bj < 2; ++bj) { const f32x4 v0 = acc[ai][bj][m][0] * us + bv[bj][0], v1 = acc[ai][bj][m][1] * us + bv[bj][1];
                    float o[4];
#define SWG(g, l) ({ const float g_ = fminf((g), 7.0f), l_ = fminf(fmaxf((l), -7.0f), 7.0f); fminf(fmaxf(g_ * sigmoidf_(1.702f * g_) * (l_ + 1.0f) * F8_AS, -448.0f), 448.0f); })
                    o[0] = SWG(v0[0], v0[1]); o[1] = SWG(v0[2], v0[3]); o[2] = SWG(v1[0], v1[1]); o[3] = SWG(v1[2], v1[3]);
#undef SWG
                    *(unsigned*)(rowp + bj * (HALF / 2)) = pk4_fp8(o[0], o[1], o[2], o[3]); } }
    }
};
struct EpiDown {
    static constexpr bool PERM = true;
    bf16_t* O; const float* bias; const float* rowgate;
    DI void operator()(const Acc& acc, const Unit& u, const Ctx& c) const {
        int row0 = u.pm * BM + c.wr * 64 + c.fr, col0 = u.pn * BM + c.wc * 32 + 8 * c.fq; asm volatile("" : "+v"(row0), "+v"(col0));
        f32x4 bv[2][2];
#pragma unroll
        for (int bj = 0; bj < 2; ++bj)
#pragma unroll
            for (int n = 0; n < 2; ++n) bv[bj][n] = *(const f32x4*)(bias + (size_t)u.aux * 1024 + col0 + bj * HALF + 4 * n);
#pragma unroll
        for (int ai = 0; ai < 2; ++ai) { float gts[4];
#pragma unroll
            for (int m = 0; m < 4; ++m) gts[m] = rowgate[row0 + ai * HALF + m * 16];
#pragma unroll
            for (int m = 0; m < 4; ++m) { const int row = row0 + ai * HALF + m * 16; const float gt = gts[m]; bf16_t* rowp = O + (size_t)row * 1024 + col0;
#pragma unroll
                for (int bj = 0; bj < 2; ++bj) { const f32x4 v0 = (acc[ai][bj][m][0] * (1.0f / (F8_AS * F8_WS)) + bv[bj][0]) * gt, v1 = (acc[ai][bj][m][1] * (1.0f / (F8_AS * F8_WS)) + bv[bj][1]) * gt;
                    u32x4 w; w.x = cvt_pk_bf16(v0[0], v0[1]); w.y = cvt_pk_bf16(v0[2], v0[3]); w.z = cvt_pk_bf16(v1[0], v1[1]); w.w = cvt_pk_bf16(v1[2], v1[3]);
                    *(u32x4*)(rowp + bj * HALF) = w; } } }
    }
};
}
constexpr size_t MiB = 1u << 20;
constexpr size_t WS_CTL = 0, CTL_ZERO_BYTES = 1 * MiB;
constexpr size_t WS_W_IN = 2 * MiB, WS_W_UQ = 10 * MiB, WS_W_UK = WS_W_UQ + 512 * 1024, WS_W_UV = WS_W_UK + 256 * 1024, WS_W_MQK = 11 * MiB, WS_W_BRM = 12 * MiB, WS_W_BRA = 13 * MiB,
                 WS_W_MIX = 14 * MiB, WS_W_CQ = 16 * MiB, WS_W_CK = 18 * MiB, WS_W_CV = 20 * MiB, WS_W_CO = 22 * MiB, WS_W_R = 24 * MiB, WS_W_GU = 26 * MiB, WS_W_DN = 90 * MiB;
constexpr size_t WS_GATES = 218 * MiB, WS_CS = 219 * MiB, WS_KPE = 223 * MiB, WS_MEMB = 225 * MiB, WS_KC = 233 * MiB, WS_VCT = 241 * MiB, WS_LOGITS = 249 * MiB,
                 WS_ASSIGN = 253 * MiB, WS_GATEW = WS_ASSIGN + 512 * 1024, WS_TOKPOS = 254 * MiB, WS_ROWGATE = WS_TOKPOS + 512 * 1024;
constexpr size_t WS_XB = 256 * MiB, WS_PROJ = 320 * MiB, WS_QN = 576 * MiB, WS_KVN = 592 * MiB, WS_XC = 608 * MiB, WS_QMLA = 640 * MiB, WS_KN = 688 * MiB, WS_VT = 720 * MiB,
                 WS_QKM = 752 * MiB, WS_KTM = 816 * MiB, WS_AO = 848 * MiB, WS_HRAW = 880 * MiB, WS_HM = 944 * MiB;
constexpr size_t WS_GATED = 576 * MiB, WS_V1B = 704 * MiB, WS_QC = 384 * MiB, WS_PC = 448 * MiB, WS_OC = 320 * MiB, WS_V2B = 864 * MiB;
constexpr size_t WS_XG = 320 * MiB, WS_ACT = 456 * MiB, WS_YB = 592 * MiB, WS_END = 976 * MiB;
static_assert((size_t)NROWS * 1024 * 2 <= 272 * MiB, "routed buffers");
static_assert(WS_ROWGATE + (size_t)NROWS * 4 <= 256 * MiB, "small buffers");
constexpr int CW_TMO = 0, CW_CNT = 64  , CW_BAR = 4096;
constexpr size_t CTL_CS1 = 64 * 1024, CTL_CB1 = 68 * 1024, CTL_CSR = 72 * 1024, CTL_CBR = 73 * 1024;
constexpr size_t CTL_STATS1 = 256 * 1024, CTL_STATS2 = 512 * 1024;

constexpr int RING_OFF = 0, RING_BYTES = 131072;
constexpr int RED_OFF = RING_BYTES;
constexpr int TST_OFF = RED_OFF + 8192;
constexpr int HIST_OFF = TST_OFF + 256, HBASE_OFF = HIST_OFF + 128;
constexpr int MISC_OFF = HBASE_OFF + 128;
constexpr int TILE_E_OFF = MISC_OFF + 128;
constexpr int LDSCTL_OFF = TST_OFF;
constexpr int LDS_BYTES = 147456;
static_assert(TILE_E_OFF + NTILES_MAX * 4 <= LDS_BYTES, "LDS map");
constexpr int NWAVES = 8;

#define LDS_WAIT() asm volatile("s_waitcnt lgkmcnt(0)" ::: "memory")
#define VM_WAIT() asm volatile("s_waitcnt vmcnt(0)" ::: "memory")

#define XB_TMO      128
#define XB_XCNT(j)  (256  + 64 * (j))
#define XB_XSUB(j)  (1280 + 64 * (j))
#define XB_XGEN(j)  (2304 + 64 * (j))
#define XB_TOP      3328
#define XB_TOPGEN   3392
#define XCD_BAR_WORDS 3456
#define XB_SPIN_CAP (1u << 18)
__device__ __forceinline__ unsigned xb_ld(unsigned* p)              { return __hip_atomic_load(p, __ATOMIC_RELAXED, __HIP_MEMORY_SCOPE_AGENT); }
__device__ __forceinline__ unsigned xb_add(unsigned* p, unsigned v) { return __hip_atomic_fetch_add(p, v, __ATOMIC_RELAXED, __HIP_MEMORY_SCOPE_AGENT); }
__device__ __forceinline__ unsigned xb_xcc_id() { return (unsigned)__builtin_amdgcn_s_getreg((3 << 11) | 20) & 0xFu; }
#define XB_SPIN(cond, bar) do { unsigned _sp = 0; while (cond) { __builtin_amdgcn_s_sleep(1); \
    if ((++_sp & 255u) == 0u) { if (xb_ld(&(bar)[XB_TMO])) break; if (_sp > XB_SPIN_CAP) { atomicAdd(&(bar)[XB_TMO], 1u); break; } } } } while (0)
struct XcdBarrier { unsigned* bar; unsigned x; volatile LAS unsigned* st; };
__device__ __forceinline__ XcdBarrier xcd_barrier_post(unsigned* bar, volatile LAS unsigned* st) {
    XcdBarrier b; b.bar = bar; b.x = xb_xcc_id(); b.st = st;
    if (threadIdx.x == 0) (void)xb_add(&bar[XB_XCNT(b.x)], 1u);
    return b;
}
__device__ __forceinline__ void xcd_barrier_complete(unsigned* bar, unsigned x, unsigned& nloc, unsigned& nx) {
    const unsigned G = gridDim.x * gridDim.y * gridDim.z;
    unsigned sum, cnt, mine, sp = 0u;
    for (;;) {
        sum = 0u; cnt = 0u; mine = 0u;
#pragma unroll
        for (unsigned j = 0; j < 16; ++j) { const unsigned c = xb_ld(&bar[XB_XCNT(j)]); sum += c; cnt += (c > 0u) ? 1u : 0u; mine = (j == x) ? c : mine; }
        if (sum == G) break;
        __builtin_amdgcn_s_sleep(1);
        if ((++sp & 255u) == 0u) { if (xb_ld(&bar[XB_TMO])) break; if (sp > XB_SPIN_CAP) { atomicAdd(&bar[XB_TMO], 1u); break; } }
    }
    nloc = mine > 0u ? mine : 1u; nx = cnt > 0u ? cnt : 1u;
}
__device__ __forceinline__ void xcd_barrier(const XcdBarrier& b) {
    asm volatile("s_waitcnt vmcnt(0)" ::: "memory");
    __syncthreads();
    if (threadIdx.x == 0) {
        unsigned* bar = b.bar;
        __builtin_amdgcn_s_waitcnt(0);
        unsigned nloc = b.st[0], nx = b.st[1];
        if (nloc == 0u) { xcd_barrier_complete(bar, b.x, nloc, nx); b.st[0] = nloc; b.st[1] = nx; }
        const unsigned old = xb_add(&bar[XB_XSUB(b.x)], 1u);
        const unsigned gen = old / nloc;
        if (old + 1u == (gen + 1u) * nloc) {
            __builtin_amdgcn_fence(__ATOMIC_RELEASE, "agent");
            asm volatile("s_waitcnt vmcnt(0)" ::: "memory");
            const unsigned og = xb_add(&bar[XB_TOP], 1u);
            const unsigned tg = og / nx;
            if (og + 1u == (tg + 1u) * nx) xb_add(&bar[XB_TOPGEN], 1u);
            else XB_SPIN(xb_ld(&bar[XB_TOPGEN]) == tg, bar);
            __builtin_amdgcn_fence(__ATOMIC_ACQUIRE, "agent");
            xb_add(&bar[XB_XGEN(b.x)], 1u);
            asm volatile("s_waitcnt vmcnt(0)" ::: "memory");
        } else {
            XB_SPIN(xb_ld(&bar[XB_XGEN(b.x)]) == gen, bar);
            __builtin_amdgcn_fence(__ATOMIC_ACQUIRE, "agent");
            asm volatile("s_waitcnt vmcnt(0)" ::: "memory");
        }
    }
    __syncthreads();
}

struct Args { const void* in[34]; float* out; unsigned char* ws; int ph_lo, ph_hi; };

DI void tr_item(const float* W, int ldw, int kvalid, bf16_t* WT, int ldk, int n0, int k0, int sc, LAS float* scr, int lane, const float* rs = nullptr) {
#pragma unroll 8
    for (int i = 0; i < 32; ++i) { const int kk = 2 * i + (lane >> 5); const int k = k0 + kk;
        float v = 0.f; if (sc >= 0 && k < kvalid) { v = W[(size_t)k * ldw + sc]; if (rs) v *= rs[k]; }
        scr[kk * 33 + (lane & 31)] = v; }
    LDS_WAIT(); asm volatile("" ::: "memory");
    const int c = lane & 7;
#pragma unroll
    for (int j = 0; j < 4; ++j) { const int n = (lane >> 3) + 8 * j; const LAS float* s = scr + (8 * c) * 33 + n;
        u32x4 o; o.x = pk2(s[0 * 33], s[1 * 33]); o.y = pk2(s[2 * 33], s[3 * 33]); o.z = pk2(s[4 * 33], s[5 * 33]); o.w = pk2(s[6 * 33], s[7 * 33]);
        *(GAS u32x4*)(WT + (size_t)(n0 + n) * ldk + k0 + 8 * c) = o; }
    LDS_WAIT(); asm volatile("" ::: "memory");
}

DI void tr_item_v4(const float* W, int ldw, bf16_t* WT, int ldk, int n0, int k0, int c0, LAS float* scr, int lane, const float* rs = nullptr) {
    const int kr = lane >> 3, n4 = lane & 7;
    f32x4 v[8];
#pragma unroll
    for (int i = 0; i < 8; ++i) v[i] = *(const f32x4*)(W + (size_t)(k0 + i * 8 + kr) * ldw + c0 + 4 * n4);
    if (rs) {
#pragma unroll
        for (int i = 0; i < 8; ++i) v[i] = v[i] * rs[k0 + i * 8 + kr]; }
#pragma unroll
    for (int i = 0; i < 8; ++i) { LAS float* p = scr + (i * 8 + kr) * 33 + 4 * n4; p[0] = v[i][0]; p[1] = v[i][1]; p[2] = v[i][2]; p[3] = v[i][3]; }
    LDS_WAIT(); asm volatile("" ::: "memory");
    const int c = lane & 7;
#pragma unroll
    for (int j = 0; j < 4; ++j) { const int n = (lane >> 3) + 8 * j; const LAS float* s = scr + (8 * c) * 33 + n;
        u32x4 o; o.x = pk2(s[0 * 33], s[1 * 33]); o.y = pk2(s[2 * 33], s[3 * 33]); o.z = pk2(s[4 * 33], s[5 * 33]); o.w = pk2(s[6 * 33], s[7 * 33]);
        *(GAS u32x4*)(WT + (size_t)(n0 + n) * ldk + k0 + 8 * c) = o; }
    LDS_WAIT(); asm volatile("" ::: "memory");
}

DI void tr_item_v4_fp8(const float* W, int ldw, unsigned char* WT, int ldk, int n0, int k0, int c0, float sc, LAS float* scr, int lane) {
    const int kr = lane >> 3, n4 = lane & 7;
    f32x4 v[8];
#pragma unroll
    for (int i = 0; i < 8; ++i) v[i] = *(const f32x4*)(W + (size_t)(k0 + i * 8 + kr) * ldw + c0 + 4 * n4);
#pragma unroll
    for (int i = 0; i < 8; ++i) { LAS float* p = scr + (i * 8 + kr) * 33 + 4 * n4; p[0] = v[i][0] * sc; p[1] = v[i][1] * sc; p[2] = v[i][2] * sc; p[3] = v[i][3] * sc; }
    LDS_WAIT(); asm volatile("" ::: "memory");
    const int c = lane & 7;
#pragma unroll
    for (int j = 0; j < 4; ++j) { const int n = (lane >> 3) + 8 * j; const LAS float* s = scr + (8 * c) * 33 + n;
        u32x2 o; o.x = pg8::pk4_fp8(s[0 * 33], s[1 * 33], s[2 * 33], s[3 * 33]); o.y = pg8::pk4_fp8(s[4 * 33], s[5 * 33], s[6 * 33], s[7 * 33]);
        *(GAS u32x2*)(WT + (size_t)(n0 + n) * ldk + k0 + 8 * c) = o; }
    LDS_WAIT(); asm volatile("" ::: "memory");
}
DI int win_src(int n) {
    if (n < 384) return n;
    if (n < 416) { const int i = (n - 384) >> 1; return 384 + i + 16 * ((n - 384) & 1); }
    if (n < 424) return 1952 + (n - 416);
    if (n < 512) return -1;
    if (n < 2048) return 416 + (n - 512);
    return 1960 + (n - 2048);
}
DI void p0_prologue(const Args& args, LAS unsigned char* lds, int vcu, int G) {
    int tid_ = threadIdx.x; asm volatile("" : "+v"(tid_)); const int lane = tid_ & 63; const int wave = __builtin_amdgcn_readfirstlane(tid_ >> 6);
    LAS float* scr = (LAS float*)(lds + RING_OFF + wave * 16384);
    const int gw = vcu * NWAVES + wave, NGW = G * NWAVES;
    unsigned char* ws = args.ws;
    const int j = lane & 31;
    constexpr int I_IN = 16 * 128, I_UQ = 4 * 24, I_UK = 4 * 16, I_UV = 4 * 16, I_MQK = 8 * 32, I_BRM = 8 * 32, I_BRA = 8 * 32, I_SQ = 16 * 32, I_R = 16 * 8,
                  I_GU = NE * 16 * 64, I_DN = NE * 16 * 32;
    constexpr int NITEMS = I_IN + I_UQ + I_UK + I_UV + I_MQK + I_BRM + I_BRA + 5 * I_SQ + I_R + I_GU + I_DN;
    for (int it = gw; it < 33 * 8; it += NGW) { const int grp = it >> 3, kc = it & 7; const bool rt = (grp == 32);
        const float* W = (const float*)args.in[rt ? 26 : 21]; const int ldw = rt ? NE : 1024; const int col = (rt ? 0 : grp * 32) + (lane & 31);
        const float* gv = (const float*)args.in[rt ? 24 : 19]; const float* bv = (const float*)args.in[rt ? 25 : 20];
        float as = 0.f, ab = 0.f;
#pragma unroll 8
        for (int i = 0; i < 64; ++i) { const int k = kc * 128 + 2 * i + (lane >> 5); const float w = W[(size_t)k * ldw + col]; as += bf2f((unsigned short)f2bf(gv[k] * w)); ab += bv[k] * w; }
        as += __shfl_xor(as, 32); ab += __shfl_xor(ab, 32);
        if (lane < 32) { float* csd = (float*)(ws + (rt ? CTL_CSR : CTL_CS1)) + col; float* cbd = (float*)(ws + (rt ? CTL_CBR : CTL_CB1)) + col;
            __hip_atomic_fetch_add(csd, as, RLX_AGENT); __hip_atomic_fetch_add(cbd, ab, RLX_AGENT); } }
    for (int it = gw; it < NITEMS; it += NGW) {
        int r = it;
        if (r < I_GU) { const int e = r / (16 * 64), q = r % (16 * 64), kb = q / 64, nb = q % 64;
            tr_item_v4_fp8((const float*)args.in[28] + (size_t)e * 1024 * 2048, 2048, ws + WS_W_GU + (size_t)e * 2048 * 1024, 1024, nb * 32, kb * 64, nb * 32, pg8::F8_WS, scr, lane); continue; } r -= I_GU;
        if (r < I_DN) { const int e = r / (16 * 32), q = r % (16 * 32), kb = q / 32, nb = q % 32;
            tr_item_v4_fp8((const float*)args.in[30] + (size_t)e * 1024 * 1024, 1024, ws + WS_W_DN + (size_t)e * 1024 * 1024, 1024, nb * 32, kb * 64, nb * 32, pg8::F8_WS, scr, lane); continue; } r -= I_DN;
        if (r < I_IN) { const int kb = r / 128, nb = r % 128;
            tr_item((const float*)args.in[3], DIN, 1024, (bf16_t*)(ws + WS_W_IN), 1024, nb * 32, kb * 64, win_src(nb * 32 + j), scr, lane); continue; } r -= I_IN;
        if (r < I_UQ) { const int kb = r / 24, nb = r % 24; const int n = nb * 32 + j, hh = n / AQK, cc = n % AQK;
            const int sc = (cc < ANOPE) ? n : hh * AQK + ANOPE + ((cc - ANOPE) >> 1) + 16 * ((cc - ANOPE) & 1);
            tr_item((const float*)args.in[14], AH * AQK, 256, (bf16_t*)(ws + WS_W_UQ), 256, nb * 32, kb * 64, sc, scr, lane); continue; } r -= I_UQ;
        if (r < I_UK) { const int kb = r / 16, nb = r % 16; const int n = nb * 32 + j;
            tr_item((const float*)args.in[15], 1024, 128, (bf16_t*)(ws + WS_W_UK), 256, nb * 32, kb * 64, (n >> 6) * 128 + (n & 63), scr, lane); continue; } r -= I_UK;
        if (r < I_UV) { const int kb = r / 16, nb = r % 16; const int n = nb * 32 + j;
            tr_item((const float*)args.in[15], 1024, 128, (bf16_t*)(ws + WS_W_UV), 256, nb * 32, kb * 64, (n >> 6) * 128 + 64 + (n & 63), scr, lane); continue; } r -= I_UV;
        if (r < I_MQK) { const int kb = r / 32, nb = r % 32; const int n = nb * 32 + j, part = n >> 9, hh = (n >> 7) & 3, e = n & 127;
            const float* src = (const float*)args.in[part ? 9 : 8];
            tr_item(src, 128, 512, (bf16_t*)(ws + WS_W_MQK), 512, nb * 32, kb * 64, ((kb >> 1) == hh) ? e : -1, scr, lane); continue; } r -= I_MQK;
        if (r < I_BRM) { const int kb = r / 32, nb = r % 32;
            tr_item_v4((const float*)args.in[16], 1024, (bf16_t*)(ws + WS_W_BRM), 512, nb * 32, kb * 64, nb * 32, scr, lane); continue; } r -= I_BRM;
        if (r < I_BRA) { const int kb = r / 32, nb = r % 32;
            tr_item_v4((const float*)args.in[17], 1024, (bf16_t*)(ws + WS_W_BRA), 512, nb * 32, kb * 64, nb * 32, scr, lane); continue; } r -= I_BRA;
        if (r < 5 * I_SQ) { const int w = r / I_SQ, q = r % I_SQ, kb = q / 32, nb = q % 32;
            const float* src; int ldw, coff; bf16_t* dst; const float* rs = nullptr;
            if (w == 0) { src = (const float*)args.in[18]; ldw = 1024; coff = 0; dst = (bf16_t*)(ws + WS_W_MIX); }
            else if (w == 1) { src = (const float*)args.in[21]; ldw = 1024; coff = 0; dst = (bf16_t*)(ws + WS_W_CQ); rs = (const float*)args.in[19]; }
            else if (w == 2) { src = (const float*)args.in[22]; ldw = 2048; coff = 0; dst = (bf16_t*)(ws + WS_W_CK); }
            else if (w == 3) { src = (const float*)args.in[22]; ldw = 2048; coff = 1024; dst = (bf16_t*)(ws + WS_W_CV); }
            else { src = (const float*)args.in[23]; ldw = 1024; coff = 0; dst = (bf16_t*)(ws + WS_W_CO); }
            tr_item_v4(src, ldw, dst, 1024, nb * 32, kb * 64, coff + nb * 32, scr, lane, rs); continue; } r -= 5 * I_SQ;
        { const int kb = r / 8, nb = r % 8; const int n = nb * 32 + j;
            tr_item((const float*)args.in[26], NE, 1024, (bf16_t*)(ws + WS_W_R), 1024, nb * 32, kb * 64, (n < NE) ? n : -1, scr, lane, (const float*)args.in[24]); }
    }
    const size_t gt = (size_t)gw * 64 + lane, NT_ = (size_t)NGW * 64;
    { const float* x = (const float*)args.in[0]; bf16_t* xb = (bf16_t*)(ws + WS_XB);
      for (size_t i = gt; i < (size_t)T * D / 8; i += NT_) { const f32x4 a = *(const f32x4*)(x + i * 8), b = *(const f32x4*)(x + i * 8 + 4);
          u32x4 o; o.x = pk2(a[0], a[1]); o.y = pk2(a[2], a[3]); o.z = pk2(b[0], b[1]); o.w = pk2(b[2], b[3]); *(u32x4*)(xb + i * 8) = o; } }
    { const float* x = (const float*)args.in[1]; bf16_t* xb = (bf16_t*)(ws + WS_MEMB);
      for (size_t i = gt; i < (size_t)NB * NMEM * D / 8; i += NT_) { const f32x4 a = *(const f32x4*)(x + i * 8), b = *(const f32x4*)(x + i * 8 + 4);
          u32x4 o; o.x = pk2(a[0], a[1]); o.y = pk2(a[2], a[3]); o.z = pk2(b[0], b[1]); o.w = pk2(b[2], b[3]); *(u32x4*)(xb + i * 8) = o; } }
}

DI void p2_tokens(const Args& args, int vcu, int G) {
    int tid_ = threadIdx.x; asm volatile("" : "+v"(tid_)); const int lane = tid_ & 63; const int wave = __builtin_amdgcn_readfirstlane(tid_ >> 6);
    unsigned char* ws = args.ws;
    const bf16_t* proj = (const bf16_t*)(ws + WS_PROJ);
    bf16_t* qn = (bf16_t*)(ws + WS_QN); bf16_t* kvn = (bf16_t*)(ws + WS_KVN); bf16_t* kpe = (bf16_t*)(ws + WS_KPE); bf16_t* xc = (bf16_t*)(ws + WS_XC); float* cs = (float*)(ws + WS_CS);
    const int* positions = (const int*)args.in[2];
    const float* conv_w = (const float*)args.in[6]; const float* conv_b = (const float*)args.in[7];
    const float* g_qlat = (const float*)args.in[12]; const float* g_kvlat = (const float*)args.in[13];
    const int gw = vcu * NWAVES + wave, NGW = G * NWAVES;
    float cw[4][8], cb[8];
#pragma unroll
    for (int jj = 0; jj < 4; ++jj)
#pragma unroll
        for (int c = 0; c < 8; ++c) cw[jj][c] = conv_w[jj * MW + 8 * lane + c];
#pragma unroll
    for (int c = 0; c < 8; ++c) cb[c] = conv_b[8 * lane + c];
    const f32x4 gq = *(const f32x4*)(g_qlat + 4 * lane);
    const f32x2 gk = *(const f32x2*)(g_kvlat + 2 * lane);
    const float inv_freq = exp2f(-(float)(lane & 15) * (13.287712379549449f / 16.0f));
    for (int t = gw; t < T; t += NGW) {
        const bf16_t* pr = proj + (size_t)t * NPROJ;
        { const u32x2 w = *(const u32x2*)(pr + PC_QLAT + 4 * lane); const float a0 = bflo(w.x), a1 = bfhi(w.x), a2 = bflo(w.y), a3 = bfhi(w.y);
          const float ss = wave_sum(a0 * a0 + a1 * a1 + a2 * a2 + a3 * a3); const float r = 1.0f / sqrtf(ss * (1.0f / AQR) + EPS);
          u32x2 o; o.x = pk2(a0 * r * gq[0], a1 * r * gq[1]); o.y = pk2(a2 * r * gq[2], a3 * r * gq[3]); *(u32x2*)(qn + (size_t)t * 256 + 4 * lane) = o; }
        { const unsigned w = *(const unsigned*)(pr + PC_KVLAT + 2 * lane); const float a0 = bflo(w), a1 = bfhi(w);
          const float ss = wave_sum(a0 * a0 + a1 * a1); const float r = 1.0f / sqrtf(ss * (1.0f / AKVR) + EPS);
          *(unsigned*)(kvn + (size_t)t * 256 + 2 * lane) = pk2(a0 * r * gk[0], a1 * r * gk[1]); *(unsigned*)(kvn + (size_t)t * 256 + 128 + 2 * lane) = 0u; }
        if (lane < 16) { const unsigned w = *(const unsigned*)(pr + PC_KROPE + 2 * lane); const float x1 = bflo(w), x2 = bfhi(w);
          const float ang = (float)positions[t] * inv_freq;
          const double rev = (double)ang * 0.15915494309189535; const float fr = (float)(rev - __builtin_rint(rev));
          const float cc = __builtin_amdgcn_cosf(fr), sn = __builtin_amdgcn_sinf(fr);
          *(unsigned*)(kpe + (size_t)t * 32 + 2 * lane) = pk2(x1 * cc - x2 * sn, x2 * cc + x1 * sn);
          *(f32x2*)(cs + (size_t)t * 32 + 2 * lane) = (f32x2){cc, sn}; }
        { const int s = t & (SEQ - 1); float a[8];
#pragma unroll
          for (int c = 0; c < 8; ++c) a[c] = cb[c];
#pragma unroll
          for (int jj = 0; jj < 4; ++jj) { const int back = 3 - jj; if (s - back >= 0) { const u32x4 w = *(const u32x4*)(pr - (size_t)back * NPROJ + PC_XM + 8 * lane);
              a[0] += cw[jj][0] * bflo(w.x); a[1] += cw[jj][1] * bfhi(w.x); a[2] += cw[jj][2] * bflo(w.y); a[3] += cw[jj][3] * bfhi(w.y);
              a[4] += cw[jj][4] * bflo(w.z); a[5] += cw[jj][5] * bfhi(w.z); a[6] += cw[jj][6] * bflo(w.w); a[7] += cw[jj][7] * bfhi(w.w); } }
#pragma unroll
          for (int c = 0; c < 8; ++c) a[c] = a[c] * sigmoidf_(a[c]);
          u32x4 o; o.x = pk2(a[0], a[1]); o.y = pk2(a[2], a[3]); o.z = pk2(a[4], a[5]); o.w = pk2(a[6], a[7]); *(u32x4*)(xc + (size_t)t * MW + 8 * lane) = o; }
    }
}

DI void p6_mpost(const Args& args, int vcu, int G) {
    int tid_ = threadIdx.x; asm volatile("" : "+v"(tid_)); const int lane = tid_ & 63; const int wave = __builtin_amdgcn_readfirstlane(tid_ >> 6);
    unsigned char* ws = args.ws;
    const float* hraw = (const float*)(ws + WS_HRAW); const bf16_t* xc = (const bf16_t*)(ws + WS_XC); const bf16_t* proj = (const bf16_t*)(ws + WS_PROJ); bf16_t* hm = (bf16_t*)(ws + WS_HM);
    const float* g_mhead = (const float*)args.in[10]; const float* w_mskip = (const float*)args.in[11];
    const int gw = vcu * NWAVES + wave, NGW = G * NWAVES;
    float gm[8], wsk[8];
#pragma unroll
    for (int c = 0; c < 8; ++c) { gm[c] = g_mhead[8 * lane + c]; wsk[c] = w_mskip[8 * lane + c]; }
    for (int t = gw; t < T; t += NGW) {
        const f32x4 h0 = *(const f32x4*)(hraw + (size_t)t * MW + 8 * lane), h1 = *(const f32x4*)(hraw + (size_t)t * MW + 8 * lane + 4);
        float h[8] = {h0[0], h0[1], h0[2], h0[3], h1[0], h1[1], h1[2], h1[3]};
        float s = 0.f;
#pragma unroll
        for (int c = 0; c < 8; ++c) s += h[c];
        s += __shfl_xor(s, 1); s += __shfl_xor(s, 2); s += __shfl_xor(s, 4); s += __shfl_xor(s, 8);
        const float mu = s * (1.0f / MHD); float q = 0.f;
#pragma unroll
        for (int c = 0; c < 8; ++c) { h[c] -= mu; q += h[c] * h[c]; }
        q += __shfl_xor(q, 1); q += __shfl_xor(q, 2); q += __shfl_xor(q, 4); q += __shfl_xor(q, 8);
        const float rstd = 1.0f / sqrtf(q * (1.0f / MHD) + EPS);
        const u32x4 xw = *(const u32x4*)(xc + (size_t)t * MW + 8 * lane); const u32x4 ow = *(const u32x4*)(proj + (size_t)t * NPROJ + PC_OP + 8 * lane);
        const float xv[8] = {bflo(xw.x), bfhi(xw.x), bflo(xw.y), bfhi(xw.y), bflo(xw.z), bfhi(xw.z), bflo(xw.w), bfhi(xw.w)};
        const float ov[8] = {bflo(ow.x), bfhi(ow.x), bflo(ow.y), bfhi(ow.y), bflo(ow.z), bfhi(ow.z), bflo(ow.w), bfhi(ow.w)};
        float o[8];
#pragma unroll
        for (int c = 0; c < 8; ++c) o[c] = sigmoidf_(ov[c]) * (h[c] * rstd * gm[c] + wsk[c] * xv[c]);
        u32x4 w; w.x = pk2(o[0], o[1]); w.y = pk2(o[2], o[3]); w.z = pk2(o[4], o[5]); w.w = pk2(o[6], o[7]); *(u32x4*)(hm + (size_t)t * MW + 8 * lane) = w;
    }
}

DI void ln_pass(const float* res, const float* add, const float* g, const float* b, float* out, bf16_t* outb, int vcu, int G) {
    int tid_ = threadIdx.x; asm volatile("" : "+v"(tid_)); const int lane = tid_ & 63; const int wave = __builtin_amdgcn_readfirstlane(tid_ >> 6);
    const int gw = vcu * NWAVES + wave, NGW = G * NWAVES;
    for (int t = gw; t < T; t += NGW) {
        f32x4 v[4]; float s = 0.f;
#pragma unroll
        for (int j = 0; j < 4; ++j) { const f32x4 r = *(const f32x4*)(res + (size_t)t * D + 4 * lane + 256 * j), a = *(const f32x4*)(add + (size_t)t * D + 4 * lane + 256 * j);
            v[j] = r * DN_ALPHA + a; s += (v[j][0] + v[j][1]) + (v[j][2] + v[j][3]); }
        const float mean = wave_sum(s) * (1.0f / D); float q = 0.f;
#pragma unroll
        for (int j = 0; j < 4; ++j) { v[j] = v[j] - mean; q += (v[j][0] * v[j][0] + v[j][1] * v[j][1]) + (v[j][2] * v[j][2] + v[j][3] * v[j][3]); }
        const float rstd = 1.0f / sqrtf(wave_sum(q) * (1.0f / D) + EPS);
#pragma unroll
        for (int j = 0; j < 4; ++j) { const f32x4 gg = *(const f32x4*)(g + 4 * lane + 256 * j), bb = *(const f32x4*)(b + 4 * lane + 256 * j);
            const f32x4 y = v[j] * rstd * gg + bb;
            *(f32x4*)(out + (size_t)t * D + 4 * lane + 256 * j) = y;
            if (outb) { u32x2 w; w.x = pk2(y[0], y[1]); w.y = pk2(y[2], y[3]); *(u32x2*)(outb + (size_t)t * D + 4 * lane + 256 * j) = w; } }
    }
}

DI void p16_topk(const Args& args, LAS unsigned char* lds, int vcu, int G) {
    unsigned char* ws = args.ws;
    const float* logits = (const float*)(ws + WS_LOGITS); const float* b_router = (const float*)args.in[27];
    int* assign = (int*)(ws + WS_ASSIGN); float* gatew = (float*)(ws + WS_GATEW);
    unsigned* gcnt = (unsigned*)(ws + WS_CTL) + CW_CNT;
    LAS unsigned* hist = (LAS unsigned*)(lds + HIST_OFF); LAS unsigned* hbase = (LAS unsigned*)(lds + HBASE_OFF);
    int tid = threadIdx.x; asm volatile("" : "+v"(tid));
    for (int blk = vcu; blk < T / 512; blk += G) {
        const int t = blk * 512 + tid;
        float v[NE];
#pragma unroll
        for (int j = 0; j < NE / 4; ++j) { const f32x4 a = *(const f32x4*)(logits + (size_t)t * NE + 4 * j), bb = *(const f32x4*)(b_router + 4 * j);
            v[4 * j] = a[0] + bb[0]; v[4 * j + 1] = a[1] + bb[1]; v[4 * j + 2] = a[2] + bb[2]; v[4 * j + 3] = a[3] + bb[3]; }
        int idx[TOPK]; float val[TOPK];
#pragma unroll
        for (int k = 0; k < TOPK; ++k) { float best = -INFINITY; int bi = 0;
#pragma unroll
            for (int e = 0; e < NE; ++e) { bool taken = false;
#pragma unroll
                for (int kk = 0; kk < k; ++kk) taken = taken || (idx[kk] == e);
                if (!taken && v[e] > best) { best = v[e]; bi = e; } }
            idx[k] = bi; val[k] = best; }
        float ex[TOPK], sum = 0.f;
#pragma unroll
        for (int k = 0; k < TOPK; ++k) { ex[k] = __expf(val[k] - val[0]); sum += ex[k]; }
        const float inv = 1.0f / sum;
        if (tid < NE) hist[tid] = 0u;
        __syncthreads();
        unsigned lr[TOPK];
#pragma unroll
        for (int k = 0; k < TOPK; ++k) lr[k] = __hip_atomic_fetch_add(hist + idx[k], 1u, __ATOMIC_RELAXED, __HIP_MEMORY_SCOPE_WORKGROUP);
        __syncthreads();
        if (tid < NE) hbase[tid] = __hip_atomic_fetch_add(gcnt + tid, hist[tid], RLX_AGENT);
        __syncthreads();
#pragma unroll
        for (int k = 0; k < TOPK; ++k) { assign[(size_t)t * TOPK + k] = (idx[k] << 20) | (int)(hbase[idx[k]] + lr[k]); gatew[(size_t)t * TOPK + k] = ex[k] * inv; }
        __syncthreads();
    }
}
DI void build_tstart(const Args& args, LAS unsigned char* lds) {
    const unsigned* gcnt = (const unsigned*)(args.ws + WS_CTL) + CW_CNT; LAS int* tst = (LAS int*)(lds + TST_OFF); LAS int* tile_e = (LAS int*)(lds + TILE_E_OFF);
    if (threadIdx.x == 0) { int acc = 0;
        for (int e = 0; e < NE; ++e) { tst[e] = acc; const unsigned c = __hip_atomic_load(gcnt + e, RLX_AGENT); acc += (int)((c + 255u) >> 8); }
        tst[NE] = acc; }
    __syncthreads();
    for (int t = threadIdx.x; t < tst[NE]; t += NWAVES * 64) { int e = 0;
        for (int j = 1; j < NE; ++j) e += (tst[j] <= t) ? 1 : 0;
        tile_e[t] = e; }
    __syncthreads();
}
DI void p17_gather(const Args& args, LAS unsigned char* lds, int vcu, int G) {
    int tid_ = threadIdx.x; asm volatile("" : "+v"(tid_)); const int lane = tid_ & 63; const int wave = __builtin_amdgcn_readfirstlane(tid_ >> 6);
    unsigned char* ws = args.ws;
    build_tstart(args, lds);
    const LAS int* tst = (const LAS int*)(lds + TST_OFF);
    const unsigned* gcnt = (const unsigned*)(ws + WS_CTL) + CW_CNT;
    const int* assign = (const int*)(ws + WS_ASSIGN); const float* gatew = (const float*)(ws + WS_GATEW);
    int* tokpos = (int*)(ws + WS_TOKPOS); float* rowgate = (float*)(ws + WS_ROWGATE);
    const bf16_t* v2 = (const bf16_t*)(ws + WS_V2B); const float* stats2 = (const float*)(ws + CTL_STATS2); unsigned char* xg = ws + WS_XG;
    const int gw = vcu * NWAVES + wave, NGW = G * NWAVES;
    f32x4 g2[4], b2[4];
#pragma unroll
    for (int j = 0; j < 4; ++j) { g2[j] = *(const f32x4*)((const float*)args.in[24] + 16 * lane + 4 * j) * pg8::F8_XS; b2[j] = *(const f32x4*)((const float*)args.in[25] + 16 * lane + 4 * j) * pg8::F8_XS; }
    for (int t = gw; t < T; t += NGW) {
        float mean, rstd; pg8::row_stats(stats2, t, mean, rstd);
        u32x4 o; const u32x4 wa = *(const u32x4*)(v2 + (size_t)t * D + 16 * lane), wb = *(const u32x4*)(v2 + (size_t)t * D + 16 * lane + 8);
        const f32x4 xin[4] = {{bflo(wa.x), bfhi(wa.x), bflo(wa.y), bfhi(wa.y)}, {bflo(wa.z), bfhi(wa.z), bflo(wa.w), bfhi(wa.w)}, {bflo(wb.x), bfhi(wb.x), bflo(wb.y), bfhi(wb.y)}, {bflo(wb.z), bfhi(wb.z), bflo(wb.w), bfhi(wb.w)}};
#pragma unroll
        for (int j = 0; j < 4; ++j) { const f32x4 x = (xin[j] - mean) * rstd * g2[j] + b2[j]; o[j] = pg8::pk4_fp8(x[0], x[1], x[2], x[3]); }
#pragma unroll
        for (int k = 0; k < TOPK; ++k) { const int as = assign[(size_t)t * TOPK + k]; const int e = as >> 20, rank = as & 0xfffff; const int pos = tst[e] * 256 + rank;
            *(u32x4*)(xg + (size_t)pos * D + 16 * lane) = o;
            if (lane == 0) { tokpos[(size_t)t * TOPK + k] = pos; rowgate[pos] = gatew[(size_t)t * TOPK + k]; } }
    }
    for (int idx = gw; idx < NE * 256; idx += NGW) { const int e = idx >> 8, r = idx & 255; const int row = tst[e] * 256 + (int)__hip_atomic_load(gcnt + e, RLX_AGENT) + r;
        if (row < tst[e + 1] * 256) { const u32x4 z = {0u, 0u, 0u, 0u}; *(u32x4*)(xg + (size_t)row * D + 16 * lane) = z; if (lane == 0) rowgate[row] = 0.f; } }
}
DI void p20_final(const Args& args, int vcu, int G) {
    int tid_ = threadIdx.x; asm volatile("" : "+v"(tid_)); const int lane = tid_ & 63; const int wave = __builtin_amdgcn_readfirstlane(tid_ >> 6);
    unsigned char* ws = args.ws;
    const int* tokpos = (const int*)(ws + WS_TOKPOS); const bf16_t* yb = (const bf16_t*)(ws + WS_YB);
    const bf16_t* v2 = (const bf16_t*)(ws + WS_V2B); const float* stats2 = (const float*)(ws + CTL_STATS2);
    const float* g2 = (const float*)args.in[24]; const float* b2 = (const float*)args.in[25];
    const float* g = (const float*)args.in[32]; const float* b = (const float*)args.in[33]; float* out = args.out;
    const int gw = vcu * NWAVES + wave, NGW = G * NWAVES;
    for (int t = gw; t < T; t += NGW) {
        int pos[TOPK];
#pragma unroll
        for (int k = 0; k < TOPK; ++k) pos[k] = tokpos[(size_t)t * TOPK + k];
        float mean2, rstd2; pg8::row_stats(stats2, t, mean2, rstd2);
        f32x4 v[4]; float s = 0.f;
#pragma unroll
        for (int j = 0; j < 4; ++j) { const u32x2 vw = *(const u32x2*)(v2 + (size_t)t * D + 4 * lane + 256 * j); const f32x4 vin = {bflo(vw.x), bfhi(vw.x), bflo(vw.y), bfhi(vw.y)};
            const f32x4 r = (vin - mean2) * rstd2 * *(const f32x4*)(g2 + 4 * lane + 256 * j) + *(const f32x4*)(b2 + 4 * lane + 256 * j);
            f32x4 a = {0.f, 0.f, 0.f, 0.f};
#pragma unroll
            for (int k = 0; k < TOPK; ++k) { const u32x2 w = *(const u32x2*)(yb + (size_t)pos[k] * D + 4 * lane + 256 * j); a[0] += bflo(w.x); a[1] += bfhi(w.x); a[2] += bflo(w.y); a[3] += bfhi(w.y); }
            v[j] = r * DN_ALPHA + a; s += (v[j][0] + v[j][1]) + (v[j][2] + v[j][3]); }
        const float mean = wave_sum(s) * (1.0f / D); float q = 0.f;
#pragma unroll
        for (int j = 0; j < 4; ++j) { v[j] = v[j] - mean; q += (v[j][0] * v[j][0] + v[j][1] * v[j][1]) + (v[j][2] * v[j][2] + v[j][3] * v[j][3]); }
        const float rstd = 1.0f / sqrtf(wave_sum(q) * (1.0f / D) + EPS);
#pragma unroll
        for (int j = 0; j < 4; ++j) { const f32x4 gg = *(const f32x4*)(g + 4 * lane + 256 * j), bb = *(const f32x4*)(b + 4 * lane + 256 * j);
            *(f32x4*)(out + (size_t)t * D + 4 * lane + 256 * j) = v[j] * rstd * gg + bb; }
    }
}
constexpr int AT_KROW = 208, AT_VROW = 136;
constexpr int AT_KBUF = 64 * AT_KROW, AT_VBUF = 64 * AT_VROW, AT_VOFF = 2 * AT_KBUF;
DI void mla_unit(int b, int h, int qb, const bf16_t* Q, const bf16_t* Kn, const bf16_t* Kpe, const bf16_t* Vt, bf16_t* O, LAS unsigned char* lds) {
    int tid = threadIdx.x; asm volatile("" : "+v"(tid)); const int lane = tid & 63, r32 = lane & 31, hi = lane >> 5; const int wid = __builtin_amdgcn_readfirstlane(tid >> 6);
    const int q0 = qb * 256 + wid * 32;
    const int qi = q0 + r32;
    const size_t tokb = (size_t)b * SEQ;
    bf16x8 qf[6];
    { const bf16_t* qp = Q + (tokb + qi) * (AH * AQK) + h * AQK + 8 * hi;
#pragma unroll
      for (int s = 0; s < 6; ++s) qf[s] = *(const bf16x8*)(qp + 16 * s); }
    const int kkey = tid >> 3, kch = tid & 7, pkey = (tid & 255) >> 2, pch = tid & 3, vd = tid >> 3, vch = tid & 7;
    const bf16_t* ksrc = Kn + (tokb + kkey) * 512 + h * 64 + kch * 8;
    const bf16_t* psrc = Kpe + (tokb + pkey) * 32 + pch * 8;
    const bf16_t* vsrc = Vt + (size_t)(h * 64 + vd) * T + tokb + vch * 8;
    const int kdst = kkey * AT_KROW + kch * 16, pdst = pkey * AT_KROW + 128 + pch * 16, vdst = AT_VOFF + vd * AT_VROW + vch * 16;
    const int nkt = 4 * (qb + 1);
    u32x4 rk, rp, rv;
    rk = *(const u32x4*)ksrc; rv = *(const u32x4*)vsrc; rp = (u32x4){0u, 0u, 0u, 0u}; if (tid < 256) rp = *(const u32x4*)psrc;
    *(LAS u32x4*)(lds + kdst) = rk; if (tid < 256) *(LAS u32x4*)(lds + pdst) = rp;
    *(LAS u32x2*)(lds + vdst) = (u32x2){rv.x, rv.y}; *(LAS u32x2*)(lds + vdst + 8) = (u32x2){rv.z, rv.w};
    __syncthreads();
    float m_run = -INFINITY, l_run = 0.f;
    f32x16 o0, o1;
#pragma unroll
    for (int r = 0; r < 16; ++r) { o0[r] = 0.f; o1[r] = 0.f; }
    for (int kt = 0; kt < nkt; ++kt) {
        const int buf = kt & 1;
        if (kt + 1 < nkt) { rk = *(const u32x4*)(ksrc + (size_t)(kt + 1) * 64 * 512); rv = *(const u32x4*)(vsrc + (kt + 1) * 64); if (tid < 256) rp = *(const u32x4*)(psrc + (size_t)(kt + 1) * 64 * 32); }
        const int key0 = kt * 64;
        if (key0 <= q0 + 31) {
            const LAS unsigned char* kb = lds + buf * AT_KBUF + r32 * AT_KROW + hi * 16;
            f32x16 p0, p1;
#pragma unroll
            for (int r = 0; r < 16; ++r) { p0[r] = 0.f; p1[r] = 0.f; }
#pragma unroll
            for (int s = 0; s < 6; ++s) { const bf16x8 a0 = *(const LAS bf16x8*)(kb + s * 32), a1 = *(const LAS bf16x8*)(kb + 32 * AT_KROW + s * 32);
                p0 = MFMA32(a0, qf[s], p0); p1 = MFMA32(a1, qf[s], p1); }
            if (key0 + 63 > q0) {
#pragma unroll
                for (int r = 0; r < 16; ++r) { const int key = key0 + crow(r, hi); if (key > qi) p0[r] = -INFINITY; if (key + 32 > qi) p1[r] = -INFINITY; }
            }
            float mx = fmaxf(p0[0], p1[0]);
#pragma unroll
            for (int r = 1; r < 16; ++r) mx = fmaxf(mx, fmaxf(p0[r], p1[r]));
            mx = fmaxf(mx, __shfl_xor(mx, 32));
            const float m_new = fmaxf(m_run, mx);
            const float alpha = __builtin_amdgcn_exp2f(m_run - m_new);
            m_run = m_new;
            float ls = 0.f;
#pragma unroll
            for (int r = 0; r < 16; ++r) { p0[r] = __builtin_amdgcn_exp2f(p0[r] - m_new); p1[r] = __builtin_amdgcn_exp2f(p1[r] - m_new); ls += p0[r] + p1[r]; }
            l_run = l_run * alpha + ls;
#pragma unroll
            for (int r = 0; r < 16; ++r) { o0[r] *= alpha; o1[r] *= alpha; }
            bf16x8 pb[4];
#pragma unroll
            for (int s = 0; s < 4; ++s) { u32x4 w;
                if (s < 2) { w.x = pk2(p0[8 * s], p0[8 * s + 1]); w.y = pk2(p0[8 * s + 2], p0[8 * s + 3]); w.z = pk2(p0[8 * s + 4], p0[8 * s + 5]); w.w = pk2(p0[8 * s + 6], p0[8 * s + 7]); }
                else { const int s2 = s - 2; w.x = pk2(p1[8 * s2], p1[8 * s2 + 1]); w.y = pk2(p1[8 * s2 + 2], p1[8 * s2 + 3]); w.z = pk2(p1[8 * s2 + 4], p1[8 * s2 + 5]); w.w = pk2(p1[8 * s2 + 6], p1[8 * s2 + 7]); }
                pb[s] = __builtin_bit_cast(bf16x8, w); }
            const LAS unsigned char* vb = lds + AT_VOFF + buf * AT_VBUF + r32 * AT_VROW + hi * 8;
#pragma unroll
            for (int s = 0; s < 4; ++s) {
                const u32x2 a0l = *(const LAS u32x2*)(vb + s * 32), a0h = *(const LAS u32x2*)(vb + s * 32 + 16);
                const u32x2 a1l = *(const LAS u32x2*)(vb + 32 * AT_VROW + s * 32), a1h = *(const LAS u32x2*)(vb + 32 * AT_VROW + s * 32 + 16);
                const bf16x8 a0 = __builtin_bit_cast(bf16x8, (u32x4){a0l.x, a0l.y, a0h.x, a0h.y}), a1 = __builtin_bit_cast(bf16x8, (u32x4){a1l.x, a1l.y, a1h.x, a1h.y});
                o0 = MFMA32(a0, pb[s], o0); o1 = MFMA32(a1, pb[s], o1); }
        }
        if (kt + 1 < nkt) { const int nb = (kt + 1) & 1;
            *(LAS u32x4*)(lds + nb * AT_KBUF + kdst) = rk; if (tid < 256) *(LAS u32x4*)(lds + nb * AT_KBUF + pdst) = rp;
            *(LAS u32x2*)(lds + nb * AT_VBUF + vdst) = (u32x2){rv.x, rv.y}; *(LAS u32x2*)(lds + nb * AT_VBUF + vdst + 8) = (u32x2){rv.z, rv.w}; }
        __syncthreads();
    }
    const float lt = l_run + __shfl_xor(l_run, 32); const float inv = 1.0f / lt;
    bf16_t* op = O + (tokb + qi) * AW + h * AVD + 4 * hi;
#pragma unroll
    for (int g = 0; g < 4; ++g) { u32x2 w0, w1;
        w0.x = pk2(o0[4 * g] * inv, o0[4 * g + 1] * inv); w0.y = pk2(o0[4 * g + 2] * inv, o0[4 * g + 3] * inv);
        w1.x = pk2(o1[4 * g] * inv, o1[4 * g + 1] * inv); w1.y = pk2(o1[4 * g + 2] * inv, o1[4 * g + 3] * inv);
        *(u32x2*)(op + 8 * g) = w0; *(u32x2*)(op + 32 + 8 * g) = w1; }
}
DI void p4_attention(const Args& args, LAS unsigned char* lds, int vcu, int G) {
    unsigned char* ws = args.ws;
    const bf16_t* Q = (const bf16_t*)(ws + WS_QMLA); const bf16_t* Kn = (const bf16_t*)(ws + WS_KN); const bf16_t* Kpe = (const bf16_t*)(ws + WS_KPE); const bf16_t* Vt = (const bf16_t*)(ws + WS_VT);
    bf16_t* O = (bf16_t*)(ws + WS_AO);
    for (int p = vcu; p < NB * AH * 4; p += G) { const int bh = p >> 2, j = p & 3; const int b = bh / AH, h = bh % AH;
        mla_unit(b, h, 7 - j, Q, Kn, Kpe, Vt, O, lds);
        mla_unit(b, h, j, Q, Kn, Kpe, Vt, O, lds); }
}

constexpr int ML_QROW = 272, ML_TROW = 144;
constexpr int ML_QS = 0, ML_KS = ML_QS + 64 * ML_QROW, ML_KTS = ML_KS + 64 * ML_QROW, ML_VTS = ML_KTS + 128 * ML_TROW, ML_CS = ML_VTS + 32 * ML_TROW, ML_SS = ML_CS + 32 * ML_QROW,
              ML_VEC = ML_SS + 64 * ML_TROW;
static_assert(ML_VEC + (7 * 64 + 128 + 4) * 4 <= RING_BYTES, "mLSTM LDS");
DI void mlstm_unit(int b, int h, int vs, const Args& args, LAS unsigned char* lds) {
    unsigned char* ws = args.ws;
    const bf16_t* qkm = (const bf16_t*)(ws + WS_QKM); const bf16_t* ktm = (const bf16_t*)(ws + WS_KTM); const bf16_t* proj = (const bf16_t*)(ws + WS_PROJ);
    const float* gates = (const float*)(ws + WS_GATES); float* hraw = (float*)(ws + WS_HRAW);
    const float b_i = ((const float*)args.in[4])[h], b_f = ((const float*)args.in[5])[h];
    int tid = threadIdx.x; asm volatile("" : "+v"(tid)); const int lane = tid & 63, r32 = lane & 31, hi = lane >> 5; const int wid = __builtin_amdgcn_readfirstlane(tid >> 6);
    LAS float* ROWT = (LAS float*)(lds + ML_VEC); LAS float* COLT = ROWT + 64; LAS float* WINT = ROWT + 128; LAS float* ENEG = ROWT + 192; LAS float* WAS = ROWT + 256;
    LAS float* NQ = ROWT + 320; LAS float* DINV = ROWT + 384; LAS float* NVEC = ROWT + 448; LAS float* SCAL = ROWT + 576;
    const size_t tokb = (size_t)b * SEQ;
    for (int i = tid; i < 32 * ML_QROW / 4; i += 512) ((LAS unsigned*)(lds + ML_CS))[i] = 0u;
    if (tid < 128) NVEC[tid] = 0.f;
    f32x16 cacc;
#pragma unroll
    for (int r = 0; r < 16; ++r) cacc[r] = 0.f;
    float m_st = 0.f;
    u32x4 sq[2], sk[2], skt[2], sv; float gi = 0.f, gf = 0.f;
    sv = (u32x4){0u, 0u, 0u, 0u};
#define ML_LOAD(c) do { const size_t tok0 = tokb + (size_t)(c) * MCH; \
        _Pragma("unroll") for (int i = 0; i < 2; ++i) { const int idx = tid + 512 * i; \
            sq[i] = *(const u32x4*)(qkm + (tok0 + (idx >> 4)) * 1024 + h * MHD + (idx & 15) * 8); \
            sk[i] = *(const u32x4*)(qkm + (tok0 + (idx >> 4)) * 1024 + 512 + h * MHD + (idx & 15) * 8); \
            skt[i] = *(const u32x4*)(ktm + (size_t)(h * MHD + (idx >> 3)) * T + tok0 + (idx & 7) * 8); } \
        if (tid < 256) sv = *(const u32x4*)(proj + (tok0 + (tid >> 2)) * NPROJ + PC_VM + h * MHD + vs * 32 + (tid & 3) * 8); \
        if (wid == 0) { gi = gates[(tok0 + lane) * 8 + h]; gf = gates[(tok0 + lane) * 8 + 4 + h]; } } while (0)
    ML_LOAD(0);
    for (int c = 0; c < SEQ / MCH; ++c) {
        const size_t tok0 = tokb + (size_t)c * MCH;
#pragma unroll
        for (int i = 0; i < 2; ++i) { const int idx = tid + 512 * i;
            *(LAS u32x4*)(lds + ML_QS + (idx >> 4) * ML_QROW + (idx & 15) * 16) = sq[i];
            *(LAS u32x4*)(lds + ML_KS + (idx >> 4) * ML_QROW + (idx & 15) * 16) = sk[i];
            *(LAS u32x4*)(lds + ML_KTS + (idx >> 3) * ML_TROW + (idx & 7) * 16) = skt[i]; }
        if (tid < 256) { const int l = tid >> 2, v0 = (tid & 3) * 8; LAS bf16_t* vt = (LAS bf16_t*)(lds + ML_VTS);
            vt[(v0 + 0) * (ML_TROW / 2) + l] = (bf16_t)(sv.x & 0xffff); vt[(v0 + 1) * (ML_TROW / 2) + l] = (bf16_t)(sv.x >> 16);
            vt[(v0 + 2) * (ML_TROW / 2) + l] = (bf16_t)(sv.y & 0xffff); vt[(v0 + 3) * (ML_TROW / 2) + l] = (bf16_t)(sv.y >> 16);
            vt[(v0 + 4) * (ML_TROW / 2) + l] = (bf16_t)(sv.z & 0xffff); vt[(v0 + 5) * (ML_TROW / 2) + l] = (bf16_t)(sv.z >> 16);
            vt[(v0 + 6) * (ML_TROW / 2) + l] = (bf16_t)(sv.w & 0xffff); vt[(v0 + 7) * (ML_TROW / 2) + l] = (bf16_t)(sv.w >> 16); }
        if (wid == 0) {
            const float xf = gf + b_f;
            const float lf = (xf >= 0.f) ? -log1pf(__expf(-xf)) : xf - log1pf(__expf(xf));
            float bb = lf;
#pragma unroll
            for (int o = 1; o < 64; o <<= 1) { const float tv = __shfl_up(bb, o); if (lane >= o) bb += tv; }
            const float btot = __shfl(bb, 63);
            const float ig = gi + b_i;
            const float a = btot - bb + ig;
            const float mchunk = wave_max(a);
            const float wa = __expf(a - mchunk);
            const float u = ig - bb;
            float pm = u;
#pragma unroll
            for (int o = 1; o < 64; o <<= 1) { const float tv = __shfl_up(pm, o); if (lane >= o) pm = fmaxf(pm, tv); }
            const float mintra = bb + pm;
            const float ginter = bb + m_st;
            const float m = fmaxf(ginter, mintra);
            const float mnew = fmaxf(btot + m_st, mchunk);
            const float sold = __expf(btot + m_st - mnew), snew = __expf(mchunk - mnew);
            ROWT[lane] = bb - m; COLT[lane] = u; WINT[lane] = __expf(ginter - m); ENEG[lane] = __expf(-m); WAS[lane] = snew * wa;
            if (lane == 0) SCAL[0] = sold;
            m_st = mnew;
        }
        __syncthreads();
        if (c + 1 < SEQ / MCH) ML_LOAD(c + 1);
        f32x16 iacc;
#pragma unroll
        for (int r = 0; r < 16; ++r) iacc[r] = 0.f;
        if (wid < 4) {
            const int jb = wid >> 1, sb = wid & 1;
            LAS bf16_t* ss = (LAS bf16_t*)(lds + ML_SS);
            if (sb <= jb) {
                f32x16 s;
#pragma unroll
                for (int r = 0; r < 16; ++r) s[r] = 0.f;
                const LAS unsigned char* qa = lds + ML_QS + (32 * jb + r32) * ML_QROW + hi * 16; const LAS unsigned char* kb = lds + ML_KS + (32 * sb + r32) * ML_QROW + hi * 16;
#pragma unroll
                for (int kk = 0; kk < 8; ++kk) s = MFMA32(*(const LAS bf16x8*)(qa + kk * 32), *(const LAS bf16x8*)(kb + kk * 32), s);
                const int sidx = 32 * sb + r32; const float ct = COLT[sidx];
#pragma unroll
                for (int r = 0; r < 16; ++r) { const int j = 32 * jb + crow(r, hi);
                    const float val = (sidx <= j) ? s[r] * __expf(ROWT[j] + ct) : 0.f;
                    ss[j * (ML_TROW / 2) + sidx] = (bf16_t)f2bf(val); }
            } else {
#pragma unroll
                for (int r = 0; r < 16; ++r) ss[(32 * jb + crow(r, hi)) * (ML_TROW / 2) + 32 * sb + r32] = (bf16_t)0;
            }
        } else if (wid < 6) {
            const int jb = wid - 4;
            const LAS unsigned char* qa = lds + ML_QS + (32 * jb + r32) * ML_QROW + hi * 16; const LAS unsigned char* cb = lds + ML_CS + r32 * ML_QROW + hi * 16;
#pragma unroll
            for (int kk = 0; kk < 8; ++kk) iacc = MFMA32(*(const LAS bf16x8*)(qa + kk * 32), *(const LAS bf16x8*)(cb + kk * 32), iacc);
        } else {
            const int j = 32 * (wid - 6) + (lane >> 1), half = lane & 1;
            const LAS unsigned char* qa = lds + ML_QS + j * ML_QROW + half * 128; float acc = 0.f;
#pragma unroll
            for (int i = 0; i < 8; ++i) { const u32x4 w = *(const LAS u32x4*)(qa + i * 16); const f32x4 n0 = *(const LAS f32x4*)(NVEC + half * 64 + i * 8), n1 = *(const LAS f32x4*)(NVEC + half * 64 + i * 8 + 4);
                acc += bflo(w.x) * n0[0] + bfhi(w.x) * n0[1] + bflo(w.y) * n0[2] + bfhi(w.y) * n0[3] + bflo(w.z) * n1[0] + bfhi(w.z) * n1[1] + bflo(w.w) * n1[2] + bfhi(w.w) * n1[3]; }
            acc += __shfl_xor(acc, 1);
            if (half == 0) NQ[j] = acc;
        }
        __syncthreads();
        if (wid < 4) {
            const float sold = SCAL[0];
#pragma unroll
            for (int r = 0; r < 16; ++r) cacc[r] *= sold;
            const LAS unsigned char* va = lds + ML_VTS + r32 * ML_TROW + hi * 16; const LAS unsigned char* kb = lds + ML_KTS + (32 * wid + r32) * ML_TROW + hi * 16;
#pragma unroll
            for (int kk = 0; kk < 4; ++kk) { const u32x4 w = *(const LAS u32x4*)(va + kk * 32);
                const f32x4 w0 = *(const LAS f32x4*)(WAS + 16 * kk + 8 * hi), w1 = *(const LAS f32x4*)(WAS + 16 * kk + 8 * hi + 4);
                u32x4 sa; sa.x = pk2(bflo(w.x) * w0[0], bfhi(w.x) * w0[1]); sa.y = pk2(bflo(w.y) * w0[2], bfhi(w.y) * w0[3]); sa.z = pk2(bflo(w.z) * w1[0], bfhi(w.z) * w1[1]); sa.w = pk2(bflo(w.w) * w1[2], bfhi(w.w) * w1[3]);
                cacc = MFMA32(__builtin_bit_cast(bf16x8, sa), *(const LAS bf16x8*)(kb + kk * 32), cacc); }
            LAS bf16_t* cs = (LAS bf16_t*)(lds + ML_CS);
#pragma unroll
            for (int r = 0; r < 16; ++r) cs[crow(r, hi) * (ML_QROW / 2) + 32 * wid + r32] = (bf16_t)f2bf(cacc[r]);
        } else if (wid < 6) {
            const int jb = wid - 4;
#pragma unroll
            for (int r = 0; r < 16; ++r) iacc[r] *= WINT[32 * jb + crow(r, hi)];
            const LAS unsigned char* sa = lds + ML_SS + (32 * jb + r32) * ML_TROW + hi * 16; const LAS unsigned char* vb = lds + ML_VTS + r32 * ML_TROW + hi * 16;
#pragma unroll
            for (int kk = 0; kk < 4; ++kk) iacc = MFMA32(*(const LAS bf16x8*)(sa + kk * 32), *(const LAS bf16x8*)(vb + kk * 32), iacc);
        } else {
            const int tl = (wid - 6) * 64 + lane;
            { const int j = tl >> 1, half = tl & 1; const LAS unsigned char* sp = lds + ML_SS + j * ML_TROW + half * 64; float rs = 0.f;
#pragma unroll
              for (int i = 0; i < 4; ++i) { const u32x4 w = *(const LAS u32x4*)(sp + i * 16); rs += (bflo(w.x) + bfhi(w.x)) + (bflo(w.y) + bfhi(w.y)) + (bflo(w.z) + bfhi(w.z)) + (bflo(w.w) + bfhi(w.w)); }
              rs += __shfl_xor(rs, 1);
              if (half == 0) { const float den = WINT[j] * NQ[j] + rs; DINV[j] = 1.0f / fmaxf(fabsf(den), ENEG[j]); } }
            { const int k = tl; const LAS unsigned char* kp = lds + ML_KTS + k * ML_TROW; float acc = SCAL[0] * NVEC[k];
#pragma unroll
              for (int i = 0; i < 8; ++i) { const u32x4 w = *(const LAS u32x4*)(kp + i * 16); const f32x4 w0 = *(const LAS f32x4*)(WAS + i * 8), w1 = *(const LAS f32x4*)(WAS + i * 8 + 4);
                  acc += bflo(w.x) * w0[0] + bfhi(w.x) * w0[1] + bflo(w.y) * w0[2] + bfhi(w.y) * w0[3] + bflo(w.z) * w1[0] + bfhi(w.z) * w1[1] + bflo(w.w) * w1[2] + bfhi(w.w) * w1[3]; }
              NVEC[k] = acc; }
        }
        __syncthreads();
        if (wid == 4 || wid == 5) {
            const int jb = wid - 4; float* hp = hraw + (tok0 + 32 * jb) * MW + h * MHD + vs * 32 + r32;
#pragma unroll
            for (int r = 0; r < 16; ++r) { const int j = crow(r, hi); hp[(size_t)j * MW] = iacc[r] * DINV[32 * jb + j]; }
        }
    }
#undef ML_LOAD
    __syncthreads();
}
DI void p5_mlstm(const Args& args, LAS unsigned char* lds, int vcu, int G) {
    for (int u = vcu; u < NB * MH * 4; u += G) { const int vs = u & 3, bh = u >> 2; mlstm_unit(bh / MH, bh % MH, vs, args, lds); }
}
#ifndef MK_ONE_LAUNCH
#define MK_ONE_LAUNCH 1
#endif
#ifndef P3SEL
#define P3SEL 31
#endif
constexpr int NPH = 20;
__global__ void __launch_bounds__(NWAVES * 64, 2) fwd_kernel(Args args) {
    extern __shared__ __attribute__((aligned(16))) unsigned char lds_raw[];
    LAS unsigned char* lds = (LAS unsigned char*)lds_raw;
    const int tid = threadIdx.x;
    const int G = gridDim.x; const int bx = blockIdx.x; const int vcu = (G % 8 == 0) ? (bx % 8) * (G / 8) + bx / 8 : bx;
    unsigned char* ws = args.ws;
    for (int u = tid; u < (LDS_BYTES - LDSCTL_OFF) / 4; u += NWAVES * 64) ((LAS unsigned*)(lds + LDSCTL_OFF))[u] = 0u;
    __syncthreads();
    volatile LAS unsigned* MISC = (volatile LAS unsigned*)(lds + MISC_OFF);
    XcdBarrier bar; bar.bar = (unsigned*)(ws + WS_CTL) + CW_BAR; bar.x = 0; bar.st = nullptr;
    const int lo = args.ph_lo, hi = args.ph_hi;
    if (hi - lo > 1) bar = xcd_barrier_post((unsigned*)(ws + WS_CTL) + CW_BAR, MISC + 8);
#ifndef PHASE_MASK
#define PHASE_MASK 0xFFFFFu
#endif
#define IN(k) (((PHASE_MASK >> (k)) & 1u) && lo <= (k) && (k) < hi)
#ifndef DUP_PHASE
#define DUP_PHASE -1
#endif
#define REP(k) _Pragma("unroll 1") for (int rep_ = 0; rep_ < ((DUP_PHASE == (k)) ? 2 : 1); ++rep_)
#define SEAM(k) do { if (IN(k) && IN(NEXTPH(k))) xcd_barrier(bar); } while (0)
#define NEXTPH(k) (((k) == 7 || (k) == 12) ? (k) + 2 : (k) + 1)
    using namespace pg8;
    LAS unsigned char* ring = lds + RING_OFF;
    const bf16_t* cws = (const bf16_t*)ws;
#define WSB(off) ((bf16_t*)(ws + (off)))
#define WSF(off) ((float*)(ws + (off)))

    if (IN(0)) REP(0) { p0_prologue(args, lds, vcu, G); }
    SEAM(0);
    if (IN(1)) REP(1) {
        { DenseOrder S; S.init(WSB(WS_XB), WSB(WS_W_IN), T, NPROJ, D, D, G, bx); EpiProj E{WSB(WS_PROJ), WSF(WS_GATES)}; gemm_phase(ring, D, D, D, S, E); }
        { DenseOrder S; S.init(WSB(WS_MEMB), WSB(WS_W_CK), NB * NMEM, D, D, D, G, bx); EpiBf16 E{WSB(WS_KC), D, 1 << 30, 1.f}; gemm_phase(ring, D, D, D, S, E); }
        { DenseOrder S; S.init(WSB(WS_W_CV), WSB(WS_MEMB), D, NB * NMEM, D, D, G, bx); EpiBf16 E{WSB(WS_VCT), NB * NMEM, 1 << 30, 1.f}; gemm_phase(ring, D, D, D, S, E); }
    }
    SEAM(1);
    if (IN(2)) REP(2) { p2_tokens(args, vcu, G); }
    SEAM(2);
    if (IN(3)) REP(3) {
        if (P3SEL & 1) { DenseOrder S; S.init(WSB(WS_QN), WSB(WS_W_UQ), T, AH * AQK, 256, 256, G, bx); EpiQmla E{WSB(WS_QMLA), WSF(WS_CS), 0.10206207261596575f * 1.4426950408889634f}; gemm_phase(ring, 256, 256, 256, S, E); }
        if (P3SEL & 2) { DenseOrder S; S.init(WSB(WS_KVN), WSB(WS_W_UK), T, 512, 256, 256, G, bx); EpiBf16 E{WSB(WS_KN), 512, 1 << 30, 1.f}; gemm_phase(ring, 256, 256, 256, S, E); }
        if (P3SEL & 4) { DenseOrder S; S.init(WSB(WS_W_UV), WSB(WS_KVN), 512, T, 256, 256, G, bx); EpiBf16 E{WSB(WS_VT), T, 1 << 30, 1.f}; gemm_phase(ring, 256, 256, 256, S, E); }
        if (P3SEL & 8) { DenseOrder S; S.init(WSB(WS_XC), WSB(WS_W_MQK), T, 1024, 512, 512, G, bx); EpiBf16 E{WSB(WS_QKM), 1024, 2, 0.08838834764831845f}; gemm_phase(ring, 512, 512, 512, S, E); }
        if (P3SEL & 16) { DenseOrder S; S.init(WSB(WS_W_MQK) + 512 * 512, WSB(WS_XC), 512, T, 512, 512, G, bx); EpiBf16 E{WSB(WS_KTM), T, 0, 0.08838834764831845f}; gemm_phase(ring, 512, 512, 512, S, E); }
    }
    SEAM(3);
    if (IN(4)) { REP(40) { p5_mlstm(args, lds, vcu, G); } REP(41) { p4_attention(args, lds, vcu, G); } }
    SEAM(4);
    if (IN(5)) REP(5) { p6_mpost(args, vcu, G); }
    SEAM(5);
    if (IN(6)) REP(6) {
        { DenseOrder S; S.init(WSB(WS_HM), WSB(WS_W_BRM), T, D, 512, 512, G, bx); EpiGate<false> E{WSB(WS_GATED), WSB(WS_PROJ), PC_GM}; gemm_phase(ring, 512, 512, 512, S, E); }
        { DenseOrder S; S.init(WSB(WS_AO), WSB(WS_W_BRA), T, D, 512, 512, G, bx); EpiGate<true> E{WSB(WS_GATED), WSB(WS_PROJ), PC_GA}; gemm_phase(ring, 512, 512, 512, S, E); }
    }
    SEAM(6);
    if (IN(7)) REP(7) { DenseOrder S; S.init(WSB(WS_GATED), WSB(WS_W_MIX), T, D, D, D, G, bx); EpiResStats<false> E{WSB(WS_XB), nullptr, nullptr, nullptr, WSB(WS_V1B), WSF(CTL_STATS1)}; gemm_phase(ring, D, D, D, S, E); }
    SEAM(7);
    if (IN(9)) REP(9) { DenseOrder S; S.init(WSB(WS_V1B), WSB(WS_W_CQ), T, D, D, D, G, bx); EpiLNApplyBf16 E{WSB(WS_QC), D, WSF(CTL_STATS1), WSF(CTL_CS1), WSF(CTL_CB1), 0.0625f * 1.4426950408889634f}; gemm_phase(ring, D, D, D, S, E); }
    SEAM(9);
    if (IN(10)) REP(10) { CrossSOrder S{(const char*)(ws + WS_QC), (const char*)(ws + WS_KC), G, vcu}; EpiSoftmax E{WSB(WS_PC), (LAS float*)(lds + RED_OFF)}; gemm_phase(ring, 256, D, D, S, E); }
    SEAM(10);
    if (IN(11)) REP(11) { CrossOOrder S{(const char*)(ws + WS_PC), (const char*)(ws + WS_VCT), G, vcu}; EpiBf16 E{WSB(WS_OC), D, 1 << 30, 1.f}; gemm_phase(ring, 256, D, NB * NMEM, S, E); }
    SEAM(11);
    if (IN(12)) REP(12) { DenseOrder S; S.init(WSB(WS_OC), WSB(WS_W_CO), T, D, D, D, G, bx); EpiResStats<true> E{WSB(WS_V1B), WSF(CTL_STATS1), (const float*)args.in[19], (const float*)args.in[20], WSB(WS_V2B), WSF(CTL_STATS2)}; gemm_phase(ring, D, D, D, S, E); }
    SEAM(12);
    if (IN(14)) REP(14) { DenseOrder S; S.init(WSB(WS_V2B), WSB(WS_W_R), T, 256, D, D, G, bx); EpiLNApplyF32 E{WSF(WS_LOGITS), NE, NE, WSF(CTL_STATS2), WSF(CTL_CSR), WSF(CTL_CBR)}; gemm_phase(ring, D, D, D, S, E); }
    SEAM(14);
    if (IN(15)) REP(15) { p16_topk(args, lds, vcu, G); }
    SEAM(15);
    if (IN(16)) REP(16) { p17_gather(args, lds, vcu, G); }
    SEAM(16);
    if (IN(17)) REP(17) { build_tstart(args, lds);
        MoeOrder S{(const char*)(ws + WS_XG), (const char*)(ws + WS_W_GU), (const LAS int*)(lds + TST_OFF), (const LAS int*)(lds + TILE_E_OFF), 8, G, vcu, (size_t)256 * D, (size_t)2048 * 1024, (size_t)256 * 1024};
        EpiSwiglu E{ws + WS_ACT, (const float*)args.in[29]}; gemm_phase<EpiSwiglu, MoeOrder, true>(ring, D, D, D, S, E); }
    SEAM(17);
    if (IN(18)) REP(18) { build_tstart(args, lds);
        MoeOrder S{(const char*)(ws + WS_ACT), (const char*)(ws + WS_W_DN), (const LAS int*)(lds + TST_OFF), (const LAS int*)(lds + TILE_E_OFF), 4, G, vcu, (size_t)256 * D, (size_t)1024 * 1024, (size_t)256 * 1024};
        EpiDown E{WSB(WS_YB), (const float*)args.in[31], WSF(WS_ROWGATE)}; gemm_phase<EpiDown, MoeOrder, true>(ring, D, D, D, S, E); }
    SEAM(18);
    if (IN(19)) REP(19) { p20_final(args, vcu, G); }
    (void)cws;
#undef IN
#undef SEAM
}

extern "C" void kernel_launch(void* const* d_in, const int* in_sizes, int n_in, void* d_out, int out_size, void* d_ws, size_t ws_size, hipStream_t stream) {
    static int grid = 0;
    if (grid == 0) {
        if (n_in != 34 || in_sizes[0] != T * D || out_size != T * D || ws_size < WS_END) { fprintf(stderr, "kernel_launch: unexpected shapes / workspace (n_in %d, ws %zu)\n", n_in, ws_size); grid = -1; return; }
        int dev = 0, cus = 0, per_cu = 0;
        if (hipGetDevice(&dev) != hipSuccess || hipDeviceGetAttribute(&cus, hipDeviceAttributeMultiprocessorCount, dev) != hipSuccess) { grid = -1; return; }
        if (hipFuncSetAttribute((const void*)fwd_kernel, hipFuncAttributeMaxDynamicSharedMemorySize, LDS_BYTES) != hipSuccess) { fprintf(stderr, "kernel_launch: hipFuncSetAttribute failed\n"); grid = -1; return; }
        if (hipOccupancyMaxActiveBlocksPerMultiprocessor(&per_cu, (const void*)fwd_kernel, NWAVES * 64, LDS_BYTES) != hipSuccess || per_cu < 1) fprintf(stderr, "kernel_launch: occupancy query says %d\n", per_cu);
        (void)hipGetLastError();
        grid = cus;
    }
    if (grid < 0) return;
    if (hipMemsetAsync((char*)d_ws + WS_CTL, 0, CTL_ZERO_BYTES, stream) != hipSuccess) return;
    Args a{};
    for (int i = 0; i < 34; ++i) a.in[i] = d_in[i];
    a.out = (float*)d_out; a.ws = (unsigned char*)d_ws;
#if MK_ONE_LAUNCH
    a.ph_lo = 0; a.ph_hi = NPH;
    hipLaunchKernelGGL(fwd_kernel, dim3(grid), dim3(NWAVES * 64), LDS_BYTES, stream, a);
#else
    for (int p = 0; p < NPH; ++p) { a.ph_lo = p; a.ph_hi = p + 1; hipLaunchKernelGGL(fwd_kernel, dim3(grid), dim3(NWAVES * 64), LDS_BYTES, stream, a); }
#endif
}
```

```cpp
#include <hip/hip_runtime.h>
#include <cstdio>
#include <cstdint>
#include <cmath>

#define LAS __attribute__((address_space(3)))
#define GAS __attribute__((address_space(1)))
typedef unsigned short bf16_t;
typedef short bf16x8 __attribute__((ext_vector_type(8)));
typedef float f32x4 __attribute__((ext_vector_type(4)));
typedef float f32x2 __attribute__((ext_vector_type(2)));
typedef float f32x16 __attribute__((ext_vector_type(16)));
typedef unsigned u32x4 __attribute__((ext_vector_type(4)));
typedef unsigned u32x2 __attribute__((ext_vector_type(2)));
typedef GAS unsigned gu32;
#define RLX_AGENT __ATOMIC_RELAXED, __HIP_MEMORY_SCOPE_AGENT
#define DI __device__ __forceinline__

constexpr int D = 1024, NB = 16, SEQ = 2048, T = NB * SEQ, NMEM = 256;
constexpr int MH = 4, MHD = 128, MW = 512, MCH = 64;
constexpr int AH = 8, ANOPE = 64, AROPE = 32, AQK = 96, AVD = 64, AW = 512, AQR = 256, AKVR = 128;
constexpr int XH = 4, XHD = 256;
constexpr int NE = 32, TOPK = 4;
constexpr int DIN = 4008, NPROJ = 4096;
constexpr float DN_ALPHA = 1.189207115002721f;
constexpr float EPS = 1e-5f;
constexpr int NASSIGN = T * TOPK;
constexpr int NROWS = NASSIGN + NE * 256;
constexpr int NTILES_MAX = NROWS / 256;
constexpr int PC_QLAT = 0, PC_KVLAT = 256, PC_KROPE = 384, PC_IG = 416, PC_FG = 420, PC_XM = 512, PC_VM = 1024, PC_OP = 1536, PC_GM = 2048, PC_GA = 3072;

DI unsigned f2bf(float f) { unsigned u = __builtin_bit_cast(unsigned, f); return (u + 0x7fffu + ((u >> 16) & 1u)) >> 16; }
typedef __bf16 bf16x2_hw __attribute__((ext_vector_type(2)));
DI unsigned pk2(float lo, float hi) { const f32x2 v = {lo, hi}; return __builtin_bit_cast(unsigned, __builtin_convertvector(v, bf16x2_hw)); }
DI float bf2f(unsigned short b) { return __builtin_bit_cast(float, (unsigned)b << 16); }
DI float bflo(unsigned w) { return __builtin_bit_cast(float, w << 16); }
DI float bfhi(unsigned w) { return __builtin_bit_cast(float, w & 0xffff0000u); }
DI float wave_sum(float v) {
#pragma unroll
    for (int o = 1; o < 64; o <<= 1) v += __shfl_xor(v, o);
    return v;
}
DI float wave_max(float v) {
#pragma unroll
    for (int o = 1; o < 64; o <<= 1) v = fmaxf(v, __shfl_xor(v, o));
    return v;
}
DI float rcpf_(float x) { return __builtin_amdgcn_rcpf(x); }
DI float sigmoidf_(float x) { return __builtin_amdgcn_rcpf(1.0f + __builtin_amdgcn_exp2f(-1.4426950408889634f * x)); }
DI int crow(int r, int hi) { return (r & 3) + 8 * (r >> 2) + 4 * hi; }
#define MFMA32(a, b, c) __builtin_amdgcn_mfma_f32_32x32x16_bf16((a), (b), (c), 0, 0, 0)

namespace pg8 {
constexpr int BM = 256, BK = 64, HALF = 128, HTB = HALF * BK * 2, STAGE_BYTES = 8 * HTB;
__host__ __device__ __forceinline__ int lds_byte(int r, int c) { const int st = (r >> 4) * 2 + (c >> 5), rr = r & 15, cc = c & 31, ob = rr * 64 + cc * 2; return st * 1024 + (ob ^ (((ob >> 9) & 1) << 5)); }
__host__ __device__ __forceinline__ void stage_rc(int b, int& R, int& C) { const int st = b / 1024, sb = b % 1024, swz = sb ^ (((sb >> 9) & 1) << 5); R = (st >> 1) * 16 + swz / 64; C = (st & 1) * 32 + (swz % 64) / 2; }
__host__ __device__ __forceinline__ int perm32(int rho) { const int n = rho >> 4, i = rho & 15; return 8 * (i >> 2) + 4 * n + (i & 3); }

struct Unit { int pm, pn, aux; const char* a; const char* b; };
struct Ctx { int wr, wc, fr, fq, wid, lane; };

DI unsigned cvt_pk_bf16(float lo, float hi) { unsigned r; asm volatile("v_cvt_pk_bf16_f32 %0, %1, %2" : "=v"(r) : "v"(lo), "v"(hi)); return r; }

typedef f32x4 Acc[2][2][4][2];

DI void glds16_s(const char* gbase, unsigned voff, unsigned lds_dst) { unsigned keep;
    asm volatile("s_mov_b32 %0, m0\n\ts_mov_b32 m0, %1\n\ts_nop 0\n\tglobal_load_lds_dwordx4 %2, %3\n\ts_mov_b32 m0, %0" : "=&s"(keep) : "s"(lds_dst), "v"(voff), "s"(gbase) : "memory"); }
typedef int v8i_t __attribute__((ext_vector_type(8)));
typedef int i32x4_t __attribute__((ext_vector_type(4)));
template <class Epi, class Sched, bool FP8 = false>
DI void gemm_phase(LAS unsigned char* lds, const int K, const int lda, const int ldb, const Sched& S, const Epi& E) {
    int tid = threadIdx.x; asm volatile("" : "+v"(tid));
    const int wid = __builtin_amdgcn_readfirstlane(tid >> 6), lane = tid & 63, wr = wid >> 2, wc = wid & 3, fr = lane & 15, fq = lane >> 4;
    constexpr int ESZ = FP8 ? 1 : 2;
    const int nt = K * ESZ / (BK * 2);
    unsigned voffA[2], voffB[2];
#pragma unroll
    for (int i = 0; i < 2; ++i) { int R, C; stage_rc(tid * 16 + i * 8192, R, C); const int Rb = Epi::PERM ? ((R & ~31) + perm32(R & 31)) : R;
        voffA[i] = (unsigned)(R * lda * ESZ + C * 2); voffB[i] = (unsigned)(Rb * ldb * ESZ + C * 2); }
    const size_t kstep = (size_t)(BK * 2);
    const size_t hstepA = (size_t)HALF * lda * ESZ, hstepB = (size_t)HALF * ldb * ESZ;
    const unsigned ldsw = (unsigned)wid * 1024u;
    const int aoff = lds_byte(wr * 64 + fr, fq * 8), boff = lds_byte(wc * 32 + fr, fq * 8);
    const Ctx cx{wr, wc, fr, fq, wid, lane};
    const unsigned lds_u = (unsigned)__builtin_amdgcn_readfirstlane((int)((unsigned)(size_t)lds + ldsw));
    LAS unsigned char* ldsB = lds + 4 * HTB + boff;
#define PG8_SA(b, h) (((b) * 2 + (h)) * HTB)
#define PG8_SB(b, h) ((4 + (b) * 2 + (h)) * HTB)
#define PG8_SBL(b, h) (((b) * 2 + (h)) * HTB)
#define PG8_STAGE(bufoff, gbase, voff) do { _Pragma("unroll") for (int _i = 0; _i < 2; ++_i) \
        glds16_s((const char*)(gbase), (voff)[_i], lds_u + (unsigned)((bufoff) + _i * 8192)); } while (0)
#define PG8_RD(off) (*(const LAS i32x4_t*)(lds + (off)))
#define PG8_CAT2(x, y) __builtin_shufflevector((x), (y), 0, 1, 2, 3, 4, 5, 6, 7)
#define PG8_LDA(dst, b, h) do { if constexpr (FP8) { _Pragma("unroll") for (int m = 0; m < 4; ++m) dst##8[m] = PG8_CAT2(PG8_RD(PG8_SA(b, h) + aoff + m * 2048), PG8_RD(PG8_SA(b, h) + aoff + m * 2048 + 1024)); } \
        else { _Pragma("unroll") for (int m = 0; m < 4; ++m) _Pragma("unroll") for (int k = 0; k < 2; ++k) dst[m][k] = *(const LAS bf16x8*)(lds + PG8_SA(b, h) + aoff + m * 2048 + k * 1024); } } while (0)
#define PG8_LDB(dst, b, h) do { if constexpr (FP8) { _Pragma("unroll") for (int n = 0; n < 2; ++n) dst##8[n] = PG8_CAT2(*(const LAS i32x4_t*)(ldsB + PG8_SBL(b, h) + n * 2048), *(const LAS i32x4_t*)(ldsB + PG8_SBL(b, h) + n * 2048 + 1024)); } \
        else { _Pragma("unroll") for (int n = 0; n < 2; ++n) _Pragma("unroll") for (int k = 0; k < 2; ++k) dst[n][k] = *(const LAS bf16x8*)(ldsB + PG8_SBL(b, h) + n * 2048 + k * 1024); } } while (0)
#define PG8_MMA(ai, bj, At, Bt) do { __builtin_amdgcn_s_setprio(1); \
        if constexpr (FP8) { _Pragma("unroll") for (int m = 0; m < 4; ++m) _Pragma("unroll") for (int n = 0; n < 2; ++n) \
            acc[ai][bj][m][n] = __builtin_amdgcn_mfma_scale_f32_16x16x128_f8f6f4(Bt##8[n], At##8[m], acc[ai][bj][m][n], 0, 0, 0, 0x7f7f7f7f, 0, 0x7f7f7f7f); } \
        else { _Pragma("unroll") for (int m = 0; m < 4; ++m) _Pragma("unroll") for (int n = 0; n < 2; ++n) _Pragma("unroll") for (int k = 0; k < 2; ++k) \
            acc[ai][bj][m][n] = __builtin_amdgcn_mfma_f32_16x16x32_bf16(Bt[n][k], At[m][k], acc[ai][bj][m][n], 0, 0, 0); } \
        __builtin_amdgcn_s_setprio(0); } while (0)
#define PG8_WAIT_V(n) asm volatile("s_waitcnt vmcnt(" #n ")" ::: "memory")
#define PG8_WAIT_L(n) asm volatile("s_waitcnt lgkmcnt(" #n ")" ::: "memory")
#define PG8_BAR __builtin_amdgcn_s_barrier()
#define PG8_SCHED __builtin_amdgcn_sched_barrier(0)
    Unit cur, nxt; int ui = 0;
    if (!S.next(0, cur)) return;
    Acc acc;
#pragma unroll
    for (int a = 0; a < 2; ++a)
#pragma unroll
        for (int b = 0; b < 2; ++b)
#pragma unroll
            for (int m = 0; m < 4; ++m)
#pragma unroll
                for (int n = 0; n < 2; ++n) acc[a][b][m][n] = (f32x4){0.f, 0.f, 0.f, 0.f};
    bf16x8 At[4][2], B0[2][2], B1[2][2]; v8i_t At8[4], B08[2], B18[2];
    const char* cA = cur.a; const char* cB = cur.b;
    PG8_STAGE(PG8_SB(0, 0), cB, voffB); PG8_STAGE(PG8_SB(0, 1), cB + hstepB, voffB); PG8_STAGE(PG8_SA(0, 0), cA, voffA); PG8_STAGE(PG8_SA(0, 1), cA + hstepA, voffA);
    if (wr == 1) PG8_BAR;
    PG8_WAIT_V(2); PG8_BAR;
    PG8_STAGE(PG8_SB(1, 0), cB + kstep, voffB); PG8_STAGE(PG8_SA(1, 0), cA + kstep, voffA); PG8_STAGE(PG8_SB(1, 1), cB + hstepB + kstep, voffB);
    PG8_WAIT_V(6); PG8_BAR;
    for (;;) {
        const bool has_next = S.next(ui + 1, nxt);
        const char* nA = has_next ? nxt.a : cA; const char* nB = has_next ? nxt.b : cB;
#pragma unroll 1
        for (int t = 0; t < nt; t += 2) {
            const bool last = (t == nt - 2);
            const char* a1 = cA + (size_t)(t + 1) * kstep;
            const char* a2 = last ? nA : cA + (size_t)(t + 2) * kstep; const char* b2 = last ? nB : cB + (size_t)(t + 2) * kstep;
            const char* a3 = a2 + kstep; const char* b3 = b2 + kstep;
            PG8_LDB(B0, 0, 0); PG8_LDB(B1, 0, 1); PG8_SCHED; PG8_LDA(At, 0, 0); PG8_STAGE(PG8_SA(1, 1), a1 + hstepA, voffA);
            PG8_WAIT_V(8); PG8_WAIT_L(0); PG8_BAR; PG8_MMA(0, 0, At, B0); PG8_MMA(0, 1, At, B1); PG8_BAR; PG8_SCHED;
            PG8_LDA(At, 0, 1); PG8_STAGE(PG8_SB(0, 0), b2, voffB); PG8_STAGE(PG8_SB(0, 1), b2 + hstepB, voffB); PG8_STAGE(PG8_SA(0, 0), a2, voffA);
            PG8_WAIT_V(8); PG8_WAIT_L(0); PG8_BAR; PG8_MMA(1, 0, At, B0); PG8_MMA(1, 1, At, B1); PG8_BAR; PG8_SCHED;
            PG8_LDB(B0, 1, 0); PG8_LDB(B1, 1, 1); PG8_SCHED; PG8_LDA(At, 1, 0); PG8_STAGE(PG8_SA(0, 1), a2 + hstepA, voffA);
            PG8_WAIT_V(8); PG8_WAIT_L(0); PG8_BAR; PG8_MMA(0, 0, At, B0); PG8_MMA(0, 1, At, B1); PG8_BAR; PG8_SCHED;
            PG8_LDA(At, 1, 1); PG8_STAGE(PG8_SB(1, 0), b3, voffB); PG8_STAGE(PG8_SB(1, 1), b3 + hstepB, voffB); PG8_STAGE(PG8_SA(1, 0), a3, voffA);
            PG8_WAIT_V(8); PG8_WAIT_L(0); PG8_BAR; PG8_MMA(1, 0, At, B0); PG8_MMA(1, 1, At, B1); PG8_BAR; PG8_SCHED;
        }
        if (wr == 0) PG8_BAR;
        E(acc, cur, cx);
        if (!has_next) break;
#pragma unroll
        for (int a = 0; a < 2; ++a)
#pragma unroll
            for (int b = 0; b < 2; ++b)
#pragma unroll
                for (int m = 0; m < 4; ++m)
#pragma unroll
                    for (int n = 0; n < 2; ++n) acc[a][b][m][n] = (f32x4){0.f, 0.f, 0.f, 0.f};
        cur = nxt; cA = nA; cB = nB; ++ui;
        if (wr == 1) PG8_BAR;
    }
    PG8_WAIT_V(0);
    PG8_BAR;
#undef PG8_SA
#undef PG8_SB
#undef PG8_SBL
#undef PG8_STAGE
#undef PG8_LDA
#undef PG8_LDB
#undef PG8_MMA
#undef PG8_CAT2
#undef PG8_RD
#undef PG8_WAIT_V
#undef PG8_WAIT_L
#undef PG8_BAR
#undef PG8_SCHED
}
}
namespace pg8 {
constexpr int NXCD = 8, WGM = 8;
struct DenseOrder {
    const char* A; const char* B; int nM, nN, nwg, G, c; size_t strideA, strideB;
    DI void init(const void* A_, const void* B_, int M, int N, int lda, int ldb, int G_, int c_) { A = (const char*)A_; B = (const char*)B_; nM = M / BM; nN = N / BM; nwg = nM * nN; G = G_; c = c_;
        strideA = (size_t)BM * lda * 2; strideB = (size_t)BM * ldb * 2; }
    DI bool next(int i, Unit& u) const {
        const long L = (long)i * G + c; if (L >= nwg) return false;
        int wgid = (int)L; { const int q = nwg / NXCD, r = nwg % NXCD, xcd = wgid % NXCD, off = wgid / NXCD; wgid = (xcd < r ? xcd * (q + 1) : r * (q + 1) + (xcd - r) * q) + off; }
        const int nig = WGM * nN, gid = wgid / nig, fm = gid * WGM, gsz = (nM - fm) < WGM ? (nM - fm) : WGM;
        u.pm = fm + ((wgid % nig) % gsz); u.pn = (wgid % nig) / gsz; u.aux = 0;
        u.a = A + (size_t)u.pm * strideA; u.b = B + (size_t)u.pn * strideB; return true;
    }
};
struct CrossSOrder {
    const char* Q; const char* Kc; int G, v;
    DI bool next(int i, Unit& u) const {
        const int L = i * G + v; if (L >= (T / 256) * XH) return false;
        u.pm = L >> 2; u.pn = L & 3; u.aux = 0;
        u.a = Q + ((size_t)u.pm * 256 * D + u.pn * 256) * 2; u.b = Kc + ((size_t)(u.pm >> 3) * 256 * D + u.pn * 256) * 2; return true;
    }
};
struct CrossOOrder {
    const char* P; const char* Vt; int G, v;
    DI bool next(int i, Unit& u) const {
        const int L = i * G + v; if (L >= (T / 256) * XH) return false;
        u.pm = L >> 2; u.pn = L & 3; u.aux = 0;
        u.a = P + ((size_t)u.pm * 256 * D + u.pn * 256) * 2; u.b = Vt + ((size_t)u.pn * 256 * (NB * NMEM) + (size_t)(u.pm >> 3) * 256) * 2; return true;
    }
};
struct MoeOrder {
    const char* A; const char* W; const LAS int* tstart; const LAS int* tile_e; int npn, G, v; size_t strideA, strideW, strideN;
    DI bool next(int i, Unit& u) const {
        const int L = i * G + v; const int total = __builtin_amdgcn_readfirstlane(tstart[NE]) * npn; if (L >= total) return false;
        const int tile = L / npn; u.pm = tile; u.pn = L - tile * npn;
        const int e = __builtin_amdgcn_readfirstlane(tile_e[tile]);
        u.aux = e;
        u.a = A + (size_t)tile * strideA; u.b = W + (size_t)e * strideW + (size_t)u.pn * strideN; return true;
    }
};

DI unsigned pk4_fp8(float a, float b, float c, float d) { int w = 0; w = __builtin_amdgcn_cvt_pk_fp8_f32(a, b, w, false); w = __builtin_amdgcn_cvt_pk_fp8_f32(c, d, w, true); return (unsigned)w; }
constexpr float F8_XS = 16.0f, F8_WS = 64.0f, F8_AS = 8.0f;
struct EpiBf16 {
    static constexpr bool PERM = true;
    bf16_t* O; int ldc; int sc_from; float scale;
    DI void operator()(const Acc& acc, const Unit& u, const Ctx& c) const {
        int row0 = u.pm * BM + c.wr * 64 + c.fr, col0 = u.pn * BM + c.wc * 32 + 8 * c.fq; asm volatile("" : "+v"(row0), "+v"(col0));
        const float sc = (u.pn >= sc_from) ? scale : 1.0f;
#pragma unroll
        for (int ai = 0; ai < 2; ++ai)
#pragma unroll
            for (int m = 0; m < 4; ++m) { bf16_t* rowp = O + (size_t)(row0 + ai * HALF + m * 16) * ldc + col0;
#pragma unroll
                for (int bj = 0; bj < 2; ++bj) { const f32x4 v0 = acc[ai][bj][m][0] * sc, v1 = acc[ai][bj][m][1] * sc;
                    u32x4 w; w.x = cvt_pk_bf16(v0[0], v0[1]); w.y = cvt_pk_bf16(v0[2], v0[3]); w.z = cvt_pk_bf16(v1[0], v1[1]); w.w = cvt_pk_bf16(v1[2], v1[3]);
                    *(u32x4*)(rowp + bj * HALF) = w; } }
    }
};
struct EpiProj {
    static constexpr bool PERM = true;
    bf16_t* O; float* gates;
    DI void operator()(const Acc& acc, const Unit& u, const Ctx& c) const {
        int row0 = u.pm * BM + c.wr * 64 + c.fr, col0 = u.pn * BM + c.wc * 32 + 8 * c.fq; asm volatile("" : "+v"(row0), "+v"(col0));
#pragma unroll
        for (int ai = 0; ai < 2; ++ai)
#pragma unroll
            for (int m = 0; m < 4; ++m) { const int row = row0 + ai * HALF + m * 16; bf16_t* rowp = O + (size_t)row * NPROJ + col0;
#pragma unroll
                for (int bj = 0; bj < 2; ++bj) { const f32x4 v0 = acc[ai][bj][m][0], v1 = acc[ai][bj][m][1];
                    u32x4 w; w.x = cvt_pk_bf16(v0[0], v0[1]); w.y = cvt_pk_bf16(v0[2], v0[3]); w.z = cvt_pk_bf16(v1[0], v1[1]); w.w = cvt_pk_bf16(v1[2], v1[3]);
                    *(u32x4*)(rowp + bj * HALF) = w; }
                if (u.pn == 1 && c.wc == 1 && c.fq == 0) { *(f32x4*)(gates + (size_t)row * 8) = acc[ai][1][m][0]; *(f32x4*)(gates + (size_t)row * 8 + 4) = acc[ai][1][m][1]; } }
    }
};
struct EpiQmla {
    static constexpr bool PERM = true;
    bf16_t* O; const float* cs;
    float scale;
    DI void operator()(const Acc& acc, const Unit& u, const Ctx& c) const {
        int row0 = u.pm * BM + c.wr * 64 + c.fr, col0 = u.pn * BM + c.wc * 32 + 8 * c.fq; asm volatile("" : "+v"(row0), "+v"(col0));
#pragma unroll
        for (int ai = 0; ai < 2; ++ai)
#pragma unroll
            for (int m = 0; m < 4; ++m) { const int row = row0 + ai * HALF + m * 16; bf16_t* rowp = O + (size_t)row * (AH * AQK) + col0;
#pragma unroll
                for (int bj = 0; bj < 2; ++bj) { f32x4 v0 = acc[ai][bj][m][0] * scale, v1 = acc[ai][bj][m][1] * scale;
                    const int cc = (col0 + bj * HALF) % AQK;
                    if (cc >= ANOPE) { const int p0 = (cc - ANOPE) >> 1;
                        const f32x4 t0 = *(const f32x4*)(cs + (size_t)row * 32 + p0 * 2), t1 = *(const f32x4*)(cs + (size_t)row * 32 + p0 * 2 + 4);
                        f32x4 r0, r1;
                        r0[0] = v0[0] * t0[0] - v0[1] * t0[1]; r0[1] = v0[1] * t0[0] + v0[0] * t0[1];
                        r0[2] = v0[2] * t0[2] - v0[3] * t0[3]; r0[3] = v0[3] * t0[2] + v0[2] * t0[3];
                        r1[0] = v1[0] * t1[0] - v1[1] * t1[1]; r1[1] = v1[1] * t1[0] + v1[0] * t1[1];
                        r1[2] = v1[2] * t1[2] - v1[3] * t1[3]; r1[3] = v1[3] * t1[2] + v1[2] * t1[3];
                        v0 = r0; v1 = r1; }
                    u32x4 w; w.x = cvt_pk_bf16(v0[0], v0[1]); w.y = cvt_pk_bf16(v0[2], v0[3]); w.z = cvt_pk_bf16(v1[0], v1[1]); w.w = cvt_pk_bf16(v1[2], v1[3]);
                    *(u32x4*)(rowp + bj * HALF) = w; } }
    }
};
template <bool ADD> struct EpiGate {
    static constexpr bool PERM = true;
    bf16_t* O; const bf16_t* proj; int gcol;
    DI void operator()(const Acc& acc, const Unit& u, const Ctx& c) const {
        int row0 = u.pm * BM + c.wr * 64 + c.fr, col0 = u.pn * BM + c.wc * 32 + 8 * c.fq; asm volatile("" : "+v"(row0), "+v"(col0));
#pragma unroll
        for (int ai = 0; ai < 2; ++ai) {
            u32x4 gg[4][2], pp[4][2];
#pragma unroll
            for (int m = 0; m < 4; ++m)
#pragma unroll
                for (int bj = 0; bj < 2; ++bj) { const int row = row0 + ai * HALF + m * 16; gg[m][bj] = *(const u32x4*)(proj + (size_t)row * NPROJ + gcol + col0 + bj * HALF);
                    if (ADD) pp[m][bj] = *(const u32x4*)(O + (size_t)row * D + col0 + bj * HALF); }
#pragma unroll
            for (int m = 0; m < 4; ++m) { const int row = row0 + ai * HALF + m * 16; bf16_t* rowp = O + (size_t)row * D + col0;
#pragma unroll
                for (int bj = 0; bj < 2; ++bj) { const f32x4 v0 = acc[ai][bj][m][0], v1 = acc[ai][bj][m][1];
                    const u32x4 g = gg[m][bj];
                    float o[8];
                    o[0] = sigmoidf_(bflo(g.x)) * v0[0]; o[1] = sigmoidf_(bfhi(g.x)) * v0[1]; o[2] = sigmoidf_(bflo(g.y)) * v0[2]; o[3] = sigmoidf_(bfhi(g.y)) * v0[3];
                    o[4] = sigmoidf_(bflo(g.z)) * v1[0]; o[5] = sigmoidf_(bfhi(g.z)) * v1[1]; o[6] = sigmoidf_(bflo(g.w)) * v1[2]; o[7] = sigmoidf_(bfhi(g.w)) * v1[3];
                    if (ADD) { const u32x4 p = pp[m][bj];
                        o[0] += bflo(p.x); o[1] += bfhi(p.x); o[2] += bflo(p.y); o[3] += bfhi(p.y); o[4] += bflo(p.z); o[5] += bfhi(p.z); o[6] += bflo(p.w); o[7] += bfhi(p.w); }
                    u32x4 w; w.x = cvt_pk_bf16(o[0], o[1]); w.y = cvt_pk_bf16(o[2], o[3]); w.z = cvt_pk_bf16(o[4], o[5]); w.w = cvt_pk_bf16(o[6], o[7]);
                    *(u32x4*)(rowp + bj * HALF) = w; } }
            __builtin_amdgcn_sched_barrier(0); }
    }
};
struct EpiF32 {
    static constexpr bool PERM = false;
    float* C; int ldc; int ncols_valid;
    DI void operator()(const Acc& acc, const Unit& u, const Ctx& c) const {
        int row0 = u.pm * BM + c.wr * 64 + c.fr, col0 = u.pn * BM + c.wc * 32 + 4 * c.fq; asm volatile("" : "+v"(row0), "+v"(col0));
#pragma unroll
        for (int ai = 0; ai < 2; ++ai)
#pragma unroll
            for (int m = 0; m < 4; ++m) { float* rowp = C + (size_t)(row0 + ai * HALF + m * 16) * ldc + col0;
#pragma unroll
                for (int bj = 0; bj < 2; ++bj)
#pragma unroll
                    for (int n = 0; n < 2; ++n) if (col0 + bj * HALF + n * 16 < ncols_valid) *(f32x4*)(rowp + bj * HALF + n * 16) = acc[ai][bj][m][n]; }
    }
};

DI void row_stats(const float* stats, int row, float& mean, float& rstd) { const f32x2 st = *(const f32x2*)(stats + (size_t)row * 2);
    mean = st[0] * (1.0f / D); const float var = fmaxf(st[1] * (1.0f / D) - mean * mean, 0.f); rstd = __builtin_amdgcn_rsqf(var + EPS); }
template <bool NORM> struct EpiResStats {
    static constexpr bool PERM = true;
    const bf16_t* res; const float* pstats; const float* pg; const float* pb; bf16_t* VB; float* stats;
    DI void operator()(const Acc& acc, const Unit& u, const Ctx& c) const {
        int row0 = u.pm * BM + c.wr * 64 + c.fr, col0 = u.pn * BM + c.wc * 32 + 8 * c.fq; asm volatile("" : "+v"(row0), "+v"(col0));
#pragma unroll
        for (int ai = 0; ai < 2; ++ai) {
            u32x4 rr[4][2];
#pragma unroll
            for (int m = 0; m < 4; ++m)
#pragma unroll
                for (int bj = 0; bj < 2; ++bj) rr[m][bj] = *(const u32x4*)(res + (size_t)(row0 + ai * HALF + m * 16) * D + col0 + bj * HALF);
#pragma unroll
            for (int m = 0; m < 4; ++m) { const int row = row0 + ai * HALF + m * 16; const size_t ro = (size_t)row * D + col0;
                float mean = 0.f, rstd = 1.f; if (NORM) row_stats(pstats, row, mean, rstd);
                float s1 = 0.f, s2 = 0.f;
#pragma unroll
                for (int bj = 0; bj < 2; ++bj) { const u32x4 w = rr[m][bj];
                    f32x4 r0 = {bflo(w.x), bfhi(w.x), bflo(w.y), bfhi(w.y)}, r1 = {bflo(w.z), bfhi(w.z), bflo(w.w), bfhi(w.w)};
                    if (NORM) { const f32x4 g0 = *(const f32x4*)(pg + col0 + bj * HALF), g1 = *(const f32x4*)(pg + col0 + bj * HALF + 4), b0 = *(const f32x4*)(pb + col0 + bj * HALF), b1 = *(const f32x4*)(pb + col0 + bj * HALF + 4);
                        r0 = (r0 - mean) * rstd * g0 + b0; r1 = (r1 - mean) * rstd * g1 + b1; }
                    const f32x4 v0 = r0 * DN_ALPHA + acc[ai][bj][m][0], v1 = r1 * DN_ALPHA + acc[ai][bj][m][1];
                    u32x4 o; o.x = cvt_pk_bf16(v0[0], v0[1]); o.y = cvt_pk_bf16(v0[2], v0[3]); o.z = cvt_pk_bf16(v1[0], v1[1]); o.w = cvt_pk_bf16(v1[2], v1[3]);
                    *(u32x4*)(VB + ro + bj * HALF) = o;
                    s1 += (v0[0] + v0[1]) + (v0[2] + v0[3]) + (v1[0] + v1[1]) + (v1[2] + v1[3]);
                    s2 += (v0[0] * v0[0] + v0[1] * v0[1]) + (v0[2] * v0[2] + v0[3] * v0[3]) + (v1[0] * v1[0] + v1[1] * v1[1]) + (v1[2] * v1[2] + v1[3] * v1[3]); }
                s1 += __shfl_xor(s1, 16); s1 += __shfl_xor(s1, 32); s2 += __shfl_xor(s2, 16); s2 += __shfl_xor(s2, 32);
                if (c.fq == 0) { __hip_atomic_fetch_add(stats + (size_t)row * 2, s1, RLX_AGENT); __hip_atomic_fetch_add(stats + (size_t)row * 2 + 1, s2, RLX_AGENT); } }
            __builtin_amdgcn_sched_barrier(0); }
    }
};
struct EpiLNApplyBf16 {
    static constexpr bool PERM = true;
    bf16_t* O; int ldc; const float* stats; const float* cs; const float* cb; float scale;
    DI void operator()(const Acc& acc, const Unit& u, const Ctx& c) const {
        int row0 = u.pm * BM + c.wr * 64 + c.fr, col0 = u.pn * BM + c.wc * 32 + 8 * c.fq; asm volatile("" : "+v"(row0), "+v"(col0));
        f32x4 csv[2][2], cbv[2][2];
#pragma unroll
        for (int bj = 0; bj < 2; ++bj)
#pragma unroll
            for (int n = 0; n < 2; ++n) { csv[bj][n] = *(const f32x4*)(cs + col0 + bj * HALF + 4 * n); cbv[bj][n] = *(const f32x4*)(cb + col0 + bj * HALF + 4 * n); }
        f32x2 sts[2][4];
#pragma unroll
        for (int ai = 0; ai < 2; ++ai)
#pragma unroll
            for (int m = 0; m < 4; ++m) sts[ai][m] = *(const f32x2*)(stats + (size_t)(row0 + ai * HALF + m * 16) * 2);
#pragma unroll
        for (int ai = 0; ai < 2; ++ai)
#pragma unroll
            for (int m = 0; m < 4; ++m) { const int row = row0 + ai * HALF + m * 16; const float mean = sts[ai][m][0] * (1.0f / D); const float rstd = __builtin_amdgcn_rsqf(fmaxf(sts[ai][m][1] * (1.0f / D) - mean * mean, 0.f) + EPS);
                bf16_t* rowp = O + (size_t)row * ldc + col0;
#pragma unroll
                for (int bj = 0; bj < 2; ++bj) { const f32x4 v0 = ((acc[ai][bj][m][0] - csv[bj][0] * mean) * rstd + cbv[bj][0]) * scale, v1 = ((acc[ai][bj][m][1] - csv[bj][1] * mean) * rstd + cbv[bj][1]) * scale;
                    u32x4 w; w.x = cvt_pk_bf16(v0[0], v0[1]); w.y = cvt_pk_bf16(v0[2], v0[3]); w.z = cvt_pk_bf16(v1[0], v1[1]); w.w = cvt_pk_bf16(v1[2], v1[3]);
                    *(u32x4*)(rowp + bj * HALF) = w; } }
    }
};
struct EpiLNApplyF32 {
    static constexpr bool PERM = false;
    float* C; int ldc; int ncols_valid; const float* stats; const float* cs; const float* cb;
    DI void operator()(const Acc& acc, const Unit& u, const Ctx& c) const {
        int row0 = u.pm * BM + c.wr * 64 + c.fr, col0 = u.pn * BM + c.wc * 32 + 4 * c.fq; asm volatile("" : "+v"(row0), "+v"(col0));
#pragma unroll
        for (int ai = 0; ai < 2; ++ai)
#pragma unroll
            for (int m = 0; m < 4; ++m) { const int row = row0 + ai * HALF + m * 16; float mean, rstd; row_stats(stats, row, mean, rstd);
                float* rowp = C + (size_t)row * ldc + col0;
#pragma unroll
                for (int bj = 0; bj < 2; ++bj)
#pragma unroll
                    for (int n = 0; n < 2; ++n) if (col0 + bj * HALF + n * 16 < ncols_valid) { const f32x4 csv = *(const f32x4*)(cs + col0 + bj * HALF + n * 16), cbv = *(const f32x4*)(cb + col0 + bj * HALF + n * 16);
                        *(f32x4*)(rowp + bj * HALF + n * 16) = (acc[ai][bj][m][n] - csv * mean) * rstd + cbv; } }
    }
};
struct EpiSoftmax {
    static constexpr bool PERM = true;
    bf16_t* O; LAS float* red;
    DI void operator()(Acc& acc, const Unit& u, const Ctx& c) const {
        int row0 = u.pm * BM + c.wr * 64 + c.fr, col0 = u.pn * BM + c.wc * 32 + 8 * c.fq; asm volatile("" : "+v"(row0), "+v"(col0));
        int rbase = (c.wr * 64 + c.fr) * 4; asm volatile("" : "+v"(rbase));
        LAS float* r1 = red + rbase; LAS float* r2 = red + 1024 + rbase;
#pragma unroll
        for (int ai = 0; ai < 2; ++ai)
#pragma unroll
            for (int m = 0; m < 4; ++m) { float v = -INFINITY;
#pragma unroll
                for (int bj = 0; bj < 2; ++bj)
#pragma unroll
                    for (int n = 0; n < 2; ++n) { const f32x4 x = acc[ai][bj][m][n]; v = fmaxf(v, fmaxf(fmaxf(x[0], x[1]), fmaxf(x[2], x[3]))); }
                v = fmaxf(v, __shfl_xor(v, 16)); v = fmaxf(v, __shfl_xor(v, 32));
                if (c.fq == 0) r1[(ai * HALF + m * 16) * 4 + c.wc] = v;
                __builtin_amdgcn_sched_barrier(0); }
        asm volatile("s_waitcnt lgkmcnt(0)" ::: "memory"); __builtin_amdgcn_s_barrier(); asm volatile("" ::: "memory");
#pragma unroll
        for (int ai = 0; ai < 2; ++ai)
#pragma unroll
            for (int m = 0; m < 4; ++m) { const f32x4 q = *(const LAS f32x4*)(r1 + (ai * HALF + m * 16) * 4);
                const float mm = fmaxf(fmaxf(q[0], q[1]), fmaxf(q[2], q[3])); float s = 0.f;
#pragma unroll
                for (int bj = 0; bj < 2; ++bj)
#pragma unroll
                    for (int n = 0; n < 2; ++n) { f32x4 x = acc[ai][bj][m][n];
                        x[0] = __builtin_amdgcn_exp2f(x[0] - mm); x[1] = __builtin_amdgcn_exp2f(x[1] - mm); x[2] = __builtin_amdgcn_exp2f(x[2] - mm); x[3] = __builtin_amdgcn_exp2f(x[3] - mm);
                        acc[ai][bj][m][n] = x; s += (x[0] + x[1]) + (x[2] + x[3]); }
                s += __shfl_xor(s, 16); s += __shfl_xor(s, 32);
                if (c.fq == 0) r2[(ai * HALF + m * 16) * 4 + c.wc] = s;
                __builtin_amdgcn_sched_barrier(0); }
        asm volatile("s_waitcnt lgkmcnt(0)" ::: "memory"); __builtin_amdgcn_s_barrier(); asm volatile("" ::: "memory");
#pragma unroll
        for (int ai = 0; ai < 2; ++ai)
#pragma unroll
            for (int m = 0; m < 4; ++m) { const f32x4 q = *(const LAS f32x4*)(r2 + (ai * HALF + m * 16) * 4);
                const float inv = rcpf_((q[0] + q[1]) + (q[2] + q[3]));
                bf16_t* rowp = O + (size_t)(row0 + ai * HALF + m * 16) * D + col0;
#pragma unroll
                for (int bj = 0; bj < 2; ++bj) { const f32x4 v0 = acc[ai][bj][m][0] * inv, v1 = acc[ai][bj][m][1] * inv;
                    u32x4 w; w.x = cvt_pk_bf16(v0[0], v0[1]); w.y = cvt_pk_bf16(v0[2], v0[3]); w.z = cvt_pk_bf16(v1[0], v1[1]); w.w = cvt_pk_bf16(v1[2], v1[3]);
                    *(u32x4*)(rowp + bj * HALF) = w; }
                __builtin_amdgcn_sched_barrier(0); }
    }
};
struct EpiSwiglu {
    static constexpr bool PERM = true;
    unsigned char* O; const float* bias;
    DI void operator()(const Acc& acc, const Unit& u, const Ctx& c) const {
        int row0 = u.pm * BM + c.wr * 64 + c.fr, col0 = u.pn * BM + c.wc * 32 + 8 * c.fq; asm volatile("" : "+v"(row0), "+v"(col0));
        constexpr float us = 1.0f / (F8_XS * F8_WS);
        f32x4 bv[2][2];
#pragma unroll
        for (int bj = 0; bj < 2; ++bj)
#pragma unroll
            for (int n = 0; n < 2; ++n) bv[bj][n] = *(const f32x4*)(bias + (size_t)u.aux * 2048 + col0 + bj * HALF + 4 * n);
#pragma unroll
        for (int ai = 0; ai < 2; ++ai)
#pragma unroll
            for (int m = 0; m < 4; ++m) { unsigned char* rowp = O + (size_t)(row0 + ai * HALF + m * 16) * 1024 + (col0 >> 1);
#pragma unroll
                for (int bj = 0; bj < 2; ++bj) { const f32x4 v0 = acc[ai][bj][m][0] * us + bv[bj][0], v1 = acc[ai][bj][m][1] * us + bv[bj][1];
                    float o[4];
#define SWG(g, l) ({ const float g_ = fminf((g), 7.0f), l_ = fminf(fmaxf((l), -7.0f), 7.0f); fminf(fmaxf(g_ * sigmoidf_(1.702f * g_) * (l_ + 1.0f) * F8_AS, -448.0f), 448.0f); })
                    o[0] = SWG(v0[0], v0[1]); o[1] = SWG(v0[2], v0[3]); o[2] = SWG(v1[0], v1[1]); o[3] = SWG(v1[2], v1[3]);
#undef SWG
                    *(unsigned*)(rowp + bj * (HALF / 2)) = pk4_fp8(o[0], o[1], o[2], o[3]); } }
    }
};
struct EpiDown {
    static constexpr bool PERM = true;
    bf16_t* O; const float* bias; const float* rowgate;
    DI void operator()(const Acc& acc, const Unit& u, const Ctx& c) const {
        int row0 = u.pm * BM + c.wr * 64 + c.fr, col0 = u.pn * BM + c.wc * 32 + 8 * c.fq; asm volatile("" : "+v"(row0), "+v"(col0));
        f32x4 bv[2][2];
#pragma unroll
        for (int bj = 0; bj < 2; ++bj)
#pragma unroll
            for (int n = 0; n < 2; ++n) bv[bj][n] = *(const f32x4*)(bias + (size_t)u.aux * 1024 + col0 + bj * HALF + 4 * n);
#pragma unroll
        for (int ai = 0; ai < 2; ++ai) { float gts[4];
#pragma unroll
            for (int m = 0; m < 4; ++m) gts[m] = rowgate[row0 + ai * HALF + m * 16];
#pragma unroll
            for (int m = 0; m < 4; ++m) { const int row = row0 + ai * HALF + m * 16; const float gt = gts[m]; bf16_t* rowp = O + (size_t)row * 1024 + col0;
#pragma unroll
                for (int bj = 0; bj < 2; ++bj) { const f32x4 v0 = (acc[ai][bj][m][0] * (1.0f / (F8_AS * F8_WS)) + bv[bj][0]) * gt, v1 = (acc[ai][bj][m][1] * (1.0f / (F8_AS * F8_WS)) + bv[bj][1]) * gt;
                    u32x4 w; w.x = cvt_pk_bf16(v0[0], v0[1]); w.y = cvt_pk_bf16(v0[2], v0[3]); w.z = cvt_pk_bf16(v1[0], v1[1]); w.w = cvt_pk_bf16(v1[2], v1[3]);
                    *(u32x4*)(rowp + bj * HALF) = w; } } }
    }
};
}
constexpr size_t MiB = 1u << 20;
constexpr size_t WS_CTL = 0, CTL_ZERO_BYTES = 1 * MiB;
constexpr size_t WS_W_IN = 2 * MiB, WS_W_UQ = 10 * MiB, WS_W_UK = WS_W_UQ + 512 * 1024, WS_W_UV = WS_W_UK + 256 * 1024, WS_W_MQK = 11 * MiB, WS_W_BRM = 12 * MiB, WS_W_BRA = 13 * MiB,
                 WS_W_MIX = 14 * MiB, WS_W_CQ = 16 * MiB, WS_W_CK = 18 * MiB, WS_W_CV = 20 * MiB, WS_W_CO = 22 * MiB, WS_W_R = 24 * MiB, WS_W_GU = 26 * MiB, WS_W_DN = 90 * MiB;
constexpr size_t WS_GATES = 218 * MiB, WS_CS = 219 * MiB, WS_KPE = 223 * MiB, WS_MEMB = 225 * MiB, WS_KC = 233 * MiB, WS_VCT = 241 * MiB, WS_LOGITS = 249 * MiB,
                 WS_ASSIGN = 253 * MiB, WS_GATEW = WS_ASSIGN + 512 * 1024, WS_TOKPOS = 254 * MiB, WS_ROWGATE = WS_TOKPOS + 512 * 1024;
constexpr size_t WS_XB = 256 * MiB, WS_PROJ = 320 * MiB, WS_QN = 576 * MiB, WS_KVN = 592 * MiB, WS_XC = 608 * MiB, WS_QMLA = 640 * MiB, WS_KN = 688 * MiB, WS_VT = 720 * MiB,
                 WS_QKM = 752 * MiB, WS_KTM = 816 * MiB, WS_AO = 848 * MiB, WS_HRAW = 880 * MiB, WS_HM = 944 * MiB;
constexpr size_t WS_GATED = 576 * MiB, WS_V1B = 704 * MiB, WS_QC = 384 * MiB, WS_PC = 448 * MiB, WS_OC = 320 * MiB, WS_V2B = 864 * MiB;
constexpr size_t WS_XG = 320 * MiB, WS_ACT = 456 * MiB, WS_YB = 592 * MiB, WS_END = 976 * MiB;
static_assert((size_t)NROWS * 1024 * 2 <= 272 * MiB, "routed buffers");
static_assert(WS_ROWGATE + (size_t)NROWS * 4 <= 256 * MiB, "small buffers");
constexpr int CW_TMO = 0, CW_CNT = 64  , CW_BAR = 4096;
constexpr size_t CTL_CS1 = 64 * 1024, CTL_CB1 = 68 * 1024, CTL_CSR = 72 * 1024, CTL_CBR = 73 * 1024;
constexpr size_t CTL_STATS1 = 256 * 1024, CTL_STATS2 = 512 * 1024;

constexpr int RING_OFF = 0, RING_BYTES = 131072;
constexpr int RED_OFF = RING_BYTES;
constexpr int TST_OFF = RED_OFF + 8192;
constexpr int HIST_OFF = TST_OFF + 256, HBASE_OFF = HIST_OFF + 128;
constexpr int MISC_OFF = HBASE_OFF + 128;
constexpr int TILE_E_OFF = MISC_OFF + 128;
constexpr int LDSCTL_OFF = TST_OFF;
constexpr int LDS_BYTES = 147456;
static_assert(TILE_E_OFF + NTILES_MAX * 4 <= LDS_BYTES, "LDS map");
constexpr int NWAVES = 8;

#define LDS_WAIT() asm volatile("s_waitcnt lgkmcnt(0)" ::: "memory")
#define VM_WAIT() asm volatile("s_waitcnt vmcnt(0)" ::: "memory")

#define XB_TMO      128
#define XB_XCNT(j)  (256  + 64 * (j))
#define XB_XSUB(j)  (1280 + 64 * (j))
#define XB_XGEN(j)  (2304 + 64 * (j))
#define XB_TOP      3328
#define XB_TOPGEN   3392
#define XCD_BAR_WORDS 3456
#define XB_SPIN_CAP (1u << 18)
__device__ __forceinline__ unsigned xb_ld(unsigned* p)              { return __hip_atomic_load(p, __ATOMIC_RELAXED, __HIP_MEMORY_SCOPE_AGENT); }
__device__ __forceinline__ unsigned xb_add(unsigned* p, unsigned v) { return __hip_atomic_fetch_add(p, v, __ATOMIC_RELAXED, __HIP_MEMORY_SCOPE_AGENT); }
__device__ __forceinline__ unsigned xb_xcc_id() { return (unsigned)__builtin_amdgcn_s_getreg((3 << 11) | 20) & 0xFu; }
#define XB_SPIN(cond, bar) do { unsigned _sp = 0; while (cond) { __builtin_amdgcn_s_sleep(1); \
    if ((++_sp & 255u) == 0u) { if (xb_ld(&(bar)[XB_TMO])) break; if (_sp > XB_SPIN_CAP) { atomicAdd(&(bar)[XB_TMO], 1u); break; } } } } while (0)
struct XcdBarrier { unsigned* bar; unsigned x; volatile LAS unsigned* st; };
__device__ __forceinline__ XcdBarrier xcd_barrier_post(unsigned* bar, volatile LAS unsigned* st) {
    XcdBarrier b; b.bar = bar; b.x = xb_xcc_id(); b.st = st;
    if (threadIdx.x == 0) (void)xb_add(&bar[XB_XCNT(b.x)], 1u);
    return b;
}
__device__ __forceinline__ void xcd_barrier_complete(unsigned* bar, unsigned x, unsigned& nloc, unsigned& nx) {
    const unsigned G = gridDim.x * gridDim.y * gridDim.z;
    unsigned sum, cnt, mine, sp = 0u;
    for (;;) {
        sum = 0u; cnt = 0u; mine = 0u;
#pragma unroll
        for (unsigned j = 0; j < 16; ++j) { const unsigned c = xb_ld(&bar[XB_XCNT(j)]); sum += c; cnt += (c > 0u) ? 1u : 0u; mine = (j == x) ? c : mine; }
        if (sum == G) break;
        __builtin_amdgcn_s_sleep(1);
        if ((++sp & 255u) == 0u) { if (xb_ld(&bar[XB_TMO])) break; if (sp > XB_SPIN_CAP) { atomicAdd(&bar[XB_TMO], 1u); break; } }
    }
    nloc = mine > 0u ? mine : 1u; nx = cnt > 0u ? cnt : 1u;
}
__device__ __forceinline__ void xcd_barrier(const XcdBarrier& b) {
    asm volatile("s_waitcnt vmcnt(0)" ::: "memory");
    __syncthreads();
    if (threadIdx.x == 0) {
        unsigned* bar = b.bar;
        __builtin_amdgcn_s_waitcnt(0);
        unsigned nloc = b.st[0], nx = b.st[1];
        if (nloc == 0u) { xcd_barrier_complete(bar, b.x, nloc, nx); b.st[0] = nloc; b.st[1] = nx; }
        const unsigned old = xb_add(&bar[XB_XSUB(b.x)], 1u);
        const unsigned gen = old / nloc;
        if (old + 1u == (gen + 1u) * nloc) {
            __builtin_amdgcn_fence(__ATOMIC_RELEASE, "agent");
            asm volatile("s_waitcnt vmcnt(0)" ::: "memory");
            const unsigned og = xb_add(&bar[XB_TOP], 1u);
            const unsigned tg = og / nx;
            if (og + 1u == (tg + 1u) * nx) xb_add(&bar[XB_TOPGEN], 1u);
            else XB_SPIN(xb_ld(&bar[XB_TOPGEN]) == tg, bar);
            __builtin_amdgcn_fence(__ATOMIC_ACQUIRE, "agent");
            xb_add(&bar[XB_XGEN(b.x)], 1u);
            asm volatile("s_waitcnt vmcnt(0)" ::: "memory");
        } else {
            XB_SPIN(xb_ld(&bar[XB_XGEN(b.x)]) == gen, bar);
            __builtin_amdgcn_fence(__ATOMIC_ACQUIRE, "agent");
            asm volatile("s_waitcnt vmcnt(0)" ::: "memory");
        }
    }
    __syncthreads();
}

struct Args { const void* in[34]; float* out; unsigned char* ws; int ph_lo, ph_hi; };

DI void tr_item(const float* W, int ldw, int kvalid, bf16_t* WT, int ldk, int n0, int k0, int sc, LAS float* scr, int lane, const float* rs = nullptr) {
#pragma unroll 8
    for (int i = 0; i < 32; ++i) { const int kk = 2 * i + (lane >> 5); const int k = k0 + kk;
        float v = 0.f; if (sc >= 0 && k < kvalid) { v = W[(size_t)k * ldw + sc]; if (rs) v *= rs[k]; }
        scr[kk * 33 + (lane & 31)] = v; }
    LDS_WAIT(); asm volatile("" ::: "memory");
    const int c = lane & 7;
#pragma unroll
    for (int j = 0; j < 4; ++j) { const int n = (lane >> 3) + 8 * j; const LAS float* s = scr + (8 * c) * 33 + n;
        u32x4 o; o.x = pk2(s[0 * 33], s[1 * 33]); o.y = pk2(s[2 * 33], s[3 * 33]); o.z = pk2(s[4 * 33], s[5 * 33]); o.w = pk2(s[6 * 33], s[7 * 33]);
        *(GAS u32x4*)(WT + (size_t)(n0 + n) * ldk + k0 + 8 * c) = o; }
    LDS_WAIT(); asm volatile("" ::: "memory");
}

DI void tr_item_v4(const float* W, int ldw, bf16_t* WT, int ldk, int n0, int k0, int c0, LAS float* scr, int lane, const float* rs = nullptr) {
    const int kr = lane >> 3, n4 = lane & 7;
    f32x4 v[8];
#pragma unroll
    for (int i = 0; i < 8; ++i) v[i] = *(const f32x4*)(W + (size_t)(k0 + i * 8 + kr) * ldw + c0 + 4 * n4);
    if (rs) {
#pragma unroll
        for (int i = 0; i < 8; ++i) v[i] = v[i] * rs[k0 + i * 8 + kr]; }
#pragma unroll
    for (int i = 0; i < 8; ++i) { LAS float* p = scr + (i * 8 + kr) * 33 + 4 * n4; p[0] = v[i][0]; p[1] = v[i][1]; p[2] = v[i][2]; p[3] = v[i][3]; }
    LDS_WAIT(); asm volatile("" ::: "memory");
    const int c = lane & 7;
#pragma unroll
    for (int j = 0; j < 4; ++j) { const int n = (lane >> 3) + 8 * j; const LAS float* s = scr + (8 * c) * 33 + n;
        u32x4 o; o.x = pk2(s[0 * 33], s[1 * 33]); o.y = pk2(s[2 * 33], s[3 * 33]); o.z = pk2(s[4 * 33], s[5 * 33]); o.w = pk2(s[6 * 33], s[7 * 33]);
        *(GAS u32x4*)(WT + (size_t)(n0 + n) * ldk + k0 + 8 * c) = o; }
    LDS_WAIT(); asm volatile("" ::: "memory");
}

DI void tr_item_v4_fp8(const float* W, int ldw, unsigned char* WT, int ldk, int n0, int k0, int c0, float sc, LAS float* scr, int lane) {
    const int kr = lane >> 3, n4 = lane & 7;
    f32x4 v[8];
#pragma unroll
    for (int i = 0; i < 8; ++i) v[i] = *(const f32x4*)(W + (size_t)(k0 + i * 8 + kr) * ldw + c0 + 4 * n4);
#pragma unroll
    for (int i = 0; i < 8; ++i) { LAS float* p = scr + (i * 8 + kr) * 33 + 4 * n4; p[0] = v[i][0] * sc; p[1] = v[i][1] * sc; p[2] = v[i][2] * sc; p[3] = v[i][3] * sc; }
    LDS_WAIT(); asm volatile("" ::: "memory");
    const int c = lane & 7;
#pragma unroll
    for (int j = 0; j < 4; ++j) { const int n = (lane >> 3) + 8 * j; const LAS float* s = scr + (8 * c) * 33 + n;
        u32x2 o; o.x = pg8::pk4_fp8(s[0 * 33], s[1 * 33], s[2 * 33], s[3 * 33]); o.y = pg8::pk4_fp8(s[4 * 33], s[5 * 33], s[6 * 33], s[7 * 33]);
        *(GAS u32x2*)(WT + (size_t)(n0 + n) * ldk + k0 + 8 * c) = o; }
    LDS_WAIT(); asm volatile("" ::: "memory");
}
DI int win_src(int n) {
    if (n < 384) return n;
    if (n < 416) { const int i = (n - 384) >> 1; return 384 + i + 16 * ((n - 384) & 1); }
    if (n < 424) return 1952 + (n - 416);
    if (n < 512) return -1;
    if (n < 2048) return 416 + (n - 512);
    return 1960 + (n - 2048);
}
DI void p0_prologue(const Args& args, LAS unsigned char* lds, int vcu, int G) {
    int tid_ = threadIdx.x; asm volatile("" : "+v"(tid_)); const int lane = tid_ & 63; const int wave = __builtin_amdgcn_readfirstlane(tid_ >> 6);
    LAS float* scr = (LAS float*)(lds + RING_OFF + wave * 16384);
    const int gw = vcu * NWAVES + wave, NGW = G * NWAVES;
    unsigned char* ws = args.ws;
    const int j = lane & 31;
    constexpr int I_IN = 16 * 128, I_UQ = 4 * 24, I_UK = 4 * 16, I_UV = 4 * 16, I_MQK = 8 * 32, I_BRM = 8 * 32, I_BRA = 8 * 32, I_SQ = 16 * 32, I_R = 16 * 8,
                  I_GU = NE * 16 * 64, I_DN = NE * 16 * 32;
    constexpr int NITEMS = I_IN + I_UQ + I_UK + I_UV + I_MQK + I_BRM + I_BRA + 5 * I_SQ + I_R + I_GU + I_DN;
    for (int it = gw; it < 33 * 8; it += NGW) { const int grp = it >> 3, kc = it & 7; const bool rt = (grp == 32);
        const float* W = (const float*)args.in[rt ? 26 : 21]; const int ldw = rt ? NE : 1024; const int col = (rt ? 0 : grp * 32) + (lane & 31);
        const float* gv = (const float*)args.in[rt ? 24 : 19]; const float* bv = (const float*)args.in[rt ? 25 : 20];
        float as = 0.f, ab = 0.f;
#pragma unroll 8
        for (int i = 0; i < 64; ++i) { const int k = kc * 128 + 2 * i + (lane >> 5); const float w = W[(size_t)k * ldw + col]; as += bf2f((unsigned short)f2bf(gv[k] * w)); ab += bv[k] * w; }
        as += __shfl_xor(as, 32); ab += __shfl_xor(ab, 32);
        if (lane < 32) { float* csd = (float*)(ws + (rt ? CTL_CSR : CTL_CS1)) + col; float* cbd = (float*)(ws + (rt ? CTL_CBR : CTL_CB1)) + col;
            __hip_atomic_fetch_add(csd, as, RLX_AGENT); __hip_atomic_fetch_add(cbd, ab, RLX_AGENT); } }
    for (int it = gw; it < NITEMS; it += NGW) {
        int r = it;
        if (r < I_GU) { const int e = r / (16 * 64), q = r % (16 * 64), kb = q / 64, nb = q % 64;
            tr_item_v4_fp8((const float*)args.in[28] + (size_t)e * 1024 * 2048, 2048, ws + WS_W_GU + (size_t)e * 2048 * 1024, 1024, nb * 32, kb * 64, nb * 32, pg8::F8_WS, scr, lane); continue; } r -= I_GU;
        if (r < I_DN) { const int e = r / (16 * 32), q = r % (16 * 32), kb = q / 32, nb = q % 32;
            tr_item_v4_fp8((const float*)args.in[30] + (size_t)e * 1024 * 1024, 1024, ws + WS_W_DN + (size_t)e * 1024 * 1024, 1024, nb * 32, kb * 64, nb * 32, pg8::F8_WS, scr, lane); continue; } r -= I_DN;
        if (r < I_IN) { const int kb = r / 128, nb = r % 128;
            tr_item((const float*)args.in[3], DIN, 1024, (bf16_t*)(ws + WS_W_IN), 1024, nb * 32, kb * 64, win_src(nb * 32 + j), scr, lane); continue; } r -= I_IN;
        if (r < I_UQ) { const int kb = r / 24, nb = r % 24; const int n = nb * 32 + j, hh = n / AQK, cc = n % AQK;
            const int sc = (cc < ANOPE) ? n : hh * AQK + ANOPE + ((cc - ANOPE) >> 1) + 16 * ((cc - ANOPE) & 1);
            tr_item((const float*)args.in[14], AH * AQK, 256, (bf16_t*)(ws + WS_W_UQ), 256, nb * 32, kb * 64, sc, scr, lane); continue; } r -= I_UQ;
        if (r < I_UK) { const int kb = r / 16, nb = r % 16; const int n = nb * 32 + j;
            tr_item((const float*)args.in[15], 1024, 128, (bf16_t*)(ws + WS_W_UK), 256, nb * 32, kb * 64, (n >> 6) * 128 + (n & 63), scr, lane); continue; } r -= I_UK;
        if (r < I_UV) { const int kb = r / 16, nb = r % 16; const int n = nb * 32 + j;
            tr_item((const float*)args.in[15], 1024, 128, (bf16_t*)(ws + WS_W_UV), 256, nb * 32, kb * 64, (n >> 6) * 128 + 64 + (n & 63), scr, lane); continue; } r -= I_UV;
        if (r < I_MQK) { const int kb = r / 32, nb = r % 32; const int n = nb * 32 + j, part = n >> 9, hh = (n >> 7) & 3, e = n & 127;
            const float* src = (const float*)args.in[part ? 9 : 8];
            tr_item(src, 128, 512, (bf16_t*)(ws + WS_W_MQK), 512, nb * 32, kb * 64, ((kb >> 1) == hh) ? e : -1, scr, lane); continue; } r -= I_MQK;
        if (r < I_BRM) { const int kb = r / 32, nb = r % 32;
            tr_item_v4((const float*)args.in[16], 1024, (bf16_t*)(ws + WS_W_BRM), 512, nb * 32, kb * 64, nb * 32, scr, lane); continue; } r -= I_BRM;
        if (r < I_BRA) { const int kb = r / 32, nb = r % 32;
            tr_item_v4((const float*)args.in[17], 1024, (bf16_t*)(ws + WS_W_BRA), 512, nb * 32, kb * 64, nb * 32, scr, lane); continue; } r -= I_BRA;
        if (r < 5 * I_SQ) { const int w = r / I_SQ, q = r % I_SQ, kb = q / 32, nb = q % 32;
            const float* src; int ldw, coff; bf16_t* dst; const float* rs = nullptr;
            if (w == 0) { src = (const float*)args.in[18]; ldw = 1024; coff = 0; dst = (bf16_t*)(ws + WS_W_MIX); }
            else if (w == 1) { src = (const float*)args.in[21]; ldw = 1024; coff = 0; dst = (bf16_t*)(ws + WS_W_CQ); rs = (const float*)args.in[19]; }
            else if (w == 2) { src = (const float*)args.in[22]; ldw = 2048; coff = 0; dst = (bf16_t*)(ws + WS_W_CK); }
            else if (w == 3) { src = (const float*)args.in[22]; ldw = 2048; coff = 1024; dst = (bf16_t*)(ws + WS_W_CV); }
            else { src = (const float*)args.in[23]; ldw = 1024; coff = 0; dst = (bf16_t*)(ws + WS_W_CO); }
            tr_item_v4(src, ldw, dst, 1024, nb * 32, kb * 64, coff + nb * 32, scr, lane, rs); continue; } r -= 5 * I_SQ;
        { const int kb = r / 8, nb = r % 8; const int n = nb * 32 + j;
            tr_item((const float*)args.in[26], NE, 1024, (bf16_t*)(ws + WS_W_R), 1024, nb * 32, kb * 64, (n < NE) ? n : -1, scr, lane, (const float*)args.in[24]); }
    }
    const size_t gt = (size_t)gw * 64 + lane, NT_ = (size_t)NGW * 64;
    { const float* x = (const float*)args.in[0]; bf16_t* xb = (bf16_t*)(ws + WS_XB);
      for (size_t i = gt; i < (size_t)T * D / 8; i += NT_) { const f32x4 a = *(const f32x4*)(x + i * 8), b = *(const f32x4*)(x + i * 8 + 4);
          u32x4 o; o.x = pk2(a[0], a[1]); o.y = pk2(a[2], a[3]); o.z = pk2(b[0], b[1]); o.w = pk2(b[2], b[3]); *(u32x4*)(xb + i * 8) = o; } }
    { const float* x = (const float*)args.in[1]; bf16_t* xb = (bf16_t*)(ws + WS_MEMB);
      for (size_t i = gt; i < (size_t)NB * NMEM * D / 8; i += NT_) { const f32x4 a = *(const f32x4*)(x + i * 8), b = *(const f32x4*)(x + i * 8 + 4);
          u32x4 o; o.x = pk2(a[0], a[1]); o.y = pk2(a[2], a[3]); o.z = pk2(b[0], b[1]); o.w = pk2(b[2], b[3]); *(u32x4*)(xb + i * 8) = o; } }
}

DI void p2_tokens(const Args& args, int vcu, int G) {
    int tid_ = threadIdx.x; asm volatile("" : "+v"(tid_)); const int lane = tid_ & 63; const int wave = __builtin_amdgcn_readfirstlane(tid_ >> 6);
    unsigned char* ws = args.ws;
    const bf16_t* proj = (const bf16_t*)(ws + WS_PROJ);
    bf16_t* qn = (bf16_t*)(ws + WS_QN); bf16_t* kvn = (bf16_t*)(ws + WS_KVN); bf16_t* kpe = (bf16_t*)(ws + WS_KPE); bf16_t* xc = (bf16_t*)(ws + WS_XC); float* cs = (float*)(ws + WS_CS);
    const int* positions = (const int*)args.in[2];
    const float* conv_w = (const float*)args.in[6]; const float* conv_b = (const float*)args.in[7];
    const float* g_qlat = (const float*)args.in[12]; const float* g_kvlat = (const float*)args.in[13];
    const int gw = vcu * NWAVES + wave, NGW = G * NWAVES;
    float cw[4][8], cb[8];
#pragma unroll
    for (int jj = 0; jj < 4; ++jj)
#pragma unroll
        for (int c = 0; c < 8; ++c) cw[jj][c] = conv_w[jj * MW + 8 * lane + c];
#pragma unroll
    for (int c = 0; c < 8; ++c) cb[c] = conv_b[8 * lane + c];
    const f32x4 gq = *(const f32x4*)(g_qlat + 4 * lane);
    const f32x2 gk = *(const f32x2*)(g_kvlat + 2 * lane);
    const float inv_freq = exp2f(-(float)(lane & 15) * (13.287712379549449f / 16.0f));
    for (int t = gw; t < T; t += NGW) {
        const bf16_t* pr = proj + (size_t)t * NPROJ;
        { const u32x2 w = *(const u32x2*)(pr + PC_QLAT + 4 * lane); const float a0 = bflo(w.x), a1 = bfhi(w.x), a2 = bflo(w.y), a3 = bfhi(w.y);
          const float ss = wave_sum(a0 * a0 + a1 * a1 + a2 * a2 + a3 * a3); const float r = 1.0f / sqrtf(ss * (1.0f / AQR) + EPS);
          u32x2 o; o.x = pk2(a0 * r * gq[0], a1 * r * gq[1]); o.y = pk2(a2 * r * gq[2], a3 * r * gq[3]); *(u32x2*)(qn + (size_t)t * 256 + 4 * lane) = o; }
        { const unsigned w = *(const unsigned*)(pr + PC_KVLAT + 2 * lane); const float a0 = bflo(w), a1 = bfhi(w);
          const float ss = wave_sum(a0 * a0 + a1 * a1); const float r = 1.0f / sqrtf(ss * (1.0f / AKVR) + EPS);
          *(unsigned*)(kvn + (size_t)t * 256 + 2 * lane) = pk2(a0 * r * gk[0], a1 * r * gk[1]); *(unsigned*)(kvn + (size_t)t * 256 + 128 + 2 * lane) = 0u; }
        if (lane < 16) { const unsigned w = *(const unsigned*)(pr + PC_KROPE + 2 * lane); const float x1 = bflo(w), x2 = bfhi(w);
          const float ang = (float)positions[t] * inv_freq;
          const double rev = (double)ang * 0.15915494309189535; const float fr = (float)(rev - __builtin_rint(rev));
          const float cc = __builtin_amdgcn_cosf(fr), sn = __builtin_amdgcn_sinf(fr);
          *(unsigned*)(kpe + (size_t)t * 32 + 2 * lane) = pk2(x1 * cc - x2 * sn, x2 * cc + x1 * sn);
          *(f32x2*)(cs + (size_t)t * 32 + 2 * lane) = (f32x2){cc, sn}; }
        { const int s = t & (SEQ - 1); float a[8];
#pragma unroll
          for (int c = 0; c < 8; ++c) a[c] = cb[c];
#pragma unroll
          for (int jj = 0; jj < 4; ++jj) { const int back = 3 - jj; if (s - back >= 0) { const u32x4 w = *(const u32x4*)(pr - (size_t)back * NPROJ + PC_XM + 8 * lane);
              a[0] += cw[jj][0] * bflo(w.x); a[1] += cw[jj][1] * bfhi(w.x); a[2] += cw[jj][2] * bflo(w.y); a[3] += cw[jj][3] * bfhi(w.y);
              a[4] += cw[jj][4] * bflo(w.z); a[5] += cw[jj][5] * bfhi(w.z); a[6] += cw[jj][6] * bflo(w.w); a[7] += cw[jj][7] * bfhi(w.w); } }
#pragma unroll
          for (int c = 0; c < 8; ++c) a[c] = a[c] * sigmoidf_(a[c]);
          u32x4 o; o.x = pk2(a[0], a[1]); o.y = pk2(a[2], a[3]); o.z = pk2(a[4], a[5]); o.w = pk2(a[6], a[7]); *(u32x4*)(xc + (size_t)t * MW + 8 * lane) = o; }
    }
}

DI void p6_mpost(const Args& args, int vcu, int G) {
    int tid_ = threadIdx.x; asm volatile("" : "+v"(tid_)); const int lane = tid_ & 63; const int wave = __builtin_amdgcn_readfirstlane(tid_ >> 6);
    unsigned char* ws = args.ws;
    const float* hraw = (const float*)(ws + WS_HRAW); const bf16_t* xc = (const bf16_t*)(ws + WS_XC); const bf16_t* proj = (const bf16_t*)(ws + WS_PROJ); bf16_t* hm = (bf16_t*)(ws + WS_HM);
    const float* g_mhead = (const float*)args.in[10]; const float* w_mskip = (const float*)args.in[11];
    const int gw = vcu * NWAVES + wave, NGW = G * NWAVES;
    float gm[8], wsk[8];
#pragma unroll
    for (int c = 0; c < 8; ++c) { gm[c] = g_mhead[8 * lane + c]; wsk[c] = w_mskip[8 * lane + c]; }
    for (int t = gw; t < T; t += NGW) {
        const f32x4 h0 = *(const f32x4*)(hraw + (size_t)t * MW + 8 * lane), h1 = *(const f32x4*)(hraw + (size_t)t * MW + 8 * lane + 4);
        float h[8] = {h0[0], h0[1], h0[2], h0[3], h1[0], h1[1], h1[2], h1[3]};
        float s = 0.f;
#pragma unroll
        for (int c = 0; c < 8; ++c) s += h[c];
        s += __shfl_xor(s, 1); s += __shfl_xor(s, 2); s += __shfl_xor(s, 4); s += __shfl_xor(s, 8);
        const float mu = s * (1.0f / MHD); float q = 0.f;
#pragma unroll
        for (int c = 0; c < 8; ++c) { h[c] -= mu; q += h[c] * h[c]; }
        q += __shfl_xor(q, 1); q += __shfl_xor(q, 2); q += __shfl_xor(q, 4); q += __shfl_xor(q, 8);
        const float rstd = 1.0f / sqrtf(q * (1.0f / MHD) + EPS);
        const u32x4 xw = *(const u32x4*)(xc + (size_t)t * MW + 8 * lane); const u32x4 ow = *(const u32x4*)(proj + (size_t)t * NPROJ + PC_OP + 8 * lane);
        const float xv[8] = {bflo(xw.x), bfhi(xw.x), bflo(xw.y), bfhi(xw.y), bflo(xw.z), bfhi(xw.z), bflo(xw.w), bfhi(xw.w)};
        const float ov[8] = {bflo(ow.x), bfhi(ow.x), bflo(ow.y), bfhi(ow.y), bflo(ow.z), bfhi(ow.z), bflo(ow.w), bfhi(ow.w)};
        float o[8];
#pragma unroll
        for (int c = 0; c < 8; ++c) o[c] = sigmoidf_(ov[c]) * (h[c] * rstd * gm[c] + wsk[c] * xv[c]);
        u32x4 w; w.x = pk2(o[0], o[1]); w.y = pk2(o[2], o[3]); w.z = pk2(o[4], o[5]); w.w = pk2(o[6], o[7]); *(u32x4*)(hm + (size_t)t * MW + 8 * lane) = w;
    }
}

DI void ln_pass(const float* res, const float* add, const float* g, const float* b, float* out, bf16_t* outb, int vcu, int G) {
    int tid_ = threadIdx.x; asm volatile("" : "+v"(tid_)); const int lane = tid_ & 63; const int wave = __builtin_amdgcn_readfirstlane(tid_ >> 6);
    const int gw = vcu * NWAVES + wave, NGW = G * NWAVES;
    for (int t = gw; t < T; t += NGW) {
        f32x4 v[4]; float s = 0.f;
#pragma unroll
        for (int j = 0; j < 4; ++j) { const f32x4 r = *(const f32x4*)(res + (size_t)t * D + 4 * lane + 256 * j), a = *(const f32x4*)(add + (size_t)t * D + 4 * lane + 256 * j);
            v[j] = r * DN_ALPHA + a; s += (v[j][0] + v[j][1]) + (v[j][2] + v[j][3]); }
        const float mean = wave_sum(s) * (1.0f / D); float q = 0.f;
#pragma unroll
        for (int j = 0; j < 4; ++j) { v[j] = v[j] - mean; q += (v[j][0] * v[j][0] + v[j][1] * v[j][1]) + (v[j][2] * v[j][2] + v[j][3] * v[j][3]); }
        const float rstd = 1.0f / sqrtf(wave_sum(q) * (1.0f / D) + EPS);
#pragma unroll
        for (int j = 0; j < 4; ++j) { const f32x4 gg = *(const f32x4*)(g + 4 * lane + 256 * j), bb = *(const f32x4*)(b + 4 * lane + 256 * j);
            const f32x4 y = v[j] * rstd * gg + bb;
            *(f32x4*)(out + (size_t)t * D + 4 * lane + 256 * j) = y;
            if (outb) { u32x2 w; w.x = pk2(y[0], y[1]); w.y = pk2(y[2], y[3]); *(u32x2*)(outb + (size_t)t * D + 4 * lane + 256 * j) = w; } }
    }
}

DI void p16_topk(const Args& args, LAS unsigned char* lds, int vcu, int G) {
    unsigned char* ws = args.ws;
    const float* logits = (const float*)(ws + WS_LOGITS); const float* b_router = (const float*)args.in[27];
    int* assign = (int*)(ws + WS_ASSIGN); float* gatew = (float*)(ws + WS_GATEW);
    unsigned* gcnt = (unsigned*)(ws + WS_CTL) + CW_CNT;
    LAS unsigned* hist = (LAS unsigned*)(lds + HIST_OFF); LAS unsigned* hbase = (LAS unsigned*)(lds + HBASE_OFF);
    int tid = threadIdx.x; asm volatile("" : "+v"(tid));
    for (int blk = vcu; blk < T / 512; blk += G) {
        const int t = blk * 512 + tid;
        float v[NE];
#pragma unroll
        for (int j = 0; j < NE / 4; ++j) { const f32x4 a = *(const f32x4*)(logits + (size_t)t * NE + 4 * j), bb = *(const f32x4*)(b_router + 4 * j);
            v[4 * j] = a[0] + bb[0]; v[4 * j + 1] = a[1] + bb[1]; v[4 * j + 2] = a[2] + bb[2]; v[4 * j + 3] = a[3] + bb[3]; }
        int idx[TOPK]; float val[TOPK];
#pragma unroll
        for (int k = 0; k < TOPK; ++k) { float best = -INFINITY; int bi = 0;
#pragma unroll
            for (int e = 0; e < NE; ++e) { bool taken = false;
#pragma unroll
                for (int kk = 0; kk < k; ++kk) taken = taken || (idx[kk] == e);
                if (!taken && v[e] > best) { best = v[e]; bi = e; } }
            idx[k] = bi; val[k] = best; }
        float ex[TOPK], sum = 0.f;
#pragma unroll
        for (int k = 0; k < TOPK; ++k) { ex[k] = __expf(val[k] - val[0]); sum += ex[k]; }
        const float inv = 1.0f / sum;
        if (tid < NE) hist[tid] = 0u;
        __syncthreads();
        unsigned lr[TOPK];
#pragma unroll
        for (int k = 0; k < TOPK; ++k) lr[k] = __hip_atomic_fetch_add(hist + idx[k], 1u, __ATOMIC_RELAXED, __HIP_MEMORY_SCOPE_WORKGROUP);
        __syncthreads();
        if (tid < NE) hbase[tid] = __hip_atomic_fetch_add(gcnt + tid, hist[tid], RLX_AGENT);
        __syncthreads();
#pragma unroll
        for (int k = 0; k < TOPK; ++k) { assign[(size_t)t * TOPK + k] = (idx[k] << 20) | (int)(hbase[idx[k]] + lr[k]); gatew[(size_t)t * TOPK + k] = ex[k] * inv; }
        __syncthreads();
    }
}
DI void build_tstart(const Args& args, LAS unsigned char* lds) {
    const unsigned* gcnt = (const unsigned*)(args.ws + WS_CTL) + CW_CNT; LAS int* tst = (LAS int*)(lds + TST_OFF); LAS int* tile_e = (LAS int*)(lds + TILE_E_OFF);
    if (threadIdx.x == 0) { int acc = 0;
        for (int e = 0; e < NE; ++e) { tst[e] = acc; const unsigned c = __hip_atomic_load(gcnt + e, RLX_AGENT); acc += (int)((c + 255u) >> 8); }
        tst[NE] = acc; }
    __syncthreads();
    for (int t = threadIdx.x; t < tst[NE]; t += NWAVES * 64) { int e = 0;
        for (int j = 1; j < NE; ++j) e += (tst[j] <= t) ? 1 : 0;
        tile_e[t] = e; }
    __syncthreads();
}
DI void p17_gather(const Args& args, LAS unsigned char* lds, int vcu, int G) {
    int tid_ = threadIdx.x; asm volatile("" : "+v"(tid_)); const int lane = tid_ & 63; const int wave = __builtin_amdgcn_readfirstlane(tid_ >> 6);
    unsigned char* ws = args.ws;
    build_tstart(args, lds);
    const LAS int* tst = (const LAS int*)(lds + TST_OFF);
    const unsigned* gcnt = (const unsigned*)(ws + WS_CTL) + CW_CNT;
    const int* assign = (const int*)(ws + WS_ASSIGN); const float* gatew = (const float*)(ws + WS_GATEW);
    int* tokpos = (int*)(ws + WS_TOKPOS); float* rowgate = (float*)(ws + WS_ROWGATE);
    const bf16_t* v2 = (const bf16_t*)(ws + WS_V2B); const float* stats2 = (const float*)(ws + CTL_STATS2); unsigned char* xg = ws + WS_XG;
    const int gw = vcu * NWAVES + wave, NGW = G * NWAVES;
    f32x4 g2[4], b2[4];
#pragma unroll
    for (int j = 0; j < 4; ++j) { g2[j] = *(const f32x4*)((const float*)args.in[24] + 16 * lane + 4 * j) * pg8::F8_XS; b2[j] = *(const f32x4*)((const float*)args.in[25] + 16 * lane + 4 * j) * pg8::F8_XS; }
    for (int t = gw; t < T; t += NGW) {
        float mean, rstd; pg8::row_stats(stats2, t, mean, rstd);
        u32x4 o; const u32x4 wa = *(const u32x4*)(v2 + (size_t)t * D + 16 * lane), wb = *(const u32x4*)(v2 + (size_t)t * D + 16 * lane + 8);
        const f32x4 xin[4] = {{bflo(wa.x), bfhi(wa.x), bflo(wa.y), bfhi(wa.y)}, {bflo(wa.z), bfhi(wa.z), bflo(wa.w), bfhi(wa.w)}, {bflo(wb.x), bfhi(wb.x), bflo(wb.y), bfhi(wb.y)}, {bflo(wb.z), bfhi(wb.z), bflo(wb.w), bfhi(wb.w)}};
#pragma unroll
        for (int j = 0; j < 4; ++j) { const f32x4 x = (xin[j] - mean) * rstd * g2[j] + b2[j]; o[j] = pg8::pk4_fp8(x[0], x[1], x[2], x[3]); }
#pragma unroll
        for (int k = 0; k < TOPK; ++k) { const int as = assign[(size_t)t * TOPK + k]; const int e = as >> 20, rank = as & 0xfffff; const int pos = tst[e] * 256 + rank;
            *(u32x4*)(xg + (size_t)pos * D + 16 * lane) = o;
            if (lane == 0) { tokpos[(size_t)t * TOPK + k] = pos; rowgate[pos] = gatew[(size_t)t * TOPK + k]; } }
    }
    for (int idx = gw; idx < NE * 256; idx += NGW) { const int e = idx >> 8, r = idx & 255; const int row = tst[e] * 256 + (int)__hip_atomic_load(gcnt + e, RLX_AGENT) + r;
        if (row < tst[e + 1] * 256) { const u32x4 z = {0u, 0u, 0u, 0u}; *(u32x4*)(xg + (size_t)row * D + 16 * lane) = z; if (lane == 0) rowgate[row] = 0.f; } }
}
DI void p20_final(const Args& args, int vcu, int G) {
    int tid_ = threadIdx.x; asm volatile("" : "+v"(tid_)); const int lane = tid_ & 63; const int wave = __builtin_amdgcn_readfirstlane(tid_ >> 6);
    unsigned char* ws = args.ws;
    const int* tokpos = (const int*)(ws + WS_TOKPOS); const bf16_t* yb = (const bf16_t*)(ws + WS_YB);
    const bf16_t* v2 = (const bf16_t*)(ws + WS_V2B); const float* stats2 = (const float*)(ws + CTL_STATS2);
    const float* g2 = (const float*)args.in[24]; const float* b2 = (const float*)args.in[25];
    const float* g = (const float*)args.in[32]; const float* b = (const float*)args.in[33]; float* out = args.out;
    const int gw = vcu * NWAVES + wave, NGW = G * NWAVES;
    for (int t = gw; t < T; t += NGW) {
        int pos[TOPK];
#pragma unroll
        for (int k = 0; k < TOPK; ++k) pos[k] = tokpos[(size_t)t * TOPK + k];
        float mean2, rstd2; pg8::row_stats(stats2, t, mean2, rstd2);
        f32x4 v[4]; float s = 0.f;
#pragma unroll
        for (int j = 0; j < 4; ++j) { const u32x2 vw = *(const u32x2*)(v2 + (size_t)t * D + 4 * lane + 256 * j); const f32x4 vin = {bflo(vw.x), bfhi(vw.x), bflo(vw.y), bfhi(vw.y)};
            const f32x4 r = (vin - mean2) * rstd2 * *(const f32x4*)(g2 + 4 * lane + 256 * j) + *(const f32x4*)(b2 + 4 * lane + 256 * j);
            f32x4 a = {0.f, 0.f, 0.f, 0.f};
#pragma unroll
            for (int k = 0; k < TOPK; ++k) { const u32x2 w = *(const u32x2*)(yb + (size_t)pos[k] * D + 4 * lane + 256 * j); a[0] += bflo(w.x); a[1] += bfhi(w.x); a[2] += bflo(w.y); a[3] += bfhi(w.y); }
            v[j] = r * DN_ALPHA + a; s += (v[j][0] + v[j][1]) + (v[j][2] + v[j][3]); }
        const float mean = wave_sum(s) * (1.0f / D); float q = 0.f;
#pragma unroll
        for (int j = 0; j < 4; ++j) { v[j] = v[j] - mean; q += (v[j][0] * v[j][0] + v[j][1] * v[j][1]) + (v[j][2] * v[j][2] + v[j][3] * v[j][3]); }
        const float rstd = 1.0f / sqrtf(wave_sum(q) * (1.0f / D) + EPS);
#pragma unroll
        for (int j = 0; j < 4; ++j) { const f32x4 gg = *(const f32x4*)(g + 4 * lane + 256 * j), bb = *(const f32x4*)(b + 4 * lane + 256 * j);
            *(f32x4*)(out + (size_t)t * D + 4 * lane + 256 * j) = v[j] * rstd * gg + bb; }
    }
}
constexpr int AT_KROW = 208, AT_VROW = 136;
constexpr int AT_KBUF = 64 * AT_KROW, AT_VBUF = 64 * AT_VROW, AT_VOFF = 2 * AT_KBUF;
DI void mla_unit(int b, int h, int qb, const bf16_t* Q, const bf16_t* Kn, const bf16_t* Kpe, const bf16_t* Vt, bf16_t* O, LAS unsigned char* lds) {
    int tid = threadIdx.x; asm volatile("" : "+v"(tid)); const int lane = tid & 63, r32 = lane & 31, hi = lane >> 5; const int wid = __builtin_amdgcn_readfirstlane(tid >> 6);
    const int q0 = qb * 256 + wid * 32;
    const int qi = q0 + r32;
    const size_t tokb = (size_t)b * SEQ;
    bf16x8 qf[6];
    { const bf16_t* qp = Q + (tokb + qi) * (AH * AQK) + h * AQK + 8 * hi;
#pragma unroll
      for (int s = 0; s < 6; ++s) qf[s] = *(const bf16x8*)(qp + 16 * s); }
    const int kkey = tid >> 3, kch = tid & 7, pkey = (tid & 255) >> 2, pch = tid & 3, vd = tid >> 3, vch = tid & 7;
    const bf16_t* ksrc = Kn + (tokb + kkey) * 512 + h * 64 + kch * 8;
    const bf16_t* psrc = Kpe + (tokb + pkey) * 32 + pch * 8;
    const bf16_t* vsrc = Vt + (size_t)(h * 64 + vd) * T + tokb + vch * 8;
    const int kdst = kkey * AT_KROW + kch * 16, pdst = pkey * AT_KROW + 128 + pch * 16, vdst = AT_VOFF + vd * AT_VROW + vch * 16;
    const int nkt = 4 * (qb + 1);
    u32x4 rk, rp, rv;
    rk = *(const u32x4*)ksrc; rv = *(const u32x4*)vsrc; rp = (u32x4){0u, 0u, 0u, 0u}; if (tid < 256) rp = *(const u32x4*)psrc;
    *(LAS u32x4*)(lds + kdst) = rk; if (tid < 256) *(LAS u32x4*)(lds + pdst) = rp;
    *(LAS u32x2*)(lds + vdst) = (u32x2){rv.x, rv.y}; *(LAS u32x2*)(lds + vdst + 8) = (u32x2){rv.z, rv.w};
    __syncthreads();
    float m_run = -INFINITY, l_run = 0.f;
    f32x16 o0, o1;
#pragma unroll
    for (int r = 0; r < 16; ++r) { o0[r] = 0.f; o1[r] = 0.f; }
    for (int kt = 0; kt < nkt; ++kt) {
        const int buf = kt & 1;
        if (kt + 1 < nkt) { rk = *(const u32x4*)(ksrc + (size_t)(kt + 1) * 64 * 512); rv = *(const u32x4*)(vsrc + (kt + 1) * 64); if (tid < 256) rp = *(const u32x4*)(psrc + (size_t)(kt + 1) * 64 * 32); }
        const int key0 = kt * 64;
        if (key0 <= q0 + 31) {
            const LAS unsigned char* kb = lds + buf * AT_KBUF + r32 * AT_KROW + hi * 16;
            f32x16 p0, p1;
#pragma unroll
            for (int r = 0; r < 16; ++r) { p0[r] = 0.f; p1[r] = 0.f; }
#pragma unroll
            for (int s = 0; s < 6; ++s) { const bf16x8 a0 = *(const LAS bf16x8*)(kb + s * 32), a1 = *(const LAS bf16x8*)(kb + 32 * AT_KROW + s * 32);
                p0 = MFMA32(a0, qf[s], p0); p1 = MFMA32(a1, qf[s], p1); }
            if (key0 + 63 > q0) {
#pragma unroll
                for (int r = 0; r < 16; ++r) { const int key = key0 + crow(r, hi); if (key > qi) p0[r] = -INFINITY; if (key + 32 > qi) p1[r] = -INFINITY; }
            }
            float mx = fmaxf(p0[0], p1[0]);
#pragma unroll
            for (int r = 1; r < 16; ++r) mx = fmaxf(mx, fmaxf(p0[r], p1[r]));
            mx = fmaxf(mx, __shfl_xor(mx, 32));
            const float m_new = fmaxf(m_run, mx);
            const float alpha = __builtin_amdgcn_exp2f(m_run - m_new);
            m_run = m_new;
            float ls = 0.f;
#pragma unroll
            for (int r = 0; r < 16; ++r) { p0[r] = __builtin_amdgcn_exp2f(p0[r] - m_new); p1[r] = __builtin_amdgcn_exp2f(p1[r] - m_new); ls += p0[r] + p1[r]; }
            l_run = l_run * alpha + ls;
            if (!__all(alpha == 1.0f)) {
#pragma unroll
                for (int r = 0; r < 16; ++r) { o0[r] *= alpha; o1[r] *= alpha; } }
            bf16x8 pb[4];
#pragma unroll
            for (int s = 0; s < 4; ++s) { u32x4 w;
                if (s < 2) { w.x = pk2(p0[8 * s], p0[8 * s + 1]); w.y = pk2(p0[8 * s + 2], p0[8 * s + 3]); w.z = pk2(p0[8 * s + 4], p0[8 * s + 5]); w.w = pk2(p0[8 * s + 6], p0[8 * s + 7]); }
                else { const int s2 = s - 2; w.x = pk2(p1[8 * s2], p1[8 * s2 + 1]); w.y = pk2(p1[8 * s2 + 2], p1[8 * s2 + 3]); w.z = pk2(p1[8 * s2 + 4], p1[8 * s2 + 5]); w.w = pk2(p1[8 * s2 + 6], p1[8 * s2 + 7]); }
                pb[s] = __builtin_bit_cast(bf16x8, w); }
            const LAS unsigned char* vb = lds + AT_VOFF + buf * AT_VBUF + r32 * AT_VROW + hi * 8;
#pragma unroll
            for (int s = 0; s < 4; ++s) {
                const u32x2 a0l = *(const LAS u32x2*)(vb + s * 32), a0h = *(const LAS u32x2*)(vb + s * 32 + 16);
                const u32x2 a1l = *(const LAS u32x2*)(vb + 32 * AT_VROW + s * 32), a1h = *(const LAS u32x2*)(vb + 32 * AT_VROW + s * 32 + 16);
                const bf16x8 a0 = __builtin_bit_cast(bf16x8, (u32x4){a0l.x, a0l.y, a0h.x, a0h.y}), a1 = __builtin_bit_cast(bf16x8, (u32x4){a1l.x, a1l.y, a1h.x, a1h.y});
                o0 = MFMA32(a0, pb[s], o0); o1 = MFMA32(a1, pb[s], o1); }
        }
        if (kt + 1 < nkt) { const int nb = (kt + 1) & 1;
            *(LAS u32x4*)(lds + nb * AT_KBUF + kdst) = rk; if (tid < 256) *(LAS u32x4*)(lds + nb * AT_KBUF + pdst) = rp;
            *(LAS u32x2*)(lds + nb * AT_VBUF + vdst) = (u32x2){rv.x, rv.y}; *(LAS u32x2*)(lds + nb * AT_VBUF + vdst + 8) = (u32x2){rv.z, rv.w}; }
        __syncthreads();
    }
    const float lt = l_run + __shfl_xor(l_run, 32); const float inv = 1.0f / lt;
    bf16_t* op = O + (tokb + qi) * AW + h * AVD + 4 * hi;
#pragma unroll
    for (int g = 0; g < 4; ++g) { u32x2 w0, w1;
        w0.x = pk2(o0[4 * g] * inv, o0[4 * g + 1] * inv); w0.y = pk2(o0[4 * g + 2] * inv, o0[4 * g + 3] * inv);
        w1.x = pk2(o1[4 * g] * inv, o1[4 * g + 1] * inv); w1.y = pk2(o1[4 * g + 2] * inv, o1[4 * g + 3] * inv);
        *(u32x2*)(op + 8 * g) = w0; *(u32x2*)(op + 32 + 8 * g) = w1; }
}
DI void p4_attention(const Args& args, LAS unsigned char* lds, int vcu, int G) {
    unsigned char* ws = args.ws;
    const bf16_t* Q = (const bf16_t*)(ws + WS_QMLA); const bf16_t* Kn = (const bf16_t*)(ws + WS_KN); const bf16_t* Kpe = (const bf16_t*)(ws + WS_KPE); const bf16_t* Vt = (const bf16_t*)(ws + WS_VT);
    bf16_t* O = (bf16_t*)(ws + WS_AO);
    for (int p = vcu; p < NB * AH * 4; p += G) { const int bh = p >> 2, j = p & 3; const int b = bh / AH, h = bh % AH;
        mla_unit(b, h, 7 - j, Q, Kn, Kpe, Vt, O, lds);
        mla_unit(b, h, j, Q, Kn, Kpe, Vt, O, lds); }
}

constexpr int ML_QROW = 272, ML_TROW = 144;
constexpr int ML_QS = 0, ML_KS = ML_QS + 64 * ML_QROW, ML_KTS = ML_KS + 64 * ML_QROW, ML_VTS = ML_KTS + 128 * ML_TROW, ML_CS = ML_VTS + 32 * ML_TROW, ML_SS = ML_CS + 32 * ML_QROW,
              ML_VEC = ML_SS + 64 * ML_TROW;
static_assert(ML_VEC + (7 * 64 + 128 + 4) * 4 <= RING_BYTES, "mLSTM LDS");
DI void mlstm_unit(int b, int h, int vs, const Args& args, LAS unsigned char* lds) {
    unsigned char* ws = args.ws;
    const bf16_t* qkm = (const bf16_t*)(ws + WS_QKM); const bf16_t* ktm = (const bf16_t*)(ws + WS_KTM); const bf16_t* proj = (const bf16_t*)(ws + WS_PROJ);
    const float* gates = (const float*)(ws + WS_GATES); float* hraw = (float*)(ws + WS_HRAW);
    const float b_i = ((const float*)args.in[4])[h], b_f = ((const float*)args.in[5])[h];
    int tid = threadIdx.x; asm volatile("" : "+v"(tid)); const int lane = tid & 63, r32 = lane & 31, hi = lane >> 5; const int wid = __builtin_amdgcn_readfirstlane(tid >> 6);
    LAS float* ROWT = (LAS float*)(lds + ML_VEC); LAS float* COLT = ROWT + 64; LAS float* WINT = ROWT + 128; LAS float* ENEG = ROWT + 192; LAS float* WAS = ROWT + 256;
    LAS float* NQ = ROWT + 320; LAS float* DINV = ROWT + 384; LAS float* NVEC = ROWT + 448; LAS float* SCAL = ROWT + 576;
    const size_t tokb = (size_t)b * SEQ;
    for (int i = tid; i < 32 * ML_QROW / 4; i += 512) ((LAS unsigned*)(lds + ML_CS))[i] = 0u;
    if (tid < 128) NVEC[tid] = 0.f;
    f32x16 cacc;
#pragma unroll
    for (int r = 0; r < 16; ++r) cacc[r] = 0.f;
    float m_st = 0.f;
    u32x4 sq[2], sk[2], skt[2], sv; float gi = 0.f, gf = 0.f;
    sv = (u32x4){0u, 0u, 0u, 0u};
#define ML_LOAD(c) do { const size_t tok0 = tokb + (size_t)(c) * MCH; \
        _Pragma("unroll") for (int i = 0; i < 2; ++i) { const int idx = tid + 512 * i; \
            sq[i] = *(const u32x4*)(qkm + (tok0 + (idx >> 4)) * 1024 + h * MHD + (idx & 15) * 8); \
            sk[i] = *(const u32x4*)(qkm + (tok0 + (idx >> 4)) * 1024 + 512 + h * MHD + (idx & 15) * 8); \
            skt[i] = *(const u32x4*)(ktm + (size_t)(h * MHD + (idx >> 3)) * T + tok0 + (idx & 7) * 8); } \
        if (tid < 256) sv = *(const u32x4*)(proj + (tok0 + (tid >> 2)) * NPROJ + PC_VM + h * MHD + vs * 32 + (tid & 3) * 8); \
        if (wid == 0) { gi = gates[(tok0 + lane) * 8 + h]; gf = gates[(tok0 + lane) * 8 + 4 + h]; } } while (0)
    ML_LOAD(0);
    for (int c = 0; c < SEQ / MCH; ++c) {
        const size_t tok0 = tokb + (size_t)c * MCH;
#pragma unroll
        for (int i = 0; i < 2; ++i) { const int idx = tid + 512 * i;
            *(LAS u32x4*)(lds + ML_QS + (idx >> 4) * ML_QROW + (idx & 15) * 16) = sq[i];
            *(LAS u32x4*)(lds + ML_KS + (idx >> 4) * ML_QROW + (idx & 15) * 16) = sk[i];
            *(LAS u32x4*)(lds + ML_KTS + (idx >> 3) * ML_TROW + (idx & 7) * 16) = skt[i]; }
        if (tid < 256) { const int l = tid >> 2, v0 = (tid & 3) * 8; LAS bf16_t* vt = (LAS bf16_t*)(lds + ML_VTS);
            vt[(v0 + 0) * (ML_TROW / 2) + l] = (bf16_t)(sv.x & 0xffff); vt[(v0 + 1) * (ML_TROW / 2) + l] = (bf16_t)(sv.x >> 16);
            vt[(v0 + 2) * (ML_TROW / 2) + l] = (bf16_t)(sv.y & 0xffff); vt[(v0 + 3) * (ML_TROW / 2) + l] = (bf16_t)(sv.y >> 16);
            vt[(v0 + 4) * (ML_TROW / 2) + l] = (bf16_t)(sv.z & 0xffff); vt[(v0 + 5) * (ML_TROW / 2) + l] = (bf16_t)(sv.z >> 16);
            vt[(v0 + 6) * (ML_TROW / 2) + l] = (bf16_t)(sv.w & 0xffff); vt[(v0 + 7) * (ML_TROW / 2) + l] = (bf16_t)(sv.w >> 16); }
        if (wid == 0) {
            const float xf = gf + b_f;
            const float lf = (xf >= 0.f) ? -log1pf(__expf(-xf)) : xf - log1pf(__expf(xf));
            float bb = lf;
#pragma unroll
            for (int o = 1; o < 64; o <<= 1) { const float tv = __shfl_up(bb, o); if (lane >= o) bb += tv; }
            const float btot = __shfl(bb, 63);
            const float ig = gi + b_i;
            const float a = btot - bb + ig;
            const float mchunk = wave_max(a);
            const float wa = __expf(a - mchunk);
            const float u = ig - bb;
            float pm = u;
#pragma unroll
            for (int o = 1; o < 64; o <<= 1) { const float tv = __shfl_up(pm, o); if (lane >= o) pm = fmaxf(pm, tv); }
            const float mintra = bb + pm;
            const float ginter = bb + m_st;
            const float m = fmaxf(ginter, mintra);
            const float mnew = fmaxf(btot + m_st, mchunk);
            const float sold = __expf(btot + m_st - mnew), snew = __expf(mchunk - mnew);
            ROWT[lane] = bb - m; COLT[lane] = u; WINT[lane] = __expf(ginter - m); ENEG[lane] = __expf(-m); WAS[lane] = snew * wa;
            if (lane == 0) SCAL[0] = sold;
            m_st = mnew;
        }
        __syncthreads();
        if (c + 1 < SEQ / MCH) ML_LOAD(c + 1);
        f32x16 iacc;
#pragma unroll
        for (int r = 0; r < 16; ++r) iacc[r] = 0.f;
        if (wid < 4) {
            const int jb = wid >> 1, sb = wid & 1;
            LAS bf16_t* ss = (LAS bf16_t*)(lds + ML_SS);
            if (sb <= jb) {
                f32x16 s;
#pragma unroll
                for (int r = 0; r < 16; ++r) s[r] = 0.f;
                const LAS unsigned char* qa = lds + ML_QS + (32 * jb + r32) * ML_QROW + hi * 16; const LAS unsigned char* kb = lds + ML_KS + (32 * sb + r32) * ML_QROW + hi * 16;
#pragma unroll
                for (int kk = 0; kk < 8; ++kk) s = MFMA32(*(const LAS bf16x8*)(qa + kk * 32), *(const LAS bf16x8*)(kb + kk * 32), s);
                const int sidx = 32 * sb + r32; const float ct = COLT[sidx];
#pragma unroll
                for (int r = 0; r < 16; ++r) { const int j = 32 * jb + crow(r, hi);
                    const float val = (sidx <= j) ? s[r] * __expf(ROWT[j] + ct) : 0.f;
                    ss[j * (ML_TROW / 2) + sidx] = (bf16_t)pk2(val, 0.f); }
            } else {
#pragma unroll
                for (int r = 0; r < 16; ++r) ss[(32 * jb + crow(r, hi)) * (ML_TROW / 2) + 32 * sb + r32] = (bf16_t)0;
            }
        } else if (wid < 6) {
            const int jb = wid - 4;
            const LAS unsigned char* qa = lds + ML_QS + (32 * jb + r32) * ML_QROW + hi * 16; const LAS unsigned char* cb = lds + ML_CS + r32 * ML_QROW + hi * 16;
#pragma unroll
            for (int kk = 0; kk < 8; ++kk) iacc = MFMA32(*(const LAS bf16x8*)(qa + kk * 32), *(const LAS bf16x8*)(cb + kk * 32), iacc);
        } else {
            const int j = 32 * (wid - 6) + (lane >> 1), half = lane & 1;
            const LAS unsigned char* qa = lds + ML_QS + j * ML_QROW + half * 128; float acc = 0.f;
#pragma unroll
            for (int i = 0; i < 8; ++i) { const u32x4 w = *(const LAS u32x4*)(qa + i * 16); const f32x4 n0 = *(const LAS f32x4*)(NVEC + half * 64 + i * 8), n1 = *(const LAS f32x4*)(NVEC + half * 64 + i * 8 + 4);
                acc += bflo(w.x) * n0[0] + bfhi(w.x) * n0[1] + bflo(w.y) * n0[2] + bfhi(w.y) * n0[3] + bflo(w.z) * n1[0] + bfhi(w.z) * n1[1] + bflo(w.w) * n1[2] + bfhi(w.w) * n1[3]; }
            acc += __shfl_xor(acc, 1);
            if (half == 0) NQ[j] = acc;
        }
        __syncthreads();
        if (wid < 4) {
            const float sold = SCAL[0];
#pragma unroll
            for (int r = 0; r < 16; ++r) cacc[r] *= sold;
            const LAS unsigned char* va = lds + ML_VTS + r32 * ML_TROW + hi * 16; const LAS unsigned char* kb = lds + ML_KTS + (32 * wid + r32) * ML_TROW + hi * 16;
#pragma unroll
            for (int kk = 0; kk < 4; ++kk) { const u32x4 w = *(const LAS u32x4*)(va + kk * 32);
                const f32x4 w0 = *(const LAS f32x4*)(WAS + 16 * kk + 8 * hi), w1 = *(const LAS f32x4*)(WAS + 16 * kk + 8 * hi + 4);
                u32x4 sa; sa.x = pk2(bflo(w.x) * w0[0], bfhi(w.x) * w0[1]); sa.y = pk2(bflo(w.y) * w0[2], bfhi(w.y) * w0[3]); sa.z = pk2(bflo(w.z) * w1[0], bfhi(w.z) * w1[1]); sa.w = pk2(bflo(w.w) * w1[2], bfhi(w.w) * w1[3]);
                cacc = MFMA32(__builtin_bit_cast(bf16x8, sa), *(const LAS bf16x8*)(kb + kk * 32), cacc); }
            LAS bf16_t* cs = (LAS bf16_t*)(lds + ML_CS);
#pragma unroll
            for (int r = 0; r < 16; ++r) cs[crow(r, hi) * (ML_QROW / 2) + 32 * wid + r32] = (bf16_t)pk2(cacc[r], 0.f);
        } else if (wid < 6) {
            const int jb = wid - 4;
#pragma unroll
            for (int r = 0; r < 16; ++r) iacc[r] *= WINT[32 * jb + crow(r, hi)];
            const LAS unsigned char* sa = lds + ML_SS + (32 * jb + r32) * ML_TROW + hi * 16; const LAS unsigned char* vb = lds + ML_VTS + r32 * ML_TROW + hi * 16;
#pragma unroll
            for (int kk = 0; kk < 4; ++kk) iacc = MFMA32(*(const LAS bf16x8*)(sa + kk * 32), *(const LAS bf16x8*)(vb + kk * 32), iacc);
        } else {
            const int tl = (wid - 6) * 64 + lane;
            { const int j = tl >> 1, half = tl & 1; const LAS unsigned char* sp = lds + ML_SS + j * ML_TROW + half * 64; float rs = 0.f;
#pragma unroll
              for (int i = 0; i < 4; ++i) { const u32x4 w = *(const LAS u32x4*)(sp + i * 16); rs += (bflo(w.x) + bfhi(w.x)) + (bflo(w.y) + bfhi(w.y)) + (bflo(w.z) + bfhi(w.z)) + (bflo(w.w) + bfhi(w.w)); }
              rs += __shfl_xor(rs, 1);
              if (half == 0) { const float den = WINT[j] * NQ[j] + rs; DINV[j] = 1.0f / fmaxf(fabsf(den), ENEG[j]); } }
            { const int k = tl; const LAS unsigned char* kp = lds + ML_KTS + k * ML_TROW; float acc = SCAL[0] * NVEC[k];
#pragma unroll
              for (int i = 0; i < 8; ++i) { const u32x4 w = *(const LAS u32x4*)(kp + i * 16); const f32x4 w0 = *(const LAS f32x4*)(WAS + i * 8), w1 = *(const LAS f32x4*)(WAS + i * 8 + 4);
                  acc += bflo(w.x) * w0[0] + bfhi(w.x) * w0[1] + bflo(w.y) * w0[2] + bfhi(w.y) * w0[3] + bflo(w.z) * w1[0] + bfhi(w.z) * w1[1] + bflo(w.w) * w1[2] + bfhi(w.w) * w1[3]; }
              NVEC[k] = acc; }
        }
        __syncthreads();
        if (wid == 4 || wid == 5) {
            const int jb = wid - 4; float* hp = hraw + (tok0 + 32 * jb) * MW + h * MHD + vs * 32 + r32;
#pragma unroll
            for (int r = 0; r < 16; ++r) { const int j = crow(r, hi); hp[(size_t)j * MW] = iacc[r] * DINV[32 * jb + j]; }
        }
    }
#undef ML_LOAD
    __syncthreads();
}
DI void p5_mlstm(const Args& args, LAS unsigned char* lds, int vcu, int G) {
    for (int u = vcu; u < NB * MH * 4; u += G) { const int vs = u & 3, bh = u >> 2; mlstm_unit(bh / MH, bh % MH, vs, args, lds); }
}
#ifndef MK_ONE_LAUNCH
#define MK_ONE_LAUNCH 1
#endif
#ifndef P3SEL
#define P3SEL 31
#endif
constexpr int NPH = 20;
__global__ void __launch_bounds__(NWAVES * 64, 2) fwd_kernel(Args args) {
    extern __shared__ __attribute__((aligned(16))) unsigned char lds_raw[];
    LAS unsigned char* lds = (LAS unsigned char*)lds_raw;
    const int tid = threadIdx.x;
    const int G = gridDim.x; const int bx = blockIdx.x; const int vcu = (G % 8 == 0) ? (bx % 8) * (G / 8) + bx / 8 : bx;
    unsigned char* ws = args.ws;
    for (int u = tid; u < (LDS_BYTES - LDSCTL_OFF) / 4; u += NWAVES * 64) ((LAS unsigned*)(lds + LDSCTL_OFF))[u] = 0u;
    __syncthreads();
    volatile LAS unsigned* MISC = (volatile LAS unsigned*)(lds + MISC_OFF);
    XcdBarrier bar; bar.bar = (unsigned*)(ws + WS_CTL) + CW_BAR; bar.x = 0; bar.st = nullptr;
    const int lo = args.ph_lo, hi = args.ph_hi;
    if (hi - lo > 1) bar = xcd_barrier_post((unsigned*)(ws + WS_CTL) + CW_BAR, MISC + 8);
#ifndef PHASE_MASK
#define PHASE_MASK 0xFFFFFu
#endif
#define IN(k) (((PHASE_MASK >> (k)) & 1u) && lo <= (k) && (k) < hi)
#ifndef DUP_PHASE
#define DUP_PHASE -1
#endif
#define REP(k) _Pragma("unroll 1") for (int rep_ = 0; rep_ < ((DUP_PHASE == (k)) ? 2 : 1); ++rep_)
#define SEAM(k) do { if (IN(k) && IN(NEXTPH(k))) xcd_barrier(bar); } while (0)
#define NEXTPH(k) (((k) == 7 || (k) == 12) ? (k) + 2 : (k) + 1)
    using namespace pg8;
    LAS unsigned char* ring = lds + RING_OFF;
    const bf16_t* cws = (const bf16_t*)ws;
#define WSB(off) ((bf16_t*)(ws + (off)))
#define WSF(off) ((float*)(ws + (off)))

    if (IN(0)) REP(0) { p0_prologue(args, lds, vcu, G); }
    SEAM(0);
    if (IN(1)) REP(1) {
        { DenseOrder S; S.init(WSB(WS_XB), WSB(WS_W_IN), T, NPROJ, D, D, G, bx); EpiProj E{WSB(WS_PROJ), WSF(WS_GATES)}; gemm_phase(ring, D, D, D, S, E); }
        { DenseOrder S; S.init(WSB(WS_MEMB), WSB(WS_W_CK), NB * NMEM, D, D, D, G, bx); EpiBf16 E{WSB(WS_KC), D, 1 << 30, 1.f}; gemm_phase(ring, D, D, D, S, E); }
        { DenseOrder S; S.init(WSB(WS_W_CV), WSB(WS_MEMB), D, NB * NMEM, D, D, G, bx); EpiBf16 E{WSB(WS_VCT), NB * NMEM, 1 << 30, 1.f}; gemm_phase(ring, D, D, D, S, E); }
    }
    SEAM(1);
    if (IN(2)) REP(2) { p2_tokens(args, vcu, G); }
    SEAM(2);
    if (IN(3)) REP(3) {
        if (P3SEL & 1) { DenseOrder S; S.init(WSB(WS_QN), WSB(WS_W_UQ), T, AH * AQK, 256, 256, G, bx); EpiQmla E{WSB(WS_QMLA), WSF(WS_CS), 0.10206207261596575f * 1.4426950408889634f}; gemm_phase(ring, 256, 256, 256, S, E); }
        if (P3SEL & 2) { DenseOrder S; S.init(WSB(WS_KVN), WSB(WS_W_UK), T, 512, 256, 256, G, bx); EpiBf16 E{WSB(WS_KN), 512, 1 << 30, 1.f}; gemm_phase(ring, 256, 256, 256, S, E); }
        if (P3SEL & 4) { DenseOrder S; S.init(WSB(WS_W_UV), WSB(WS_KVN), 512, T, 256, 256, G, bx); EpiBf16 E{WSB(WS_VT), T, 1 << 30, 1.f}; gemm_phase(ring, 256, 256, 256, S, E); }
        if (P3SEL & 8) { DenseOrder S; S.init(WSB(WS_XC), WSB(WS_W_MQK), T, 1024, 512, 512, G, bx); EpiBf16 E{WSB(WS_QKM), 1024, 2, 0.08838834764831845f}; gemm_phase(ring, 512, 512, 512, S, E); }
        if (P3SEL & 16) { DenseOrder S; S.init(WSB(WS_W_MQK) + 512 * 512, WSB(WS_XC), 512, T, 512, 512, G, bx); EpiBf16 E{WSB(WS_KTM), T, 0, 0.08838834764831845f}; gemm_phase(ring, 512, 512, 512, S, E); }
    }
    SEAM(3);
    if (IN(4)) { REP(40) { p5_mlstm(args, lds, vcu, G); } REP(41) { p4_attention(args, lds, vcu, G); } }
    SEAM(4);
    if (IN(5)) REP(5) { p6_mpost(args, vcu, G); }
    SEAM(5);
    if (IN(6)) REP(6) {
        { DenseOrder S; S.init(WSB(WS_HM), WSB(WS_W_BRM), T, D, 512, 512, G, bx); EpiGate<false> E{WSB(WS_GATED), WSB(WS_PROJ), PC_GM}; gemm_phase(ring, 512, 512, 512, S, E); }
        { DenseOrder S; S.init(WSB(WS_AO), WSB(WS_W_BRA), T, D, 512, 512, G, bx); EpiGate<true> E{WSB(WS_GATED), WSB(WS_PROJ), PC_GA}; gemm_phase(ring, 512, 512, 512, S, E); }
    }
    SEAM(6);
    if (IN(7)) REP(7) { DenseOrder S; S.init(WSB(WS_GATED), WSB(WS_W_MIX), T, D, D, D, G, bx); EpiResStats<false> E{WSB(WS_XB), nullptr, nullptr, nullptr, WSB(WS_V1B), WSF(CTL_STATS1)}; gemm_phase(ring, D, D, D, S, E); }
    SEAM(7);
    if (IN(9)) REP(9) { DenseOrder S; S.init(WSB(WS_V1B), WSB(WS_W_CQ), T, D, D, D, G, bx); EpiLNApplyBf16 E{WSB(WS_QC), D, WSF(CTL_STATS1), WSF(CTL_CS1), WSF(CTL_CB1), 0.0625f * 1.4426950408889634f}; gemm_phase(ring, D, D, D, S, E); }
    SEAM(9);
    if (IN(10)) REP(10) { CrossSOrder S{(const char*)(ws + WS_QC), (const char*)(ws + WS_KC), G, vcu}; EpiSoftmax E{WSB(WS_PC), (LAS float*)(lds + RED_OFF)}; gemm_phase(ring, 256, D, D, S, E); }
    SEAM(10);
    if (IN(11)) REP(11) { CrossOOrder S{(const char*)(ws + WS_PC), (const char*)(ws + WS_VCT), G, vcu}; EpiBf16 E{WSB(WS_OC), D, 1 << 30, 1.f}; gemm_phase(ring, 256, D, NB * NMEM, S, E); }
    SEAM(11);
    if (IN(12)) REP(12) { DenseOrder S; S.init(WSB(WS_OC), WSB(WS_W_CO), T, D, D, D, G, bx); EpiResStats<true> E{WSB(WS_V1B), WSF(CTL_STATS1), (const float*)args.in[19], (const float*)args.in[20], WSB(WS_V2B), WSF(CTL_STATS2)}; gemm_phase(ring, D, D, D, S, E); }
    SEAM(12);
    if (IN(14)) REP(14) { DenseOrder S; S.init(WSB(WS_V2B), WSB(WS_W_R), T, 256, D, D, G, bx); EpiLNApplyF32 E{WSF(WS_LOGITS), NE, NE, WSF(CTL_STATS2), WSF(CTL_CSR), WSF(CTL_CBR)}; gemm_phase(ring, D, D, D, S, E); }
    SEAM(14);
    if (IN(15)) REP(15) { p16_topk(args, lds, vcu, G); }
    SEAM(15);
    if (IN(16)) REP(16) { p17_gather(args, lds, vcu, G); }
    SEAM(16);
    if (IN(17)) REP(17) { build_tstart(args, lds);
        MoeOrder S{(const char*)(ws + WS_XG), (const char*)(ws + WS_W_GU), (const LAS int*)(lds + TST_OFF), (const LAS int*)(lds + TILE_E_OFF), 8, G, vcu, (size_t)256 * D, (size_t)2048 * 1024, (size_t)256 * 1024};
        EpiSwiglu E{ws + WS_ACT, (const float*)args.in[29]}; gemm_phase<EpiSwiglu, MoeOrder, true>(ring, D, D, D, S, E); }
    SEAM(17);
    if (IN(18)) REP(18) { build_tstart(args, lds);
        MoeOrder S{(const char*)(ws + WS_ACT), (const char*)(ws + WS_W_DN), (const LAS int*)(lds + TST_OFF), (const LAS int*)(lds + TILE_E_OFF), 4, G, vcu, (size_t)256 * D, (size_t)1024 * 1024, (size_t)256 * 1024};
        EpiDown E{WSB(WS_YB), (const float*)args.in[31], WSF(WS_ROWGATE)}; gemm_phase<EpiDown, MoeOrder, true>(ring, D, D, D, S, E); }
    SEAM(18);
    if (IN(19)) REP(19) { p20_final(args, vcu, G); }
    (void)cws;
#undef IN
#undef SEAM
}

extern "C" void kernel_launch(void* const* d_in, const int* in_sizes, int n_in, void* d_out, int out_size, void* d_ws, size_t ws_size, hipStream_t stream) {
    static int grid = 0;
    if (grid == 0) {
        if (n_in != 34 || in_sizes[0] != T * D || out_size != T * D || ws_size < WS_END) { fprintf(stderr, "kernel_launch: unexpected shapes / workspace (n_in %d, ws %zu)\n", n_in, ws_size); grid = -1; return; }
        int dev = 0, cus = 0, per_cu = 0;
        if (hipGetDevice(&dev) != hipSuccess || hipDeviceGetAttribute(&cus, hipDeviceAttributeMultiprocessorCount, dev) != hipSuccess) { grid = -1; return; }
        if (hipFuncSetAttribute((const void*)fwd_kernel, hipFuncAttributeMaxDynamicSharedMemorySize, LDS_BYTES) != hipSuccess) { fprintf(stderr, "kernel_launch: hipFuncSetAttribute failed\n"); grid = -1; return; }
        if (hipOccupancyMaxActiveBlocksPerMultiprocessor(&per_cu, (const void*)fwd_kernel, NWAVES * 64, LDS_BYTES) != hipSuccess || per_cu < 1) fprintf(stderr, "kernel_launch: occupancy query says %d\n", per_cu);
        (void)hipGetLastError();
        grid = cus;
    }
    if (grid < 0) return;
    if (hipMemsetAsync((char*)d_ws + WS_CTL, 0, CTL_ZERO_BYTES, stream) != hipSuccess) return;
    Args a{};
    for (int i = 0; i < 34; ++i) a.in[i] = d_in[i];
    a.out = (float*)d_out; a.ws = (unsigned char*)d_ws;
#if MK_ONE_LAUNCH
    a.ph_lo = 0; a.ph_hi = NPH;
    hipLaunchKernelGGL(fwd_kernel, dim3(grid), dim3(NWAVES * 64), LDS_BYTES, stream, a);
#else
    for (int p = 0; p < NPH; ++p) { a.ph_lo = p; a.ph_hi = p + 1; hipLaunchKernelGGL(fwd_kernel, dim3(grid), dim3(NWAVES * 64), LDS_BYTES, stream, a); }
#endif
}
```

```cpp
#include <hip/hip_runtime.h>
#include <cstdio>
#include <cstdint>
#include <cmath>

#define LAS __attribute__((address_space(3)))
#define GAS __attribute__((address_space(1)))
typedef unsigned short bf16_t;
typedef short bf16x8 __attribute__((ext_vector_type(8)));
typedef float f32x4 __attribute__((ext_vector_type(4)));
typedef float f32x2 __attribute__((ext_vector_type(2)));
typedef float f32x16 __attribute__((ext_vector_type(16)));
typedef unsigned u32x4 __attribute__((ext_vector_type(4)));
typedef unsigned u32x2 __attribute__((ext_vector_type(2)));
typedef GAS unsigned gu32;
#define RLX_AGENT __ATOMIC_RELAXED, __HIP_MEMORY_SCOPE_AGENT
#define DI __device__ __forceinline__

constexpr int D = 1024, NB = 16, SEQ = 2048, T = NB * SEQ, NMEM = 256;
constexpr int MH = 4, MHD = 128, MW = 512, MCH = 64;
constexpr int AH = 8, ANOPE = 64, AROPE = 32, AQK = 96, AVD = 64, AW = 512, AQR = 256, AKVR = 128;
constexpr int XH = 4, XHD = 256;
constexpr int NE = 32, TOPK = 4;
constexpr int DIN = 4008, NPROJ = 4096;
constexpr float DN_ALPHA = 1.189207115002721f;
constexpr float EPS = 1e-5f;
constexpr int NASSIGN = T * TOPK;
constexpr int NROWS = NASSIGN + NE * 256;
constexpr int NTILES_MAX = NROWS / 256;
constexpr int PC_QLAT = 0, PC_KVLAT = 256, PC_KROPE = 384, PC_IG = 416, PC_FG = 420, PC_XM = 512, PC_VM = 1024, PC_OP = 1536, PC_GM = 2048, PC_GA = 3072;

DI unsigned f2bf(float f) { unsigned u = __builtin_bit_cast(unsigned, f); return (u + 0x7fffu + ((u >> 16) & 1u)) >> 16; }
typedef __bf16 bf16x2_hw __attribute__((ext_vector_type(2)));
DI unsigned pk2(float lo, float hi) { const f32x2 v = {lo, hi}; return __builtin_bit_cast(unsigned, __builtin_convertvector(v, bf16x2_hw)); }
DI float bf2f(unsigned short b) { return __builtin_bit_cast(float, (unsigned)b << 16); }
DI float bflo(unsigned w) { return __builtin_bit_cast(float, w << 16); }
DI float bfhi(unsigned w) { return __builtin_bit_cast(float, w & 0xffff0000u); }
DI float wave_sum(float v) {
#pragma unroll
    for (int o = 1; o < 64; o <<= 1) v += __shfl_xor(v, o);
    return v;
}
DI float wave_max(float v) {
#pragma unroll
    for (int o = 1; o < 64; o <<= 1) v = fmaxf(v, __shfl_xor(v, o));
    return v;
}
DI float rcpf_(float x) { return __builtin_amdgcn_rcpf(x); }
DI float sigmoidf_(float x) { return __builtin_amdgcn_rcpf(1.0f + __builtin_amdgcn_exp2f(-1.4426950408889634f * x)); }
DI int crow(int r, int hi) { return (r & 3) + 8 * (r >> 2) + 4 * hi; }
#define MFMA32(a, b, c) __builtin_amdgcn_mfma_f32_32x32x16_bf16((a), (b), (c), 0, 0, 0)

namespace pg8 {
constexpr int BM = 256, BK = 64, HALF = 128, HTB = HALF * BK * 2, STAGE_BYTES = 8 * HTB;
__host__ __device__ __forceinline__ int lds_byte(int r, int c) { const int st = (r >> 4) * 2 + (c >> 5), rr = r & 15, cc = c & 31, ob = rr * 64 + cc * 2; return st * 1024 + (ob ^ (((ob >> 9) & 1) << 5)); }
__host__ __device__ __forceinline__ void stage_rc(int b, int& R, int& C) { const int st = b / 1024, sb = b % 1024, swz = sb ^ (((sb >> 9) & 1) << 5); R = (st >> 1) * 16 + swz / 64; C = (st & 1) * 32 + (swz % 64) / 2; }
__host__ __device__ __forceinline__ int perm32(int rho) { const int n = rho >> 4, i = rho & 15; return 8 * (i >> 2) + 4 * n + (i & 3); }

struct Unit { int pm, pn, aux; const char* a; const char* b; };
struct Ctx { int wr, wc, fr, fq, wid, lane; };

DI unsigned cvt_pk_bf16(float lo, float hi) { unsigned r; asm volatile("v_cvt_pk_bf16_f32 %0, %1, %2" : "=v"(r) : "v"(lo), "v"(hi)); return r; }

typedef f32x4 Acc[2][2][4][2];

DI void glds16_s(const char* gbase, unsigned voff, unsigned lds_dst) { unsigned keep;
    asm volatile("s_mov_b32 %0, m0\n\ts_mov_b32 m0, %1\n\ts_nop 0\n\tglobal_load_lds_dwordx4 %2, %3\n\ts_mov_b32 m0, %0" : "=&s"(keep) : "s"(lds_dst), "v"(voff), "s"(gbase) : "memory"); }
typedef int v8i_t __attribute__((ext_vector_type(8)));
typedef int i32x4_t __attribute__((ext_vector_type(4)));
template <class Epi, class Sched, bool FP8 = false>
DI void gemm_phase(LAS unsigned char* lds, const int K, const int lda, const int ldb, const Sched& S, const Epi& E) {
    int tid = threadIdx.x; asm volatile("" : "+v"(tid));
    const int wid = __builtin_amdgcn_readfirstlane(tid >> 6), lane = tid & 63, wr = wid >> 2, wc = wid & 3, fr = lane & 15, fq = lane >> 4;
    constexpr int ESZ = FP8 ? 1 : 2;
    const int nt = K * ESZ / (BK * 2);
    unsigned voffA[2], voffB[2];
#pragma unroll
    for (int i = 0; i < 2; ++i) { int R, C; stage_rc(tid * 16 + i * 8192, R, C); const int Rb = Epi::PERM ? ((R & ~31) + perm32(R & 31)) : R;
        voffA[i] = (unsigned)(R * lda * ESZ + C * 2); voffB[i] = (unsigned)(Rb * ldb * ESZ + C * 2); }
    const size_t kstep = (size_t)(BK * 2);
    const size_t hstepA = (size_t)HALF * lda * ESZ, hstepB = (size_t)HALF * ldb * ESZ;
    const unsigned ldsw = (unsigned)wid * 1024u;
    const int aoff = lds_byte(wr * 64 + fr, fq * 8), boff = lds_byte(wc * 32 + fr, fq * 8);
    const Ctx cx{wr, wc, fr, fq, wid, lane};
    const unsigned lds_u = (unsigned)__builtin_amdgcn_readfirstlane((int)((unsigned)(size_t)lds + ldsw));
    LAS unsigned char* ldsB = lds + 4 * HTB + boff;
#define PG8_SA(b, h) (((b) * 2 + (h)) * HTB)
#define PG8_SB(b, h) ((4 + (b) * 2 + (h)) * HTB)
#define PG8_SBL(b, h) (((b) * 2 + (h)) * HTB)
#define PG8_STAGE(bufoff, gbase, voff) do { _Pragma("unroll") for (int _i = 0; _i < 2; ++_i) \
        glds16_s((const char*)(gbase), (voff)[_i], lds_u + (unsigned)((bufoff) + _i * 8192)); } while (0)
#define PG8_RD(off) (*(const LAS i32x4_t*)(lds + (off)))
#define PG8_CAT2(x, y) __builtin_shufflevector((x), (y), 0, 1, 2, 3, 4, 5, 6, 7)
#define PG8_LDA(dst, b, h) do { if constexpr (FP8) { _Pragma("unroll") for (int m = 0; m < 4; ++m) dst##8[m] = PG8_CAT2(PG8_RD(PG8_SA(b, h) + aoff + m * 2048), PG8_RD(PG8_SA(b, h) + aoff + m * 2048 + 1024)); } \
        else { _Pragma("unroll") for (int m = 0; m < 4; ++m) _Pragma("unroll") for (int k = 0; k < 2; ++k) dst[m][k] = *(const LAS bf16x8*)(lds + PG8_SA(b, h) + aoff + m * 2048 + k * 1024); } } while (0)
#define PG8_LDB(dst, b, h) do { if constexpr (FP8) { _Pragma("unroll") for (int n = 0; n < 2; ++n) dst##8[n] = PG8_CAT2(*(const LAS i32x4_t*)(ldsB + PG8_SBL(b, h) + n * 2048), *(const LAS i32x4_t*)(ldsB + PG8_SBL(b, h) + n * 2048 + 1024)); } \
        else { _Pragma("unroll") for (int n = 0; n < 2; ++n) _Pragma("unroll") for (int k = 0; k < 2; ++k) dst[n][k] = *(const LAS bf16x8*)(ldsB + PG8_SBL(b, h) + n * 2048 + k * 1024); } } while (0)
#define PG8_MMA(ai, bj, At, Bt) do { __builtin_amdgcn_s_setprio(1); \
        if constexpr (FP8) { _Pragma("unroll") for (int m = 0; m < 4; ++m) _Pragma("unroll") for (int n = 0; n < 2; ++n) \
            acc[ai][bj][m][n] = __builtin_amdgcn_mfma_scale_f32_16x16x128_f8f6f4(Bt##8[n], At##8[m], acc[ai][bj][m][n], 0, 0, 0, 0x7f7f7f7f, 0, 0x7f7f7f7f); } \
        else { _Pragma("unroll") for (int m = 0; m < 4; ++m) _Pragma("unroll") for (int n = 0; n < 2; ++n) _Pragma("unroll") for (int k = 0; k < 2; ++k) \
            acc[ai][bj][m][n] = __builtin_amdgcn_mfma_f32_16x16x32_bf16(Bt[n][k], At[m][k], acc[ai][bj][m][n], 0, 0, 0); } \
        __builtin_amdgcn_s_setprio(0); } while (0)
#define PG8_WAIT_V(n) asm volatile("s_waitcnt vmcnt(" #n ")" ::: "memory")
#define PG8_WAIT_L(n) asm volatile("s_waitcnt lgkmcnt(" #n ")" ::: "memory")
#define PG8_BAR __builtin_amdgcn_s_barrier()
#define PG8_SCHED __builtin_amdgcn_sched_barrier(0)
    Unit cur, nxt; int ui = 0;
    if (!S.next(0, cur)) return;
    Acc acc;
#pragma unroll
    for (int a = 0; a < 2; ++a)
#pragma unroll
        for (int b = 0; b < 2; ++b)
#pragma unroll
            for (int m = 0; m < 4; ++m)
#pragma unroll
                for (int n = 0; n < 2; ++n) acc[a][b][m][n] = (f32x4){0.f, 0.f, 0.f, 0.f};
    bf16x8 At[4][2], B0[2][2], B1[2][2]; v8i_t At8[4], B08[2], B18[2];
    const char* cA = cur.a; const char* cB = cur.b;
    PG8_STAGE(PG8_SB(0, 0), cB, voffB); PG8_STAGE(PG8_SB(0, 1), cB + hstepB, voffB); PG8_STAGE(PG8_SA(0, 0), cA, voffA); PG8_STAGE(PG8_SA(0, 1), cA + hstepA, voffA);
    if (wr == 1) PG8_BAR;
    PG8_WAIT_V(2); PG8_BAR;
    PG8_STAGE(PG8_SB(1, 0), cB + kstep, voffB); PG8_STAGE(PG8_SA(1, 0), cA + kstep, voffA); PG8_STAGE(PG8_SB(1, 1), cB + hstepB + kstep, voffB);
    PG8_WAIT_V(6); PG8_BAR;
    for (;;) {
        const bool has_next = S.next(ui + 1, nxt);
        const char* nA = has_next ? nxt.a : cA; const char* nB = has_next ? nxt.b : cB;
#pragma unroll 1
        for (int t = 0; t < nt; t += 2) {
            const bool last = (t == nt - 2);
            const char* a1 = cA + (size_t)(t + 1) * kstep;
            const char* a2 = last ? nA : cA + (size_t)(t + 2) * kstep; const char* b2 = last ? nB : cB + (size_t)(t + 2) * kstep;
            const char* a3 = a2 + kstep; const char* b3 = b2 + kstep;
            PG8_LDB(B0, 0, 0); PG8_LDB(B1, 0, 1); PG8_SCHED; PG8_LDA(At, 0, 0); PG8_STAGE(PG8_SA(1, 1), a1 + hstepA, voffA);
            PG8_WAIT_V(8); PG8_WAIT_L(0); PG8_BAR; PG8_MMA(0, 0, At, B0); PG8_MMA(0, 1, At, B1); PG8_BAR; PG8_SCHED;
            PG8_LDA(At, 0, 1); PG8_STAGE(PG8_SB(0, 0), b2, voffB); PG8_STAGE(PG8_SB(0, 1), b2 + hstepB, voffB); PG8_STAGE(PG8_SA(0, 0), a2, voffA);
            PG8_WAIT_V(8); PG8_WAIT_L(0); PG8_BAR; PG8_MMA(1, 0, At, B0); PG8_MMA(1, 1, At, B1); PG8_BAR; PG8_SCHED;
            PG8_LDB(B0, 1, 0); PG8_LDB(B1, 1, 1); PG8_SCHED; PG8_LDA(At, 1, 0); PG8_STAGE(PG8_SA(0, 1), a2 + hstepA, voffA);
            PG8_WAIT_V(8); PG8_WAIT_L(0); PG8_BAR; PG8_MMA(0, 0, At, B0); PG8_MMA(0, 1, At, B1); PG8_BAR; PG8_SCHED;
            PG8_LDA(At, 1, 1); PG8_STAGE(PG8_SB(1, 0), b3, voffB); PG8_STAGE(PG8_SB(1, 1), b3 + hstepB, voffB); PG8_STAGE(PG8_SA(1, 0), a3, voffA);
            PG8_WAIT_V(8); PG8_WAIT_L(0); PG8_BAR; PG8_MMA(1, 0, At, B0); PG8_MMA(1, 1, At, B1); PG8_BAR; PG8_SCHED;
        }
        if (wr == 0) PG8_BAR;
        E(acc, cur, cx);
        if (!has_next) break;
#pragma unroll
        for (int a = 0; a < 2; ++a)
#pragma unroll
            for (int b = 0; b < 2; ++b)
#pragma unroll
                for (int m = 0; m < 4; ++m)
#pragma unroll
                    for (int n = 0; n < 2; ++n) acc[a][b][m][n] = (f32x4){0.f, 0.f, 0.f, 0.f};
        cur = nxt; cA = nA; cB = nB; ++ui;
        if (wr == 1) PG8_BAR;
    }
    PG8_WAIT_V(0);
    PG8_BAR;
#undef PG8_SA
#undef PG8_SB
#undef PG8_SBL
#undef PG8_STAGE
#undef PG8_LDA
#undef PG8_LDB
#undef PG8_MMA
#undef PG8_CAT2
#undef PG8_RD
#undef PG8_WAIT_V
#undef PG8_WAIT_L
#undef PG8_BAR
#undef PG8_SCHED
}
}
namespace pg8 {
constexpr int NXCD = 8, WGM = 8;
struct DenseOrder {
    const char* A; const char* B; int nM, nN, nwg, G, c; size_t strideA, strideB;
    DI void init(const void* A_, const void* B_, int M, int N, int lda, int ldb, int G_, int c_) { A = (const char*)A_; B = (const char*)B_; nM = M / BM; nN = N / BM; nwg = nM * nN; G = G_; c = c_;
        strideA = (size_t)BM * lda * 2; strideB = (size_t)BM * ldb * 2; }
    DI bool next(int i, Unit& u) const {
        const long L = (long)i * G + c; if (L >= nwg) return false;
        int wgid = (int)L; { const int q = nwg / NXCD, r = nwg % NXCD, xcd = wgid % NXCD, off = wgid / NXCD; wgid = (xcd < r ? xcd * (q + 1) : r * (q + 1) + (xcd - r) * q) + off; }
        const int nig = WGM * nN, gid = wgid / nig, fm = gid * WGM, gsz = (nM - fm) < WGM ? (nM - fm) : WGM;
        u.pm = fm + ((wgid % nig) % gsz); u.pn = (wgid % nig) / gsz; u.aux = 0;
        u.a = A + (size_t)u.pm * strideA; u.b = B + (size_t)u.pn * strideB; return true;
    }
};
struct CrossSOrder {
    const char* Q; const char* Kc; int G, v;
    DI bool next(int i, Unit& u) const {
        const int L = i * G + v; if (L >= (T / 256) * XH) return false;
        u.pm = L >> 2; u.pn = L & 3; u.aux = 0;
        u.a = Q + ((size_t)u.pm * 256 * D + u.pn * 256) * 2; u.b = Kc + ((size_t)(u.pm >> 3) * 256 * D + u.pn * 256) * 2; return true;
    }
};
struct CrossOOrder {
    const char* P; const char* Vt; int G, v;
    DI bool next(int i, Unit& u) const {
        const int L = i * G + v; if (L >= (T / 256) * XH) return false;
        u.pm = L >> 2; u.pn = L & 3; u.aux = 0;
        u.a = P + ((size_t)u.pm * 256 * D + u.pn * 256) * 2; u.b = Vt + ((size_t)u.pn * 256 * (NB * NMEM) + (size_t)(u.pm >> 3) * 256) * 2; return true;
    }
};
struct MoeOrder {
    const char* A; const char* W; const LAS int* tstart; const LAS int* tile_e; int npn, G, v; size_t strideA, strideW, strideN;
    DI bool next(int i, Unit& u) const {
        const int L = i * G + v; const int total = __builtin_amdgcn_readfirstlane(tstart[NE]) * npn; if (L >= total) return false;
        const int tile = L / npn; u.pm = tile; u.pn = L - tile * npn;
        const int e = __builtin_amdgcn_readfirstlane(tile_e[tile]);
        u.aux = e;
        u.a = A + (size_t)tile * strideA; u.b = W + (size_t)e * strideW + (size_t)u.pn * strideN; return true;
    }
};

DI unsigned pk4_fp8(float a, float b, float c, float d) { int w = 0; w = __builtin_amdgcn_cvt_pk_fp8_f32(a, b, w, false); w = __builtin_amdgcn_cvt_pk_fp8_f32(c, d, w, true); return (unsigned)w; }
constexpr float F8_XS = 16.0f, F8_WS = 64.0f, F8_AS = 8.0f;
struct EpiBf16 {
    static constexpr bool PERM = true;
    bf16_t* O; int ldc; int sc_from; float scale;
    DI void operator()(const Acc& acc, const Unit& u, const Ctx& c) const {
        int row0 = u.pm * BM + c.wr * 64 + c.fr, col0 = u.pn * BM + c.wc * 32 + 8 * c.fq; asm volatile("" : "+v"(row0), "+v"(col0));
        const float sc = (u.pn >= sc_from) ? scale : 1.0f;
#pragma unroll
        for (int ai = 0; ai < 2; ++ai)
#pragma unroll
            for (int m = 0; m < 4; ++m) { bf16_t* rowp = O + (size_t)(row0 + ai * HALF + m * 16) * ldc + col0;
#pragma unroll
                for (int bj = 0; bj < 2; ++bj) { const f32x4 v0 = acc[ai][bj][m][0] * sc, v1 = acc[ai][bj][m][1] * sc;
                    u32x4 w; w.x = cvt_pk_bf16(v0[0], v0[1]); w.y = cvt_pk_bf16(v0[2], v0[3]); w.z = cvt_pk_bf16(v1[0], v1[1]); w.w = cvt_pk_bf16(v1[2], v1[3]);
                    *(u32x4*)(rowp + bj * HALF) = w; } }
    }
};
struct EpiProj {
    static constexpr bool PERM = true;
    bf16_t* O; float* gates;
    DI void operator()(const Acc& acc, const Unit& u, const Ctx& c) const {
        int row0 = u.pm * BM + c.wr * 64 + c.fr, col0 = u.pn * BM + c.wc * 32 + 8 * c.fq; asm volatile("" : "+v"(row0), "+v"(col0));
#pragma unroll
        for (int ai = 0; ai < 2; ++ai)
#pragma unroll
            for (int m = 0; m < 4; ++m) { const int row = row0 + ai * HALF + m * 16; bf16_t* rowp = O + (size_t)row * NPROJ + col0;
#pragma unroll
                for (int bj = 0; bj < 2; ++bj) { const f32x4 v0 = acc[ai][bj][m][0], v1 = acc[ai][bj][m][1];
                    u32x4 w; w.x = cvt_pk_bf16(v0[0], v0[1]); w.y = cvt_pk_bf16(v0[2], v0[3]); w.z = cvt_pk_bf16(v1[0], v1[1]); w.w = cvt_pk_bf16(v1[2], v1[3]);
                    *(u32x4*)(rowp + bj * HALF) = w; }
                if (u.pn == 1 && c.wc == 1 && c.fq == 0) { *(f32x4*)(gates + (size_t)row * 8) = acc[ai][1][m][0]; *(f32x4*)(gates + (size_t)row * 8 + 4) = acc[ai][1][m][1]; } }
    }
};
struct EpiQmla {
    static constexpr bool PERM = true;
    bf16_t* O; const float* cs;
    float scale;
    DI void operator()(const Acc& acc, const Unit& u, const Ctx& c) const {
        int row0 = u.pm * BM + c.wr * 64 + c.fr, col0 = u.pn * BM + c.wc * 32 + 8 * c.fq; asm volatile("" : "+v"(row0), "+v"(col0));
#pragma unroll
        for (int ai = 0; ai < 2; ++ai)
#pragma unroll
            for (int m = 0; m < 4; ++m) { const int row = row0 + ai * HALF + m * 16; bf16_t* rowp = O + (size_t)row * (AH * AQK) + col0;
#pragma unroll
                for (int bj = 0; bj < 2; ++bj) { f32x4 v0 = acc[ai][bj][m][0] * scale, v1 = acc[ai][bj][m][1] * scale;
                    const int cc = (col0 + bj * HALF) % AQK;
                    if (cc >= ANOPE) { const int p0 = (cc - ANOPE) >> 1;
                        const f32x4 t0 = *(const f32x4*)(cs + (size_t)row * 32 + p0 * 2), t1 = *(const f32x4*)(cs + (size_t)row * 32 + p0 * 2 + 4);
                        f32x4 r0, r1;
                        r0[0] = v0[0] * t0[0] - v0[1] * t0[1]; r0[1] = v0[1] * t0[0] + v0[0] * t0[1];
                        r0[2] = v0[2] * t0[2] - v0[3] * t0[3]; r0[3] = v0[3] * t0[2] + v0[2] * t0[3];
                        r1[0] = v1[0] * t1[0] - v1[1] * t1[1]; r1[1] = v1[1] * t1[0] + v1[0] * t1[1];
                        r1[2] = v1[2] * t1[2] - v1[3] * t1[3]; r1[3] = v1[3] * t1[2] + v1[2] * t1[3];
                        v0 = r0; v1 = r1; }
                    u32x4 w; w.x = cvt_pk_bf16(v0[0], v0[1]); w.y = cvt_pk_bf16(v0[2], v0[3]); w.z = cvt_pk_bf16(v1[0], v1[1]); w.w = cvt_pk_bf16(v1[2], v1[3]);
                    *(u32x4*)(rowp + bj * HALF) = w; } }
    }
};
template <bool ADD> struct EpiGate {
    static constexpr bool PERM = true;
    bf16_t* O; const bf16_t* proj; int gcol;
    DI void operator()(const Acc& acc, const Unit& u, const Ctx& c) const {
        int row0 = u.pm * BM + c.wr * 64 + c.fr, col0 = u.pn * BM + c.wc * 32 + 8 * c.fq; asm volatile("" : "+v"(row0), "+v"(col0));
#pragma unroll
        for (int ai = 0; ai < 2; ++ai) {
            u32x4 gg[4][2], pp[4][2];
#pragma unroll
            for (int m = 0; m < 4; ++m)
#pragma unroll
                for (int bj = 0; bj < 2; ++bj) { const int row = row0 + ai * HALF + m * 16; gg[m][bj] = *(const u32x4*)(proj + (size_t)row * NPROJ + gcol + col0 + bj * HALF);
                    if (ADD) pp[m][bj] = *(const u32x4*)(O + (size_t)row * D + col0 + bj * HALF); }
#pragma unroll
            for (int m = 0; m < 4; ++m) { const int row = row0 + ai * HALF + m * 16; bf16_t* rowp = O + (size_t)row * D + col0;
#pragma unroll
                for (int bj = 0; bj < 2; ++bj) { const f32x4 v0 = acc[ai][bj][m][0], v1 = acc[ai][bj][m][1];
                    const u32x4 g = gg[m][bj];
                    float o[8];
                    o[0] = sigmoidf_(bflo(g.x)) * v0[0]; o[1] = sigmoidf_(bfhi(g.x)) * v0[1]; o[2] = sigmoidf_(bflo(g.y)) * v0[2]; o[3] = sigmoidf_(bfhi(g.y)) * v0[3];
                    o[4] = sigmoidf_(bflo(g.z)) * v1[0]; o[5] = sigmoidf_(bfhi(g.z)) * v1[1]; o[6] = sigmoidf_(bflo(g.w)) * v1[2]; o[7] = sigmoidf_(bfhi(g.w)) * v1[3];
                    if (ADD) { const u32x4 p = pp[m][bj];
                        o[0] += bflo(p.x); o[1] += bfhi(p.x); o[2] += bflo(p.y); o[3] += bfhi(p.y); o[4] += bflo(p.z); o[5] += bfhi(p.z); o[6] += bflo(p.w); o[7] += bfhi(p.w); }
                    u32x4 w; w.x = cvt_pk_bf16(o[0], o[1]); w.y = cvt_pk_bf16(o[2], o[3]); w.z = cvt_pk_bf16(o[4], o[5]); w.w = cvt_pk_bf16(o[6], o[7]);
                    *(u32x4*)(rowp + bj * HALF) = w; } }
            __builtin_amdgcn_sched_barrier(0); }
    }
};
struct EpiF32 {
    static constexpr bool PERM = false;
    float* C; int ldc; int ncols_valid;
    DI void operator()(const Acc& acc, const Unit& u, const Ctx& c) const {
        int row0 = u.pm * BM + c.wr * 64 + c.fr, col0 = u.pn * BM + c.wc * 32 + 4 * c.fq; asm volatile("" : "+v"(row0), "+v"(col0));
#pragma unroll
        for (int ai = 0; ai < 2; ++ai)
#pragma unroll
            for (int m = 0; m < 4; ++m) { float* rowp = C + (size_t)(row0 + ai * HALF + m * 16) * ldc + col0;
#pragma unroll
                for (int bj = 0; bj < 2; ++bj)
#pragma unroll
                    for (int n = 0; n < 2; ++n) if (col0 + bj * HALF + n * 16 < ncols_valid) *(f32x4*)(rowp + bj * HALF + n * 16) = acc[ai][bj][m][n]; }
    }
};

DI void row_stats(const float* stats, int row, float& mean, float& rstd) { const f32x2 st = *(const f32x2*)(stats + (size_t)row * 2);
    mean = st[0] * (1.0f / D); const float var = fmaxf(st[1] * (1.0f / D) - mean * mean, 0.f); rstd = __builtin_amdgcn_rsqf(var + EPS); }
template <bool NORM> struct EpiResStats {
    static constexpr bool PERM = true;
    const bf16_t* res; const float* pstats; const float* pg; const float* pb; bf16_t* VB; float* stats;
    DI void operator()(const Acc& acc, const Unit& u, const Ctx& c) const {
        int row0 = u.pm * BM + c.wr * 64 + c.fr, col0 = u.pn * BM + c.wc * 32 + 8 * c.fq; asm volatile("" : "+v"(row0), "+v"(col0));
#pragma unroll
        for (int ai = 0; ai < 2; ++ai) {
            u32x4 rr[4][2];
#pragma unroll
            for (int m = 0; m < 4; ++m)
#pragma unroll
                for (int bj = 0; bj < 2; ++bj) rr[m][bj] = *(const u32x4*)(res + (size_t)(row0 + ai * HALF + m * 16) * D + col0 + bj * HALF);
#pragma unroll
            for (int m = 0; m < 4; ++m) { const int row = row0 + ai * HALF + m * 16; const size_t ro = (size_t)row * D + col0;
                float mean = 0.f, rstd = 1.f; if (NORM) row_stats(pstats, row, mean, rstd);
                float s1 = 0.f, s2 = 0.f;
#pragma unroll
                for (int bj = 0; bj < 2; ++bj) { const u32x4 w = rr[m][bj];
                    f32x4 r0 = {bflo(w.x), bfhi(w.x), bflo(w.y), bfhi(w.y)}, r1 = {bflo(w.z), bfhi(w.z), bflo(w.w), bfhi(w.w)};
                    if (NORM) { const f32x4 g0 = *(const f32x4*)(pg + col0 + bj * HALF), g1 = *(const f32x4*)(pg + col0 + bj * HALF + 4), b0 = *(const f32x4*)(pb + col0 + bj * HALF), b1 = *(const f32x4*)(pb + col0 + bj * HALF + 4);
                        r0 = (r0 - mean) * rstd * g0 + b0; r1 = (r1 - mean) * rstd * g1 + b1; }
                    const f32x4 v0 = r0 * DN_ALPHA + acc[ai][bj][m][0], v1 = r1 * DN_ALPHA + acc[ai][bj][m][1];
                    u32x4 o; o.x = cvt_pk_bf16(v0[0], v0[1]); o.y = cvt_pk_bf16(v0[2], v0[3]); o.z = cvt_pk_bf16(v1[0], v1[1]); o.w = cvt_pk_bf16(v1[2], v1[3]);
                    *(u32x4*)(VB + ro + bj * HALF) = o;
                    s1 += (v0[0] + v0[1]) + (v0[2] + v0[3]) + (v1[0] + v1[1]) + (v1[2] + v1[3]);
                    s2 += (v0[0] * v0[0] + v0[1] * v0[1]) + (v0[2] * v0[2] + v0[3] * v0[3]) + (v1[0] * v1[0] + v1[1] * v1[1]) + (v1[2] * v1[2] + v1[3] * v1[3]); }
                s1 += __shfl_xor(s1, 16); s1 += __shfl_xor(s1, 32); s2 += __shfl_xor(s2, 16); s2 += __shfl_xor(s2, 32);
                if (c.fq == 0) { __hip_atomic_fetch_add(stats + (size_t)row * 2, s1, RLX_AGENT); __hip_atomic_fetch_add(stats + (size_t)row * 2 + 1, s2, RLX_AGENT); } }
            __builtin_amdgcn_sched_barrier(0); }
    }
};
struct EpiLNApplyBf16 {
    static constexpr bool PERM = true;
    bf16_t* O; int ldc; const float* stats; const float* cs; const float* cb; float scale;
    DI void operator()(const Acc& acc, const Unit& u, const Ctx& c) const {
        int row0 = u.pm * BM + c.wr * 64 + c.fr, col0 = u.pn * BM + c.wc * 32 + 8 * c.fq; asm volatile("" : "+v"(row0), "+v"(col0));
        f32x4 csv[2][2], cbv[2][2];
#pragma unroll
        for (int bj = 0; bj < 2; ++bj)
#pragma unroll
            for (int n = 0; n < 2; ++n) { csv[bj][n] = *(const f32x4*)(cs + col0 + bj * HALF + 4 * n); cbv[bj][n] = *(const f32x4*)(cb + col0 + bj * HALF + 4 * n); }
        f32x2 sts[2][4];
#pragma unroll
        for (int ai = 0; ai < 2; ++ai)
#pragma unroll
            for (int m = 0; m < 4; ++m) sts[ai][m] = *(const f32x2*)(stats + (size_t)(row0 + ai * HALF + m * 16) * 2);
#pragma unroll
        for (int ai = 0; ai < 2; ++ai)
#pragma unroll
            for (int m = 0; m < 4; ++m) { const int row = row0 + ai * HALF + m * 16; const float mean = sts[ai][m][0] * (1.0f / D); const float rstd = __builtin_amdgcn_rsqf(fmaxf(sts[ai][m][1] * (1.0f / D) - mean * mean, 0.f) + EPS);
                bf16_t* rowp = O + (size_t)row * ldc + col0;
#pragma unroll
                for (int bj = 0; bj < 2; ++bj) { const f32x4 v0 = ((acc[ai][bj][m][0] - csv[bj][0] * mean) * rstd + cbv[bj][0]) * scale, v1 = ((acc[ai][bj][m][1] - csv[bj][1] * mean) * rstd + cbv[bj][1]) * scale;
                    u32x4 w; w.x = cvt_pk_bf16(v0[0], v0[1]); w.y = cvt_pk_bf16(v0[2], v0[3]); w.z = cvt_pk_bf16(v1[0], v1[1]); w.w = cvt_pk_bf16(v1[2], v1[3]);
                    *(u32x4*)(rowp + bj * HALF) = w; } }
    }
};
struct EpiLNApplyF32 {
    static constexpr bool PERM = false;
    float* C; int ldc; int ncols_valid; const float* stats; const float* cs; const float* cb;
    DI void operator()(const Acc& acc, const Unit& u, const Ctx& c) const {
        int row0 = u.pm * BM + c.wr * 64 + c.fr, col0 = u.pn * BM + c.wc * 32 + 4 * c.fq; asm volatile("" : "+v"(row0), "+v"(col0));
#pragma unroll
        for (int ai = 0; ai < 2; ++ai)
#pragma unroll
            for (int m = 0; m < 4; ++m) { const int row = row0 + ai * HALF + m * 16; float mean, rstd; row_stats(stats, row, mean, rstd);
                float* rowp = C + (size_t)row * ldc + col0;
#pragma unroll
                for (int bj = 0; bj < 2; ++bj)
#pragma unroll
                    for (int n = 0; n < 2; ++n) if (col0 + bj * HALF + n * 16 < ncols_valid) { const f32x4 csv = *(const f32x4*)(cs + col0 + bj * HALF + n * 16), cbv = *(const f32x4*)(cb + col0 + bj * HALF + n * 16);
                        *(f32x4*)(rowp + bj * HALF + n * 16) = (acc[ai][bj][m][n] - csv * mean) * rstd + cbv; } }
    }
};
struct EpiSoftmax {
    static constexpr bool PERM = true;
    bf16_t* O; LAS float* red;
    DI void operator()(Acc& acc, const Unit& u, const Ctx& c) const {
        int row0 = u.pm * BM + c.wr * 64 + c.fr, col0 = u.pn * BM + c.wc * 32 + 8 * c.fq; asm volatile("" : "+v"(row0), "+v"(col0));
        int rbase = (c.wr * 64 + c.fr) * 4; asm volatile("" : "+v"(rbase));
        LAS float* r1 = red + rbase; LAS float* r2 = red + 1024 + rbase;
#pragma unroll
        for (int ai = 0; ai < 2; ++ai)
#pragma unroll
            for (int m = 0; m < 4; ++m) { float v = -INFINITY;
#pragma unroll
                for (int bj = 0; bj < 2; ++bj)
#pragma unroll
                    for (int n = 0; n < 2; ++n) { const f32x4 x = acc[ai][bj][m][n]; v = fmaxf(v, fmaxf(fmaxf(x[0], x[1]), fmaxf(x[2], x[3]))); }
                v = fmaxf(v, __shfl_xor(v, 16)); v = fmaxf(v, __shfl_xor(v, 32));
                if (c.fq == 0) r1[(ai * HALF + m * 16) * 4 + c.wc] = v;
                __builtin_amdgcn_sched_barrier(0); }
        asm volatile("s_waitcnt lgkmcnt(0)" ::: "memory"); __builtin_amdgcn_s_barrier(); asm volatile("" ::: "memory");
#pragma unroll
        for (int ai = 0; ai < 2; ++ai)
#pragma unroll
            for (int m = 0; m < 4; ++m) { const f32x4 q = *(const LAS f32x4*)(r1 + (ai * HALF + m * 16) * 4);
                const float mm = fmaxf(fmaxf(q[0], q[1]), fmaxf(q[2], q[3])); float s = 0.f;
#pragma unroll
                for (int bj = 0; bj < 2; ++bj)
#pragma unroll
                    for (int n = 0; n < 2; ++n) { f32x4 x = acc[ai][bj][m][n];
                        x[0] = __builtin_amdgcn_exp2f(x[0] - mm); x[1] = __builtin_amdgcn_exp2f(x[1] - mm); x[2] = __builtin_amdgcn_exp2f(x[2] - mm); x[3] = __builtin_amdgcn_exp2f(x[3] - mm);
                        acc[ai][bj][m][n] = x; s += (x[0] + x[1]) + (x[2] + x[3]); }
                s += __shfl_xor(s, 16); s += __shfl_xor(s, 32);
                if (c.fq == 0) r2[(ai * HALF + m * 16) * 4 + c.wc] = s;
                __builtin_amdgcn_sched_barrier(0); }
        asm volatile("s_waitcnt lgkmcnt(0)" ::: "memory"); __builtin_amdgcn_s_barrier(); asm volatile("" ::: "memory");
#pragma unroll
        for (int ai = 0; ai < 2; ++ai)
#pragma unroll
            for (int m = 0; m < 4; ++m) { const f32x4 q = *(const LAS f32x4*)(r2 + (ai * HALF + m * 16) * 4);
                const float inv = rcpf_((q[0] + q[1]) + (q[2] + q[3]));
                bf16_t* rowp = O + (size_t)(row0 + ai * HALF + m * 16) * D + col0;
#pragma unroll
                for (int bj = 0; bj < 2; ++bj) { const f32x4 v0 = acc[ai][bj][m][0] * inv, v1 = acc[ai][bj][m][1] * inv;
                    u32x4 w; w.x = cvt_pk_bf16(v0[0], v0[1]); w.y = cvt_pk_bf16(v0[2], v0[3]); w.z = cvt_pk_bf16(v1[0], v1[1]); w.w = cvt_pk_bf16(v1[2], v1[3]);
                    *(u32x4*)(rowp + bj * HALF) = w; }
                __builtin_amdgcn_sched_barrier(0); }
    }
};
struct EpiSwiglu {
    static constexpr bool PERM = true;
    unsigned char* O; const float* bias;
    DI void operator()(const Acc& acc, const Unit& u, const Ctx& c) const {
        int row0 = u.pm * BM + c.wr * 64 + c.fr, col0 = u.pn * BM + c.wc * 32 + 8 * c.fq; asm volatile("" : "+v"(row0), "+v"(col0));
        constexpr float us = 1.0f / (F8_XS * F8_WS);
        f32x4 bv[2][2];
#pragma unroll
        for (int bj = 0; bj < 2; ++bj)
#pragma unroll
            for (int n = 0; n < 2; ++n) bv[bj][n] = *(const f32x4*)(bias + (size_t)u.aux * 2048 + col0 + bj * HALF + 4 * n);
#pragma unroll
        for (int ai = 0; ai < 2; ++ai)
#pragma unroll
            for (int m = 0; m < 4; ++m) { unsigned char* rowp = O + (size_t)(row0 + ai * HALF + m * 16) * 1024 + (col0 >> 1);
#pragma unroll
                for (int bj = 0; bj < 2; ++bj) { const f32x4 v0 = acc[ai][bj][m][0] * us + bv[bj][0], v1 = acc[ai][bj][m][1] * us + bv[bj][1];
                    float o[4];
#define SWG(g, l) ({ const float g_ = fminf((g), 7.0f), l_ = fminf(fmaxf((l), -7.0f), 7.0f); fminf(fmaxf(g_ * sigmoidf_(1.702f * g_) * (l_ + 1.0f) * F8_AS, -448.0f), 448.0f); })
                    o[0] = SWG(v0[0], v0[1]); o[1] = SWG(v0[2], v0[3]); o[2] = SWG(v1[0], v1[1]); o[3] = SWG(v1[2], v1[3]);
#undef SWG
                    *(unsigned*)(rowp + bj * (HALF / 2)) = pk4_fp8(o[0], o[1], o[2], o[3]); } }
    }
};
struct EpiDown {
    static constexpr bool PERM = true;
    bf16_t* O; const float* bias; const float* rowgate;
    DI void operator()(const Acc& acc, const Unit& u, const Ctx& c) const {
        int row0 = u.pm * BM + c.wr * 64 + c.fr, col0 = u.pn * BM + c.wc * 32 + 8 * c.fq; asm volatile("" : "+v"(row0), "+v"(col0));
        f32x4 bv[2][2];
#pragma unroll
        for (int bj = 0; bj < 2; ++bj)
#pragma unroll
            for (int n = 0; n < 2; ++n) bv[bj][n] = *(const f32x4*)(bias + (size_t)u.aux * 1024 + col0 + bj * HALF + 4 * n);
#pragma unroll
        for (int ai = 0; ai < 2; ++ai) { float gts[4];
#pragma unroll
            for (int m = 0; m < 4; ++m) gts[m] = rowgate[row0 + ai * HALF + m * 16];
#pragma unroll
            for (int m = 0; m < 4; ++m) { const int row = row0 + ai * HALF + m * 16; const float gt = gts[m]; bf16_t* rowp = O + (size_t)row * 1024 + col0;
#pragma unroll
                for (int bj = 0; bj < 2; ++bj) { const f32x4 v0 = (acc[ai][bj][m][0] * (1.0f / (F8_AS * F8_WS)) + bv[bj][0]) * gt, v1 = (acc[ai][bj][m][1] * (1.0f / (F8_AS * F8_WS)) + bv[bj][1]) * gt;
                    u32x4 w; w.x = cvt_pk_bf16(v0[0], v0[1]); w.y = cvt_pk_bf16(v0[2], v0[3]); w.z = cvt_pk_bf16(v1[0], v1[1]); w.w = cvt_pk_bf16(v1[2], v1[3]);
                    *(u32x4*)(rowp + bj * HALF) = w; } } }
    }
};
}
constexpr size_t MiB = 1u << 20;
constexpr size_t WS_CTL = 0, CTL_ZERO_BYTES = 1 * MiB;
constexpr size_t WS_W_IN = 2 * MiB, WS_W_UQ = 10 * MiB, WS_W_UK = WS_W_UQ + 512 * 1024, WS_W_UV = WS_W_UK + 256 * 1024, WS_W_MQK = 11 * MiB, WS_W_BRM = 12 * MiB, WS_W_BRA = 13 * MiB,
                 WS_W_MIX = 14 * MiB, WS_W_CQ = 16 * MiB, WS_W_CK = 18 * MiB, WS_W_CV = 20 * MiB, WS_W_CO = 22 * MiB, WS_W_R = 24 * MiB, WS_W_GU = 26 * MiB, WS_W_DN = 90 * MiB;
constexpr size_t WS_GATES = 218 * MiB, WS_CS = 219 * MiB, WS_KPE = 223 * MiB, WS_MEMB = 225 * MiB, WS_KC = 233 * MiB, WS_VCT = 241 * MiB, WS_LOGITS = 249 * MiB,
                 WS_ASSIGN = 253 * MiB, WS_GATEW = WS_ASSIGN + 512 * 1024, WS_TOKPOS = 254 * MiB, WS_ROWGATE = WS_TOKPOS + 512 * 1024;
constexpr size_t WS_XB = 256 * MiB, WS_PROJ = 320 * MiB, WS_QN = 576 * MiB, WS_KVN = 592 * MiB, WS_XC = 608 * MiB, WS_QMLA = 640 * MiB, WS_KN = 688 * MiB, WS_VT = 720 * MiB,
                 WS_QKM = 752 * MiB, WS_KTM = 816 * MiB, WS_AO = 848 * MiB, WS_HRAW = 880 * MiB, WS_HM = 944 * MiB;
constexpr size_t WS_GATED = 576 * MiB, WS_V1B = 704 * MiB, WS_QC = 384 * MiB, WS_PC = 448 * MiB, WS_OC = 320 * MiB, WS_V2B = 864 * MiB;
constexpr size_t WS_XG = 320 * MiB, WS_ACT = 456 * MiB, WS_YB = 592 * MiB, WS_END = 976 * MiB;
static_assert((size_t)NROWS * 1024 * 2 <= 272 * MiB, "routed buffers");
static_assert(WS_ROWGATE + (size_t)NROWS * 4 <= 256 * MiB, "small buffers");
constexpr int CW_TMO = 0, CW_CNT = 64  , CW_BAR = 4096;
constexpr size_t CTL_CS1 = 64 * 1024, CTL_CB1 = 68 * 1024, CTL_CSR = 72 * 1024, CTL_CBR = 73 * 1024;
constexpr size_t CTL_STATS1 = 256 * 1024, CTL_STATS2 = 512 * 1024;

constexpr int RING_OFF = 0, RING_BYTES = 131072;
constexpr int RED_OFF = RING_BYTES;
constexpr int TST_OFF = RED_OFF + 8192;
constexpr int HIST_OFF = TST_OFF + 256, HBASE_OFF = HIST_OFF + 128;
constexpr int MISC_OFF = HBASE_OFF + 128;
constexpr int TILE_E_OFF = MISC_OFF + 128;
constexpr int LDSCTL_OFF = TST_OFF;
constexpr int LDS_BYTES = 147456;
static_assert(TILE_E_OFF + NTILES_MAX * 4 <= LDS_BYTES, "LDS map");
constexpr int NWAVES = 8;

#define LDS_WAIT() asm volatile("s_waitcnt lgkmcnt(0)" ::: "memory")
#define VM_WAIT() asm volatile("s_waitcnt vmcnt(0)" ::: "memory")

#define XB_TMO      128
#define XB_XCNT(j)  (256  + 64 * (j))
#define XB_XSUB(j)  (1280 + 64 * (j))
#define XB_XGEN(j)  (2304 + 64 * (j))
#define XB_TOP      3328
#define XB_TOPGEN   3392
#define XCD_BAR_WORDS 3456
#define XB_SPIN_CAP (1u << 18)
__device__ __forceinline__ unsigned xb_ld(unsigned* p)              { return __hip_atomic_load(p, __ATOMIC_RELAXED, __HIP_MEMORY_SCOPE_AGENT); }
__device__ __forceinline__ unsigned xb_add(unsigned* p, unsigned v) { return __hip_atomic_fetch_add(p, v, __ATOMIC_RELAXED, __HIP_MEMORY_SCOPE_AGENT); }
__device__ __forceinline__ unsigned xb_xcc_id() { return (unsigned)__builtin_amdgcn_s_getreg((3 << 11) | 20) & 0xFu; }
#define XB_SPIN(cond, bar) do { unsigned _sp = 0; while (cond) { __builtin_amdgcn_s_sleep(1); \
    if ((++_sp & 255u) == 0u) { if (xb_ld(&(bar)[XB_TMO])) break; if (_sp > XB_SPIN_CAP) { atomicAdd(&(bar)[XB_TMO], 1u); break; } } } } while (0)
struct XcdBarrier { unsigned* bar; unsigned x; volatile LAS unsigned* st; };
__device__ __forceinline__ XcdBarrier xcd_barrier_post(unsigned* bar, volatile LAS unsigned* st) {
    XcdBarrier b; b.bar = bar; b.x = xb_xcc_id(); b.st = st;
    if (threadIdx.x == 0) (void)xb_add(&bar[XB_XCNT(b.x)], 1u);
    return b;
}
__device__ __forceinline__ void xcd_barrier_complete(unsigned* bar, unsigned x, unsigned& nloc, unsigned& nx) {
    const unsigned G = gridDim.x * gridDim.y * gridDim.z;
    unsigned sum, cnt, mine, sp = 0u;
    for (;;) {
        sum = 0u; cnt = 0u; mine = 0u;
#pragma unroll
        for (unsigned j = 0; j < 16; ++j) { const unsigned c = xb_ld(&bar[XB_XCNT(j)]); sum += c; cnt += (c > 0u) ? 1u : 0u; mine = (j == x) ? c : mine; }
        if (sum == G) break;
        __builtin_amdgcn_s_sleep(1);
        if ((++sp & 255u) == 0u) { if (xb_ld(&bar[XB_TMO])) break; if (sp > XB_SPIN_CAP) { atomicAdd(&bar[XB_TMO], 1u); break; } }
    }
    nloc = mine > 0u ? mine : 1u; nx = cnt > 0u ? cnt : 1u;
}
__device__ __forceinline__ void xcd_barrier(const XcdBarrier& b) {
    asm volatile("s_waitcnt vmcnt(0)" ::: "memory");
    __syncthreads();
    if (threadIdx.x == 0) {
        unsigned* bar = b.bar;
        __builtin_amdgcn_s_waitcnt(0);
        unsigned nloc = b.st[0], nx = b.st[1];
        if (nloc == 0u) { xcd_barrier_complete(bar, b.x, nloc, nx); b.st[0] = nloc; b.st[1] = nx; }
        const unsigned old = xb_add(&bar[XB_XSUB(b.x)], 1u);
        const unsigned gen = old / nloc;
        if (old + 1u == (gen + 1u) * nloc) {
            __builtin_amdgcn_fence(__ATOMIC_RELEASE, "agent");
            asm volatile("s_waitcnt vmcnt(0)" ::: "memory");
            const unsigned og = xb_add(&bar[XB_TOP], 1u);
            const unsigned tg = og / nx;
            if (og + 1u == (tg + 1u) * nx) xb_add(&bar[XB_TOPGEN], 1u);
            else XB_SPIN(xb_ld(&bar[XB_TOPGEN]) == tg, bar);
            __builtin_amdgcn_fence(__ATOMIC_ACQUIRE, "agent");
            xb_add(&bar[XB_XGEN(b.x)], 1u);
            asm volatile("s_waitcnt vmcnt(0)" ::: "memory");
        } else {
            XB_SPIN(xb_ld(&bar[XB_XGEN(b.x)]) == gen, bar);
            __builtin_amdgcn_fence(__ATOMIC_ACQUIRE, "agent");
            asm volatile("s_waitcnt vmcnt(0)" ::: "memory");
        }
    }
    __syncthreads();
}

struct Args { const void* in[34]; float* out; unsigned char* ws; int ph_lo, ph_hi; };

DI void tr_item(const float* W, int ldw, int kvalid, bf16_t* WT, int ldk, int n0, int k0, int sc, LAS float* scr, int lane, const float* rs = nullptr) {
#pragma unroll 8
    for (int i = 0; i < 32; ++i) { const int kk = 2 * i + (lane >> 5); const int k = k0 + kk;
        float v = 0.f; if (sc >= 0 && k < kvalid) { v = W[(size_t)k * ldw + sc]; if (rs) v *= rs[k]; }
        scr[kk * 33 + (lane & 31)] = v; }
    LDS_WAIT(); asm volatile("" ::: "memory");
    const int c = lane & 7;
#pragma unroll
    for (int j = 0; j < 4; ++j) { const int n = (lane >> 3) + 8 * j; const LAS float* s = scr + (8 * c) * 33 + n;
        u32x4 o; o.x = pk2(s[0 * 33], s[1 * 33]); o.y = pk2(s[2 * 33], s[3 * 33]); o.z = pk2(s[4 * 33], s[5 * 33]); o.w = pk2(s[6 * 33], s[7 * 33]);
        *(GAS u32x4*)(WT + (size_t)(n0 + n) * ldk + k0 + 8 * c) = o; }
    LDS_WAIT(); asm volatile("" ::: "memory");
}

DI void tr_item_v4(const float* W, int ldw, bf16_t* WT, int ldk, int n0, int k0, int c0, LAS float* scr, int lane, const float* rs = nullptr) {
    const int kr = lane >> 3, n4 = lane & 7;
    f32x4 v[8];
#pragma unroll
    for (int i = 0; i < 8; ++i) v[i] = *(const f32x4*)(W + (size_t)(k0 + i * 8 + kr) * ldw + c0 + 4 * n4);
    if (rs) {
#pragma unroll
        for (int i = 0; i < 8; ++i) v[i] = v[i] * rs[k0 + i * 8 + kr]; }
#pragma unroll
    for (int i = 0; i < 8; ++i) { LAS float* p = scr + (i * 8 + kr) * 33 + 4 * n4; p[0] = v[i][0]; p[1] = v[i][1]; p[2] = v[i][2]; p[3] = v[i][3]; }
    LDS_WAIT(); asm volatile("" ::: "memory");
    const int c = lane & 7;
#pragma unroll
    for (int j = 0; j < 4; ++j) { const int n = (lane >> 3) + 8 * j; const LAS float* s = scr + (8 * c) * 33 + n;
        u32x4 o; o.x = pk2(s[0 * 33], s[1 * 33]); o.y = pk2(s[2 * 33], s[3 * 33]); o.z = pk2(s[4 * 33], s[5 * 33]); o.w = pk2(s[6 * 33], s[7 * 33]);
        *(GAS u32x4*)(WT + (size_t)(n0 + n) * ldk + k0 + 8 * c) = o; }
    LDS_WAIT(); asm volatile("" ::: "memory");
}

DI void tr_item_v4_fp8(const float* W, int ldw, unsigned char* WT, int ldk, int n0, int k0, int c0, float sc, LAS float* scr, int lane) {
    const int kr = lane >> 3, n4 = lane & 7;
    f32x4 v[8];
#pragma unroll
    for (int i = 0; i < 8; ++i) v[i] = *(const f32x4*)(W + (size_t)(k0 + i * 8 + kr) * ldw + c0 + 4 * n4);
#pragma unroll
    for (int i = 0; i < 8; ++i) { LAS float* p = scr + (i * 8 + kr) * 33 + 4 * n4; p[0] = v[i][0] * sc; p[1] = v[i][1] * sc; p[2] = v[i][2] * sc; p[3] = v[i][3] * sc; }
    LDS_WAIT(); asm volatile("" ::: "memory");
    const int c = lane & 7;
#pragma unroll
    for (int j = 0; j < 4; ++j) { const int n = (lane >> 3) + 8 * j; const LAS float* s = scr + (8 * c) * 33 + n;
        u32x2 o; o.x = pg8::pk4_fp8(s[0 * 33], s[1 * 33], s[2 * 33], s[3 * 33]); o.y = pg8::pk4_fp8(s[4 * 33], s[5 * 33], s[6 * 33], s[7 * 33]);
        *(GAS u32x2*)(WT + (size_t)(n0 + n) * ldk + k0 + 8 * c) = o; }
    LDS_WAIT(); asm volatile("" ::: "memory");
}
DI int win_src(int n) {
    if (n < 384) return n;
    if (n < 416) { const int i = (n - 384) >> 1; return 384 + i + 16 * ((n - 384) & 1); }
    if (n < 424) return 1952 + (n - 416);
    if (n < 512) return -1;
    if (n < 2048) return 416 + (n - 512);
    return 1960 + (n - 2048);
}
DI void p0_prologue(const Args& args, LAS unsigned char* lds, int vcu, int G) {
    int tid_ = threadIdx.x; asm volatile("" : "+v"(tid_)); const int lane = tid_ & 63; const int wave = __builtin_amdgcn_readfirstlane(tid_ >> 6);
    LAS float* scr = (LAS float*)(lds + RING_OFF + wave * 16384);
    const int gw = vcu * NWAVES + wave, NGW = G * NWAVES;
    unsigned char* ws = args.ws;
    const int j = lane & 31;
    constexpr int I_IN = 16 * 128, I_UQ = 4 * 24, I_UK = 4 * 16, I_UV = 4 * 16, I_MQK = 8 * 32, I_BRM = 8 * 32, I_BRA = 8 * 32, I_SQ = 16 * 32, I_R = 16 * 8,
                  I_GU = NE * 16 * 64, I_DN = NE * 16 * 32;
    constexpr int NITEMS = I_IN + I_UQ + I_UK + I_UV + I_MQK + I_BRM + I_BRA + 5 * I_SQ + I_R + I_GU + I_DN;
    for (int it = gw; it < 33 * 8; it += NGW) { const int grp = it >> 3, kc = it & 7; const bool rt = (grp == 32);
        const float* W = (const float*)args.in[rt ? 26 : 21]; const int ldw = rt ? NE : 1024; const int col = (rt ? 0 : grp * 32) + (lane & 31);
        const float* gv = (const float*)args.in[rt ? 24 : 19]; const float* bv = (const float*)args.in[rt ? 25 : 20];
        float as = 0.f, ab = 0.f;
#pragma unroll 8
        for (int i = 0; i < 64; ++i) { const int k = kc * 128 + 2 * i + (lane >> 5); const float w = W[(size_t)k * ldw + col]; as += bf2f((unsigned short)f2bf(gv[k] * w)); ab += bv[k] * w; }
        as += __shfl_xor(as, 32); ab += __shfl_xor(ab, 32);
        if (lane < 32) { float* csd = (float*)(ws + (rt ? CTL_CSR : CTL_CS1)) + col; float* cbd = (float*)(ws + (rt ? CTL_CBR : CTL_CB1)) + col;
            __hip_atomic_fetch_add(csd, as, RLX_AGENT); __hip_atomic_fetch_add(cbd, ab, RLX_AGENT); } }
    for (int it = gw; it < NITEMS; it += NGW) {
        int r = it;
        if (r < I_GU) { const int e = r / (16 * 64), q = r % (16 * 64), kb = q / 64, nb = q % 64;
            tr_item_v4_fp8((const float*)args.in[28] + (size_t)e * 1024 * 2048, 2048, ws + WS_W_GU + (size_t)e * 2048 * 1024, 1024, nb * 32, kb * 64, nb * 32, pg8::F8_WS, scr, lane); continue; } r -= I_GU;
        if (r < I_DN) { const int e = r / (16 * 32), q = r % (16 * 32), kb = q / 32, nb = q % 32;
            tr_item_v4_fp8((const float*)args.in[30] + (size_t)e * 1024 * 1024, 1024, ws + WS_W_DN + (size_t)e * 1024 * 1024, 1024, nb * 32, kb * 64, nb * 32, pg8::F8_WS, scr, lane); continue; } r -= I_DN;
        if (r < I_IN) { const int kb = r / 128, nb = r % 128;
            tr_item((const float*)args.in[3], DIN, 1024, (bf16_t*)(ws + WS_W_IN), 1024, nb * 32, kb * 64, win_src(nb * 32 + j), scr, lane); continue; } r -= I_IN;
        if (r < I_UQ) { const int kb = r / 24, nb = r % 24; const int n = nb * 32 + j, hh = n / AQK, cc = n % AQK;
            const int sc = (cc < ANOPE) ? n : hh * AQK + ANOPE + ((cc - ANOPE) >> 1) + 16 * ((cc - ANOPE) & 1);
            tr_item((const float*)args.in[14], AH * AQK, 256, (bf16_t*)(ws + WS_W_UQ), 256, nb * 32, kb * 64, sc, scr, lane); continue; } r -= I_UQ;
        if (r < I_UK) { const int kb = r / 16, nb = r % 16; const int n = nb * 32 + j;
            tr_item((const float*)args.in[15], 1024, 128, (bf16_t*)(ws + WS_W_UK), 256, nb * 32, kb * 64, (n >> 6) * 128 + (n & 63), scr, lane); continue; } r -= I_UK;
        if (r < I_UV) { const int kb = r / 16, nb = r % 16; const int n = nb * 32 + j;
            tr_item((const float*)args.in[15], 1024, 128, (bf16_t*)(ws + WS_W_UV), 256, nb * 32, kb * 64, (n >> 6) * 128 + 64 + (n & 63), scr, lane); continue; } r -= I_UV;
        if (r < I_MQK) { const int kb = r / 32, nb = r % 32; const int n = nb * 32 + j, part = n >> 9, hh = (n >> 7) & 3, e = n & 127;
            const float* src = (const float*)args.in[part ? 9 : 8];
            tr_item(src, 128, 512, (bf16_t*)(ws + WS_W_MQK), 512, nb * 32, kb * 64, ((kb >> 1) == hh) ? e : -1, scr, lane); continue; } r -= I_MQK;
        if (r < I_BRM) { const int kb = r / 32, nb = r % 32;
            tr_item_v4((const float*)args.in[16], 1024, (bf16_t*)(ws + WS_W_BRM), 512, nb * 32, kb * 64, nb * 32, scr, lane); continue; } r -= I_BRM;
        if (r < I_BRA) { const int kb = r / 32, nb = r % 32;
            tr_item_v4((const float*)args.in[17], 1024, (bf16_t*)(ws + WS_W_BRA), 512, nb * 32, kb * 64, nb * 32, scr, lane); continue; } r -= I_BRA;
        if (r < 5 * I_SQ) { const int w = r / I_SQ, q = r % I_SQ, kb = q / 32, nb = q % 32;
            const float* src; int ldw, coff; bf16_t* dst; const float* rs = nullptr;
            if (w == 0) { src = (const float*)args.in[18]; ldw = 1024; coff = 0; dst = (bf16_t*)(ws + WS_W_MIX); }
            else if (w == 1) { src = (const float*)args.in[21]; ldw = 1024; coff = 0; dst = (bf16_t*)(ws + WS_W_CQ); rs = (const float*)args.in[19]; }
            else if (w == 2) { src = (const float*)args.in[22]; ldw = 2048; coff = 0; dst = (bf16_t*)(ws + WS_W_CK); }
            else if (w == 3) { src = (const float*)args.in[22]; ldw = 2048; coff = 1024; dst = (bf16_t*)(ws + WS_W_CV); }
            else { src = (const float*)args.in[23]; ldw = 1024; coff = 0; dst = (bf16_t*)(ws + WS_W_CO); }
            tr_item_v4(src, ldw, dst, 1024, nb * 32, kb * 64, coff + nb * 32, scr, lane, rs); continue; } r -= 5 * I_SQ;
        { const int kb = r / 8, nb = r % 8; const int n = nb * 32 + j;
            tr_item((const float*)args.in[26], NE, 1024, (bf16_t*)(ws + WS_W_R), 1024, nb * 32, kb * 64, (n < NE) ? n : -1, scr, lane, (const float*)args.in[24]); }
    }
    const size_t gt = (size_t)gw * 64 + lane, NT_ = (size_t)NGW * 64;
    { const float* x = (const float*)args.in[0]; bf16_t* xb = (bf16_t*)(ws + WS_XB);
      for (size_t i = gt; i < (size_t)T * D / 8; i += NT_) { const f32x4 a = *(const f32x4*)(x + i * 8), b = *(const f32x4*)(x + i * 8 + 4);
          u32x4 o; o.x = pk2(a[0], a[1]); o.y = pk2(a[2], a[3]); o.z = pk2(b[0], b[1]); o.w = pk2(b[2], b[3]); *(u32x4*)(xb + i * 8) = o; } }
    { const float* x = (const float*)args.in[1]; bf16_t* xb = (bf16_t*)(ws + WS_MEMB);
      for (size_t i = gt; i < (size_t)NB * NMEM * D / 8; i += NT_) { const f32x4 a = *(const f32x4*)(x + i * 8), b = *(const f32x4*)(x + i * 8 + 4);
          u32x4 o; o.x = pk2(a[0], a[1]); o.y = pk2(a[2], a[3]); o.z = pk2(b[0], b[1]); o.w = pk2(b[2], b[3]); *(u32x4*)(xb + i * 8) = o; } }
}

DI void p2_tokens(const Args& args, int vcu, int G) {
    int tid_ = threadIdx.x; asm volatile("" : "+v"(tid_)); const int lane = tid_ & 63; const int wave = __builtin_amdgcn_readfirstlane(tid_ >> 6);
    unsigned char* ws = args.ws;
    const bf16_t* proj = (const bf16_t*)(ws + WS_PROJ);
    bf16_t* qn = (bf16_t*)(ws + WS_QN); bf16_t* kvn = (bf16_t*)(ws + WS_KVN); bf16_t* kpe = (bf16_t*)(ws + WS_KPE); bf16_t* xc = (bf16_t*)(ws + WS_XC); float* cs = (float*)(ws + WS_CS);
    const int* positions = (const int*)args.in[2];
    const float* conv_w = (const float*)args.in[6]; const float* conv_b = (const float*)args.in[7];
    const float* g_qlat = (const float*)args.in[12]; const float* g_kvlat = (const float*)args.in[13];
    const int gw = vcu * NWAVES + wave, NGW = G * NWAVES;
    float cw[4][8], cb[8];
#pragma unroll
    for (int jj = 0; jj < 4; ++jj)
#pragma unroll
        for (int c = 0; c < 8; ++c) cw[jj][c] = conv_w[jj * MW + 8 * lane + c];
#pragma unroll
    for (int c = 0; c < 8; ++c) cb[c] = conv_b[8 * lane + c];
    const f32x4 gq = *(const f32x4*)(g_qlat + 4 * lane);
    const f32x2 gk = *(const f32x2*)(g_kvlat + 2 * lane);
    const float inv_freq = exp2f(-(float)(lane & 15) * (13.287712379549449f / 16.0f));
    for (int t = gw; t < T; t += NGW) {
        const bf16_t* pr = proj + (size_t)t * NPROJ;
        { const u32x2 w = *(const u32x2*)(pr + PC_QLAT + 4 * lane); const float a0 = bflo(w.x), a1 = bfhi(w.x), a2 = bflo(w.y), a3 = bfhi(w.y);
          const float ss = wave_sum(a0 * a0 + a1 * a1 + a2 * a2 + a3 * a3); const float r = 1.0f / sqrtf(ss * (1.0f / AQR) + EPS);
          u32x2 o; o.x = pk2(a0 * r * gq[0], a1 * r * gq[1]); o.y = pk2(a2 * r * gq[2], a3 * r * gq[3]); *(u32x2*)(qn + (size_t)t * 256 + 4 * lane) = o; }
        { const unsigned w = *(const unsigned*)(pr + PC_KVLAT + 2 * lane); const float a0 = bflo(w), a1 = bfhi(w);
          const float ss = wave_sum(a0 * a0 + a1 * a1); const float r = 1.0f / sqrtf(ss * (1.0f / AKVR) + EPS);
          *(unsigned*)(kvn + (size_t)t * 256 + 2 * lane) = pk2(a0 * r * gk[0], a1 * r * gk[1]); *(unsigned*)(kvn + (size_t)t * 256 + 128 + 2 * lane) = 0u; }
        if (lane < 16) { const unsigned w = *(const unsigned*)(pr + PC_KROPE + 2 * lane); const float x1 = bflo(w), x2 = bfhi(w);
          const float ang = (float)positions[t] * inv_freq;
          const double rev = (double)ang * 0.15915494309189535; const float fr = (float)(rev - __builtin_rint(rev));
          const float cc = __builtin_amdgcn_cosf(fr), sn = __builtin_amdgcn_sinf(fr);
          *(unsigned*)(kpe + (size_t)t * 32 + 2 * lane) = pk2(x1 * cc - x2 * sn, x2 * cc + x1 * sn);
          *(f32x2*)(cs + (size_t)t * 32 + 2 * lane) = (f32x2){cc, sn}; }
        { const int s = t & (SEQ - 1); float a[8];
#pragma unroll
          for (int c = 0; c < 8; ++c) a[c] = cb[c];
#pragma unroll
          for (int jj = 0; jj < 4; ++jj) { const int back = 3 - jj; if (s - back >= 0) { const u32x4 w = *(const u32x4*)(pr - (size_t)back * NPROJ + PC_XM + 8 * lane);
              a[0] += cw[jj][0] * bflo(w.x); a[1] += cw[jj][1] * bfhi(w.x); a[2] += cw[jj][2] * bflo(w.y); a[3] += cw[jj][3] * bfhi(w.y);
              a[4] += cw[jj][4] * bflo(w.z); a[5] += cw[jj][5] * bfhi(w.z); a[6] += cw[jj][6] * bflo(w.w); a[7] += cw[jj][7] * bfhi(w.w); } }
#pragma unroll
          for (int c = 0; c < 8; ++c) a[c] = a[c] * sigmoidf_(a[c]);
          u32x4 o; o.x = pk2(a[0], a[1]); o.y = pk2(a[2], a[3]); o.z = pk2(a[4], a[5]); o.w = pk2(a[6], a[7]); *(u32x4*)(xc + (size_t)t * MW + 8 * lane) = o; }
    }
}

DI void p6_mpost(const Args& args, int vcu, int G) {
    int tid_ = threadIdx.x; asm volatile("" : "+v"(tid_)); const int lane = tid_ & 63; const int wave = __builtin_amdgcn_readfirstlane(tid_ >> 6);
    unsigned char* ws = args.ws;
    const float* hraw = (const float*)(ws + WS_HRAW); const bf16_t* xc = (const bf16_t*)(ws + WS_XC); const bf16_t* proj = (const bf16_t*)(ws + WS_PROJ); bf16_t* hm = (bf16_t*)(ws + WS_HM);
    const float* g_mhead = (const float*)args.in[10]; const float* w_mskip = (const float*)args.in[11];
    const int gw = vcu * NWAVES + wave, NGW = G * NWAVES;
    float gm[8], wsk[8];
#pragma unroll
    for (int c = 0; c < 8; ++c) { gm[c] = g_mhead[8 * lane + c]; wsk[c] = w_mskip[8 * lane + c]; }
    for (int t = gw; t < T; t += NGW) {
        const f32x4 h0 = *(const f32x4*)(hraw + (size_t)t * MW + 8 * lane), h1 = *(const f32x4*)(hraw + (size_t)t * MW + 8 * lane + 4);
        float h[8] = {h0[0], h0[1], h0[2], h0[3], h1[0], h1[1], h1[2], h1[3]};
        float s = 0.f;
#pragma unroll
        for (int c = 0; c < 8; ++c) s += h[c];
        s += __shfl_xor(s, 1); s += __shfl_xor(s, 2); s += __shfl_xor(s, 4); s += __shfl_xor(s, 8);
        const float mu = s * (1.0f / MHD); float q = 0.f;
#pragma unroll
        for (int c = 0; c < 8; ++c) { h[c] -= mu; q += h[c] * h[c]; }
        q += __shfl_xor(q, 1); q += __shfl_xor(q, 2); q += __shfl_xor(q, 4); q += __shfl_xor(q, 8);
        const float rstd = 1.0f / sqrtf(q * (1.0f / MHD) + EPS);
        const u32x4 xw = *(const u32x4*)(xc + (size_t)t * MW + 8 * lane); const u32x4 ow = *(const u32x4*)(proj + (size_t)t * NPROJ + PC_OP + 8 * lane);
        const float xv[8] = {bflo(xw.x), bfhi(xw.x), bflo(xw.y), bfhi(xw.y), bflo(xw.z), bfhi(xw.z), bflo(xw.w), bfhi(xw.w)};
        const float ov[8] = {bflo(ow.x), bfhi(ow.x), bflo(ow.y), bfhi(ow.y), bflo(ow.z), bfhi(ow.z), bflo(ow.w), bfhi(ow.w)};
        float o[8];
#pragma unroll
        for (int c = 0; c < 8; ++c) o[c] = sigmoidf_(ov[c]) * (h[c] * rstd * gm[c] + wsk[c] * xv[c]);
        u32x4 w; w.x = pk2(o[0], o[1]); w.y = pk2(o[2], o[3]); w.z = pk2(o[4], o[5]); w.w = pk2(o[6], o[7]); *(u32x4*)(hm + (size_t)t * MW + 8 * lane) = w;
    }
}

DI void ln_pass(const float* res, const float* add, const float* g, const float* b, float* out, bf16_t* outb, int vcu, int G) {
    int tid_ = threadIdx.x; asm volatile("" : "+v"(tid_)); const int lane = tid_ & 63; const int wave = __builtin_amdgcn_readfirstlane(tid_ >> 6);
    const int gw = vcu * NWAVES + wave, NGW = G * NWAVES;
    for (int t = gw; t < T; t += NGW) {
        f32x4 v[4]; float s = 0.f;
#pragma unroll
        for (int j = 0; j < 4; ++j) { const f32x4 r = *(const f32x4*)(res + (size_t)t * D + 4 * lane + 256 * j), a = *(const f32x4*)(add + (size_t)t * D + 4 * lane + 256 * j);
            v[j] = r * DN_ALPHA + a; s += (v[j][0] + v[j][1]) + (v[j][2] + v[j][3]); }
        const float mean = wave_sum(s) * (1.0f / D); float q = 0.f;
#pragma unroll
        for (int j = 0; j < 4; ++j) { v[j] = v[j] - mean; q += (v[j][0] * v[j][0] + v[j][1] * v[j][1]) + (v[j][2] * v[j][2] + v[j][3] * v[j][3]); }
        const float rstd = 1.0f / sqrtf(wave_sum(q) * (1.0f / D) + EPS);
#pragma unroll
        for (int j = 0; j < 4; ++j) { const f32x4 gg = *(const f32x4*)(g + 4 * lane + 256 * j), bb = *(const f32x4*)(b + 4 * lane + 256 * j);
            const f32x4 y = v[j] * rstd * gg + bb;
            *(f32x4*)(out + (size_t)t * D + 4 * lane + 256 * j) = y;
            if (outb) { u32x2 w; w.x = pk2(y[0], y[1]); w.y = pk2(y[2], y[3]); *(u32x2*)(outb + (size_t)t * D + 4 * lane + 256 * j) = w; } }
    }
}

DI void p16_topk(const Args& args, LAS unsigned char* lds, int vcu, int G) {
    unsigned char* ws = args.ws;
    const float* logits = (const float*)(ws + WS_LOGITS); const float* b_router = (const float*)args.in[27];
    int* assign = (int*)(ws + WS_ASSIGN); float* gatew = (float*)(ws + WS_GATEW);
    unsigned* gcnt = (unsigned*)(ws + WS_CTL) + CW_CNT;
    LAS unsigned* hist = (LAS unsigned*)(lds + HIST_OFF); LAS unsigned* hbase = (LAS unsigned*)(lds + HBASE_OFF);
    int tid = threadIdx.x; asm volatile("" : "+v"(tid));
    for (int blk = vcu; blk < T / 512; blk += G) {
        const int t = blk * 512 + tid;
        float v[NE];
#pragma unroll
        for (int j = 0; j < NE / 4; ++j) { const f32x4 a = *(const f32x4*)(logits + (size_t)t * NE + 4 * j), bb = *(const f32x4*)(b_router + 4 * j);
            v[4 * j] = a[0] + bb[0]; v[4 * j + 1] = a[1] + bb[1]; v[4 * j + 2] = a[2] + bb[2]; v[4 * j + 3] = a[3] + bb[3]; }
        int idx[TOPK]; float val[TOPK];
#pragma unroll
        for (int k = 0; k < TOPK; ++k) { float best = -INFINITY; int bi = 0;
#pragma unroll
            for (int e = 0; e < NE; ++e) { bool taken = false;
#pragma unroll
                for (int kk = 0; kk < k; ++kk) taken = taken || (idx[kk] == e);
                if (!taken && v[e] > best) { best = v[e]; bi = e; } }
            idx[k] = bi; val[k] = best; }
        float ex[TOPK], sum = 0.f;
#pragma unroll
        for (int k = 0; k < TOPK; ++k) { ex[k] = __expf(val[k] - val[0]); sum += ex[k]; }
        const float inv = 1.0f / sum;
        if (tid < NE) hist[tid] = 0u;
        __syncthreads();
        unsigned lr[TOPK];
#pragma unroll
        for (int k = 0; k < TOPK; ++k) lr[k] = __hip_atomic_fetch_add(hist + idx[k], 1u, __ATOMIC_RELAXED, __HIP_MEMORY_SCOPE_WORKGROUP);
        __syncthreads();
        if (tid < NE) hbase[tid] = __hip_atomic_fetch_add(gcnt + tid, hist[tid], RLX_AGENT);
        __syncthreads();
#pragma unroll
        for (int k = 0; k < TOPK; ++k) { assign[(size_t)t * TOPK + k] = (idx[k] << 20) | (int)(hbase[idx[k]] + lr[k]); gatew[(size_t)t * TOPK + k] = ex[k] * inv; }
        __syncthreads();
    }
}
DI void build_tstart(const Args& args, LAS unsigned char* lds) {
    const unsigned* gcnt = (const unsigned*)(args.ws + WS_CTL) + CW_CNT; LAS int* tst = (LAS int*)(lds + TST_OFF); LAS int* tile_e = (LAS int*)(lds + TILE_E_OFF);
    if (threadIdx.x == 0) { int acc = 0;
        for (int e = 0; e < NE; ++e) { tst[e] = acc; const unsigned c = __hip_atomic_load(gcnt + e, RLX_AGENT); acc += (int)((c + 255u) >> 8); }
        tst[NE] = acc; }
    __syncthreads();
    for (int t = threadIdx.x; t < tst[NE]; t += NWAVES * 64) { int e = 0;
        for (int j = 1; j < NE; ++j) e += (tst[j] <= t) ? 1 : 0;
        tile_e[t] = e; }
    __syncthreads();
}
DI void p17_gather(const Args& args, LAS unsigned char* lds, int vcu, int G) {
    int tid_ = threadIdx.x; asm volatile("" : "+v"(tid_)); const int lane = tid_ & 63; const int wave = __builtin_amdgcn_readfirstlane(tid_ >> 6);
    unsigned char* ws = args.ws;
    build_tstart(args, lds);
    const LAS int* tst = (const LAS int*)(lds + TST_OFF);
    const unsigned* gcnt = (const unsigned*)(ws + WS_CTL) + CW_CNT;
    const int* assign = (const int*)(ws + WS_ASSIGN); const float* gatew = (const float*)(ws + WS_GATEW);
    int* tokpos = (int*)(ws + WS_TOKPOS); float* rowgate = (float*)(ws + WS_ROWGATE);
    const bf16_t* v2 = (const bf16_t*)(ws + WS_V2B); const float* stats2 = (const float*)(ws + CTL_STATS2); unsigned char* xg = ws + WS_XG;
    const int gw = vcu * NWAVES + wave, NGW = G * NWAVES;
    f32x4 g2[4], b2[4];
#pragma unroll
    for (int j = 0; j < 4; ++j) { g2[j] = *(const f32x4*)((const float*)args.in[24] + 16 * lane + 4 * j) * pg8::F8_XS; b2[j] = *(const f32x4*)((const float*)args.in[25] + 16 * lane + 4 * j) * pg8::F8_XS; }
    for (int t = gw; t < T; t += NGW) {
        float mean, rstd; pg8::row_stats(stats2, t, mean, rstd);
        u32x4 o; const u32x4 wa = *(const u32x4*)(v2 + (size_t)t * D + 16 * lane), wb = *(const u32x4*)(v2 + (size_t)t * D + 16 * lane + 8);
        const f32x4 xin[4] = {{bflo(wa.x), bfhi(wa.x), bflo(wa.y), bfhi(wa.y)}, {bflo(wa.z), bfhi(wa.z), bflo(wa.w), bfhi(wa.w)}, {bflo(wb.x), bfhi(wb.x), bflo(wb.y), bfhi(wb.y)}, {bflo(wb.z), bfhi(wb.z), bflo(wb.w), bfhi(wb.w)}};
#pragma unroll
        for (int j = 0; j < 4; ++j) { const f32x4 x = (xin[j] - mean) * rstd * g2[j] + b2[j]; o[j] = pg8::pk4_fp8(x[0], x[1], x[2], x[3]); }
#pragma unroll
        for (int k = 0; k < TOPK; ++k) { const int as = assign[(size_t)t * TOPK + k]; const int e = as >> 20, rank = as & 0xfffff; const int pos = tst[e] * 256 + rank;
            *(u32x4*)(xg + (size_t)pos * D + 16 * lane) = o;
            if (lane == 0) { tokpos[(size_t)t * TOPK + k] = pos; rowgate[pos] = gatew[(size_t)t * TOPK + k]; } }
    }
    for (int idx = gw; idx < NE * 256; idx += NGW) { const int e = idx >> 8, r = idx & 255; const int row = tst[e] * 256 + (int)__hip_atomic_load(gcnt + e, RLX_AGENT) + r;
        if (row < tst[e + 1] * 256) { const u32x4 z = {0u, 0u, 0u, 0u}; *(u32x4*)(xg + (size_t)row * D + 16 * lane) = z; if (lane == 0) rowgate[row] = 0.f; } }
}
DI void p20_final(const Args& args, int vcu, int G) {
    int tid_ = threadIdx.x; asm volatile("" : "+v"(tid_)); const int lane = tid_ & 63; const int wave = __builtin_amdgcn_readfirstlane(tid_ >> 6);
    unsigned char* ws = args.ws;
    const int* tokpos = (const int*)(ws + WS_TOKPOS); const bf16_t* yb = (const bf16_t*)(ws + WS_YB);
    const bf16_t* v2 = (const bf16_t*)(ws + WS_V2B); const float* stats2 = (const float*)(ws + CTL_STATS2);
    const float* g2 = (const float*)args.in[24]; const float* b2 = (const float*)args.in[25];
    const float* g = (const float*)args.in[32]; const float* b = (const float*)args.in[33]; float* out = args.out;
    const int gw = vcu * NWAVES + wave, NGW = G * NWAVES;
    for (int t = gw; t < T; t += NGW) {
        int pos[TOPK];
#pragma unroll
        for (int k = 0; k < TOPK; ++k) pos[k] = tokpos[(size_t)t * TOPK + k];
        float mean2, rstd2; pg8::row_stats(stats2, t, mean2, rstd2);
        f32x4 v[4]; float s = 0.f;
#pragma unroll
        for (int j = 0; j < 4; ++j) { const u32x2 vw = *(const u32x2*)(v2 + (size_t)t * D + 4 * lane + 256 * j); const f32x4 vin = {bflo(vw.x), bfhi(vw.x), bflo(vw.y), bfhi(vw.y)};
            const f32x4 r = (vin - mean2) * rstd2 * *(const f32x4*)(g2 + 4 * lane + 256 * j) + *(const f32x4*)(b2 + 4 * lane + 256 * j);
            f32x4 a = {0.f, 0.f, 0.f, 0.f};
#pragma unroll
            for (int k = 0; k < TOPK; ++k) { const u32x2 w = *(const u32x2*)(yb + (size_t)pos[k] * D + 4 * lane + 256 * j); a[0] += bflo(w.x); a[1] += bfhi(w.x); a[2] += bflo(w.y); a[3] += bfhi(w.y); }
            v[j] = r * DN_ALPHA + a; s += (v[j][0] + v[j][1]) + (v[j][2] + v[j][3]); }
        const float mean = wave_sum(s) * (1.0f / D); float q = 0.f;
#pragma unroll
        for (int j = 0; j < 4; ++j) { v[j] = v[j] - mean; q += (v[j][0] * v[j][0] + v[j][1] * v[j][1]) + (v[j][2] * v[j][2] + v[j][3] * v[j][3]); }
        const float rstd = 1.0f / sqrtf(wave_sum(q) * (1.0f / D) + EPS);
#pragma unroll
        for (int j = 0; j < 4; ++j) { const f32x4 gg = *(const f32x4*)(g + 4 * lane + 256 * j), bb = *(const f32x4*)(b + 4 * lane + 256 * j);
            *(f32x4*)(out + (size_t)t * D + 4 * lane + 256 * j) = v[j] * rstd * gg + bb; }
    }
}
constexpr int AT_KROW = 208, AT_VROW = 264;
constexpr int AT_KBUF = 128 * AT_KROW, AT_VBUF = 64 * AT_VROW, AT_VOFF = 2 * AT_KBUF;
#define MLA_QK(P0, P1, kbase) do { _Pragma("unroll") for (int r_ = 0; r_ < 16; ++r_) { P0[r_] = 0.f; P1[r_] = 0.f; } \
        _Pragma("unroll") for (int s_ = 0; s_ < 6; ++s_) { const bf16x8 a0_ = *(const LAS bf16x8*)((kbase) + s_ * 32), a1_ = *(const LAS bf16x8*)((kbase) + 32 * AT_KROW + s_ * 32); \
            P0 = MFMA32(a0_, qf[s_], P0); P1 = MFMA32(a1_, qf[s_], P1); } } while (0)
#define MLA_SOFTPV(P0, P1, vbase, MASK, key0) do { \
        if (MASK) { _Pragma("unroll") for (int r_ = 0; r_ < 16; ++r_) { const int key_ = (key0) + crow(r_, hi); if (key_ > qi) P0[r_] = -INFINITY; if (key_ + 32 > qi) P1[r_] = -INFINITY; } } \
        float mx_ = fmaxf(P0[0], P1[0]); \
        _Pragma("unroll") for (int r_ = 1; r_ < 16; ++r_) mx_ = fmaxf(mx_, fmaxf(P0[r_], P1[r_])); \
        mx_ = fmaxf(mx_, __shfl_xor(mx_, 32)); \
        const float m_new_ = fmaxf(m_run, mx_); const float alpha_ = __builtin_amdgcn_exp2f(m_run - m_new_); m_run = m_new_; \
        float ls_ = 0.f; \
        _Pragma("unroll") for (int r_ = 0; r_ < 16; ++r_) { P0[r_] = __builtin_amdgcn_exp2f(P0[r_] - m_new_); P1[r_] = __builtin_amdgcn_exp2f(P1[r_] - m_new_); ls_ += P0[r_] + P1[r_]; } \
        l_run = l_run * alpha_ + ls_; \
        if (!__all(alpha_ == 1.0f)) { _Pragma("unroll") for (int r_ = 0; r_ < 16; ++r_) { o0[r_] *= alpha_; o1[r_] *= alpha_; } } \
        _Pragma("unroll") for (int s_ = 0; s_ < 4; ++s_) { u32x4 w_; \
            if (s_ < 2) { w_.x = pk2(P0[8 * s_], P0[8 * s_ + 1]); w_.y = pk2(P0[8 * s_ + 2], P0[8 * s_ + 3]); w_.z = pk2(P0[8 * s_ + 4], P0[8 * s_ + 5]); w_.w = pk2(P0[8 * s_ + 6], P0[8 * s_ + 7]); } \
            else { w_.x = pk2(P1[8 * s_ - 16], P1[8 * s_ - 15]); w_.y = pk2(P1[8 * s_ - 14], P1[8 * s_ - 13]); w_.z = pk2(P1[8 * s_ - 12], P1[8 * s_ - 11]); w_.w = pk2(P1[8 * s_ - 10], P1[8 * s_ - 9]); } \
            const bf16x8 pb_ = __builtin_bit_cast(bf16x8, w_); \
            const u32x2 a0l_ = *(const LAS u32x2*)((vbase) + s_ * 32), a0h_ = *(const LAS u32x2*)((vbase) + s_ * 32 + 16); \
            const u32x2 a1l_ = *(const LAS u32x2*)((vbase) + 32 * AT_VROW + s_ * 32), a1h_ = *(const LAS u32x2*)((vbase) + 32 * AT_VROW + s_ * 32 + 16); \
            const bf16x8 a0_ = __builtin_bit_cast(bf16x8, (u32x4){a0l_.x, a0l_.y, a0h_.x, a0h_.y}), a1_ = __builtin_bit_cast(bf16x8, (u32x4){a1l_.x, a1l_.y, a1h_.x, a1h_.y}); \
            o0 = MFMA32(a0_, pb_, o0); o1 = MFMA32(a1_, pb_, o1); } } while (0)
DI void mla_unit(int b, int h, int qb, const bf16_t* Q, const bf16_t* Kn, const bf16_t* Kpe, const bf16_t* Vt, bf16_t* O, LAS unsigned char* lds) {
    int tid = threadIdx.x; asm volatile("" : "+v"(tid)); const int lane = tid & 63, r32 = lane & 31, hi = lane >> 5; const int wid = __builtin_amdgcn_readfirstlane(tid >> 6);
    const int q0 = qb * 256 + wid * 32;
    const int qi = q0 + r32;
    const size_t tokb = (size_t)b * SEQ;
    bf16x8 qf[6];
    { const bf16_t* qp = Q + (tokb + qi) * (AH * AQK) + h * AQK + 8 * hi;
#pragma unroll
      for (int s = 0; s < 6; ++s) qf[s] = *(const bf16x8*)(qp + 16 * s); }
    const int kkey = tid >> 3, kch = tid & 7, pkey = tid >> 2, pch = tid & 3, vd = tid >> 3, vch = tid & 7;
    const bf16_t* ksrc = Kn + (tokb + kkey) * 512 + h * 64 + kch * 8;
    const bf16_t* psrc = Kpe + (tokb + pkey) * 32 + pch * 8;
    const bf16_t* vsrc = Vt + (size_t)(h * 64 + vd) * T + tokb + vch * 8;
    const int kdst = kkey * AT_KROW + kch * 16, pdst = pkey * AT_KROW + 128 + pch * 16, vdst = AT_VOFF + vd * AT_VROW + vch * 16;
    const int nbt = 2 * (qb + 1), nfull = 2 * qb;
    u32x4 rk0, rk1, rp, rv0, rv1;
#define MLA_LD(t) do { rk0 = *(const u32x4*)(ksrc + (size_t)(t) * 128 * 512); rk1 = *(const u32x4*)(ksrc + ((size_t)(t) * 128 + 64) * 512); rp = *(const u32x4*)(psrc + (size_t)(t) * 128 * 32); \
        rv0 = *(const u32x4*)(vsrc + (t) * 128); rv1 = *(const u32x4*)(vsrc + (t) * 128 + 64); } while (0)
#define MLA_ST(buf) do { *(LAS u32x4*)(lds + (buf) * AT_KBUF + kdst) = rk0; *(LAS u32x4*)(lds + (buf) * AT_KBUF + 64 * AT_KROW + kdst) = rk1; *(LAS u32x4*)(lds + (buf) * AT_KBUF + pdst) = rp; \
        *(LAS u32x2*)(lds + (buf) * AT_VBUF + vdst) = (u32x2){rv0.x, rv0.y}; *(LAS u32x2*)(lds + (buf) * AT_VBUF + vdst + 8) = (u32x2){rv0.z, rv0.w}; \
        *(LAS u32x2*)(lds + (buf) * AT_VBUF + vdst + 128) = (u32x2){rv1.x, rv1.y}; *(LAS u32x2*)(lds + (buf) * AT_VBUF + vdst + 136) = (u32x2){rv1.z, rv1.w}; } while (0)
    MLA_LD(0); MLA_ST(0);
    __syncthreads();
    float m_run = -INFINITY, l_run = 0.f;
    f32x16 o0, o1, pa0, pa1, pb0, pb1;
#pragma unroll
    for (int r = 0; r < 16; ++r) { o0[r] = 0.f; o1[r] = 0.f; }
    const LAS unsigned char* kl = lds + r32 * AT_KROW + hi * 16; const LAS unsigned char* vl = lds + AT_VOFF + r32 * AT_VROW + hi * 8;
    int t = 0;
    for (; t < nfull; ++t) {
        MLA_LD(t + 1);
        const LAS unsigned char* kb = kl + (t & 1) * AT_KBUF; const LAS unsigned char* vb = vl + (t & 1) * AT_VBUF;
        MLA_QK(pa0, pa1, kb);
        MLA_QK(pb0, pb1, kb + 64 * AT_KROW);
        MLA_SOFTPV(pa0, pa1, vb, false, 0);
        MLA_SOFTPV(pb0, pb1, vb + 128, false, 0);
        MLA_ST((t + 1) & 1);
        __syncthreads();
    }
    for (; t < nbt; ++t) {
        if (t + 1 < nbt) MLA_LD(t + 1);
        const LAS unsigned char* kb = kl + (t & 1) * AT_KBUF; const LAS unsigned char* vb = vl + (t & 1) * AT_VBUF;
        const int key0 = t * 128;
        if (key0 <= q0 + 31) { MLA_QK(pa0, pa1, kb); MLA_SOFTPV(pa0, pa1, vb, true, key0); }
        if (key0 + 64 <= q0 + 31) { MLA_QK(pb0, pb1, kb + 64 * AT_KROW); MLA_SOFTPV(pb0, pb1, vb + 128, true, key0 + 64); }
        if (t + 1 < nbt) MLA_ST((t + 1) & 1);
        __syncthreads();
    }
#undef MLA_LD
#undef MLA_ST
    const float lt = l_run + __shfl_xor(l_run, 32); const float inv = 1.0f / lt;
    bf16_t* op = O + (tokb + qi) * AW + h * AVD + 4 * hi;
#pragma unroll
    for (int g = 0; g < 4; ++g) { u32x2 w0, w1;
        w0.x = pk2(o0[4 * g] * inv, o0[4 * g + 1] * inv); w0.y = pk2(o0[4 * g + 2] * inv, o0[4 * g + 3] * inv);
        w1.x = pk2(o1[4 * g] * inv, o1[4 * g + 1] * inv); w1.y = pk2(o1[4 * g + 2] * inv, o1[4 * g + 3] * inv);
        *(u32x2*)(op + 8 * g) = w0; *(u32x2*)(op + 32 + 8 * g) = w1; }
}
DI void p4_attention(const Args& args, LAS unsigned char* lds, int vcu, int G) {
    unsigned char* ws = args.ws;
    const bf16_t* Q = (const bf16_t*)(ws + WS_QMLA); const bf16_t* Kn = (const bf16_t*)(ws + WS_KN); const bf16_t* Kpe = (const bf16_t*)(ws + WS_KPE); const bf16_t* Vt = (const bf16_t*)(ws + WS_VT);
    bf16_t* O = (bf16_t*)(ws + WS_AO);
    for (int p = vcu; p < NB * AH * 4; p += G) { const int bh = p >> 2, j = p & 3; const int b = bh / AH, h = bh % AH;
        mla_unit(b, h, 7 - j, Q, Kn, Kpe, Vt, O, lds);
        mla_unit(b, h, j, Q, Kn, Kpe, Vt, O, lds); }
}

constexpr int ML_QROW = 272, ML_TROW = 144;
constexpr int ML_QS = 0, ML_KS = ML_QS + 64 * ML_QROW, ML_KTS = ML_KS + 64 * ML_QROW, ML_VTS = ML_KTS + 128 * ML_TROW, ML_CS = ML_VTS + 32 * ML_TROW, ML_SS = ML_CS + 32 * ML_QROW,
              ML_VEC = ML_SS + 64 * ML_TROW;
static_assert(ML_VEC + (7 * 64 + 128 + 4) * 4 <= RING_BYTES, "mLSTM LDS");
DI void mlstm_unit(int b, int h, int vs, const Args& args, LAS unsigned char* lds) {
    unsigned char* ws = args.ws;
    const bf16_t* qkm = (const bf16_t*)(ws + WS_QKM); const bf16_t* ktm = (const bf16_t*)(ws + WS_KTM); const bf16_t* proj = (const bf16_t*)(ws + WS_PROJ);
    const float* gates = (const float*)(ws + WS_GATES); float* hraw = (float*)(ws + WS_HRAW);
    const float b_i = ((const float*)args.in[4])[h], b_f = ((const float*)args.in[5])[h];
    int tid = threadIdx.x; asm volatile("" : "+v"(tid)); const int lane = tid & 63, r32 = lane & 31, hi = lane >> 5; const int wid = __builtin_amdgcn_readfirstlane(tid >> 6);
    LAS float* ROWT = (LAS float*)(lds + ML_VEC); LAS float* COLT = ROWT + 64; LAS float* WINT = ROWT + 128; LAS float* ENEG = ROWT + 192; LAS float* WAS = ROWT + 256;
    LAS float* NQ = ROWT + 320; LAS float* DINV = ROWT + 384; LAS float* NVEC = ROWT + 448; LAS float* SCAL = ROWT + 576;
    const size_t tokb = (size_t)b * SEQ;
    for (int i = tid; i < 32 * ML_QROW / 4; i += 512) ((LAS unsigned*)(lds + ML_CS))[i] = 0u;
    if (tid < 128) NVEC[tid] = 0.f;
    f32x16 cacc;
#pragma unroll
    for (int r = 0; r < 16; ++r) cacc[r] = 0.f;
    float m_st = 0.f;
    u32x4 sq[2], sk[2], skt[2], sv; float gi = 0.f, gf = 0.f;
    sv = (u32x4){0u, 0u, 0u, 0u};
#define ML_LOAD(c) do { const size_t tok0 = tokb + (size_t)(c) * MCH; \
        _Pragma("unroll") for (int i = 0; i < 2; ++i) { const int idx = tid + 512 * i; \
            sq[i] = *(const u32x4*)(qkm + (tok0 + (idx >> 4)) * 1024 + h * MHD + (idx & 15) * 8); \
            sk[i] = *(const u32x4*)(qkm + (tok0 + (idx >> 4)) * 1024 + 512 + h * MHD + (idx & 15) * 8); \
            skt[i] = *(const u32x4*)(ktm + (size_t)(h * MHD + (idx >> 3)) * T + tok0 + (idx & 7) * 8); } \
        if (tid < 256) sv = *(const u32x4*)(proj + (tok0 + (tid >> 2)) * NPROJ + PC_VM + h * MHD + vs * 32 + (tid & 3) * 8); \
        if (wid == 0) { gi = gates[(tok0 + lane) * 8 + h]; gf = gates[(tok0 + lane) * 8 + 4 + h]; } } while (0)
    ML_LOAD(0);
    for (int c = 0; c < SEQ / MCH; ++c) {
        const size_t tok0 = tokb + (size_t)c * MCH;
#pragma unroll
        for (int i = 0; i < 2; ++i) { const int idx = tid + 512 * i;
            *(LAS u32x4*)(lds + ML_QS + (idx >> 4) * ML_QROW + (idx & 15) * 16) = sq[i];
            *(LAS u32x4*)(lds + ML_KS + (idx >> 4) * ML_QROW + (idx & 15) * 16) = sk[i];
            *(LAS u32x4*)(lds + ML_KTS + (idx >> 3) * ML_TROW + (idx & 7) * 16) = skt[i]; }
        if (tid < 256) { const int l = tid >> 2, v0 = (tid & 3) * 8; LAS bf16_t* vt = (LAS bf16_t*)(lds + ML_VTS);
            vt[(v0 + 0) * (ML_TROW / 2) + l] = (bf16_t)(sv.x & 0xffff); vt[(v0 + 1) * (ML_TROW / 2) + l] = (bf16_t)(sv.x >> 16);
            vt[(v0 + 2) * (ML_TROW / 2) + l] = (bf16_t)(sv.y & 0xffff); vt[(v0 + 3) * (ML_TROW / 2) + l] = (bf16_t)(sv.y >> 16);
            vt[(v0 + 4) * (ML_TROW / 2) + l] = (bf16_t)(sv.z & 0xffff); vt[(v0 + 5) * (ML_TROW / 2) + l] = (bf16_t)(sv.z >> 16);
            vt[(v0 + 6) * (ML_TROW / 2) + l] = (bf16_t)(sv.w & 0xffff); vt[(v0 + 7) * (ML_TROW / 2) + l] = (bf16_t)(sv.w >> 16); }
        if (wid == 0) {
            const float xf = gf + b_f;
            const float lf = (xf >= 0.f) ? -log1pf(__expf(-xf)) : xf - log1pf(__expf(xf));
            float bb = lf;
#pragma unroll
            for (int o = 1; o < 64; o <<= 1) { const float tv = __shfl_up(bb, o); if (lane >= o) bb += tv; }
            const float btot = __shfl(bb, 63);
            const float ig = gi + b_i;
            const float a = btot - bb + ig;
            const float mchunk = wave_max(a);
            const float wa = __expf(a - mchunk);
            const float u = ig - bb;
            float pm = u;
#pragma unroll
            for (int o = 1; o < 64; o <<= 1) { const float tv = __shfl_up(pm, o); if (lane >= o) pm = fmaxf(pm, tv); }
            const float mintra = bb + pm;
            const float ginter = bb + m_st;
            const float m = fmaxf(ginter, mintra);
            const float mnew = fmaxf(btot + m_st, mchunk);
            const float sold = __expf(btot + m_st - mnew), snew = __expf(mchunk - mnew);
            ROWT[lane] = bb - m; COLT[lane] = u; WINT[lane] = __expf(ginter - m); ENEG[lane] = __expf(-m); WAS[lane] = snew * wa;
            if (lane == 0) SCAL[0] = sold;
            m_st = mnew;
        }
        __syncthreads();
        if (c + 1 < SEQ / MCH) ML_LOAD(c + 1);
        f32x16 iacc;
#pragma unroll
        for (int r = 0; r < 16; ++r) iacc[r] = 0.f;
        if (wid < 4) {
            const int jb = wid >> 1, sb = wid & 1;
            LAS bf16_t* ss = (LAS bf16_t*)(lds + ML_SS);
            if (sb <= jb) {
                f32x16 s;
#pragma unroll
                for (int r = 0; r < 16; ++r) s[r] = 0.f;
                const LAS unsigned char* qa = lds + ML_QS + (32 * jb + r32) * ML_QROW + hi * 16; const LAS unsigned char* kb = lds + ML_KS + (32 * sb + r32) * ML_QROW + hi * 16;
#pragma unroll
                for (int kk = 0; kk < 8; ++kk) s = MFMA32(*(const LAS bf16x8*)(qa + kk * 32), *(const LAS bf16x8*)(kb + kk * 32), s);
                const int sidx = 32 * sb + r32; const float ct = COLT[sidx];
#pragma unroll
                for (int r = 0; r < 16; ++r) { const int j = 32 * jb + crow(r, hi);
                    const float val = (sidx <= j) ? s[r] * __expf(ROWT[j] + ct) : 0.f;
                    ss[j * (ML_TROW / 2) + sidx] = (bf16_t)pk2(val, 0.f); }
            } else {
#pragma unroll
                for (int r = 0; r < 16; ++r) ss[(32 * jb + crow(r, hi)) * (ML_TROW / 2) + 32 * sb + r32] = (bf16_t)0;
            }
        } else if (wid < 6) {
            const int jb = wid - 4;
            const LAS unsigned char* qa = lds + ML_QS + (32 * jb + r32) * ML_QROW + hi * 16; const LAS unsigned char* cb = lds + ML_CS + r32 * ML_QROW + hi * 16;
#pragma unroll
            for (int kk = 0; kk < 8; ++kk) iacc = MFMA32(*(const LAS bf16x8*)(qa + kk * 32), *(const LAS bf16x8*)(cb + kk * 32), iacc);
        } else {
            const int j = 32 * (wid - 6) + (lane >> 1), half = lane & 1;
            const LAS unsigned char* qa = lds + ML_QS + j * ML_QROW + half * 128; float acc = 0.f;
#pragma unroll
            for (int i = 0; i < 8; ++i) { const u32x4 w = *(const LAS u32x4*)(qa + i * 16); const f32x4 n0 = *(const LAS f32x4*)(NVEC + half * 64 + i * 8), n1 = *(const LAS f32x4*)(NVEC + half * 64 + i * 8 + 4);
                acc += bflo(w.x) * n0[0] + bfhi(w.x) * n0[1] + bflo(w.y) * n0[2] + bfhi(w.y) * n0[3] + bflo(w.z) * n1[0] + bfhi(w.z) * n1[1] + bflo(w.w) * n1[2] + bfhi(w.w) * n1[3]; }
            acc += __shfl_xor(acc, 1);
            if (half == 0) NQ[j] = acc;
        }
        __syncthreads();
        if (wid < 4) {
            const float sold = SCAL[0];
#pragma unroll
            for (int r = 0; r < 16; ++r) cacc[r] *= sold;
            const LAS unsigned char* va = lds + ML_VTS + r32 * ML_TROW + hi * 16; const LAS unsigned char* kb = lds + ML_KTS + (32 * wid + r32) * ML_TROW + hi * 16;
#pragma unroll
            for (int kk = 0; kk < 4; ++kk) { const u32x4 w = *(const LAS u32x4*)(va + kk * 32);
                const f32x4 w0 = *(const LAS f32x4*)(WAS + 16 * kk + 8 * hi), w1 = *(const LAS f32x4*)(WAS + 16 * kk + 8 * hi + 4);
                u32x4 sa; sa.x = pk2(bflo(w.x) * w0[0], bfhi(w.x) * w0[1]); sa.y = pk2(bflo(w.y) * w0[2], bfhi(w.y) * w0[3]); sa.z = pk2(bflo(w.z) * w1[0], bfhi(w.z) * w1[1]); sa.w = pk2(bflo(w.w) * w1[2], bfhi(w.w) * w1[3]);
                cacc = MFMA32(__builtin_bit_cast(bf16x8, sa), *(const LAS bf16x8*)(kb + kk * 32), cacc); }
            LAS bf16_t* cs = (LAS bf16_t*)(lds + ML_CS);
#pragma unroll
            for (int r = 0; r < 16; ++r) cs[crow(r, hi) * (ML_QROW / 2) + 32 * wid + r32] = (bf16_t)pk2(cacc[r], 0.f);
        } else if (wid < 6) {
            const int jb = wid - 4;
#pragma unroll
            for (int r = 0; r < 16; ++r) iacc[r] *= WINT[32 * jb + crow(r, hi)];
            const LAS unsigned char* sa = lds + ML_SS + (32 * jb + r32) * ML_TROW + hi * 16; const LAS unsigned char* vb = lds + ML_VTS + r32 * ML_TROW + hi * 16;
#pragma unroll
            for (int kk = 0; kk < 4; ++kk) iacc = MFMA32(*(const LAS bf16x8*)(sa + kk * 32), *(const LAS bf16x8*)(vb + kk * 32), iacc);
        } else {
            const int tl = (wid - 6) * 64 + lane;
            { const int j = tl >> 1, half = tl & 1; const LAS unsigned char* sp = lds + ML_SS + j * ML_TROW + half * 64; float rs = 0.f;
#pragma unroll
              for (int i = 0; i < 4; ++i) { const u32x4 w = *(const LAS u32x4*)(sp + i * 16); rs += (bflo(w.x) + bfhi(w.x)) + (bflo(w.y) + bfhi(w.y)) + (bflo(w.z) + bfhi(w.z)) + (bflo(w.w) + bfhi(w.w)); }
              rs += __shfl_xor(rs, 1);
              if (half == 0) { const float den = WINT[j] * NQ[j] + rs; DINV[j] = 1.0f / fmaxf(fabsf(den), ENEG[j]); } }
            { const int k = tl; const LAS unsigned char* kp = lds + ML_KTS + k * ML_TROW; float acc = SCAL[0] * NVEC[k];
#pragma unroll
              for (int i = 0; i < 8; ++i) { const u32x4 w = *(const LAS u32x4*)(kp + i * 16); const f32x4 w0 = *(const LAS f32x4*)(WAS + i * 8), w1 = *(const LAS f32x4*)(WAS + i * 8 + 4);
                  acc += bflo(w.x) * w0[0] + bfhi(w.x) * w0[1] + bflo(w.y) * w0[2] + bfhi(w.y) * w0[3] + bflo(w.z) * w1[0] + bfhi(w.z) * w1[1] + bflo(w.w) * w1[2] + bfhi(w.w) * w1[3]; }
              NVEC[k] = acc; }
        }
        __syncthreads();
        if (wid == 4 || wid == 5) {
            const int jb = wid - 4; float* hp = hraw + (tok0 + 32 * jb) * MW + h * MHD + vs * 32 + r32;
#pragma unroll
            for (int r = 0; r < 16; ++r) { const int j = crow(r, hi); hp[(size_t)j * MW] = iacc[r] * DINV[32 * jb + j]; }
        }
    }
#undef ML_LOAD
    __syncthreads();
}
DI void p5_mlstm(const Args& args, LAS unsigned char* lds, int vcu, int G) {
    for (int u = vcu; u < NB * MH * 4; u += G) { const int vs = u & 3, bh = u >> 2; mlstm_unit(bh / MH, bh % MH, vs, args, lds); }
}
#ifndef MK_ONE_LAUNCH
#define MK_ONE_LAUNCH 1
#endif
#ifndef P3SEL
#define P3SEL 31
#endif
constexpr int NPH = 20;
__global__ void __launch_bounds__(NWAVES * 64, 2) fwd_kernel(Args args) {
    extern __shared__ __attribute__((aligned(16))) unsigned char lds_raw[];
    LAS unsigned char* lds = (LAS unsigned char*)lds_raw;
    const int tid = threadIdx.x;
    const int G = gridDim.x; const int bx = blockIdx.x; const int vcu = (G % 8 == 0) ? (bx % 8) * (G / 8) + bx / 8 : bx;
    unsigned char* ws = args.ws;
    for (int u = tid; u < (LDS_BYTES - LDSCTL_OFF) / 4; u += NWAVES * 64) ((LAS unsigned*)(lds + LDSCTL_OFF))[u] = 0u;
    __syncthreads();
    volatile LAS unsigned* MISC = (volatile LAS unsigned*)(lds + MISC_OFF);
    XcdBarrier bar; bar.bar = (unsigned*)(ws + WS_CTL) + CW_BAR; bar.x = 0; bar.st = nullptr;
    const int lo = args.ph_lo, hi = args.ph_hi;
    if (hi - lo > 1) bar = xcd_barrier_post((unsigned*)(ws + WS_CTL) + CW_BAR, MISC + 8);
#ifndef PHASE_MASK
#define PHASE_MASK 0xFFFFFu
#endif
#define IN(k) (((PHASE_MASK >> (k)) & 1u) && lo <= (k) && (k) < hi)
#ifndef DUP_PHASE
#define DUP_PHASE -1
#endif
#define REP(k) _Pragma("unroll 1") for (int rep_ = 0; rep_ < ((DUP_PHASE == (k)) ? 2 : 1); ++rep_)
#define SEAM(k) do { if (IN(k) && IN(NEXTPH(k))) xcd_barrier(bar); } while (0)
#define NEXTPH(k) (((k) == 7 || (k) == 12) ? (k) + 2 : (k) + 1)
    using namespace pg8;
    LAS unsigned char* ring = lds + RING_OFF;
    const bf16_t* cws = (const bf16_t*)ws;
#define WSB(off) ((bf16_t*)(ws + (off)))
#define WSF(off) ((float*)(ws + (off)))

    if (IN(0)) REP(0) { p0_prologue(args, lds, vcu, G); }
    SEAM(0);
    if (IN(1)) REP(1) {
        { DenseOrder S; S.init(WSB(WS_XB), WSB(WS_W_IN), T, NPROJ, D, D, G, bx); EpiProj E{WSB(WS_PROJ), WSF(WS_GATES)}; gemm_phase(ring, D, D, D, S, E); }
        { DenseOrder S; S.init(WSB(WS_MEMB), WSB(WS_W_CK), NB * NMEM, D, D, D, G, bx); EpiBf16 E{WSB(WS_KC), D, 1 << 30, 1.f}; gemm_phase(ring, D, D, D, S, E); }
        { DenseOrder S; S.init(WSB(WS_W_CV), WSB(WS_MEMB), D, NB * NMEM, D, D, G, bx); EpiBf16 E{WSB(WS_VCT), NB * NMEM, 1 << 30, 1.f}; gemm_phase(ring, D, D, D, S, E); }
    }
    SEAM(1);
    if (IN(2)) REP(2) { p2_tokens(args, vcu, G); }
    SEAM(2);
    if (IN(3)) REP(3) {
        if (P3SEL & 1) { DenseOrder S; S.init(WSB(WS_QN), WSB(WS_W_UQ), T, AH * AQK, 256, 256, G, bx); EpiQmla E{WSB(WS_QMLA), WSF(WS_CS), 0.10206207261596575f * 1.4426950408889634f}; gemm_phase(ring, 256, 256, 256, S, E); }
        if (P3SEL & 2) { DenseOrder S; S.init(WSB(WS_KVN), WSB(WS_W_UK), T, 512, 256, 256, G, bx); EpiBf16 E{WSB(WS_KN), 512, 1 << 30, 1.f}; gemm_phase(ring, 256, 256, 256, S, E); }
        if (P3SEL & 4) { DenseOrder S; S.init(WSB(WS_W_UV), WSB(WS_KVN), 512, T, 256, 256, G, bx); EpiBf16 E{WSB(WS_VT), T, 1 << 30, 1.f}; gemm_phase(ring, 256, 256, 256, S, E); }
        if (P3SEL & 8) { DenseOrder S; S.init(WSB(WS_XC), WSB(WS_W_MQK), T, 1024, 512, 512, G, bx); EpiBf16 E{WSB(WS_QKM), 1024, 2, 0.08838834764831845f}; gemm_phase(ring, 512, 512, 512, S, E); }
        if (P3SEL & 16) { DenseOrder S; S.init(WSB(WS_W_MQK) + 512 * 512, WSB(WS_XC), 512, T, 512, 512, G, bx); EpiBf16 E{WSB(WS_KTM), T, 0, 0.08838834764831845f}; gemm_phase(ring, 512, 512, 512, S, E); }
    }
    SEAM(3);
    if (IN(4)) { REP(40) { p5_mlstm(args, lds, vcu, G); } REP(41) { p4_attention(args, lds, vcu, G); } }
    SEAM(4);
    if (IN(5)) REP(5) { p6_mpost(args, vcu, G); }
    SEAM(5);
    if (IN(6)) REP(6) {
        { DenseOrder S; S.init(WSB(WS_HM), WSB(WS_W_BRM), T, D, 512, 512, G, bx); EpiGate<false> E{WSB(WS_GATED), WSB(WS_PROJ), PC_GM}; gemm_phase(ring, 512, 512, 512, S, E); }
        { DenseOrder S; S.init(WSB(WS_AO), WSB(WS_W_BRA), T, D, 512, 512, G, bx); EpiGate<true> E{WSB(WS_GATED), WSB(WS_PROJ), PC_GA}; gemm_phase(ring, 512, 512, 512, S, E); }
    }
    SEAM(6);
    if (IN(7)) REP(7) { DenseOrder S; S.init(WSB(WS_GATED), WSB(WS_W_MIX), T, D, D, D, G, bx); EpiResStats<false> E{WSB(WS_XB), nullptr, nullptr, nullptr, WSB(WS_V1B), WSF(CTL_STATS1)}; gemm_phase(ring, D, D, D, S, E); }
    SEAM(7);
    if (IN(9)) REP(9) { DenseOrder S; S.init(WSB(WS_V1B), WSB(WS_W_CQ), T, D, D, D, G, bx); EpiLNApplyBf16 E{WSB(WS_QC), D, WSF(CTL_STATS1), WSF(CTL_CS1), WSF(CTL_CB1), 0.0625f * 1.4426950408889634f}; gemm_phase(ring, D, D, D, S, E); }
    SEAM(9);
    if (IN(10)) REP(10) { CrossSOrder S{(const char*)(ws + WS_QC), (const char*)(ws + WS_KC), G, vcu}; EpiSoftmax E{WSB(WS_PC), (LAS float*)(lds + RED_OFF)}; gemm_phase(ring, 256, D, D, S, E); }
    SEAM(10);
    if (IN(11)) REP(11) { CrossOOrder S{(const char*)(ws + WS_PC), (const char*)(ws + WS_VCT), G, vcu}; EpiBf16 E{WSB(WS_OC), D, 1 << 30, 1.f}; gemm_phase(ring, 256, D, NB * NMEM, S, E); }
    SEAM(11);
    if (IN(12)) REP(12) { DenseOrder S; S.init(WSB(WS_OC), WSB(WS_W_CO), T, D, D, D, G, bx); EpiResStats<true> E{WSB(WS_V1B), WSF(CTL_STATS1), (const float*)args.in[19], (const float*)args.in[20], WSB(WS_V2B), WSF(CTL_STATS2)}; gemm_phase(ring, D, D, D, S, E); }
    SEAM(12);
    if (IN(14)) REP(14) { DenseOrder S; S.init(WSB(WS_V2B), WSB(WS_W_R), T, 256, D, D, G, bx); EpiLNApplyF32 E{WSF(WS_LOGITS), NE, NE, WSF(CTL_STATS2), WSF(CTL_CSR), WSF(CTL_CBR)}; gemm_phase(ring, D, D, D, S, E); }
    SEAM(14);
    if (IN(15)) REP(15) { p16_topk(args, lds, vcu, G); }
    SEAM(15);
    if (IN(16)) REP(16) { p17_gather(args, lds, vcu, G); }
    SEAM(16);
    if (IN(17)) REP(17) { build_tstart(args, lds);
        MoeOrder S{(const char*)(ws + WS_XG), (const char*)(ws + WS_W_GU), (const LAS int*)(lds + TST_OFF), (const LAS int*)(lds + TILE_E_OFF), 8, G, vcu, (size_t)256 * D, (size_t)2048 * 1024, (size_t)256 * 1024};
        EpiSwiglu E{ws + WS_ACT, (const float*)args.in[29]}; gemm_phase<EpiSwiglu, MoeOrder, true>(ring, D, D, D, S, E); }
    SEAM(17);
    if (IN(18)) REP(18) { build_tstart(args, lds);
        MoeOrder S{(const char*)(ws + WS_ACT), (const char*)(ws + WS_W_DN), (const LAS int*)(lds + TST_OFF), (const LAS int*)(lds + TILE_E_OFF), 4, G, vcu, (size_t)256 * D, (size_t)1024 * 1024, (size_t)256 * 1024};
        EpiDown E{WSB(WS_YB), (const float*)args.in[31], WSF(WS_ROWGATE)}; gemm_phase<EpiDown, MoeOrder, true>(ring, D, D, D, S, E); }
    SEAM(18);
    if (IN(19)) REP(19) { p20_final(args, vcu, G); }
    (void)cws;
#undef IN
#undef SEAM
}

extern "C" void kernel_launch(void* const* d_in, const int* in_sizes, int n_in, void* d_out, int out_size, void* d_ws, size_t ws_size, hipStream_t stream) {
    static int grid = 0;
    if (grid == 0) {
        if (n_in != 34 || in_sizes[0] != T * D || out_size != T * D || ws_size < WS_END) { fprintf(stderr, "kernel_launch: unexpected shapes / workspace (n_in %d, ws %zu)\n", n_in, ws_size); grid = -1; return; }
        int dev = 0, cus = 0, per_cu = 0;
        if (hipGetDevice(&dev) != hipSuccess || hipDeviceGetAttribute(&cus, hipDeviceAttributeMultiprocessorCount, dev) != hipSuccess) { grid = -1; return; }
        if (hipFuncSetAttribute((const void*)fwd_kernel, hipFuncAttributeMaxDynamicSharedMemorySize, LDS_BYTES) != hipSuccess) { fprintf(stderr, "kernel_launch: hipFuncSetAttribute failed\n"); grid = -1; return; }
        if (hipOccupancyMaxActiveBlocksPerMultiprocessor(&per_cu, (const void*)fwd_kernel, NWAVES * 64, LDS_BYTES) != hipSuccess || per_cu < 1) fprintf(stderr, "kernel_launch: occupancy query says %d\n", per_cu);
        (void)hipGetLastError();
        grid = cus;
    }
    if (grid < 0) return;
    if (hipMemsetAsync((char*)d_ws + WS_CTL, 0, CTL_ZERO_BYTES, stream) != hipSuccess) return;
    Args a{};
    for (int i = 0; i < 34; ++i) a.in[i] = d_in[i];
    a.out = (float*)d_out; a.ws = (unsigned char*)d_ws;
#if MK_ONE_LAUNCH
    a.ph_lo = 0; a.ph_hi = NPH;
    hipLaunchKernelGGL(fwd_kernel, dim3(grid), dim3(NWAVES * 64), LDS_BYTES, stream, a);
#else
    for (int p = 0; p < NPH; ++p) { a.ph_lo = p; a.ph_hi = p + 1; hipLaunchKernelGGL(fwd_kernel, dim3(grid), dim3(NWAVES * 64), LDS_BYTES, stream, a); }
#endif
}
```

```cpp
#include <hip/hip_runtime.h>
#include <cstdio>
#include <cstdint>
#include <cmath>

#define LAS __attribute__((address_space(3)))
#define GAS __attribute__((address_space(1)))
typedef unsigned short bf16_t;
typedef short bf16x8 __attribute__((ext_vector_type(8)));
typedef float f32x4 __attribute__((ext_vector_type(4)));
typedef float f32x2 __attribute__((ext_vector_type(2)));
typedef float f32x16 __attribute__((ext_vector_type(16)));
typedef unsigned u32x4 __attribute__((ext_vector_type(4)));
typedef unsigned u32x2 __attribute__((ext_vector_type(2)));
typedef GAS unsigned gu32;
#define RLX_AGENT __ATOMIC_RELAXED, __HIP_MEMORY_SCOPE_AGENT
#define DI __device__ __forceinline__

constexpr int D = 1024, NB = 16, SEQ = 2048, T = NB * SEQ, NMEM = 256;
constexpr int MH = 4, MHD = 128, MW = 512, MCH = 64;
constexpr int AH = 8, ANOPE = 64, AROPE = 32, AQK = 96, AVD = 64, AW = 512, AQR = 256, AKVR = 128;
constexpr int XH = 4, XHD = 256;
constexpr int NE = 32, TOPK = 4;
constexpr int DIN = 4008, NPROJ = 4096;
constexpr float DN_ALPHA = 1.189207115002721f;
constexpr float EPS = 1e-5f;
constexpr int NASSIGN = T * TOPK;
constexpr int NROWS = NASSIGN + NE * 256;
constexpr int NTILES_MAX = NROWS / 256;
constexpr int PC_QLAT = 0, PC_KVLAT = 256, PC_KROPE = 384, PC_IG = 416, PC_FG = 420, PC_XM = 512, PC_VM = 1024, PC_OP = 1536, PC_GM = 2048, PC_GA = 3072;

DI unsigned f2bf(float f) { unsigned u = __builtin_bit_cast(unsigned, f); return (u + 0x7fffu + ((u >> 16) & 1u)) >> 16; }
typedef __bf16 bf16x2_hw __attribute__((ext_vector_type(2)));
DI unsigned pk2(float lo, float hi) { const f32x2 v = {lo, hi}; return __builtin_bit_cast(unsigned, __builtin_convertvector(v, bf16x2_hw)); }
DI float bf2f(unsigned short b) { return __builtin_bit_cast(float, (unsigned)b << 16); }
DI float bflo(unsigned w) { return __builtin_bit_cast(float, w << 16); }
DI float bfhi(unsigned w) { return __builtin_bit_cast(float, w & 0xffff0000u); }
DI float wave_sum(float v) {
#pragma unroll
    for (int o = 1; o < 64; o <<= 1) v += __shfl_xor(v, o);
    return v;
}
DI float wave_max(float v) {
#pragma unroll
    for (int o = 1; o < 64; o <<= 1) v = fmaxf(v, __shfl_xor(v, o));
    return v;
}
DI float rcpf_(float x) { return __builtin_amdgcn_rcpf(x); }
DI float sigmoidf_(float x) { return __builtin_amdgcn_rcpf(1.0f + __builtin_amdgcn_exp2f(-1.4426950408889634f * x)); }
DI int crow(int r, int hi) { return (r & 3) + 8 * (r >> 2) + 4 * hi; }
#define MFMA32(a, b, c) __builtin_amdgcn_mfma_f32_32x32x16_bf16((a), (b), (c), 0, 0, 0)

namespace pg8 {
constexpr int BM = 256, BK = 64, HALF = 128, HTB = HALF * BK * 2, STAGE_BYTES = 8 * HTB;
__host__ __device__ __forceinline__ int lds_byte(int r, int c) { const int st = (r >> 4) * 2 + (c >> 5), rr = r & 15, cc = c & 31, ob = rr * 64 + cc * 2; return st * 1024 + (ob ^ (((ob >> 9) & 1) << 5)); }
__host__ __device__ __forceinline__ void stage_rc(int b, int& R, int& C) { const int st = b / 1024, sb = b % 1024, swz = sb ^ (((sb >> 9) & 1) << 5); R = (st >> 1) * 16 + swz / 64; C = (st & 1) * 32 + (swz % 64) / 2; }
__host__ __device__ __forceinline__ int perm32(int rho) { const int n = rho >> 4, i = rho & 15; return 8 * (i >> 2) + 4 * n + (i & 3); }

struct Unit { int pm, pn, aux; const char* a; const char* b; };
struct Ctx { int wr, wc, fr, fq, wid, lane; };

DI unsigned cvt_pk_bf16(float lo, float hi) { unsigned r; asm volatile("v_cvt_pk_bf16_f32 %0, %1, %2" : "=v"(r) : "v"(lo), "v"(hi)); return r; }

typedef f32x4 Acc[2][2][4][2];

DI void glds16_s(const char* gbase, unsigned voff, unsigned lds_dst) { unsigned keep;
    asm volatile("s_mov_b32 %0, m0\n\ts_mov_b32 m0, %1\n\ts_nop 0\n\tglobal_load_lds_dwordx4 %2, %3\n\ts_mov_b32 m0, %0" : "=&s"(keep) : "s"(lds_dst), "v"(voff), "s"(gbase) : "memory"); }
typedef int v8i_t __attribute__((ext_vector_type(8)));
typedef int i32x4_t __attribute__((ext_vector_type(4)));
template <class Epi, class Sched, bool FP8 = false>
DI void gemm_phase(LAS unsigned char* lds, const int K, const int lda, const int ldb, const Sched& S, const Epi& E) {
    int tid = threadIdx.x; asm volatile("" : "+v"(tid));
    const int wid = __builtin_amdgcn_readfirstlane(tid >> 6), lane = tid & 63, wr = wid >> 2, wc = wid & 3, fr = lane & 15, fq = lane >> 4;
    constexpr int ESZ = FP8 ? 1 : 2;
    const int nt = K * ESZ / (BK * 2);
    unsigned voffA[2], voffB[2];
#pragma unroll
    for (int i = 0; i < 2; ++i) { int R, C; stage_rc(tid * 16 + i * 8192, R, C); const int Rb = Epi::PERM ? ((R & ~31) + perm32(R & 31)) : R;
        voffA[i] = (unsigned)(R * lda * ESZ + C * 2); voffB[i] = (unsigned)(Rb * ldb * ESZ + C * 2); }
    const size_t kstep = (size_t)(BK * 2);
    const size_t hstepA = (size_t)HALF * lda * ESZ, hstepB = (size_t)HALF * ldb * ESZ;
    const unsigned ldsw = (unsigned)wid * 1024u;
    const int aoff = lds_byte(wr * 64 + fr, fq * 8), boff = lds_byte(wc * 32 + fr, fq * 8);
    const Ctx cx{wr, wc, fr, fq, wid, lane};
    const unsigned lds_u = (unsigned)__builtin_amdgcn_readfirstlane((int)((unsigned)(size_t)lds + ldsw));
    LAS unsigned char* ldsB = lds + 4 * HTB + boff;
#define PG8_SA(b, h) (((b) * 2 + (h)) * HTB)
#define PG8_SB(b, h) ((4 + (b) * 2 + (h)) * HTB)
#define PG8_SBL(b, h) (((b) * 2 + (h)) * HTB)
#define PG8_STAGE(bufoff, gbase, voff) do { _Pragma("unroll") for (int _i = 0; _i < 2; ++_i) \
        glds16_s((const char*)(gbase), (voff)[_i], lds_u + (unsigned)((bufoff) + _i * 8192)); } while (0)
#define PG8_RD(off) (*(const LAS i32x4_t*)(lds + (off)))
#define PG8_CAT2(x, y) __builtin_shufflevector((x), (y), 0, 1, 2, 3, 4, 5, 6, 7)
#define PG8_LDA(dst, b, h) do { if constexpr (FP8) { _Pragma("unroll") for (int m = 0; m < 4; ++m) dst##8[m] = PG8_CAT2(PG8_RD(PG8_SA(b, h) + aoff + m * 2048), PG8_RD(PG8_SA(b, h) + aoff + m * 2048 + 1024)); } \
        else { _Pragma("unroll") for (int m = 0; m < 4; ++m) _Pragma("unroll") for (int k = 0; k < 2; ++k) dst[m][k] = *(const LAS bf16x8*)(lds + PG8_SA(b, h) + aoff + m * 2048 + k * 1024); } } while (0)
#define PG8_LDB(dst, b, h) do { if constexpr (FP8) { _Pragma("unroll") for (int n = 0; n < 2; ++n) dst##8[n] = PG8_CAT2(*(const LAS i32x4_t*)(ldsB + PG8_SBL(b, h) + n * 2048), *(const LAS i32x4_t*)(ldsB + PG8_SBL(b, h) + n * 2048 + 1024)); } \
        else { _Pragma("unroll") for (int n = 0; n < 2; ++n) _Pragma("unroll") for (int k = 0; k < 2; ++k) dst[n][k] = *(const LAS bf16x8*)(ldsB + PG8_SBL(b, h) + n * 2048 + k * 1024); } } while (0)
#define PG8_MMA(ai, bj, At, Bt) do { __builtin_amdgcn_s_setprio(1); \
        if constexpr (FP8) { _Pragma("unroll") for (int m = 0; m < 4; ++m) _Pragma("unroll") for (int n = 0; n < 2; ++n) \
            acc[ai][bj][m][n] = __builtin_amdgcn_mfma_scale_f32_16x16x128_f8f6f4(Bt##8[n], At##8[m], acc[ai][bj][m][n], 0, 0, 0, 0x7f7f7f7f, 0, 0x7f7f7f7f); } \
        else { _Pragma("unroll") for (int m = 0; m < 4; ++m) _Pragma("unroll") for (int n = 0; n < 2; ++n) _Pragma("unroll") for (int k = 0; k < 2; ++k) \
            acc[ai][bj][m][n] = __builtin_amdgcn_mfma_f32_16x16x32_bf16(Bt[n][k], At[m][k], acc[ai][bj][m][n], 0, 0, 0); } \
        __builtin_amdgcn_s_setprio(0); } while (0)
#define PG8_WAIT_V(n) asm volatile("s_waitcnt vmcnt(" #n ")" ::: "memory")
#define PG8_WAIT_L(n) asm volatile("s_waitcnt lgkmcnt(" #n ")" ::: "memory")
#define PG8_BAR __builtin_amdgcn_s_barrier()
#define PG8_SCHED __builtin_amdgcn_sched_barrier(0)
    Unit cur, nxt; int ui = 0;
    if (!S.next(0, cur)) return;
    Acc acc;
#pragma unroll
    for (int a = 0; a < 2; ++a)
#pragma unroll
        for (int b = 0; b < 2; ++b)
#pragma unroll
            for (int m = 0; m < 4; ++m)
#pragma unroll
                for (int n = 0; n < 2; ++n) acc[a][b][m][n] = (f32x4){0.f, 0.f, 0.f, 0.f};
    bf16x8 At[4][2], B0[2][2], B1[2][2]; v8i_t At8[4], B08[2], B18[2];
    const char* cA = cur.a; const char* cB = cur.b;
    PG8_STAGE(PG8_SB(0, 0), cB, voffB); PG8_STAGE(PG8_SB(0, 1), cB + hstepB, voffB); PG8_STAGE(PG8_SA(0, 0), cA, voffA); PG8_STAGE(PG8_SA(0, 1), cA + hstepA, voffA);
    if (wr == 1) PG8_BAR;
    PG8_WAIT_V(2); PG8_BAR;
    PG8_STAGE(PG8_SB(1, 0), cB + kstep, voffB); PG8_STAGE(PG8_SA(1, 0), cA + kstep, voffA); PG8_STAGE(PG8_SB(1, 1), cB + hstepB + kstep, voffB);
    PG8_WAIT_V(6); PG8_BAR;
    for (;;) {
        const bool has_next = S.next(ui + 1, nxt);
        const char* nA = has_next ? nxt.a : cA; const char* nB = has_next ? nxt.b : cB;
#pragma unroll 1
        for (int t = 0; t < nt; t += 2) {
            const bool last = (t == nt - 2);
            const char* a1 = cA + (size_t)(t + 1) * kstep;
            const char* a2 = last ? nA : cA + (size_t)(t + 2) * kstep; const char* b2 = last ? nB : cB + (size_t)(t + 2) * kstep;
            const char* a3 = a2 + kstep; const char* b3 = b2 + kstep;
            PG8_LDB(B0, 0, 0); PG8_LDB(B1, 0, 1); PG8_SCHED; PG8_LDA(At, 0, 0); PG8_STAGE(PG8_SA(1, 1), a1 + hstepA, voffA);
            PG8_WAIT_V(8); PG8_WAIT_L(0); PG8_BAR; PG8_MMA(0, 0, At, B0); PG8_MMA(0, 1, At, B1); PG8_BAR; PG8_SCHED;
            PG8_LDA(At, 0, 1); PG8_STAGE(PG8_SB(0, 0), b2, voffB); PG8_STAGE(PG8_SB(0, 1), b2 + hstepB, voffB); PG8_STAGE(PG8_SA(0, 0), a2, voffA);
            PG8_WAIT_V(8); PG8_WAIT_L(0); PG8_BAR; PG8_MMA(1, 0, At, B0); PG8_MMA(1, 1, At, B1); PG8_BAR; PG8_SCHED;
            PG8_LDB(B0, 1, 0); PG8_LDB(B1, 1, 1); PG8_SCHED; PG8_LDA(At, 1, 0); PG8_STAGE(PG8_SA(0, 1), a2 + hstepA, voffA);
            PG8_WAIT_V(8); PG8_WAIT_L(0); PG8_BAR; PG8_MMA(0, 0, At, B0); PG8_MMA(0, 1, At, B1); PG8_BAR; PG8_SCHED;
            PG8_LDA(At, 1, 1); PG8_STAGE(PG8_SB(1, 0), b3, voffB); PG8_STAGE(PG8_SB(1, 1), b3 + hstepB, voffB); PG8_STAGE(PG8_SA(1, 0), a3, voffA);
            PG8_WAIT_V(8); PG8_WAIT_L(0); PG8_BAR; PG8_MMA(1, 0, At, B0); PG8_MMA(1, 1, At, B1); PG8_BAR; PG8_SCHED;
        }
        if (wr == 0) PG8_BAR;
        E(acc, cur, cx);
        if (!has_next) break;
#pragma unroll
        for (int a = 0; a < 2; ++a)
#pragma unroll
            for (int b = 0; b < 2; ++b)
#pragma unroll
                for (int m = 0; m < 4; ++m)
#pragma unroll
                    for (int n = 0; n < 2; ++n) acc[a][b][m][n] = (f32x4){0.f, 0.f, 0.f, 0.f};
        cur = nxt; cA = nA; cB = nB; ++ui;
        if (wr == 1) PG8_BAR;
    }
    PG8_WAIT_V(0);
    PG8_BAR;
#undef PG8_SA
#undef PG8_SB
#undef PG8_SBL
#undef PG8_STAGE
#undef PG8_LDA
#undef PG8_LDB
#undef PG8_MMA
#undef PG8_CAT2
#undef PG8_RD
#undef PG8_WAIT_V
#undef PG8_WAIT_L
#undef PG8_BAR
#undef PG8_SCHED
}
}
namespace pg8 {
constexpr int NXCD = 8, WGM = 8;
struct DenseOrder {
    const char* A; const char* B; int nM, nN, nwg, G, c; size_t strideA, strideB;
    DI void init(const void* A_, const void* B_, int M, int N, int lda, int ldb, int G_, int c_) { A = (const char*)A_; B = (const char*)B_; nM = M / BM; nN = N / BM; nwg = nM * nN; G = G_; c = c_;
        strideA = (size_t)BM * lda * 2; strideB = (size_t)BM * ldb * 2; }
    DI bool next(int i, Unit& u) const {
        const long L = (long)i * G + c; if (L >= nwg) return false;
        int wgid = (int)L; { const int q = nwg / NXCD, r = nwg % NXCD, xcd = wgid % NXCD, off = wgid / NXCD; wgid = (xcd < r ? xcd * (q + 1) : r * (q + 1) + (xcd - r) * q) + off; }
        const int nig = WGM * nN, gid = wgid / nig, fm = gid * WGM, gsz = (nM - fm) < WGM ? (nM - fm) : WGM;
        u.pm = fm + ((wgid % nig) % gsz); u.pn = (wgid % nig) / gsz; u.aux = 0;
        u.a = A + (size_t)u.pm * strideA; u.b = B + (size_t)u.pn * strideB; return true;
    }
};
struct P1Order {
    DenseOrder proj; const char* memb; const char* wck; const char* wcv; int G, c;
    DI bool next(int i, Unit& u) const {
        if (proj.next(i, u)) return true;
        const int L = i * G + c - proj.nwg; if (L < 0 || L >= 128) return false;
        const int kind = L >> 6, r = L & 63;
        if (kind == 0) { u.pm = r >> 2; u.pn = r & 3; u.aux = 1; u.a = memb + (size_t)u.pm * 256 * D * 2; u.b = wck + (size_t)u.pn * 256 * D * 2; }
        else { u.pm = r >> 4; u.pn = r & 15; u.aux = 2; u.a = wcv + (size_t)u.pm * 256 * D * 2; u.b = memb + (size_t)u.pn * 256 * D * 2; }
        return true;
    }
};
struct PairOrderA {
    const char* A; const char* B; int G, v;
    DI bool next(int i, Unit& u) const { const int L = i * G + v; if (L >= (T / 256) * 4) return false;
        u.pm = L >> 2; u.pn = L & 3; u.aux = 0; u.a = A + ((size_t)u.pm * 256 * MW + (u.pn & 1) * 256) * 2; u.b = B + (size_t)u.pn * 256 * 256 * 2; return true; }
};
struct PairOrderB {
    const char* A; const char* B; int G, v;
    DI bool next(int i, Unit& u) const { const int L = i * G + v; if (L >= 2 * (T / 256)) return false;
        u.pm = L & 1; u.pn = L >> 1; u.aux = 0; u.a = A + (size_t)u.pm * 256 * 256 * 2; u.b = B + ((size_t)u.pn * 256 * MW + u.pm * 256) * 2; return true; }
};
struct CrossSOrder {
    const char* Q; const char* Kc; int G, v;
    DI bool next(int i, Unit& u) const {
        const int L = i * G + v; if (L >= (T / 256) * XH) return false;
        u.pm = L >> 2; u.pn = L & 3; u.aux = 0;
        u.a = Q + ((size_t)u.pm * 256 * D + u.pn * 256) * 2; u.b = Kc + ((size_t)(u.pm >> 3) * 256 * D + u.pn * 256) * 2; return true;
    }
};
struct CrossOOrder {
    const char* P; const char* Vt; int G, v;
    DI bool next(int i, Unit& u) const {
        const int L = i * G + v; if (L >= (T / 256) * XH) return false;
        u.pm = L >> 2; u.pn = L & 3; u.aux = 0;
        u.a = P + ((size_t)u.pm * 256 * D + u.pn * 256) * 2; u.b = Vt + ((size_t)u.pn * 256 * (NB * NMEM) + (size_t)(u.pm >> 3) * 256) * 2; return true;
    }
};
struct MoeOrder {
    const char* A; const char* W; const LAS int* tstart; const LAS int* tile_e; int npn, G, v; size_t strideA, strideW, strideN;
    DI bool next(int i, Unit& u) const {
        const int L = i * G + v; const int total = __builtin_amdgcn_readfirstlane(tstart[NE]) * npn; if (L >= total) return false;
        const int tile = L / npn; u.pm = tile; u.pn = L - tile * npn;
        const int e = __builtin_amdgcn_readfirstlane(tile_e[tile]);
        u.aux = e;
        u.a = A + (size_t)tile * strideA; u.b = W + (size_t)e * strideW + (size_t)u.pn * strideN; return true;
    }
};

DI unsigned pk4_fp8(float a, float b, float c, float d) { int w = 0; w = __builtin_amdgcn_cvt_pk_fp8_f32(a, b, w, false); w = __builtin_amdgcn_cvt_pk_fp8_f32(c, d, w, true); return (unsigned)w; }
constexpr float F8_XS = 16.0f, F8_WS = 64.0f, F8_AS = 8.0f;
struct EpiBf16 {
    static constexpr bool PERM = true;
    bf16_t* O; int ldc; int sc_from; float scale;
    DI void operator()(const Acc& acc, const Unit& u, const Ctx& c) const {
        int row0 = u.pm * BM + c.wr * 64 + c.fr, col0 = u.pn * BM + c.wc * 32 + 8 * c.fq; asm volatile("" : "+v"(row0), "+v"(col0));
        const float sc = (u.pn >= sc_from) ? scale : 1.0f;
#pragma unroll
        for (int ai = 0; ai < 2; ++ai)
#pragma unroll
            for (int m = 0; m < 4; ++m) { bf16_t* rowp = O + (size_t)(row0 + ai * HALF + m * 16) * ldc + col0;
#pragma unroll
                for (int bj = 0; bj < 2; ++bj) { const f32x4 v0 = acc[ai][bj][m][0] * sc, v1 = acc[ai][bj][m][1] * sc;
                    u32x4 w; w.x = cvt_pk_bf16(v0[0], v0[1]); w.y = cvt_pk_bf16(v0[2], v0[3]); w.z = cvt_pk_bf16(v1[0], v1[1]); w.w = cvt_pk_bf16(v1[2], v1[3]);
                    *(u32x4*)(rowp + bj * HALF) = w; } }
    }
};
struct EpiProj {
    static constexpr bool PERM = true;
    bf16_t* O; float* gates; bf16_t* Kc; bf16_t* VcT;
    DI void operator()(const Acc& acc, const Unit& u, const Ctx& c) const {
        int row0 = u.pm * BM + c.wr * 64 + c.fr, col0 = u.pn * BM + c.wc * 32 + 8 * c.fq; asm volatile("" : "+v"(row0), "+v"(col0));
        bf16_t* base = (u.aux == 0) ? O : (u.aux == 1) ? Kc : VcT; const int ldc = (u.aux == 0) ? NPROJ : (u.aux == 1) ? D : NB * NMEM;
#pragma unroll
        for (int ai = 0; ai < 2; ++ai)
#pragma unroll
            for (int m = 0; m < 4; ++m) { const int row = row0 + ai * HALF + m * 16; bf16_t* rowp = base + (size_t)row * ldc + col0;
#pragma unroll
                for (int bj = 0; bj < 2; ++bj) { const f32x4 v0 = acc[ai][bj][m][0], v1 = acc[ai][bj][m][1];
                    u32x4 w; w.x = cvt_pk_bf16(v0[0], v0[1]); w.y = cvt_pk_bf16(v0[2], v0[3]); w.z = cvt_pk_bf16(v1[0], v1[1]); w.w = cvt_pk_bf16(v1[2], v1[3]);
                    *(u32x4*)(rowp + bj * HALF) = w; }
                if (u.aux == 0 && u.pn == 1 && c.wc == 1 && c.fq == 0) { *(f32x4*)(gates + (size_t)row * 8) = acc[ai][1][m][0]; *(f32x4*)(gates + (size_t)row * 8 + 4) = acc[ai][1][m][1]; } }
    }
};
struct EpiQmla {
    static constexpr bool PERM = true;
    bf16_t* O; const float* cs;
    float scale;
    DI void operator()(const Acc& acc, const Unit& u, const Ctx& c) const {
        int row0 = u.pm * BM + c.wr * 64 + c.fr, col0 = u.pn * BM + c.wc * 32 + 8 * c.fq; asm volatile("" : "+v"(row0), "+v"(col0));
#pragma unroll
        for (int ai = 0; ai < 2; ++ai)
#pragma unroll
            for (int m = 0; m < 4; ++m) { const int row = row0 + ai * HALF + m * 16; bf16_t* rowp = O + (size_t)row * (AH * AQK) + col0;
#pragma unroll
                for (int bj = 0; bj < 2; ++bj) { f32x4 v0 = acc[ai][bj][m][0] * scale, v1 = acc[ai][bj][m][1] * scale;
                    const int cc = (col0 + bj * HALF) % AQK;
                    if (cc >= ANOPE) { const int p0 = (cc - ANOPE) >> 1;
                        const f32x4 t0 = *(const f32x4*)(cs + (size_t)row * 32 + p0 * 2), t1 = *(const f32x4*)(cs + (size_t)row * 32 + p0 * 2 + 4);
                        f32x4 r0, r1;
                        r0[0] = v0[0] * t0[0] - v0[1] * t0[1]; r0[1] = v0[1] * t0[0] + v0[0] * t0[1];
                        r0[2] = v0[2] * t0[2] - v0[3] * t0[3]; r0[3] = v0[3] * t0[2] + v0[2] * t0[3];
                        r1[0] = v1[0] * t1[0] - v1[1] * t1[1]; r1[1] = v1[1] * t1[0] + v1[0] * t1[1];
                        r1[2] = v1[2] * t1[2] - v1[3] * t1[3]; r1[3] = v1[3] * t1[2] + v1[2] * t1[3];
                        v0 = r0; v1 = r1; }
                    u32x4 w; w.x = cvt_pk_bf16(v0[0], v0[1]); w.y = cvt_pk_bf16(v0[2], v0[3]); w.z = cvt_pk_bf16(v1[0], v1[1]); w.w = cvt_pk_bf16(v1[2], v1[3]);
                    *(u32x4*)(rowp + bj * HALF) = w; } }
    }
};
template <bool ADD> struct EpiGate {
    static constexpr bool PERM = true;
    bf16_t* O; const bf16_t* proj; int gcol;
    DI void operator()(const Acc& acc, const Unit& u, const Ctx& c) const {
        int row0 = u.pm * BM + c.wr * 64 + c.fr, col0 = u.pn * BM + c.wc * 32 + 8 * c.fq; asm volatile("" : "+v"(row0), "+v"(col0));
#pragma unroll
        for (int ai = 0; ai < 2; ++ai) {
            u32x4 gg[4][2], pp[4][2];
#pragma unroll
            for (int m = 0; m < 4; ++m)
#pragma unroll
                for (int bj = 0; bj < 2; ++bj) { const int row = row0 + ai * HALF + m * 16; gg[m][bj] = *(const u32x4*)(proj + (size_t)row * NPROJ + gcol + col0 + bj * HALF);
                    if (ADD) pp[m][bj] = *(const u32x4*)(O + (size_t)row * D + col0 + bj * HALF); }
#pragma unroll
            for (int m = 0; m < 4; ++m) { const int row = row0 + ai * HALF + m * 16; bf16_t* rowp = O + (size_t)row * D + col0;
#pragma unroll
                for (int bj = 0; bj < 2; ++bj) { const f32x4 v0 = acc[ai][bj][m][0], v1 = acc[ai][bj][m][1];
                    const u32x4 g = gg[m][bj];
                    float o[8];
                    o[0] = sigmoidf_(bflo(g.x)) * v0[0]; o[1] = sigmoidf_(bfhi(g.x)) * v0[1]; o[2] = sigmoidf_(bflo(g.y)) * v0[2]; o[3] = sigmoidf_(bfhi(g.y)) * v0[3];
                    o[4] = sigmoidf_(bflo(g.z)) * v1[0]; o[5] = sigmoidf_(bfhi(g.z)) * v1[1]; o[6] = sigmoidf_(bflo(g.w)) * v1[2]; o[7] = sigmoidf_(bfhi(g.w)) * v1[3];
                    if (ADD) { const u32x4 p = pp[m][bj];
                        o[0] += bflo(p.x); o[1] += bfhi(p.x); o[2] += bflo(p.y); o[3] += bfhi(p.y); o[4] += bflo(p.z); o[5] += bfhi(p.z); o[6] += bflo(p.w); o[7] += bfhi(p.w); }
                    u32x4 w; w.x = cvt_pk_bf16(o[0], o[1]); w.y = cvt_pk_bf16(o[2], o[3]); w.z = cvt_pk_bf16(o[4], o[5]); w.w = cvt_pk_bf16(o[6], o[7]);
                    *(u32x4*)(rowp + bj * HALF) = w; } }
            __builtin_amdgcn_sched_barrier(0); }
    }
};
struct EpiF32 {
    static constexpr bool PERM = false;
    float* C; int ldc; int ncols_valid;
    DI void operator()(const Acc& acc, const Unit& u, const Ctx& c) const {
        int row0 = u.pm * BM + c.wr * 64 + c.fr, col0 = u.pn * BM + c.wc * 32 + 4 * c.fq; asm volatile("" : "+v"(row0), "+v"(col0));
#pragma unroll
        for (int ai = 0; ai < 2; ++ai)
#pragma unroll
            for (int m = 0; m < 4; ++m) { float* rowp = C + (size_t)(row0 + ai * HALF + m * 16) * ldc + col0;
#pragma unroll
                for (int bj = 0; bj < 2; ++bj)
#pragma unroll
                    for (int n = 0; n < 2; ++n) if (col0 + bj * HALF + n * 16 < ncols_valid) *(f32x4*)(rowp + bj * HALF + n * 16) = acc[ai][bj][m][n]; }
    }
};

DI void row_stats(const float* stats, int row, float& mean, float& rstd) { const f32x2 st = *(const f32x2*)(stats + (size_t)row * 2);
    mean = st[0] * (1.0f / D); const float var = fmaxf(st[1] * (1.0f / D) - mean * mean, 0.f); rstd = __builtin_amdgcn_rsqf(var + EPS); }
template <bool NORM> struct EpiResStats {
    static constexpr bool PERM = true;
    const bf16_t* res; const float* pstats; const float* pg; const float* pb; bf16_t* VB; float* stats;
    DI void operator()(const Acc& acc, const Unit& u, const Ctx& c) const {
        int row0 = u.pm * BM + c.wr * 64 + c.fr, col0 = u.pn * BM + c.wc * 32 + 8 * c.fq; asm volatile("" : "+v"(row0), "+v"(col0));
#pragma unroll
        for (int ai = 0; ai < 2; ++ai) {
            u32x4 rr[4][2];
#pragma unroll
            for (int m = 0; m < 4; ++m)
#pragma unroll
                for (int bj = 0; bj < 2; ++bj) rr[m][bj] = *(const u32x4*)(res + (size_t)(row0 + ai * HALF + m * 16) * D + col0 + bj * HALF);
#pragma unroll
            for (int m = 0; m < 4; ++m) { const int row = row0 + ai * HALF + m * 16; const size_t ro = (size_t)row * D + col0;
                float mean = 0.f, rstd = 1.f; if (NORM) row_stats(pstats, row, mean, rstd);
                float s1 = 0.f, s2 = 0.f;
#pragma unroll
                for (int bj = 0; bj < 2; ++bj) { const u32x4 w = rr[m][bj];
                    f32x4 r0 = {bflo(w.x), bfhi(w.x), bflo(w.y), bfhi(w.y)}, r1 = {bflo(w.z), bfhi(w.z), bflo(w.w), bfhi(w.w)};
                    if (NORM) { const f32x4 g0 = *(const f32x4*)(pg + col0 + bj * HALF), g1 = *(const f32x4*)(pg + col0 + bj * HALF + 4), b0 = *(const f32x4*)(pb + col0 + bj * HALF), b1 = *(const f32x4*)(pb + col0 + bj * HALF + 4);
                        r0 = (r0 - mean) * rstd * g0 + b0; r1 = (r1 - mean) * rstd * g1 + b1; }
                    const f32x4 v0 = r0 * DN_ALPHA + acc[ai][bj][m][0], v1 = r1 * DN_ALPHA + acc[ai][bj][m][1];
                    u32x4 o; o.x = cvt_pk_bf16(v0[0], v0[1]); o.y = cvt_pk_bf16(v0[2], v0[3]); o.z = cvt_pk_bf16(v1[0], v1[1]); o.w = cvt_pk_bf16(v1[2], v1[3]);
                    *(u32x4*)(VB + ro + bj * HALF) = o;
                    s1 += (v0[0] + v0[1]) + (v0[2] + v0[3]) + (v1[0] + v1[1]) + (v1[2] + v1[3]);
                    s2 += (v0[0] * v0[0] + v0[1] * v0[1]) + (v0[2] * v0[2] + v0[3] * v0[3]) + (v1[0] * v1[0] + v1[1] * v1[1]) + (v1[2] * v1[2] + v1[3] * v1[3]); }
                s1 += __shfl_xor(s1, 16); s1 += __shfl_xor(s1, 32); s2 += __shfl_xor(s2, 16); s2 += __shfl_xor(s2, 32);
                if (c.fq == 0) { __hip_atomic_fetch_add(stats + (size_t)row * 2, s1, RLX_AGENT); __hip_atomic_fetch_add(stats + (size_t)row * 2 + 1, s2, RLX_AGENT); } }
            __builtin_amdgcn_sched_barrier(0); }
    }
};
struct EpiLNApplyBf16 {
    static constexpr bool PERM = true;
    bf16_t* O; int ldc; const float* stats; const float* cs; const float* cb; float scale;
    DI void operator()(const Acc& acc, const Unit& u, const Ctx& c) const {
        int row0 = u.pm * BM + c.wr * 64 + c.fr, col0 = u.pn * BM + c.wc * 32 + 8 * c.fq; asm volatile("" : "+v"(row0), "+v"(col0));
        f32x4 csv[2][2], cbv[2][2];
#pragma unroll
        for (int bj = 0; bj < 2; ++bj)
#pragma unroll
            for (int n = 0; n < 2; ++n) { csv[bj][n] = *(const f32x4*)(cs + col0 + bj * HALF + 4 * n); cbv[bj][n] = *(const f32x4*)(cb + col0 + bj * HALF + 4 * n); }
        f32x2 sts[2][4];
#pragma unroll
        for (int ai = 0; ai < 2; ++ai)
#pragma unroll
            for (int m = 0; m < 4; ++m) sts[ai][m] = *(const f32x2*)(stats + (size_t)(row0 + ai * HALF + m * 16) * 2);
#pragma unroll
        for (int ai = 0; ai < 2; ++ai)
#pragma unroll
            for (int m = 0; m < 4; ++m) { const int row = row0 + ai * HALF + m * 16; const float mean = sts[ai][m][0] * (1.0f / D); const float rstd = __builtin_amdgcn_rsqf(fmaxf(sts[ai][m][1] * (1.0f / D) - mean * mean, 0.f) + EPS);
                bf16_t* rowp = O + (size_t)row * ldc + col0;
#pragma unroll
                for (int bj = 0; bj < 2; ++bj) { const f32x4 v0 = ((acc[ai][bj][m][0] - csv[bj][0] * mean) * rstd + cbv[bj][0]) * scale, v1 = ((acc[ai][bj][m][1] - csv[bj][1] * mean) * rstd + cbv[bj][1]) * scale;
                    u32x4 w; w.x = cvt_pk_bf16(v0[0], v0[1]); w.y = cvt_pk_bf16(v0[2], v0[3]); w.z = cvt_pk_bf16(v1[0], v1[1]); w.w = cvt_pk_bf16(v1[2], v1[3]);
                    *(u32x4*)(rowp + bj * HALF) = w; } }
    }
};
struct EpiLNApplyF32 {
    static constexpr bool PERM = false;
    float* C; int ldc; int ncols_valid; const float* stats; const float* cs; const float* cb;
    DI void operator()(const Acc& acc, const Unit& u, const Ctx& c) const {
        int row0 = u.pm * BM + c.wr * 64 + c.fr, col0 = u.pn * BM + c.wc * 32 + 4 * c.fq; asm volatile("" : "+v"(row0), "+v"(col0));
#pragma unroll
        for (int ai = 0; ai < 2; ++ai)
#pragma unroll
            for (int m = 0; m < 4; ++m) { const int row = row0 + ai * HALF + m * 16; float mean, rstd; row_stats(stats, row, mean, rstd);
                float* rowp = C + (size_t)row * ldc + col0;
#pragma unroll
                for (int bj = 0; bj < 2; ++bj)
#pragma unroll
                    for (int n = 0; n < 2; ++n) if (col0 + bj * HALF + n * 16 < ncols_valid) { const f32x4 csv = *(const f32x4*)(cs + col0 + bj * HALF + n * 16), cbv = *(const f32x4*)(cb + col0 + bj * HALF + n * 16);
                        *(f32x4*)(rowp + bj * HALF + n * 16) = (acc[ai][bj][m][n] - csv * mean) * rstd + cbv; } }
    }
};
struct EpiSoftmax {
    static constexpr bool PERM = true;
    bf16_t* O; LAS float* red;
    DI void operator()(Acc& acc, const Unit& u, const Ctx& c) const {
        int row0 = u.pm * BM + c.wr * 64 + c.fr, col0 = u.pn * BM + c.wc * 32 + 8 * c.fq; asm volatile("" : "+v"(row0), "+v"(col0));
        int rbase = (c.wr * 64 + c.fr) * 4; asm volatile("" : "+v"(rbase));
        LAS float* r1 = red + rbase; LAS float* r2 = red + 1024 + rbase;
#pragma unroll
        for (int ai = 0; ai < 2; ++ai)
#pragma unroll
            for (int m = 0; m < 4; ++m) { float v = -INFINITY;
#pragma unroll
                for (int bj = 0; bj < 2; ++bj)
#pragma unroll
                    for (int n = 0; n < 2; ++n) { const f32x4 x = acc[ai][bj][m][n]; v = fmaxf(v, fmaxf(fmaxf(x[0], x[1]), fmaxf(x[2], x[3]))); }
                v = fmaxf(v, __shfl_xor(v, 16)); v = fmaxf(v, __shfl_xor(v, 32));
                if (c.fq == 0) r1[(ai * HALF + m * 16) * 4 + c.wc] = v;
                __builtin_amdgcn_sched_barrier(0); }
        asm volatile("s_waitcnt lgkmcnt(0)" ::: "memory"); __builtin_amdgcn_s_barrier(); asm volatile("" ::: "memory");
#pragma unroll
        for (int ai = 0; ai < 2; ++ai)
#pragma unroll
            for (int m = 0; m < 4; ++m) { const f32x4 q = *(const LAS f32x4*)(r1 + (ai * HALF + m * 16) * 4);
                const float mm = fmaxf(fmaxf(q[0], q[1]), fmaxf(q[2], q[3])); float s = 0.f;
#pragma unroll
                for (int bj = 0; bj < 2; ++bj)
#pragma unroll
                    for (int n = 0; n < 2; ++n) { f32x4 x = acc[ai][bj][m][n];
                        x[0] = __builtin_amdgcn_exp2f(x[0] - mm); x[1] = __builtin_amdgcn_exp2f(x[1] - mm); x[2] = __builtin_amdgcn_exp2f(x[2] - mm); x[3] = __builtin_amdgcn_exp2f(x[3] - mm);
                        acc[ai][bj][m][n] = x; s += (x[0] + x[1]) + (x[2] + x[3]); }
                s += __shfl_xor(s, 16); s += __shfl_xor(s, 32);
                if (c.fq == 0) r2[(ai * HALF + m * 16) * 4 + c.wc] = s;
                __builtin_amdgcn_sched_barrier(0); }
        asm volatile("s_waitcnt lgkmcnt(0)" ::: "memory"); __builtin_amdgcn_s_barrier(); asm volatile("" ::: "memory");
#pragma unroll
        for (int ai = 0; ai < 2; ++ai)
#pragma unroll
            for (int m = 0; m < 4; ++m) { const f32x4 q = *(const LAS f32x4*)(r2 + (ai * HALF + m * 16) * 4);
                const float inv = rcpf_((q[0] + q[1]) + (q[2] + q[3]));
                bf16_t* rowp = O + (size_t)(row0 + ai * HALF + m * 16) * D + col0;
#pragma unroll
                for (int bj = 0; bj < 2; ++bj) { const f32x4 v0 = acc[ai][bj][m][0] * inv, v1 = acc[ai][bj][m][1] * inv;
                    u32x4 w; w.x = cvt_pk_bf16(v0[0], v0[1]); w.y = cvt_pk_bf16(v0[2], v0[3]); w.z = cvt_pk_bf16(v1[0], v1[1]); w.w = cvt_pk_bf16(v1[2], v1[3]);
                    *(u32x4*)(rowp + bj * HALF) = w; }
                __builtin_amdgcn_sched_barrier(0); }
    }
};
struct EpiSwiglu {
    static constexpr bool PERM = true;
    unsigned char* O; const float* bias;
    DI void operator()(const Acc& acc, const Unit& u, const Ctx& c) const {
        int row0 = u.pm * BM + c.wr * 64 + c.fr, col0 = u.pn * BM + c.wc * 32 + 8 * c.fq; asm volatile("" : "+v"(row0), "+v"(col0));
        constexpr float us = 1.0f / (F8_XS * F8_WS);
        f32x4 bv[2][2];
#pragma unroll
        for (int bj = 0; bj < 2; ++bj)
#pragma unroll
            for (int n = 0; n < 2; ++n) bv[bj][n] = *(const f32x4*)(bias + (size_t)u.aux * 2048 + col0 + bj * HALF + 4 * n);
#pragma unroll
        for (int ai = 0; ai < 2; ++ai)
#pragma unroll
            for (int m = 0; m < 4; ++m) { unsigned char* rowp = O + (size_t)(row0 + ai * HALF + m * 16) * 1024 + (col0 >> 1);
#pragma unroll
                for (int bj = 0; bj < 2; ++bj) { const f32x4 v0 = acc[ai][bj][m][0] * us + bv[bj][0], v1 = acc[ai][bj][m][1] * us + bv[bj][1];
                    float o[4];
#define SWG(g, l) ({ const float g_ = fminf((g), 7.0f), l_ = fminf(fmaxf((l), -7.0f), 7.0f); fminf(fmaxf(g_ * sigmoidf_(1.702f * g_) * (l_ + 1.0f) * F8_AS, -448.0f), 448.0f); })
                    o[0] = SWG(v0[0], v0[1]); o[1] = SWG(v0[2], v0[3]); o[2] = SWG(v1[0], v1[1]); o[3] = SWG(v1[2], v1[3]);
#undef SWG
                    *(unsigned*)(rowp + bj * (HALF / 2)) = pk4_fp8(o[0], o[1], o[2], o[3]); } }
    }
};
struct EpiDown {
    static constexpr bool PERM = true;
    bf16_t* O; const float* bias; const float* rowgate;
    DI void operator()(const Acc& acc, const Unit& u, const Ctx& c) const {
        int row0 = u.pm * BM + c.wr * 64 + c.fr, col0 = u.pn * BM + c.wc * 32 + 8 * c.fq; asm volatile("" : "+v"(row0), "+v"(col0));
        f32x4 bv[2][2];
#pragma unroll
        for (int bj = 0; bj < 2; ++bj)
#pragma unroll
            for (int n = 0; n < 2; ++n) bv[bj][n] = *(const f32x4*)(bias + (size_t)u.aux * 1024 + col0 + bj * HALF + 4 * n);
#pragma unroll
        for (int ai = 0; ai < 2; ++ai) { float gts[4];
#pragma unroll
            for (int m = 0; m < 4; ++m) gts[m] = rowgate[row0 + ai * HALF + m * 16];
#pragma unroll
            for (int m = 0; m < 4; ++m) { const int row = row0 + ai * HALF + m * 16; const float gt = gts[m]; bf16_t* rowp = O + (size_t)row * 1024 + col0;
#pragma unroll
                for (int bj = 0; bj < 2; ++bj) { const f32x4 v0 = (acc[ai][bj][m][0] * (1.0f / (F8_AS * F8_WS)) + bv[bj][0]) * gt, v1 = (acc[ai][bj][m][1] * (1.0f / (F8_AS * F8_WS)) + bv[bj][1]) * gt;
                    u32x4 w; w.x = cvt_pk_bf16(v0[0], v0[1]); w.y = cvt_pk_bf16(v0[2], v0[3]); w.z = cvt_pk_bf16(v1[0], v1[1]); w.w = cvt_pk_bf16(v1[2], v1[3]);
                    *(u32x4*)(rowp + bj * HALF) = w; } } }
    }
};
}
constexpr size_t MiB = 1u << 20;
constexpr size_t WS_CTL = 0, CTL_ZERO_BYTES = 1 * MiB;
constexpr size_t WS_W_IN = 2 * MiB, WS_W_UQ = 10 * MiB, WS_W_UK = WS_W_UQ + 512 * 1024, WS_W_UV = WS_W_UK + 256 * 1024, WS_W_MQK = 11 * MiB, WS_W_BRM = 12 * MiB, WS_W_BRA = 13 * MiB,
                 WS_W_MIX = 14 * MiB, WS_W_CQ = 16 * MiB, WS_W_CK = 18 * MiB, WS_W_CV = 20 * MiB, WS_W_CO = 22 * MiB, WS_W_R = 24 * MiB, WS_W_GU = 26 * MiB, WS_W_DN = 90 * MiB;
constexpr size_t WS_GATES = 218 * MiB, WS_CS = 219 * MiB, WS_KPE = 223 * MiB, WS_MEMB = 225 * MiB, WS_KC = 233 * MiB, WS_VCT = 241 * MiB, WS_LOGITS = 249 * MiB,
                 WS_ASSIGN = 253 * MiB, WS_GATEW = WS_ASSIGN + 512 * 1024, WS_TOKPOS = 254 * MiB, WS_ROWGATE = WS_TOKPOS + 512 * 1024;
constexpr size_t WS_XB = 256 * MiB, WS_PROJ = 320 * MiB, WS_QN = 576 * MiB, WS_KVN = 592 * MiB, WS_XC = 608 * MiB, WS_QMLA = 640 * MiB, WS_KN = 688 * MiB, WS_VT = 720 * MiB,
                 WS_QKM = 752 * MiB, WS_KTM = 816 * MiB, WS_AO = 848 * MiB, WS_HRAW = 880 * MiB, WS_HM = 944 * MiB;
constexpr size_t WS_GATED = 576 * MiB, WS_V1B = 704 * MiB, WS_QC = 384 * MiB, WS_PC = 448 * MiB, WS_OC = 320 * MiB, WS_V2B = 864 * MiB;
constexpr size_t WS_XG = 320 * MiB, WS_ACT = 456 * MiB, WS_YB = 592 * MiB, WS_END = 976 * MiB;
static_assert((size_t)NROWS * 1024 * 2 <= 272 * MiB, "routed buffers");
static_assert(WS_ROWGATE + (size_t)NROWS * 4 <= 256 * MiB, "small buffers");
constexpr int CW_TMO = 0, CW_CNT = 64  , CW_BAR = 4096;
constexpr size_t CTL_CS1 = 64 * 1024, CTL_CB1 = 68 * 1024, CTL_CSR = 72 * 1024, CTL_CBR = 73 * 1024;
constexpr size_t CTL_STATS1 = 256 * 1024, CTL_STATS2 = 512 * 1024;

constexpr int RING_OFF = 0, RING_BYTES = 131072;
constexpr int RED_OFF = RING_BYTES;
constexpr int TST_OFF = RED_OFF + 8192;
constexpr int HIST_OFF = TST_OFF + 256, HBASE_OFF = HIST_OFF + 128;
constexpr int MISC_OFF = HBASE_OFF + 128;
constexpr int TILE_E_OFF = MISC_OFF + 128;
constexpr int LDSCTL_OFF = TST_OFF;
constexpr int LDS_BYTES = 147456;
static_assert(TILE_E_OFF + NTILES_MAX * 4 <= LDS_BYTES, "LDS map");
constexpr int NWAVES = 8;

#define LDS_WAIT() asm volatile("s_waitcnt lgkmcnt(0)" ::: "memory")
#define VM_WAIT() asm volatile("s_waitcnt vmcnt(0)" ::: "memory")

#define XB_TMO      128
#define XB_XCNT(j)  (256  + 64 * (j))
#define XB_XSUB(j)  (1280 + 64 * (j))
#define XB_XGEN(j)  (2304 + 64 * (j))
#define XB_TOP      3328
#define XB_TOPGEN   3392
#define XCD_BAR_WORDS 3456
#define XB_SPIN_CAP (1u << 18)
__device__ __forceinline__ unsigned xb_ld(unsigned* p)              { return __hip_atomic_load(p, __ATOMIC_RELAXED, __HIP_MEMORY_SCOPE_AGENT); }
__device__ __forceinline__ unsigned xb_add(unsigned* p, unsigned v) { return __hip_atomic_fetch_add(p, v, __ATOMIC_RELAXED, __HIP_MEMORY_SCOPE_AGENT); }
__device__ __forceinline__ unsigned xb_xcc_id() { return (unsigned)__builtin_amdgcn_s_getreg((3 << 11) | 20) & 0xFu; }
#define XB_SPIN(cond, bar) do { unsigned _sp = 0; while (cond) { __builtin_amdgcn_s_sleep(1); \
    if ((++_sp & 255u) == 0u) { if (xb_ld(&(bar)[XB_TMO])) break; if (_sp > XB_SPIN_CAP) { atomicAdd(&(bar)[XB_TMO], 1u); break; } } } } while (0)
struct XcdBarrier { unsigned* bar; unsigned x; volatile LAS unsigned* st; };
__device__ __forceinline__ XcdBarrier xcd_barrier_post(unsigned* bar, volatile LAS unsigned* st) {
    XcdBarrier b; b.bar = bar; b.x = xb_xcc_id(); b.st = st;
    if (threadIdx.x == 0) (void)xb_add(&bar[XB_XCNT(b.x)], 1u);
    return b;
}
__device__ __forceinline__ void xcd_barrier_complete(unsigned* bar, unsigned x, unsigned& nloc, unsigned& nx) {
    const unsigned G = gridDim.x * gridDim.y * gridDim.z;
    unsigned sum, cnt, mine, sp = 0u;
    for (;;) {
        sum = 0u; cnt = 0u; mine = 0u;
#pragma unroll
        for (unsigned j = 0; j < 16; ++j) { const unsigned c = xb_ld(&bar[XB_XCNT(j)]); sum += c; cnt += (c > 0u) ? 1u : 0u; mine = (j == x) ? c : mine; }
        if (sum == G) break;
        __builtin_amdgcn_s_sleep(1);
        if ((++sp & 255u) == 0u) { if (xb_ld(&bar[XB_TMO])) break; if (sp > XB_SPIN_CAP) { atomicAdd(&bar[XB_TMO], 1u); break; } }
    }
    nloc = mine > 0u ? mine : 1u; nx = cnt > 0u ? cnt : 1u;
}
__device__ __forceinline__ void xcd_barrier(const XcdBarrier& b) {
    asm volatile("s_waitcnt vmcnt(0)" ::: "memory");
    __syncthreads();
    if (threadIdx.x == 0) {
        unsigned* bar = b.bar;
        __builtin_amdgcn_s_waitcnt(0);
        unsigned nloc = b.st[0], nx = b.st[1];
        if (nloc == 0u) { xcd_barrier_complete(bar, b.x, nloc, nx); b.st[0] = nloc; b.st[1] = nx; }
        const unsigned old = xb_add(&bar[XB_XSUB(b.x)], 1u);
        const unsigned gen = old / nloc;
        if (old + 1u == (gen + 1u) * nloc) {
            __builtin_amdgcn_fence(__ATOMIC_RELEASE, "agent");
            asm volatile("s_waitcnt vmcnt(0)" ::: "memory");
            const unsigned og = xb_add(&bar[XB_TOP], 1u);
            const unsigned tg = og / nx;
            if (og + 1u == (tg + 1u) * nx) xb_add(&bar[XB_TOPGEN], 1u);
            else XB_SPIN(xb_ld(&bar[XB_TOPGEN]) == tg, bar);
            __builtin_amdgcn_fence(__ATOMIC_ACQUIRE, "agent");
            xb_add(&bar[XB_XGEN(b.x)], 1u);
            asm volatile("s_waitcnt vmcnt(0)" ::: "memory");
        } else {
            XB_SPIN(xb_ld(&bar[XB_XGEN(b.x)]) == gen, bar);
            __builtin_amdgcn_fence(__ATOMIC_ACQUIRE, "agent");
            asm volatile("s_waitcnt vmcnt(0)" ::: "memory");
        }
    }
    __syncthreads();
}

struct Args { const void* in[34]; float* out; unsigned char* ws; int ph_lo, ph_hi; };

DI void tr_item(const float* W, int ldw, int kvalid, bf16_t* WT, int ldk, int n0, int k0, int sc, LAS float* scr, int lane, const float* rs = nullptr, int kshift = 0) {
#pragma unroll 8
    for (int i = 0; i < 32; ++i) { const int kk = 2 * i + (lane >> 5); const int k = k0 + kk + kshift;
        float v = 0.f; if (sc >= 0 && k < kvalid) { v = W[(size_t)k * ldw + sc]; if (rs) v *= rs[k]; }
        scr[kk * 33 + (lane & 31)] = v; }
    LDS_WAIT(); asm volatile("" ::: "memory");
    const int c = lane & 7;
#pragma unroll
    for (int j = 0; j < 4; ++j) { const int n = (lane >> 3) + 8 * j; const LAS float* s = scr + (8 * c) * 33 + n;
        u32x4 o; o.x = pk2(s[0 * 33], s[1 * 33]); o.y = pk2(s[2 * 33], s[3 * 33]); o.z = pk2(s[4 * 33], s[5 * 33]); o.w = pk2(s[6 * 33], s[7 * 33]);
        *(GAS u32x4*)(WT + (size_t)(n0 + n) * ldk + k0 + 8 * c) = o; }
    LDS_WAIT(); asm volatile("" ::: "memory");
}

DI void tr_item_v4(const float* W, int ldw, bf16_t* WT, int ldk, int n0, int k0, int c0, LAS float* scr, int lane, const float* rs = nullptr) {
    const int kr = lane >> 3, n4 = lane & 7;
    f32x4 v[8];
#pragma unroll
    for (int i = 0; i < 8; ++i) v[i] = *(const f32x4*)(W + (size_t)(k0 + i * 8 + kr) * ldw + c0 + 4 * n4);
    if (rs) {
#pragma unroll
        for (int i = 0; i < 8; ++i) v[i] = v[i] * rs[k0 + i * 8 + kr]; }
#pragma unroll
    for (int i = 0; i < 8; ++i) { LAS float* p = scr + (i * 8 + kr) * 33 + 4 * n4; p[0] = v[i][0]; p[1] = v[i][1]; p[2] = v[i][2]; p[3] = v[i][3]; }
    LDS_WAIT(); asm volatile("" ::: "memory");
    const int c = lane & 7;
#pragma unroll
    for (int j = 0; j < 4; ++j) { const int n = (lane >> 3) + 8 * j; const LAS float* s = scr + (8 * c) * 33 + n;
        u32x4 o; o.x = pk2(s[0 * 33], s[1 * 33]); o.y = pk2(s[2 * 33], s[3 * 33]); o.z = pk2(s[4 * 33], s[5 * 33]); o.w = pk2(s[6 * 33], s[7 * 33]);
        *(GAS u32x4*)(WT + (size_t)(n0 + n) * ldk + k0 + 8 * c) = o; }
    LDS_WAIT(); asm volatile("" ::: "memory");
}

DI void tr_item_v4_fp8(const float* W, int ldw, unsigned char* WT, int ldk, int n0, int k0, int c0, float sc, LAS float* scr, int lane) {
    const int kr = lane >> 3, n4 = lane & 7;
    f32x4 v[8];
#pragma unroll
    for (int i = 0; i < 8; ++i) v[i] = *(const f32x4*)(W + (size_t)(k0 + i * 8 + kr) * ldw + c0 + 4 * n4);
#pragma unroll
    for (int i = 0; i < 8; ++i) { LAS float* p = scr + (i * 8 + kr) * 33 + 4 * n4; p[0] = v[i][0] * sc; p[1] = v[i][1] * sc; p[2] = v[i][2] * sc; p[3] = v[i][3] * sc; }
    LDS_WAIT(); asm volatile("" ::: "memory");
    const int c = lane & 7;
#pragma unroll
    for (int j = 0; j < 4; ++j) { const int n = (lane >> 3) + 8 * j; const LAS float* s = scr + (8 * c) * 33 + n;
        u32x2 o; o.x = pg8::pk4_fp8(s[0 * 33], s[1 * 33], s[2 * 33], s[3 * 33]); o.y = pg8::pk4_fp8(s[4 * 33], s[5 * 33], s[6 * 33], s[7 * 33]);
        *(GAS u32x2*)(WT + (size_t)(n0 + n) * ldk + k0 + 8 * c) = o; }
    LDS_WAIT(); asm volatile("" ::: "memory");
}
DI int win_src(int n) {
    if (n < 384) return n;
    if (n < 416) { const int i = (n - 384) >> 1; return 384 + i + 16 * ((n - 384) & 1); }
    if (n < 424) return 1952 + (n - 416);
    if (n < 512) return -1;
    if (n < 2048) return 416 + (n - 512);
    return 1960 + (n - 2048);
}
DI void p0_prologue(const Args& args, LAS unsigned char* lds, int vcu, int G) {
    int tid_ = threadIdx.x; asm volatile("" : "+v"(tid_)); const int lane = tid_ & 63; const int wave = __builtin_amdgcn_readfirstlane(tid_ >> 6);
    LAS float* scr = (LAS float*)(lds + RING_OFF + wave * 16384);
    const int gw = vcu * NWAVES + wave, NGW = G * NWAVES;
    unsigned char* ws = args.ws;
    const int j = lane & 31;
    constexpr int I_IN = 16 * 128, I_UQ = 4 * 24, I_UK = 4 * 16, I_UV = 4 * 16, I_MQK = 4 * 32, I_BRM = 8 * 32, I_BRA = 8 * 32, I_SQ = 16 * 32, I_R = 16 * 8,
                  I_GU = NE * 16 * 64, I_DN = NE * 16 * 32;
    constexpr int NITEMS = I_IN + I_UQ + I_UK + I_UV + I_MQK + I_BRM + I_BRA + 5 * I_SQ + I_R + I_GU + I_DN;
    for (int it = gw; it < 33 * 8; it += NGW) { const int grp = it >> 3, kc = it & 7; const bool rt = (grp == 32);
        const float* W = (const float*)args.in[rt ? 26 : 21]; const int ldw = rt ? NE : 1024; const int col = (rt ? 0 : grp * 32) + (lane & 31);
        const float* gv = (const float*)args.in[rt ? 24 : 19]; const float* bv = (const float*)args.in[rt ? 25 : 20];
        float as = 0.f, ab = 0.f;
#pragma unroll 8
        for (int i = 0; i < 64; ++i) { const int k = kc * 128 + 2 * i + (lane >> 5); const float w = W[(size_t)k * ldw + col]; as += bf2f((unsigned short)f2bf(gv[k] * w)); ab += bv[k] * w; }
        as += __shfl_xor(as, 32); ab += __shfl_xor(ab, 32);
        if (lane < 32) { float* csd = (float*)(ws + (rt ? CTL_CSR : CTL_CS1)) + col; float* cbd = (float*)(ws + (rt ? CTL_CBR : CTL_CB1)) + col;
            __hip_atomic_fetch_add(csd, as, RLX_AGENT); __hip_atomic_fetch_add(cbd, ab, RLX_AGENT); } }
    for (int it = gw; it < NITEMS; it += NGW) {
        int r = it;
        if (r < I_GU) { const int e = r / (16 * 64), q = r % (16 * 64), kb = q / 64, nb = q % 64;
            tr_item_v4_fp8((const float*)args.in[28] + (size_t)e * 1024 * 2048, 2048, ws + WS_W_GU + (size_t)e * 2048 * 1024, 1024, nb * 32, kb * 64, nb * 32, pg8::F8_WS, scr, lane); continue; } r -= I_GU;
        if (r < I_DN) { const int e = r / (16 * 32), q = r % (16 * 32), kb = q / 32, nb = q % 32;
            tr_item_v4_fp8((const float*)args.in[30] + (size_t)e * 1024 * 1024, 1024, ws + WS_W_DN + (size_t)e * 1024 * 1024, 1024, nb * 32, kb * 64, nb * 32, pg8::F8_WS, scr, lane); continue; } r -= I_DN;
        if (r < I_IN) { const int kb = r / 128, nb = r % 128;
            tr_item((const float*)args.in[3], DIN, 1024, (bf16_t*)(ws + WS_W_IN), 1024, nb * 32, kb * 64, win_src(nb * 32 + j), scr, lane); continue; } r -= I_IN;
        if (r < I_UQ) { const int kb = r / 24, nb = r % 24; const int n = nb * 32 + j, hh = n / AQK, cc = n % AQK;
            const int sc = (cc < ANOPE) ? n : hh * AQK + ANOPE + ((cc - ANOPE) >> 1) + 16 * ((cc - ANOPE) & 1);
            tr_item((const float*)args.in[14], AH * AQK, 256, (bf16_t*)(ws + WS_W_UQ), 256, nb * 32, kb * 64, sc, scr, lane); continue; } r -= I_UQ;
        if (r < I_UK) { const int kb = r / 16, nb = r % 16; const int n = nb * 32 + j;
            tr_item((const float*)args.in[15], 1024, 128, (bf16_t*)(ws + WS_W_UK), 256, nb * 32, kb * 64, (n >> 6) * 128 + (n & 63), scr, lane); continue; } r -= I_UK;
        if (r < I_UV) { const int kb = r / 16, nb = r % 16; const int n = nb * 32 + j;
            tr_item((const float*)args.in[15], 1024, 128, (bf16_t*)(ws + WS_W_UV), 256, nb * 32, kb * 64, (n >> 6) * 128 + 64 + (n & 63), scr, lane); continue; } r -= I_UV;
        if (r < I_MQK) { const int kb = r / 32, nb = r % 32; const int n = nb * 32 + j, part = n >> 9, hh = (n >> 7) & 3, e = n & 127;
            const float* src = (const float*)args.in[part ? 9 : 8];
            tr_item(src, 128, 512, (bf16_t*)(ws + WS_W_MQK), 256, nb * 32, kb * 64, ((kb >> 1) == (hh & 1)) ? e : -1, scr, lane, nullptr, (hh >> 1) * 256); continue; } r -= I_MQK;
        if (r < I_BRM) { const int kb = r / 32, nb = r % 32;
            tr_item_v4((const float*)args.in[16], 1024, (bf16_t*)(ws + WS_W_BRM), 512, nb * 32, kb * 64, nb * 32, scr, lane); continue; } r -= I_BRM;
        if (r < I_BRA) { const int kb = r / 32, nb = r % 32;
            tr_item_v4((const float*)args.in[17], 1024, (bf16_t*)(ws + WS_W_BRA), 512, nb * 32, kb * 64, nb * 32, scr, lane); continue; } r -= I_BRA;
        if (r < 5 * I_SQ) { const int w = r / I_SQ, q = r % I_SQ, kb = q / 32, nb = q % 32;
            const float* src; int ldw, coff; bf16_t* dst; const float* rs = nullptr;
            if (w == 0) { src = (const float*)args.in[18]; ldw = 1024; coff = 0; dst = (bf16_t*)(ws + WS_W_MIX); }
            else if (w == 1) { src = (const float*)args.in[21]; ldw = 1024; coff = 0; dst = (bf16_t*)(ws + WS_W_CQ); rs = (const float*)args.in[19]; }
            else if (w == 2) { src = (const float*)args.in[22]; ldw = 2048; coff = 0; dst = (bf16_t*)(ws + WS_W_CK); }
            else if (w == 3) { src = (const float*)args.in[22]; ldw = 2048; coff = 1024; dst = (bf16_t*)(ws + WS_W_CV); }
            else { src = (const float*)args.in[23]; ldw = 1024; coff = 0; dst = (bf16_t*)(ws + WS_W_CO); }
            tr_item_v4(src, ldw, dst, 1024, nb * 32, kb * 64, coff + nb * 32, scr, lane, rs); continue; } r -= 5 * I_SQ;
        { const int kb = r / 8, nb = r % 8; const int n = nb * 32 + j;
            tr_item((const float*)args.in[26], NE, 1024, (bf16_t*)(ws + WS_W_R), 1024, nb * 32, kb * 64, (n < NE) ? n : -1, scr, lane, (const float*)args.in[24]); }
    }
    const size_t gt = (size_t)gw * 64 + lane, NT_ = (size_t)NGW * 64;
    { const float* x = (const float*)args.in[0]; bf16_t* xb = (bf16_t*)(ws + WS_XB);
      for (size_t i = gt; i < (size_t)T * D / 8; i += NT_) { const f32x4 a = *(const f32x4*)(x + i * 8), b = *(const f32x4*)(x + i * 8 + 4);
          u32x4 o; o.x = pk2(a[0], a[1]); o.y = pk2(a[2], a[3]); o.z = pk2(b[0], b[1]); o.w = pk2(b[2], b[3]); *(u32x4*)(xb + i * 8) = o; } }
    { const float* x = (const float*)args.in[1]; bf16_t* xb = (bf16_t*)(ws + WS_MEMB);
      for (size_t i = gt; i < (size_t)NB * NMEM * D / 8; i += NT_) { const f32x4 a = *(const f32x4*)(x + i * 8), b = *(const f32x4*)(x + i * 8 + 4);
          u32x4 o; o.x = pk2(a[0], a[1]); o.y = pk2(a[2], a[3]); o.z = pk2(b[0], b[1]); o.w = pk2(b[2], b[3]); *(u32x4*)(xb + i * 8) = o; } }
}

DI void p2_tokens(const Args& args, int vcu, int G) {
    int tid_ = threadIdx.x; asm volatile("" : "+v"(tid_)); const int lane = tid_ & 63; const int wave = __builtin_amdgcn_readfirstlane(tid_ >> 6);
    unsigned char* ws = args.ws;
    const bf16_t* proj = (const bf16_t*)(ws + WS_PROJ);
    bf16_t* qn = (bf16_t*)(ws + WS_QN); bf16_t* kvn = (bf16_t*)(ws + WS_KVN); bf16_t* kpe = (bf16_t*)(ws + WS_KPE); bf16_t* xc = (bf16_t*)(ws + WS_XC); float* cs = (float*)(ws + WS_CS);
    const int* positions = (const int*)args.in[2];
    const float* conv_w = (const float*)args.in[6]; const float* conv_b = (const float*)args.in[7];
    const float* g_qlat = (const float*)args.in[12]; const float* g_kvlat = (const float*)args.in[13];
    const int gw = vcu * NWAVES + wave, NGW = G * NWAVES;
    float cw[4][8], cb[8];
#pragma unroll
    for (int jj = 0; jj < 4; ++jj)
#pragma unroll
        for (int c = 0; c < 8; ++c) cw[jj][c] = conv_w[jj * MW + 8 * lane + c];
#pragma unroll
    for (int c = 0; c < 8; ++c) cb[c] = conv_b[8 * lane + c];
    const f32x4 gq = *(const f32x4*)(g_qlat + 4 * lane);
    const f32x2 gk = *(const f32x2*)(g_kvlat + 2 * lane);
    const float inv_freq = exp2f(-(float)(lane & 15) * (13.287712379549449f / 16.0f));
    for (int t = gw; t < T; t += NGW) {
        const bf16_t* pr = proj + (size_t)t * NPROJ;
        { const u32x2 w = *(const u32x2*)(pr + PC_QLAT + 4 * lane); const float a0 = bflo(w.x), a1 = bfhi(w.x), a2 = bflo(w.y), a3 = bfhi(w.y);
          const float ss = wave_sum(a0 * a0 + a1 * a1 + a2 * a2 + a3 * a3); const float r = 1.0f / sqrtf(ss * (1.0f / AQR) + EPS);
          u32x2 o; o.x = pk2(a0 * r * gq[0], a1 * r * gq[1]); o.y = pk2(a2 * r * gq[2], a3 * r * gq[3]); *(u32x2*)(qn + (size_t)t * 256 + 4 * lane) = o; }
        { const unsigned w = *(const unsigned*)(pr + PC_KVLAT + 2 * lane); const float a0 = bflo(w), a1 = bfhi(w);
          const float ss = wave_sum(a0 * a0 + a1 * a1); const float r = 1.0f / sqrtf(ss * (1.0f / AKVR) + EPS);
          *(unsigned*)(kvn + (size_t)t * 256 + 2 * lane) = pk2(a0 * r * gk[0], a1 * r * gk[1]); *(unsigned*)(kvn + (size_t)t * 256 + 128 + 2 * lane) = 0u; }
        if (lane < 16) { const unsigned w = *(const unsigned*)(pr + PC_KROPE + 2 * lane); const float x1 = bflo(w), x2 = bfhi(w);
          const float ang = (float)positions[t] * inv_freq;
          const double rev = (double)ang * 0.15915494309189535; const float fr = (float)(rev - __builtin_rint(rev));
          const float cc = __builtin_amdgcn_cosf(fr), sn = __builtin_amdgcn_sinf(fr);
          *(unsigned*)(kpe + (size_t)t * 32 + 2 * lane) = pk2(x1 * cc - x2 * sn, x2 * cc + x1 * sn);
          *(f32x2*)(cs + (size_t)t * 32 + 2 * lane) = (f32x2){cc, sn}; }
        { const int s = t & (SEQ - 1); float a[8];
#pragma unroll
          for (int c = 0; c < 8; ++c) a[c] = cb[c];
#pragma unroll
          for (int jj = 0; jj < 4; ++jj) { const int back = 3 - jj; if (s - back >= 0) { const u32x4 w = *(const u32x4*)(pr - (size_t)back * NPROJ + PC_XM + 8 * lane);
              a[0] += cw[jj][0] * bflo(w.x); a[1] += cw[jj][1] * bfhi(w.x); a[2] += cw[jj][2] * bflo(w.y); a[3] += cw[jj][3] * bfhi(w.y);
              a[4] += cw[jj][4] * bflo(w.z); a[5] += cw[jj][5] * bfhi(w.z); a[6] += cw[jj][6] * bflo(w.w); a[7] += cw[jj][7] * bfhi(w.w); } }
#pragma unroll
          for (int c = 0; c < 8; ++c) a[c] = a[c] * sigmoidf_(a[c]);
          u32x4 o; o.x = pk2(a[0], a[1]); o.y = pk2(a[2], a[3]); o.z = pk2(a[4], a[5]); o.w = pk2(a[6], a[7]); *(u32x4*)(xc + (size_t)t * MW + 8 * lane) = o; }
    }
}

DI void p6_mpost(const Args& args, int vcu, int G) {
    int tid_ = threadIdx.x; asm volatile("" : "+v"(tid_)); const int lane = tid_ & 63; const int wave = __builtin_amdgcn_readfirstlane(tid_ >> 6);
    unsigned char* ws = args.ws;
    const float* hraw = (const float*)(ws + WS_HRAW); const bf16_t* xc = (const bf16_t*)(ws + WS_XC); const bf16_t* proj = (const bf16_t*)(ws + WS_PROJ); bf16_t* hm = (bf16_t*)(ws + WS_HM);
    const float* g_mhead = (const float*)args.in[10]; const float* w_mskip = (const float*)args.in[11];
    const int gw = vcu * NWAVES + wave, NGW = G * NWAVES;
    float gm[8], wsk[8];
#pragma unroll
    for (int c = 0; c < 8; ++c) { gm[c] = g_mhead[8 * lane + c]; wsk[c] = w_mskip[8 * lane + c]; }
    for (int t = gw; t < T; t += NGW) {
        const f32x4 h0 = *(const f32x4*)(hraw + (size_t)t * MW + 8 * lane), h1 = *(const f32x4*)(hraw + (size_t)t * MW + 8 * lane + 4);
        float h[8] = {h0[0], h0[1], h0[2], h0[3], h1[0], h1[1], h1[2], h1[3]};
        float s = 0.f;
#pragma unroll
        for (int c = 0; c < 8; ++c) s += h[c];
        s += __shfl_xor(s, 1); s += __shfl_xor(s, 2); s += __shfl_xor(s, 4); s += __shfl_xor(s, 8);
        const float mu = s * (1.0f / MHD); float q = 0.f;
#pragma unroll
        for (int c = 0; c < 8; ++c) { h[c] -= mu; q += h[c] * h[c]; }
        q += __shfl_xor(q, 1); q += __shfl_xor(q, 2); q += __shfl_xor(q, 4); q += __shfl_xor(q, 8);
        const float rstd = 1.0f / sqrtf(q * (1.0f / MHD) + EPS);
        const u32x4 xw = *(const u32x4*)(xc + (size_t)t * MW + 8 * lane); const u32x4 ow = *(const u32x4*)(proj + (size_t)t * NPROJ + PC_OP + 8 * lane);
        const float xv[8] = {bflo(xw.x), bfhi(xw.x), bflo(xw.y), bfhi(xw.y), bflo(xw.z), bfhi(xw.z), bflo(xw.w), bfhi(xw.w)};
        const float ov[8] = {bflo(ow.x), bfhi(ow.x), bflo(ow.y), bfhi(ow.y), bflo(ow.z), bfhi(ow.z), bflo(ow.w), bfhi(ow.w)};
        float o[8];
#pragma unroll
        for (int c = 0; c < 8; ++c) o[c] = sigmoidf_(ov[c]) * (h[c] * rstd * gm[c] + wsk[c] * xv[c]);
        u32x4 w; w.x = pk2(o[0], o[1]); w.y = pk2(o[2], o[3]); w.z = pk2(o[4], o[5]); w.w = pk2(o[6], o[7]); *(u32x4*)(hm + (size_t)t * MW + 8 * lane) = w;
    }
}

DI void ln_pass(const float* res, const float* add, const float* g, const float* b, float* out, bf16_t* outb, int vcu, int G) {
    int tid_ = threadIdx.x; asm volatile("" : "+v"(tid_)); const int lane = tid_ & 63; const int wave = __builtin_amdgcn_readfirstlane(tid_ >> 6);
    const int gw = vcu * NWAVES + wave, NGW = G * NWAVES;
    for (int t = gw; t < T; t += NGW) {
        f32x4 v[4]; float s = 0.f;
#pragma unroll
        for (int j = 0; j < 4; ++j) { const f32x4 r = *(const f32x4*)(res + (size_t)t * D + 4 * lane + 256 * j), a = *(const f32x4*)(add + (size_t)t * D + 4 * lane + 256 * j);
            v[j] = r * DN_ALPHA + a; s += (v[j][0] + v[j][1]) + (v[j][2] + v[j][3]); }
        const float mean = wave_sum(s) * (1.0f / D); float q = 0.f;
#pragma unroll
        for (int j = 0; j < 4; ++j) { v[j] = v[j] - mean; q += (v[j][0] * v[j][0] + v[j][1] * v[j][1]) + (v[j][2] * v[j][2] + v[j][3] * v[j][3]); }
        const float rstd = 1.0f / sqrtf(wave_sum(q) * (1.0f / D) + EPS);
#pragma unroll
        for (int j = 0; j < 4; ++j) { const f32x4 gg = *(const f32x4*)(g + 4 * lane + 256 * j), bb = *(const f32x4*)(b + 4 * lane + 256 * j);
            const f32x4 y = v[j] * rstd * gg + bb;
            *(f32x4*)(out + (size_t)t * D + 4 * lane + 256 * j) = y;
            if (outb) { u32x2 w; w.x = pk2(y[0], y[1]); w.y = pk2(y[2], y[3]); *(u32x2*)(outb + (size_t)t * D + 4 * lane + 256 * j) = w; } }
    }
}

DI void p16_topk(const Args& args, LAS unsigned char* lds, int vcu, int G) {
    unsigned char* ws = args.ws;
    const float* logits = (const float*)(ws + WS_LOGITS); const float* b_router = (const float*)args.in[27];
    int* assign = (int*)(ws + WS_ASSIGN); float* gatew = (float*)(ws + WS_GATEW);
    unsigned* gcnt = (unsigned*)(ws + WS_CTL) + CW_CNT;
    LAS unsigned* hist = (LAS unsigned*)(lds + HIST_OFF); LAS unsigned* hbase = (LAS unsigned*)(lds + HBASE_OFF);
    int tid = threadIdx.x; asm volatile("" : "+v"(tid));
    for (int blk = vcu; blk < T / 512; blk += G) {
        const int t = blk * 512 + tid;
        float v[NE];
#pragma unroll
        for (int j = 0; j < NE / 4; ++j) { const f32x4 a = *(const f32x4*)(logits + (size_t)t * NE + 4 * j), bb = *(const f32x4*)(b_router + 4 * j);
            v[4 * j] = a[0] + bb[0]; v[4 * j + 1] = a[1] + bb[1]; v[4 * j + 2] = a[2] + bb[2]; v[4 * j + 3] = a[3] + bb[3]; }
        int idx[TOPK]; float val[TOPK];
#pragma unroll
        for (int k = 0; k < TOPK; ++k) { float best = -INFINITY; int bi = 0;
#pragma unroll
            for (int e = 0; e < NE; ++e) { bool taken = false;
#pragma unroll
                for (int kk = 0; kk < k; ++kk) taken = taken || (idx[kk] == e);
                if (!taken && v[e] > best) { best = v[e]; bi = e; } }
            idx[k] = bi; val[k] = best; }
        float ex[TOPK], sum = 0.f;
#pragma unroll
        for (int k = 0; k < TOPK; ++k) { ex[k] = __expf(val[k] - val[0]); sum += ex[k]; }
        const float inv = 1.0f / sum;
        if (tid < NE) hist[tid] = 0u;
        __syncthreads();
        unsigned lr[TOPK];
#pragma unroll
        for (int k = 0; k < TOPK; ++k) lr[k] = __hip_atomic_fetch_add(hist + idx[k], 1u, __ATOMIC_RELAXED, __HIP_MEMORY_SCOPE_WORKGROUP);
        __syncthreads();
        if (tid < NE) hbase[tid] = __hip_atomic_fetch_add(gcnt + tid, hist[tid], RLX_AGENT);
        __syncthreads();
#pragma unroll
        for (int k = 0; k < TOPK; ++k) { assign[(size_t)t * TOPK + k] = (idx[k] << 20) | (int)(hbase[idx[k]] + lr[k]); gatew[(size_t)t * TOPK + k] = ex[k] * inv; }
        __syncthreads();
    }
}
DI void build_tstart(const Args& args, LAS unsigned char* lds) {
    const unsigned* gcnt = (const unsigned*)(args.ws + WS_CTL) + CW_CNT; LAS int* tst = (LAS int*)(lds + TST_OFF); LAS int* tile_e = (LAS int*)(lds + TILE_E_OFF);
    if (threadIdx.x == 0) { int acc = 0;
        for (int e = 0; e < NE; ++e) { tst[e] = acc; const unsigned c = __hip_atomic_load(gcnt + e, RLX_AGENT); acc += (int)((c + 255u) >> 8); }
        tst[NE] = acc; }
    __syncthreads();
    for (int t = threadIdx.x; t < tst[NE]; t += NWAVES * 64) { int e = 0;
        for (int j = 1; j < NE; ++j) e += (tst[j] <= t) ? 1 : 0;
        tile_e[t] = e; }
    __syncthreads();
}
DI void p17_gather(const Args& args, LAS unsigned char* lds, int vcu, int G) {
    int tid_ = threadIdx.x; asm volatile("" : "+v"(tid_)); const int lane = tid_ & 63; const int wave = __builtin_amdgcn_readfirstlane(tid_ >> 6);
    unsigned char* ws = args.ws;
    build_tstart(args, lds);
    const LAS int* tst = (const LAS int*)(lds + TST_OFF);
    const unsigned* gcnt = (const unsigned*)(ws + WS_CTL) + CW_CNT;
    const int* assign = (const int*)(ws + WS_ASSIGN); const float* gatew = (const float*)(ws + WS_GATEW);
    int* tokpos = (int*)(ws + WS_TOKPOS); float* rowgate = (float*)(ws + WS_ROWGATE);
    const bf16_t* v2 = (const bf16_t*)(ws + WS_V2B); const float* stats2 = (const float*)(ws + CTL_STATS2); unsigned char* xg = ws + WS_XG;
    const int gw = vcu * NWAVES + wave, NGW = G * NWAVES;
    f32x4 g2[4], b2[4];
#pragma unroll
    for (int j = 0; j < 4; ++j) { g2[j] = *(const f32x4*)((const float*)args.in[24] + 16 * lane + 4 * j) * pg8::F8_XS; b2[j] = *(const f32x4*)((const float*)args.in[25] + 16 * lane + 4 * j) * pg8::F8_XS; }
    for (int t = gw; t < T; t += NGW) {
        float mean, rstd; pg8::row_stats(stats2, t, mean, rstd);
        u32x4 o; const u32x4 wa = *(const u32x4*)(v2 + (size_t)t * D + 16 * lane), wb = *(const u32x4*)(v2 + (size_t)t * D + 16 * lane + 8);
        const f32x4 xin[4] = {{bflo(wa.x), bfhi(wa.x), bflo(wa.y), bfhi(wa.y)}, {bflo(wa.z), bfhi(wa.z), bflo(wa.w), bfhi(wa.w)}, {bflo(wb.x), bfhi(wb.x), bflo(wb.y), bfhi(wb.y)}, {bflo(wb.z), bfhi(wb.z), bflo(wb.w), bfhi(wb.w)}};
#pragma unroll
        for (int j = 0; j < 4; ++j) { const f32x4 x = (xin[j] - mean) * rstd * g2[j] + b2[j]; o[j] = pg8::pk4_fp8(x[0], x[1], x[2], x[3]); }
#pragma unroll
        for (int k = 0; k < TOPK; ++k) { const int as = assign[(size_t)t * TOPK + k]; const int e = as >> 20, rank = as & 0xfffff; const int pos = tst[e] * 256 + rank;
            *(u32x4*)(xg + (size_t)pos * D + 16 * lane) = o;
            if (lane == 0) { tokpos[(size_t)t * TOPK + k] = pos; rowgate[pos] = gatew[(size_t)t * TOPK + k]; } }
    }
    for (int idx = gw; idx < NE * 256; idx += NGW) { const int e = idx >> 8, r = idx & 255; const int row = tst[e] * 256 + (int)__hip_atomic_load(gcnt + e, RLX_AGENT) + r;
        if (row < tst[e + 1] * 256) { const u32x4 z = {0u, 0u, 0u, 0u}; *(u32x4*)(xg + (size_t)row * D + 16 * lane) = z; if (lane == 0) rowgate[row] = 0.f; } }
}
DI void p20_final(const Args& args, int vcu, int G) {
    int tid_ = threadIdx.x; asm volatile("" : "+v"(tid_)); const int lane = tid_ & 63; const int wave = __builtin_amdgcn_readfirstlane(tid_ >> 6);
    unsigned char* ws = args.ws;
    const int* tokpos = (const int*)(ws + WS_TOKPOS); const bf16_t* yb = (const bf16_t*)(ws + WS_YB);
    const bf16_t* v2 = (const bf16_t*)(ws + WS_V2B); const float* stats2 = (const float*)(ws + CTL_STATS2);
    const float* g2 = (const float*)args.in[24]; const float* b2 = (const float*)args.in[25];
    const float* g = (const float*)args.in[32]; const float* b = (const float*)args.in[33]; float* out = args.out;
    const int gw = vcu * NWAVES + wave, NGW = G * NWAVES;
    for (int t = gw; t < T; t += NGW) {
        int pos[TOPK];
#pragma unroll
        for (int k = 0; k < TOPK; ++k) pos[k] = tokpos[(size_t)t * TOPK + k];
        float mean2, rstd2; pg8::row_stats(stats2, t, mean2, rstd2);
        f32x4 v[4]; float s = 0.f;
#pragma unroll
        for (int j = 0; j < 4; ++j) { const u32x2 vw = *(const u32x2*)(v2 + (size_t)t * D + 4 * lane + 256 * j); const f32x4 vin = {bflo(vw.x), bfhi(vw.x), bflo(vw.y), bfhi(vw.y)};
            const f32x4 r = (vin - mean2) * rstd2 * *(const f32x4*)(g2 + 4 * lane + 256 * j) + *(const f32x4*)(b2 + 4 * lane + 256 * j);
            f32x4 a = {0.f, 0.f, 0.f, 0.f};
#pragma unroll
            for (int k = 0; k < TOPK; ++k) { const u32x2 w = *(const u32x2*)(yb + (size_t)pos[k] * D + 4 * lane + 256 * j); a[0] += bflo(w.x); a[1] += bfhi(w.x); a[2] += bflo(w.y); a[3] += bfhi(w.y); }
            v[j] = r * DN_ALPHA + a; s += (v[j][0] + v[j][1]) + (v[j][2] + v[j][3]); }
        const float mean = wave_sum(s) * (1.0f / D); float q = 0.f;
#pragma unroll
        for (int j = 0; j < 4; ++j) { v[j] = v[j] - mean; q += (v[j][0] * v[j][0] + v[j][1] * v[j][1]) + (v[j][2] * v[j][2] + v[j][3] * v[j][3]); }
        const float rstd = 1.0f / sqrtf(wave_sum(q) * (1.0f / D) + EPS);
#pragma unroll
        for (int j = 0; j < 4; ++j) { const f32x4 gg = *(const f32x4*)(g + 4 * lane + 256 * j), bb = *(const f32x4*)(b + 4 * lane + 256 * j);
            *(f32x4*)(out + (size_t)t * D + 4 * lane + 256 * j) = v[j] * rstd * gg + bb; }
    }
}
constexpr int AT_KROW = 208, AT_VROW = 264;
constexpr int AT_KBUF = 128 * AT_KROW, AT_VBUF = 64 * AT_VROW, AT_VOFF = 2 * AT_KBUF;
#define MLA_QK(P0, P1, kbase) do { _Pragma("unroll") for (int r_ = 0; r_ < 16; ++r_) { P0[r_] = 0.f; P1[r_] = 0.f; } \
        _Pragma("unroll") for (int s_ = 0; s_ < 6; ++s_) { const bf16x8 a0_ = *(const LAS bf16x8*)((kbase) + s_ * 32), a1_ = *(const LAS bf16x8*)((kbase) + 32 * AT_KROW + s_ * 32); \
            P0 = MFMA32(a0_, qf[s_], P0); P1 = MFMA32(a1_, qf[s_], P1); } } while (0)
#define MLA_SOFTPV(P0, P1, vbase, MASK, key0) do { \
        if (MASK) { _Pragma("unroll") for (int r_ = 0; r_ < 16; ++r_) { const int key_ = (key0) + crow(r_, hi); if (key_ > qi) P0[r_] = -INFINITY; if (key_ + 32 > qi) P1[r_] = -INFINITY; } } \
        float mx_ = fmaxf(P0[0], P1[0]); \
        _Pragma("unroll") for (int r_ = 1; r_ < 16; ++r_) mx_ = fmaxf(mx_, fmaxf(P0[r_], P1[r_])); \
        mx_ = fmaxf(mx_, __shfl_xor(mx_, 32)); \
        const float m_new_ = fmaxf(m_run, mx_); const float alpha_ = __builtin_amdgcn_exp2f(m_run - m_new_); m_run = m_new_; \
        float ls_ = 0.f; \
        _Pragma("unroll") for (int r_ = 0; r_ < 16; ++r_) { P0[r_] = __builtin_amdgcn_exp2f(P0[r_] - m_new_); P1[r_] = __builtin_amdgcn_exp2f(P1[r_] - m_new_); ls_ += P0[r_] + P1[r_]; } \
        l_run = l_run * alpha_ + ls_; \
        if (!__all(alpha_ == 1.0f)) { _Pragma("unroll") for (int r_ = 0; r_ < 16; ++r_) { o0[r_] *= alpha_; o1[r_] *= alpha_; } } \
        _Pragma("unroll") for (int s_ = 0; s_ < 4; ++s_) { u32x4 w_; \
            if (s_ < 2) { w_.x = pk2(P0[8 * s_], P0[8 * s_ + 1]); w_.y = pk2(P0[8 * s_ + 2], P0[8 * s_ + 3]); w_.z = pk2(P0[8 * s_ + 4], P0[8 * s_ + 5]); w_.w = pk2(P0[8 * s_ + 6], P0[8 * s_ + 7]); } \
            else { w_.x = pk2(P1[8 * s_ - 16], P1[8 * s_ - 15]); w_.y = pk2(P1[8 * s_ - 14], P1[8 * s_ - 13]); w_.z = pk2(P1[8 * s_ - 12], P1[8 * s_ - 11]); w_.w = pk2(P1[8 * s_ - 10], P1[8 * s_ - 9]); } \
            const bf16x8 pb_ = __builtin_bit_cast(bf16x8, w_); \
            const u32x2 a0l_ = *(const LAS u32x2*)((vbase) + s_ * 32), a0h_ = *(const LAS u32x2*)((vbase) + s_ * 32 + 16); \
            const u32x2 a1l_ = *(const LAS u32x2*)((vbase) + 32 * AT_VROW + s_ * 32), a1h_ = *(const LAS u32x2*)((vbase) + 32 * AT_VROW + s_ * 32 + 16); \
            const bf16x8 a0_ = __builtin_bit_cast(bf16x8, (u32x4){a0l_.x, a0l_.y, a0h_.x, a0h_.y}), a1_ = __builtin_bit_cast(bf16x8, (u32x4){a1l_.x, a1l_.y, a1h_.x, a1h_.y}); \
            o0 = MFMA32(a0_, pb_, o0); o1 = MFMA32(a1_, pb_, o1); } } while (0)
DI void mla_unit(int b, int h, int qb, const bf16_t* Q, const bf16_t* Kn, const bf16_t* Kpe, const bf16_t* Vt, bf16_t* O, LAS unsigned char* lds) {
    int tid = threadIdx.x; asm volatile("" : "+v"(tid)); const int lane = tid & 63, r32 = lane & 31, hi = lane >> 5; const int wid = __builtin_amdgcn_readfirstlane(tid >> 6);
    const int q0 = qb * 256 + wid * 32;
    const int qi = q0 + r32;
    const size_t tokb = (size_t)b * SEQ;
    bf16x8 qf[6];
    { const bf16_t* qp = Q + (tokb + qi) * (AH * AQK) + h * AQK + 8 * hi;
#pragma unroll
      for (int s = 0; s < 6; ++s) qf[s] = *(const bf16x8*)(qp + 16 * s); }
    const int kkey = tid >> 3, kch = tid & 7, pkey = tid >> 2, pch = tid & 3, vd = tid >> 3, vch = tid & 7;
    const bf16_t* ksrc = Kn + (tokb + kkey) * 512 + h * 64 + kch * 8;
    const bf16_t* psrc = Kpe + (tokb + pkey) * 32 + pch * 8;
    const bf16_t* vsrc = Vt + (size_t)(h * 64 + vd) * T + tokb + vch * 8;
    const int kdst = kkey * AT_KROW + kch * 16, pdst = pkey * AT_KROW + 128 + pch * 16, vdst = AT_VOFF + vd * AT_VROW + vch * 16;
    const int nbt = 2 * (qb + 1), nfull = 2 * qb;
    u32x4 rk0, rk1, rp, rv0, rv1;
#define MLA_LD(t) do { rk0 = *(const u32x4*)(ksrc + (size_t)(t) * 128 * 512); rk1 = *(const u32x4*)(ksrc + ((size_t)(t) * 128 + 64) * 512); rp = *(const u32x4*)(psrc + (size_t)(t) * 128 * 32); \
        rv0 = *(const u32x4*)(vsrc + (t) * 128); rv1 = *(const u32x4*)(vsrc + (t) * 128 + 64); } while (0)
#define MLA_ST(buf) do { *(LAS u32x4*)(lds + (buf) * AT_KBUF + kdst) = rk0; *(LAS u32x4*)(lds + (buf) * AT_KBUF + 64 * AT_KROW + kdst) = rk1; *(LAS u32x4*)(lds + (buf) * AT_KBUF + pdst) = rp; \
        *(LAS u32x2*)(lds + (buf) * AT_VBUF + vdst) = (u32x2){rv0.x, rv0.y}; *(LAS u32x2*)(lds + (buf) * AT_VBUF + vdst + 8) = (u32x2){rv0.z, rv0.w}; \
        *(LAS u32x2*)(lds + (buf) * AT_VBUF + vdst + 128) = (u32x2){rv1.x, rv1.y}; *(LAS u32x2*)(lds + (buf) * AT_VBUF + vdst + 136) = (u32x2){rv1.z, rv1.w}; } while (0)
    MLA_LD(0); MLA_ST(0);
    __syncthreads();
    float m_run = -INFINITY, l_run = 0.f;
    f32x16 o0, o1, pa0, pa1, pb0, pb1;
#pragma unroll
    for (int r = 0; r < 16; ++r) { o0[r] = 0.f; o1[r] = 0.f; }
    const LAS unsigned char* kl = lds + r32 * AT_KROW + hi * 16; const LAS unsigned char* vl = lds + AT_VOFF + r32 * AT_VROW + hi * 8;
    int t = 0;
    for (; t < nfull; ++t) {
        MLA_LD(t + 1);
        const LAS unsigned char* kb = kl + (t & 1) * AT_KBUF; const LAS unsigned char* vb = vl + (t & 1) * AT_VBUF;
        MLA_QK(pa0, pa1, kb);
        MLA_QK(pb0, pb1, kb + 64 * AT_KROW);
        MLA_SOFTPV(pa0, pa1, vb, false, 0);
        MLA_SOFTPV(pb0, pb1, vb + 128, false, 0);
        MLA_ST((t + 1) & 1);
        __syncthreads();
    }
    for (; t < nbt; ++t) {
        if (t + 1 < nbt) MLA_LD(t + 1);
        const LAS unsigned char* kb = kl + (t & 1) * AT_KBUF; const LAS unsigned char* vb = vl + (t & 1) * AT_VBUF;
        const int key0 = t * 128;
        if (key0 <= q0 + 31) { MLA_QK(pa0, pa1, kb); MLA_SOFTPV(pa0, pa1, vb, true, key0); }
        if (key0 + 64 <= q0 + 31) { MLA_QK(pb0, pb1, kb + 64 * AT_KROW); MLA_SOFTPV(pb0, pb1, vb + 128, true, key0 + 64); }
        if (t + 1 < nbt) MLA_ST((t + 1) & 1);
        __syncthreads();
    }
#undef MLA_LD
#undef MLA_ST
    const float lt = l_run + __shfl_xor(l_run, 32); const float inv = 1.0f / lt;
    bf16_t* op = O + (tokb + qi) * AW + h * AVD + 4 * hi;
#pragma unroll
    for (int g = 0; g < 4; ++g) { u32x2 w0, w1;
        w0.x = pk2(o0[4 * g] * inv, o0[4 * g + 1] * inv); w0.y = pk2(o0[4 * g + 2] * inv, o0[4 * g + 3] * inv);
        w1.x = pk2(o1[4 * g] * inv, o1[4 * g + 1] * inv); w1.y = pk2(o1[4 * g + 2] * inv, o1[4 * g + 3] * inv);
        *(u32x2*)(op + 8 * g) = w0; *(u32x2*)(op + 32 + 8 * g) = w1; }
}
DI void p4_attention(const Args& args, LAS unsigned char* lds, int vcu, int G) {
    unsigned char* ws = args.ws;
    const bf16_t* Q = (const bf16_t*)(ws + WS_QMLA); const bf16_t* Kn = (const bf16_t*)(ws + WS_KN); const bf16_t* Kpe = (const bf16_t*)(ws + WS_KPE); const bf16_t* Vt = (const bf16_t*)(ws + WS_VT);
    bf16_t* O = (bf16_t*)(ws + WS_AO);
    for (int p = vcu; p < NB * AH * 4; p += G) { const int bh = p >> 2, j = p & 3; const int b = bh / AH, h = bh % AH;
        mla_unit(b, h, 7 - j, Q, Kn, Kpe, Vt, O, lds);
        mla_unit(b, h, j, Q, Kn, Kpe, Vt, O, lds); }
}

constexpr int ML_QROW = 272, ML_TROW = 144;
constexpr int ML_QS = 0, ML_KS = ML_QS + 64 * ML_QROW, ML_KTS = ML_KS + 64 * ML_QROW, ML_VTS = ML_KTS + 128 * ML_TROW, ML_CS = ML_VTS + 32 * ML_TROW, ML_SS = ML_CS + 32 * ML_QROW,
              ML_VEC = ML_SS + 64 * ML_TROW;
static_assert(ML_VEC + (7 * 64 + 128 + 4) * 4 <= RING_BYTES, "mLSTM LDS");
DI void mlstm_unit(int b, int h, int vs, const Args& args, LAS unsigned char* lds) {
    unsigned char* ws = args.ws;
    const bf16_t* qkm = (const bf16_t*)(ws + WS_QKM); const bf16_t* ktm = (const bf16_t*)(ws + WS_KTM); const bf16_t* proj = (const bf16_t*)(ws + WS_PROJ);
    const float* gates = (const float*)(ws + WS_GATES); float* hraw = (float*)(ws + WS_HRAW);
    const float b_i = ((const float*)args.in[4])[h], b_f = ((const float*)args.in[5])[h];
    int tid = threadIdx.x; asm volatile("" : "+v"(tid)); const int lane = tid & 63, r32 = lane & 31, hi = lane >> 5; const int wid = __builtin_amdgcn_readfirstlane(tid >> 6);
    LAS float* ROWT = (LAS float*)(lds + ML_VEC); LAS float* COLT = ROWT + 64; LAS float* WINT = ROWT + 128; LAS float* ENEG = ROWT + 192; LAS float* WAS = ROWT + 256;
    LAS float* NQ = ROWT + 320; LAS float* DINV = ROWT + 384; LAS float* NVEC = ROWT + 448; LAS float* SCAL = ROWT + 576;
    const size_t tokb = (size_t)b * SEQ;
    for (int i = tid; i < 32 * ML_QROW / 4; i += 512) ((LAS unsigned*)(lds + ML_CS))[i] = 0u;
    if (tid < 128) NVEC[tid] = 0.f;
    f32x16 cacc;
#pragma unroll
    for (int r = 0; r < 16; ++r) cacc[r] = 0.f;
    float m_st = 0.f;
    u32x4 sq[2], sk[2], skt[2], sv; float gi = 0.f, gf = 0.f;
    sv = (u32x4){0u, 0u, 0u, 0u};
#define ML_LOAD(c) do { const size_t tok0 = tokb + (size_t)(c) * MCH; \
        _Pragma("unroll") for (int i = 0; i < 2; ++i) { const int idx = tid + 512 * i; \
            sq[i] = *(const u32x4*)(qkm + (tok0 + (idx >> 4)) * 1024 + h * MHD + (idx & 15) * 8); \
            sk[i] = *(const u32x4*)(qkm + (tok0 + (idx >> 4)) * 1024 + 512 + h * MHD + (idx & 15) * 8); \
            skt[i] = *(const u32x4*)(ktm + (size_t)(h * MHD + (idx >> 3)) * T + tok0 + (idx & 7) * 8); } \
        if (tid < 256) sv = *(const u32x4*)(proj + (tok0 + (tid >> 2)) * NPROJ + PC_VM + h * MHD + vs * 32 + (tid & 3) * 8); \
        if (wid == 0) { gi = gates[(tok0 + lane) * 8 + h]; gf = gates[(tok0 + lane) * 8 + 4 + h]; } } while (0)
    ML_LOAD(0);
    for (int c = 0; c < SEQ / MCH; ++c) {
        const size_t tok0 = tokb + (size_t)c * MCH;
#pragma unroll
        for (int i = 0; i < 2; ++i) { const int idx = tid + 512 * i;
            *(LAS u32x4*)(lds + ML_QS + (idx >> 4) * ML_QROW + (idx & 15) * 16) = sq[i];
            *(LAS u32x4*)(lds + ML_KS + (idx >> 4) * ML_QROW + (idx & 15) * 16) = sk[i];
            *(LAS u32x4*)(lds + ML_KTS + (idx >> 3) * ML_TROW + (idx & 7) * 16) = skt[i]; }
        if (tid < 256) { const int l = tid >> 2, v0 = (tid & 3) * 8; LAS bf16_t* vt = (LAS bf16_t*)(lds + ML_VTS);
            vt[(v0 + 0) * (ML_TROW / 2) + l] = (bf16_t)(sv.x & 0xffff); vt[(v0 + 1) * (ML_TROW / 2) + l] = (bf16_t)(sv.x >> 16);
            vt[(v0 + 2) * (ML_TROW / 2) + l] = (bf16_t)(sv.y & 0xffff); vt[(v0 + 3) * (ML_TROW / 2) + l] = (bf16_t)(sv.y >> 16);
            vt[(v0 + 4) * (ML_TROW / 2) + l] = (bf16_t)(sv.z & 0xffff); vt[(v0 + 5) * (ML_TROW / 2) + l] = (bf16_t)(sv.z >> 16);
            vt[(v0 + 6) * (ML_TROW / 2) + l] = (bf16_t)(sv.w & 0xffff); vt[(v0 + 7) * (ML_TROW / 2) + l] = (bf16_t)(sv.w >> 16); }
        if (wid == 0) {
            const float xf = gf + b_f;
            const float lf = (xf >= 0.f) ? -log1pf(__expf(-xf)) : xf - log1pf(__expf(xf));
            float bb = lf;
#pragma unroll
            for (int o = 1; o < 64; o <<= 1) { const float tv = __shfl_up(bb, o); if (lane >= o) bb += tv; }
            const float btot = __shfl(bb, 63);
            const float ig = gi + b_i;
            const float a = btot - bb + ig;
            const float mchunk = wave_max(a);
            const float wa = __expf(a - mchunk);
            const float u = ig - bb;
            float pm = u;
#pragma unroll
            for (int o = 1; o < 64; o <<= 1) { const float tv = __shfl_up(pm, o); if (lane >= o) pm = fmaxf(pm, tv); }
            const float mintra = bb + pm;
            const float ginter = bb + m_st;
            const float m = fmaxf(ginter, mintra);
            const float mnew = fmaxf(btot + m_st, mchunk);
            const float sold = __expf(btot + m_st - mnew), snew = __expf(mchunk - mnew);
            ROWT[lane] = bb - m; COLT[lane] = u; WINT[lane] = __expf(ginter - m); ENEG[lane] = __expf(-m); WAS[lane] = snew * wa;
            if (lane == 0) SCAL[0] = sold;
            m_st = mnew;
        }
        __syncthreads();
        if (c + 1 < SEQ / MCH) ML_LOAD(c + 1);
        f32x16 iacc;
#pragma unroll
        for (int r = 0; r < 16; ++r) iacc[r] = 0.f;
        if (wid < 4) {
            const int jb = wid >> 1, sb = wid & 1;
            LAS bf16_t* ss = (LAS bf16_t*)(lds + ML_SS);
            if (sb <= jb) {
                f32x16 s;
#pragma unroll
                for (int r = 0; r < 16; ++r) s[r] = 0.f;
                const LAS unsigned char* qa = lds + ML_QS + (32 * jb + r32) * ML_QROW + hi * 16; const LAS unsigned char* kb = lds + ML_KS + (32 * sb + r32) * ML_QROW + hi * 16;
#pragma unroll
                for (int kk = 0; kk < 8; ++kk) s = MFMA32(*(const LAS bf16x8*)(qa + kk * 32), *(const LAS bf16x8*)(kb + kk * 32), s);
                const int sidx = 32 * sb + r32; const float ct = COLT[sidx];
#pragma unroll
                for (int r = 0; r < 16; ++r) { const int j = 32 * jb + crow(r, hi);
                    const float ev = __builtin_amdgcn_exp2f((ROWT[j] + ct) * 1.4426950408889634f); const float val = (sidx <= j) ? s[r] * ev : 0.f;
                    ss[j * (ML_TROW / 2) + sidx] = (bf16_t)pk2(val, 0.f); }
            } else {
#pragma unroll
                for (int r = 0; r < 16; ++r) ss[(32 * jb + crow(r, hi)) * (ML_TROW / 2) + 32 * sb + r32] = (bf16_t)0;
            }
        } else if (wid < 6) {
            const int jb = wid - 4;
            const LAS unsigned char* qa = lds + ML_QS + (32 * jb + r32) * ML_QROW + hi * 16; const LAS unsigned char* cb = lds + ML_CS + r32 * ML_QROW + hi * 16;
#pragma unroll
            for (int kk = 0; kk < 8; ++kk) iacc = MFMA32(*(const LAS bf16x8*)(qa + kk * 32), *(const LAS bf16x8*)(cb + kk * 32), iacc);
        } else {
            const int j = 32 * (wid - 6) + (lane >> 1), half = lane & 1;
            const LAS unsigned char* qa = lds + ML_QS + j * ML_QROW + half * 128; float acc = 0.f;
#pragma unroll
            for (int i = 0; i < 8; ++i) { const u32x4 w = *(const LAS u32x4*)(qa + i * 16); const f32x4 n0 = *(const LAS f32x4*)(NVEC + half * 64 + i * 8), n1 = *(const LAS f32x4*)(NVEC + half * 64 + i * 8 + 4);
                acc += bflo(w.x) * n0[0] + bfhi(w.x) * n0[1] + bflo(w.y) * n0[2] + bfhi(w.y) * n0[3] + bflo(w.z) * n1[0] + bfhi(w.z) * n1[1] + bflo(w.w) * n1[2] + bfhi(w.w) * n1[3]; }
            acc += __shfl_xor(acc, 1);
            if (half == 0) NQ[j] = acc;
        }
        __syncthreads();
        if (wid < 4) {
            const float sold = SCAL[0];
#pragma unroll
            for (int r = 0; r < 16; ++r) cacc[r] *= sold;
            const LAS unsigned char* va = lds + ML_VTS + r32 * ML_TROW + hi * 16; const LAS unsigned char* kb = lds + ML_KTS + (32 * wid + r32) * ML_TROW + hi * 16;
#pragma unroll
            for (int kk = 0; kk < 4; ++kk) { const u32x4 w = *(const LAS u32x4*)(va + kk * 32);
                const f32x4 w0 = *(const LAS f32x4*)(WAS + 16 * kk + 8 * hi), w1 = *(const LAS f32x4*)(WAS + 16 * kk + 8 * hi + 4);
                u32x4 sa; sa.x = pk2(bflo(w.x) * w0[0], bfhi(w.x) * w0[1]); sa.y = pk2(bflo(w.y) * w0[2], bfhi(w.y) * w0[3]); sa.z = pk2(bflo(w.z) * w1[0], bfhi(w.z) * w1[1]); sa.w = pk2(bflo(w.w) * w1[2], bfhi(w.w) * w1[3]);
                cacc = MFMA32(__builtin_bit_cast(bf16x8, sa), *(const LAS bf16x8*)(kb + kk * 32), cacc); }
            LAS bf16_t* cs = (LAS bf16_t*)(lds + ML_CS);
#pragma unroll
            for (int r = 0; r < 16; ++r) cs[crow(r, hi) * (ML_QROW / 2) + 32 * wid + r32] = (bf16_t)pk2(cacc[r], 0.f);
        } else if (wid < 6) {
            const int jb = wid - 4;
#pragma unroll
            for (int r = 0; r < 16; ++r) iacc[r] *= WINT[32 * jb + crow(r, hi)];
            const LAS unsigned char* sa = lds + ML_SS + (32 * jb + r32) * ML_TROW + hi * 16; const LAS unsigned char* vb = lds + ML_VTS + r32 * ML_TROW + hi * 16;
#pragma unroll
            for (int kk = 0; kk < 4; ++kk) iacc = MFMA32(*(const LAS bf16x8*)(sa + kk * 32), *(const LAS bf16x8*)(vb + kk * 32), iacc);
        } else {
            const int tl = (wid - 6) * 64 + lane;
            { const int j = tl >> 1, half = tl & 1; const LAS unsigned char* sp = lds + ML_SS + j * ML_TROW + half * 64; float rs = 0.f;
#pragma unroll
              for (int i = 0; i < 4; ++i) { const u32x4 w = *(const LAS u32x4*)(sp + i * 16); rs += (bflo(w.x) + bfhi(w.x)) + (bflo(w.y) + bfhi(w.y)) + (bflo(w.z) + bfhi(w.z)) + (bflo(w.w) + bfhi(w.w)); }
              rs += __shfl_xor(rs, 1);
              if (half == 0) { const float den = WINT[j] * NQ[j] + rs; DINV[j] = 1.0f / fmaxf(fabsf(den), ENEG[j]); } }
            { const int k = tl; const LAS unsigned char* kp = lds + ML_KTS + k * ML_TROW; float acc = SCAL[0] * NVEC[k];
#pragma unroll
              for (int i = 0; i < 8; ++i) { const u32x4 w = *(const LAS u32x4*)(kp + i * 16); const f32x4 w0 = *(const LAS f32x4*)(WAS + i * 8), w1 = *(const LAS f32x4*)(WAS + i * 8 + 4);
                  acc += bflo(w.x) * w0[0] + bfhi(w.x) * w0[1] + bflo(w.y) * w0[2] + bfhi(w.y) * w0[3] + bflo(w.z) * w1[0] + bfhi(w.z) * w1[1] + bflo(w.w) * w1[2] + bfhi(w.w) * w1[3]; }
              NVEC[k] = acc; }
        }
        __syncthreads();
        if (wid == 4 || wid == 5) {
            const int jb = wid - 4; float* hp = hraw + (tok0 + 32 * jb) * MW + h * MHD + vs * 32 + r32;
#pragma unroll
            for (int r = 0; r < 16; ++r) { const int j = crow(r, hi); hp[(size_t)j * MW] = iacc[r] * DINV[32 * jb + j]; }
        }
    }
#undef ML_LOAD
    __syncthreads();
}
DI void p5_mlstm(const Args& args, LAS unsigned char* lds, int vcu, int G) {
    for (int u = vcu; u < NB * MH * 4; u += G) { const int vs = u & 3, bh = u >> 2; mlstm_unit(bh / MH, bh % MH, vs, args, lds); }
}
#ifndef MK_ONE_LAUNCH
#define MK_ONE_LAUNCH 1
#endif
#ifndef P3SEL
#define P3SEL 31
#endif
constexpr int NPH = 20;
__global__ void __launch_bounds__(NWAVES * 64, 2) fwd_kernel(Args args) {
    extern __shared__ __attribute__((aligned(16))) unsigned char lds_raw[];
    LAS unsigned char* lds = (LAS unsigned char*)lds_raw;
    const int tid = threadIdx.x;
    const int G = gridDim.x; const int bx = blockIdx.x; const int vcu = (G % 8 == 0) ? (bx % 8) * (G / 8) + bx / 8 : bx;
    unsigned char* ws = args.ws;
    for (int u = tid; u < (LDS_BYTES - LDSCTL_OFF) / 4; u += NWAVES * 64) ((LAS unsigned*)(lds + LDSCTL_OFF))[u] = 0u;
    __syncthreads();
    volatile LAS unsigned* MISC = (volatile LAS unsigned*)(lds + MISC_OFF);
    XcdBarrier bar; bar.bar = (unsigned*)(ws + WS_CTL) + CW_BAR; bar.x = 0; bar.st = nullptr;
    const int lo = args.ph_lo, hi = args.ph_hi;
    if (hi - lo > 1) bar = xcd_barrier_post((unsigned*)(ws + WS_CTL) + CW_BAR, MISC + 8);
#ifndef PHASE_MASK
#define PHASE_MASK 0xFFFFFu
#endif
#define IN(k) (((PHASE_MASK >> (k)) & 1u) && lo <= (k) && (k) < hi)
#ifndef DUP_PHASE
#define DUP_PHASE -1
#endif
#define REP(k) _Pragma("unroll 1") for (int rep_ = 0; rep_ < ((DUP_PHASE == (k)) ? 2 : 1); ++rep_)
#define SEAM(k) do { if (IN(k) && IN(NEXTPH(k))) xcd_barrier(bar); } while (0)
#define NEXTPH(k) (((k) == 7 || (k) == 12) ? (k) + 2 : (k) + 1)
    using namespace pg8;
    LAS unsigned char* ring = lds + RING_OFF;
    const bf16_t* cws = (const bf16_t*)ws;
#define WSB(off) ((bf16_t*)(ws + (off)))
#define WSF(off) ((float*)(ws + (off)))

    if (IN(0)) REP(0) { p0_prologue(args, lds, vcu, G); }
    SEAM(0);
    if (IN(1)) REP(1) {
        { P1Order S; S.proj.init(WSB(WS_XB), WSB(WS_W_IN), T, NPROJ, D, D, G, bx); S.memb = (const char*)(ws + WS_MEMB); S.wck = (const char*)(ws + WS_W_CK); S.wcv = (const char*)(ws + WS_W_CV); S.G = G; S.c = bx;
          EpiProj E{WSB(WS_PROJ), WSF(WS_GATES), WSB(WS_KC), WSB(WS_VCT)}; gemm_phase(ring, D, D, D, S, E); }
    }
    SEAM(1);
    if (IN(2)) REP(2) { p2_tokens(args, vcu, G); }
    SEAM(2);
    if (IN(3)) REP(3) {
        if (P3SEL & 1) { DenseOrder S; S.init(WSB(WS_QN), WSB(WS_W_UQ), T, AH * AQK, 256, 256, G, bx); EpiQmla E{WSB(WS_QMLA), WSF(WS_CS), 0.10206207261596575f * 1.4426950408889634f}; gemm_phase(ring, 256, 256, 256, S, E); }
        if (P3SEL & 2) { DenseOrder S; S.init(WSB(WS_KVN), WSB(WS_W_UK), T, 512, 256, 256, G, bx); EpiBf16 E{WSB(WS_KN), 512, 1 << 30, 1.f}; gemm_phase(ring, 256, 256, 256, S, E); }
        if (P3SEL & 4) { DenseOrder S; S.init(WSB(WS_W_UV), WSB(WS_KVN), 512, T, 256, 256, G, bx); EpiBf16 E{WSB(WS_VT), T, 1 << 30, 1.f}; gemm_phase(ring, 256, 256, 256, S, E); }
        if (P3SEL & 8) { PairOrderA S{(const char*)(ws + WS_XC), (const char*)(ws + WS_W_MQK), G, vcu}; EpiBf16 E{WSB(WS_QKM), 1024, 2, 0.08838834764831845f}; gemm_phase(ring, 256, 512, 256, S, E); }
        if (P3SEL & 16) { PairOrderB S{(const char*)(ws + WS_W_MQK) + (size_t)512 * 256 * 2, (const char*)(ws + WS_XC), G, vcu}; EpiBf16 E{WSB(WS_KTM), T, 0, 0.08838834764831845f}; gemm_phase(ring, 256, 256, 512, S, E); }
    }
    SEAM(3);
    if (IN(4)) { REP(40) { p5_mlstm(args, lds, vcu, G); } REP(41) { p4_attention(args, lds, vcu, G); } }
    SEAM(4);
    if (IN(5)) REP(5) { p6_mpost(args, vcu, G); }
    SEAM(5);
    if (IN(6)) REP(6) {
        { DenseOrder S; S.init(WSB(WS_HM), WSB(WS_W_BRM), T, D, 512, 512, G, bx); EpiGate<false> E{WSB(WS_GATED), WSB(WS_PROJ), PC_GM}; gemm_phase(ring, 512, 512, 512, S, E); }
        { DenseOrder S; S.init(WSB(WS_AO), WSB(WS_W_BRA), T, D, 512, 512, G, bx); EpiGate<true> E{WSB(WS_GATED), WSB(WS_PROJ), PC_GA}; gemm_phase(ring, 512, 512, 512, S, E); }
    }
    SEAM(6);
    if (IN(7)) REP(7) { DenseOrder S; S.init(WSB(WS_GATED), WSB(WS_W_MIX), T, D, D, D, G, bx); EpiResStats<false> E{WSB(WS_XB), nullptr, nullptr, nullptr, WSB(WS_V1B), WSF(CTL_STATS1)}; gemm_phase(ring, D, D, D, S, E); }
    SEAM(7);
    if (IN(9)) REP(9) { DenseOrder S; S.init(WSB(WS_V1B), WSB(WS_W_CQ), T, D, D, D, G, bx); EpiLNApplyBf16 E{WSB(WS_QC), D, WSF(CTL_STATS1), WSF(CTL_CS1), WSF(CTL_CB1), 0.0625f * 1.4426950408889634f}; gemm_phase(ring, D, D, D, S, E); }
    SEAM(9);
    if (IN(10)) REP(10) { CrossSOrder S{(const char*)(ws + WS_QC), (const char*)(ws + WS_KC), G, vcu}; EpiSoftmax E{WSB(WS_PC), (LAS float*)(lds + RED_OFF)}; gemm_phase(ring, 256, D, D, S, E); }
    SEAM(10);
    if (IN(11)) REP(11) { CrossOOrder S{(const char*)(ws + WS_PC), (const char*)(ws + WS_VCT), G, vcu}; EpiBf16 E{WSB(WS_OC), D, 1 << 30, 1.f}; gemm_phase(ring, 256, D, NB * NMEM, S, E); }
    SEAM(11);
    if (IN(12)) REP(12) { DenseOrder S; S.init(WSB(WS_OC), WSB(WS_W_CO), T, D, D, D, G, bx); EpiResStats<true> E{WSB(WS_V1B), WSF(CTL_STATS1), (const float*)args.in[19], (const float*)args.in[20], WSB(WS_V2B), WSF(CTL_STATS2)}; gemm_phase(ring, D, D, D, S, E); }
    SEAM(12);
    if (IN(14)) REP(14) { DenseOrder S; S.init(WSB(WS_V2B), WSB(WS_W_R), T, 256, D, D, G, bx); EpiLNApplyF32 E{WSF(WS_LOGITS), NE, NE, WSF(CTL_STATS2), WSF(CTL_CSR), WSF(CTL_CBR)}; gemm_phase(ring, D, D, D, S, E); }
    SEAM(14);
    if (IN(15)) REP(15) { p16_topk(args, lds, vcu, G); }
    SEAM(15);
    if (IN(16)) REP(16) { p17_gather(args, lds, vcu, G); }
    SEAM(16);
    if (IN(17)) REP(17) { build_tstart(args, lds);
        MoeOrder S{(const char*)(ws + WS_XG), (const char*)(ws + WS_W_GU), (const LAS int*)(lds + TST_OFF), (const LAS int*)(lds + TILE_E_OFF), 8, G, vcu, (size_t)256 * D, (size_t)2048 * 1024, (size_t)256 * 1024};
        EpiSwiglu E{ws + WS_ACT, (const float*)args.in[29]}; gemm_phase<EpiSwiglu, MoeOrder, true>(ring, D, D, D, S, E); }
    SEAM(17);
    if (IN(18)) REP(18) { build_tstart(args, lds);
        MoeOrder S{(const char*)(ws + WS_ACT), (const char*)(ws + WS_W_DN), (const LAS int*)(lds + TST_OFF), (const LAS int*)(lds + TILE_E_OFF), 4, G, vcu, (size_t)256 * D, (size_t)1024 * 1024, (size_t)256 * 1024};
        EpiDown E{WSB(WS_YB), (const float*)args.in[31], WSF(WS_ROWGATE)}; gemm_phase<EpiDown, MoeOrder, true>(ring, D, D, D, S, E); }
    SEAM(18);
    if (IN(19)) REP(19) { p20_final(args, vcu, G); }
    (void)cws;
#undef IN
#undef SEAM
}

extern "C" void kernel_launch(void* const* d_in, const int* in_sizes, int n_in, void* d_out, int out_size, void* d_ws, size_t ws_size, hipStream_t stream) {
    static int grid = 0;
    if (grid == 0) {
        if (n_in != 34 || in_sizes[0] != T * D || out_size != T * D || ws_size < WS_END) { fprintf(stderr, "kernel_launch: unexpected shapes / workspace (n_in %d, ws %zu)\n", n_in, ws_size); grid = -1; return; }
        int dev = 0, cus = 0, per_cu = 0;
        if (hipGetDevice(&dev) != hipSuccess || hipDeviceGetAttribute(&cus, hipDeviceAttributeMultiprocessorCount, dev) != hipSuccess) { grid = -1; return; }
        if (hipFuncSetAttribute((const void*)fwd_kernel, hipFuncAttributeMaxDynamicSharedMemorySize, LDS_BYTES) != hipSuccess) { fprintf(stderr, "kernel_launch: hipFuncSetAttribute failed\n"); grid = -1; return; }
        if (hipOccupancyMaxActiveBlocksPerMultiprocessor(&per_cu, (const void*)fwd_kernel, NWAVES * 64, LDS_BYTES) != hipSuccess || per_cu < 1) fprintf(stderr, "kernel_launch: occupancy query says %d\n", per_cu);
        (void)hipGetLastError();
        grid = cus;
    }
    if (grid < 0) return;
    if (hipMemsetAsync((char*)d_ws + WS_CTL, 0, CTL_ZERO_BYTES, stream) != hipSuccess) return;
    Args a{};
    for (int i = 0; i < 34; ++i) a.in[i] = d_in[i];
    a.out = (float*)d_out; a.ws = (unsigned char*)d_ws;
#if MK_ONE_LAUNCH
    a.ph_lo = 0; a.ph_hi = NPH;
    hipLaunchKernelGGL(fwd_kernel, dim3(grid), dim3(NWAVES * 64), LDS_BYTES, stream, a);
#else
    for (int p = 0; p < NPH; ++p) { a.ph_lo = p; a.ph_hi = p + 1; hipLaunchKernelGGL(fwd_kernel, dim3(grid), dim3(NWAVES * 64), LDS_BYTES, stream, a); }
#endif
}
```

```cpp
#include <hip/hip_runtime.h>
#include <cstdio>
#include <cstdint>
#include <cmath>

#ifndef P1_FP8
#define P1_FP8 1
#endif
#ifndef P6_FP8
#define P6_FP8 1
#endif
#ifndef XA_FP8
#define XA_FP8 1
#endif
#ifndef XS_FP8
#define XS_FP8 1
#endif
#ifndef CO_FP8
#define CO_FP8 1
#endif
#ifndef CQ_FP8
#define CQ_FP8 0
#endif
#define LAS __attribute__((address_space(3)))
#define GAS __attribute__((address_space(1)))
typedef unsigned short bf16_t;
typedef short bf16x8 __attribute__((ext_vector_type(8)));
typedef float f32x4 __attribute__((ext_vector_type(4)));
typedef float f32x2 __attribute__((ext_vector_type(2)));
typedef float f32x16 __attribute__((ext_vector_type(16)));
typedef unsigned u32x4 __attribute__((ext_vector_type(4)));
typedef unsigned u32x2 __attribute__((ext_vector_type(2)));
typedef GAS unsigned gu32;
#define RLX_AGENT __ATOMIC_RELAXED, __HIP_MEMORY_SCOPE_AGENT
#define DI __device__ __forceinline__

constexpr int D = 1024, NB = 16, SEQ = 2048, T = NB * SEQ, NMEM = 256;
constexpr int MH = 4, MHD = 128, MW = 512, MCH = 64;
constexpr int AH = 8, ANOPE = 64, AROPE = 32, AQK = 96, AVD = 64, AW = 512, AQR = 256, AKVR = 128;
constexpr int XH = 4, XHD = 256;
constexpr int NE = 32, TOPK = 4;
constexpr int DIN = 4008, NPROJ = 4096;
constexpr float DN_ALPHA = 1.189207115002721f;
constexpr float EPS = 1e-5f;
constexpr int NASSIGN = T * TOPK;
constexpr int NROWS = NASSIGN + NE * 256;
constexpr int NTILES_MAX = NROWS / 256;
constexpr int RCAP = 32768;
constexpr int PC_QLAT = 0, PC_KVLAT = 256, PC_KROPE = 384, PC_IG = 416, PC_FG = 420, PC_XM = 512, PC_VM = 1024, PC_OP = 1536, PC_GM = 2048, PC_GA = 3072;

DI unsigned f2bf(float f) { unsigned u = __builtin_bit_cast(unsigned, f); return (u + 0x7fffu + ((u >> 16) & 1u)) >> 16; }
typedef __bf16 bf16x2_hw __attribute__((ext_vector_type(2)));
DI unsigned pk2(float lo, float hi) { const f32x2 v = {lo, hi}; return __builtin_bit_cast(unsigned, __builtin_convertvector(v, bf16x2_hw)); }
DI float bf2f(unsigned short b) { return __builtin_bit_cast(float, (unsigned)b << 16); }
DI float bflo(unsigned w) { return __builtin_bit_cast(float, w << 16); }
DI float bfhi(unsigned w) { return __builtin_bit_cast(float, w & 0xffff0000u); }
DI float wave_sum(float v) {
#pragma unroll
    for (int o = 1; o < 64; o <<= 1) v += __shfl_xor(v, o);
    return v;
}
DI float wave_max(float v) {
#pragma unroll
    for (int o = 1; o < 64; o <<= 1) v = fmaxf(v, __shfl_xor(v, o));
    return v;
}
DI float rcpf_(float x) { return __builtin_amdgcn_rcpf(x); }
DI float sigmoidf_(float x) { return __builtin_amdgcn_rcpf(1.0f + __builtin_amdgcn_exp2f(-1.4426950408889634f * x)); }
DI int lane_id() { int l; asm volatile("v_mbcnt_lo_u32_b32 %0, -1, 0\n\tv_mbcnt_hi_u32_b32 %0, -1, %0" : "=v"(l)); return l; }
DI float swz_xor1(float v) { return __shfl_xor(v, 1); }
DI float swz_xor16(float v) { return __shfl_xor(v, 16); }
DI float sum_xor32(float v) { return v + __shfl_xor(v, 32); }
DI float max_xor32(float v) { return fmaxf(v, __shfl_xor(v, 32)); }
DI int crow(int r, int hi) { return (r & 3) + 8 * (r >> 2) + 4 * hi; }
#define MFMA32(a, b, c) __builtin_amdgcn_mfma_f32_32x32x16_bf16((a), (b), (c), 0, 0, 0)

namespace pg8 {
constexpr int BM = 256, BK = 64, HALF = 128, HTB = HALF * BK * 2, STAGE_BYTES = 8 * HTB;
__host__ __device__ __forceinline__ int lds_byte(int r, int c) { const int st = (r >> 4) * 2 + (c >> 5), rr = r & 15, cc = c & 31, ob = rr * 64 + cc * 2; return st * 1024 + (ob ^ (((ob >> 9) & 1) << 5)); }
__host__ __device__ __forceinline__ void stage_rc(int b, int& R, int& C) { const int st = b / 1024, sb = b % 1024, swz = sb ^ (((sb >> 9) & 1) << 5); R = (st >> 1) * 16 + swz / 64; C = (st & 1) * 32 + (swz % 64) / 2; }
__host__ __device__ __forceinline__ int perm32(int rho) { const int n = rho >> 4, i = rho & 15; return 8 * (i >> 2) + 4 * n + (i & 3); }

struct Unit { int pm, pn, aux; const char* a; const char* b; int gr = 0; };
struct Ctx { int wr, wc, fr, fq, wid, lane; };

DI unsigned cvt_pk_bf16(float lo, float hi) { unsigned r; asm volatile("v_cvt_pk_bf16_f32 %0, %1, %2" : "=v"(r) : "v"(lo), "v"(hi)); return r; }

typedef f32x4 Acc[2][2][4][2];

DI void glds16_s(const char* gbase, unsigned voff, unsigned lds_dst) { unsigned keep;
    asm volatile("s_mov_b32 %0, m0\n\ts_mov_b32 m0, %1\n\ts_nop 0\n\tglobal_load_lds_dwordx4 %2, %3\n\ts_mov_b32 m0, %0" : "=&s"(keep) : "s"(lds_dst), "v"(voff), "s"(gbase) : "memory"); }
typedef int v8i_t __attribute__((ext_vector_type(8)));
typedef int i32x4_t __attribute__((ext_vector_type(4)));
template <class E, class = void> struct Wide16T { static constexpr bool v = false; };
template <class E> struct Wide16T<E, decltype((void)E::WIDE16)> { static constexpr bool v = E::WIDE16; };
template <class E> constexpr bool epi_wide16() { return Wide16T<E>::v; }
template <class E, class = void> struct GluT { static constexpr bool v = false; };
template <class E> struct GluT<E, decltype((void)E::GLU)> { static constexpr bool v = E::GLU; };
template <class E> constexpr bool epi_glu() { return GluT<E>::v; }
template <class E, class = void> struct VmMinT { static constexpr int v = 0; };
template <class E> struct VmMinT<E, decltype((void)E::VM_MIN)> { static constexpr int v = E::VM_MIN; };
template <int N> DI void wait_vm() { asm volatile("s_waitcnt vmcnt(%0)" :: "n"(N) : "memory"); }
template <int N> DI void wait_vm_sel(int relax) { asm volatile("s_cmp_lg_u32 %0, 0\n\ts_cbranch_scc0 .Lw8_%=\n\ts_waitcnt vmcnt(%1)\n\ts_branch .Lwe_%=\n.Lw8_%=:\n\ts_waitcnt vmcnt(8)\n.Lwe_%=:" :: "s"(relax), "n"(N) : "memory", "scc"); }
template <class Epi, class Sched, bool FP8 = false, int STAG = 0, bool GATHER = false>
DI void gemm_phase(LAS unsigned char* lds, const int wv, const int K, const int lda, const int ldb, const Sched& S, const Epi& E) {
    if constexpr (STAG > 0) {
        const unsigned long long t0_ = __builtin_amdgcn_s_memrealtime(); const unsigned long long d_ = (unsigned long long)((blockIdx.x >> 3) & 3) * STAG;
        while (__builtin_amdgcn_s_memrealtime() - t0_ < d_) __builtin_amdgcn_s_sleep(8);
    }
    int tid = wv * 64 + lane_id(); asm volatile("" : "+v"(tid));
    const int wid = wv, lane = tid & 63, wr = wid >> 2, wc = wid & 3, fr = lane & 15, fq = lane >> 4;
    constexpr int ESZ = FP8 ? 1 : 2;
    int nt = K * ESZ / (BK * 2); asm volatile("" : "+s"(nt));
    unsigned voffA[2], voffB[2]; unsigned cbyte = 0; const LAS unsigned char* tcur = nullptr;
    if constexpr (GATHER) { int R, C; stage_rc(tid * 16, R, C); cbyte = (unsigned)(C * 2); tcur = (const LAS unsigned char*)S.tab + R * 2; }
#pragma unroll
    for (int i = 0; i < 2; ++i) { int R, C; stage_rc(tid * 16 + i * 8192, R, C); const int p32 = perm32(R & 31);
        const int Rb = Epi::PERM ? (epi_glu<Epi>() ? (64 * (R >> 5) + 16 * (p32 >> 3) + 2 * (p32 & 3) + ((p32 >> 2) & 1)) : epi_wide16<Epi>() ? (64 * (R >> 5) + 16 * (p32 >> 3) + (p32 & 7)) : ((R & ~31) + p32)) : R;
        voffA[i] = (unsigned)(R * lda * ESZ + C * 2); voffB[i] = (unsigned)(Rb * ldb * ESZ + C * 2); }
    const size_t kstep = (size_t)(BK * 2);
    const size_t hstepA = (size_t)HALF * lda * ESZ, hstepB = (size_t)(epi_wide16<Epi>() ? 8 : HALF) * ldb * ESZ;
    const unsigned ldsw = (unsigned)wid * 1024u;
    const int aoff = lds_byte(wr * 64 + fr, fq * 8), boff = lds_byte(wc * 32 + fr, fq * 8);
    const Ctx cx{wr, wc, fr, fq, wid, lane};
    const unsigned lds_u = (unsigned)__builtin_amdgcn_readfirstlane((int)((unsigned)(size_t)lds + ldsw));
    LAS unsigned char* ldsB = lds + 4 * HTB + boff;
#define PG8_SA(b, h) (((b) * 2 + (h)) * HTB)
#define PG8_SB(b, h) ((4 + (b) * 2 + (h)) * HTB)
#define PG8_SBL(b, h) (((b) * 2 + (h)) * HTB)
#define PG8_STAGE(bufoff, gbase, voff) do { _Pragma("unroll") for (int _i = 0; _i < 2; ++_i) \
        glds16_s((const char*)(gbase), (voff)[_i], lds_u + (unsigned)((bufoff) + _i * 8192)); } while (0)
#define PG8_STAGE_A(bufoff, half, gbase, tb) do { if constexpr (GATHER) { _Pragma("unroll") for (int _i = 0; _i < 2; ++_i) { const unsigned tk_ = *(const LAS unsigned short*)((tb) + (half) * 256 + _i * 128); \
        glds16_s((const char*)(gbase), tk_ * 1024u + cbyte, lds_u + (unsigned)((bufoff) + _i * 8192)); } } else { PG8_STAGE(bufoff, (gbase) + (half) * hstepA, voffA); } } while (0)
#define PG8_RD(off) (*(const LAS i32x4_t*)(lds + (off)))
#define PG8_CAT2(x, y) __builtin_shufflevector((x), (y), 0, 1, 2, 3, 4, 5, 6, 7)
#define PG8_LDA(dst, b, h) do { if constexpr (FP8) { _Pragma("unroll") for (int m = 0; m < 4; ++m) dst##8[m] = PG8_CAT2(PG8_RD(PG8_SA(b, h) + aoff + m * 2048), PG8_RD(PG8_SA(b, h) + aoff + m * 2048 + 1024)); } \
        else { _Pragma("unroll") for (int m = 0; m < 4; ++m) _Pragma("unroll") for (int k = 0; k < 2; ++k) dst[m][k] = *(const LAS bf16x8*)(lds + PG8_SA(b, h) + aoff + m * 2048 + k * 1024); } } while (0)
#define PG8_LDB(dst, b, h) do { if constexpr (FP8) { _Pragma("unroll") for (int n = 0; n < 2; ++n) dst##8[n] = PG8_CAT2(*(const LAS i32x4_t*)(ldsB + PG8_SBL(b, h) + n * 2048), *(const LAS i32x4_t*)(ldsB + PG8_SBL(b, h) + n * 2048 + 1024)); } \
        else { _Pragma("unroll") for (int n = 0; n < 2; ++n) _Pragma("unroll") for (int k = 0; k < 2; ++k) dst[n][k] = *(const LAS bf16x8*)(ldsB + PG8_SBL(b, h) + n * 2048 + k * 1024); } } while (0)
#define PG8_MMA(ai, bj, At, Bt) do { __builtin_amdgcn_s_setprio(1); \
        if constexpr (FP8) { _Pragma("unroll") for (int m = 0; m < 4; ++m) _Pragma("unroll") for (int n = 0; n < 2; ++n) \
            acc[ai][bj][m][n] = __builtin_amdgcn_mfma_scale_f32_16x16x128_f8f6f4(Bt##8[n], At##8[m], acc[ai][bj][m][n], 0, 0, 0, 0x7f7f7f7f, 0, 0x7f7f7f7f); } \
        else { _Pragma("unroll") for (int m = 0; m < 4; ++m) _Pragma("unroll") for (int n = 0; n < 2; ++n) _Pragma("unroll") for (int k = 0; k < 2; ++k) \
            acc[ai][bj][m][n] = __builtin_amdgcn_mfma_f32_16x16x32_bf16(Bt[n][k], At[m][k], acc[ai][bj][m][n], 0, 0, 0); } \
        __builtin_amdgcn_s_setprio(0); } while (0)
#define PG8_WAIT_V(n) asm volatile("s_waitcnt vmcnt(" #n ")" ::: "memory")
#define PG8_WAIT_L(n) asm volatile("s_waitcnt lgkmcnt(" #n ")" ::: "memory")
#define PG8_BAR __builtin_amdgcn_s_barrier()
#define PG8_SCHED __builtin_amdgcn_sched_barrier(0)
    Unit cur, nxt; int ui = 0;
    if (!S.next(0, cur)) return;
    Acc acc;
#pragma unroll
    for (int a = 0; a < 2; ++a)
#pragma unroll
        for (int b = 0; b < 2; ++b)
#pragma unroll
            for (int m = 0; m < 4; ++m)
#pragma unroll
                for (int n = 0; n < 2; ++n) acc[a][b][m][n] = (f32x4){0.f, 0.f, 0.f, 0.f};
    bf16x8 At[4][2], B0[2][2], B1[2][2]; v8i_t At8[4], B08[2], B18[2];
    const char* cA = cur.a; const char* cB = cur.b;
    PG8_STAGE(PG8_SB(0, 0), cB, voffB); PG8_STAGE(PG8_SB(0, 1), cB + hstepB, voffB); PG8_STAGE_A(PG8_SA(0, 0), 0, cA, tcur); PG8_STAGE_A(PG8_SA(0, 1), 1, cA, tcur);
    if (wr == 1) PG8_BAR;
    PG8_WAIT_V(2); PG8_BAR;
    PG8_STAGE(PG8_SB(1, 0), cB + kstep, voffB); PG8_STAGE_A(PG8_SA(1, 0), 0, cA + kstep, tcur); PG8_STAGE(PG8_SB(1, 1), cB + hstepB + kstep, voffB);
    PG8_WAIT_V(6); PG8_BAR;
    for (;;) {
        const bool has_next = S.next(ui + 1, nxt);
        const char* nA = has_next ? nxt.a : cA; const char* nB = has_next ? nxt.b : cB;
#pragma unroll 1
        for (int t = 0; t < nt; t += 2) {
            const bool last = (t == nt - 2);
            const char* a1 = cA + (size_t)(t + 1) * kstep;
            const char* a2 = last ? nA : cA + (size_t)(t + 2) * kstep; const char* b2 = last ? nB : cB + (size_t)(t + 2) * kstep;
            const char* a3 = a2 + kstep; const char* b3 = b2 + kstep;
            const LAS unsigned char* t2 = tcur + ((GATHER && last && has_next) ? 512 : 0);
            PG8_LDB(B0, 0, 0); PG8_LDB(B1, 0, 1); PG8_SCHED; PG8_LDA(At, 0, 0); PG8_STAGE_A(PG8_SA(1, 1), 1, a1, tcur);
            PG8_WAIT_V(8); PG8_WAIT_L(0); PG8_BAR; PG8_MMA(0, 0, At, B0); PG8_MMA(0, 1, At, B1); PG8_BAR; PG8_SCHED;
            PG8_LDA(At, 0, 1); PG8_STAGE(PG8_SB(0, 0), b2, voffB); PG8_STAGE(PG8_SB(0, 1), b2 + hstepB, voffB); PG8_STAGE_A(PG8_SA(0, 0), 0, a2, t2);
            PG8_WAIT_V(8); PG8_WAIT_L(0); PG8_BAR; PG8_MMA(1, 0, At, B0); PG8_MMA(1, 1, At, B1); PG8_BAR; PG8_SCHED;
            PG8_LDB(B0, 1, 0); PG8_LDB(B1, 1, 1); PG8_SCHED; PG8_LDA(At, 1, 0); PG8_STAGE_A(PG8_SA(0, 1), 1, a2, t2);
            PG8_WAIT_V(8); PG8_WAIT_L(0); PG8_BAR; PG8_MMA(0, 0, At, B0); PG8_MMA(0, 1, At, B1); PG8_BAR; PG8_SCHED;
            PG8_LDA(At, 1, 1); PG8_STAGE(PG8_SB(1, 0), b3, voffB); PG8_STAGE(PG8_SB(1, 1), b3 + hstepB, voffB); PG8_STAGE_A(PG8_SA(1, 0), 0, a3, t2);
            PG8_WAIT_V(8); PG8_WAIT_L(0); PG8_BAR; PG8_MMA(1, 0, At, B0); PG8_MMA(1, 1, At, B1); PG8_BAR; PG8_SCHED;
        }
        if (wr == 0) PG8_BAR;
        E(acc, cur, cx);
#ifdef DUP_EPI
        if constexpr (FP8) E(acc, cur, cx);
#endif
        if (!has_next) break;
#pragma unroll
        for (int a = 0; a < 2; ++a)
#pragma unroll
            for (int b = 0; b < 2; ++b)
#pragma unroll
                for (int m = 0; m < 4; ++m)
#pragma unroll
                    for (int n = 0; n < 2; ++n) acc[a][b][m][n] = (f32x4){0.f, 0.f, 0.f, 0.f};
        cur = nxt; cA = nA; cB = nB; ++ui; if constexpr (GATHER) tcur += 512;
        if (wr == 1) PG8_BAR;
    }
    PG8_WAIT_V(0);
    PG8_BAR;
#undef PG8_SA
#undef PG8_SB
#undef PG8_SBL
#undef PG8_STAGE
#undef PG8_STAGE_A
#undef PG8_LDA
#undef PG8_LDB
#undef PG8_MMA
#undef PG8_CAT2
#undef PG8_RD
#undef PG8_WAIT_V
#undef PG8_WAIT_L
#undef PG8_BAR
#undef PG8_SCHED
}
}
namespace pg8 {
constexpr int NXCD = 8, WGM = 8;
struct DenseOrder {
    const char* A; const char* B; int nM, nN, nwg, G, c; size_t strideA, strideB;
    DI void init(const void* A_, const void* B_, int M, int N, int lda, int ldb, int G_, int c_, int esz = 2) { A = (const char*)A_; B = (const char*)B_; nM = M / BM; nN = N / BM; nwg = nM * nN; G = G_; c = c_;
        strideA = (size_t)BM * lda * esz; strideB = (size_t)BM * ldb * esz; }
    DI void unit_at(int wgid, Unit& u) const {
        { const int q = nwg / NXCD, r = nwg % NXCD, xcd = wgid % NXCD, off = wgid / NXCD; wgid = (xcd < r ? xcd * (q + 1) : r * (q + 1) + (xcd - r) * q) + off; }
        const int nig = WGM * nN, gid = wgid / nig, fm = gid * WGM, gsz = (nM - fm) < WGM ? (nM - fm) : WGM;
        u.pm = fm + ((wgid % nig) % gsz); u.pn = (wgid % nig) / gsz; u.aux = 0;
        u.a = A + (size_t)u.pm * strideA; u.b = B + (size_t)u.pn * strideB;
    }
    DI bool next(int i, Unit& u) const {
        const long L = (long)i * G + c; if (L >= nwg) return false;
        unit_at((int)L, u); return true;
    }
};
struct P1Order {
    DenseOrder proj; const char* memb; const char* wck; const char* wcv; int G, c, esz, nconv, ncu;
    DI bool next(int i, Unit& u) const {
        const int total = proj.nwg + 128, tail = nconv * ncu; int L;
        if (c >= G - nconv) { if (i >= ncu) return false; L = total - tail + i * nconv + (c - (G - nconv)); }
        else { L = i * (G - nconv) + c; if (L >= total - tail) return false; }
        if (L < proj.nwg) { proj.unit_at(L, u); return true; }
        L -= proj.nwg;
        const int kind = L >> 6, r = L & 63;
        if (kind == 0) { u.pm = r >> 2; u.pn = r & 3; u.aux = 1; u.a = memb + (size_t)u.pm * 256 * D * esz; u.b = wck + (size_t)u.pn * 256 * D * esz; }
        else { u.pm = r >> 4; u.pn = r & 15; u.aux = 2; u.a = wcv + (size_t)u.pm * 256 * D * esz; u.b = memb + (size_t)u.pn * 256 * D * esz; }
        return true;
    }
};
struct PairOrderA {
    const char* A; const char* B; int G, v;
    DI bool next(int i, Unit& u) const { const int L = i * G + v; if (L >= (T / 256) * 4) return false;
        u.pm = L >> 2; u.pn = L & 3; u.aux = 0; u.a = A + ((size_t)u.pm * 256 * MW + (u.pn & 1) * 256) * 2; u.b = B + (size_t)u.pn * 256 * 256 * 2; return true; }
};
struct PairOrderB {
    const char* A; const char* B; int G, v;
    DI bool next(int i, Unit& u) const { const int L = i * G + v; if (L >= 2 * (T / 256)) return false;
        u.pm = L & 1; u.pn = L >> 1; u.aux = 0; u.a = A + (size_t)u.pm * 256 * 256 * 2; u.b = B + ((size_t)u.pn * 256 * MW + u.pm * 256) * 2; return true; }
};
struct BranchOrder {
    DenseOrder d; const char* A1; const char* B1; int rounds;
    DI bool next(int i, Unit& u) const {
        const int kind = (i >= rounds) ? 1 : 0;
        if (!d.next(i - kind * rounds, u)) return false;
        if (kind) { u.a = A1 + (size_t)u.pm * d.strideA; u.b = B1 + (size_t)u.pn * d.strideB; u.aux = 1; }
        return true;
    }
};
struct CrossSOrder {
    const char* Q; const char* Kc; int G, v, esz;
    DI bool next(int i, Unit& u) const {
        const int L = i * G + v; if (L >= (T / 256) * XH) return false;
        u.pm = L >> 2; u.pn = L & 3; u.aux = 0;
        u.a = Q + ((size_t)u.pm * 256 * D + u.pn * 256) * esz; u.b = Kc + ((size_t)(u.pm >> 3) * 256 * D + u.pn * 256) * esz; return true;
    }
};
struct CrossOOrder {
    const char* P; const char* Vt; int G, v, esz;
    DI bool next(int i, Unit& u) const {
        const int L = i * G + v; if (L >= (T / 256) * XH) return false;
        u.pm = L >> 2; u.pn = L & 3; u.aux = 0;
        u.a = P + ((size_t)u.pm * 256 * D + u.pn * 256) * esz; u.b = Vt + ((size_t)u.pn * 256 * (NB * NMEM) + (size_t)(u.pm >> 3) * 256) * esz; return true;
    }
};
struct MoeOrder {
    const char* A; const char* W; const LAS int* tstart; const LAS int* tile_e; int npn, G, v; size_t strideA, strideW, strideN;
    const LAS unsigned short* tab = nullptr;
    DI bool next(int i, Unit& u) const {
        const int L = i * G + v; const int total = __builtin_amdgcn_readfirstlane(tstart[NE]) * npn; if (L >= total) return false;
        const int tile = L / npn; u.pm = tile; u.pn = L - tile * npn;
        const int e = __builtin_amdgcn_readfirstlane(tile_e[tile]);
        u.aux = e; u.gr = e * RCAP + (tile - __builtin_amdgcn_readfirstlane(tstart[e])) * 256;
        u.a = A + (size_t)tile * strideA; u.b = W + (size_t)e * strideW + (size_t)u.pn * strideN; return true;
    }
};

DI float clamp_f8(float x) { return __builtin_amdgcn_fmed3f(x, -448.0f, 448.0f); }
DI unsigned pk4_fp8(float a, float b, float c, float d) { int w = 0; w = __builtin_amdgcn_cvt_pk_fp8_f32(clamp_f8(a), clamp_f8(b), w, false); w = __builtin_amdgcn_cvt_pk_fp8_f32(clamp_f8(c), clamp_f8(d), w, true); return (unsigned)w; }
DI unsigned pk4_fp8_nc(float a, float b, float c, float d) { int w = 0; w = __builtin_amdgcn_cvt_pk_fp8_f32(a, b, w, false); w = __builtin_amdgcn_cvt_pk_fp8_f32(c, d, w, true); return (unsigned)w; }
constexpr float F8_XS = 16.0f, F8_WS = 64.0f, F8_AS = 8.0f, F8_OS = 256.0f, F8_YS = 64.0f;
#ifdef USE_NT
#define NT_STORE(p, v) __builtin_nontemporal_store((v), (p))
#else
#define NT_STORE(p, v) (*(p) = (v))
#endif
struct EpiBf16 {
    static constexpr int VM_MIN = 16;
    static constexpr bool PERM = true, WIDE16 = true;
    bf16_t* O; int ldc; int sc_from; float scale;
    DI void operator()(const Acc& acc, const Unit& u, const Ctx& c) const {
        int row0 = u.pm * BM + c.wr * 64 + c.fr, col0 = u.pn * BM + c.wc * 64 + 16 * c.fq; asm volatile("" : "+v"(row0), "+v"(col0));
        const float sc = (u.pn >= sc_from) ? scale : 1.0f;
#pragma unroll
        for (int ai = 0; ai < 2; ++ai)
#pragma unroll
            for (int m = 0; m < 4; ++m) { bf16_t* rowp = O + (size_t)(row0 + ai * HALF + m * 16) * ldc + col0;
#pragma unroll
                for (int bj = 0; bj < 2; ++bj) { const f32x4 v0 = acc[ai][bj][m][0] * sc, v1 = acc[ai][bj][m][1] * sc;
                    u32x4 w; w.x = cvt_pk_bf16(v0[0], v0[1]); w.y = cvt_pk_bf16(v0[2], v0[3]); w.z = cvt_pk_bf16(v1[0], v1[1]); w.w = cvt_pk_bf16(v1[2], v1[3]);
                    *(u32x4*)(rowp + bj * 8) = w; } }
    }
};
struct EpiF8 {
    static constexpr bool PERM = true;
    unsigned char* O; int ldc; float scale;
    DI void operator()(const Acc& acc, const Unit& u, const Ctx& c) const {
        int row0 = u.pm * BM + c.wr * 64 + c.fr, col0 = u.pn * BM + c.wc * 32 + 8 * c.fq; asm volatile("" : "+v"(row0), "+v"(col0));
#pragma unroll
        for (int ai = 0; ai < 2; ++ai)
#pragma unroll
            for (int m = 0; m < 4; ++m) { unsigned char* rowp = O + (size_t)(row0 + ai * HALF + m * 16) * ldc + col0;
#pragma unroll
                for (int bj = 0; bj < 2; ++bj) { const f32x4 v0 = acc[ai][bj][m][0] * scale, v1 = acc[ai][bj][m][1] * scale;
                    u32x2 q; q.x = pk4_fp8(v0[0], v0[1], v0[2], v0[3]); q.y = pk4_fp8(v1[0], v1[1], v1[2], v1[3]); *(u32x2*)(rowp + bj * HALF) = q; } }
    }
};
struct EpiProj {
    static constexpr int VM_MIN = 16;
    static constexpr bool PERM = true, WIDE16 = true;
    bf16_t* O; float* gates; bf16_t* Kc; bf16_t* VcT; int col_base; float us;
    DI void operator()(const Acc& acc, const Unit& u, const Ctx& c) const {
        int row0 = u.pm * BM + c.wr * 64 + c.fr, col0 = u.pn * BM + c.wc * 64 + 16 * c.fq; asm volatile("" : "+v"(row0), "+v"(col0));
        if ((XS_FP8 && u.aux == 1) || (XA_FP8 && u.aux == 2)) {
            unsigned char* base8 = (unsigned char*)((u.aux == 1) ? Kc : VcT); const int ldc8 = (u.aux == 1) ? D : NB * NMEM; const float sc = us * F8_XS;
#pragma unroll
            for (int ai = 0; ai < 2; ++ai)
#pragma unroll
                for (int m = 0; m < 4; ++m) { unsigned char* rowp = base8 + (size_t)(row0 + ai * HALF + m * 16) * ldc8 + col0;
                    u32x4 q;
#pragma unroll
                    for (int bj = 0; bj < 2; ++bj) { const f32x4 v0 = acc[ai][bj][m][0] * sc, v1 = acc[ai][bj][m][1] * sc; q[2 * bj] = pk4_fp8(v0[0], v0[1], v0[2], v0[3]); q[2 * bj + 1] = pk4_fp8(v1[0], v1[1], v1[2], v1[3]); }
                    *(u32x4*)rowp = q; }
            return; }
        bf16_t* base = (u.aux == 0) ? O + col_base : (u.aux == 1) ? Kc : VcT; const int ldc = (u.aux == 0) ? NPROJ : (u.aux == 1) ? D : NB * NMEM;
        const bool gt = (u.aux == 0 && col_base + u.pn * BM == 256 && c.wc == 2 && c.fq == 2);
#pragma unroll
        for (int ai = 0; ai < 2; ++ai)
#pragma unroll
            for (int m = 0; m < 4; ++m) { const int row = row0 + ai * HALF + m * 16; bf16_t* rowp = base + (size_t)row * ldc + col0;
#pragma unroll
                for (int bj = 0; bj < 2; ++bj) { const f32x4 v0 = acc[ai][bj][m][0] * us, v1 = acc[ai][bj][m][1] * us;
                    u32x4 w; w.x = cvt_pk_bf16(v0[0], v0[1]); w.y = cvt_pk_bf16(v0[2], v0[3]); w.z = cvt_pk_bf16(v1[0], v1[1]); w.w = cvt_pk_bf16(v1[2], v1[3]);
                    *(u32x4*)(rowp + bj * 8) = w; }
                if (gt) { *(f32x4*)(gates + (size_t)row * 8) = acc[ai][0][m][0] * us; *(f32x4*)(gates + (size_t)row * 8 + 4) = acc[ai][0][m][1] * us; } }
    }
};
struct EpiQmla {
    static constexpr int VM_MIN = 16;
    static constexpr bool PERM = true;
    bf16_t* O; const float* cs;
    float scale;
    DI void operator()(const Acc& acc, const Unit& u, const Ctx& c) const {
        int row0 = u.pm * BM + c.wr * 64 + c.fr, col0 = u.pn * BM + c.wc * 32 + 8 * c.fq; asm volatile("" : "+v"(row0), "+v"(col0));
        bool rot[2]; int p0[2];
#pragma unroll
        for (int bj = 0; bj < 2; ++bj) { const int cc = (col0 + bj * HALF) % AQK; rot[bj] = cc >= ANOPE; p0[bj] = rot[bj] ? (cc - ANOPE) >> 1 : 0; }
#pragma unroll
        for (int ai = 0; ai < 2; ++ai) {
            f32x4 t0[4][2], t1[4][2];
#pragma unroll
            for (int m = 0; m < 4; ++m)
#pragma unroll
                for (int bj = 0; bj < 2; ++bj) { const float* cp = cs + (size_t)(row0 + ai * HALF + m * 16) * 32 + p0[bj] * 2; t0[m][bj] = *(const f32x4*)cp; t1[m][bj] = *(const f32x4*)(cp + 4); }
#pragma unroll
            for (int m = 0; m < 4; ++m) { const int row = row0 + ai * HALF + m * 16; bf16_t* rowp = O + (size_t)row * (AH * AQK) + col0;
#pragma unroll
                for (int bj = 0; bj < 2; ++bj) { f32x4 v0 = acc[ai][bj][m][0] * scale, v1 = acc[ai][bj][m][1] * scale;
                    const f32x4 a0 = t0[m][bj], a1 = t1[m][bj];
                    f32x4 r0, r1;
                    r0[0] = v0[0] * a0[0] - v0[1] * a0[1]; r0[1] = v0[1] * a0[0] + v0[0] * a0[1];
                    r0[2] = v0[2] * a0[2] - v0[3] * a0[3]; r0[3] = v0[3] * a0[2] + v0[2] * a0[3];
                    r1[0] = v1[0] * a1[0] - v1[1] * a1[1]; r1[1] = v1[1] * a1[0] + v1[0] * a1[1];
                    r1[2] = v1[2] * a1[2] - v1[3] * a1[3]; r1[3] = v1[3] * a1[2] + v1[2] * a1[3];
                    if (rot[bj]) { v0 = r0; v1 = r1; }
                    u32x4 w; w.x = cvt_pk_bf16(v0[0], v0[1]); w.y = cvt_pk_bf16(v0[2], v0[3]); w.z = cvt_pk_bf16(v1[0], v1[1]); w.w = cvt_pk_bf16(v1[2], v1[3]);
                    *(u32x4*)(rowp + bj * HALF) = w; } }
            __builtin_amdgcn_sched_barrier(0); }
    }
};
struct EpiGate {
    static constexpr int VM_MIN = 32;
    static constexpr bool PERM = true, WIDE16 = true;
    bf16_t* O; const bf16_t* proj; int gcol0, gcol1; float us;
    DI void operator()(const Acc& acc, const Unit& u, const Ctx& c) const {
        int row0 = u.pm * BM + c.wr * 64 + c.fr, col0 = u.pn * BM + c.wc * 64 + 16 * c.fq; asm volatile("" : "+v"(row0), "+v"(col0));
        const bool ADD = (u.aux != 0); const int gcol = ADD ? gcol1 : gcol0;
#pragma unroll
        for (int ai = 0; ai < 2; ++ai) {
            u32x4 gg[4][2], pp[4][2];
#pragma unroll
            for (int m = 0; m < 4; ++m)
#pragma unroll
                for (int bj = 0; bj < 2; ++bj) { const int row = row0 + ai * HALF + m * 16; gg[m][bj] = *(const u32x4*)(proj + (size_t)row * NPROJ + gcol + col0 + bj * 8);
                    pp[m][bj] = (u32x4){0u, 0u, 0u, 0u}; if (ADD) pp[m][bj] = *(const u32x4*)(O + (size_t)row * D + col0 + bj * 8); }
#pragma unroll
            for (int m = 0; m < 4; ++m) { const int row = row0 + ai * HALF + m * 16; bf16_t* rowp = O + (size_t)row * D + col0;
#pragma unroll
                for (int bj = 0; bj < 2; ++bj) { const f32x4 v0 = acc[ai][bj][m][0] * us, v1 = acc[ai][bj][m][1] * us;
                    const u32x4 g = gg[m][bj], p = pp[m][bj];
                    float o[8];
                    o[0] = sigmoidf_(bflo(g.x)) * v0[0] + bflo(p.x); o[1] = sigmoidf_(bfhi(g.x)) * v0[1] + bfhi(p.x); o[2] = sigmoidf_(bflo(g.y)) * v0[2] + bflo(p.y); o[3] = sigmoidf_(bfhi(g.y)) * v0[3] + bfhi(p.y);
                    o[4] = sigmoidf_(bflo(g.z)) * v1[0] + bflo(p.z); o[5] = sigmoidf_(bfhi(g.z)) * v1[1] + bfhi(p.z); o[6] = sigmoidf_(bflo(g.w)) * v1[2] + bflo(p.w); o[7] = sigmoidf_(bfhi(g.w)) * v1[3] + bfhi(p.w);
                    u32x4 w; w.x = cvt_pk_bf16(o[0], o[1]); w.y = cvt_pk_bf16(o[2], o[3]); w.z = cvt_pk_bf16(o[4], o[5]); w.w = cvt_pk_bf16(o[6], o[7]);
                    *(u32x4*)(rowp + bj * 8) = w; } }
            __builtin_amdgcn_sched_barrier(0); }
    }
};
struct EpiF32 {
    static constexpr bool PERM = false;
    float* C; int ldc; int ncols_valid;
    DI void operator()(const Acc& acc, const Unit& u, const Ctx& c) const {
        int row0 = u.pm * BM + c.wr * 64 + c.fr, col0 = u.pn * BM + c.wc * 32 + 4 * c.fq; asm volatile("" : "+v"(row0), "+v"(col0));
#pragma unroll
        for (int ai = 0; ai < 2; ++ai)
#pragma unroll
            for (int m = 0; m < 4; ++m) { float* rowp = C + (size_t)(row0 + ai * HALF + m * 16) * ldc + col0;
#pragma unroll
                for (int bj = 0; bj < 2; ++bj)
#pragma unroll
                    for (int n = 0; n < 2; ++n) if (col0 + bj * HALF + n * 16 < ncols_valid) *(f32x4*)(rowp + bj * HALF + n * 16) = acc[ai][bj][m][n]; }
    }
};

DI void stats_finish(float s1, float s2, float& mean, float& rstd) { mean = s1 * (1.0f / D); const float var = fmaxf(s2 * (1.0f / D) - mean * mean, 0.f); rstd = __builtin_amdgcn_rsqf(var + EPS); }
DI void unit_row_stats(const float* part, int pm, LAS f32x2* tab, const Ctx& c) {
    int t = c.wid * 64 + c.lane; asm volatile("" : "+v"(t));
    const int row = t >> 1, half = t & 1;
    const f32x4* p = (const f32x4*)(part + ((size_t)(pm * BM + row) * 16 + half * 8) * 2);
    const f32x4 a = p[0], b = p[1], cc = p[2], d = p[3];
    float s1 = ((a[0] + a[2]) + (b[0] + b[2])) + ((cc[0] + cc[2]) + (d[0] + d[2])), s2 = ((a[1] + a[3]) + (b[1] + b[3])) + ((cc[1] + cc[3]) + (d[1] + d[3]));
    s1 += swz_xor1(s1); s2 += swz_xor1(s2);
    float mean, rstd; stats_finish(s1, s2, mean, rstd);
    if (half == 0) tab[row] = (f32x2){mean, rstd};
    asm volatile("s_waitcnt lgkmcnt(0)" ::: "memory"); __builtin_amdgcn_s_barrier(); asm volatile("" ::: "memory");
}
DI void wave_row_stats(const float* part, int row, int lane, float& mean, float& rstd) {
    f32x2 p = {0.f, 0.f}; if (lane < 16) p = *(const f32x2*)(part + ((size_t)row * 16 + lane) * 2);
    float s1 = p[0], s2 = p[1];
#pragma unroll
    for (int o = 1; o < 16; o <<= 1) { s1 += __shfl_xor(s1, o); s2 += __shfl_xor(s2, o); }
    s1 = __shfl(s1, 0); s2 = __shfl(s2, 0);
    stats_finish(s1, s2, mean, rstd);
}
template <bool NORM> struct EpiResStats {
    static constexpr int VM_MIN = 40;
    static constexpr bool PERM = true;
    const bf16_t* res; const float* pstats; const float* pg; const float* pb; bf16_t* VB; float* stats; LAS f32x2* tab; unsigned char* V8; float us;
    DI void operator()(const Acc& acc, const Unit& u, const Ctx& c) const {
        int row0 = u.pm * BM + c.wr * 64 + c.fr, col0 = u.pn * BM + c.wc * 32 + 8 * c.fq; asm volatile("" : "+v"(row0), "+v"(col0));
        if (NORM) unit_row_stats(pstats, u.pm, tab, c);
        int trow = c.wr * 64 + c.fr; asm volatile("" : "+v"(trow));
        constexpr int RB = NORM ? 2 : 4;
#pragma unroll
        for (int rb = 0; rb < 8 / RB; ++rb) {
            int cz = col0; asm volatile("" : "+v"(cz));
            u32x4 rr[RB][2];
#pragma unroll
            for (int q = 0; q < RB; ++q)
#pragma unroll
                for (int bj = 0; bj < 2; ++bj) { const int ai = (rb * RB + q) >> 2, m = (rb * RB + q) & 3; rr[q][bj] = *(const u32x4*)(res + (size_t)(row0 + ai * HALF + m * 16) * D + col0 + bj * HALF); }
#pragma unroll
            for (int q = 0; q < RB; ++q) { const int ai = (rb * RB + q) >> 2, m = (rb * RB + q) & 3; const int row = row0 + ai * HALF + m * 16; const size_t ro = (size_t)row * D + col0;
                float mean = 0.f, rstd = 1.f; if (NORM) { const f32x2 st = tab[trow + ai * HALF + m * 16]; mean = st[0]; rstd = st[1]; }
                float s1 = 0.f, s2 = 0.f;
#pragma unroll
                for (int bj = 0; bj < 2; ++bj) { const u32x4 w = rr[q][bj];
                    f32x4 r0 = {bflo(w.x), bfhi(w.x), bflo(w.y), bfhi(w.y)}, r1 = {bflo(w.z), bfhi(w.z), bflo(w.w), bfhi(w.w)};
                    if (NORM) { const f32x4 g0 = *(const f32x4*)(pg + cz + bj * HALF), g1 = *(const f32x4*)(pg + cz + bj * HALF + 4), b0 = *(const f32x4*)(pb + cz + bj * HALF), b1 = *(const f32x4*)(pb + cz + bj * HALF + 4);
                        r0 = (r0 - mean) * rstd * g0 + b0; r1 = (r1 - mean) * rstd * g1 + b1; }
                    const f32x4 v0 = r0 * DN_ALPHA + acc[ai][bj][m][0] * us, v1 = r1 * DN_ALPHA + acc[ai][bj][m][1] * us;
                    u32x4 o; o.x = cvt_pk_bf16(v0[0], v0[1]); o.y = cvt_pk_bf16(v0[2], v0[3]); o.z = cvt_pk_bf16(v1[0], v1[1]); o.w = cvt_pk_bf16(v1[2], v1[3]);
                    *(u32x4*)(VB + ro + bj * HALF) = o;
                    if (V8) { u32x2 q8; q8.x = pk4_fp8(v0[0] * F8_XS, v0[1] * F8_XS, v0[2] * F8_XS, v0[3] * F8_XS); q8.y = pk4_fp8(v1[0] * F8_XS, v1[1] * F8_XS, v1[2] * F8_XS, v1[3] * F8_XS); *(u32x2*)(V8 + ro + bj * HALF) = q8; }
                    s1 += (v0[0] + v0[1]) + (v0[2] + v0[3]) + (v1[0] + v1[1]) + (v1[2] + v1[3]);
                    s2 += (v0[0] * v0[0] + v0[1] * v0[1]) + (v0[2] * v0[2] + v0[3] * v0[3]) + (v1[0] * v1[0] + v1[1] * v1[1]) + (v1[2] * v1[2] + v1[3] * v1[3]); }
                s1 += swz_xor16(s1); s1 = sum_xor32(s1); s2 += swz_xor16(s2); s2 = sum_xor32(s2);
                if (c.fq == 0) *(f32x2*)(stats + ((size_t)row * 16 + u.pn * 4 + c.wc) * 2) = (f32x2){s1, s2}; }
            __builtin_amdgcn_sched_barrier(0); }
    }
};
struct EpiLNApplyBf16 {
    static constexpr int VM_MIN = 24;
    static constexpr bool PERM = true;
    bf16_t* O; int ldc; const float* stats; const float* cs; const float* cb; float scale; LAS f32x2* tab; float us;
    DI void operator()(const Acc& acc, const Unit& u, const Ctx& c) const {
        int row0 = u.pm * BM + c.wr * 64 + c.fr, col0 = u.pn * BM + c.wc * 32 + 8 * c.fq; asm volatile("" : "+v"(row0), "+v"(col0));
        unit_row_stats(stats, u.pm, tab, c);
        int trow = c.wr * 64 + c.fr; asm volatile("" : "+v"(trow));
#pragma unroll
        for (int bj = 0; bj < 2; ++bj) {
            const f32x4 cs0 = *(const f32x4*)(cs + col0 + bj * HALF), cs1 = *(const f32x4*)(cs + col0 + bj * HALF + 4), cb0 = *(const f32x4*)(cb + col0 + bj * HALF), cb1 = *(const f32x4*)(cb + col0 + bj * HALF + 4);
#pragma unroll
            for (int ai = 0; ai < 2; ++ai)
#pragma unroll
                for (int m = 0; m < 4; ++m) { const int row = row0 + ai * HALF + m * 16; const f32x2 st = tab[trow + ai * HALF + m * 16]; const float mean = st[0], rstd = st[1];
                    const f32x4 v0 = ((acc[ai][bj][m][0] * us - cs0 * mean) * rstd + cb0) * scale, v1 = ((acc[ai][bj][m][1] * us - cs1 * mean) * rstd + cb1) * scale;
                    if (XS_FP8) { u32x2 q; q.x = pk4_fp8(v0[0] * F8_WS, v0[1] * F8_WS, v0[2] * F8_WS, v0[3] * F8_WS); q.y = pk4_fp8(v1[0] * F8_WS, v1[1] * F8_WS, v1[2] * F8_WS, v1[3] * F8_WS); *(u32x2*)((unsigned char*)O + (size_t)row * ldc + col0 + bj * HALF) = q; }
                    else { u32x4 w; w.x = cvt_pk_bf16(v0[0], v0[1]); w.y = cvt_pk_bf16(v0[2], v0[3]); w.z = cvt_pk_bf16(v1[0], v1[1]); w.w = cvt_pk_bf16(v1[2], v1[3]);
                    *(u32x4*)(O + (size_t)row * ldc + col0 + bj * HALF) = w; } }
            __builtin_amdgcn_sched_barrier(0); }
    }
};
struct EpiLNApplyF32 {
    static constexpr bool PERM = false;
    float* C; int ldc; int ncols_valid; const float* stats; const float* cs; const float* cb; LAS f32x2* tab;
    DI void operator()(const Acc& acc, const Unit& u, const Ctx& c) const {
        int row0 = u.pm * BM + c.wr * 64 + c.fr, col0 = u.pn * BM + c.wc * 32 + 4 * c.fq; asm volatile("" : "+v"(row0), "+v"(col0));
        unit_row_stats(stats, u.pm, tab, c);
        int trow = c.wr * 64 + c.fr; asm volatile("" : "+v"(trow));
#pragma unroll
        for (int ai = 0; ai < 2; ++ai)
#pragma unroll
            for (int m = 0; m < 4; ++m) { const int row = row0 + ai * HALF + m * 16; const f32x2 st = tab[trow + ai * HALF + m * 16]; const float mean = st[0], rstd = st[1];
                float* rowp = C + (size_t)row * ldc + col0;
#pragma unroll
                for (int bj = 0; bj < 2; ++bj)
#pragma unroll
                    for (int n = 0; n < 2; ++n) if (col0 + bj * HALF + n * 16 < ncols_valid) { const f32x4 csv = *(const f32x4*)(cs + col0 + bj * HALF + n * 16), cbv = *(const f32x4*)(cb + col0 + bj * HALF + n * 16);
                        *(f32x4*)(rowp + bj * HALF + n * 16) = (acc[ai][bj][m][n] - csv * mean) * rstd + cbv; } }
    }
};
struct EpiSoftmax {
    static constexpr int VM_MIN = 16;
    static constexpr bool PERM = true;
    bf16_t* O; LAS float* red; float us;
    DI void operator()(Acc& acc, const Unit& u, const Ctx& c) const {
        int row0 = u.pm * BM + c.wr * 64 + c.fr, col0 = u.pn * BM + c.wc * 32 + 8 * c.fq; asm volatile("" : "+v"(row0), "+v"(col0));
        int rbase = (c.wr * 64 + c.fr) * 4; asm volatile("" : "+v"(rbase));
        LAS float* r1 = red + rbase; LAS float* r2 = red + 1024 + rbase;
#pragma unroll
        for (int ai = 0; ai < 2; ++ai)
#pragma unroll
            for (int m = 0; m < 4; ++m) { float v = -INFINITY;
#pragma unroll
                for (int bj = 0; bj < 2; ++bj)
#pragma unroll
                    for (int n = 0; n < 2; ++n) { const f32x4 x = acc[ai][bj][m][n]; v = fmaxf(v, fmaxf(fmaxf(x[0], x[1]), fmaxf(x[2], x[3]))); }
                v = fmaxf(v, swz_xor16(v)); v = max_xor32(v);
                if (c.fq == 0) r1[(ai * HALF + m * 16) * 4 + c.wc] = v;
                __builtin_amdgcn_sched_barrier(0); }
        asm volatile("s_waitcnt lgkmcnt(0)" ::: "memory"); __builtin_amdgcn_s_barrier(); asm volatile("" ::: "memory");
#pragma unroll
        for (int ai = 0; ai < 2; ++ai)
#pragma unroll
            for (int m = 0; m < 4; ++m) { const f32x4 q = *(const LAS f32x4*)(r1 + (ai * HALF + m * 16) * 4);
                const float mm = fmaxf(fmaxf(q[0], q[1]), fmaxf(q[2], q[3])); float s = 0.f;
#pragma unroll
                for (int bj = 0; bj < 2; ++bj)
#pragma unroll
                    for (int n = 0; n < 2; ++n) { f32x4 x = acc[ai][bj][m][n];
                        x[0] = __builtin_amdgcn_exp2f((x[0] - mm) * us); x[1] = __builtin_amdgcn_exp2f((x[1] - mm) * us); x[2] = __builtin_amdgcn_exp2f((x[2] - mm) * us); x[3] = __builtin_amdgcn_exp2f((x[3] - mm) * us);
                        acc[ai][bj][m][n] = x; s += (x[0] + x[1]) + (x[2] + x[3]); }
                s += swz_xor16(s); s = sum_xor32(s);
                if (c.fq == 0) r2[(ai * HALF + m * 16) * 4 + c.wc] = s;
                __builtin_amdgcn_sched_barrier(0); }
        asm volatile("s_waitcnt lgkmcnt(0)" ::: "memory"); __builtin_amdgcn_s_barrier(); asm volatile("" ::: "memory");
#pragma unroll
        for (int ai = 0; ai < 2; ++ai)
#pragma unroll
            for (int m = 0; m < 4; ++m) { const f32x4 q = *(const LAS f32x4*)(r2 + (ai * HALF + m * 16) * 4);
                const float inv = rcpf_((q[0] + q[1]) + (q[2] + q[3]));
                bf16_t* rowp = O + (size_t)(row0 + ai * HALF + m * 16) * D + col0;
#pragma unroll
                for (int bj = 0; bj < 2; ++bj) { const f32x4 v0 = acc[ai][bj][m][0] * inv, v1 = acc[ai][bj][m][1] * inv;
                    if (XA_FP8) { u32x2 q; q.x = pk4_fp8(v0[0] * F8_OS, v0[1] * F8_OS, v0[2] * F8_OS, v0[3] * F8_OS); q.y = pk4_fp8(v1[0] * F8_OS, v1[1] * F8_OS, v1[2] * F8_OS, v1[3] * F8_OS);
                        *(u32x2*)((unsigned char*)O + (size_t)(row0 + ai * HALF + m * 16) * D + col0 + bj * HALF) = q; }
                    else { u32x4 w; w.x = cvt_pk_bf16(v0[0], v0[1]); w.y = cvt_pk_bf16(v0[2], v0[3]); w.z = cvt_pk_bf16(v1[0], v1[1]); w.w = cvt_pk_bf16(v1[2], v1[3]);
                    *(u32x4*)(rowp + bj * HALF) = w; } }
                __builtin_amdgcn_sched_barrier(0); }
    }
};
struct EpiSwiglu {
    static constexpr int VM_MIN = 12;
    static constexpr bool PERM = true, WIDE16 = true, GLU = true;
    unsigned char* O; const float* bias;
    DI void operator()(const Acc& acc, const Unit& u, const Ctx& c) const {
        int row0 = u.pm * BM + c.wr * 64 + c.fr, out0 = u.pn * HALF + c.wc * 32 + 8 * c.fq; asm volatile("" : "+v"(row0), "+v"(out0));
        constexpr float us = 1.0f / (F8_XS * F8_WS);
        f32x4 bgf[2], blf[2];
#pragma unroll
        for (int bj = 0; bj < 2; ++bj) { const f32x4 b0 = *(const f32x4*)(bias + (size_t)u.aux * 2048 + 2 * (out0 + 4 * bj)), b1 = *(const f32x4*)(bias + (size_t)u.aux * 2048 + 2 * (out0 + 4 * bj) + 4);
            bgf[bj] = (f32x4){b0[0], b0[2], b1[0], b1[2]}; blf[bj] = (f32x4){b0[1], b0[3], b1[1], b1[3]}; }
#pragma unroll
        for (int ai = 0; ai < 2; ++ai)
#pragma unroll
            for (int m = 0; m < 4; ++m) { unsigned char* rowp = O + (size_t)(row0 + ai * HALF + m * 16) * 1024 + out0;
                u32x2 w;
#pragma unroll
                for (int bj = 0; bj < 2; ++bj) { const f32x4 bgv = bgf[bj], blv = blf[bj];
                    f32x4 g = acc[ai][bj][m][0] * us + bgv, l = acc[ai][bj][m][1] * us + blv;
                    g = __builtin_elementwise_min(g, (f32x4){7.f, 7.f, 7.f, 7.f}); l = __builtin_elementwise_min(__builtin_elementwise_max(l, (f32x4){-7.f, -7.f, -7.f, -7.f}), (f32x4){7.f, 7.f, 7.f, 7.f});
                    const f32x4 t = g * (-1.702f * 1.4426950408889634f);
                    f32x4 e; e[0] = __builtin_amdgcn_exp2f(t[0]); e[1] = __builtin_amdgcn_exp2f(t[1]); e[2] = __builtin_amdgcn_exp2f(t[2]); e[3] = __builtin_amdgcn_exp2f(t[3]);
                    const f32x4 d = e + 1.0f;
                    f32x4 r; r[0] = __builtin_amdgcn_rcpf(d[0]); r[1] = __builtin_amdgcn_rcpf(d[1]); r[2] = __builtin_amdgcn_rcpf(d[2]); r[3] = __builtin_amdgcn_rcpf(d[3]);
                    const f32x4 o = (g * r) * ((l + 1.0f) * F8_AS);
                    w[bj] = pk4_fp8_nc(o[0], o[1], o[2], o[3]); }
                *(u32x2*)rowp = w; __builtin_amdgcn_sched_barrier(0); }
    }
};
struct EpiDown {
    static constexpr int VM_MIN = 20;
    static constexpr bool PERM = true, WIDE16 = true;
    unsigned char* O; const float* bias; const float* rowgate;
    DI void operator()(const Acc& acc, const Unit& u, const Ctx& c) const {
        int row0 = u.pm * BM + c.wr * 64 + c.fr, col0 = u.pn * BM + c.wc * 64 + 16 * c.fq; asm volatile("" : "+v"(row0), "+v"(col0));
        const float* rg = rowgate + u.gr + c.wr * 64 + c.fr;
        f32x4 bv[2][2];
#pragma unroll
        for (int bj = 0; bj < 2; ++bj)
#pragma unroll
            for (int n = 0; n < 2; ++n) bv[bj][n] = *(const f32x4*)(bias + (size_t)u.aux * 1024 + col0 + 8 * bj + 4 * n);
#pragma unroll
        for (int ai = 0; ai < 2; ++ai) { float gts[4];
#pragma unroll
            for (int m = 0; m < 4; ++m) gts[m] = rg[ai * HALF + m * 16] * F8_YS;
#pragma unroll
            for (int m = 0; m < 4; ++m) { const int row = row0 + ai * HALF + m * 16; const float gt = gts[m]; unsigned char* rowp = O + (size_t)row * 1024 + col0;
                u32x4 w;
#pragma unroll
                for (int bj = 0; bj < 2; ++bj) { const f32x4 v0 = (acc[ai][bj][m][0] * (1.0f / (F8_AS * F8_WS)) + bv[bj][0]) * gt, v1 = (acc[ai][bj][m][1] * (1.0f / (F8_AS * F8_WS)) + bv[bj][1]) * gt;
                    w[2 * bj] = pk4_fp8(v0[0], v0[1], v0[2], v0[3]); w[2 * bj + 1] = pk4_fp8(v1[0], v1[1], v1[2], v1[3]); }
                *(u32x4*)rowp = w; } }
    }
};
}
constexpr size_t MiB = 1u << 20;
constexpr size_t WS_CTL = 0, CTL_ZERO_BYTES = 44 * 1024;
constexpr int P1_NBF = 1536;
constexpr size_t WS_W_IN8 = 6 * MiB;
constexpr size_t WS_W_IN = 2 * MiB, WS_W_UQ = 10 * MiB, WS_W_UK = WS_W_UQ + 512 * 1024, WS_W_UV = WS_W_UK + 256 * 1024, WS_W_MQK = 11 * MiB, WS_W_BRM = 12 * MiB, WS_W_BRA = 13 * MiB,
                 WS_W_MIX = 14 * MiB, WS_W_CQ = 16 * MiB, WS_W_CK = 18 * MiB, WS_W_CV = 20 * MiB, WS_W_CO = 22 * MiB, WS_W_R = 24 * MiB, WS_W_GU = 26 * MiB, WS_W_DN = 90 * MiB;
constexpr size_t WS_GATES = 218 * MiB, WS_CS = 219 * MiB, WS_KPE = 223 * MiB, WS_MEMB = 225 * MiB, WS_KC = 233 * MiB, WS_VCT = 241 * MiB, WS_LOGITS = 249 * MiB,
                 WS_ASSIGN = 253 * MiB, WS_GATEW = WS_ASSIGN + 512 * 1024, WS_TOKPOS = 254 * MiB;
constexpr size_t WS_XB = 256 * MiB, WS_PROJ = 320 * MiB, WS_QN = 576 * MiB, WS_KVN = 592 * MiB, WS_XC = 608 * MiB, WS_QMLA = 640 * MiB, WS_KN = 688 * MiB, WS_VT = 720 * MiB,
                 WS_QKM = 752 * MiB, WS_KTM = 816 * MiB, WS_AO = 848 * MiB, WS_HRAW = 880 * MiB, WS_HM = 944 * MiB;
constexpr size_t WS_X8 = 576 * MiB  , WS_GATED = 576 * MiB, WS_V1B8 = 640 * MiB  , WS_V1B = 704 * MiB, WS_QC = 384 * MiB, WS_PC = 448 * MiB, WS_OC = 320 * MiB, WS_V2B = 864 * MiB;
constexpr size_t WS_ROWTOK = 400 * MiB, WS_ROWGATE = 404 * MiB;
constexpr size_t WS_XG = 320 * MiB, WS_ACT = 456 * MiB, WS_YB = 592 * MiB, WS_END = 985 * MiB;
static_assert((size_t)NROWS * 1024 * 2 <= 272 * MiB, "routed buffers");
static_assert(WS_TOKPOS + (size_t)T * 4 * 4 <= 256 * MiB, "small buffers");
constexpr int CW_TMO = 0, CW_CNT = 64  , CNT_STRIDE = 1, CW_BAR = 4096;
static_assert(CW_CNT + NE * CNT_STRIDE <= CW_BAR, "control words");
constexpr size_t CTL_CS1 = 32 * 1024, CTL_CB1 = 36 * 1024, CTL_CSR = 40 * 1024, CTL_CBR = 41 * 1024;
constexpr size_t WS_STATS1 = 976 * MiB, WS_STATS2 = 980 * MiB;
constexpr size_t WS_CSP = 984 * MiB;

constexpr int RING_OFF = 0, RING_BYTES = 131072;
constexpr int RED_OFF = RING_BYTES;
constexpr int TST_OFF = RED_OFF + 8192;
constexpr int HIST_OFF = TST_OFF + 256, HBASE_OFF = HIST_OFF + 128;
constexpr int MISC_OFF = HBASE_OFF + 128;
constexpr int TILE_E_OFF = MISC_OFF + 128;
constexpr int LDSCTL_OFF = TST_OFF;
constexpr int GB_OFF = ((TILE_E_OFF + NTILES_MAX * 4 + 15) / 16) * 16;
constexpr int LDS_BYTES = 155648;
static_assert(GB_OFF + 8192 <= LDS_BYTES && GB_OFF + 26 * 512 <= LDS_BYTES, "LDS map");
constexpr int NWAVES = 8;

#define LDS_WAIT() asm volatile("s_waitcnt lgkmcnt(0)" ::: "memory")
#define VM_WAIT() asm volatile("s_waitcnt vmcnt(0)" ::: "memory")

#define XB_TMO      128
#define XB_XCNT(j)  (256  + 64 * (j))
#define XB_XSUB(j)  (1280 + 64 * (j))
#define XB_XGEN(j)  (2304 + 64 * (j))
#define XB_TOP      3328
#define XB_TOPGEN   3392
#define XCD_BAR_WORDS 3456
#define XB_SPIN_CAP (1u << 18)
__device__ __forceinline__ unsigned xb_ld(unsigned* p)              { return __hip_atomic_load(p, __ATOMIC_RELAXED, __HIP_MEMORY_SCOPE_AGENT); }
__device__ __forceinline__ unsigned xb_add(unsigned* p, unsigned v) { return __hip_atomic_fetch_add(p, v, __ATOMIC_RELAXED, __HIP_MEMORY_SCOPE_AGENT); }
__device__ __forceinline__ unsigned xb_xcc_id() { return (unsigned)__builtin_amdgcn_s_getreg((3 << 11) | 20) & 0xFu; }
#define XB_SPIN(cond, bar) do { unsigned _sp = 0; while (cond) { __builtin_amdgcn_s_sleep(1); \
    if ((++_sp & 255u) == 0u) { if (xb_ld(&(bar)[XB_TMO])) break; if (_sp > XB_SPIN_CAP) { atomicAdd(&(bar)[XB_TMO], 1u); break; } } } } while (0)
struct XcdBarrier { unsigned* bar; unsigned x; volatile LAS unsigned* st; };
__device__ __forceinline__ XcdBarrier xcd_barrier_post(unsigned* bar, volatile LAS unsigned* st, int wv) {
    XcdBarrier b; b.bar = bar; b.x = xb_xcc_id(); b.st = st;
    if (wv == 0 && lane_id() == 0) (void)xb_add(&bar[XB_XCNT(b.x)], 1u);
    return b;
}
__device__ __forceinline__ void xcd_barrier_complete(unsigned* bar, unsigned x, unsigned& nloc, unsigned& nx) {
    const unsigned G = gridDim.x * gridDim.y * gridDim.z;
    unsigned sum, cnt, mine, sp = 0u;
    for (;;) {
        sum = 0u; cnt = 0u; mine = 0u;
#pragma unroll
        for (unsigned j = 0; j < 16; ++j) { const unsigned c = xb_ld(&bar[XB_XCNT(j)]); sum += c; cnt += (c > 0u) ? 1u : 0u; mine = (j == x) ? c : mine; }
        if (sum == G) break;
        __builtin_amdgcn_s_sleep(1);
        if ((++sp & 255u) == 0u) { if (xb_ld(&bar[XB_TMO])) break; if (sp > XB_SPIN_CAP) { atomicAdd(&bar[XB_TMO], 1u); break; } }
    }
    nloc = mine > 0u ? mine : 1u; nx = cnt > 0u ? cnt : 1u;
}
__device__ __forceinline__ void xcd_barrier(const XcdBarrier& b, int wv) {
    asm volatile("s_waitcnt vmcnt(0)" ::: "memory");
    __syncthreads();
    if (wv == 0 && lane_id() == 0) {
        unsigned* bar = b.bar;
        __builtin_amdgcn_s_waitcnt(0);
        unsigned nloc = b.st[0], nx = b.st[1];
        if (nloc == 0u) { xcd_barrier_complete(bar, b.x, nloc, nx); b.st[0] = nloc; b.st[1] = nx; }
        const unsigned old = xb_add(&bar[XB_XSUB(b.x)], 1u);
        const unsigned gen = old / nloc;
        if (old + 1u == (gen + 1u) * nloc) {
            __builtin_amdgcn_fence(__ATOMIC_RELEASE, "agent");
            asm volatile("s_waitcnt vmcnt(0)" ::: "memory");
            const unsigned og = xb_add(&bar[XB_TOP], 1u);
            const unsigned tg = og / nx;
            if (og + 1u == (tg + 1u) * nx) xb_add(&bar[XB_TOPGEN], 1u);
            else XB_SPIN(xb_ld(&bar[XB_TOPGEN]) == tg, bar);
            __builtin_amdgcn_fence(__ATOMIC_ACQUIRE, "agent");
            xb_add(&bar[XB_XGEN(b.x)], 1u);
            asm volatile("s_waitcnt vmcnt(0)" ::: "memory");
        } else {
            XB_SPIN(xb_ld(&bar[XB_XGEN(b.x)]) == gen, bar);
            __builtin_amdgcn_fence(__ATOMIC_ACQUIRE, "agent");
            asm volatile("s_waitcnt vmcnt(0)" ::: "memory");
        }
    }
    __syncthreads();
}

struct Args { const void* in[34]; float* out; unsigned char* ws; int ph_lo, ph_hi; };
typedef const __attribute__((address_space(4))) Args* CArgs;
DI CArgs launder_args(CArgs p) { asm volatile("" : "+s"(p)); return p; }

DI void tr_item(const float* W, int ldw, int kvalid, bf16_t* WT, int ldk, int n0, int k0, int sc, LAS float* scr, int lane, const float* rs = nullptr, int kshift = 0, float f8scale = 0.f) {
#pragma unroll 8
    for (int i = 0; i < 32; ++i) { const int kk = 2 * i + (lane >> 5); const int k = k0 + kk + kshift;
        float v = 0.f; if (sc >= 0 && k < kvalid) { v = W[(size_t)k * ldw + sc]; if (rs) v *= rs[k]; }
        scr[kk * 33 + (lane & 31)] = v; }
    LDS_WAIT(); asm volatile("" ::: "memory");
    const int c = lane & 7;
    if (f8scale != 0.f) {
#pragma unroll
        for (int j = 0; j < 4; ++j) { const int n = (lane >> 3) + 8 * j; const LAS float* s = scr + (8 * c) * 33 + n;
            u32x2 o; o.x = pg8::pk4_fp8(s[0 * 33] * f8scale, s[1 * 33] * f8scale, s[2 * 33] * f8scale, s[3 * 33] * f8scale); o.y = pg8::pk4_fp8(s[4 * 33] * f8scale, s[5 * 33] * f8scale, s[6 * 33] * f8scale, s[7 * 33] * f8scale);
            *(GAS u32x2*)((unsigned char*)WT + (size_t)(n0 + n) * ldk + k0 + 8 * c) = o; }
    } else {
#pragma unroll
        for (int j = 0; j < 4; ++j) { const int n = (lane >> 3) + 8 * j; const LAS float* s = scr + (8 * c) * 33 + n;
            u32x4 o; o.x = pk2(s[0 * 33], s[1 * 33]); o.y = pk2(s[2 * 33], s[3 * 33]); o.z = pk2(s[4 * 33], s[5 * 33]); o.w = pk2(s[6 * 33], s[7 * 33]);
            *(GAS u32x4*)(WT + (size_t)(n0 + n) * ldk + k0 + 8 * c) = o; }
    }
    LDS_WAIT(); asm volatile("" ::: "memory");
}

DI void tr_item_v4(const float* W, int ldw, bf16_t* WT, int ldk, int n0, int k0, int c0, LAS float* scr, int lane, const float* rs = nullptr, int kvalid = 1 << 30, int kshift = 0) {
    const int kr = lane >> 3, n4 = lane & 7;
    f32x4 v[8];
#pragma unroll
    for (int i = 0; i < 8; ++i) v[i] = (f32x4){0.f, 0.f, 0.f, 0.f};
    if (c0 >= 0 && k0 + kshift + 63 < kvalid) {
#pragma unroll
        for (int i = 0; i < 8; ++i) v[i] = *(const f32x4*)(W + (size_t)(k0 + i * 8 + kr + kshift) * ldw + c0 + 4 * n4); }
    if (rs) {
#pragma unroll
        for (int i = 0; i < 8; ++i) v[i] = v[i] * rs[k0 + i * 8 + kr]; }
#pragma unroll
    for (int i = 0; i < 8; ++i) { LAS float* p = scr + (i * 8 + kr) * 33 + 4 * n4; p[0] = v[i][0]; p[1] = v[i][1]; p[2] = v[i][2]; p[3] = v[i][3]; }
    LDS_WAIT(); asm volatile("" ::: "memory");
    const int c = lane & 7;
#pragma unroll
    for (int j = 0; j < 4; ++j) { const int n = (lane >> 3) + 8 * j; const LAS float* s = scr + (8 * c) * 33 + n;
        u32x4 o; o.x = pk2(s[0 * 33], s[1 * 33]); o.y = pk2(s[2 * 33], s[3 * 33]); o.z = pk2(s[4 * 33], s[5 * 33]); o.w = pk2(s[6 * 33], s[7 * 33]);
        *(GAS u32x4*)(WT + (size_t)(n0 + n) * ldk + k0 + 8 * c) = o; }
    LDS_WAIT(); asm volatile("" ::: "memory");
}

DI void tr_item_v4_fp8(const float* W, int ldw, unsigned char* WT, int ldk, int n0, int k0, int c0, float sc, LAS float* scr, int lane, const float* rs = nullptr) {
    const int kr = lane >> 3, n4 = lane & 7;
    f32x4 v[8];
#pragma unroll
    for (int i = 0; i < 8; ++i) v[i] = *(const f32x4*)(W + (size_t)(k0 + i * 8 + kr) * ldw + c0 + 4 * n4);
    if (rs) {
#pragma unroll
        for (int i = 0; i < 8; ++i) v[i] = v[i] * rs[k0 + i * 8 + kr]; }
#pragma unroll
    for (int i = 0; i < 8; ++i) { LAS float* p = scr + (i * 8 + kr) * 33 + 4 * n4; p[0] = v[i][0] * sc; p[1] = v[i][1] * sc; p[2] = v[i][2] * sc; p[3] = v[i][3] * sc; }
    LDS_WAIT(); asm volatile("" ::: "memory");
    const int c = lane & 7;
#pragma unroll
    for (int j = 0; j < 4; ++j) { const int n = (lane >> 3) + 8 * j; const LAS float* s = scr + (8 * c) * 33 + n;
        u32x2 o; o.x = pg8::pk4_fp8(s[0 * 33], s[1 * 33], s[2 * 33], s[3 * 33]); o.y = pg8::pk4_fp8(s[4 * 33], s[5 * 33], s[6 * 33], s[7 * 33]);
        *(GAS u32x2*)(WT + (size_t)(n0 + n) * ldk + k0 + 8 * c) = o; }
    LDS_WAIT(); asm volatile("" ::: "memory");
}

DI void tr_k128_load(f32x4 (&v)[16], const float* W, int ldw, int k0, int c0, int lane) {
    const int kr = lane >> 3, n4 = lane & 7;
#pragma unroll
    for (int i = 0; i < 16; ++i) v[i] = *(const f32x4*)(W + (size_t)(k0 + i * 8 + kr) * ldw + c0 + 4 * n4);
}
DI void tr_k128_finish(const f32x4 (&v)[16], unsigned char* WT, int ldk, int n0, int k0, float sc, LAS float* scr, int lane) {
    const int kr = lane >> 3, n4 = lane & 7;
#pragma unroll
    for (int i = 0; i < 16; ++i) { LAS float* p = scr + (i * 8 + kr) * 33 + 4 * n4; p[0] = v[i][0] * sc; p[1] = v[i][1] * sc; p[2] = v[i][2] * sc; p[3] = v[i][3] * sc; }
    LDS_WAIT(); asm volatile("" ::: "memory");
    const int c = lane & 7;
#pragma unroll
    for (int j = 0; j < 4; ++j) { const int n = (lane >> 3) + 8 * j; const LAS float* s = scr + (16 * c) * 33 + n;
        u32x4 o; o.x = pg8::pk4_fp8(s[0 * 33], s[1 * 33], s[2 * 33], s[3 * 33]); o.y = pg8::pk4_fp8(s[4 * 33], s[5 * 33], s[6 * 33], s[7 * 33]);
        o.z = pg8::pk4_fp8(s[8 * 33], s[9 * 33], s[10 * 33], s[11 * 33]); o.w = pg8::pk4_fp8(s[12 * 33], s[13 * 33], s[14 * 33], s[15 * 33]);
        *(GAS u32x4*)(WT + (size_t)(n0 + n) * ldk + k0 + 16 * c) = o; }
    LDS_WAIT(); asm volatile("" ::: "memory");
}
struct XwItem { const float* W; unsigned char* WT; int ldw, n0, k0; };
DI XwItem xw_item(int r, const float* wgu, const float* wdn, unsigned char* ws) {
    XwItem x; constexpr int I_GU = NE * 8 * 64;
    if (r < I_GU) { const int e = r / (8 * 64), q = r % (8 * 64), kb = q / 64, nb = q % 64; x.W = wgu + (size_t)e * 1024 * 2048; x.WT = ws + WS_W_GU + (size_t)e * 2048 * 1024; x.ldw = 2048; x.n0 = nb * 32; x.k0 = kb * 128; }
    else { r -= I_GU; const int e = r / (8 * 32), q = r % (8 * 32), kb = q / 32, nb = q % 32; x.W = wdn + (size_t)e * 1024 * 1024; x.WT = ws + WS_W_DN + (size_t)e * 1024 * 1024; x.ldw = 1024; x.n0 = nb * 32; x.k0 = kb * 128; }
    return x;
}
DI int win_src(int n) {
    if (n < 384) return n;
    if (n < 416) { const int i = (n - 384) >> 1; return 384 + i + 16 * ((n - 384) & 1); }
    if (n < 424) return 1952 + (n - 416);
    if (n < 512) return -1;
    if (n < 2048) return 416 + (n - 512);
    return 1960 + (n - 2048);
}
template <bool LATE>
DI void p0_prologue(CArgs args, LAS unsigned char* lds, int gw, int NGW, int wv, int xlo = 0, int xhi = NE * 8 * 96, bool small_items = true) {
    const int lane = lane_id(); const int wave = wv;
    LAS float* scr = (LAS float*)(lds + RING_OFF + wave * 16896);
    unsigned char* ws = args->ws;
    const int j = lane & 31;
    constexpr int I_IN = 16 * 128, I_UQ = 4 * 24, I_UK = 4 * 16, I_UV = 4 * 16, I_MQK = 4 * 32, I_BRM = 8 * 32, I_BRA = 8 * 32, I_SQ = 16 * 32, I_R = 16 * 8,
                  I_GU = NE * 8 * 64, I_DN = NE * 8 * 32;
    constexpr int NITEMS = LATE ? I_UQ + I_UK + I_UV + I_MQK + I_BRM + I_BRA + 3 * I_SQ + I_R : I_IN + 2 * I_SQ;
    if (LATE && small_items) for (int it = gw; it < 33 * 32; it += NGW) { const int grp = it >> 5, kc = it & 31; const bool rt = (grp == 32);
        const float* W = (const float*)args->in[rt ? 26 : 21]; const int ldw = rt ? NE : 1024; const int col = (rt ? 0 : grp * 32) + (lane & 31);
        const float* gv = (const float*)args->in[rt ? 24 : 19]; const float* bv = (const float*)args->in[rt ? 25 : 20];
        float as = 0.f, ab = 0.f;
#pragma unroll
        for (int i = 0; i < 16; ++i) { const int k = kc * 32 + 2 * i + (lane >> 5); const float w = W[(size_t)k * ldw + col]; const float gw_ = gv[k] * w;
            as += (rt || !CQ_FP8) ? bf2f((unsigned short)f2bf(gw_)) : __builtin_amdgcn_cvt_f32_fp8(__builtin_amdgcn_cvt_pk_fp8_f32(gw_ * pg8::F8_WS, 0.f, 0, false), 0) * (1.0f / pg8::F8_WS); ab += bv[k] * w; }
        as += __shfl_xor(as, 32); ab += __shfl_xor(ab, 32);
        if (lane < 32) { float* pp = (float*)(ws + WS_CSP); pp[((rt ? 2 : 0) * 32 + kc) * 1024 + col] = as; pp[((rt ? 3 : 1) * 32 + kc) * 1024 + col] = ab; } }
    if (LATE) {
        const float* wgu = (const float*)args->in[28]; const float* wdn = (const float*)args->in[30];
        f32x4 va[16], vb[16];
        int it = xlo + gw;
        if (it < xhi) { const XwItem x = xw_item(it, wgu, wdn, ws); tr_k128_load(va, x.W, x.ldw, x.k0, x.n0, lane); }
#pragma unroll 1
        for (; it < xhi; it += 2 * NGW) {
            const XwItem x0 = xw_item(it, wgu, wdn, ws);
            const bool h1 = it + NGW < xhi; const XwItem x1 = xw_item(h1 ? it + NGW : it, wgu, wdn, ws);
            if (h1) tr_k128_load(vb, x1.W, x1.ldw, x1.k0, x1.n0, lane);
            tr_k128_finish(va, x0.WT, 1024, x0.n0, x0.k0, pg8::F8_WS, scr, lane);
            const bool h2 = it + 2 * NGW < xhi; const XwItem x2 = xw_item(h2 ? it + 2 * NGW : it, wgu, wdn, ws);
            if (h2) tr_k128_load(va, x2.W, x2.ldw, x2.k0, x2.n0, lane);
            if (h1) tr_k128_finish(vb, x1.WT, 1024, x1.n0, x1.k0, pg8::F8_WS, scr, lane);
        }
    }
    if (!LATE || small_items) for (int it = gw; it < NITEMS; it += NGW) {
        int r = it;
        if (LATE) {
        } else {
        if (r < I_IN) { const int kb = r / 128, nb = r % 128;
            if (P1_FP8 && nb >= P1_NBF / 32) tr_item_v4_fp8((const float*)args->in[3], DIN, ws + WS_W_IN8, 1024, nb * 32 - P1_NBF, kb * 64, win_src(nb * 32), pg8::F8_WS, scr, lane);
            else if (nb < 12 || nb >= 16) tr_item_v4((const float*)args->in[3], DIN, (bf16_t*)(ws + WS_W_IN), 1024, nb * 32, kb * 64, win_src(nb * 32), scr, lane);
            else tr_item((const float*)args->in[3], DIN, 1024, (bf16_t*)(ws + WS_W_IN), 1024, nb * 32, kb * 64, win_src(nb * 32 + j), scr, lane); continue; } r -= I_IN;
        }
        if (LATE) {
        if (r < I_UQ) { const int kb = r / 24, nb = r % 24; const int n = nb * 32 + j, hh = n / AQK, cc = n % AQK;
            const int sc = (cc < ANOPE) ? n : hh * AQK + ANOPE + ((cc - ANOPE) >> 1) + 16 * ((cc - ANOPE) & 1);
            tr_item((const float*)args->in[14], AH * AQK, 256, (bf16_t*)(ws + WS_W_UQ), 256, nb * 32, kb * 64, sc, scr, lane); continue; } r -= I_UQ;
        if (r < I_UK) { const int kb = r / 16, nb = r % 16; const int n = nb * 32 + j;
            tr_item_v4((const float*)args->in[15], 1024, (bf16_t*)(ws + WS_W_UK), 256, nb * 32, kb * 64, ((nb * 32) >> 6) * 128 + ((nb * 32) & 63), scr, lane, nullptr, 128); (void)n; continue; } r -= I_UK;
        if (r < I_UV) { const int kb = r / 16, nb = r % 16; const int n = nb * 32 + j;
            tr_item_v4((const float*)args->in[15], 1024, (bf16_t*)(ws + WS_W_UV), 256, nb * 32, kb * 64, ((nb * 32) >> 6) * 128 + 64 + ((nb * 32) & 63), scr, lane, nullptr, 128); (void)n; continue; } r -= I_UV;
        if (r < I_MQK) { const int kb = r / 32, nb = r % 32; const int n = nb * 32 + j, part = n >> 9, hh = (n >> 7) & 3, e = n & 127;
            const float* src = (const float*)args->in[part ? 9 : 8];
            tr_item_v4(src, 128, (bf16_t*)(ws + WS_W_MQK), 256, nb * 32, kb * 64, ((kb >> 1) == (hh & 1)) ? (e & ~31) : -1, scr, lane, nullptr, 512, (hh >> 1) * 256); continue; } r -= I_MQK;
        if (r < I_BRM) { const int kb = r / 32, nb = r % 32;
            if (P6_FP8) tr_item_v4_fp8((const float*)args->in[16], 1024, ws + WS_W_BRM, 512, nb * 32, kb * 64, nb * 32, pg8::F8_WS, scr, lane); else tr_item_v4((const float*)args->in[16], 1024, (bf16_t*)(ws + WS_W_BRM), 512, nb * 32, kb * 64, nb * 32, scr, lane); continue; } r -= I_BRM;
        if (r < I_BRA) { const int kb = r / 32, nb = r % 32;
            if (P6_FP8) tr_item_v4_fp8((const float*)args->in[17], 1024, ws + WS_W_BRA, 512, nb * 32, kb * 64, nb * 32, pg8::F8_WS, scr, lane); else tr_item_v4((const float*)args->in[17], 1024, (bf16_t*)(ws + WS_W_BRA), 512, nb * 32, kb * 64, nb * 32, scr, lane); continue; } r -= I_BRA;
        }
        if (r < (LATE ? 3 : 2) * I_SQ) { const int w_ = r / I_SQ, w = LATE ? (w_ == 2 ? 4 : w_) : 2 + w_, q = r % I_SQ, kb = q / 32, nb = q % 32;
            const float* src; int ldw, coff; bf16_t* dst; const float* rs = nullptr;
            if (w == 0) { src = (const float*)args->in[18]; ldw = 1024; coff = 0; dst = (bf16_t*)(ws + WS_W_MIX); }
            else if (w == 1) { src = (const float*)args->in[21]; ldw = 1024; coff = 0; dst = (bf16_t*)(ws + WS_W_CQ); rs = (const float*)args->in[19]; }
            else if (w == 2) { src = (const float*)args->in[22]; ldw = 2048; coff = 0; dst = (bf16_t*)(ws + WS_W_CK); }
            else if (w == 3) { src = (const float*)args->in[22]; ldw = 2048; coff = 1024; dst = (bf16_t*)(ws + WS_W_CV); }
            else { src = (const float*)args->in[23]; ldw = 1024; coff = 0; dst = (bf16_t*)(ws + WS_W_CO); }
            if ((CQ_FP8 && w == 1) || (CO_FP8 && w == 4) || (P1_FP8 && (w == 2 || w == 3))) tr_item_v4_fp8(src, ldw, (unsigned char*)dst, 1024, nb * 32, kb * 64, coff + nb * 32, pg8::F8_WS, scr, lane, rs); else tr_item_v4(src, ldw, dst, 1024, nb * 32, kb * 64, coff + nb * 32, scr, lane, rs); continue; } r -= (LATE ? 3 : 2) * I_SQ;
        if (LATE) { const int kb = r / 8, nb = r % 8; const int n = nb * 32 + j;
            tr_item_v4((const float*)args->in[26], NE, (bf16_t*)(ws + WS_W_R), 1024, nb * 32, kb * 64, (nb == 0) ? 0 : -1, scr, lane, (const float*)args->in[24]); (void)n; }
    }
    if (LATE) return;
    const size_t gt = (size_t)gw * 64 + lane, NT_ = (size_t)NGW * 64;
    { const float* x = (const float*)args->in[0]; bf16_t* xb = (bf16_t*)(ws + WS_XB); unsigned char* x8 = ws + WS_X8;
      constexpr int UB = 4;
      for (size_t i0 = gt; i0 < (size_t)T * D / 8; i0 += UB * NT_) {
          f32x4 a[UB], b[UB];
#pragma unroll
          for (int u = 0; u < UB; ++u) { const size_t i = (i0 + u * NT_ < (size_t)T * D / 8) ? i0 + u * NT_ : i0; a[u] = *(const f32x4*)(x + i * 8); b[u] = *(const f32x4*)(x + i * 8 + 4); }
#pragma unroll
          for (int u = 0; u < UB; ++u) { const size_t i = i0 + u * NT_; if (i < (size_t)T * D / 8) {
              u32x4 o; o.x = pk2(a[u][0], a[u][1]); o.y = pk2(a[u][2], a[u][3]); o.z = pk2(b[u][0], b[u][1]); o.w = pk2(b[u][2], b[u][3]); *(u32x4*)(xb + i * 8) = o;
              if (P1_FP8) { u32x2 q; q.x = pg8::pk4_fp8(a[u][0] * pg8::F8_XS, a[u][1] * pg8::F8_XS, a[u][2] * pg8::F8_XS, a[u][3] * pg8::F8_XS); q.y = pg8::pk4_fp8(b[u][0] * pg8::F8_XS, b[u][1] * pg8::F8_XS, b[u][2] * pg8::F8_XS, b[u][3] * pg8::F8_XS); *(u32x2*)(x8 + i * 8) = q; } } } } }
    if (P1_FP8) { const float* x = (const float*)args->in[1]; unsigned char* x8 = ws + WS_MEMB;
      for (size_t i = gt; i < (size_t)NB * NMEM * D / 8; i += NT_) { const f32x4 a = *(const f32x4*)(x + i * 8), b = *(const f32x4*)(x + i * 8 + 4);
          u32x2 q; q.x = pg8::pk4_fp8(a[0] * pg8::F8_XS, a[1] * pg8::F8_XS, a[2] * pg8::F8_XS, a[3] * pg8::F8_XS); q.y = pg8::pk4_fp8(b[0] * pg8::F8_XS, b[1] * pg8::F8_XS, b[2] * pg8::F8_XS, b[3] * pg8::F8_XS); *(u32x2*)(x8 + i * 8) = q; } }
    else { const float* x = (const float*)args->in[1]; bf16_t* xb = (bf16_t*)(ws + WS_MEMB);
      for (size_t i = gt; i < (size_t)NB * NMEM * D / 8; i += NT_) { const f32x4 a = *(const f32x4*)(x + i * 8), b = *(const f32x4*)(x + i * 8 + 4);
          u32x4 o; o.x = pk2(a[0], a[1]); o.y = pk2(a[2], a[3]); o.z = pk2(b[0], b[1]); o.w = pk2(b[2], b[3]); *(u32x4*)(xb + i * 8) = o; } }
}

DI void p2_tokens(CArgs args, int vcu, int G, int wv) {
    const int lane = lane_id(); const int wave = wv;
    unsigned char* ws = args->ws;
    const bf16_t* proj = (const bf16_t*)(ws + WS_PROJ);
    bf16_t* qn = (bf16_t*)(ws + WS_QN); bf16_t* kvn = (bf16_t*)(ws + WS_KVN); bf16_t* kpe = (bf16_t*)(ws + WS_KPE); bf16_t* xc = (bf16_t*)(ws + WS_XC); float* cs = (float*)(ws + WS_CS);
    const int* positions = (const int*)args->in[2];
    const float* conv_w = (const float*)args->in[6]; const float* conv_b = (const float*)args->in[7];
    const float* g_qlat = (const float*)args->in[12]; const float* g_kvlat = (const float*)args->in[13];
    const int gw = vcu * NWAVES + wave, NGW = G * NWAVES;
    if (gw < 33) { const bool rt = (gw == 32); const float* pp = (const float*)(ws + WS_CSP); const int col = (rt ? 0 : gw * 32) + (lane & 31); const int which = (rt ? 2 : 0) + (lane >> 5);
        float a = 0.f;
#pragma unroll 8
        for (int kc = 0; kc < 32; ++kc) a += pp[(which * 32 + kc) * 1024 + col];
        float* dst = (float*)(ws + ((lane >> 5) ? (rt ? CTL_CBR : CTL_CB1) : (rt ? CTL_CSR : CTL_CS1))); dst[col] = a; }
    float cw[4][8], cb[8];
#pragma unroll
    for (int jj = 0; jj < 4; ++jj)
#pragma unroll
        for (int c = 0; c < 8; ++c) cw[jj][c] = conv_w[jj * MW + 8 * lane + c];
#pragma unroll
    for (int c = 0; c < 8; ++c) cb[c] = conv_b[8 * lane + c];
    const f32x4 gq = *(const f32x4*)(g_qlat + 4 * lane);
    const f32x2 gk = *(const f32x2*)(g_kvlat + 2 * lane);
    const float inv_freq = exp2f(-(float)(lane & 15) * (13.287712379549449f / 16.0f));
    constexpr int U = 4;
    for (int t0 = gw; t0 < T; t0 += U * NGW) {
        int tt[U]; u32x2 wq[U]; unsigned wk[U], wr[U]; int pos[U]; u32x4 w4[U][4]; float vz[U][4];
#pragma unroll
        for (int u = 0; u < U; ++u) { tt[u] = (t0 + u * NGW < T) ? t0 + u * NGW : t0; const bf16_t* pr = proj + (size_t)tt[u] * NPROJ;
            wq[u] = *(const u32x2*)(pr + PC_QLAT + 4 * lane); wk[u] = *(const unsigned*)(pr + PC_KVLAT + 2 * lane); wr[u] = *(const unsigned*)(pr + PC_KROPE + 2 * (lane & 15)); pos[u] = positions[tt[u]];
            const int s = tt[u] & (SEQ - 1);
#pragma unroll
            for (int jj = 0; jj < 4; ++jj) { const int back = 3 - jj; const bool ok = (s - back >= 0); vz[u][jj] = ok ? 1.0f : 0.0f; w4[u][jj] = *(const u32x4*)(pr - (size_t)(ok ? back : 0) * NPROJ + PC_XM + 8 * lane); } }
#pragma unroll
        for (int u = 0; u < U; ++u) if (u == 0 || t0 + u * NGW < T) { const int t = tt[u];
        { const u32x2 w = wq[u]; const float a0 = bflo(w.x), a1 = bfhi(w.x), a2 = bflo(w.y), a3 = bfhi(w.y);
          const float ss = wave_sum(a0 * a0 + a1 * a1 + a2 * a2 + a3 * a3); const float r = 1.0f / sqrtf(ss * (1.0f / AQR) + EPS);
          u32x2 o; o.x = pk2(a0 * r * gq[0], a1 * r * gq[1]); o.y = pk2(a2 * r * gq[2], a3 * r * gq[3]); *(u32x2*)(qn + (size_t)t * 256 + 4 * lane) = o; }
        { const unsigned w = wk[u]; const float a0 = bflo(w), a1 = bfhi(w);
          const float ss = wave_sum(a0 * a0 + a1 * a1); const float r = 1.0f / sqrtf(ss * (1.0f / AKVR) + EPS);
          *(unsigned*)(kvn + (size_t)t * 256 + 2 * lane) = pk2(a0 * r * gk[0], a1 * r * gk[1]); *(unsigned*)(kvn + (size_t)t * 256 + 128 + 2 * lane) = 0u; }
        { const unsigned w = wr[u]; const float x1 = bflo(w), x2 = bfhi(w);
          const float ang = (float)pos[u] * inv_freq;
          const double rev = (double)ang * 0.15915494309189535; const float fr = (float)(rev - __builtin_rint(rev));
          const float cc = __builtin_amdgcn_cosf(fr), sn = __builtin_amdgcn_sinf(fr);
          if (lane < 16) { *(unsigned*)(kpe + (size_t)t * 32 + 2 * lane) = pk2(x1 * cc - x2 * sn, x2 * cc + x1 * sn);
              *(f32x2*)(cs + (size_t)t * 32 + 2 * lane) = (f32x2){cc, sn}; } }
        { float a[8];
#pragma unroll
          for (int c = 0; c < 8; ++c) a[c] = cb[c];
#pragma unroll
          for (int jj = 0; jj < 4; ++jj) { const u32x4 w = w4[u][jj]; const float z = vz[u][jj];
              a[0] += cw[jj][0] * z * bflo(w.x); a[1] += cw[jj][1] * z * bfhi(w.x); a[2] += cw[jj][2] * z * bflo(w.y); a[3] += cw[jj][3] * z * bfhi(w.y);
              a[4] += cw[jj][4] * z * bflo(w.z); a[5] += cw[jj][5] * z * bfhi(w.z); a[6] += cw[jj][6] * z * bflo(w.w); a[7] += cw[jj][7] * z * bfhi(w.w); }
#pragma unroll
          for (int c = 0; c < 8; ++c) a[c] = a[c] * sigmoidf_(a[c]);
          u32x4 o; o.x = pk2(a[0], a[1]); o.y = pk2(a[2], a[3]); o.z = pk2(a[4], a[5]); o.w = pk2(a[6], a[7]); *(u32x4*)(xc + (size_t)t * MW + 8 * lane) = o; }
        }
    }
}

DI void p6_mpost(CArgs args, int vcu, int G, int wv) {
    const int lane = lane_id(); const int wave = wv;
    unsigned char* ws = args->ws;
    const bf16_t* hraw = (const bf16_t*)(ws + WS_HRAW); const bf16_t* xc = (const bf16_t*)(ws + WS_XC); const bf16_t* proj = (const bf16_t*)(ws + WS_PROJ); bf16_t* hm = (bf16_t*)(ws + WS_HM);
    const float* g_mhead = (const float*)args->in[10]; const float* w_mskip = (const float*)args->in[11];
    const int gw = vcu * NWAVES + wave, NGW = G * NWAVES;
    float gm[8], wsk[8];
#pragma unroll
    for (int c = 0; c < 8; ++c) { gm[c] = g_mhead[8 * lane + c]; wsk[c] = w_mskip[8 * lane + c]; }
    constexpr int U = 4;
    for (int t0 = gw; t0 < T; t0 += U * NGW) {
        int tt[U]; u32x4 hwv[U], xwv[U], owv[U];
#pragma unroll
        for (int u = 0; u < U; ++u) { tt[u] = (t0 + u * NGW < T) ? t0 + u * NGW : t0;
            hwv[u] = *(const u32x4*)(hraw + (size_t)tt[u] * MW + 8 * lane); xwv[u] = *(const u32x4*)(xc + (size_t)tt[u] * MW + 8 * lane); owv[u] = *(const u32x4*)(proj + (size_t)tt[u] * NPROJ + PC_OP + 8 * lane); }
#pragma unroll
        for (int u = 0; u < U; ++u) if (u == 0 || t0 + u * NGW < T) { const int t = tt[u];
        const u32x4 hw = hwv[u];
        float h[8] = {bflo(hw.x), bfhi(hw.x), bflo(hw.y), bfhi(hw.y), bflo(hw.z), bfhi(hw.z), bflo(hw.w), bfhi(hw.w)};
        float s = 0.f;
#pragma unroll
        for (int c = 0; c < 8; ++c) s += h[c];
        s += __shfl_xor(s, 1); s += __shfl_xor(s, 2); s += __shfl_xor(s, 4); s += __shfl_xor(s, 8);
        const float mu = s * (1.0f / MHD); float q = 0.f;
#pragma unroll
        for (int c = 0; c < 8; ++c) { h[c] -= mu; q += h[c] * h[c]; }
        q += __shfl_xor(q, 1); q += __shfl_xor(q, 2); q += __shfl_xor(q, 4); q += __shfl_xor(q, 8);
        const float rstd = 1.0f / sqrtf(q * (1.0f / MHD) + EPS);
        const u32x4 xw = xwv[u]; const u32x4 ow = owv[u];
        const float xv[8] = {bflo(xw.x), bfhi(xw.x), bflo(xw.y), bfhi(xw.y), bflo(xw.z), bfhi(xw.z), bflo(xw.w), bfhi(xw.w)};
        const float ov[8] = {bflo(ow.x), bfhi(ow.x), bflo(ow.y), bfhi(ow.y), bflo(ow.z), bfhi(ow.z), bflo(ow.w), bfhi(ow.w)};
        float o[8];
#pragma unroll
        for (int c = 0; c < 8; ++c) o[c] = sigmoidf_(ov[c]) * (h[c] * rstd * gm[c] + wsk[c] * xv[c]);
        if (P6_FP8) { u32x2 q; q.x = pg8::pk4_fp8(o[0] * pg8::F8_XS, o[1] * pg8::F8_XS, o[2] * pg8::F8_XS, o[3] * pg8::F8_XS); q.y = pg8::pk4_fp8(o[4] * pg8::F8_XS, o[5] * pg8::F8_XS, o[6] * pg8::F8_XS, o[7] * pg8::F8_XS); *(u32x2*)((unsigned char*)hm + (size_t)t * MW + 8 * lane) = q; }
        else { u32x4 w; w.x = pk2(o[0], o[1]); w.y = pk2(o[2], o[3]); w.z = pk2(o[4], o[5]); w.w = pk2(o[6], o[7]); *(u32x4*)(hm + (size_t)t * MW + 8 * lane) = w; }
        }
    }
}

DI void ln_pass(const float* res, const float* add, const float* g, const float* b, float* out, bf16_t* outb, int vcu, int G, int wv = 0) {
    const int lane = lane_id(); const int wave = wv;
    const int gw = vcu * NWAVES + wave, NGW = G * NWAVES;
    for (int t = gw; t < T; t += NGW) {
        f32x4 v[4]; float s = 0.f;
#pragma unroll
        for (int j = 0; j < 4; ++j) { const f32x4 r = *(const f32x4*)(res + (size_t)t * D + 4 * lane + 256 * j), a = *(const f32x4*)(add + (size_t)t * D + 4 * lane + 256 * j);
            v[j] = r * DN_ALPHA + a; s += (v[j][0] + v[j][1]) + (v[j][2] + v[j][3]); }
        const float mean = wave_sum(s) * (1.0f / D); float q = 0.f;
#pragma unroll
        for (int j = 0; j < 4; ++j) { v[j] = v[j] - mean; q += (v[j][0] * v[j][0] + v[j][1] * v[j][1]) + (v[j][2] * v[j][2] + v[j][3] * v[j][3]); }
        const float rstd = 1.0f / sqrtf(wave_sum(q) * (1.0f / D) + EPS);
#pragma unroll
        for (int j = 0; j < 4; ++j) { const f32x4 gg = *(const f32x4*)(g + 4 * lane + 256 * j), bb = *(const f32x4*)(b + 4 * lane + 256 * j);
            const f32x4 y = v[j] * rstd * gg + bb;
            *(f32x4*)(out + (size_t)t * D + 4 * lane + 256 * j) = y;
            if (outb) { u32x2 w; w.x = pk2(y[0], y[1]); w.y = pk2(y[2], y[3]); *(u32x2*)(outb + (size_t)t * D + 4 * lane + 256 * j) = w; } }
    }
}

DI void build_tstart(CArgs args, LAS unsigned char* lds, int wv) {
    const unsigned* gcnt = (const unsigned*)(args->ws + WS_CTL) + CW_CNT; LAS int* tst = (LAS int*)(lds + TST_OFF); LAS int* tile_e = (LAS int*)(lds + TILE_E_OFF);
    const int tidb = wv * 64 + lane_id();
    if (tidb < 64) {
        const int e = tidb & 31; const unsigned c = __hip_atomic_load(gcnt + e * CNT_STRIDE, RLX_AGENT); const int tl = (int)((c + 255u) >> 8);
        int sc = tl;
#pragma unroll
        for (int o = 1; o < 32; o <<= 1) { const int tv = __shfl_up(sc, o); if (e >= o) sc += tv; }
        if (tidb < 32) { tst[e] = sc - tl; if (e == 31) tst[NE] = sc; } }
    __syncthreads();
    for (int t = tidb; t < tst[NE]; t += NWAVES * 64) { int e = 0;
        for (int j = 1; j < NE; ++j) e += (tst[j] <= t) ? 1 : 0;
        tile_e[t] = e; }
    __syncthreads();
}
constexpr int RT_WROW = 2064, RT_G_OFF = 32 * RT_WROW;
DI void p14_router(CArgs args, LAS unsigned char* lds, int vcu, int G, int wv) {
    unsigned char* ws = args->ws;
    const int lane = lane_id(); const int fr = lane & 15, fq = lane >> 4; int tid = wv * 64 + lane; asm volatile("" : "+v"(tid));
    { const u32x4* src = (const u32x4*)(ws + WS_W_R);
      for (int i = tid; i < 32 * 128; i += NWAVES * 64) { const int n = i >> 7, c = i & 127; *(LAS u32x4*)(lds + n * RT_WROW + c * 16) = src[i]; }
      const float* g2 = (const float*)args->in[24]; const float* b2 = (const float*)args->in[25]; LAS float* gl = (LAS float*)(lds + RT_G_OFF);
      for (int i = tid; i < 1024; i += NWAVES * 64) { gl[i] = g2[i] * pg8::F8_XS; gl[1024 + i] = b2[i] * pg8::F8_XS; }
      __syncthreads(); }
    const unsigned char* v2 = ws + WS_V2B; const float* stats2 = (const float*)(ws + WS_STATS2); unsigned char* xn8 = ws + WS_XG;
    const float* cs = (const float*)(ws + CTL_CSR); const float* cb = (const float*)(ws + CTL_CBR);
    const LAS float* gl = (const LAS float*)(lds + RT_G_OFF) + 16 * fq;
    const LAS unsigned char* wl = lds + fr * RT_WROW + 32 * fq;
    LAS float* lg = (LAS float*)(lds + RT_G_OFF + 8192);
    const float* b_router = (const float*)args->in[27]; unsigned* gcnt = (unsigned*)(ws + WS_CTL) + CW_CNT;
    LAS unsigned* hist = (LAS unsigned*)(lds + HIST_OFF); LAS unsigned* hbase = (LAS unsigned*)(lds + HBASE_OFF);
    int* tokpos = (int*)(ws + WS_TOKPOS); float* rowgate = (float*)(ws + WS_ROWGATE); unsigned short* rowtok = (unsigned short*)(ws + WS_ROWTOK);
    for (int blk = vcu; blk < T / 128; blk += G) {
        const int row = blk * 128 + wv * 16 + fr;
        const f32x4 p0 = *(const f32x4*)(stats2 + ((size_t)row * 16 + 4 * fq) * 2), p1 = *(const f32x4*)(stats2 + ((size_t)row * 16 + 4 * fq + 2) * 2);
        float s1 = (p0[0] + p0[2]) + (p1[0] + p1[2]), s2 = (p0[1] + p0[3]) + (p1[1] + p1[3]);
        s1 += __shfl_xor(s1, 16); s2 += __shfl_xor(s2, 16); s1 += __shfl_xor(s1, 32); s2 += __shfl_xor(s2, 32);
        float mean, rstd; pg8::stats_finish(s1, s2, mean, rstd);
        f32x4 acc0 = {0.f, 0.f, 0.f, 0.f}, acc1 = {0.f, 0.f, 0.f, 0.f};
        const unsigned char* ap = v2 + (size_t)row * 2048 + 32 * fq; unsigned char* op = xn8 + (size_t)row * 1024 + 16 * fq;
#pragma unroll 1
        for (int h = 0; h < 2; ++h) {
            u32x4 a[16];
#pragma unroll
            for (int p = 0; p < 8; ++p) { a[2 * p] = *(const u32x4*)(ap + (h * 8 + p) * 128); a[2 * p + 1] = *(const u32x4*)(ap + (h * 8 + p) * 128 + 16); }
#pragma unroll
            for (int p = 0; p < 8; ++p) { const int pp = h * 8 + p; u32x4 o;
#pragma unroll
                for (int s = 0; s < 2; ++s) { const u32x4 w = a[2 * p + s]; const bf16x8 af = __builtin_bit_cast(bf16x8, w);
                    const bf16x8 b0 = *(const LAS bf16x8*)(wl + pp * 128 + 16 * s), b1 = *(const LAS bf16x8*)(wl + 16 * RT_WROW + pp * 128 + 16 * s);
                    acc0 = __builtin_amdgcn_mfma_f32_16x16x32_bf16(b0, af, acc0, 0, 0, 0); acc1 = __builtin_amdgcn_mfma_f32_16x16x32_bf16(b1, af, acc1, 0, 0, 0);
                    const f32x4 g0 = *(const LAS f32x4*)(gl + pp * 64 + 8 * s), g1 = *(const LAS f32x4*)(gl + pp * 64 + 8 * s + 4), c0 = *(const LAS f32x4*)(gl + 1024 + pp * 64 + 8 * s), c1 = *(const LAS f32x4*)(gl + 1024 + pp * 64 + 8 * s + 4);
                    const f32x4 x0 = {bflo(w.x), bfhi(w.x), bflo(w.y), bfhi(w.y)}, x1 = {bflo(w.z), bfhi(w.z), bflo(w.w), bfhi(w.w)};
                    const f32x4 y0 = (x0 - mean) * rstd * g0 + c0, y1 = (x1 - mean) * rstd * g1 + c1;
                    o[2 * s] = pg8::pk4_fp8(y0[0], y0[1], y0[2], y0[3]); o[2 * s + 1] = pg8::pk4_fp8(y1[0], y1[1], y1[2], y1[3]); }
                *(u32x4*)(op + pp * 64) = o; __builtin_amdgcn_sched_barrier(0); }
        }
        { const f32x4 cs0 = *(const f32x4*)(cs + 4 * fq), cs1 = *(const f32x4*)(cs + 16 + 4 * fq), cb0 = *(const f32x4*)(cb + 4 * fq), cb1 = *(const f32x4*)(cb + 16 + 4 * fq);
          const f32x4 l0 = (acc0 - cs0 * mean) * rstd + cb0, l1 = (acc1 - cs1 * mean) * rstd + cb1;
          LAS float* lw = lg + (wv * 16 + fr) * 33 + 4 * fq;
          lw[0] = l0[0]; lw[1] = l0[1]; lw[2] = l0[2]; lw[3] = l0[3]; lw[16] = l1[0]; lw[17] = l1[1]; lw[18] = l1[2]; lw[19] = l1[3]; }
        if (tid < NE) hist[tid] = 0u;
        __syncthreads();
        int idx[TOPK]; float gate[TOPK]; unsigned lr[TOPK];
        if (tid < 128) {
            float v[NE];
#pragma unroll
            for (int j = 0; j < NE; ++j) v[j] = lg[tid * 33 + j] + b_router[j];
            float val[TOPK];
#pragma unroll
            for (int k = 0; k < TOPK; ++k) { float best = -INFINITY; int bi = 0;
#pragma unroll
                for (int e = 0; e < NE; ++e) { bool taken = false;
#pragma unroll
                    for (int kk = 0; kk < k; ++kk) taken = taken || (idx[kk] == e);
                    if (!taken && v[e] > best) { best = v[e]; bi = e; } }
                idx[k] = bi; val[k] = best; }
            float sum = 0.f;
#pragma unroll
            for (int k = 0; k < TOPK; ++k) { gate[k] = __expf(val[k] - val[0]); sum += gate[k]; }
            const float inv = 1.0f / sum;
#pragma unroll
            for (int k = 0; k < TOPK; ++k) { gate[k] *= inv; lr[k] = __hip_atomic_fetch_add(hist + idx[k], 1u, __ATOMIC_RELAXED, __HIP_MEMORY_SCOPE_WORKGROUP); }
        }
        __syncthreads();
        if (tid < NE) hbase[tid] = __hip_atomic_fetch_add(gcnt + tid * CNT_STRIDE, hist[tid], RLX_AGENT);
        __syncthreads();
        if (tid < 128) { const int t = blk * 128 + tid;
#pragma unroll
            for (int k = 0; k < TOPK; ++k) { const int e = idx[k]; const int rank = (int)(hbase[e] + lr[k]);
                tokpos[(size_t)t * TOPK + k] = (e << 20) | rank; rowgate[(size_t)e * RCAP + rank] = gate[k]; rowtok[(size_t)e * RCAP + rank] = (unsigned short)t; } }
        __syncthreads();
    }
}
DI void p20_final(CArgs args, LAS unsigned char* lds, int vcu, int G, int wv) {
    build_tstart(args, lds, wv);
    const LAS int* tst = (const LAS int*)(lds + TST_OFF);
    const int lane = lane_id(); const int wave = wv;
    unsigned char* ws = args->ws;
    const int* tokpos = (const int*)(ws + WS_TOKPOS); const unsigned char* yb = ws + WS_YB;
    const bf16_t* v2 = (const bf16_t*)(ws + WS_V2B); const float* stats2 = (const float*)(ws + WS_STATS2);
    const float* g2 = (const float*)args->in[24]; const float* b2 = (const float*)args->in[25];
    const float* g = (const float*)args->in[32]; const float* b = (const float*)args->in[33]; float* out = args->out;
    const int gw = vcu * NWAVES + wave, NGW = G * NWAVES;
    constexpr int U = 4;
    for (int t0 = gw; t0 < T; t0 += U * NGW) {
        int tt[U]; int pos[U][TOPK]; f32x2 sp[U]; u32x2 vw[U][4];
#pragma unroll
        for (int u = 0; u < U; ++u) { tt[u] = (t0 + u * NGW < T) ? t0 + u * NGW : t0;
#pragma unroll
            for (int k = 0; k < TOPK; ++k) { const int as = tokpos[(size_t)tt[u] * TOPK + k]; pos[u][k] = tst[as >> 20] * 256 + (as & 0xfffff); }
            sp[u] = (f32x2){0.f, 0.f}; if (lane < 16) sp[u] = *(const f32x2*)(stats2 + ((size_t)tt[u] * 16 + lane) * 2);
#pragma unroll
            for (int j = 0; j < 4; ++j) vw[u][j] = *(const u32x2*)(v2 + (size_t)tt[u] * D + 4 * lane + 256 * j); }
        int yw[U][4][TOPK];
#pragma unroll
        for (int u = 0; u < U; ++u)
#pragma unroll
            for (int j = 0; j < 4; ++j)
#pragma unroll
                for (int k = 0; k < TOPK; ++k) yw[u][j][k] = *(const int*)(yb + (size_t)pos[u][k] * D + 4 * lane + 256 * j);
#pragma unroll
        for (int u = 0; u < U; ++u) {
            float s1 = sp[u][0], s2 = sp[u][1];
#pragma unroll
            for (int o = 1; o < 16; o <<= 1) { s1 += __shfl_xor(s1, o); s2 += __shfl_xor(s2, o); }
            s1 = __shfl(s1, 0); s2 = __shfl(s2, 0);
            float mean2, rstd2; pg8::stats_finish(s1, s2, mean2, rstd2);
            f32x4 v[4]; float s = 0.f;
#pragma unroll
            for (int j = 0; j < 4; ++j) { const f32x4 vin = {bflo(vw[u][j].x), bfhi(vw[u][j].x), bflo(vw[u][j].y), bfhi(vw[u][j].y)};
                const f32x4 r = (vin - mean2) * rstd2 * *(const f32x4*)(g2 + 4 * lane + 256 * j) + *(const f32x4*)(b2 + 4 * lane + 256 * j);
                f32x4 a = {0.f, 0.f, 0.f, 0.f};
#pragma unroll
                for (int k = 0; k < TOPK; ++k) { const int w = yw[u][j][k]; const f32x2 lo = __builtin_amdgcn_cvt_pk_f32_fp8(w, false), hi2 = __builtin_amdgcn_cvt_pk_f32_fp8(w, true); a[0] += lo[0]; a[1] += lo[1]; a[2] += hi2[0]; a[3] += hi2[1]; }
                v[j] = r * DN_ALPHA + a * (1.0f / pg8::F8_YS); s += (v[j][0] + v[j][1]) + (v[j][2] + v[j][3]); }
            const float mean = wave_sum(s) * (1.0f / D); float q = 0.f;
#pragma unroll
            for (int j = 0; j < 4; ++j) { v[j] = v[j] - mean; q += (v[j][0] * v[j][0] + v[j][1] * v[j][1]) + (v[j][2] * v[j][2] + v[j][3] * v[j][3]); }
            const float rstd = 1.0f / sqrtf(wave_sum(q) * (1.0f / D) + EPS);
            if (u == 0 || t0 + u * NGW < T) {
#pragma unroll
                for (int j = 0; j < 4; ++j) { const f32x4 gg = *(const f32x4*)(g + 4 * lane + 256 * j), bb = *(const f32x4*)(b + 4 * lane + 256 * j);
                    *(f32x4*)(out + (size_t)tt[u] * D + 4 * lane + 256 * j) = v[j] * rstd * gg + bb; } }
        }
    }
}
constexpr float F8_XS_ = 16.0f;
#ifndef ML4_A0
#define ML4_A0 0x00u
#endif
#ifndef ML4_B0
#define ML4_B0 0x00u
#endif
#ifndef ML_NS_
#define ML_NS_ 4
#endif
constexpr int ML_NS = ML_NS_;
constexpr int ML_SVN = (ML_NS + 1) / 2;
constexpr int AT_KROW = 208, AT_VROW = 264;
constexpr int AT_KBUF = 128 * AT_KROW, AT_VBUF = 64 * AT_VROW, AT_VOFF = 2 * AT_KBUF;
DI float max2f_(float a, float b) { return __builtin_amdgcn_fmed3f(a, b, INFINITY); }
#define MLA_QK(P0, P1, kbase) do { _Pragma("unroll") for (int r_ = 0; r_ < 16; ++r_) { P0[r_] = 0.f; P1[r_] = 0.f; } \
        _Pragma("unroll") for (int s_ = 0; s_ < 6; ++s_) { const bf16x8 a0_ = *(const LAS bf16x8*)((kbase) + s_ * 32), a1_ = *(const LAS bf16x8*)((kbase) + 32 * AT_KROW + s_ * 32); \
            P0 = MFMA32(a0_, qf[s_], P0); P1 = MFMA32(a1_, qf[s_], P1); } } while (0)
#define MLA_SOFTPV(P0, P1, vbase, MASK, key0) do { \
        if (MASK) { _Pragma("unroll") for (int r_ = 0; r_ < 16; ++r_) { const int key_ = (key0) + crow(r_, hi); if (key_ > qi) P0[r_] = -INFINITY; if (key_ + 32 > qi) P1[r_] = -INFINITY; } } \
        float mx_ = max2f_(P0[0], P1[0]); \
        _Pragma("unroll") for (int r_ = 1; r_ < 16; ++r_) { mx_ = max2f_(mx_, P0[r_]); mx_ = max2f_(mx_, P1[r_]); } \
        mx_ = fmaxf(mx_, __shfl_xor(mx_, 32)); \
        const float m_new_ = fmaxf(m_run, mx_); const float alpha_ = __builtin_amdgcn_exp2f(m_run - m_new_); m_run = m_new_; \
        f32x2 ls2_ = {0.f, 0.f}; \
        _Pragma("unroll") for (int r_ = 0; r_ < 16; ++r_) { P0[r_] = __builtin_amdgcn_exp2f(P0[r_] - m_new_); P1[r_] = __builtin_amdgcn_exp2f(P1[r_] - m_new_); } \
        _Pragma("unroll") for (int r_ = 0; r_ < 16; r_ += 2) { ls2_ += (f32x2){P0[r_], P0[r_ + 1]}; ls2_ += (f32x2){P1[r_], P1[r_ + 1]}; } \
        l_run = l_run * alpha_ + (ls2_[0] + ls2_[1]); \
        if (!__all(alpha_ == 1.0f)) { _Pragma("unroll") for (int r_ = 0; r_ < 16; ++r_) { o0[r_] *= alpha_; o1[r_] *= alpha_; } } \
        _Pragma("unroll") for (int s_ = 0; s_ < 4; ++s_) { u32x4 w_; \
            if (s_ < 2) { w_.x = pk2(P0[8 * s_], P0[8 * s_ + 1]); w_.y = pk2(P0[8 * s_ + 2], P0[8 * s_ + 3]); w_.z = pk2(P0[8 * s_ + 4], P0[8 * s_ + 5]); w_.w = pk2(P0[8 * s_ + 6], P0[8 * s_ + 7]); } \
            else { w_.x = pk2(P1[8 * s_ - 16], P1[8 * s_ - 15]); w_.y = pk2(P1[8 * s_ - 14], P1[8 * s_ - 13]); w_.z = pk2(P1[8 * s_ - 12], P1[8 * s_ - 11]); w_.w = pk2(P1[8 * s_ - 10], P1[8 * s_ - 9]); } \
            const bf16x8 pb_ = __builtin_bit_cast(bf16x8, w_); \
            const u32x2 a0l_ = *(const LAS u32x2*)((vbase) + s_ * 32), a0h_ = *(const LAS u32x2*)((vbase) + s_ * 32 + 16); \
            const u32x2 a1l_ = *(const LAS u32x2*)((vbase) + 32 * AT_VROW + s_ * 32), a1h_ = *(const LAS u32x2*)((vbase) + 32 * AT_VROW + s_ * 32 + 16); \
            const bf16x8 a0_ = __builtin_bit_cast(bf16x8, (u32x4){a0l_.x, a0l_.y, a0h_.x, a0h_.y}), a1_ = __builtin_bit_cast(bf16x8, (u32x4){a1l_.x, a1l_.y, a1h_.x, a1h_.y}); \
            o0 = MFMA32(a0_, pb_, o0); o1 = MFMA32(a1_, pb_, o1); } } while (0)
DI void mla_unit(int b, int h, int qb, const bf16_t* Q, const bf16_t* Kn, const bf16_t* Kpe, const bf16_t* Vt, bf16_t* O, LAS unsigned char* lds, int wv) {
    int tid = wv * 64 + lane_id(); asm volatile("" : "+v"(tid)); const int lane = tid & 63, r32 = lane & 31, hi = lane >> 5; const int wid = wv;
    const int q0 = qb * 256 + wid * 32;
    const int qi = q0 + r32;
    const size_t tokb = (size_t)b * SEQ;
    bf16x8 qf[6];
    { const bf16_t* qp = Q + (tokb + qi) * (AH * AQK) + h * AQK + 8 * hi;
#pragma unroll
      for (int s = 0; s < 6; ++s) qf[s] = *(const bf16x8*)(qp + 16 * s); }
    const int kkey = tid >> 3, kch = tid & 7, pkey = tid >> 2, pch = tid & 3, vd = tid >> 3, vch = tid & 7;
    const bf16_t* ksrc = Kn + (tokb + kkey) * 512 + h * 64 + kch * 8;
    const bf16_t* psrc = Kpe + (tokb + pkey) * 32 + pch * 8;
    const bf16_t* vsrc = Vt + (size_t)(h * 64 + vd) * T + tokb + vch * 8;
    const int kdst = kkey * AT_KROW + kch * 16, pdst = pkey * AT_KROW + 128 + pch * 16, vdst = AT_VOFF + vd * AT_VROW + vch * 16;
    const int nbt = 2 * (qb + 1), nfull = 2 * qb;
    u32x4 rk0, rk1, rp, rv0, rv1;
#define MLA_LD(t) do { rk0 = *(const u32x4*)(ksrc + (size_t)(t) * 128 * 512); rk1 = *(const u32x4*)(ksrc + ((size_t)(t) * 128 + 64) * 512); rp = *(const u32x4*)(psrc + (size_t)(t) * 128 * 32); \
        rv0 = *(const u32x4*)(vsrc + (t) * 128); rv1 = *(const u32x4*)(vsrc + (t) * 128 + 64); } while (0)
#define MLA_ST(buf) do { *(LAS u32x4*)(lds + (buf) * AT_KBUF + kdst) = rk0; *(LAS u32x4*)(lds + (buf) * AT_KBUF + 64 * AT_KROW + kdst) = rk1; *(LAS u32x4*)(lds + (buf) * AT_KBUF + pdst) = rp; \
        *(LAS u32x2*)(lds + (buf) * AT_VBUF + vdst) = (u32x2){rv0.x, rv0.y}; *(LAS u32x2*)(lds + (buf) * AT_VBUF + vdst + 8) = (u32x2){rv0.z, rv0.w}; \
        *(LAS u32x2*)(lds + (buf) * AT_VBUF + vdst + 128) = (u32x2){rv1.x, rv1.y}; *(LAS u32x2*)(lds + (buf) * AT_VBUF + vdst + 136) = (u32x2){rv1.z, rv1.w}; } while (0)
    MLA_LD(0); MLA_ST(0);
    __syncthreads();
    float m_run = -INFINITY, l_run = 0.f;
    f32x16 o0, o1, pa0, pa1, pb0, pb1;
#pragma unroll
    for (int r = 0; r < 16; ++r) { o0[r] = 0.f; o1[r] = 0.f; }
    const LAS unsigned char* kl = lds + r32 * AT_KROW + hi * 16; const LAS unsigned char* vl = lds + AT_VOFF + r32 * AT_VROW + hi * 8;
    int t = 0;
    for (; t < nfull; ++t) {
        MLA_LD(t + 1);
        const LAS unsigned char* kb = kl + (t & 1) * AT_KBUF; const LAS unsigned char* vb = vl + (t & 1) * AT_VBUF;
        MLA_QK(pa0, pa1, kb);
        MLA_QK(pb0, pb1, kb + 64 * AT_KROW);
        MLA_SOFTPV(pa0, pa1, vb, false, 0);
        MLA_SOFTPV(pb0, pb1, vb + 128, false, 0);
        MLA_ST((t + 1) & 1);
        __syncthreads();
    }
    for (; t < nbt; ++t) {
        if (t + 1 < nbt) MLA_LD(t + 1);
        const LAS unsigned char* kb = kl + (t & 1) * AT_KBUF; const LAS unsigned char* vb = vl + (t & 1) * AT_VBUF;
        const int key0 = t * 128;
        if (key0 <= q0 + 31) { MLA_QK(pa0, pa1, kb); MLA_SOFTPV(pa0, pa1, vb, true, key0); }
        if (key0 + 64 <= q0 + 31) { MLA_QK(pb0, pb1, kb + 64 * AT_KROW); MLA_SOFTPV(pb0, pb1, vb + 128, true, key0 + 64); }
        if (t + 1 < nbt) MLA_ST((t + 1) & 1);
        __syncthreads();
    }
#undef MLA_LD
#undef MLA_ST
    const float lt = l_run + __shfl_xor(l_run, 32); const float inv = 1.0f / lt;
    if (P6_FP8) { unsigned char* op8 = (unsigned char*)O + (tokb + qi) * AW + h * AVD + 4 * hi; const float sc = inv * F8_XS_;
#pragma unroll
        for (int g = 0; g < 4; ++g) { *(unsigned*)(op8 + 8 * g) = pg8::pk4_fp8(o0[4 * g] * sc, o0[4 * g + 1] * sc, o0[4 * g + 2] * sc, o0[4 * g + 3] * sc);
            *(unsigned*)(op8 + 32 + 8 * g) = pg8::pk4_fp8(o1[4 * g] * sc, o1[4 * g + 1] * sc, o1[4 * g + 2] * sc, o1[4 * g + 3] * sc); } }
    else {
    bf16_t* op = O + (tokb + qi) * AW + h * AVD + 4 * hi;
#pragma unroll
    for (int g = 0; g < 4; ++g) { u32x2 w0, w1;
        w0.x = pk2(o0[4 * g] * inv, o0[4 * g + 1] * inv); w0.y = pk2(o0[4 * g + 2] * inv, o0[4 * g + 3] * inv);
        w1.x = pk2(o1[4 * g] * inv, o1[4 * g + 1] * inv); w1.y = pk2(o1[4 * g + 2] * inv, o1[4 * g + 3] * inv);
        *(u32x2*)(op + 8 * g) = w0; *(u32x2*)(op + 32 + 8 * g) = w1; } }
}
DI void p4_attention(CArgs args, LAS unsigned char* lds, int vcu, int G, int wv) {
    unsigned char* ws = args->ws;
    const bf16_t* Q = (const bf16_t*)(ws + WS_QMLA); const bf16_t* Kn = (const bf16_t*)(ws + WS_KN); const bf16_t* Kpe = (const bf16_t*)(ws + WS_KPE); const bf16_t* Vt = (const bf16_t*)(ws + WS_VT);
    bf16_t* O = (bf16_t*)(ws + WS_AO);
    if (ML_NS == 2 && G == 2 * NB * AH && NB * MH * 2 == NB * AH) {
        const int bh = vcu % (NB * AH); const int b = bh / AH, h = bh % AH;
        if (vcu < NB * AH) { mla_unit(b, h, 7, Q, Kn, Kpe, Vt, O, lds, wv); mla_unit(b, h, 1, Q, Kn, Kpe, Vt, O, lds, wv); }
        else {
#pragma unroll 1
            for (int qb = 6; qb >= 0; --qb) if (qb != 1) mla_unit(b, h, qb, Q, Kn, Kpe, Vt, O, lds, wv); }
        return;
    }
    if (ML_NS == 4 && G == 4 * NB * MH && NB * AH == 2 * NB * MH) {
        const int g = vcu >> 2, r = vcu & 3; const int bhA = 2 * g, bhB = 2 * g + 1;
        constexpr unsigned MA0 = ML4_A0, MB0 = ML4_B0;
        const unsigned mA = (r == 0) ? MA0 : (r == 1) ? 0xC0u : (r == 2) ? 0x31u : (0x0Eu & ~MA0);
        const unsigned mB = (r == 0) ? MB0 : (r == 1) ? 0x81u : (r == 2) ? 0x50u : (0x2Eu & ~MB0);
#pragma unroll 1
        for (int qb = 7; qb >= 0; --qb) if ((mA >> qb) & 1u) mla_unit(bhA / AH, bhA % AH, qb, Q, Kn, Kpe, Vt, O, lds, wv);
#pragma unroll 1
        for (int qb = 7; qb >= 0; --qb) if ((mB >> qb) & 1u) mla_unit(bhB / AH, bhB % AH, qb, Q, Kn, Kpe, Vt, O, lds, wv);
        return;
    }
    for (int p = vcu; p < NB * AH * 4; p += G) { const int bh = p >> 2, j = p & 3; const int b = bh / AH, h = bh % AH;
        mla_unit(b, h, 7 - j, Q, Kn, Kpe, Vt, O, lds, wv);
        mla_unit(b, h, j, Q, Kn, Kpe, Vt, O, lds, wv); }
}

constexpr int ML_QROW = 272, ML_TROW = 144;
constexpr int ML_QS = 0, ML_KS = ML_QS + 64 * ML_QROW, ML_KTS = ML_KS + 64 * ML_QROW, ML_VTS = ML_KTS + 128 * ML_TROW, ML_CS = ML_VTS + ML_NS * 32 * ML_TROW, ML_SS = ML_CS + ML_NS * 32 * ML_QROW,
              ML_VEC = ML_SS + 64 * ML_TROW;
constexpr int ML_VBUF = 5 * 64 + 16;
static_assert(ML_VEC + (2 * ML_VBUF + 2 * 64 + 128) * 4 <= RING_BYTES, "mLSTM LDS");
DI void mlstm_unit(int b, int h, int vs, CArgs args, LAS unsigned char* lds, int wv) {
    unsigned char* ws = args->ws;
    const bf16_t* qkm = (const bf16_t*)(ws + WS_QKM); const bf16_t* ktm = (const bf16_t*)(ws + WS_KTM); const bf16_t* proj = (const bf16_t*)(ws + WS_PROJ);
    const float* gates = (const float*)(ws + WS_GATES); bf16_t* hraw = (bf16_t*)(ws + WS_HRAW);
    const float b_i = ((const float*)args->in[4])[h], b_f = ((const float*)args->in[5])[h];
    int tid = wv * 64 + lane_id(); asm volatile("" : "+v"(tid)); const int lane = tid & 63, r32 = lane & 31, hi = lane >> 5; const int wid = wv;
    LAS float* VEC0 = (LAS float*)(lds + ML_VEC);
    LAS float* NQ = VEC0 + 2 * ML_VBUF; LAS float* DINV = NQ + 64; LAS float* NVEC = NQ + 128;
    const size_t tokb = (size_t)b * SEQ;
    for (int i = tid; i < ML_NS * 32 * ML_QROW / 4; i += 512) ((LAS unsigned*)(lds + ML_CS))[i] = 0u;
    if (tid < 128) NVEC[tid] = 0.f;
    f32x16 cacc[ML_NS];
#pragma unroll
    for (int s = 0; s < ML_NS; ++s)
#pragma unroll
        for (int r = 0; r < 16; ++r) cacc[s][r] = 0.f;
    float m_st = 0.f;
    u32x4 sq[2], sk[2], skt[2], sv[ML_SVN]; float gi = 0.f, gf = 0.f;
#pragma unroll
    for (int i = 0; i < ML_SVN; ++i) sv[i] = (u32x4){0u, 0u, 0u, 0u};
#define ML_LOAD(c) do { const size_t tok0 = tokb + (size_t)(c) * MCH; \
        _Pragma("unroll") for (int i = 0; i < 2; ++i) { const int idx = tid + 512 * i; \
            sq[i] = *(const u32x4*)(qkm + (tok0 + (idx >> 4)) * 1024 + h * MHD + (idx & 15) * 8); \
            sk[i] = *(const u32x4*)(qkm + (tok0 + (idx >> 4)) * 1024 + 512 + h * MHD + (idx & 15) * 8); \
            skt[i] = *(const u32x4*)(ktm + (size_t)(h * MHD + (idx >> 3)) * T + tok0 + (idx & 7) * 8); } \
        _Pragma("unroll") for (int i = 0; i < ML_SVN; ++i) if ((tid >> 8) + 2 * i < ML_NS) sv[i] = *(const u32x4*)(proj + (tok0 + ((tid & 255) >> 2)) * NPROJ + PC_VM + h * MHD + (vs + (tid >> 8) + 2 * i) * 32 + (tid & 3) * 8); } while (0)
#define ML_GLOAD(c) do { const size_t tok0_ = tokb + (size_t)(c) * MCH; gi = gates[(tok0_ + lane) * 8 + h]; gf = gates[(tok0_ + lane) * 8 + 4 + h]; } while (0)
#define ML_GVEC(vb) do { LAS float* ROWT_ = (vb); \
            const float xf = gf + b_f; \
            const float lf = (xf >= 0.f) ? -log1pf(__expf(-xf)) : xf - log1pf(__expf(xf)); \
            float bb = lf; \
            _Pragma("unroll") for (int o = 1; o < 64; o <<= 1) { const float tv = __shfl_up(bb, o); if (lane >= o) bb += tv; } \
            const float btot = __builtin_bit_cast(float, __builtin_amdgcn_readlane(__builtin_bit_cast(int, bb), 63)); \
            const float ig = gi + b_i; \
            const float a = btot - bb + ig; \
            const float mchunk = wave_max(a); \
            const float wa = __expf(a - mchunk); \
            const float u = ig - bb; \
            float pm = u; \
            _Pragma("unroll") for (int o = 1; o < 64; o <<= 1) { const float tv = __shfl_up(pm, o); if (lane >= o) pm = fmaxf(pm, tv); } \
            const float mintra = bb + pm; \
            const float ginter = bb + m_st; \
            const float m = fmaxf(ginter, mintra); \
            const float mnew = fmaxf(btot + m_st, mchunk); \
            const float sold = __expf(btot + m_st - mnew), snew = __expf(mchunk - mnew); \
            ROWT_[lane] = bb - m; ROWT_[64 + lane] = u; ROWT_[128 + lane] = __expf(ginter - m); ROWT_[192 + lane] = __expf(-m); ROWT_[256 + lane] = snew * wa; \
            if (lane == 0) ROWT_[320] = sold; \
            m_st = mnew; } while (0)
    if (wid == 1) { ML_GLOAD(0); ML_GVEC(VEC0); ML_GLOAD(1);
        LAS bf16_t* ss0 = (LAS bf16_t*)(lds + ML_SS);
#pragma unroll
        for (int r = 0; r < 16; ++r) ss0[crow(r, hi) * (ML_TROW / 2) + 32 + r32] = (bf16_t)0; }
    ML_LOAD(0);
    for (int c = 0; c < SEQ / MCH; ++c) {
        const size_t tok0 = tokb + (size_t)c * MCH;
        LAS float* ROWT = VEC0 + (c & 1) * ML_VBUF; LAS float* COLT = ROWT + 64; LAS float* WINT = ROWT + 128; LAS float* ENEG = ROWT + 192; LAS float* WAS = ROWT + 256; LAS float* SCAL = ROWT + 320;
#pragma unroll
        for (int i = 0; i < 2; ++i) { const int idx = tid + 512 * i;
            *(LAS u32x4*)(lds + ML_QS + (idx >> 4) * ML_QROW + (idx & 15) * 16) = sq[i];
            *(LAS u32x4*)(lds + ML_KS + (idx >> 4) * ML_QROW + (idx & 15) * 16) = sk[i];
            *(LAS u32x4*)(lds + ML_KTS + (idx >> 3) * ML_TROW + (idx & 7) * 16) = skt[i]; }
#pragma unroll
        for (int i = 0; i < ML_SVN; ++i) if ((tid >> 8) + 2 * i < ML_NS) { const int l = (tid & 255) >> 2, v0 = ((tid >> 8) + 2 * i) * 32 + (tid & 3) * 8; LAS bf16_t* vt = (LAS bf16_t*)(lds + ML_VTS); const u32x4 w = sv[i];
            vt[(v0 + 0) * (ML_TROW / 2) + l] = (bf16_t)(w.x & 0xffff); vt[(v0 + 1) * (ML_TROW / 2) + l] = (bf16_t)(w.x >> 16);
            vt[(v0 + 2) * (ML_TROW / 2) + l] = (bf16_t)(w.y & 0xffff); vt[(v0 + 3) * (ML_TROW / 2) + l] = (bf16_t)(w.y >> 16);
            vt[(v0 + 4) * (ML_TROW / 2) + l] = (bf16_t)(w.z & 0xffff); vt[(v0 + 5) * (ML_TROW / 2) + l] = (bf16_t)(w.z >> 16);
            vt[(v0 + 6) * (ML_TROW / 2) + l] = (bf16_t)(w.w & 0xffff); vt[(v0 + 7) * (ML_TROW / 2) + l] = (bf16_t)(w.w >> 16); }
        __syncthreads();
        if (c + 1 < SEQ / MCH) ML_LOAD(c + 1);
        if (wid < 4) {
            const int jb = wid >> 1, sb = wid & 1;
            LAS bf16_t* ss = (LAS bf16_t*)(lds + ML_SS);
            if (sb <= jb) {
                f32x16 s;
#pragma unroll
                for (int r = 0; r < 16; ++r) s[r] = 0.f;
                const LAS unsigned char* qa = lds + ML_QS + (32 * jb + r32) * ML_QROW + hi * 16; const LAS unsigned char* kb = lds + ML_KS + (32 * sb + r32) * ML_QROW + hi * 16;
#pragma unroll
                for (int kk = 0; kk < 8; ++kk) s = MFMA32(*(const LAS bf16x8*)(qa + kk * 32), *(const LAS bf16x8*)(kb + kk * 32), s);
                const int sidx = 32 * sb + r32; const float ct = COLT[sidx];
#pragma unroll
                for (int r = 0; r < 16; ++r) { const int j = 32 * jb + crow(r, hi);
                    const float ev = __builtin_amdgcn_exp2f((ROWT[j] + ct) * 1.4426950408889634f); const float val = (sidx <= j) ? s[r] * ev : 0.f;
                    ss[j * (ML_TROW / 2) + sidx] = (bf16_t)pk2(val, 0.f); }
            } else if (c + 1 < SEQ / MCH) {
                ML_GVEC(VEC0 + ((c + 1) & 1) * ML_VBUF);
                if (c + 2 < SEQ / MCH) ML_GLOAD(c + 2);
            }
        } else if (wid < 6) {
            const int jb = wid - 4;
            const LAS unsigned char* qa = lds + ML_QS + (32 * jb + r32) * ML_QROW + hi * 16; const LAS unsigned char* cb = lds + ML_CS + r32 * ML_QROW + hi * 16;
#pragma unroll
            for (int s = 0; s < ML_NS; ++s)
#pragma unroll
                for (int r = 0; r < 16; ++r) cacc[s][r] = 0.f;
#pragma unroll
            for (int kk = 0; kk < 8; ++kk) { const bf16x8 qv = *(const LAS bf16x8*)(qa + kk * 32);
#pragma unroll
                for (int s = 0; s < ML_NS; ++s) cacc[s] = MFMA32(qv, *(const LAS bf16x8*)(cb + s * 32 * ML_QROW + kk * 32), cacc[s]);
                if (ML_NS > 2) __builtin_amdgcn_sched_barrier(0); }
        } else {
            const int j = 32 * (wid - 6) + (lane >> 1), half = lane & 1;
            const LAS unsigned char* qa = lds + ML_QS + j * ML_QROW + half * 128; float acc = 0.f;
#pragma unroll
            for (int i = 0; i < 8; ++i) { const u32x4 w = *(const LAS u32x4*)(qa + i * 16); const f32x4 n0 = *(const LAS f32x4*)(NVEC + half * 64 + i * 8), n1 = *(const LAS f32x4*)(NVEC + half * 64 + i * 8 + 4);
                acc += bflo(w.x) * n0[0] + bfhi(w.x) * n0[1] + bflo(w.y) * n0[2] + bfhi(w.y) * n0[3] + bflo(w.z) * n1[0] + bfhi(w.z) * n1[1] + bflo(w.w) * n1[2] + bfhi(w.w) * n1[3]; }
            acc += __shfl_xor(acc, 1);
            if (half == 0) NQ[j] = acc;
        }
        __syncthreads();
        if (wid < 4) {
            const float sold = SCAL[0];
#pragma unroll
            for (int s = 0; s < ML_NS; ++s)
#pragma unroll
                for (int r = 0; r < 16; ++r) cacc[s][r] *= sold;
            const LAS unsigned char* va = lds + ML_VTS + r32 * ML_TROW + hi * 16; const LAS unsigned char* kb = lds + ML_KTS + (32 * wid + r32) * ML_TROW + hi * 16;
#pragma unroll
            for (int kk = 0; kk < 4; ++kk) { const bf16x8 kv = *(const LAS bf16x8*)(kb + kk * 32);
                const f32x4 w0 = *(const LAS f32x4*)(WAS + 16 * kk + 8 * hi), w1 = *(const LAS f32x4*)(WAS + 16 * kk + 8 * hi + 4);
#pragma unroll
                for (int s = 0; s < ML_NS; ++s) { const u32x4 w = *(const LAS u32x4*)(va + s * 32 * ML_TROW + kk * 32);
                    u32x4 sa; sa.x = pk2(bflo(w.x) * w0[0], bfhi(w.x) * w0[1]); sa.y = pk2(bflo(w.y) * w0[2], bfhi(w.y) * w0[3]); sa.z = pk2(bflo(w.z) * w1[0], bfhi(w.z) * w1[1]); sa.w = pk2(bflo(w.w) * w1[2], bfhi(w.w) * w1[3]);
                    cacc[s] = MFMA32(__builtin_bit_cast(bf16x8, sa), kv, cacc[s]); }
                if (ML_NS > 2) __builtin_amdgcn_sched_barrier(0); }
            LAS bf16_t* cs = (LAS bf16_t*)(lds + ML_CS);
#pragma unroll
            for (int s = 0; s < ML_NS; ++s)
#pragma unroll
                for (int r = 0; r < 16; ++r) cs[(s * 32 + crow(r, hi)) * (ML_QROW / 2) + 32 * wid + r32] = (bf16_t)pk2(cacc[s][r], 0.f);
        } else if (wid < 6) {
            const int jb = wid - 4;
#pragma unroll
            for (int r = 0; r < 16; ++r) { const float wi = WINT[32 * jb + crow(r, hi)];
#pragma unroll
                for (int s = 0; s < ML_NS; ++s) cacc[s][r] *= wi; }
            const LAS unsigned char* sa = lds + ML_SS + (32 * jb + r32) * ML_TROW + hi * 16; const LAS unsigned char* vb = lds + ML_VTS + r32 * ML_TROW + hi * 16;
#pragma unroll
            for (int kk = 0; kk < 4; ++kk) { const bf16x8 sv_ = *(const LAS bf16x8*)(sa + kk * 32);
#pragma unroll
                for (int s = 0; s < ML_NS; ++s) cacc[s] = MFMA32(sv_, *(const LAS bf16x8*)(vb + s * 32 * ML_TROW + kk * 32), cacc[s]);
                if (ML_NS > 2) __builtin_amdgcn_sched_barrier(0); }
        } else {
            const int tl = (wid - 6) * 64 + lane;
            { const int j = tl >> 1, half = tl & 1; const LAS unsigned char* sp = lds + ML_SS + j * ML_TROW + half * 64; float rs = 0.f;
#pragma unroll
              for (int i = 0; i < 4; ++i) { const u32x4 w = *(const LAS u32x4*)(sp + i * 16); rs += (bflo(w.x) + bfhi(w.x)) + (bflo(w.y) + bfhi(w.y)) + (bflo(w.z) + bfhi(w.z)) + (bflo(w.w) + bfhi(w.w)); }
              rs += __shfl_xor(rs, 1);
              if (half == 0) { const float den = WINT[j] * NQ[j] + rs; DINV[j] = 1.0f / fmaxf(fabsf(den), ENEG[j]); } }
            { const int k = tl; const LAS unsigned char* kp = lds + ML_KTS + k * ML_TROW; float acc = SCAL[0] * NVEC[k];
#pragma unroll
              for (int i = 0; i < 8; ++i) { const u32x4 w = *(const LAS u32x4*)(kp + i * 16); const f32x4 w0 = *(const LAS f32x4*)(WAS + i * 8), w1 = *(const LAS f32x4*)(WAS + i * 8 + 4);
                  acc += bflo(w.x) * w0[0] + bfhi(w.x) * w0[1] + bflo(w.y) * w0[2] + bfhi(w.y) * w0[3] + bflo(w.z) * w1[0] + bfhi(w.z) * w1[1] + bflo(w.w) * w1[2] + bfhi(w.w) * w1[3]; }
              NVEC[k] = acc; }
        }
        __syncthreads();
        if (wid == 4 || wid == 5) {
            const int jb = wid - 4; bf16_t* hp = hraw + (tok0 + 32 * jb) * MW + h * MHD + vs * 32 + r32;
#pragma unroll
            for (int r = 0; r < 16; ++r) { const int j = crow(r, hi); const float di = DINV[32 * jb + j];
#pragma unroll
                for (int s = 0; s < ML_NS; ++s) hp[(size_t)j * MW + s * 32] = (bf16_t)pk2(cacc[s][r] * di, 0.f); }
        }
    }
#undef ML_LOAD
#undef ML_GLOAD
#undef ML_GVEC
    __syncthreads();
}
DI void p5_mlstm(CArgs args, LAS unsigned char* lds, int vcu, int G, int wv) {
    constexpr int UPH = 4 / ML_NS;
    if (ML_NS == 4 && G == 4 * NB * MH) { if ((vcu & 3) == 0) { const int bh = vcu >> 2; mlstm_unit(bh / MH, bh % MH, 0, args, lds, wv); } return; }
    for (int u = vcu; u < NB * MH * UPH; u += G) { const int vs = (u % UPH) * ML_NS, bh = u / UPH; mlstm_unit(bh / MH, bh % MH, vs, args, lds, wv); }
}
#ifndef MK_ONE_LAUNCH
#define MK_ONE_LAUNCH 1
#endif
#ifndef P3SEL
#define P3SEL 31
#endif
#ifndef P1_NCU
#define P1_NCU 0
#endif
#ifndef P1_TAIL_PCT
#define P1_TAIL_PCT 17
#endif
#ifndef STAG17
#define STAG17 0
#endif
#ifndef STAG18
#define STAG18 0
#endif
constexpr int NPH = 20;
__global__ void __launch_bounds__(NWAVES * 64, 2) fwd_kernel(Args args_byval) {
    extern __shared__ __attribute__((aligned(16))) unsigned char lds_raw[];
    LAS unsigned char* lds = (LAS unsigned char*)lds_raw;
    const int wv = __builtin_amdgcn_readfirstlane((int)(threadIdx.x >> 6)); const int tid = wv * 64 + lane_id();
    const int G = gridDim.x; const int bx = blockIdx.x; const int vcu = (G % 8 == 0) ? (bx % 8) * (G / 8) + bx / 8 : bx;
    const CArgs args0 = (CArgs)__builtin_amdgcn_kernarg_segment_ptr(); (void)args_byval;
#define args launder_args(args0)
    unsigned char* ws = args->ws;
    for (int u = tid; u < (LDS_BYTES - LDSCTL_OFF) / 4; u += NWAVES * 64) ((LAS unsigned*)(lds + LDSCTL_OFF))[u] = 0u;
    __syncthreads();
    volatile LAS unsigned* MISC = (volatile LAS unsigned*)(lds + MISC_OFF);
    XcdBarrier bar; bar.bar = (unsigned*)(ws + WS_CTL) + CW_BAR; bar.x = 0; bar.st = nullptr;
    const int lo = args->ph_lo, hi = args->ph_hi;
    if (hi - lo > 1) bar = xcd_barrier_post((unsigned*)(ws + WS_CTL) + CW_BAR, MISC + 8, wv);
#ifndef PHASE_MASK
#define PHASE_MASK 0xFFFFFu
#endif
#define IN(k) (((PHASE_MASK >> (k)) & 1u) && lo <= (k) && (k) < hi)
#ifndef DUP_PHASE
#define DUP_PHASE -1
#endif
#define REP(k) _Pragma("unroll 1") for (int rep_ = 0; rep_ < ((DUP_PHASE == (k)) ? 2 : 1); ++rep_)
#ifdef DUPBAR
#define SEAM(k) do { if (IN(k) && IN(NEXTPH(k))) { xcd_barrier(bar, wv); xcd_barrier(bar, wv); } } while (0)
#else
#define SEAM(k) do { if (IN(k) && IN(NEXTPH(k))) xcd_barrier(bar, wv); } while (0)
#endif
#define NEXTPH(k) (((k) == 7 || (k) == 12) ? (k) + 2 : ((k) == 14) ? 17 : (k) + 1)
    using namespace pg8;
    LAS unsigned char* ring = lds + RING_OFF;
    const bf16_t* cws = (const bf16_t*)ws;
#define WSB(off) ((bf16_t*)(ws + (off)))
#define WSF(off) ((float*)(ws + (off)))

    const int nconv = G / 4;
    if (IN(0)) REP(0) { p0_prologue<false>(args, lds, vcu * NWAVES + wv, G * NWAVES, wv); }
    SEAM(0);
    if (IN(1)) REP(1) {
#if P1_FP8
        constexpr int XW_ITEMS = NE * 8 * 96, XW_TAIL = (XW_ITEMS * P1_TAIL_PCT / 100) / 1024 * 1024;
        if (bx >= G - nconv) { p0_prologue<true>(args, lds, (bx - (G - nconv)) * NWAVES + wv, nconv * NWAVES, wv, 0, XW_ITEMS - XW_TAIL, true); __syncthreads(); }
        else { DenseOrder S; S.init(WSB(WS_XB), WSB(WS_W_IN), T, P1_NBF, D, D, G - nconv, bx); EpiProj E{WSB(WS_PROJ), WSF(WS_GATES), nullptr, nullptr, 0, 1.0f}; gemm_phase(ring, wv, D, D, D, S, E); }
        { P1Order S; S.proj.init(ws + WS_X8, ws + WS_W_IN8, T, NPROJ - P1_NBF, D, D, G, bx, 1); S.esz = 1; S.memb = (const char*)(ws + WS_MEMB); S.wck = (const char*)(ws + WS_W_CK); S.wcv = (const char*)(ws + WS_W_CV); S.G = G; S.c = bx; S.nconv = nconv; S.ncu = P1_NCU;
          EpiProj E{WSB(WS_PROJ), WSF(WS_GATES), WSB(WS_KC), WSB(WS_VCT), P1_NBF, 1.0f / (F8_XS * F8_WS)}; gemm_phase<EpiProj, P1Order, true>(ring, wv, D, D, D, S, E); }
        { const int ntail = (P1_NCU == 0 && XW_TAIL > 0) ? (G - nconv) - ((NPROJ - P1_NBF) / 256 * (T / 256) + 128) % (G - nconv) : 0, first = (G - nconv) - ntail;
          if (ntail > 0 && bx >= first && bx < G - nconv) { __syncthreads(); p0_prologue<true>(args, lds, (bx - first) * NWAVES + wv, ntail * NWAVES, wv, XW_ITEMS - XW_TAIL, XW_ITEMS, false); __syncthreads(); } }
#else
        { P1Order S; S.proj.init(WSB(WS_XB), WSB(WS_W_IN), T, NPROJ, D, D, G, bx, 2); S.esz = 2; S.memb = (const char*)(ws + WS_MEMB); S.wck = (const char*)(ws + WS_W_CK); S.wcv = (const char*)(ws + WS_W_CV); S.G = G; S.c = bx; S.nconv = 0; S.ncu = 0;
          EpiProj E{WSB(WS_PROJ), WSF(WS_GATES), WSB(WS_KC), WSB(WS_VCT), 0, 1.0f}; gemm_phase(ring, wv, D, D, D, S, E); }
#endif
    }
    SEAM(1);
    if (IN(2)) REP(2) { p2_tokens(args, vcu, G, wv); }
    SEAM(2);
    if (IN(3)) REP(3) {
        if (P3SEL & 1) { DenseOrder S; S.init(WSB(WS_QN), WSB(WS_W_UQ), T, AH * AQK, 256, 256, G, bx); EpiQmla E{WSB(WS_QMLA), WSF(WS_CS), 0.10206207261596575f * 1.4426950408889634f}; gemm_phase(ring, wv, 256, 256, 256, S, E); }
        if (P3SEL & 2) { DenseOrder S; S.init(WSB(WS_KVN), WSB(WS_W_UK), T, 512, 256, 256, G, bx); EpiBf16 E{WSB(WS_KN), 512, 1 << 30, 1.f}; gemm_phase(ring, wv, 128, 256, 256, S, E); }
        if (P3SEL & 4) { DenseOrder S; S.init(WSB(WS_W_UV), WSB(WS_KVN), 512, T, 256, 256, G, bx); EpiBf16 E{WSB(WS_VT), T, 1 << 30, 1.f}; gemm_phase(ring, wv, 128, 256, 256, S, E); }
        if (P3SEL & 8) { PairOrderA S{(const char*)(ws + WS_XC), (const char*)(ws + WS_W_MQK), G, vcu}; EpiBf16 E{WSB(WS_QKM), 1024, 2, 0.08838834764831845f}; gemm_phase(ring, wv, 256, 512, 256, S, E); }
        if (P3SEL & 16) { PairOrderB S{(const char*)(ws + WS_W_MQK) + (size_t)512 * 256 * 2, (const char*)(ws + WS_XC), G, vcu}; EpiBf16 E{WSB(WS_KTM), T, 0, 0.08838834764831845f}; gemm_phase(ring, wv, 256, 256, 512, S, E); }
    }
    SEAM(3);
    if (IN(4)) { REP(40) { p5_mlstm(args, lds, vcu, G, wv); } REP(41) { p4_attention(args, lds, vcu, G, wv); } }
    SEAM(4);
    if (IN(5)) REP(5) { p6_mpost(args, vcu, G, wv); }
    SEAM(5);
    if (IN(6)) REP(6) {
        { BranchOrder S; S.d.init(ws + WS_HM, ws + WS_W_BRM, T, D, 512, 512, G, bx, P6_FP8 ? 1 : 2); S.A1 = (const char*)(ws + WS_AO); S.B1 = (const char*)(ws + WS_W_BRA); S.rounds = (S.d.nwg + G - 1) / G;
          EpiGate E{WSB(WS_GATED), WSB(WS_PROJ), PC_GM, PC_GA, P6_FP8 ? 1.0f / (F8_XS * F8_WS) : 1.0f}; gemm_phase<EpiGate, BranchOrder, P6_FP8 != 0>(ring, wv, 512, 512, 512, S, E); }
    }
    SEAM(6);
    if (IN(7)) REP(7) { DenseOrder S; S.init(WSB(WS_GATED), WSB(WS_W_MIX), T, D, D, D, G, bx); EpiResStats<false> E{WSB(WS_XB), nullptr, nullptr, nullptr, WSB(WS_V1B), WSF(WS_STATS1), (LAS f32x2*)(lds + RED_OFF), CQ_FP8 ? ws + WS_V1B8 : nullptr, 1.0f}; gemm_phase(ring, wv, D, D, D, S, E); }
    SEAM(7);
    if (IN(9)) REP(9) { DenseOrder S; S.init(CQ_FP8 ? ws + WS_V1B8 : ws + WS_V1B, ws + WS_W_CQ, T, D, D, D, G, bx, CQ_FP8 ? 1 : 2); EpiLNApplyBf16 E{WSB(WS_QC), D, WSF(WS_STATS1), WSF(CTL_CS1), WSF(CTL_CB1), 0.0625f * 1.4426950408889634f, (LAS f32x2*)(lds + RED_OFF), CQ_FP8 ? 1.0f / (F8_XS * F8_WS) : 1.0f}; gemm_phase<EpiLNApplyBf16, DenseOrder, CQ_FP8 != 0>(ring, wv, D, D, D, S, E); }
    SEAM(9);
    if (IN(10)) REP(10) { CrossSOrder S{(const char*)(ws + WS_QC), (const char*)(ws + WS_KC), G, vcu, XS_FP8 ? 1 : 2}; EpiSoftmax E{WSB(WS_PC), (LAS float*)(lds + RED_OFF), XS_FP8 ? 1.0f / (F8_WS * F8_XS) : 1.0f}; gemm_phase<EpiSoftmax, CrossSOrder, XS_FP8 != 0>(ring, wv, 256, D, D, S, E); }
    SEAM(10);
    if (IN(11)) REP(11) { CrossOOrder S{(const char*)(ws + WS_PC), (const char*)(ws + WS_VCT), G, vcu, XA_FP8 ? 1 : 2}; if (CO_FP8) { EpiF8 E{ws + WS_OC, D, F8_OS * (XA_FP8 ? 1.0f / (F8_OS * F8_XS) : 1.0f)}; gemm_phase<EpiF8, CrossOOrder, XA_FP8 != 0>(ring, wv, 256, D, NB * NMEM, S, E); }
        else { EpiBf16 E{WSB(WS_OC), D, 0, XA_FP8 ? 1.0f / (F8_OS * F8_XS) : 1.0f}; gemm_phase<EpiBf16, CrossOOrder, XA_FP8 != 0>(ring, wv, 256, D, NB * NMEM, S, E); } }
    SEAM(11);
    if (IN(12)) REP(12) { { LAS float* gb = (LAS float*)(lds + GB_OFF); const int t_ = wv * 64 + lane_id(); const float* g1 = (const float*)args->in[19]; const float* b1 = (const float*)args->in[20];
          for (int i = t_; i < 1024; i += NWAVES * 64) { gb[i] = g1[i]; gb[1024 + i] = b1[i]; } __syncthreads(); }
        DenseOrder S; S.init(ws + WS_OC, ws + WS_W_CO, T, D, D, D, G, bx, CO_FP8 ? 1 : 2); EpiResStats<true> E{WSB(WS_V1B), WSF(WS_STATS1), (const float*)args->in[19], (const float*)args->in[20], WSB(WS_V2B), WSF(WS_STATS2), (LAS f32x2*)(lds + RED_OFF), nullptr, CO_FP8 ? 1.0f / (F8_OS * F8_WS) : 1.0f}; gemm_phase<EpiResStats<true>, DenseOrder, CO_FP8 != 0>(ring, wv, D, D, D, S, E); }
    SEAM(12);
    if (IN(14)) REP(14) { p14_router(args, lds, vcu, G, wv); }
    SEAM(14);
    if (IN(17)) REP(17) { build_tstart(args, lds, wv);
        LAS unsigned short* tab = (LAS unsigned short*)(lds + GB_OFF);
        { const unsigned short* rowtok = (const unsigned short*)(ws + WS_ROWTOK); const int total = ((const LAS int*)(lds + TST_OFF))[NE] * 8; const int t_ = wv * 64 + lane_id();
          const LAS int* tst_ = (const LAS int*)(lds + TST_OFF); const LAS int* tile_e_ = (const LAS int*)(lds + TILE_E_OFF); const unsigned* gcnt_ = (const unsigned*)(ws + WS_CTL) + CW_CNT;
          for (int i = 0; i * G + vcu < total && i < 26; ++i) { const int tile = (i * G + vcu) >> 3; const int e = tile_e_[tile]; const int r = (tile - tst_[e]) * 256 + t_;
              if (t_ < 256) tab[i * 256 + t_] = (r < (int)__hip_atomic_load(gcnt_ + e * CNT_STRIDE, RLX_AGENT)) ? rowtok[(size_t)e * RCAP + r] : (unsigned short)0; }
          __syncthreads(); }
        MoeOrder S{(const char*)(ws + WS_XG), (const char*)(ws + WS_W_GU), (const LAS int*)(lds + TST_OFF), (const LAS int*)(lds + TILE_E_OFF), 8, G, vcu, (size_t)0, (size_t)2048 * 1024, (size_t)256 * 1024, tab};
        EpiSwiglu E{ws + WS_ACT, (const float*)args->in[29]}; gemm_phase<EpiSwiglu, MoeOrder, true, STAG17, true>(ring, wv, D, D, D, S, E); }
    SEAM(17);
    if (IN(18)) REP(18) { build_tstart(args, lds, wv);
        MoeOrder S{(const char*)(ws + WS_ACT), (const char*)(ws + WS_W_DN), (const LAS int*)(lds + TST_OFF), (const LAS int*)(lds + TILE_E_OFF), 4, G, vcu, (size_t)256 * D, (size_t)1024 * 1024, (size_t)256 * 1024};
        EpiDown E{ws + WS_YB, (const float*)args->in[31], WSF(WS_ROWGATE)}; gemm_phase<EpiDown, MoeOrder, true, STAG18>(ring, wv, D, D, D, S, E); }
    SEAM(18);
    if (IN(19)) REP(19) { p20_final(args, lds, vcu, G, wv); }
    (void)cws;
#undef IN
#undef SEAM
#undef args
}

extern "C" void kernel_launch(void* const* d_in, const int* in_sizes, int n_in, void* d_out, int out_size, void* d_ws, size_t ws_size, hipStream_t stream) {
    static int grid = 0;
    if (grid == 0) {
        if (n_in != 34 || in_sizes[0] != T * D || out_size != T * D || ws_size < WS_END) { fprintf(stderr, "kernel_launch: unexpected shapes / workspace (n_in %d, ws %zu)\n", n_in, ws_size); grid = -1; return; }
        int dev = 0, cus = 0, per_cu = 0;
        if (hipGetDevice(&dev) != hipSuccess || hipDeviceGetAttribute(&cus, hipDeviceAttributeMultiprocessorCount, dev) != hipSuccess) { grid = -1; return; }
        if (hipFuncSetAttribute((const void*)fwd_kernel, hipFuncAttributeMaxDynamicSharedMemorySize, LDS_BYTES) != hipSuccess) { fprintf(stderr, "kernel_launch: hipFuncSetAttribute failed\n"); grid = -1; return; }
        if (hipOccupancyMaxActiveBlocksPerMultiprocessor(&per_cu, (const void*)fwd_kernel, NWAVES * 64, LDS_BYTES) != hipSuccess || per_cu < 1) fprintf(stderr, "kernel_launch: occupancy query says %d\n", per_cu);
        (void)hipGetLastError();
        grid = cus;
    }
    if (grid < 0) return;
    if (hipMemsetAsync((char*)d_ws + WS_CTL, 0, CTL_ZERO_BYTES, stream) != hipSuccess) return;
    Args a{};
    for (int i = 0; i < 34; ++i) a.in[i] = d_in[i];
    a.out = (float*)d_out; a.ws = (unsigned char*)d_ws;
#if MK_ONE_LAUNCH
    a.ph_lo = 0; a.ph_hi = NPH;
    hipLaunchKernelGGL(fwd_kernel, dim3(grid), dim3(NWAVES * 64), LDS_BYTES, stream, a);
#else
    for (int p = 0; p < NPH; ++p) { a.ph_lo = p; a.ph_hi = p + 1; hipLaunchKernelGGL(fwd_kernel, dim3(grid), dim3(NWAVES * 64), LDS_BYTES, stream, a); }
#endif
}
```

```cpp
#include <hip/hip_runtime.h>
#include <cstdio>
#include <cstdint>
#include <cmath>

#ifndef P1_FP8
#define P1_FP8 1
#endif
#ifndef P6_FP8
#define P6_FP8 1
#endif
#ifndef XA_FP8
#define XA_FP8 1
#endif
#ifndef XS_FP8
#define XS_FP8 1
#endif
#ifndef CO_FP8
#define CO_FP8 1
#endif
#ifndef CQ_FP8
#define CQ_FP8 0
#endif
#define LAS __attribute__((address_space(3)))
#define GAS __attribute__((address_space(1)))
typedef unsigned short bf16_t;
typedef short bf16x8 __attribute__((ext_vector_type(8)));
typedef float f32x4 __attribute__((ext_vector_type(4)));
typedef float f32x2 __attribute__((ext_vector_type(2)));
typedef float f32x16 __attribute__((ext_vector_type(16)));
typedef unsigned u32x4 __attribute__((ext_vector_type(4)));
typedef unsigned u32x2 __attribute__((ext_vector_type(2)));
typedef GAS unsigned gu32;
#define RLX_AGENT __ATOMIC_RELAXED, __HIP_MEMORY_SCOPE_AGENT
#define DI __device__ __forceinline__

constexpr int D = 1024, NB = 16, SEQ = 2048, T = NB * SEQ, NMEM = 256;
constexpr int MH = 4, MHD = 128, MW = 512, MCH = 64;
constexpr int AH = 8, ANOPE = 64, AROPE = 32, AQK = 96, AVD = 64, AW = 512, AQR = 256, AKVR = 128;
constexpr int XH = 4, XHD = 256;
constexpr int NE = 32, TOPK = 4;
constexpr int DIN = 4008, NPROJ = 4096;
constexpr float DN_ALPHA = 1.189207115002721f;
constexpr float EPS = 1e-5f;
constexpr int NASSIGN = T * TOPK;
constexpr int NROWS = NASSIGN + NE * 256;
constexpr int NTILES_MAX = NROWS / 256;
constexpr int RCAP = 32768;
constexpr int PC_QLAT = 0, PC_KVLAT = 256, PC_KROPE = 384, PC_IG = 416, PC_FG = 420, PC_XM = 512, PC_VM = 1024, PC_OP = 1536, PC_GM = 2048, PC_GA = 3072;

DI unsigned f2bf(float f) { unsigned u = __builtin_bit_cast(unsigned, f); return (u + 0x7fffu + ((u >> 16) & 1u)) >> 16; }
typedef __bf16 bf16x2_hw __attribute__((ext_vector_type(2)));
DI unsigned pk2(float lo, float hi) { const f32x2 v = {lo, hi}; return __builtin_bit_cast(unsigned, __builtin_convertvector(v, bf16x2_hw)); }
DI float bf2f(unsigned short b) { return __builtin_bit_cast(float, (unsigned)b << 16); }
DI float bflo(unsigned w) { return __builtin_bit_cast(float, w << 16); }
DI float bfhi(unsigned w) { return __builtin_bit_cast(float, w & 0xffff0000u); }
DI float wave_sum(float v) {
#pragma unroll
    for (int o = 1; o < 64; o <<= 1) v += __shfl_xor(v, o);
    return v;
}
DI float wave_max(float v) {
#pragma unroll
    for (int o = 1; o < 64; o <<= 1) v = fmaxf(v, __shfl_xor(v, o));
    return v;
}
DI float rcpf_(float x) { return __builtin_amdgcn_rcpf(x); }
DI float sigmoidf_(float x) { return __builtin_amdgcn_rcpf(1.0f + __builtin_amdgcn_exp2f(-1.4426950408889634f * x)); }
DI int lane_id() { int l; asm volatile("v_mbcnt_lo_u32_b32 %0, -1, 0\n\tv_mbcnt_hi_u32_b32 %0, -1, %0" : "=v"(l)); return l; }
DI float swz_xor1(float v) { return __shfl_xor(v, 1); }
DI float swz_xor16(float v) { return __shfl_xor(v, 16); }
DI float sum_xor32(float v) { return v + __shfl_xor(v, 32); }
DI float max_xor32(float v) { return fmaxf(v, __shfl_xor(v, 32)); }
DI int crow(int r, int hi) { return (r & 3) + 8 * (r >> 2) + 4 * hi; }
#define MFMA32(a, b, c) __builtin_amdgcn_mfma_f32_32x32x16_bf16((a), (b), (c), 0, 0, 0)

namespace pg8 {
constexpr int BM = 256, BK = 64, HALF = 128, HTB = HALF * BK * 2, STAGE_BYTES = 8 * HTB;
__host__ __device__ __forceinline__ int lds_byte(int r, int c) { const int st = (r >> 4) * 2 + (c >> 5), rr = r & 15, cc = c & 31, ob = rr * 64 + cc * 2; return st * 1024 + (ob ^ (((ob >> 9) & 1) << 5)); }
__host__ __device__ __forceinline__ void stage_rc(int b, int& R, int& C) { const int st = b / 1024, sb = b % 1024, swz = sb ^ (((sb >> 9) & 1) << 5); R = (st >> 1) * 16 + swz / 64; C = (st & 1) * 32 + (swz % 64) / 2; }
__host__ __device__ __forceinline__ int perm32(int rho) { const int n = rho >> 4, i = rho & 15; return 8 * (i >> 2) + 4 * n + (i & 3); }

struct Unit { int pm, pn, aux; const char* a; const char* b; int gr = 0; };
struct Ctx { int wr, wc, fr, fq, wid, lane; };

DI unsigned cvt_pk_bf16(float lo, float hi) { unsigned r; asm volatile("v_cvt_pk_bf16_f32 %0, %1, %2" : "=v"(r) : "v"(lo), "v"(hi)); return r; }

typedef f32x4 Acc[2][2][4][2];

DI void glds16_s(const char* gbase, unsigned voff, unsigned lds_dst) { unsigned keep;
    asm volatile("s_mov_b32 %0, m0\n\ts_mov_b32 m0, %1\n\ts_nop 0\n\tglobal_load_lds_dwordx4 %2, %3\n\ts_mov_b32 m0, %0" : "=&s"(keep) : "s"(lds_dst), "v"(voff), "s"(gbase) : "memory"); }
typedef int v8i_t __attribute__((ext_vector_type(8)));
typedef int i32x4_t __attribute__((ext_vector_type(4)));
template <class E, class = void> struct Wide16T { static constexpr bool v = false; };
template <class E> struct Wide16T<E, decltype((void)E::WIDE16)> { static constexpr bool v = E::WIDE16; };
template <class E> constexpr bool epi_wide16() { return Wide16T<E>::v; }
template <class E, class = void> struct GluT { static constexpr bool v = false; };
template <class E> struct GluT<E, decltype((void)E::GLU)> { static constexpr bool v = E::GLU; };
template <class E> constexpr bool epi_glu() { return GluT<E>::v; }
template <class E, class = void> struct VmMinT { static constexpr int v = 0; };
template <class E> struct VmMinT<E, decltype((void)E::VM_MIN)> { static constexpr int v = E::VM_MIN; };
template <int N> DI void wait_vm() { asm volatile("s_waitcnt vmcnt(%0)" :: "n"(N) : "memory"); }
template <int N> DI void wait_vm_sel(int relax) { asm volatile("s_cmp_lg_u32 %0, 0\n\ts_cbranch_scc0 .Lw8_%=\n\ts_waitcnt vmcnt(%1)\n\ts_branch .Lwe_%=\n.Lw8_%=:\n\ts_waitcnt vmcnt(8)\n.Lwe_%=:" :: "s"(relax), "n"(N) : "memory", "scc"); }
template <class Epi, class Sched, bool FP8 = false, int STAG = 0, bool GATHER = false>
DI void gemm_phase(LAS unsigned char* lds, const int wv, const int K, const int lda, const int ldb, const Sched& S, const Epi& E) {
    if constexpr (STAG > 0) {
        const unsigned long long t0_ = __builtin_amdgcn_s_memrealtime(); const unsigned long long d_ = (unsigned long long)((blockIdx.x >> 3) & 3) * STAG;
        while (__builtin_amdgcn_s_memrealtime() - t0_ < d_) __builtin_amdgcn_s_sleep(8);
    }
    int tid = wv * 64 + lane_id(); asm volatile("" : "+v"(tid));
    const int wid = wv, lane = tid & 63, wr = wid >> 2, wc = wid & 3, fr = lane & 15, fq = lane >> 4;
    constexpr int ESZ = FP8 ? 1 : 2;
    int nt = K * ESZ / (BK * 2); asm volatile("" : "+s"(nt));
    unsigned voffA[2], voffB[2]; unsigned cbyte = 0; const LAS unsigned char* tcur = nullptr;
    if constexpr (GATHER) { int R, C; stage_rc(tid * 16, R, C); cbyte = (unsigned)(C * 2); tcur = (const LAS unsigned char*)S.tab + R * 2; }
#pragma unroll
    for (int i = 0; i < 2; ++i) { int R, C; stage_rc(tid * 16 + i * 8192, R, C); const int p32 = perm32(R & 31);
        const int Rb = Epi::PERM ? (epi_glu<Epi>() ? (64 * (R >> 5) + 16 * (p32 >> 3) + 2 * (p32 & 3) + ((p32 >> 2) & 1)) : epi_wide16<Epi>() ? (64 * (R >> 5) + 16 * (p32 >> 3) + (p32 & 7)) : ((R & ~31) + p32)) : R;
        voffA[i] = (unsigned)(R * lda * ESZ + C * 2); voffB[i] = (unsigned)(Rb * ldb * ESZ + C * 2); }
    const size_t kstep = (size_t)(BK * 2);
    const size_t hstepA = (size_t)HALF * lda * ESZ, hstepB = (size_t)(epi_wide16<Epi>() ? 8 : HALF) * ldb * ESZ;
    const unsigned ldsw = (unsigned)wid * 1024u;
    const int aoff = lds_byte(wr * 64 + fr, fq * 8), boff = lds_byte(wc * 32 + fr, fq * 8);
    const Ctx cx{wr, wc, fr, fq, wid, lane};
    const unsigned lds_u = (unsigned)__builtin_amdgcn_readfirstlane((int)((unsigned)(size_t)lds + ldsw));
    LAS unsigned char* ldsB = lds + 4 * HTB + boff;
#define PG8_SA(b, h) (((b) * 2 + (h)) * HTB)
#define PG8_SB(b, h) ((4 + (b) * 2 + (h)) * HTB)
#define PG8_SBL(b, h) (((b) * 2 + (h)) * HTB)
#define PG8_STAGE(bufoff, gbase, voff) do { _Pragma("unroll") for (int _i = 0; _i < 2; ++_i) \
        glds16_s((const char*)(gbase), (voff)[_i], lds_u + (unsigned)((bufoff) + _i * 8192)); } while (0)
#define PG8_STAGE_A(bufoff, half, gbase, tb) do { if constexpr (GATHER) { _Pragma("unroll") for (int _i = 0; _i < 2; ++_i) { const unsigned tk_ = *(const LAS unsigned short*)((tb) + (half) * 256 + _i * 128); \
        glds16_s((const char*)(gbase), tk_ * 1024u + cbyte, lds_u + (unsigned)((bufoff) + _i * 8192)); } } else { PG8_STAGE(bufoff, (gbase) + (half) * hstepA, voffA); } } while (0)
#define PG8_RD(off) (*(const LAS i32x4_t*)(lds + (off)))
#define PG8_CAT2(x, y) __builtin_shufflevector((x), (y), 0, 1, 2, 3, 4, 5, 6, 7)
#define PG8_LDA(dst, b, h) do { if constexpr (FP8) { _Pragma("unroll") for (int m = 0; m < 4; ++m) dst##8[m] = PG8_CAT2(PG8_RD(PG8_SA(b, h) + aoff + m * 2048), PG8_RD(PG8_SA(b, h) + aoff + m * 2048 + 1024)); } \
        else { _Pragma("unroll") for (int m = 0; m < 4; ++m) _Pragma("unroll") for (int k = 0; k < 2; ++k) dst[m][k] = *(const LAS bf16x8*)(lds + PG8_SA(b, h) + aoff + m * 2048 + k * 1024); } } while (0)
#define PG8_LDB(dst, b, h) do { if constexpr (FP8) { _Pragma("unroll") for (int n = 0; n < 2; ++n) dst##8[n] = PG8_CAT2(*(const LAS i32x4_t*)(ldsB + PG8_SBL(b, h) + n * 2048), *(const LAS i32x4_t*)(ldsB + PG8_SBL(b, h) + n * 2048 + 1024)); } \
        else { _Pragma("unroll") for (int n = 0; n < 2; ++n) _Pragma("unroll") for (int k = 0; k < 2; ++k) dst[n][k] = *(const LAS bf16x8*)(ldsB + PG8_SBL(b, h) + n * 2048 + k * 1024); } } while (0)
#define PG8_MMA(ai, bj, At, Bt) do { __builtin_amdgcn_s_setprio(1); \
        if constexpr (FP8) { _Pragma("unroll") for (int m = 0; m < 4; ++m) _Pragma("unroll") for (int n = 0; n < 2; ++n) \
            acc[ai][bj][m][n] = __builtin_amdgcn_mfma_scale_f32_16x16x128_f8f6f4(Bt##8[n], At##8[m], acc[ai][bj][m][n], 0, 0, 0, 0x7f7f7f7f, 0, 0x7f7f7f7f); } \
        else { _Pragma("unroll") for (int m = 0; m < 4; ++m) _Pragma("unroll") for (int n = 0; n < 2; ++n) _Pragma("unroll") for (int k = 0; k < 2; ++k) \
            acc[ai][bj][m][n] = __builtin_amdgcn_mfma_f32_16x16x32_bf16(Bt[n][k], At[m][k], acc[ai][bj][m][n], 0, 0, 0); } \
        __builtin_amdgcn_s_setprio(0); } while (0)
#define PG8_WAIT_V(n) asm volatile("s_waitcnt vmcnt(" #n ")" ::: "memory")
#define PG8_WAIT_L(n) asm volatile("s_waitcnt lgkmcnt(" #n ")" ::: "memory")
#define PG8_BAR __builtin_amdgcn_s_barrier()
#define PG8_SCHED __builtin_amdgcn_sched_barrier(0)
    Unit cur, nxt; int ui = 0;
    if (!S.next(0, cur)) return;
    Acc acc;
#pragma unroll
    for (int a = 0; a < 2; ++a)
#pragma unroll
        for (int b = 0; b < 2; ++b)
#pragma unroll
            for (int m = 0; m < 4; ++m)
#pragma unroll
                for (int n = 0; n < 2; ++n) acc[a][b][m][n] = (f32x4){0.f, 0.f, 0.f, 0.f};
    bf16x8 At[4][2], B0[2][2], B1[2][2]; v8i_t At8[4], B08[2], B18[2];
    const char* cA = cur.a; const char* cB = cur.b;
    PG8_STAGE(PG8_SB(0, 0), cB, voffB); PG8_STAGE(PG8_SB(0, 1), cB + hstepB, voffB); PG8_STAGE_A(PG8_SA(0, 0), 0, cA, tcur); PG8_STAGE_A(PG8_SA(0, 1), 1, cA, tcur);
    if (wr == 1) PG8_BAR;
    PG8_WAIT_V(2); PG8_BAR;
    PG8_STAGE(PG8_SB(1, 0), cB + kstep, voffB); PG8_STAGE_A(PG8_SA(1, 0), 0, cA + kstep, tcur); PG8_STAGE(PG8_SB(1, 1), cB + hstepB + kstep, voffB);
    PG8_WAIT_V(6); PG8_BAR;
    for (;;) {
        const bool has_next = S.next(ui + 1, nxt);
        const char* nA = has_next ? nxt.a : cA; const char* nB = has_next ? nxt.b : cB;
#pragma unroll 1
        for (int t = 0; t < nt; t += 2) {
            const bool last = (t == nt - 2);
            const char* a1 = cA + (size_t)(t + 1) * kstep;
            const char* a2 = last ? nA : cA + (size_t)(t + 2) * kstep; const char* b2 = last ? nB : cB + (size_t)(t + 2) * kstep;
            const char* a3 = a2 + kstep; const char* b3 = b2 + kstep;
            const LAS unsigned char* t2 = tcur + ((GATHER && last && has_next) ? 512 : 0);
            PG8_LDB(B0, 0, 0); PG8_LDB(B1, 0, 1); PG8_SCHED; PG8_LDA(At, 0, 0); PG8_STAGE_A(PG8_SA(1, 1), 1, a1, tcur);
            PG8_WAIT_V(8); PG8_WAIT_L(0); PG8_BAR; PG8_MMA(0, 0, At, B0); PG8_MMA(0, 1, At, B1); PG8_BAR; PG8_SCHED;
            PG8_LDA(At, 0, 1); PG8_STAGE(PG8_SB(0, 0), b2, voffB); PG8_STAGE(PG8_SB(0, 1), b2 + hstepB, voffB); PG8_STAGE_A(PG8_SA(0, 0), 0, a2, t2);
            PG8_WAIT_V(8); PG8_WAIT_L(0); PG8_BAR; PG8_MMA(1, 0, At, B0); PG8_MMA(1, 1, At, B1); PG8_BAR; PG8_SCHED;
            PG8_LDB(B0, 1, 0); PG8_LDB(B1, 1, 1); PG8_SCHED; PG8_LDA(At, 1, 0); PG8_STAGE_A(PG8_SA(0, 1), 1, a2, t2);
            PG8_WAIT_V(8); PG8_WAIT_L(0); PG8_BAR; PG8_MMA(0, 0, At, B0); PG8_MMA(0, 1, At, B1); PG8_BAR; PG8_SCHED;
            PG8_LDA(At, 1, 1); PG8_STAGE(PG8_SB(1, 0), b3, voffB); PG8_STAGE(PG8_SB(1, 1), b3 + hstepB, voffB); PG8_STAGE_A(PG8_SA(1, 0), 0, a3, t2);
            PG8_WAIT_V(8); PG8_WAIT_L(0); PG8_BAR; PG8_MMA(1, 0, At, B0); PG8_MMA(1, 1, At, B1); PG8_BAR; PG8_SCHED;
        }
        if (wr == 0) PG8_BAR;
        E(acc, cur, cx);
#ifdef DUP_EPI
        if constexpr (FP8) E(acc, cur, cx);
#endif
        if (!has_next) break;
#pragma unroll
        for (int a = 0; a < 2; ++a)
#pragma unroll
            for (int b = 0; b < 2; ++b)
#pragma unroll
                for (int m = 0; m < 4; ++m)
#pragma unroll
                    for (int n = 0; n < 2; ++n) acc[a][b][m][n] = (f32x4){0.f, 0.f, 0.f, 0.f};
        cur = nxt; cA = nA; cB = nB; ++ui; if constexpr (GATHER) tcur += 512;
        if (wr == 1) PG8_BAR;
    }
    PG8_WAIT_V(0);
    PG8_BAR;
#undef PG8_SA
#undef PG8_SB
#undef PG8_SBL
#undef PG8_STAGE
#undef PG8_STAGE_A
#undef PG8_LDA
#undef PG8_LDB
#undef PG8_MMA
#undef PG8_CAT2
#undef PG8_RD
#undef PG8_WAIT_V
#undef PG8_WAIT_L
#undef PG8_BAR
#undef PG8_SCHED
}
}
namespace pg8 {
constexpr int NXCD = 8, WGM = 8;
struct DenseOrder {
    const char* A; const char* B; int nM, nN, nwg, G, c; size_t strideA, strideB;
    DI void init(const void* A_, const void* B_, int M, int N, int lda, int ldb, int G_, int c_, int esz = 2) { A = (const char*)A_; B = (const char*)B_; nM = M / BM; nN = N / BM; nwg = nM * nN; G = G_; c = c_;
        strideA = (size_t)BM * lda * esz; strideB = (size_t)BM * ldb * esz; }
    DI void unit_at(int wgid, Unit& u) const {
        { const int q = nwg / NXCD, r = nwg % NXCD, xcd = wgid % NXCD, off = wgid / NXCD; wgid = (xcd < r ? xcd * (q + 1) : r * (q + 1) + (xcd - r) * q) + off; }
        const int nig = WGM * nN, gid = wgid / nig, fm = gid * WGM, gsz = (nM - fm) < WGM ? (nM - fm) : WGM;
        u.pm = fm + ((wgid % nig) % gsz); u.pn = (wgid % nig) / gsz; u.aux = 0;
        u.a = A + (size_t)u.pm * strideA; u.b = B + (size_t)u.pn * strideB;
    }
    DI bool next(int i, Unit& u) const {
        const long L = (long)i * G + c; if (L >= nwg) return false;
        unit_at((int)L, u); return true;
    }
};
struct P1Order {
    DenseOrder proj; const char* memb; const char* wck; const char* wcv; int G, c, esz, nconv, ncu;
    DI bool next(int i, Unit& u) const {
        const int total = proj.nwg + 128, tail = nconv * ncu; int L;
        if (c >= G - nconv) { if (i >= ncu) return false; L = total - tail + i * nconv + (c - (G - nconv)); }
        else { L = i * (G - nconv) + c; if (L >= total - tail) return false; }
        if (L < proj.nwg) { proj.unit_at(L, u); return true; }
        L -= proj.nwg;
        const int kind = L >> 6, r = L & 63;
        if (kind == 0) { u.pm = r >> 2; u.pn = r & 3; u.aux = 1; u.a = memb + (size_t)u.pm * 256 * D * esz; u.b = wck + (size_t)u.pn * 256 * D * esz; }
        else { u.pm = r >> 4; u.pn = r & 15; u.aux = 2; u.a = wcv + (size_t)u.pm * 256 * D * esz; u.b = memb + (size_t)u.pn * 256 * D * esz; }
        return true;
    }
};
struct PairOrderA {
    const char* A; const char* B; int G, v;
    DI bool next(int i, Unit& u) const { const int L = i * G + v; if (L >= (T / 256) * 4) return false;
        u.pm = L >> 2; u.pn = L & 3; u.aux = 0; u.a = A + ((size_t)u.pm * 256 * MW + (u.pn & 1) * 256) * 2; u.b = B + (size_t)u.pn * 256 * 256 * 2; return true; }
};
struct PairOrderB {
    const char* A; const char* B; int G, v;
    DI bool next(int i, Unit& u) const { const int L = i * G + v; if (L >= 2 * (T / 256)) return false;
        u.pm = L & 1; u.pn = L >> 1; u.aux = 0; u.a = A + (size_t)u.pm * 256 * 256 * 2; u.b = B + ((size_t)u.pn * 256 * MW + u.pm * 256) * 2; return true; }
};
struct BranchOrder {
    DenseOrder d; const char* A1; const char* B1; int rounds;
    DI bool next(int i, Unit& u) const {
        const int kind = (i >= rounds) ? 1 : 0;
        if (!d.next(i - kind * rounds, u)) return false;
        if (kind) { u.a = A1 + (size_t)u.pm * d.strideA; u.b = B1 + (size_t)u.pn * d.strideB; u.aux = 1; }
        return true;
    }
};
struct CrossSOrder {
    const char* Q; const char* Kc; int G, v, esz;
    DI bool next(int i, Unit& u) const {
        const int L = i * G + v; if (L >= (T / 256) * XH) return false;
        u.pm = L >> 2; u.pn = L & 3; u.aux = 0;
        u.a = Q + ((size_t)u.pm * 256 * D + u.pn * 256) * esz; u.b = Kc + ((size_t)(u.pm >> 3) * 256 * D + u.pn * 256) * esz; return true;
    }
};
struct CrossOOrder {
    const char* P; const char* Vt; int G, v, esz;
    DI bool next(int i, Unit& u) const {
        const int L = i * G + v; if (L >= (T / 256) * XH) return false;
        u.pm = L >> 2; u.pn = L & 3; u.aux = 0;
        u.a = P + ((size_t)u.pm * 256 * D + u.pn * 256) * esz; u.b = Vt + ((size_t)u.pn * 256 * (NB * NMEM) + (size_t)(u.pm >> 3) * 256) * esz; return true;
    }
};
struct MoeOrder {
    const char* A; const char* W; const LAS int* tstart; const LAS int* tile_e; int npn, G, v; size_t strideA, strideW, strideN;
    const LAS unsigned short* tab = nullptr;
    DI bool next(int i, Unit& u) const {
        const int L = i * G + v; const int total = __builtin_amdgcn_readfirstlane(tstart[NE]) * npn; if (L >= total) return false;
        const int tile = L / npn; u.pm = tile; u.pn = L - tile * npn;
        const int e = __builtin_amdgcn_readfirstlane(tile_e[tile]);
        u.aux = e; u.gr = e * RCAP + (tile - __builtin_amdgcn_readfirstlane(tstart[e])) * 256;
        u.a = A + (size_t)tile * strideA; u.b = W + (size_t)e * strideW + (size_t)u.pn * strideN; return true;
    }
};

DI float clamp_f8(float x) { return __builtin_amdgcn_fmed3f(x, -448.0f, 448.0f); }
DI unsigned pk4_fp8(float a, float b, float c, float d) { int w = 0; w = __builtin_amdgcn_cvt_pk_fp8_f32(clamp_f8(a), clamp_f8(b), w, false); w = __builtin_amdgcn_cvt_pk_fp8_f32(clamp_f8(c), clamp_f8(d), w, true); return (unsigned)w; }
DI unsigned pk4_fp8_nc(float a, float b, float c, float d) { int w = 0; w = __builtin_amdgcn_cvt_pk_fp8_f32(a, b, w, false); w = __builtin_amdgcn_cvt_pk_fp8_f32(c, d, w, true); return (unsigned)w; }
constexpr float F8_XS = 16.0f, F8_WS = 64.0f, F8_AS = 8.0f, F8_OS = 256.0f, F8_YS = 64.0f;
#ifdef USE_NT
#define NT_STORE(p, v) __builtin_nontemporal_store((v), (p))
#else
#define NT_STORE(p, v) (*(p) = (v))
#endif
struct EpiBf16 {
    static constexpr int VM_MIN = 16;
    static constexpr bool PERM = true, WIDE16 = true;
    bf16_t* O; int ldc; int sc_from; float scale;
    DI void operator()(const Acc& acc, const Unit& u, const Ctx& c) const {
        int row0 = u.pm * BM + c.wr * 64 + c.fr, col0 = u.pn * BM + c.wc * 64 + 16 * c.fq; asm volatile("" : "+v"(row0), "+v"(col0));
        const float sc = (u.pn >= sc_from) ? scale : 1.0f;
#pragma unroll
        for (int ai = 0; ai < 2; ++ai)
#pragma unroll
            for (int m = 0; m < 4; ++m) { bf16_t* rowp = O + (size_t)(row0 + ai * HALF + m * 16) * ldc + col0;
#pragma unroll
                for (int bj = 0; bj < 2; ++bj) { const f32x4 v0 = acc[ai][bj][m][0] * sc, v1 = acc[ai][bj][m][1] * sc;
                    u32x4 w; w.x = cvt_pk_bf16(v0[0], v0[1]); w.y = cvt_pk_bf16(v0[2], v0[3]); w.z = cvt_pk_bf16(v1[0], v1[1]); w.w = cvt_pk_bf16(v1[2], v1[3]);
                    *(u32x4*)(rowp + bj * 8) = w; } }
    }
};
struct EpiF8 {
    static constexpr bool PERM = true;
    unsigned char* O; int ldc; float scale;
    DI void operator()(const Acc& acc, const Unit& u, const Ctx& c) const {
        int row0 = u.pm * BM + c.wr * 64 + c.fr, col0 = u.pn * BM + c.wc * 32 + 8 * c.fq; asm volatile("" : "+v"(row0), "+v"(col0));
#pragma unroll
        for (int ai = 0; ai < 2; ++ai)
#pragma unroll
            for (int m = 0; m < 4; ++m) { unsigned char* rowp = O + (size_t)(row0 + ai * HALF + m * 16) * ldc + col0;
#pragma unroll
                for (int bj = 0; bj < 2; ++bj) { const f32x4 v0 = acc[ai][bj][m][0] * scale, v1 = acc[ai][bj][m][1] * scale;
                    u32x2 q; q.x = pk4_fp8(v0[0], v0[1], v0[2], v0[3]); q.y = pk4_fp8(v1[0], v1[1], v1[2], v1[3]); *(u32x2*)(rowp + bj * HALF) = q; } }
    }
};
struct EpiProj {
    static constexpr int VM_MIN = 16;
    static constexpr bool PERM = true, WIDE16 = true;
    bf16_t* O; float* gates; bf16_t* Kc; bf16_t* VcT; int col_base; float us;
    DI void operator()(const Acc& acc, const Unit& u, const Ctx& c) const {
        int row0 = u.pm * BM + c.wr * 64 + c.fr, col0 = u.pn * BM + c.wc * 64 + 16 * c.fq; asm volatile("" : "+v"(row0), "+v"(col0));
        if ((XS_FP8 && u.aux == 1) || (XA_FP8 && u.aux == 2)) {
            unsigned char* base8 = (unsigned char*)((u.aux == 1) ? Kc : VcT); const int ldc8 = (u.aux == 1) ? D : NB * NMEM; const float sc = us * F8_XS;
#pragma unroll
            for (int ai = 0; ai < 2; ++ai)
#pragma unroll
                for (int m = 0; m < 4; ++m) { unsigned char* rowp = base8 + (size_t)(row0 + ai * HALF + m * 16) * ldc8 + col0;
                    u32x4 q;
#pragma unroll
                    for (int bj = 0; bj < 2; ++bj) { const f32x4 v0 = acc[ai][bj][m][0] * sc, v1 = acc[ai][bj][m][1] * sc; q[2 * bj] = pk4_fp8(v0[0], v0[1], v0[2], v0[3]); q[2 * bj + 1] = pk4_fp8(v1[0], v1[1], v1[2], v1[3]); }
                    *(u32x4*)rowp = q; }
            return; }
        bf16_t* base = (u.aux == 0) ? O + col_base : (u.aux == 1) ? Kc : VcT; const int ldc = (u.aux == 0) ? NPROJ : (u.aux == 1) ? D : NB * NMEM;
        const bool gt = (u.aux == 0 && col_base + u.pn * BM == 256 && c.wc == 2 && c.fq == 2);
#pragma unroll
        for (int ai = 0; ai < 2; ++ai)
#pragma unroll
            for (int m = 0; m < 4; ++m) { const int row = row0 + ai * HALF + m * 16; bf16_t* rowp = base + (size_t)row * ldc + col0;
#pragma unroll
                for (int bj = 0; bj < 2; ++bj) { const f32x4 v0 = acc[ai][bj][m][0] * us, v1 = acc[ai][bj][m][1] * us;
                    u32x4 w; w.x = cvt_pk_bf16(v0[0], v0[1]); w.y = cvt_pk_bf16(v0[2], v0[3]); w.z = cvt_pk_bf16(v1[0], v1[1]); w.w = cvt_pk_bf16(v1[2], v1[3]);
                    *(u32x4*)(rowp + bj * 8) = w; }
                if (gt) { *(f32x4*)(gates + (size_t)row * 8) = acc[ai][0][m][0] * us; *(f32x4*)(gates + (size_t)row * 8 + 4) = acc[ai][0][m][1] * us; } }
    }
};
struct EpiQmla {
    static constexpr int VM_MIN = 16;
    static constexpr bool PERM = true;
    bf16_t* O; const float* cs;
    float scale;
    DI void operator()(const Acc& acc, const Unit& u, const Ctx& c) const {
        int row0 = u.pm * BM + c.wr * 64 + c.fr, col0 = u.pn * BM + c.wc * 32 + 8 * c.fq; asm volatile("" : "+v"(row0), "+v"(col0));
        bool rot[2]; int p0[2];
#pragma unroll
        for (int bj = 0; bj < 2; ++bj) { const int cc = (col0 + bj * HALF) % AQK; rot[bj] = cc >= ANOPE; p0[bj] = rot[bj] ? (cc - ANOPE) >> 1 : 0; }
#pragma unroll
        for (int ai = 0; ai < 2; ++ai) {
            f32x4 t0[4][2], t1[4][2];
#pragma unroll
            for (int m = 0; m < 4; ++m)
#pragma unroll
                for (int bj = 0; bj < 2; ++bj) { const float* cp = cs + (size_t)(row0 + ai * HALF + m * 16) * 32 + p0[bj] * 2; t0[m][bj] = *(const f32x4*)cp; t1[m][bj] = *(const f32x4*)(cp + 4); }
#pragma unroll
            for (int m = 0; m < 4; ++m) { const int row = row0 + ai * HALF + m * 16; bf16_t* rowp = O + (size_t)row * (AH * AQK) + col0;
#pragma unroll
                for (int bj = 0; bj < 2; ++bj) { f32x4 v0 = acc[ai][bj][m][0] * scale, v1 = acc[ai][bj][m][1] * scale;
                    const f32x4 a0 = t0[m][bj], a1 = t1[m][bj];
                    f32x4 r0, r1;
                    r0[0] = v0[0] * a0[0] - v0[1] * a0[1]; r0[1] = v0[1] * a0[0] + v0[0] * a0[1];
                    r0[2] = v0[2] * a0[2] - v0[3] * a0[3]; r0[3] = v0[3] * a0[2] + v0[2] * a0[3];
                    r1[0] = v1[0] * a1[0] - v1[1] * a1[1]; r1[1] = v1[1] * a1[0] + v1[0] * a1[1];
                    r1[2] = v1[2] * a1[2] - v1[3] * a1[3]; r1[3] = v1[3] * a1[2] + v1[2] * a1[3];
                    if (rot[bj]) { v0 = r0; v1 = r1; }
                    u32x4 w; w.x = cvt_pk_bf16(v0[0], v0[1]); w.y = cvt_pk_bf16(v0[2], v0[3]); w.z = cvt_pk_bf16(v1[0], v1[1]); w.w = cvt_pk_bf16(v1[2], v1[3]);
                    *(u32x4*)(rowp + bj * HALF) = w; } }
            __builtin_amdgcn_sched_barrier(0); }
    }
};
struct EpiGate {
    static constexpr int VM_MIN = 32;
    static constexpr bool PERM = true, WIDE16 = true;
    bf16_t* O; const bf16_t* proj; int gcol0, gcol1; float us;
    DI void operator()(const Acc& acc, const Unit& u, const Ctx& c) const {
        int row0 = u.pm * BM + c.wr * 64 + c.fr, col0 = u.pn * BM + c.wc * 64 + 16 * c.fq; asm volatile("" : "+v"(row0), "+v"(col0));
        const bool ADD = (u.aux != 0); const int gcol = ADD ? gcol1 : gcol0;
#pragma unroll
        for (int ai = 0; ai < 2; ++ai) {
            u32x4 gg[4][2], pp[4][2];
#pragma unroll
            for (int m = 0; m < 4; ++m)
#pragma unroll
                for (int bj = 0; bj < 2; ++bj) { const int row = row0 + ai * HALF + m * 16; gg[m][bj] = *(const u32x4*)(proj + (size_t)row * NPROJ + gcol + col0 + bj * 8);
                    pp[m][bj] = (u32x4){0u, 0u, 0u, 0u}; if (ADD) pp[m][bj] = *(const u32x4*)(O + (size_t)row * D + col0 + bj * 8); }
#pragma unroll
            for (int m = 0; m < 4; ++m) { const int row = row0 + ai * HALF + m * 16; bf16_t* rowp = O + (size_t)row * D + col0;
#pragma unroll
                for (int bj = 0; bj < 2; ++bj) { const f32x4 v0 = acc[ai][bj][m][0] * us, v1 = acc[ai][bj][m][1] * us;
                    const u32x4 g = gg[m][bj], p = pp[m][bj];
                    float o[8];
                    o[0] = sigmoidf_(bflo(g.x)) * v0[0] + bflo(p.x); o[1] = sigmoidf_(bfhi(g.x)) * v0[1] + bfhi(p.x); o[2] = sigmoidf_(bflo(g.y)) * v0[2] + bflo(p.y); o[3] = sigmoidf_(bfhi(g.y)) * v0[3] + bfhi(p.y);
                    o[4] = sigmoidf_(bflo(g.z)) * v1[0] + bflo(p.z); o[5] = sigmoidf_(bfhi(g.z)) * v1[1] + bfhi(p.z); o[6] = sigmoidf_(bflo(g.w)) * v1[2] + bflo(p.w); o[7] = sigmoidf_(bfhi(g.w)) * v1[3] + bfhi(p.w);
                    u32x4 w; w.x = cvt_pk_bf16(o[0], o[1]); w.y = cvt_pk_bf16(o[2], o[3]); w.z = cvt_pk_bf16(o[4], o[5]); w.w = cvt_pk_bf16(o[6], o[7]);
                    *(u32x4*)(rowp + bj * 8) = w; } }
            __builtin_amdgcn_sched_barrier(0); }
    }
};
struct EpiF32 {
    static constexpr bool PERM = false;
    float* C; int ldc; int ncols_valid;
    DI void operator()(const Acc& acc, const Unit& u, const Ctx& c) const {
        int row0 = u.pm * BM + c.wr * 64 + c.fr, col0 = u.pn * BM + c.wc * 32 + 4 * c.fq; asm volatile("" : "+v"(row0), "+v"(col0));
#pragma unroll
        for (int ai = 0; ai < 2; ++ai)
#pragma unroll
            for (int m = 0; m < 4; ++m) { float* rowp = C + (size_t)(row0 + ai * HALF + m * 16) * ldc + col0;
#pragma unroll
                for (int bj = 0; bj < 2; ++bj)
#pragma unroll
                    for (int n = 0; n < 2; ++n) if (col0 + bj * HALF + n * 16 < ncols_valid) *(f32x4*)(rowp + bj * HALF + n * 16) = acc[ai][bj][m][n]; }
    }
};

DI void stats_finish(float s1, float s2, float& mean, float& rstd) { mean = s1 * (1.0f / D); const float var = fmaxf(s2 * (1.0f / D) - mean * mean, 0.f); rstd = __builtin_amdgcn_rsqf(var + EPS); }
DI void unit_row_stats(const float* part, int pm, LAS f32x2* tab, const Ctx& c) {
    int t = c.wid * 64 + c.lane; asm volatile("" : "+v"(t));
    const int row = t >> 1, half = t & 1;
    const f32x4* p = (const f32x4*)(part + ((size_t)(pm * BM + row) * 16 + half * 8) * 2);
    const f32x4 a = p[0], b = p[1], cc = p[2], d = p[3];
    float s1 = ((a[0] + a[2]) + (b[0] + b[2])) + ((cc[0] + cc[2]) + (d[0] + d[2])), s2 = ((a[1] + a[3]) + (b[1] + b[3])) + ((cc[1] + cc[3]) + (d[1] + d[3]));
    s1 += swz_xor1(s1); s2 += swz_xor1(s2);
    float mean, rstd; stats_finish(s1, s2, mean, rstd);
    if (half == 0) tab[row] = (f32x2){mean, rstd};
    asm volatile("s_waitcnt lgkmcnt(0)" ::: "memory"); __builtin_amdgcn_s_barrier(); asm volatile("" ::: "memory");
}
DI void wave_row_stats(const float* part, int row, int lane, float& mean, float& rstd) {
    f32x2 p = {0.f, 0.f}; if (lane < 16) p = *(const f32x2*)(part + ((size_t)row * 16 + lane) * 2);
    float s1 = p[0], s2 = p[1];
#pragma unroll
    for (int o = 1; o < 16; o <<= 1) { s1 += __shfl_xor(s1, o); s2 += __shfl_xor(s2, o); }
    s1 = __shfl(s1, 0); s2 = __shfl(s2, 0);
    stats_finish(s1, s2, mean, rstd);
}
template <bool NORM> struct EpiResStats {
    static constexpr int VM_MIN = 40;
    static constexpr bool PERM = true;
    const bf16_t* res; const float* pstats; const float* pg; const float* pb; bf16_t* VB; float* stats; LAS f32x2* tab; unsigned char* V8; float us;
    DI void operator()(const Acc& acc, const Unit& u, const Ctx& c) const {
        int row0 = u.pm * BM + c.wr * 64 + c.fr, col0 = u.pn * BM + c.wc * 32 + 8 * c.fq; asm volatile("" : "+v"(row0), "+v"(col0));
        if (NORM) unit_row_stats(pstats, u.pm, tab, c);
        int trow = c.wr * 64 + c.fr; asm volatile("" : "+v"(trow));
        constexpr int RB = NORM ? 2 : 4;
#pragma unroll
        for (int rb = 0; rb < 8 / RB; ++rb) {
            int cz = col0; asm volatile("" : "+v"(cz));
            u32x4 rr[RB][2];
#pragma unroll
            for (int q = 0; q < RB; ++q)
#pragma unroll
                for (int bj = 0; bj < 2; ++bj) { const int ai = (rb * RB + q) >> 2, m = (rb * RB + q) & 3; rr[q][bj] = *(const u32x4*)(res + (size_t)(row0 + ai * HALF + m * 16) * D + col0 + bj * HALF); }
#pragma unroll
            for (int q = 0; q < RB; ++q) { const int ai = (rb * RB + q) >> 2, m = (rb * RB + q) & 3; const int row = row0 + ai * HALF + m * 16; const size_t ro = (size_t)row * D + col0;
                float mean = 0.f, rstd = 1.f; if (NORM) { const f32x2 st = tab[trow + ai * HALF + m * 16]; mean = st[0]; rstd = st[1]; }
                float s1 = 0.f, s2 = 0.f;
#pragma unroll
                for (int bj = 0; bj < 2; ++bj) { const u32x4 w = rr[q][bj];
                    f32x4 r0 = {bflo(w.x), bfhi(w.x), bflo(w.y), bfhi(w.y)}, r1 = {bflo(w.z), bfhi(w.z), bflo(w.w), bfhi(w.w)};
                    if (NORM) { const f32x4 g0 = *(const f32x4*)(pg + cz + bj * HALF), g1 = *(const f32x4*)(pg + cz + bj * HALF + 4), b0 = *(const f32x4*)(pb + cz + bj * HALF), b1 = *(const f32x4*)(pb + cz + bj * HALF + 4);
                        r0 = (r0 - mean) * rstd * g0 + b0; r1 = (r1 - mean) * rstd * g1 + b1; }
                    const f32x4 v0 = r0 * DN_ALPHA + acc[ai][bj][m][0] * us, v1 = r1 * DN_ALPHA + acc[ai][bj][m][1] * us;
                    u32x4 o; o.x = cvt_pk_bf16(v0[0], v0[1]); o.y = cvt_pk_bf16(v0[2], v0[3]); o.z = cvt_pk_bf16(v1[0], v1[1]); o.w = cvt_pk_bf16(v1[2], v1[3]);
                    *(u32x4*)(VB + ro + bj * HALF) = o;
                    if (V8) { u32x2 q8; q8.x = pk4_fp8(v0[0] * F8_XS, v0[1] * F8_XS, v0[2] * F8_XS, v0[3] * F8_XS); q8.y = pk4_fp8(v1[0] * F8_XS, v1[1] * F8_XS, v1[2] * F8_XS, v1[3] * F8_XS); *(u32x2*)(V8 + ro + bj * HALF) = q8; }
                    s1 += (v0[0] + v0[1]) + (v0[2] + v0[3]) + (v1[0] + v1[1]) + (v1[2] + v1[3]);
                    s2 += (v0[0] * v0[0] + v0[1] * v0[1]) + (v0[2] * v0[2] + v0[3] * v0[3]) + (v1[0] * v1[0] + v1[1] * v1[1]) + (v1[2] * v1[2] + v1[3] * v1[3]); }
                s1 += swz_xor16(s1); s1 = sum_xor32(s1); s2 += swz_xor16(s2); s2 = sum_xor32(s2);
                if (c.fq == 0) *(f32x2*)(stats + ((size_t)row * 16 + u.pn * 4 + c.wc) * 2) = (f32x2){s1, s2}; }
            __builtin_amdgcn_sched_barrier(0); }
    }
};
struct EpiLNApplyBf16 {
    static constexpr int VM_MIN = 24;
    static constexpr bool PERM = true;
    bf16_t* O; int ldc; const float* stats; const float* cs; const float* cb; float scale; LAS f32x2* tab; float us;
    DI void operator()(const Acc& acc, const Unit& u, const Ctx& c) const {
        int row0 = u.pm * BM + c.wr * 64 + c.fr, col0 = u.pn * BM + c.wc * 32 + 8 * c.fq; asm volatile("" : "+v"(row0), "+v"(col0));
        unit_row_stats(stats, u.pm, tab, c);
        int trow = c.wr * 64 + c.fr; asm volatile("" : "+v"(trow));
#pragma unroll
        for (int bj = 0; bj < 2; ++bj) {
            const f32x4 cs0 = *(const f32x4*)(cs + col0 + bj * HALF), cs1 = *(const f32x4*)(cs + col0 + bj * HALF + 4), cb0 = *(const f32x4*)(cb + col0 + bj * HALF), cb1 = *(const f32x4*)(cb + col0 + bj * HALF + 4);
#pragma unroll
            for (int ai = 0; ai < 2; ++ai)
#pragma unroll
                for (int m = 0; m < 4; ++m) { const int row = row0 + ai * HALF + m * 16; const f32x2 st = tab[trow + ai * HALF + m * 16]; const float mean = st[0], rstd = st[1];
                    const f32x4 v0 = ((acc[ai][bj][m][0] * us - cs0 * mean) * rstd + cb0) * scale, v1 = ((acc[ai][bj][m][1] * us - cs1 * mean) * rstd + cb1) * scale;
                    if (XS_FP8) { u32x2 q; q.x = pk4_fp8(v0[0] * F8_WS, v0[1] * F8_WS, v0[2] * F8_WS, v0[3] * F8_WS); q.y = pk4_fp8(v1[0] * F8_WS, v1[1] * F8_WS, v1[2] * F8_WS, v1[3] * F8_WS); *(u32x2*)((unsigned char*)O + (size_t)row * ldc + col0 + bj * HALF) = q; }
                    else { u32x4 w; w.x = cvt_pk_bf16(v0[0], v0[1]); w.y = cvt_pk_bf16(v0[2], v0[3]); w.z = cvt_pk_bf16(v1[0], v1[1]); w.w = cvt_pk_bf16(v1[2], v1[3]);
                    *(u32x4*)(O + (size_t)row * ldc + col0 + bj * HALF) = w; } }
            __builtin_amdgcn_sched_barrier(0); }
    }
};
struct EpiLNApplyF32 {
    static constexpr bool PERM = false;
    float* C; int ldc; int ncols_valid; const float* stats; const float* cs; const float* cb; LAS f32x2* tab;
    DI void operator()(const Acc& acc, const Unit& u, const Ctx& c) const {
        int row0 = u.pm * BM + c.wr * 64 + c.fr, col0 = u.pn * BM + c.wc * 32 + 4 * c.fq; asm volatile("" : "+v"(row0), "+v"(col0));
        unit_row_stats(stats, u.pm, tab, c);
        int trow = c.wr * 64 + c.fr; asm volatile("" : "+v"(trow));
#pragma unroll
        for (int ai = 0; ai < 2; ++ai)
#pragma unroll
            for (int m = 0; m < 4; ++m) { const int row = row0 + ai * HALF + m * 16; const f32x2 st = tab[trow + ai * HALF + m * 16]; const float mean = st[0], rstd = st[1];
                float* rowp = C + (size_t)row * ldc + col0;
#pragma unroll
                for (int bj = 0; bj < 2; ++bj)
#pragma unroll
                    for (int n = 0; n < 2; ++n) if (col0 + bj * HALF + n * 16 < ncols_valid) { const f32x4 csv = *(const f32x4*)(cs + col0 + bj * HALF + n * 16), cbv = *(const f32x4*)(cb + col0 + bj * HALF + n * 16);
                        *(f32x4*)(rowp + bj * HALF + n * 16) = (acc[ai][bj][m][n] - csv * mean) * rstd + cbv; } }
    }
};
struct EpiSoftmax {
    static constexpr int VM_MIN = 16;
    static constexpr bool PERM = true;
    bf16_t* O; LAS float* red; float us;
    DI void operator()(Acc& acc, const Unit& u, const Ctx& c) const {
        int row0 = u.pm * BM + c.wr * 64 + c.fr, col0 = u.pn * BM + c.wc * 32 + 8 * c.fq; asm volatile("" : "+v"(row0), "+v"(col0));
        int rbase = (c.wr * 64 + c.fr) * 4; asm volatile("" : "+v"(rbase));
        LAS float* r1 = red + rbase; LAS float* r2 = red + 1024 + rbase;
#pragma unroll
        for (int ai = 0; ai < 2; ++ai)
#pragma unroll
            for (int m = 0; m < 4; ++m) { float v = -INFINITY;
#pragma unroll
                for (int bj = 0; bj < 2; ++bj)
#pragma unroll
                    for (int n = 0; n < 2; ++n) { const f32x4 x = acc[ai][bj][m][n]; v = fmaxf(v, fmaxf(fmaxf(x[0], x[1]), fmaxf(x[2], x[3]))); }
                v = fmaxf(v, swz_xor16(v)); v = max_xor32(v);
                if (c.fq == 0) r1[(ai * HALF + m * 16) * 4 + c.wc] = v;
                __builtin_amdgcn_sched_barrier(0); }
        asm volatile("s_waitcnt lgkmcnt(0)" ::: "memory"); __builtin_amdgcn_s_barrier(); asm volatile("" ::: "memory");
#pragma unroll
        for (int ai = 0; ai < 2; ++ai)
#pragma unroll
            for (int m = 0; m < 4; ++m) { const f32x4 q = *(const LAS f32x4*)(r1 + (ai * HALF + m * 16) * 4);
                const float mm = fmaxf(fmaxf(q[0], q[1]), fmaxf(q[2], q[3])); float s = 0.f;
#pragma unroll
                for (int bj = 0; bj < 2; ++bj)
#pragma unroll
                    for (int n = 0; n < 2; ++n) { f32x4 x = acc[ai][bj][m][n];
                        x[0] = __builtin_amdgcn_exp2f((x[0] - mm) * us); x[1] = __builtin_amdgcn_exp2f((x[1] - mm) * us); x[2] = __builtin_amdgcn_exp2f((x[2] - mm) * us); x[3] = __builtin_amdgcn_exp2f((x[3] - mm) * us);
                        acc[ai][bj][m][n] = x; s += (x[0] + x[1]) + (x[2] + x[3]); }
                s += swz_xor16(s); s = sum_xor32(s);
                if (c.fq == 0) r2[(ai * HALF + m * 16) * 4 + c.wc] = s;
                __builtin_amdgcn_sched_barrier(0); }
        asm volatile("s_waitcnt lgkmcnt(0)" ::: "memory"); __builtin_amdgcn_s_barrier(); asm volatile("" ::: "memory");
#pragma unroll
        for (int ai = 0; ai < 2; ++ai)
#pragma unroll
            for (int m = 0; m < 4; ++m) { const f32x4 q = *(const LAS f32x4*)(r2 + (ai * HALF + m * 16) * 4);
                const float inv = rcpf_((q[0] + q[1]) + (q[2] + q[3]));
                bf16_t* rowp = O + (size_t)(row0 + ai * HALF + m * 16) * D + col0;
#pragma unroll
                for (int bj = 0; bj < 2; ++bj) { const f32x4 v0 = acc[ai][bj][m][0] * inv, v1 = acc[ai][bj][m][1] * inv;
                    if (XA_FP8) { u32x2 q; q.x = pk4_fp8(v0[0] * F8_OS, v0[1] * F8_OS, v0[2] * F8_OS, v0[3] * F8_OS); q.y = pk4_fp8(v1[0] * F8_OS, v1[1] * F8_OS, v1[2] * F8_OS, v1[3] * F8_OS);
                        *(u32x2*)((unsigned char*)O + (size_t)(row0 + ai * HALF + m * 16) * D + col0 + bj * HALF) = q; }
                    else { u32x4 w; w.x = cvt_pk_bf16(v0[0], v0[1]); w.y = cvt_pk_bf16(v0[2], v0[3]); w.z = cvt_pk_bf16(v1[0], v1[1]); w.w = cvt_pk_bf16(v1[2], v1[3]);
                    *(u32x4*)(rowp + bj * HALF) = w; } }
                __builtin_amdgcn_sched_barrier(0); }
    }
};
struct EpiSwiglu {
    static constexpr int VM_MIN = 12;
    static constexpr bool PERM = true, WIDE16 = true, GLU = true;
    unsigned char* O; const float* bias;
    DI void operator()(const Acc& acc, const Unit& u, const Ctx& c) const {
        int row0 = u.pm * BM + c.wr * 64 + c.fr, out0 = u.pn * HALF + c.wc * 32 + 8 * c.fq; asm volatile("" : "+v"(row0), "+v"(out0));
        constexpr float us = 1.0f / (F8_XS * F8_WS);
        f32x4 bgf[2], blf[2];
#pragma unroll
        for (int bj = 0; bj < 2; ++bj) { const f32x4 b0 = *(const f32x4*)(bias + (size_t)u.aux * 2048 + 2 * (out0 + 4 * bj)), b1 = *(const f32x4*)(bias + (size_t)u.aux * 2048 + 2 * (out0 + 4 * bj) + 4);
            bgf[bj] = (f32x4){b0[0], b0[2], b1[0], b1[2]}; blf[bj] = (f32x4){b0[1], b0[3], b1[1], b1[3]}; }
#pragma unroll
        for (int ai = 0; ai < 2; ++ai)
#pragma unroll
            for (int m = 0; m < 4; ++m) { unsigned char* rowp = O + (size_t)(row0 + ai * HALF + m * 16) * 1024 + out0;
                u32x2 w;
#pragma unroll
                for (int bj = 0; bj < 2; ++bj) { const f32x4 bgv = bgf[bj], blv = blf[bj];
                    f32x4 g = acc[ai][bj][m][0] * us + bgv, l = acc[ai][bj][m][1] * us + blv;
                    g = __builtin_elementwise_min(g, (f32x4){7.f, 7.f, 7.f, 7.f}); l = __builtin_elementwise_min(__builtin_elementwise_max(l, (f32x4){-7.f, -7.f, -7.f, -7.f}), (f32x4){7.f, 7.f, 7.f, 7.f});
                    const f32x4 t = g * (-1.702f * 1.4426950408889634f);
                    f32x4 e; e[0] = __builtin_amdgcn_exp2f(t[0]); e[1] = __builtin_amdgcn_exp2f(t[1]); e[2] = __builtin_amdgcn_exp2f(t[2]); e[3] = __builtin_amdgcn_exp2f(t[3]);
                    const f32x4 d = e + 1.0f;
                    f32x4 r; r[0] = __builtin_amdgcn_rcpf(d[0]); r[1] = __builtin_amdgcn_rcpf(d[1]); r[2] = __builtin_amdgcn_rcpf(d[2]); r[3] = __builtin_amdgcn_rcpf(d[3]);
                    const f32x4 o = (g * r) * ((l + 1.0f) * F8_AS);
                    w[bj] = pk4_fp8_nc(o[0], o[1], o[2], o[3]); }
                *(u32x2*)rowp = w; __builtin_amdgcn_sched_barrier(0); }
    }
};
struct EpiDown {
    static constexpr int VM_MIN = 20;
    static constexpr bool PERM = true, WIDE16 = true;
    unsigned char* O; const float* bias; const float* rowgate;
    DI void operator()(const Acc& acc, const Unit& u, const Ctx& c) const {
        int row0 = u.pm * BM + c.wr * 64 + c.fr, col0 = u.pn * BM + c.wc * 64 + 16 * c.fq; asm volatile("" : "+v"(row0), "+v"(col0));
        const float* rg = rowgate + u.gr + c.wr * 64 + c.fr;
        f32x4 bv[2][2];
#pragma unroll
        for (int bj = 0; bj < 2; ++bj)
#pragma unroll
            for (int n = 0; n < 2; ++n) bv[bj][n] = *(const f32x4*)(bias + (size_t)u.aux * 1024 + col0 + 8 * bj + 4 * n);
        float gta[2][4];
#pragma unroll
        for (int ai = 0; ai < 2; ++ai)
#pragma unroll
            for (int m = 0; m < 4; ++m) gta[ai][m] = rg[ai * HALF + m * 16];
#pragma unroll
        for (int ai = 0; ai < 2; ++ai) {
#pragma unroll
            for (int m = 0; m < 4; ++m) { const int row = row0 + ai * HALF + m * 16; const float gt = gta[ai][m] * F8_YS; unsigned char* rowp = O + (size_t)row * 1024 + col0;
                u32x4 w;
#pragma unroll
                for (int bj = 0; bj < 2; ++bj) { const f32x4 v0 = (acc[ai][bj][m][0] * (1.0f / (F8_AS * F8_WS)) + bv[bj][0]) * gt, v1 = (acc[ai][bj][m][1] * (1.0f / (F8_AS * F8_WS)) + bv[bj][1]) * gt;
                    w[2 * bj] = pk4_fp8(v0[0], v0[1], v0[2], v0[3]); w[2 * bj + 1] = pk4_fp8(v1[0], v1[1], v1[2], v1[3]); }
                *(u32x4*)rowp = w; } }
    }
};
}
constexpr size_t MiB = 1u << 20;
constexpr size_t WS_CTL = 0, CTL_ZERO_BYTES = 44 * 1024;
constexpr int P1_NBF = 1536;
constexpr size_t WS_W_IN8 = 6 * MiB;
constexpr size_t WS_W_IN = 2 * MiB, WS_W_UQ = 10 * MiB, WS_W_UK = WS_W_UQ + 512 * 1024, WS_W_UV = WS_W_UK + 256 * 1024, WS_W_MQK = 11 * MiB, WS_W_BRM = 12 * MiB, WS_W_BRA = 13 * MiB,
                 WS_W_MIX = 14 * MiB, WS_W_CQ = 16 * MiB, WS_W_CK = 18 * MiB, WS_W_CV = 20 * MiB, WS_W_CO = 22 * MiB, WS_W_R = 24 * MiB, WS_W_GU = 26 * MiB, WS_W_DN = 90 * MiB;
constexpr size_t WS_GATES = 218 * MiB, WS_CS = 219 * MiB, WS_KPE = 223 * MiB, WS_MEMB = 225 * MiB, WS_KC = 233 * MiB, WS_VCT = 241 * MiB, WS_LOGITS = 249 * MiB,
                 WS_ASSIGN = 253 * MiB, WS_GATEW = WS_ASSIGN + 512 * 1024, WS_TOKPOS = 254 * MiB;
constexpr size_t WS_XB = 256 * MiB, WS_PROJ = 320 * MiB, WS_QN = 576 * MiB, WS_KVN = 592 * MiB, WS_XC = 608 * MiB, WS_QMLA = 640 * MiB, WS_KN = 688 * MiB, WS_VT = 720 * MiB,
                 WS_QKM = 752 * MiB, WS_KTM = 816 * MiB, WS_AO = 848 * MiB, WS_HRAW = 880 * MiB, WS_HM = 944 * MiB;
constexpr size_t WS_X8 = 576 * MiB  , WS_GATED = 576 * MiB, WS_V1B8 = 640 * MiB  , WS_V1B = 704 * MiB, WS_QC = 384 * MiB, WS_PC = 448 * MiB, WS_OC = 320 * MiB, WS_V2B = 864 * MiB;
constexpr size_t WS_ROWTOK = 400 * MiB, WS_ROWGATE = 404 * MiB;
constexpr size_t WS_XG = 320 * MiB, WS_ACT = 456 * MiB, WS_YB = 592 * MiB, WS_END = 985 * MiB;
static_assert((size_t)NROWS * 1024 * 2 <= 272 * MiB, "routed buffers");
static_assert(WS_TOKPOS + (size_t)T * 4 * 4 <= 256 * MiB, "small buffers");
constexpr int CW_TMO = 0, CW_CNT = 64  , CNT_STRIDE = 1, CW_BAR = 4096;
static_assert(CW_CNT + NE * CNT_STRIDE <= CW_BAR, "control words");
constexpr size_t CTL_CS1 = 32 * 1024, CTL_CB1 = 36 * 1024, CTL_CSR = 40 * 1024, CTL_CBR = 41 * 1024;
constexpr size_t WS_STATS1 = 976 * MiB, WS_STATS2 = 980 * MiB;
constexpr size_t WS_CSP = 984 * MiB;

constexpr int RING_OFF = 0, RING_BYTES = 131072;
constexpr int RED_OFF = RING_BYTES;
constexpr int TST_OFF = RED_OFF + 8192;
constexpr int HIST_OFF = TST_OFF + 256, HBASE_OFF = HIST_OFF + 128;
constexpr int MISC_OFF = HBASE_OFF + 128;
constexpr int TILE_E_OFF = MISC_OFF + 128;
constexpr int LDSCTL_OFF = TST_OFF;
constexpr int GB_OFF = ((TILE_E_OFF + NTILES_MAX * 4 + 15) / 16) * 16;
constexpr int LDS_BYTES = 155648;
static_assert(GB_OFF + 8192 <= LDS_BYTES && GB_OFF + 26 * 512 <= LDS_BYTES, "LDS map");
constexpr int NWAVES = 8;

#define LDS_WAIT() asm volatile("s_waitcnt lgkmcnt(0)" ::: "memory")
#define VM_WAIT() asm volatile("s_waitcnt vmcnt(0)" ::: "memory")

#define XB_TMO      128
#define XB_XCNT(j)  (256  + 64 * (j))
#define XB_XSUB(j)  (1280 + 64 * (j))
#define XB_XGEN(j)  (2304 + 64 * (j))
#define XB_TOP      3328
#define XB_TOPGEN   3392
#define XCD_BAR_WORDS 3456
#define XB_SPIN_CAP (1u << 18)
__device__ __forceinline__ unsigned xb_ld(unsigned* p)              { return __hip_atomic_load(p, __ATOMIC_RELAXED, __HIP_MEMORY_SCOPE_AGENT); }
__device__ __forceinline__ unsigned xb_add(unsigned* p, unsigned v) { return __hip_atomic_fetch_add(p, v, __ATOMIC_RELAXED, __HIP_MEMORY_SCOPE_AGENT); }
__device__ __forceinline__ unsigned xb_xcc_id() { return (unsigned)__builtin_amdgcn_s_getreg((3 << 11) | 20) & 0xFu; }
#define XB_SPIN(cond, bar) do { unsigned _sp = 0; while (cond) { __builtin_amdgcn_s_sleep(1); \
    if ((++_sp & 255u) == 0u) { if (xb_ld(&(bar)[XB_TMO])) break; if (_sp > XB_SPIN_CAP) { atomicAdd(&(bar)[XB_TMO], 1u); break; } } } } while (0)
struct XcdBarrier { unsigned* bar; unsigned x; volatile LAS unsigned* st; };
__device__ __forceinline__ XcdBarrier xcd_barrier_post(unsigned* bar, volatile LAS unsigned* st, int wv) {
    XcdBarrier b; b.bar = bar; b.x = xb_xcc_id(); b.st = st;
    if (wv == 0 && lane_id() == 0) (void)xb_add(&bar[XB_XCNT(b.x)], 1u);
    return b;
}
__device__ __forceinline__ void xcd_barrier_complete(unsigned* bar, unsigned x, unsigned& nloc, unsigned& nx) {
    const unsigned G = gridDim.x * gridDim.y * gridDim.z;
    unsigned sum, cnt, mine, sp = 0u;
    for (;;) {
        sum = 0u; cnt = 0u; mine = 0u;
#pragma unroll
        for (unsigned j = 0; j < 16; ++j) { const unsigned c = xb_ld(&bar[XB_XCNT(j)]); sum += c; cnt += (c > 0u) ? 1u : 0u; mine = (j == x) ? c : mine; }
        if (sum == G) break;
        __builtin_amdgcn_s_sleep(1);
        if ((++sp & 255u) == 0u) { if (xb_ld(&bar[XB_TMO])) break; if (sp > XB_SPIN_CAP) { atomicAdd(&bar[XB_TMO], 1u); break; } }
    }
    nloc = mine > 0u ? mine : 1u; nx = cnt > 0u ? cnt : 1u;
}
__device__ __forceinline__ void xcd_barrier(const XcdBarrier& b, int wv) {
    asm volatile("s_waitcnt vmcnt(0)" ::: "memory");
    __syncthreads();
    if (wv == 0 && lane_id() == 0) {
        unsigned* bar = b.bar;
        __builtin_amdgcn_s_waitcnt(0);
        unsigned nloc = b.st[0], nx = b.st[1];
        if (nloc == 0u) { xcd_barrier_complete(bar, b.x, nloc, nx); b.st[0] = nloc; b.st[1] = nx; }
        const unsigned old = xb_add(&bar[XB_XSUB(b.x)], 1u);
        const unsigned gen = old / nloc;
        if (old + 1u == (gen + 1u) * nloc) {
            __builtin_amdgcn_fence(__ATOMIC_RELEASE, "agent");
            asm volatile("s_waitcnt vmcnt(0)" ::: "memory");
            const unsigned og = xb_add(&bar[XB_TOP], 1u);
            const unsigned tg = og / nx;
            if (og + 1u == (tg + 1u) * nx) xb_add(&bar[XB_TOPGEN], 1u);
            else XB_SPIN(xb_ld(&bar[XB_TOPGEN]) == tg, bar);
            __builtin_amdgcn_fence(__ATOMIC_ACQUIRE, "agent");
            xb_add(&bar[XB_XGEN(b.x)], 1u);
            asm volatile("s_waitcnt vmcnt(0)" ::: "memory");
        } else {
            XB_SPIN(xb_ld(&bar[XB_XGEN(b.x)]) == gen, bar);
            __builtin_amdgcn_fence(__ATOMIC_ACQUIRE, "agent");
            asm volatile("s_waitcnt vmcnt(0)" ::: "memory");
        }
    }
    __syncthreads();
}

struct Args { const void* in[34]; float* out; unsigned char* ws; int ph_lo, ph_hi; };
typedef const __attribute__((address_space(4))) Args* CArgs;
DI CArgs launder_args(CArgs p) { asm volatile("" : "+s"(p)); return p; }

DI void tr_item(const float* W, int ldw, int kvalid, bf16_t* WT, int ldk, int n0, int k0, int sc, LAS float* scr, int lane, const float* rs = nullptr, int kshift = 0, float f8scale = 0.f) {
#pragma unroll 8
    for (int i = 0; i < 32; ++i) { const int kk = 2 * i + (lane >> 5); const int k = k0 + kk + kshift;
        float v = 0.f; if (sc >= 0 && k < kvalid) { v = W[(size_t)k * ldw + sc]; if (rs) v *= rs[k]; }
        scr[kk * 33 + (lane & 31)] = v; }
    LDS_WAIT(); asm volatile("" ::: "memory");
    const int c = lane & 7;
    if (f8scale != 0.f) {
#pragma unroll
        for (int j = 0; j < 4; ++j) { const int n = (lane >> 3) + 8 * j; const LAS float* s = scr + (8 * c) * 33 + n;
            u32x2 o; o.x = pg8::pk4_fp8(s[0 * 33] * f8scale, s[1 * 33] * f8scale, s[2 * 33] * f8scale, s[3 * 33] * f8scale); o.y = pg8::pk4_fp8(s[4 * 33] * f8scale, s[5 * 33] * f8scale, s[6 * 33] * f8scale, s[7 * 33] * f8scale);
            *(GAS u32x2*)((unsigned char*)WT + (size_t)(n0 + n) * ldk + k0 + 8 * c) = o; }
    } else {
#pragma unroll
        for (int j = 0; j < 4; ++j) { const int n = (lane >> 3) + 8 * j; const LAS float* s = scr + (8 * c) * 33 + n;
            u32x4 o; o.x = pk2(s[0 * 33], s[1 * 33]); o.y = pk2(s[2 * 33], s[3 * 33]); o.z = pk2(s[4 * 33], s[5 * 33]); o.w = pk2(s[6 * 33], s[7 * 33]);
            *(GAS u32x4*)(WT + (size_t)(n0 + n) * ldk + k0 + 8 * c) = o; }
    }
    LDS_WAIT(); asm volatile("" ::: "memory");
}

DI void tr_item_v4(const float* W, int ldw, bf16_t* WT, int ldk, int n0, int k0, int c0, LAS float* scr, int lane, const float* rs = nullptr, int kvalid = 1 << 30, int kshift = 0) {
    const int kr = lane >> 3, n4 = lane & 7;
    f32x4 v[8];
#pragma unroll
    for (int i = 0; i < 8; ++i) v[i] = (f32x4){0.f, 0.f, 0.f, 0.f};
    if (c0 >= 0 && k0 + kshift + 63 < kvalid) {
#pragma unroll
        for (int i = 0; i < 8; ++i) v[i] = *(const f32x4*)(W + (size_t)(k0 + i * 8 + kr + kshift) * ldw + c0 + 4 * n4); }
    if (rs) {
#pragma unroll
        for (int i = 0; i < 8; ++i) v[i] = v[i] * rs[k0 + i * 8 + kr]; }
#pragma unroll
    for (int i = 0; i < 8; ++i) { LAS float* p = scr + (i * 8 + kr) * 33 + 4 * n4; p[0] = v[i][0]; p[1] = v[i][1]; p[2] = v[i][2]; p[3] = v[i][3]; }
    LDS_WAIT(); asm volatile("" ::: "memory");
    const int c = lane & 7;
#pragma unroll
    for (int j = 0; j < 4; ++j) { const int n = (lane >> 3) + 8 * j; const LAS float* s = scr + (8 * c) * 33 + n;
        u32x4 o; o.x = pk2(s[0 * 33], s[1 * 33]); o.y = pk2(s[2 * 33], s[3 * 33]); o.z = pk2(s[4 * 33], s[5 * 33]); o.w = pk2(s[6 * 33], s[7 * 33]);
        *(GAS u32x4*)(WT + (size_t)(n0 + n) * ldk + k0 + 8 * c) = o; }
    LDS_WAIT(); asm volatile("" ::: "memory");
}

DI void tr_item_v4_fp8(const float* W, int ldw, unsigned char* WT, int ldk, int n0, int k0, int c0, float sc, LAS float* scr, int lane, const float* rs = nullptr) {
    const int kr = lane >> 3, n4 = lane & 7;
    f32x4 v[8];
#pragma unroll
    for (int i = 0; i < 8; ++i) v[i] = *(const f32x4*)(W + (size_t)(k0 + i * 8 + kr) * ldw + c0 + 4 * n4);
    if (rs) {
#pragma unroll
        for (int i = 0; i < 8; ++i) v[i] = v[i] * rs[k0 + i * 8 + kr]; }
#pragma unroll
    for (int i = 0; i < 8; ++i) { LAS float* p = scr + (i * 8 + kr) * 33 + 4 * n4; p[0] = v[i][0] * sc; p[1] = v[i][1] * sc; p[2] = v[i][2] * sc; p[3] = v[i][3] * sc; }
    LDS_WAIT(); asm volatile("" ::: "memory");
    const int c = lane & 7;
#pragma unroll
    for (int j = 0; j < 4; ++j) { const int n = (lane >> 3) + 8 * j; const LAS float* s = scr + (8 * c) * 33 + n;
        u32x2 o; o.x = pg8::pk4_fp8(s[0 * 33], s[1 * 33], s[2 * 33], s[3 * 33]); o.y = pg8::pk4_fp8(s[4 * 33], s[5 * 33], s[6 * 33], s[7 * 33]);
        *(GAS u32x2*)(WT + (size_t)(n0 + n) * ldk + k0 + 8 * c) = o; }
    LDS_WAIT(); asm volatile("" ::: "memory");
}

DI void tr_k128_load(f32x4 (&v)[16], const float* W, int ldw, int k0, int c0, int lane) {
    const int kr = lane >> 3, n4 = lane & 7;
#pragma unroll
    for (int i = 0; i < 16; ++i) v[i] = __builtin_nontemporal_load((const f32x4*)(W + (size_t)(k0 + i * 8 + kr) * ldw + c0 + 4 * n4));
}
DI void tr_k128_finish(const f32x4 (&v)[16], unsigned char* WT, int ldk, int n0, int k0, float sc, LAS float* scr, int lane) {
    const int kr = lane >> 3, n4 = lane & 7;
#pragma unroll
    for (int i = 0; i < 16; ++i) { LAS float* p = scr + (i * 8 + kr) * 33 + 4 * n4; p[0] = v[i][0] * sc; p[1] = v[i][1] * sc; p[2] = v[i][2] * sc; p[3] = v[i][3] * sc; }
    LDS_WAIT(); asm volatile("" ::: "memory");
    const int c = lane & 7;
#pragma unroll
    for (int j = 0; j < 4; ++j) { const int n = (lane >> 3) + 8 * j; const LAS float* s = scr + (16 * c) * 33 + n;
        u32x4 o; o.x = pg8::pk4_fp8(s[0 * 33], s[1 * 33], s[2 * 33], s[3 * 33]); o.y = pg8::pk4_fp8(s[4 * 33], s[5 * 33], s[6 * 33], s[7 * 33]);
        o.z = pg8::pk4_fp8(s[8 * 33], s[9 * 33], s[10 * 33], s[11 * 33]); o.w = pg8::pk4_fp8(s[12 * 33], s[13 * 33], s[14 * 33], s[15 * 33]);
        __builtin_nontemporal_store(o, (u32x4*)(WT + (size_t)(n0 + n) * ldk + k0 + 16 * c)); }
    LDS_WAIT(); asm volatile("" ::: "memory");
}
struct XwItem { const float* W; unsigned char* WT; int ldw, n0, k0; };
DI XwItem xw_item(int r, const float* wgu, const float* wdn, unsigned char* ws) {
    XwItem x; constexpr int I_GU = NE * 8 * 64;
    if (r < I_GU) { const int e = r / (8 * 64), q = r % (8 * 64), kb = q / 64, nb = q % 64; x.W = wgu + (size_t)e * 1024 * 2048; x.WT = ws + WS_W_GU + (size_t)e * 2048 * 1024; x.ldw = 2048; x.n0 = nb * 32; x.k0 = kb * 128; }
    else { r -= I_GU; const int e = r / (8 * 32), q = r % (8 * 32), kb = q / 32, nb = q % 32; x.W = wdn + (size_t)e * 1024 * 1024; x.WT = ws + WS_W_DN + (size_t)e * 1024 * 1024; x.ldw = 1024; x.n0 = nb * 32; x.k0 = kb * 128; }
    return x;
}
DI int win_src(int n) {
    if (n < 384) return n;
    if (n < 416) { const int i = (n - 384) >> 1; return 384 + i + 16 * ((n - 384) & 1); }
    if (n < 424) return 1952 + (n - 416);
    if (n < 512) return -1;
    if (n < 2048) return 416 + (n - 512);
    return 1960 + (n - 2048);
}
template <bool LATE>
DI void p0_prologue(CArgs args, LAS unsigned char* lds, int gw, int NGW, int wv, int xlo = 0, int xhi = NE * 8 * 96, bool small_items = true) {
    const int lane = lane_id(); const int wave = wv;
    LAS float* scr = (LAS float*)(lds + RING_OFF + wave * 16896);
    unsigned char* ws = args->ws;
    const int j = lane & 31;
    constexpr int I_IN = 16 * 128, I_UQ = 4 * 24, I_UK = 4 * 16, I_UV = 4 * 16, I_MQK = 4 * 32, I_BRM = 8 * 32, I_BRA = 8 * 32, I_SQ = 16 * 32, I_R = 16 * 8,
                  I_GU = NE * 8 * 64, I_DN = NE * 8 * 32;
    constexpr int NITEMS = LATE ? I_UQ + I_UK + I_UV + I_MQK + I_BRM + I_BRA + 3 * I_SQ + I_R : I_IN + 2 * I_SQ;
    if (LATE && small_items) for (int it = gw; it < 33 * 32; it += NGW) { const int grp = it >> 5, kc = it & 31; const bool rt = (grp == 32);
        const float* W = (const float*)args->in[rt ? 26 : 21]; const int ldw = rt ? NE : 1024; const int col = (rt ? 0 : grp * 32) + (lane & 31);
        const float* gv = (const float*)args->in[rt ? 24 : 19]; const float* bv = (const float*)args->in[rt ? 25 : 20];
        float as = 0.f, ab = 0.f;
#pragma unroll
        for (int i = 0; i < 16; ++i) { const int k = kc * 32 + 2 * i + (lane >> 5); const float w = W[(size_t)k * ldw + col]; const float gw_ = gv[k] * w;
            as += (rt || !CQ_FP8) ? bf2f((unsigned short)f2bf(gw_)) : __builtin_amdgcn_cvt_f32_fp8(__builtin_amdgcn_cvt_pk_fp8_f32(gw_ * pg8::F8_WS, 0.f, 0, false), 0) * (1.0f / pg8::F8_WS); ab += bv[k] * w; }
        as += __shfl_xor(as, 32); ab += __shfl_xor(ab, 32);
        if (lane < 32) { float* pp = (float*)(ws + WS_CSP); pp[((rt ? 2 : 0) * 32 + kc) * 1024 + col] = as; pp[((rt ? 3 : 1) * 32 + kc) * 1024 + col] = ab; } }
    if (LATE) {
        const float* wgu = (const float*)args->in[28]; const float* wdn = (const float*)args->in[30];
        f32x4 va[16], vb[16];
        int it = xlo + gw;
        if (it < xhi) { const XwItem x = xw_item(it, wgu, wdn, ws); tr_k128_load(va, x.W, x.ldw, x.k0, x.n0, lane); }
#pragma unroll 1
        for (; it < xhi; it += 2 * NGW) {
            const XwItem x0 = xw_item(it, wgu, wdn, ws);
            const bool h1 = it + NGW < xhi; const XwItem x1 = xw_item(h1 ? it + NGW : it, wgu, wdn, ws);
            if (h1) tr_k128_load(vb, x1.W, x1.ldw, x1.k0, x1.n0, lane);
            tr_k128_finish(va, x0.WT, 1024, x0.n0, x0.k0, pg8::F8_WS, scr, lane);
            const bool h2 = it + 2 * NGW < xhi; const XwItem x2 = xw_item(h2 ? it + 2 * NGW : it, wgu, wdn, ws);
            if (h2) tr_k128_load(va, x2.W, x2.ldw, x2.k0, x2.n0, lane);
            if (h1) tr_k128_finish(vb, x1.WT, 1024, x1.n0, x1.k0, pg8::F8_WS, scr, lane);
        }
    }
    if (!LATE || small_items) for (int it = gw; it < NITEMS; it += NGW) {
        int r = it;
        if (LATE) {
        } else {
        if (r < I_IN) { const int kb = r / 128, nb = r % 128;
            if (P1_FP8 && nb >= P1_NBF / 32) tr_item_v4_fp8((const float*)args->in[3], DIN, ws + WS_W_IN8, 1024, nb * 32 - P1_NBF, kb * 64, win_src(nb * 32), pg8::F8_WS, scr, lane);
            else if (nb < 12 || nb >= 16) tr_item_v4((const float*)args->in[3], DIN, (bf16_t*)(ws + WS_W_IN), 1024, nb * 32, kb * 64, win_src(nb * 32), scr, lane);
            else tr_item((const float*)args->in[3], DIN, 1024, (bf16_t*)(ws + WS_W_IN), 1024, nb * 32, kb * 64, win_src(nb * 32 + j), scr, lane); continue; } r -= I_IN;
        }
        if (LATE) {
        if (r < I_UQ) { const int kb = r / 24, nb = r % 24; const int n = nb * 32 + j, hh = n / AQK, cc = n % AQK;
            const int sc = (cc < ANOPE) ? n : hh * AQK + ANOPE + ((cc - ANOPE) >> 1) + 16 * ((cc - ANOPE) & 1);
            tr_item((const float*)args->in[14], AH * AQK, 256, (bf16_t*)(ws + WS_W_UQ), 256, nb * 32, kb * 64, sc, scr, lane); continue; } r -= I_UQ;
        if (r < I_UK) { const int kb = r / 16, nb = r % 16; const int n = nb * 32 + j;
            tr_item_v4((const float*)args->in[15], 1024, (bf16_t*)(ws + WS_W_UK), 256, nb * 32, kb * 64, ((nb * 32) >> 6) * 128 + ((nb * 32) & 63), scr, lane, nullptr, 128); (void)n; continue; } r -= I_UK;
        if (r < I_UV) { const int kb = r / 16, nb = r % 16; const int n = nb * 32 + j;
            tr_item_v4((const float*)args->in[15], 1024, (bf16_t*)(ws + WS_W_UV), 256, nb * 32, kb * 64, ((nb * 32) >> 6) * 128 + 64 + ((nb * 32) & 63), scr, lane, nullptr, 128); (void)n; continue; } r -= I_UV;
        if (r < I_MQK) { const int kb = r / 32, nb = r % 32; const int n = nb * 32 + j, part = n >> 9, hh = (n >> 7) & 3, e = n & 127;
            const float* src = (const float*)args->in[part ? 9 : 8];
            tr_item_v4(src, 128, (bf16_t*)(ws + WS_W_MQK), 256, nb * 32, kb * 64, ((kb >> 1) == (hh & 1)) ? (e & ~31) : -1, scr, lane, nullptr, 512, (hh >> 1) * 256); continue; } r -= I_MQK;
        if (r < I_BRM) { const int kb = r / 32, nb = r % 32;
            if (P6_FP8) tr_item_v4_fp8((const float*)args->in[16], 1024, ws + WS_W_BRM, 512, nb * 32, kb * 64, nb * 32, pg8::F8_WS, scr, lane); else tr_item_v4((const float*)args->in[16], 1024, (bf16_t*)(ws + WS_W_BRM), 512, nb * 32, kb * 64, nb * 32, scr, lane); continue; } r -= I_BRM;
        if (r < I_BRA) { const int kb = r / 32, nb = r % 32;
            if (P6_FP8) tr_item_v4_fp8((const float*)args->in[17], 1024, ws + WS_W_BRA, 512, nb * 32, kb * 64, nb * 32, pg8::F8_WS, scr, lane); else tr_item_v4((const float*)args->in[17], 1024, (bf16_t*)(ws + WS_W_BRA), 512, nb * 32, kb * 64, nb * 32, scr, lane); continue; } r -= I_BRA;
        }
        if (r < (LATE ? 3 : 2) * I_SQ) { const int w_ = r / I_SQ, w = LATE ? (w_ == 2 ? 4 : w_) : 2 + w_, q = r % I_SQ, kb = q / 32, nb = q % 32;
            const float* src; int ldw, coff; bf16_t* dst; const float* rs = nullptr;
            if (w == 0) { src = (const float*)args->in[18]; ldw = 1024; coff = 0; dst = (bf16_t*)(ws + WS_W_MIX); }
            else if (w == 1) { src = (const float*)args->in[21]; ldw = 1024; coff = 0; dst = (bf16_t*)(ws + WS_W_CQ); rs = (const float*)args->in[19]; }
            else if (w == 2) { src = (const float*)args->in[22]; ldw = 2048; coff = 0; dst = (bf16_t*)(ws + WS_W_CK); }
            else if (w == 3) { src = (const float*)args->in[22]; ldw = 2048; coff = 1024; dst = (bf16_t*)(ws + WS_W_CV); }
            else { src = (const float*)args->in[23]; ldw = 1024; coff = 0; dst = (bf16_t*)(ws + WS_W_CO); }
            if ((CQ_FP8 && w == 1) || (CO_FP8 && w == 4) || (P1_FP8 && (w == 2 || w == 3))) tr_item_v4_fp8(src, ldw, (unsigned char*)dst, 1024, nb * 32, kb * 64, coff + nb * 32, pg8::F8_WS, scr, lane, rs); else tr_item_v4(src, ldw, dst, 1024, nb * 32, kb * 64, coff + nb * 32, scr, lane, rs); continue; } r -= (LATE ? 3 : 2) * I_SQ;
        if (LATE) { const int kb = r / 8, nb = r % 8; const int n = nb * 32 + j;
            tr_item_v4((const float*)args->in[26], NE, (bf16_t*)(ws + WS_W_R), 1024, nb * 32, kb * 64, (nb == 0) ? 0 : -1, scr, lane, (const float*)args->in[24]); (void)n; }
    }
    if (LATE) return;
    const size_t gt = (size_t)gw * 64 + lane, NT_ = (size_t)NGW * 64;
    { const float* x = (const float*)args->in[0]; bf16_t* xb = (bf16_t*)(ws + WS_XB); unsigned char* x8 = ws + WS_X8;
      constexpr int UB = 4;
      for (size_t i0 = gt; i0 < (size_t)T * D / 8; i0 += UB * NT_) {
          f32x4 a[UB], b[UB];
#pragma unroll
          for (int u = 0; u < UB; ++u) { const size_t i = (i0 + u * NT_ < (size_t)T * D / 8) ? i0 + u * NT_ : i0; a[u] = *(const f32x4*)(x + i * 8); b[u] = *(const f32x4*)(x + i * 8 + 4); }
#pragma unroll
          for (int u = 0; u < UB; ++u) { const size_t i = i0 + u * NT_; if (i < (size_t)T * D / 8) {
              u32x4 o; o.x = pk2(a[u][0], a[u][1]); o.y = pk2(a[u][2], a[u][3]); o.z = pk2(b[u][0], b[u][1]); o.w = pk2(b[u][2], b[u][3]); *(u32x4*)(xb + i * 8) = o;
              if (P1_FP8) { u32x2 q; q.x = pg8::pk4_fp8(a[u][0] * pg8::F8_XS, a[u][1] * pg8::F8_XS, a[u][2] * pg8::F8_XS, a[u][3] * pg8::F8_XS); q.y = pg8::pk4_fp8(b[u][0] * pg8::F8_XS, b[u][1] * pg8::F8_XS, b[u][2] * pg8::F8_XS, b[u][3] * pg8::F8_XS); *(u32x2*)(x8 + i * 8) = q; } } } } }
    if (P1_FP8) { const float* x = (const float*)args->in[1]; unsigned char* x8 = ws + WS_MEMB;
      for (size_t i = gt; i < (size_t)NB * NMEM * D / 8; i += NT_) { const f32x4 a = *(const f32x4*)(x + i * 8), b = *(const f32x4*)(x + i * 8 + 4);
          u32x2 q; q.x = pg8::pk4_fp8(a[0] * pg8::F8_XS, a[1] * pg8::F8_XS, a[2] * pg8::F8_XS, a[3] * pg8::F8_XS); q.y = pg8::pk4_fp8(b[0] * pg8::F8_XS, b[1] * pg8::F8_XS, b[2] * pg8::F8_XS, b[3] * pg8::F8_XS); *(u32x2*)(x8 + i * 8) = q; } }
    else { const float* x = (const float*)args->in[1]; bf16_t* xb = (bf16_t*)(ws + WS_MEMB);
      for (size_t i = gt; i < (size_t)NB * NMEM * D / 8; i += NT_) { const f32x4 a = *(const f32x4*)(x + i * 8), b = *(const f32x4*)(x + i * 8 + 4);
          u32x4 o; o.x = pk2(a[0], a[1]); o.y = pk2(a[2], a[3]); o.z = pk2(b[0], b[1]); o.w = pk2(b[2], b[3]); *(u32x4*)(xb + i * 8) = o; } }
}

DI void p2_tokens(CArgs args, int vcu, int G, int wv) {
    const int lane = lane_id(); const int wave = wv;
    unsigned char* ws = args->ws;
    const bf16_t* proj = (const bf16_t*)(ws + WS_PROJ);
    bf16_t* qn = (bf16_t*)(ws + WS_QN); bf16_t* kvn = (bf16_t*)(ws + WS_KVN); bf16_t* kpe = (bf16_t*)(ws + WS_KPE); bf16_t* xc = (bf16_t*)(ws + WS_XC); float* cs = (float*)(ws + WS_CS);
    const int* positions = (const int*)args->in[2];
    const float* conv_w = (const float*)args->in[6]; const float* conv_b = (const float*)args->in[7];
    const float* g_qlat = (const float*)args->in[12]; const float* g_kvlat = (const float*)args->in[13];
    const int gw = vcu * NWAVES + wave, NGW = G * NWAVES;
    if (gw < 33) { const bool rt = (gw == 32); const float* pp = (const float*)(ws + WS_CSP); const int col = (rt ? 0 : gw * 32) + (lane & 31); const int which = (rt ? 2 : 0) + (lane >> 5);
        float a = 0.f;
#pragma unroll 8
        for (int kc = 0; kc < 32; ++kc) a += pp[(which * 32 + kc) * 1024 + col];
        float* dst = (float*)(ws + ((lane >> 5) ? (rt ? CTL_CBR : CTL_CB1) : (rt ? CTL_CSR : CTL_CS1))); dst[col] = a; }
    float cw[4][8], cb[8];
#pragma unroll
    for (int jj = 0; jj < 4; ++jj)
#pragma unroll
        for (int c = 0; c < 8; ++c) cw[jj][c] = conv_w[jj * MW + 8 * lane + c];
#pragma unroll
    for (int c = 0; c < 8; ++c) cb[c] = conv_b[8 * lane + c];
    const f32x4 gq = *(const f32x4*)(g_qlat + 4 * lane);
    const f32x2 gk = *(const f32x2*)(g_kvlat + 2 * lane);
    const float inv_freq = exp2f(-(float)(lane & 15) * (13.287712379549449f / 16.0f));
    constexpr int U = 4;
    for (int g0 = gw; g0 < T / U; g0 += NGW) {
        const int base = U * g0, sb = base & (SEQ - 1);
        u32x2 wq[U]; unsigned wk[U], wr[U]; int pos[U]; u32x4 xr[U + 3];
#pragma unroll
        for (int r = 0; r < U + 3; ++r) { const int tr = (sb == 0 && r < 3) ? base : base - 3 + r; xr[r] = *(const u32x4*)(proj + (size_t)tr * NPROJ + PC_XM + 8 * lane); }
#pragma unroll
        for (int u = 0; u < U; ++u) { const bf16_t* pr = proj + (size_t)(base + u) * NPROJ;
            wq[u] = *(const u32x2*)(pr + PC_QLAT + 4 * lane); wk[u] = *(const unsigned*)(pr + PC_KVLAT + 2 * lane); wr[u] = *(const unsigned*)(pr + PC_KROPE + 2 * (lane & 15)); pos[u] = positions[base + u]; }
#pragma unroll
        for (int u = 0; u < U; ++u) { const int t = base + u;
        { const u32x2 w = wq[u]; const float a0 = bflo(w.x), a1 = bfhi(w.x), a2 = bflo(w.y), a3 = bfhi(w.y);
          const float ss = wave_sum(a0 * a0 + a1 * a1 + a2 * a2 + a3 * a3); const float r = 1.0f / sqrtf(ss * (1.0f / AQR) + EPS);
          u32x2 o; o.x = pk2(a0 * r * gq[0], a1 * r * gq[1]); o.y = pk2(a2 * r * gq[2], a3 * r * gq[3]); *(u32x2*)(qn + (size_t)t * 256 + 4 * lane) = o; }
        { const unsigned w = wk[u]; const float a0 = bflo(w), a1 = bfhi(w);
          const float ss = wave_sum(a0 * a0 + a1 * a1); const float r = 1.0f / sqrtf(ss * (1.0f / AKVR) + EPS);
          *(unsigned*)(kvn + (size_t)t * 256 + 2 * lane) = pk2(a0 * r * gk[0], a1 * r * gk[1]); }
        { const unsigned w = wr[u]; const float x1 = bflo(w), x2 = bfhi(w);
          const float ang = (float)pos[u] * inv_freq;
          const double rev = (double)ang * 0.15915494309189535; const float fr = (float)(rev - __builtin_rint(rev));
          const float cc = __builtin_amdgcn_cosf(fr), sn = __builtin_amdgcn_sinf(fr);
          if (lane < 16) { *(unsigned*)(kpe + (size_t)t * 32 + 2 * lane) = pk2(x1 * cc - x2 * sn, x2 * cc + x1 * sn);
              *(f32x2*)(cs + (size_t)t * 32 + 2 * lane) = (f32x2){cc, sn}; } }
        { float a[8];
#pragma unroll
          for (int c = 0; c < 8; ++c) a[c] = cb[c];
#pragma unroll
          for (int jj = 0; jj < 4; ++jj) { const u32x4 w = xr[u + jj]; const float z = (sb == 0 && u + jj < 3) ? 0.0f : 1.0f;
              a[0] += cw[jj][0] * z * bflo(w.x); a[1] += cw[jj][1] * z * bfhi(w.x); a[2] += cw[jj][2] * z * bflo(w.y); a[3] += cw[jj][3] * z * bfhi(w.y);
              a[4] += cw[jj][4] * z * bflo(w.z); a[5] += cw[jj][5] * z * bfhi(w.z); a[6] += cw[jj][6] * z * bflo(w.w); a[7] += cw[jj][7] * z * bfhi(w.w); }
#pragma unroll
          for (int c = 0; c < 8; ++c) a[c] = a[c] * sigmoidf_(a[c]);
          u32x4 o; o.x = pk2(a[0], a[1]); o.y = pk2(a[2], a[3]); o.z = pk2(a[4], a[5]); o.w = pk2(a[6], a[7]); *(u32x4*)(xc + (size_t)t * MW + 8 * lane) = o; }
        }
    }
}

DI void p6_mpost(CArgs args, int vcu, int G, int wv) {
    const int lane = lane_id(); const int wave = wv;
    unsigned char* ws = args->ws;
    const bf16_t* hraw = (const bf16_t*)(ws + WS_HRAW); const bf16_t* xc = (const bf16_t*)(ws + WS_XC); const bf16_t* proj = (const bf16_t*)(ws + WS_PROJ); bf16_t* hm = (bf16_t*)(ws + WS_HM);
    const float* g_mhead = (const float*)args->in[10]; const float* w_mskip = (const float*)args->in[11];
    const int gw = vcu * NWAVES + wave, NGW = G * NWAVES;
    float gm[8], wsk[8];
#pragma unroll
    for (int c = 0; c < 8; ++c) { gm[c] = g_mhead[8 * lane + c]; wsk[c] = w_mskip[8 * lane + c]; }
    constexpr int U = 4;
    for (int t0 = gw; t0 < T; t0 += U * NGW) {
        int tt[U]; u32x4 hwv[U], xwv[U], owv[U];
#pragma unroll
        for (int u = 0; u < U; ++u) { tt[u] = (t0 + u * NGW < T) ? t0 + u * NGW : t0;
            hwv[u] = *(const u32x4*)(hraw + (size_t)tt[u] * MW + 8 * lane); xwv[u] = *(const u32x4*)(xc + (size_t)tt[u] * MW + 8 * lane); owv[u] = *(const u32x4*)(proj + (size_t)tt[u] * NPROJ + PC_OP + 8 * lane); }
#pragma unroll
        for (int u = 0; u < U; ++u) if (u == 0 || t0 + u * NGW < T) { const int t = tt[u];
        const u32x4 hw = hwv[u];
        float h[8] = {bflo(hw.x), bfhi(hw.x), bflo(hw.y), bfhi(hw.y), bflo(hw.z), bfhi(hw.z), bflo(hw.w), bfhi(hw.w)};
        float s = 0.f;
#pragma unroll
        for (int c = 0; c < 8; ++c) s += h[c];
        s += __shfl_xor(s, 1); s += __shfl_xor(s, 2); s += __shfl_xor(s, 4); s += __shfl_xor(s, 8);
        const float mu = s * (1.0f / MHD); float q = 0.f;
#pragma unroll
        for (int c = 0; c < 8; ++c) { h[c] -= mu; q += h[c] * h[c]; }
        q += __shfl_xor(q, 1); q += __shfl_xor(q, 2); q += __shfl_xor(q, 4); q += __shfl_xor(q, 8);
        const float rstd = 1.0f / sqrtf(q * (1.0f / MHD) + EPS);
        const u32x4 xw = xwv[u]; const u32x4 ow = owv[u];
        const float xv[8] = {bflo(xw.x), bfhi(xw.x), bflo(xw.y), bfhi(xw.y), bflo(xw.z), bfhi(xw.z), bflo(xw.w), bfhi(xw.w)};
        const float ov[8] = {bflo(ow.x), bfhi(ow.x), bflo(ow.y), bfhi(ow.y), bflo(ow.z), bfhi(ow.z), bflo(ow.w), bfhi(ow.w)};
        float o[8];
#pragma unroll
        for (int c = 0; c < 8; ++c) o[c] = sigmoidf_(ov[c]) * (h[c] * rstd * gm[c] + wsk[c] * xv[c]);
        if (P6_FP8) { u32x2 q; q.x = pg8::pk4_fp8(o[0] * pg8::F8_XS, o[1] * pg8::F8_XS, o[2] * pg8::F8_XS, o[3] * pg8::F8_XS); q.y = pg8::pk4_fp8(o[4] * pg8::F8_XS, o[5] * pg8::F8_XS, o[6] * pg8::F8_XS, o[7] * pg8::F8_XS); *(u32x2*)((unsigned char*)hm + (size_t)t * MW + 8 * lane) = q; }
        else { u32x4 w; w.x = pk2(o[0], o[1]); w.y = pk2(o[2], o[3]); w.z = pk2(o[4], o[5]); w.w = pk2(o[6], o[7]); *(u32x4*)(hm + (size_t)t * MW + 8 * lane) = w; }
        }
    }
}

DI void ln_pass(const float* res, const float* add, const float* g, const float* b, float* out, bf16_t* outb, int vcu, int G, int wv = 0) {
    const int lane = lane_id(); const int wave = wv;
    const int gw = vcu * NWAVES + wave, NGW = G * NWAVES;
    for (int t = gw; t < T; t += NGW) {
        f32x4 v[4]; float s = 0.f;
#pragma unroll
        for (int j = 0; j < 4; ++j) { const f32x4 r = *(const f32x4*)(res + (size_t)t * D + 4 * lane + 256 * j), a = *(const f32x4*)(add + (size_t)t * D + 4 * lane + 256 * j);
            v[j] = r * DN_ALPHA + a; s += (v[j][0] + v[j][1]) + (v[j][2] + v[j][3]); }
        const float mean = wave_sum(s) * (1.0f / D); float q = 0.f;
#pragma unroll
        for (int j = 0; j < 4; ++j) { v[j] = v[j] - mean; q += (v[j][0] * v[j][0] + v[j][1] * v[j][1]) + (v[j][2] * v[j][2] + v[j][3] * v[j][3]); }
        const float rstd = 1.0f / sqrtf(wave_sum(q) * (1.0f / D) + EPS);
#pragma unroll
        for (int j = 0; j < 4; ++j) { const f32x4 gg = *(const f32x4*)(g + 4 * lane + 256 * j), bb = *(const f32x4*)(b + 4 * lane + 256 * j);
            const f32x4 y = v[j] * rstd * gg + bb;
            *(f32x4*)(out + (size_t)t * D + 4 * lane + 256 * j) = y;
            if (outb) { u32x2 w; w.x = pk2(y[0], y[1]); w.y = pk2(y[2], y[3]); *(u32x2*)(outb + (size_t)t * D + 4 * lane + 256 * j) = w; } }
    }
}

DI void build_tstart(CArgs args, LAS unsigned char* lds, int wv) {
    const unsigned* gcnt = (const unsigned*)(args->ws + WS_CTL) + CW_CNT; LAS int* tst = (LAS int*)(lds + TST_OFF); LAS int* tile_e = (LAS int*)(lds + TILE_E_OFF);
    const int tidb = wv * 64 + lane_id();
    if (tidb < 64) {
        const int e = tidb & 31; const unsigned c = __hip_atomic_load(gcnt + e * CNT_STRIDE, RLX_AGENT); const int tl = (int)((c + 255u) >> 8);
        int sc = tl;
#pragma unroll
        for (int o = 1; o < 32; o <<= 1) { const int tv = __shfl_up(sc, o); if (e >= o) sc += tv; }
        if (tidb < 32) { tst[e] = sc - tl; ((LAS int*)(lds + HIST_OFF))[e] = (int)c; if (e == 31) tst[NE] = sc; } }
    __syncthreads();
    for (int t = tidb; t < tst[NE]; t += NWAVES * 64) { int e = 0;
        for (int j = 1; j < NE; ++j) e += (tst[j] <= t) ? 1 : 0;
        tile_e[t] = e; }
    __syncthreads();
}
constexpr int RT_WROW = 2064, RT_G_OFF = 32 * RT_WROW;
DI void p14_router(CArgs args, LAS unsigned char* lds, int vcu, int G, int wv) {
    unsigned char* ws = args->ws;
    const int lane = lane_id(); const int fr = lane & 15, fq = lane >> 4; int tid = wv * 64 + lane; asm volatile("" : "+v"(tid));
    { const u32x4* src = (const u32x4*)(ws + WS_W_R);
      for (int i = tid; i < 32 * 128; i += NWAVES * 64) { const int n = i >> 7, c = i & 127; *(LAS u32x4*)(lds + n * RT_WROW + c * 16) = src[i]; }
      const float* g2 = (const float*)args->in[24]; const float* b2 = (const float*)args->in[25]; LAS float* gl = (LAS float*)(lds + RT_G_OFF);
      for (int i = tid; i < 1024; i += NWAVES * 64) { gl[i] = g2[i] * pg8::F8_XS; gl[1024 + i] = b2[i] * pg8::F8_XS; }
      __syncthreads(); }
    const unsigned char* v2 = ws + WS_V2B; const float* stats2 = (const float*)(ws + WS_STATS2); unsigned char* xn8 = ws + WS_XG;
    const float* cs = (const float*)(ws + CTL_CSR); const float* cb = (const float*)(ws + CTL_CBR);
    const LAS float* gl = (const LAS float*)(lds + RT_G_OFF) + 16 * fq;
    const LAS unsigned char* wl = lds + fr * RT_WROW + 32 * fq;
    LAS float* lg = (LAS float*)(lds + RT_G_OFF + 8192);
    const float* b_router = (const float*)args->in[27]; unsigned* gcnt = (unsigned*)(ws + WS_CTL) + CW_CNT;
    LAS unsigned* hist = (LAS unsigned*)(lds + HIST_OFF); LAS unsigned* hbase = (LAS unsigned*)(lds + HBASE_OFF);
    int* tokpos = (int*)(ws + WS_TOKPOS); float* rowgate = (float*)(ws + WS_ROWGATE); unsigned short* rowtok = (unsigned short*)(ws + WS_ROWTOK);
    for (int blk = vcu; blk < T / 128; blk += G) {
        const int row = blk * 128 + wv * 16 + fr;
        const f32x4 p0 = *(const f32x4*)(stats2 + ((size_t)row * 16 + 4 * fq) * 2), p1 = *(const f32x4*)(stats2 + ((size_t)row * 16 + 4 * fq + 2) * 2);
        float s1 = (p0[0] + p0[2]) + (p1[0] + p1[2]), s2 = (p0[1] + p0[3]) + (p1[1] + p1[3]);
        s1 += __shfl_xor(s1, 16); s2 += __shfl_xor(s2, 16); s1 += __shfl_xor(s1, 32); s2 += __shfl_xor(s2, 32);
        float mean, rstd; pg8::stats_finish(s1, s2, mean, rstd);
        f32x4 acc0 = {0.f, 0.f, 0.f, 0.f}, acc1 = {0.f, 0.f, 0.f, 0.f};
        const unsigned char* ap = v2 + (size_t)row * 2048 + 32 * fq; unsigned char* op = xn8 + (size_t)row * 1024 + 16 * fq;
#pragma unroll 1
        for (int h = 0; h < 2; ++h) {
            u32x4 a[16];
#pragma unroll
            for (int p = 0; p < 8; ++p) { a[2 * p] = *(const u32x4*)(ap + (h * 8 + p) * 128); a[2 * p + 1] = *(const u32x4*)(ap + (h * 8 + p) * 128 + 16); }
#pragma unroll
            for (int p = 0; p < 8; ++p) { const int pp = h * 8 + p; u32x4 o;
#pragma unroll
                for (int s = 0; s < 2; ++s) { const u32x4 w = a[2 * p + s]; const bf16x8 af = __builtin_bit_cast(bf16x8, w);
                    const bf16x8 b0 = *(const LAS bf16x8*)(wl + pp * 128 + 16 * s), b1 = *(const LAS bf16x8*)(wl + 16 * RT_WROW + pp * 128 + 16 * s);
                    acc0 = __builtin_amdgcn_mfma_f32_16x16x32_bf16(b0, af, acc0, 0, 0, 0); acc1 = __builtin_amdgcn_mfma_f32_16x16x32_bf16(b1, af, acc1, 0, 0, 0);
                    const f32x4 g0 = *(const LAS f32x4*)(gl + pp * 64 + 8 * s), g1 = *(const LAS f32x4*)(gl + pp * 64 + 8 * s + 4), c0 = *(const LAS f32x4*)(gl + 1024 + pp * 64 + 8 * s), c1 = *(const LAS f32x4*)(gl + 1024 + pp * 64 + 8 * s + 4);
                    const f32x4 x0 = {bflo(w.x), bfhi(w.x), bflo(w.y), bfhi(w.y)}, x1 = {bflo(w.z), bfhi(w.z), bflo(w.w), bfhi(w.w)};
                    const f32x4 y0 = (x0 - mean) * rstd * g0 + c0, y1 = (x1 - mean) * rstd * g1 + c1;
                    o[2 * s] = pg8::pk4_fp8(y0[0], y0[1], y0[2], y0[3]); o[2 * s + 1] = pg8::pk4_fp8(y1[0], y1[1], y1[2], y1[3]); }
                *(u32x4*)(op + pp * 64) = o; __builtin_amdgcn_sched_barrier(0); }
        }
        { const f32x4 cs0 = *(const f32x4*)(cs + 4 * fq), cs1 = *(const f32x4*)(cs + 16 + 4 * fq), cb0 = *(const f32x4*)(cb + 4 * fq), cb1 = *(const f32x4*)(cb + 16 + 4 * fq);
          const f32x4 l0 = (acc0 - cs0 * mean) * rstd + cb0, l1 = (acc1 - cs1 * mean) * rstd + cb1;
          LAS float* lw = lg + (wv * 16 + fr) * 33 + 4 * fq;
          lw[0] = l0[0]; lw[1] = l0[1]; lw[2] = l0[2]; lw[3] = l0[3]; lw[16] = l1[0]; lw[17] = l1[1]; lw[18] = l1[2]; lw[19] = l1[3]; }
        if (tid < NE) hist[tid] = 0u;
        __syncthreads();
        int idx[TOPK]; float gate[TOPK]; unsigned lr[TOPK];
        if (tid < 128) {
            float v[NE];
#pragma unroll
            for (int j = 0; j < NE; ++j) v[j] = lg[tid * 33 + j] + b_router[j];
            float val[TOPK];
#pragma unroll
            for (int k = 0; k < TOPK; ++k) { float best = -INFINITY; int bi = 0;
#pragma unroll
                for (int e = 0; e < NE; ++e) { bool taken = false;
#pragma unroll
                    for (int kk = 0; kk < k; ++kk) taken = taken || (idx[kk] == e);
                    if (!taken && v[e] > best) { best = v[e]; bi = e; } }
                idx[k] = bi; val[k] = best; }
            float sum = 0.f;
#pragma unroll
            for (int k = 0; k < TOPK; ++k) { gate[k] = __expf(val[k] - val[0]); sum += gate[k]; }
            const float inv = 1.0f / sum;
#pragma unroll
            for (int k = 0; k < TOPK; ++k) { gate[k] *= inv; lr[k] = __hip_atomic_fetch_add(hist + idx[k], 1u, __ATOMIC_RELAXED, __HIP_MEMORY_SCOPE_WORKGROUP); }
        }
        __syncthreads();
        if (tid < NE) hbase[tid] = __hip_atomic_fetch_add(gcnt + tid * CNT_STRIDE, hist[tid], RLX_AGENT);
        __syncthreads();
        if (tid < 128) { const int t = blk * 128 + tid;
#pragma unroll
            for (int k = 0; k < TOPK; ++k) { const int e = idx[k]; const int rank = (int)(hbase[e] + lr[k]);
                tokpos[(size_t)t * TOPK + k] = (e << 20) | rank; rowgate[(size_t)e * RCAP + rank] = gate[k]; rowtok[(size_t)e * RCAP + rank] = (unsigned short)t; } }
        __syncthreads();
    }
}
DI void p20_final(CArgs args, LAS unsigned char* lds, int vcu, int G, int wv, bool have_tst) {
    if (!have_tst) build_tstart(args, lds, wv);
    const LAS int* tst = (const LAS int*)(lds + TST_OFF);
    const int lane = lane_id(); const int wave = wv;
    unsigned char* ws = args->ws;
    const int* tokpos = (const int*)(ws + WS_TOKPOS); const unsigned char* yb = ws + WS_YB;
    const bf16_t* v2 = (const bf16_t*)(ws + WS_V2B); const float* stats2 = (const float*)(ws + WS_STATS2);
    const float* g2 = (const float*)args->in[24]; const float* b2 = (const float*)args->in[25];
    const float* g = (const float*)args->in[32]; const float* b = (const float*)args->in[33]; float* out = args->out;
    const int gw = vcu * NWAVES + wave, NGW = G * NWAVES;
    f32x4 g2v[4], b2v[4], g3v[4], b3v[4];
#pragma unroll
    for (int jj = 0; jj < 4; ++jj) { g2v[jj] = *(const f32x4*)(g2 + 4 * lane + 256 * jj); b2v[jj] = *(const f32x4*)(b2 + 4 * lane + 256 * jj); g3v[jj] = *(const f32x4*)(g + 4 * lane + 256 * jj); b3v[jj] = *(const f32x4*)(b + 4 * lane + 256 * jj); }
    constexpr int U = 4;
    for (int t0 = gw; t0 < T; t0 += U * NGW) {
        int tt[U]; int pos[U][TOPK]; f32x2 sp[U]; u32x2 vw[U][4];
#pragma unroll
        for (int u = 0; u < U; ++u) { tt[u] = (t0 + u * NGW < T) ? t0 + u * NGW : t0;
#pragma unroll
            for (int k = 0; k < TOPK; ++k) { const int asv = tokpos[(size_t)tt[u] * TOPK + (lane & 3)];
                const int as = __builtin_amdgcn_readlane(asv, k); pos[u][k] = tst[as >> 20] * 256 + (as & 0xfffff); }
            sp[u] = (f32x2){0.f, 0.f}; if (lane < 16) sp[u] = *(const f32x2*)(stats2 + ((size_t)tt[u] * 16 + lane) * 2);
#pragma unroll
            for (int j = 0; j < 4; ++j) vw[u][j] = *(const u32x2*)(v2 + (size_t)tt[u] * D + 4 * lane + 256 * j); }
        int yw[U][4][TOPK];
#pragma unroll
        for (int u = 0; u < U; ++u)
#pragma unroll
            for (int j = 0; j < 4; ++j)
#pragma unroll
                for (int k = 0; k < TOPK; ++k) yw[u][j][k] = *(const int*)(yb + (size_t)pos[u][k] * D + 4 * lane + 256 * j);
#pragma unroll
        for (int u = 0; u < U; ++u) {
            float s1 = sp[u][0], s2 = sp[u][1];
#pragma unroll
            for (int o = 1; o < 16; o <<= 1) { s1 += __shfl_xor(s1, o); s2 += __shfl_xor(s2, o); }
            s1 = __shfl(s1, 0); s2 = __shfl(s2, 0);
            float mean2, rstd2; pg8::stats_finish(s1, s2, mean2, rstd2);
            f32x4 v[4]; float s = 0.f;
#pragma unroll
            for (int j = 0; j < 4; ++j) { const f32x4 vin = {bflo(vw[u][j].x), bfhi(vw[u][j].x), bflo(vw[u][j].y), bfhi(vw[u][j].y)};
                const f32x4 r = (vin - mean2) * rstd2 * g2v[j] + b2v[j];
                f32x4 a = {0.f, 0.f, 0.f, 0.f};
#pragma unroll
                for (int k = 0; k < TOPK; ++k) { const int w = yw[u][j][k]; const f32x2 lo = __builtin_amdgcn_cvt_pk_f32_fp8(w, false), hi2 = __builtin_amdgcn_cvt_pk_f32_fp8(w, true); a[0] += lo[0]; a[1] += lo[1]; a[2] += hi2[0]; a[3] += hi2[1]; }
                v[j] = r * DN_ALPHA + a * (1.0f / pg8::F8_YS); s += (v[j][0] + v[j][1]) + (v[j][2] + v[j][3]); }
            const float mean = wave_sum(s) * (1.0f / D); float q = 0.f;
#pragma unroll
            for (int j = 0; j < 4; ++j) { v[j] = v[j] - mean; q += (v[j][0] * v[j][0] + v[j][1] * v[j][1]) + (v[j][2] * v[j][2] + v[j][3] * v[j][3]); }
            const float rstd = 1.0f / sqrtf(wave_sum(q) * (1.0f / D) + EPS);
            if (u == 0 || t0 + u * NGW < T) {
#pragma unroll
                for (int j = 0; j < 4; ++j) { const f32x4 gg = g3v[j], bb = b3v[j];
                    *(f32x4*)(out + (size_t)tt[u] * D + 4 * lane + 256 * j) = v[j] * rstd * gg + bb; } }
        }
    }
}
constexpr float F8_XS_ = 16.0f;
#ifndef ML4_A0
#define ML4_A0 0x00u
#endif
#ifndef ML4_B0
#define ML4_B0 0x00u
#endif
#ifndef ML_NS_
#define ML_NS_ 4
#endif
constexpr int ML_NS = ML_NS_;
constexpr int ML_IW = (ML_NS == 4) ? 4 : 2;
constexpr int ML_WSL = ML_NS * 2 / ML_IW;
constexpr int ML_SVN = (ML_NS + 1) / 2;
constexpr int AT_KROW = 208, AT_VROW = 264;
constexpr int AT_KBUF = 128 * AT_KROW, AT_VBUF = 64 * AT_VROW, AT_VOFF = 2 * AT_KBUF;
DI float max2f_(float a, float b) { return __builtin_amdgcn_fmed3f(a, b, INFINITY); }
#define MLA_QK(P0, P1, kbase) do { _Pragma("unroll") for (int r_ = 0; r_ < 16; ++r_) { P0[r_] = 0.f; P1[r_] = 0.f; } \
        _Pragma("unroll") for (int s_ = 0; s_ < 6; ++s_) { const bf16x8 a0_ = *(const LAS bf16x8*)((kbase) + s_ * 32), a1_ = *(const LAS bf16x8*)((kbase) + 32 * AT_KROW + s_ * 32); \
            P0 = MFMA32(a0_, qf[s_], P0); P1 = MFMA32(a1_, qf[s_], P1); } } while (0)
#define MLA_SOFTPV(P0, P1, vbase, MASK, key0) do { \
        if (MASK) { _Pragma("unroll") for (int r_ = 0; r_ < 16; ++r_) { const int key_ = (key0) + crow(r_, hi); if (key_ > qi) P0[r_] = -INFINITY; if (key_ + 32 > qi) P1[r_] = -INFINITY; } } \
        float mx_ = max2f_(P0[0], P1[0]); \
        _Pragma("unroll") for (int r_ = 1; r_ < 16; ++r_) { mx_ = max2f_(mx_, P0[r_]); mx_ = max2f_(mx_, P1[r_]); } \
        mx_ = fmaxf(mx_, __shfl_xor(mx_, 32)); \
        const float m_new_ = fmaxf(m_run, mx_); const float alpha_ = __builtin_amdgcn_exp2f(m_run - m_new_); m_run = m_new_; \
        f32x2 ls2_ = {0.f, 0.f}; \
        _Pragma("unroll") for (int r_ = 0; r_ < 16; ++r_) { P0[r_] = __builtin_amdgcn_exp2f(P0[r_] - m_new_); P1[r_] = __builtin_amdgcn_exp2f(P1[r_] - m_new_); } \
        _Pragma("unroll") for (int r_ = 0; r_ < 16; r_ += 2) { ls2_ += (f32x2){P0[r_], P0[r_ + 1]}; ls2_ += (f32x2){P1[r_], P1[r_ + 1]}; } \
        l_run = l_run * alpha_ + (ls2_[0] + ls2_[1]); \
        if (!__all(alpha_ == 1.0f)) { _Pragma("unroll") for (int r_ = 0; r_ < 16; ++r_) { o0[r_] *= alpha_; o1[r_] *= alpha_; } } \
        _Pragma("unroll") for (int s_ = 0; s_ < 4; ++s_) { u32x4 w_; \
            if (s_ < 2) { w_.x = pk2(P0[8 * s_], P0[8 * s_ + 1]); w_.y = pk2(P0[8 * s_ + 2], P0[8 * s_ + 3]); w_.z = pk2(P0[8 * s_ + 4], P0[8 * s_ + 5]); w_.w = pk2(P0[8 * s_ + 6], P0[8 * s_ + 7]); } \
            else { w_.x = pk2(P1[8 * s_ - 16], P1[8 * s_ - 15]); w_.y = pk2(P1[8 * s_ - 14], P1[8 * s_ - 13]); w_.z = pk2(P1[8 * s_ - 12], P1[8 * s_ - 11]); w_.w = pk2(P1[8 * s_ - 10], P1[8 * s_ - 9]); } \
            const bf16x8 pb_ = __builtin_bit_cast(bf16x8, w_); \
            const u32x2 a0l_ = *(const LAS u32x2*)((vbase) + s_ * 32), a0h_ = *(const LAS u32x2*)((vbase) + s_ * 32 + 16); \
            const u32x2 a1l_ = *(const LAS u32x2*)((vbase) + 32 * AT_VROW + s_ * 32), a1h_ = *(const LAS u32x2*)((vbase) + 32 * AT_VROW + s_ * 32 + 16); \
            const bf16x8 a0_ = __builtin_bit_cast(bf16x8, (u32x4){a0l_.x, a0l_.y, a0h_.x, a0h_.y}), a1_ = __builtin_bit_cast(bf16x8, (u32x4){a1l_.x, a1l_.y, a1h_.x, a1h_.y}); \
            o0 = MFMA32(a0_, pb_, o0); o1 = MFMA32(a1_, pb_, o1); } } while (0)
DI void mla_unit(int b, int h, int qb, const bf16_t* Q, const bf16_t* Kn, const bf16_t* Kpe, const bf16_t* Vt, bf16_t* O, LAS unsigned char* lds, int wv, bool pre = false, bool has_next = false, int nb_ = 0, int nh_ = 0) {
    int tid = wv * 64 + lane_id(); asm volatile("" : "+v"(tid)); const int lane = tid & 63, r32 = lane & 31, hi = lane >> 5; const int wid = wv;
    const int q0 = qb * 256 + wid * 32;
    const int qi = q0 + r32;
    const size_t tokb = (size_t)b * SEQ;
    bf16x8 qf[6];
    { const bf16_t* qp = Q + (tokb + qi) * (AH * AQK) + h * AQK + 8 * hi;
#pragma unroll
      for (int s = 0; s < 6; ++s) qf[s] = *(const bf16x8*)(qp + 16 * s); }
    const int kkey = tid >> 3, kch = tid & 7, pkey = tid >> 2, pch = tid & 3, vd = tid >> 3, vch = tid & 7;
    const bf16_t* ksrc = Kn + (tokb + kkey) * 512 + h * 64 + kch * 8;
    const bf16_t* psrc = Kpe + (tokb + pkey) * 32 + pch * 8;
    const bf16_t* vsrc = Vt + (size_t)(h * 64 + vd) * T + tokb + vch * 8;
    const int kdst = kkey * AT_KROW + kch * 16, pdst = pkey * AT_KROW + 128 + pch * 16, vdst = AT_VOFF + vd * AT_VROW + vch * 16;
    const int nbt = 2 * (qb + 1), nfull = 2 * qb;
    u32x4 rk0, rk1, rp, rv0, rv1;
#define MLA_LD(t) do { rk0 = *(const u32x4*)(ksrc + (size_t)(t) * 128 * 512); rk1 = *(const u32x4*)(ksrc + ((size_t)(t) * 128 + 64) * 512); rp = *(const u32x4*)(psrc + (size_t)(t) * 128 * 32); \
        rv0 = *(const u32x4*)(vsrc + (t) * 128); rv1 = *(const u32x4*)(vsrc + (t) * 128 + 64); } while (0)
#define MLA_ST(buf) do { *(LAS u32x4*)(lds + (buf) * AT_KBUF + kdst) = rk0; *(LAS u32x4*)(lds + (buf) * AT_KBUF + 64 * AT_KROW + kdst) = rk1; *(LAS u32x4*)(lds + (buf) * AT_KBUF + pdst) = rp; \
        *(LAS u32x2*)(lds + (buf) * AT_VBUF + vdst) = (u32x2){rv0.x, rv0.y}; *(LAS u32x2*)(lds + (buf) * AT_VBUF + vdst + 8) = (u32x2){rv0.z, rv0.w}; \
        *(LAS u32x2*)(lds + (buf) * AT_VBUF + vdst + 128) = (u32x2){rv1.x, rv1.y}; *(LAS u32x2*)(lds + (buf) * AT_VBUF + vdst + 136) = (u32x2){rv1.z, rv1.w}; } while (0)
    if (!pre) { MLA_LD(0); MLA_ST(0); __syncthreads(); }
    const size_t ntokb = (size_t)nb_ * SEQ;
    const bf16_t* nksrc = Kn + (ntokb + kkey) * 512 + nh_ * 64 + kch * 8; const bf16_t* npsrc = Kpe + (ntokb + pkey) * 32 + pch * 8; const bf16_t* nvsrc = Vt + (size_t)(nh_ * 64 + vd) * T + ntokb + vch * 8;
#define MLA_LDN() do { rk0 = *(const u32x4*)(nksrc); rk1 = *(const u32x4*)(nksrc + (size_t)64 * 512); rp = *(const u32x4*)(npsrc); rv0 = *(const u32x4*)(nvsrc); rv1 = *(const u32x4*)(nvsrc + 64); } while (0)
    float m_run = -INFINITY, l_run = 0.f;
    f32x16 o0, o1, pa0, pa1, pb0, pb1;
#pragma unroll
    for (int r = 0; r < 16; ++r) { o0[r] = 0.f; o1[r] = 0.f; }
    const LAS unsigned char* kl = lds + r32 * AT_KROW + hi * 16; const LAS unsigned char* vl = lds + AT_VOFF + r32 * AT_VROW + hi * 8;
    int t = 0;
    for (; t < nfull; ++t) {
        MLA_LD(t + 1);
        const LAS unsigned char* kb = kl + (t & 1) * AT_KBUF; const LAS unsigned char* vb = vl + (t & 1) * AT_VBUF;
        MLA_QK(pa0, pa1, kb);
        MLA_QK(pb0, pb1, kb + 64 * AT_KROW);
        MLA_SOFTPV(pa0, pa1, vb, false, 0);
        MLA_SOFTPV(pb0, pb1, vb + 128, false, 0);
        MLA_ST((t + 1) & 1);
        __syncthreads();
    }
    for (; t < nbt; ++t) {
        if (t + 1 < nbt) MLA_LD(t + 1); else if (has_next) MLA_LDN();
        const LAS unsigned char* kb = kl + (t & 1) * AT_KBUF; const LAS unsigned char* vb = vl + (t & 1) * AT_VBUF;
        const int key0 = t * 128;
        if (key0 <= q0 + 31) { MLA_QK(pa0, pa1, kb); MLA_SOFTPV(pa0, pa1, vb, true, key0); }
        if (key0 + 64 <= q0 + 31) { MLA_QK(pb0, pb1, kb + 64 * AT_KROW); MLA_SOFTPV(pb0, pb1, vb + 128, true, key0 + 64); }
        if (t + 1 < nbt || has_next) MLA_ST((t + 1) & 1);
        __syncthreads();
    }
#undef MLA_LDN
#undef MLA_LD
#undef MLA_ST
    const float lt = l_run + __shfl_xor(l_run, 32); const float inv = 1.0f / lt;
    if (P6_FP8) { unsigned char* op8 = (unsigned char*)O + (tokb + qi) * AW + h * AVD + 4 * hi; const float sc = inv * F8_XS_;
#pragma unroll
        for (int g = 0; g < 4; ++g) { *(unsigned*)(op8 + 8 * g) = pg8::pk4_fp8(o0[4 * g] * sc, o0[4 * g + 1] * sc, o0[4 * g + 2] * sc, o0[4 * g + 3] * sc);
            *(unsigned*)(op8 + 32 + 8 * g) = pg8::pk4_fp8(o1[4 * g] * sc, o1[4 * g + 1] * sc, o1[4 * g + 2] * sc, o1[4 * g + 3] * sc); } }
    else {
    bf16_t* op = O + (tokb + qi) * AW + h * AVD + 4 * hi;
#pragma unroll
    for (int g = 0; g < 4; ++g) { u32x2 w0, w1;
        w0.x = pk2(o0[4 * g] * inv, o0[4 * g + 1] * inv); w0.y = pk2(o0[4 * g + 2] * inv, o0[4 * g + 3] * inv);
        w1.x = pk2(o1[4 * g] * inv, o1[4 * g + 1] * inv); w1.y = pk2(o1[4 * g + 2] * inv, o1[4 * g + 3] * inv);
        *(u32x2*)(op + 8 * g) = w0; *(u32x2*)(op + 32 + 8 * g) = w1; } }
}
DI void p4_attention(CArgs args, LAS unsigned char* lds, int vcu, int G, int wv) {
    unsigned char* ws = args->ws;
    const bf16_t* Q = (const bf16_t*)(ws + WS_QMLA); const bf16_t* Kn = (const bf16_t*)(ws + WS_KN); const bf16_t* Kpe = (const bf16_t*)(ws + WS_KPE); const bf16_t* Vt = (const bf16_t*)(ws + WS_VT);
    bf16_t* O = (bf16_t*)(ws + WS_AO);
    if (ML_NS == 2 && G == 2 * NB * AH && NB * MH * 2 == NB * AH) {
        const int bh = vcu % (NB * AH); const int b = bh / AH, h = bh % AH;
        if (vcu < NB * AH) { mla_unit(b, h, 7, Q, Kn, Kpe, Vt, O, lds, wv); mla_unit(b, h, 1, Q, Kn, Kpe, Vt, O, lds, wv); }
        else {
#pragma unroll 1
            for (int qb = 6; qb >= 0; --qb) if (qb != 1) mla_unit(b, h, qb, Q, Kn, Kpe, Vt, O, lds, wv); }
        return;
    }
    if (ML_NS == 4 && G == 4 * NB * MH && NB * AH == 2 * NB * MH) {
        const int g = vcu >> 2, r = vcu & 3; const int bhA = 2 * g, bhB = 2 * g + 1;
        unsigned long long lst = (r == 1) ? 0x080F0607ull : (r == 2) ? 0x0C0E000405ull : (r == 3) ? 0x090A0B0D010203ull : 0ull; int n = (r == 1) ? 4 : (r == 2) ? 5 : (r == 3) ? 7 : 0;
        bool pre = false;
#pragma unroll 1
        for (int i = 0; i < n; ++i) { const int cur = (int)(lst & 0xff), nx = (int)((lst >> 8) & 0xff); lst >>= 8;
            const int bh = (cur & 8) ? bhB : bhA, nbh = (nx & 8) ? bhB : bhA; const bool hn = (i + 1 < n);
            mla_unit(bh / AH, bh % AH, cur & 7, Q, Kn, Kpe, Vt, O, lds, wv, pre, hn, nbh / AH, nbh % AH); pre = hn; }
        return;
    }
    for (int p = vcu; p < NB * AH * 4; p += G) { const int bh = p >> 2, j = p & 3; const int b = bh / AH, h = bh % AH;
        mla_unit(b, h, 7 - j, Q, Kn, Kpe, Vt, O, lds, wv);
        mla_unit(b, h, j, Q, Kn, Kpe, Vt, O, lds, wv); }
}

constexpr int ML_QROW = 272, ML_TROW = 144;
constexpr int ML_QS = 0, ML_KS = ML_QS + 64 * ML_QROW, ML_KTS = ML_KS + 64 * ML_QROW, ML_VTS = ML_KTS + 128 * ML_TROW, ML_CS = ML_VTS + ML_NS * 32 * ML_TROW, ML_SS = ML_CS + ML_NS * 32 * ML_QROW,
              ML_VEC = ML_SS + 64 * ML_TROW;
constexpr int ML_VBUF = 5 * 64 + 16;
static_assert(ML_VEC + (2 * ML_VBUF + 2 * 64 + 128) * 4 <= RING_BYTES, "mLSTM LDS");
DI void mlstm_unit(int b, int h, int vs, CArgs args, LAS unsigned char* lds, int wv) {
    unsigned char* ws = args->ws;
    const bf16_t* qkm = (const bf16_t*)(ws + WS_QKM); const bf16_t* ktm = (const bf16_t*)(ws + WS_KTM); const bf16_t* proj = (const bf16_t*)(ws + WS_PROJ);
    const float* gates = (const float*)(ws + WS_GATES); bf16_t* hraw = (bf16_t*)(ws + WS_HRAW);
    const float b_i = ((const float*)args->in[4])[h], b_f = ((const float*)args->in[5])[h];
    int tid = wv * 64 + lane_id(); asm volatile("" : "+v"(tid)); const int lane = tid & 63, r32 = lane & 31, hi = lane >> 5; const int wid = wv;
    LAS float* VEC0 = (LAS float*)(lds + ML_VEC);
    LAS float* NQ = VEC0 + 2 * ML_VBUF; LAS float* DINV = NQ + 64; LAS float* NVEC = NQ + 128;
    const size_t tokb = (size_t)b * SEQ;
    for (int i = tid; i < ML_NS * 32 * ML_QROW / 4; i += 512) ((LAS unsigned*)(lds + ML_CS))[i] = 0u;
    if (tid < 128) NVEC[tid] = 0.f;
    f32x16 cacc[ML_NS];
#pragma unroll
    for (int s = 0; s < ML_NS; ++s)
#pragma unroll
        for (int r = 0; r < 16; ++r) cacc[s][r] = 0.f;
    float m_st = 0.f;
    u32x4 sq[2], sk[2], skt[2], sv[ML_SVN]; float gi = 0.f, gf = 0.f;
#pragma unroll
    for (int i = 0; i < ML_SVN; ++i) sv[i] = (u32x4){0u, 0u, 0u, 0u};
#define ML_LOAD(c) do { const size_t tok0 = tokb + (size_t)(c) * MCH; \
        _Pragma("unroll") for (int i = 0; i < 2; ++i) { const int idx = tid + 512 * i; \
            sq[i] = *(const u32x4*)(qkm + (tok0 + (idx >> 4)) * 1024 + h * MHD + (idx & 15) * 8); \
            sk[i] = *(const u32x4*)(qkm + (tok0 + (idx >> 4)) * 1024 + 512 + h * MHD + (idx & 15) * 8); \
            skt[i] = *(const u32x4*)(ktm + (size_t)(h * MHD + (idx >> 3)) * T + tok0 + (idx & 7) * 8); } \
        _Pragma("unroll") for (int i = 0; i < ML_SVN; ++i) if ((tid >> 8) + 2 * i < ML_NS) sv[i] = *(const u32x4*)(proj + (tok0 + (tid & 63)) * NPROJ + PC_VM + h * MHD + (vs + (tid >> 8) + 2 * i) * 32 + ((tid >> 6) & 3) * 8); } while (0)
#define ML_GLOAD(c) do { const size_t tok0_ = tokb + (size_t)(c) * MCH; gi = gates[(tok0_ + lane) * 8 + h]; gf = gates[(tok0_ + lane) * 8 + 4 + h]; } while (0)
#define ML_GVEC(vb) do { LAS float* ROWT_ = (vb); \
            const float xf = gf + b_f; \
            const float lf = (xf >= 0.f) ? -log1pf(__expf(-xf)) : xf - log1pf(__expf(xf)); \
            float bb = lf; \
            _Pragma("unroll") for (int o = 1; o < 64; o <<= 1) { const float tv = __shfl_up(bb, o); if (lane >= o) bb += tv; } \
            const float btot = __builtin_bit_cast(float, __builtin_amdgcn_readlane(__builtin_bit_cast(int, bb), 63)); \
            const float ig = gi + b_i; \
            const float a = btot - bb + ig; \
            const float mchunk = wave_max(a); \
            const float wa = __expf(a - mchunk); \
            const float u = ig - bb; \
            float pm = u; \
            _Pragma("unroll") for (int o = 1; o < 64; o <<= 1) { const float tv = __shfl_up(pm, o); if (lane >= o) pm = fmaxf(pm, tv); } \
            const float mintra = bb + pm; \
            const float ginter = bb + m_st; \
            const float m = fmaxf(ginter, mintra); \
            const float mnew = fmaxf(btot + m_st, mchunk); \
            const float sold = __expf(btot + m_st - mnew), snew = __expf(mchunk - mnew); \
            ROWT_[lane] = bb - m; ROWT_[64 + lane] = u; ROWT_[128 + lane] = __expf(ginter - m); ROWT_[192 + lane] = __expf(-m); ROWT_[256 + lane] = snew * wa; \
            if (lane == 0) ROWT_[320] = sold; \
            m_st = mnew; } while (0)
    if (wid == 1) { ML_GLOAD(0); ML_GVEC(VEC0); ML_GLOAD(1);
        LAS bf16_t* ss0 = (LAS bf16_t*)(lds + ML_SS);
#pragma unroll
        for (int r = 0; r < 16; ++r) ss0[crow(r, hi) * (ML_TROW / 2) + 32 + r32] = (bf16_t)0; }
    ML_LOAD(0);
    for (int c = 0; c < SEQ / MCH; ++c) {
        const size_t tok0 = tokb + (size_t)c * MCH;
        LAS float* ROWT = VEC0 + (c & 1) * ML_VBUF; LAS float* COLT = ROWT + 64; LAS float* WINT = ROWT + 128; LAS float* ENEG = ROWT + 192; LAS float* WAS = ROWT + 256; LAS float* SCAL = ROWT + 320;
#pragma unroll
        for (int i = 0; i < 2; ++i) { const int idx = tid + 512 * i;
            *(LAS u32x4*)(lds + ML_QS + (idx >> 4) * ML_QROW + (idx & 15) * 16) = sq[i];
            *(LAS u32x4*)(lds + ML_KS + (idx >> 4) * ML_QROW + (idx & 15) * 16) = sk[i];
            *(LAS u32x4*)(lds + ML_KTS + (idx >> 3) * ML_TROW + (idx & 7) * 16) = skt[i]; }
#pragma unroll
        for (int i = 0; i < ML_SVN; ++i) if ((tid >> 8) + 2 * i < ML_NS) { const int l = tid & 63, v0 = ((tid >> 8) + 2 * i) * 32 + ((tid >> 6) & 3) * 8; LAS bf16_t* vt = (LAS bf16_t*)(lds + ML_VTS); const u32x4 w = sv[i];
            vt[(v0 + 0) * (ML_TROW / 2) + l] = (bf16_t)(w.x & 0xffff); vt[(v0 + 1) * (ML_TROW / 2) + l] = (bf16_t)(w.x >> 16);
            vt[(v0 + 2) * (ML_TROW / 2) + l] = (bf16_t)(w.y & 0xffff); vt[(v0 + 3) * (ML_TROW / 2) + l] = (bf16_t)(w.y >> 16);
            vt[(v0 + 4) * (ML_TROW / 2) + l] = (bf16_t)(w.z & 0xffff); vt[(v0 + 5) * (ML_TROW / 2) + l] = (bf16_t)(w.z >> 16);
            vt[(v0 + 6) * (ML_TROW / 2) + l] = (bf16_t)(w.w & 0xffff); vt[(v0 + 7) * (ML_TROW / 2) + l] = (bf16_t)(w.w >> 16); }
        __syncthreads();
        if (c + 1 < SEQ / MCH) ML_LOAD(c + 1);
        if (wid < 4) {
            const int jb = wid >> 1, sb = wid & 1;
            LAS bf16_t* ss = (LAS bf16_t*)(lds + ML_SS);
            if (sb <= jb) {
                f32x16 s;
#pragma unroll
                for (int r = 0; r < 16; ++r) s[r] = 0.f;
                const LAS unsigned char* qa = lds + ML_QS + (32 * jb + r32) * ML_QROW + hi * 16; const LAS unsigned char* kb = lds + ML_KS + (32 * sb + r32) * ML_QROW + hi * 16;
#pragma unroll
                for (int kk = 0; kk < 8; ++kk) s = MFMA32(*(const LAS bf16x8*)(qa + kk * 32), *(const LAS bf16x8*)(kb + kk * 32), s);
                const int sidx = 32 * sb + r32; const float ct = COLT[sidx];
#pragma unroll
                for (int r = 0; r < 16; ++r) { const int j = 32 * jb + crow(r, hi);
                    const float ev = __builtin_amdgcn_exp2f((ROWT[j] + ct) * 1.4426950408889634f); const float val = (sidx <= j) ? s[r] * ev : 0.f;
                    ss[j * (ML_TROW / 2) + sidx] = (bf16_t)pk2(val, 0.f); }
            } else if (c + 1 < SEQ / MCH) {
                ML_GVEC(VEC0 + ((c + 1) & 1) * ML_VBUF);
                if (c + 2 < SEQ / MCH) ML_GLOAD(c + 2);
            }
        } else {
          if (wid - 4 < ML_IW) {
            const int jb = (wid - 4) & 1, s0 = ((wid - 4) >> 1) * ML_WSL;
            const LAS unsigned char* qa = lds + ML_QS + (32 * jb + r32) * ML_QROW + hi * 16; const LAS unsigned char* cb = lds + ML_CS + (s0 * 32 + r32) * ML_QROW + hi * 16;
#pragma unroll
            for (int s = 0; s < ML_WSL; ++s)
#pragma unroll
                for (int r = 0; r < 16; ++r) cacc[s][r] = 0.f;
#pragma unroll
            for (int kk = 0; kk < 8; ++kk) { const bf16x8 qv = *(const LAS bf16x8*)(qa + kk * 32);
#pragma unroll
                for (int s = 0; s < ML_WSL; ++s) cacc[s] = MFMA32(qv, *(const LAS bf16x8*)(cb + s * 32 * ML_QROW + kk * 32), cacc[s]); }
          }
          if (wid >= 6) {
            const int j = 32 * (wid - 6) + (lane >> 1), half = lane & 1;
            const LAS unsigned char* qa = lds + ML_QS + j * ML_QROW + half * 128; float acc = 0.f;
#pragma unroll
            for (int i = 0; i < 8; ++i) { const u32x4 w = *(const LAS u32x4*)(qa + i * 16); const f32x4 n0 = *(const LAS f32x4*)(NVEC + half * 64 + i * 8), n1 = *(const LAS f32x4*)(NVEC + half * 64 + i * 8 + 4);
                acc += bflo(w.x) * n0[0] + bfhi(w.x) * n0[1] + bflo(w.y) * n0[2] + bfhi(w.y) * n0[3] + bflo(w.z) * n1[0] + bfhi(w.z) * n1[1] + bflo(w.w) * n1[2] + bfhi(w.w) * n1[3]; }
            acc += __shfl_xor(acc, 1);
            if (half == 0) NQ[j] = acc;
          }
        }
        __syncthreads();
        if (wid < 4) {
            const float sold = SCAL[0];
#pragma unroll
            for (int s = 0; s < ML_NS; ++s)
#pragma unroll
                for (int r = 0; r < 16; ++r) cacc[s][r] *= sold;
            const LAS unsigned char* va = lds + ML_VTS + r32 * ML_TROW + hi * 16; const LAS unsigned char* kb = lds + ML_KTS + (32 * wid + r32) * ML_TROW + hi * 16;
#pragma unroll
            for (int kk = 0; kk < 4; ++kk) { const u32x4 w = *(const LAS u32x4*)(kb + kk * 32);
                const f32x4 w0 = *(const LAS f32x4*)(WAS + 16 * kk + 8 * hi), w1 = *(const LAS f32x4*)(WAS + 16 * kk + 8 * hi + 4);
                u32x4 ka; ka.x = pk2(bflo(w.x) * w0[0], bfhi(w.x) * w0[1]); ka.y = pk2(bflo(w.y) * w0[2], bfhi(w.y) * w0[3]); ka.z = pk2(bflo(w.z) * w1[0], bfhi(w.z) * w1[1]); ka.w = pk2(bflo(w.w) * w1[2], bfhi(w.w) * w1[3]);
                const bf16x8 kv = __builtin_bit_cast(bf16x8, ka);
#pragma unroll
                for (int s = 0; s < ML_NS; ++s) cacc[s] = MFMA32(kv, *(const LAS bf16x8*)(va + s * 32 * ML_TROW + kk * 32), cacc[s]);
                if (ML_NS > 2) __builtin_amdgcn_sched_barrier(0); }
            LAS unsigned char* cs = lds + ML_CS + r32 * ML_QROW + (32 * wid + 4 * hi) * 2;
#pragma unroll
            for (int s = 0; s < ML_NS; ++s)
#pragma unroll
                for (int g = 0; g < 4; ++g) *(LAS u32x2*)(cs + s * 32 * ML_QROW + g * 16) = (u32x2){pk2(cacc[s][4 * g], cacc[s][4 * g + 1]), pk2(cacc[s][4 * g + 2], cacc[s][4 * g + 3])};
        } else {
          if (wid - 4 < ML_IW) {
            const int jb = (wid - 4) & 1, s0 = ((wid - 4) >> 1) * ML_WSL;
#pragma unroll
            for (int r = 0; r < 16; ++r) { const float wi = WINT[32 * jb + crow(r, hi)];
#pragma unroll
                for (int s = 0; s < ML_WSL; ++s) cacc[s][r] *= wi; }
            const LAS unsigned char* sa = lds + ML_SS + (32 * jb + r32) * ML_TROW + hi * 16; const LAS unsigned char* vb = lds + ML_VTS + (s0 * 32 + r32) * ML_TROW + hi * 16;
#pragma unroll
            for (int kk = 0; kk < 4; ++kk) { const bf16x8 sv_ = *(const LAS bf16x8*)(sa + kk * 32);
#pragma unroll
                for (int s = 0; s < ML_WSL; ++s) cacc[s] = MFMA32(sv_, *(const LAS bf16x8*)(vb + s * 32 * ML_TROW + kk * 32), cacc[s]); }
          }
          if (wid >= 6) {
            const int tl = (wid - 6) * 64 + lane;
            { const int j = tl >> 1, half = tl & 1; const LAS unsigned char* sp = lds + ML_SS + j * ML_TROW + half * 64; float rs = 0.f;
#pragma unroll
              for (int i = 0; i < 4; ++i) { const u32x4 w = *(const LAS u32x4*)(sp + i * 16); rs += (bflo(w.x) + bfhi(w.x)) + (bflo(w.y) + bfhi(w.y)) + (bflo(w.z) + bfhi(w.z)) + (bflo(w.w) + bfhi(w.w)); }
              rs += __shfl_xor(rs, 1);
              if (half == 0) { const float den = WINT[j] * NQ[j] + rs; DINV[j] = 1.0f / fmaxf(fabsf(den), ENEG[j]); } }
            { const int k = tl; const LAS unsigned char* kp = lds + ML_KTS + k * ML_TROW; float acc = SCAL[0] * NVEC[k];
#pragma unroll
              for (int i = 0; i < 8; ++i) { const u32x4 w = *(const LAS u32x4*)(kp + i * 16); const f32x4 w0 = *(const LAS f32x4*)(WAS + i * 8), w1 = *(const LAS f32x4*)(WAS + i * 8 + 4);
                  acc += bflo(w.x) * w0[0] + bfhi(w.x) * w0[1] + bflo(w.y) * w0[2] + bfhi(w.y) * w0[3] + bflo(w.z) * w1[0] + bfhi(w.z) * w1[1] + bflo(w.w) * w1[2] + bfhi(w.w) * w1[3]; }
              NVEC[k] = acc; }
          }
        }
        __syncthreads();
        if (wid >= 4 && wid - 4 < ML_IW) {
            const int jb = (wid - 4) & 1, s0 = ((wid - 4) >> 1) * ML_WSL; bf16_t* hp = hraw + (tok0 + 32 * jb) * MW + h * MHD + (vs + s0) * 32 + r32;
#pragma unroll
            for (int r = 0; r < 16; ++r) { const int j = crow(r, hi); const float di = DINV[32 * jb + j];
#pragma unroll
                for (int s = 0; s < ML_WSL; ++s) hp[(size_t)j * MW + s * 32] = (bf16_t)pk2(cacc[s][r] * di, 0.f); }
        }
    }
#undef ML_LOAD
#undef ML_GLOAD
#undef ML_GVEC
    __syncthreads();
}
DI void p5_mlstm(CArgs args, LAS unsigned char* lds, int vcu, int G, int wv) {
    constexpr int UPH = 4 / ML_NS;
    if (ML_NS == 4 && G == 4 * NB * MH) { if ((vcu & 3) == 0) { const int bh = vcu >> 2; mlstm_unit(bh / MH, bh % MH, 0, args, lds, wv); } return; }
    for (int u = vcu; u < NB * MH * UPH; u += G) { const int vs = (u % UPH) * ML_NS, bh = u / UPH; mlstm_unit(bh / MH, bh % MH, vs, args, lds, wv); }
}
#ifndef MK_ONE_LAUNCH
#define MK_ONE_LAUNCH 1
#endif
#ifndef P3SEL
#define P3SEL 31
#endif
#ifndef P1_NCU
#define P1_NCU 0
#endif
#ifndef P1_TAIL_PCT
#define P1_TAIL_PCT 17
#endif
#ifndef STAG17
#define STAG17 0
#endif
#ifndef STAG18
#define STAG18 0
#endif
constexpr int NPH = 20;
__global__ void __launch_bounds__(NWAVES * 64, 2) fwd_kernel(Args args_byval) {
    extern __shared__ __attribute__((aligned(16))) unsigned char lds_raw[];
    LAS unsigned char* lds = (LAS unsigned char*)lds_raw;
    const int wv = __builtin_amdgcn_readfirstlane((int)(threadIdx.x >> 6)); const int tid = wv * 64 + lane_id();
    const int G = gridDim.x; const int bx = blockIdx.x; const int vcu = (G % 8 == 0) ? (bx % 8) * (G / 8) + bx / 8 : bx;
    const CArgs args0 = (CArgs)__builtin_amdgcn_kernarg_segment_ptr(); (void)args_byval;
#define args launder_args(args0)
    unsigned char* ws = args->ws;
    for (int u = tid; u < (LDS_BYTES - LDSCTL_OFF) / 4; u += NWAVES * 64) ((LAS unsigned*)(lds + LDSCTL_OFF))[u] = 0u;
    __syncthreads();
    volatile LAS unsigned* MISC = (volatile LAS unsigned*)(lds + MISC_OFF);
    XcdBarrier bar; bar.bar = (unsigned*)(ws + WS_CTL) + CW_BAR; bar.x = 0; bar.st = nullptr;
    const int lo = args->ph_lo, hi = args->ph_hi;
    if (hi - lo > 1) bar = xcd_barrier_post((unsigned*)(ws + WS_CTL) + CW_BAR, MISC + 8, wv);
#ifndef PHASE_MASK
#define PHASE_MASK 0xFFFFFu
#endif
#define IN(k) (((PHASE_MASK >> (k)) & 1u) && lo <= (k) && (k) < hi)
#ifndef DUP_PHASE
#define DUP_PHASE -1
#endif
#define REP(k) _Pragma("unroll 1") for (int rep_ = 0; rep_ < ((DUP_PHASE == (k)) ? 2 : 1); ++rep_)
#ifdef DUPBAR
#define SEAM(k) do { if (IN(k) && IN(NEXTPH(k))) { xcd_barrier(bar, wv); xcd_barrier(bar, wv); } } while (0)
#else
#define SEAM(k) do { if (IN(k) && IN(NEXTPH(k))) xcd_barrier(bar, wv); } while (0)
#endif
#define NEXTPH(k) (((k) == 7 || (k) == 12) ? (k) + 2 : ((k) == 14) ? 17 : (k) + 1)
    using namespace pg8;
    LAS unsigned char* ring = lds + RING_OFF;
    const bf16_t* cws = (const bf16_t*)ws;
#define WSB(off) ((bf16_t*)(ws + (off)))
#define WSF(off) ((float*)(ws + (off)))

    const int nconv = G / 4;
    if (IN(0)) REP(0) { p0_prologue<false>(args, lds, vcu * NWAVES + wv, G * NWAVES, wv); }
    SEAM(0);
    if (IN(1)) REP(1) {
#if P1_FP8
        constexpr int XW_ITEMS = NE * 8 * 96, XW_TAIL = (XW_ITEMS * P1_TAIL_PCT / 100) / 1024 * 1024;
        if (bx >= G - nconv) { p0_prologue<true>(args, lds, (bx - (G - nconv)) * NWAVES + wv, nconv * NWAVES, wv, 0, XW_ITEMS - XW_TAIL, true); __syncthreads(); }
        else { DenseOrder S; S.init(WSB(WS_XB), WSB(WS_W_IN), T, P1_NBF, D, D, G - nconv, bx); EpiProj E{WSB(WS_PROJ), WSF(WS_GATES), nullptr, nullptr, 0, 1.0f}; gemm_phase(ring, wv, D, D, D, S, E); }
        { P1Order S; S.proj.init(ws + WS_X8, ws + WS_W_IN8, T, NPROJ - P1_NBF, D, D, G, bx, 1); S.esz = 1; S.memb = (const char*)(ws + WS_MEMB); S.wck = (const char*)(ws + WS_W_CK); S.wcv = (const char*)(ws + WS_W_CV); S.G = G; S.c = bx; S.nconv = nconv; S.ncu = P1_NCU;
          EpiProj E{WSB(WS_PROJ), WSF(WS_GATES), WSB(WS_KC), WSB(WS_VCT), P1_NBF, 1.0f / (F8_XS * F8_WS)}; gemm_phase<EpiProj, P1Order, true>(ring, wv, D, D, D, S, E); }
        { const int ntail = (P1_NCU == 0 && XW_TAIL > 0) ? (G - nconv) - ((NPROJ - P1_NBF) / 256 * (T / 256) + 128) % (G - nconv) : 0, first = (G - nconv) - ntail;
          if (ntail > 0 && bx >= first && bx < G - nconv) { __syncthreads(); p0_prologue<true>(args, lds, (bx - first) * NWAVES + wv, ntail * NWAVES, wv, XW_ITEMS - XW_TAIL, XW_ITEMS, false); __syncthreads(); } }
#else
        { P1Order S; S.proj.init(WSB(WS_XB), WSB(WS_W_IN), T, NPROJ, D, D, G, bx, 2); S.esz = 2; S.memb = (const char*)(ws + WS_MEMB); S.wck = (const char*)(ws + WS_W_CK); S.wcv = (const char*)(ws + WS_W_CV); S.G = G; S.c = bx; S.nconv = 0; S.ncu = 0;
          EpiProj E{WSB(WS_PROJ), WSF(WS_GATES), WSB(WS_KC), WSB(WS_VCT), 0, 1.0f}; gemm_phase(ring, wv, D, D, D, S, E); }
#endif
    }
    SEAM(1);
    if (IN(2)) REP(2) { p2_tokens(args, vcu, G, wv); }
    SEAM(2);
    if (IN(3)) REP(3) {
        if (P3SEL & 1) { DenseOrder S; S.init(WSB(WS_QN), WSB(WS_W_UQ), T, AH * AQK, 256, 256, G, bx); EpiQmla E{WSB(WS_QMLA), WSF(WS_CS), 0.10206207261596575f * 1.4426950408889634f}; gemm_phase(ring, wv, 256, 256, 256, S, E); }
        if (P3SEL & 2) { DenseOrder S; S.init(WSB(WS_KVN), WSB(WS_W_UK), T, 512, 256, 256, G, bx); EpiBf16 E{WSB(WS_KN), 512, 1 << 30, 1.f}; gemm_phase(ring, wv, 128, 256, 256, S, E); }
        if (P3SEL & 4) { DenseOrder S; S.init(WSB(WS_W_UV), WSB(WS_KVN), 512, T, 256, 256, G, bx); EpiBf16 E{WSB(WS_VT), T, 1 << 30, 1.f}; gemm_phase(ring, wv, 128, 256, 256, S, E); }
        if (P3SEL & 8) { PairOrderA S{(const char*)(ws + WS_XC), (const char*)(ws + WS_W_MQK), G, vcu}; EpiBf16 E{WSB(WS_QKM), 1024, 2, 0.08838834764831845f}; gemm_phase(ring, wv, 256, 512, 256, S, E); }
        if (P3SEL & 16) { PairOrderB S{(const char*)(ws + WS_W_MQK) + (size_t)512 * 256 * 2, (const char*)(ws + WS_XC), G, vcu}; EpiBf16 E{WSB(WS_KTM), T, 0, 0.08838834764831845f}; gemm_phase(ring, wv, 256, 256, 512, S, E); }
    }
    SEAM(3);
    if (IN(4)) { REP(40) { p5_mlstm(args, lds, vcu, G, wv); } REP(41) { p4_attention(args, lds, vcu, G, wv); } }
    SEAM(4);
    if (IN(5)) REP(5) { p6_mpost(args, vcu, G, wv); }
    SEAM(5);
    if (IN(6)) REP(6) {
        { BranchOrder S; S.d.init(ws + WS_HM, ws + WS_W_BRM, T, D, 512, 512, G, bx, P6_FP8 ? 1 : 2); S.A1 = (const char*)(ws + WS_AO); S.B1 = (const char*)(ws + WS_W_BRA); S.rounds = (S.d.nwg + G - 1) / G;
          EpiGate E{WSB(WS_GATED), WSB(WS_PROJ), PC_GM, PC_GA, P6_FP8 ? 1.0f / (F8_XS * F8_WS) : 1.0f}; gemm_phase<EpiGate, BranchOrder, P6_FP8 != 0>(ring, wv, 512, 512, 512, S, E); }
    }
    SEAM(6);
    if (IN(7)) REP(7) { DenseOrder S; S.init(WSB(WS_GATED), WSB(WS_W_MIX), T, D, D, D, G, bx); EpiResStats<false> E{WSB(WS_XB), nullptr, nullptr, nullptr, WSB(WS_V1B), WSF(WS_STATS1), (LAS f32x2*)(lds + RED_OFF), CQ_FP8 ? ws + WS_V1B8 : nullptr, 1.0f}; gemm_phase(ring, wv, D, D, D, S, E); }
    SEAM(7);
    if (IN(9)) REP(9) { DenseOrder S; S.init(CQ_FP8 ? ws + WS_V1B8 : ws + WS_V1B, ws + WS_W_CQ, T, D, D, D, G, bx, CQ_FP8 ? 1 : 2); EpiLNApplyBf16 E{WSB(WS_QC), D, WSF(WS_STATS1), WSF(CTL_CS1), WSF(CTL_CB1), 0.0625f * 1.4426950408889634f, (LAS f32x2*)(lds + RED_OFF), CQ_FP8 ? 1.0f / (F8_XS * F8_WS) : 1.0f}; gemm_phase<EpiLNApplyBf16, DenseOrder, CQ_FP8 != 0>(ring, wv, D, D, D, S, E); }
    SEAM(9);
    if (IN(10)) REP(10) { CrossSOrder S{(const char*)(ws + WS_QC), (const char*)(ws + WS_KC), G, vcu, XS_FP8 ? 1 : 2}; EpiSoftmax E{WSB(WS_PC), (LAS float*)(lds + RED_OFF), XS_FP8 ? 1.0f / (F8_WS * F8_XS) : 1.0f}; gemm_phase<EpiSoftmax, CrossSOrder, XS_FP8 != 0>(ring, wv, 256, D, D, S, E); }
    SEAM(10);
    if (IN(11)) REP(11) { CrossOOrder S{(const char*)(ws + WS_PC), (const char*)(ws + WS_VCT), G, vcu, XA_FP8 ? 1 : 2}; if (CO_FP8) { EpiF8 E{ws + WS_OC, D, F8_OS * (XA_FP8 ? 1.0f / (F8_OS * F8_XS) : 1.0f)}; gemm_phase<EpiF8, CrossOOrder, XA_FP8 != 0>(ring, wv, 256, D, NB * NMEM, S, E); }
        else { EpiBf16 E{WSB(WS_OC), D, 0, XA_FP8 ? 1.0f / (F8_OS * F8_XS) : 1.0f}; gemm_phase<EpiBf16, CrossOOrder, XA_FP8 != 0>(ring, wv, 256, D, NB * NMEM, S, E); } }
    SEAM(11);
    if (IN(12)) REP(12) { { LAS float* gb = (LAS float*)(lds + GB_OFF); const int t_ = wv * 64 + lane_id(); const float* g1 = (const float*)args->in[19]; const float* b1 = (const float*)args->in[20];
          for (int i = t_; i < 1024; i += NWAVES * 64) { gb[i] = g1[i]; gb[1024 + i] = b1[i]; } __syncthreads(); }
        DenseOrder S; S.init(ws + WS_OC, ws + WS_W_CO, T, D, D, D, G, bx, CO_FP8 ? 1 : 2); EpiResStats<true> E{WSB(WS_V1B), WSF(WS_STATS1), (const float*)args->in[19], (const float*)args->in[20], WSB(WS_V2B), WSF(WS_STATS2), (LAS f32x2*)(lds + RED_OFF), nullptr, CO_FP8 ? 1.0f / (F8_OS * F8_WS) : 1.0f}; gemm_phase<EpiResStats<true>, DenseOrder, CO_FP8 != 0>(ring, wv, D, D, D, S, E); }
    SEAM(12);
    if (IN(14)) REP(14) { p14_router(args, lds, vcu, G, wv); }
    SEAM(14);
    if (IN(17)) REP(17) { build_tstart(args, lds, wv);
        LAS unsigned short* tab = (LAS unsigned short*)(lds + GB_OFF);
        { const unsigned short* rowtok = (const unsigned short*)(ws + WS_ROWTOK); const int total = ((const LAS int*)(lds + TST_OFF))[NE] * 8; const int t_ = wv * 64 + lane_id();
          const LAS int* tst_ = (const LAS int*)(lds + TST_OFF); const LAS int* tile_e_ = (const LAS int*)(lds + TILE_E_OFF); const LAS int* cnt_ = (const LAS int*)(lds + HIST_OFF);
          unsigned short val[13];
#pragma unroll
          for (int k = 0; k < 13; ++k) { const int idx = t_ + 512 * k, i = idx >> 8, r_ = idx & 255; val[k] = 0;
              if (i * G + vcu < total) { const int tile = (i * G + vcu) >> 3; const int e = tile_e_[tile]; const int r = (tile - tst_[e]) * 256 + r_; if (r < cnt_[e]) val[k] = rowtok[(size_t)e * RCAP + r]; } }
#pragma unroll
          for (int k = 0; k < 13; ++k) { const int idx = t_ + 512 * k; if ((idx >> 8) * G + vcu < total) tab[idx] = val[k]; }
          __syncthreads(); }
        MoeOrder S{(const char*)(ws + WS_XG), (const char*)(ws + WS_W_GU), (const LAS int*)(lds + TST_OFF), (const LAS int*)(lds + TILE_E_OFF), 8, G, vcu, (size_t)0, (size_t)2048 * 1024, (size_t)256 * 1024, tab};
        EpiSwiglu E{ws + WS_ACT, (const float*)args->in[29]}; gemm_phase<EpiSwiglu, MoeOrder, true, STAG17, true>(ring, wv, D, D, D, S, E); }
    SEAM(17);
    if (IN(18)) REP(18) { if (!IN(17)) build_tstart(args, lds, wv);
        MoeOrder S{(const char*)(ws + WS_ACT), (const char*)(ws + WS_W_DN), (const LAS int*)(lds + TST_OFF), (const LAS int*)(lds + TILE_E_OFF), 4, G, vcu, (size_t)256 * D, (size_t)1024 * 1024, (size_t)256 * 1024};
        EpiDown E{ws + WS_YB, (const float*)args->in[31], WSF(WS_ROWGATE)}; gemm_phase<EpiDown, MoeOrder, true, STAG18>(ring, wv, D, D, D, S, E); }
    SEAM(18);
    if (IN(19)) REP(19) { p20_final(args, lds, vcu, G, wv, IN(17)); }
    (void)cws;
#undef IN
#undef SEAM
#undef args
}

extern "C" void kernel_launch(void* const* d_in, const int* in_sizes, int n_in, void* d_out, int out_size, void* d_ws, size_t ws_size, hipStream_t stream) {
    static int grid = 0;
    if (grid == 0) {
        if (n_in != 34 || in_sizes[0] != T * D || out_size != T * D || ws_size < WS_END) { fprintf(stderr, "kernel_launch: unexpected shapes / workspace (n_in %d, ws %zu)\n", n_in, ws_size); grid = -1; return; }
        int dev = 0, cus = 0, per_cu = 0;
        if (hipGetDevice(&dev) != hipSuccess || hipDeviceGetAttribute(&cus, hipDeviceAttributeMultiprocessorCount, dev) != hipSuccess) { grid = -1; return; }
        if (hipFuncSetAttribute((const void*)fwd_kernel, hipFuncAttributeMaxDynamicSharedMemorySize, LDS_BYTES) != hipSuccess) { fprintf(stderr, "kernel_launch: hipFuncSetAttribute failed\n"); grid = -1; return; }
        if (hipOccupancyMaxActiveBlocksPerMultiprocessor(&per_cu, (const void*)fwd_kernel, NWAVES * 64, LDS_BYTES) != hipSuccess || per_cu < 1) fprintf(stderr, "kernel_launch: occupancy query says %d\n", per_cu);
        (void)hipGetLastError();
        grid = cus;
    }
    if (grid < 0) return;
    if (hipMemsetAsync((char*)d_ws + WS_CTL, 0, CTL_ZERO_BYTES, stream) != hipSuccess) return;
    Args a{};
    for (int i = 0; i < 34; ++i) a.in[i] = d_in[i];
    a.out = (float*)d_out; a.ws = (unsigned char*)d_ws;
#if MK_ONE_LAUNCH
    a.ph_lo = 0; a.ph_hi = NPH;
    hipLaunchKernelGGL(fwd_kernel, dim3(grid), dim3(NWAVES * 64), LDS_BYTES, stream, a);
#else
    for (int p = 0; p < NPH; ++p) { a.ph_lo = p; a.ph_hi = p + 1; hipLaunchKernelGGL(fwd_kernel, dim3(grid), dim3(NWAVES * 64), LDS_BYTES, stream, a); }
#endif
}
```
